# Optimizing an MI355X kernel written in HIP

```python
import math
import jax
import jax.numpy as jnp
from jax import lax
import numpy as np

D_MODEL = 1024
BATCH = 16
SEQ = 2048
DEPTH = 2

GRID_W = 64
CTX_LEN = 256
EPS = 1e-6
N_MOD = 6

H_A = 4
DK = 64
DV = 2 * DK
QK_W = H_A * 2 * DK
W_A = H_A * DV
ROT_AX = DK // 2
ROPE_BASE = 10000.0
Q_BLOCK = 128

W_B = 512
G_B = 4
CHUNK_B = 128

H_C = 4
DH_C = 128
W_C = H_C * DH_C
CONV_K = 3
MLSTM_CHUNK = 128

N_BRANCH = 3
W_BR = 512

A_K0 = 0
A_V0 = A_K0 + QK_W
C_X0 = A_V0 + W_A
MEM_COLS = C_X0 + W_C
A_Q0 = MEM_COLS
B_UV0 = A_Q0 + QK_W
C_Z0 = B_UV0 + 2 * W_B
GATE0 = C_Z0 + W_C
IN_COLS = GATE0 + N_BRANCH * D_MODEL

N_GROUPS = 4
EXP_PER_GROUP = 8
N_EXPERTS = N_GROUPS * EXP_PER_GROUP
TOP_K = 2
D_EXPERT = 512
MOE_BLOCK = 128

kernel_name = 'hybrid_prefix_diffattn_gmlp_mlstm_hmoe'


def rmsnorm(x, g):
    xf = x.astype(jnp.float32)
    y = xf * lax.rsqrt(jnp.mean(xf * xf, axis=-1, keepdims=True) + EPS)
    return y.astype(x.dtype) * g


def modulate(h, shift, scale):
    return h * (1 + scale) + shift


def axial_angles(n_tokens):
    rows = n_tokens // GRID_W
    row = jnp.broadcast_to(jnp.arange(rows)[:, None], (rows, GRID_W)).reshape(-1).astype(jnp.float32)
    col = jnp.broadcast_to(jnp.arange(GRID_W)[None, :], (rows, GRID_W)).reshape(-1).astype(jnp.float32)
    inv = ROPE_BASE ** (-jnp.arange(0, ROT_AX, 2, dtype=jnp.float32) / ROT_AX)
    return row[:, None] * inv, col[:, None] * inv


def rope_rotate(x, ang):
    cos = jnp.cos(ang)[:, None, None, :].astype(x.dtype)
    sin = jnp.sin(ang)[:, None, None, :].astype(x.dtype)
    x1, x2 = jnp.split(x, 2, axis=-1)
    return jnp.concatenate([x1 * cos - x2 * sin, x1 * sin + x2 * cos], axis=-1)


def apply_axial_rope(x, ang_r, ang_c):
    return jnp.concatenate([rope_rotate(x[..., :ROT_AX], ang_r), rope_rotate(x[..., ROT_AX:], ang_c)], axis=-1)


def diff_lambda_value(lp, layer_idx):
    lam_init = 0.8 - 0.6 * math.exp(-0.3 * layer_idx)
    lpf = lp.astype(jnp.float32)
    lam = jnp.exp(jnp.sum(lpf[0] * lpf[1])) - jnp.exp(jnp.sum(lpf[2] * lpf[3])) + lam_init
    return lam, lam_init


def diff_attention(q, k, v, lam):
    s = jnp.einsum('bqhmd,bkhmd->bhmqk', q.astype(jnp.float32), k.astype(jnp.float32)) * (DK ** -0.5)
    p = jax.nn.softmax(s, axis=-1)
    a = p[:, :, 0] - lam * p[:, :, 1]
    return jnp.einsum('bhqk,bkhd->bqhd', a, v.astype(jnp.float32)).astype(v.dtype)


def blocked_diff_attention(q, k, v, lam):
    b, t = q.shape[:2]
    nb = t // Q_BLOCK
    qb = jnp.moveaxis(q.reshape(b, nb, Q_BLOCK, *q.shape[2:]), 1, 0)
    o = lax.map(lambda blk: diff_attention(blk, k, v, lam), qb)
    return jnp.moveaxis(o, 0, 1).reshape(b, t, *o.shape[3:])


def diff_heads_out(o, g, lam_init):
    b, t = o.shape[:2]
    return (rmsnorm(o, g) * (1.0 - lam_init)).reshape(b, t, W_A)


def chunk_spatial_gate(uv, g_v, w_s, b_s):
    b, t, _ = uv.shape
    u, v = jnp.split(uv, 2, axis=-1)
    v = rmsnorm(v, g_v).reshape(b, t // CHUNK_B, CHUNK_B, G_B, W_B // G_B)
    mixed = jnp.einsum('gts,bcsgd->bctgd', w_s, v) + jnp.swapaxes(b_s, 0, 1)[:, :, None]
    return u * mixed.reshape(b, t, W_B)


def depthwise_conv(x, w, b):
    out = lax.conv_general_dilated(x, w[:, None, :], window_strides=(1,),
                                   padding=[(CONV_K // 2, CONV_K // 2)],
                                   dimension_numbers=('NWC', 'WIO', 'NWC'),
                                   feature_group_count=x.shape[-1])
    return out + b


def mlstm_features(xm, w_conv, b_conv, w_qkv, w_if, b_if):
    b, t, _ = xm.shape
    xconv = jax.nn.silu(depthwise_conv(xm, w_conv, b_conv))
    heads = lambda a: a.reshape(b, t, H_C, DH_C)
    q = jnp.einsum('bthd,hde->bthe', heads(xconv), w_qkv[0])
    k = jnp.einsum('bthd,hde->bthe', heads(xconv), w_qkv[1])
    v = jnp.einsum('bthd,hde->bthe', heads(xm), w_qkv[2])
    qkv = jnp.concatenate([q.reshape(b, t, W_C), k.reshape(b, t, W_C), v.reshape(b, t, W_C)], axis=-1)
    gates = (qkv @ w_if + b_if).reshape(b, t, 4, H_C)
    return xconv, q, k * (DH_C ** -0.5), v, gates


def mlstm_zero_state(b):
    return (jnp.zeros((b, H_C, DH_C, DH_C), jnp.float32),
            jnp.zeros((b, H_C, DH_C), jnp.float32),
            jnp.zeros((b, H_C), jnp.float32))


def mlstm_scan(q, k, v, i_pre, f_pre, state, with_h):
    b, t, h, dh = q.shape
    nc = t // MLSTM_CHUNK
    f32 = jnp.float32

    def chunks(a):
        a = a.astype(f32).reshape(b, nc, MLSTM_CHUNK, *a.shape[2:])
        return jnp.moveaxis(a, 3, 1)

    qc, kc, vc = chunks(q), chunks(k), chunks(v)
    ig = chunks(i_pre)
    bcum = jnp.cumsum(jax.nn.log_sigmoid(chunks(f_pre)), axis=-1)
    g = bcum[..., -1]
    a_end = g[..., None] - bcum + ig
    m_loc = jnp.max(a_end, axis=-1)
    w_end = jnp.exp(a_end - m_loc[..., None])
    c_loc = jnp.einsum('bhcs,bhcsd,bhcse->bhcde', w_end, vc, kc)
    n_loc = jnp.einsum('bhcs,bhcse->bhce', w_end, kc)

    def step(carry, xs):
        c_st, n_st, m_st = carry
        c_l, n_l, m_l, g_c = xs
        m_new = jnp.maximum(g_c + m_st, m_l)
        a_old = jnp.exp(g_c + m_st - m_new)
        a_new = jnp.exp(m_l - m_new)
        c_new = a_old[..., None, None] * c_st + a_new[..., None, None] * c_l
        n_new = a_old[..., None] * n_st + a_new[..., None] * n_l
        return (c_new, n_new, m_new), carry

    xs = tuple(jnp.moveaxis(a, 2, 0) for a in (c_loc, n_loc, m_loc, g))
    init = tuple(s.astype(f32) for s in state)
    final, starts = lax.scan(step, init, xs)
    if not with_h:
        return final
    c0, n0, m0 = (jnp.moveaxis(s, 0, 2) for s in starts)
    ln = MLSTM_CHUNK
    causal = jnp.tril(jnp.ones((ln, ln), dtype=bool))
    log_d = jnp.where(causal, bcum[..., :, None] - bcum[..., None, :] + ig[..., None, :], -jnp.inf)
    log_inter = bcum + m0[..., None]
    m_t = jnp.maximum(log_inter, jnp.max(log_d, axis=-1))
    s = jnp.einsum('bhctd,bhcsd->bhcts', qc, kc) * jnp.exp(log_d - m_t[..., None])
    w_inter = jnp.exp(log_inter - m_t)
    num = (jnp.einsum('bhcts,bhcsd->bhctd', s, vc)
           + w_inter[..., None] * jnp.einsum('bhcde,bhcte->bhctd', c0, qc))
    den = jnp.sum(s, axis=-1) + w_inter * jnp.einsum('bhce,bhcte->bhct', n0, qc)
    hh = num / jnp.maximum(jnp.abs(den), jnp.exp(-m_t))[..., None]
    hh = jnp.moveaxis(hh, 1, 3).reshape(b, t, h, dh)
    return hh.astype(q.dtype), final


def mlstm_bidir(q, k, v, gates, init_f, init_b, with_h):
    rev = lambda a: jnp.flip(a, axis=1)
    out_f = mlstm_scan(q, k, v, gates[:, :, 0], gates[:, :, 1], init_f, with_h)
    out_b = mlstm_scan(rev(q), rev(k), rev(v), rev(gates[:, :, 2]), rev(gates[:, :, 3]), init_b, with_h)
    if not with_h:
        return None, out_f, out_b
    h_f, st_f = out_f
    h_b, st_b = out_b
    return h_f + rev(h_b), st_f, st_b


def mlstm_out(h_sum, xconv, z, g, skip):
    b, t = h_sum.shape[:2]
    hn = rmsnorm(h_sum, g.reshape(H_C, DH_C)).reshape(b, t, W_C)
    return (hn + skip * xconv) * jax.nn.sigmoid(z)


def merge_branches(ys, gate_pre, w_br, w_o):
    g = jax.nn.sigmoid(gate_pre.reshape(*gate_pre.shape[:-1], N_BRANCH, D_MODEL))
    merged = (g[..., 0, :] * (ys[0] @ w_br[0]) + g[..., 1, :] * (ys[1] @ w_br[1])
              + g[..., 2, :] * (ys[2] @ w_br[2]))
    return merged @ w_o


def hier_route(h, w_rg, b_rg, w_re, b_re):
    f32 = jnp.float32
    hf = h.astype(f32)
    p_group = jax.nn.softmax(hf @ w_rg.astype(f32) + b_rg.astype(f32), axis=-1)
    g_star = jnp.argmax(p_group, axis=-1)
    logit_e = (hf @ w_re.astype(f32) + b_re.astype(f32)).reshape(-1, N_GROUPS, EXP_PER_GROUP)
    logit_sel = jnp.take_along_axis(logit_e, g_star[:, None, None], axis=1)[:, 0]
    top_v, top_i = lax.top_k(logit_sel, TOP_K)
    p_g = jnp.take_along_axis(p_group, g_star[:, None], axis=1)
    wt = jax.nn.softmax(top_v, axis=-1) * p_g
    eid = (g_star[:, None] * EXP_PER_GROUP + top_i).astype(jnp.int32)
    return eid, wt.astype(h.dtype)


def moe_experts(h, eid, wt, w_gate, w_up, w_down):
    n, d = h.shape
    a = n * TOP_K
    n_blocks = -(-(a + N_EXPERTS * (MOE_BLOCK - 1)) // MOE_BLOCK)
    slots = n_blocks * MOE_BLOCK
    flat_e = eid.reshape(a)
    flat_tok = jnp.repeat(jnp.arange(n, dtype=jnp.int32), TOP_K)
    flat_w = wt.reshape(a)
    order = jnp.argsort(flat_e)
    se, stok, sw = flat_e[order], flat_tok[order], flat_w[order]
    counts = jnp.bincount(flat_e, length=N_EXPERTS)
    start = jnp.cumsum(counts) - counts
    padded = (counts + MOE_BLOCK - 1) // MOE_BLOCK * MOE_BLOCK
    pend = jnp.cumsum(padded)
    dest = (pend - padded)[se] + jnp.arange(a) - start[se]
    buf_tok = jnp.full((slots,), n, jnp.int32).at[dest].set(stok)
    buf_w = jnp.zeros((slots,), wt.dtype).at[dest].set(sw)
    block_e = jnp.minimum(jnp.searchsorted(pend, jnp.arange(n_blocks) * MOE_BLOCK, side='right'),
                          N_EXPERTS - 1)
    xb = jnp.concatenate([h, jnp.zeros((1, d), h.dtype)], axis=0)[buf_tok].reshape(n_blocks, MOE_BLOCK, d)

    def run_block(args):
        xblk, e = args
        return (jax.nn.silu(xblk @ w_gate[e]) * (xblk @ w_up[e])) @ w_down[e]

    yb = lax.map(run_block, (xb, block_e)).reshape(slots, d)
    return jax.ops.segment_sum(yb * buf_w[:, None], buf_tok, num_segments=n + 1)[:n]


def setup_inputs(seed: int = 0) -> dict:
    key = jax.random.key(seed)
    ks = list(jax.random.split(key, 40))
    nrm = lambda shape, s: jax.random.normal(ks.pop(), shape, jnp.float32) * s
    D = D_MODEL
    L = DEPTH
    forget_bias = jnp.linspace(3.0, 6.0, H_C)
    b_if = (jnp.zeros((L, 4, H_C), jnp.float32).at[:, 1].set(forget_bias).at[:, 3].set(forget_bias)
            + nrm((L, 4, H_C), 0.1)).reshape(L, 4 * H_C)
    return {
        'x': nrm((BATCH, SEQ, D), 1.0),
        'c': nrm((BATCH, D), 1.0),
        'ctx': nrm((BATCH, CTX_LEN, D), 1.0),
        'c_ctx': nrm((D,), 1.0),
        'w_mod': nrm((L, D, N_MOD * D), 0.5 * D ** -0.5),
        'b_mod': nrm((L, N_MOD * D), 0.02),
        'g_norm1': 1.0 + nrm((L, D), 0.02),
        'g_norm2': 1.0 + nrm((L, D), 0.02),
        'w_in': nrm((L, D, IN_COLS), D ** -0.5),
        'diff_lambda': nrm((L, 4, DK), 0.1),
        'g_diff_subln': 1.0 + nrm((L, DV), 0.02),
        'w_gmlp_s': nrm((L, G_B, CHUNK_B, CHUNK_B), CHUNK_B ** -0.5),
        'b_gmlp_s': 1.0 + nrm((L, G_B, CHUNK_B), 0.02),
        'g_gmlp_v': 1.0 + nrm((L, W_B), 0.02),
        'w_conv_m': nrm((L, CONV_K, W_C), CONV_K ** -0.5),
        'b_conv_m': nrm((L, W_C), 0.02),
        'w_qkv_m': nrm((L, 3, H_C, DH_C, DH_C), DH_C ** -0.5),
        'w_if_m': nrm((L, 3 * W_C, 4 * H_C), (3 * W_C) ** -0.5),
        'b_if_m': b_if,
        'g_mlstm_norm': 1.0 + nrm((L, W_C), 0.02),
        'skip_m': 1.0 + nrm((L, W_C), 0.02),
        'w_branch': nrm((L, N_BRANCH, W_BR, D), W_BR ** -0.5),
        'w_out': nrm((L, D, D), D ** -0.5),
        'w_route_g': nrm((L, D, N_GROUPS), D ** -0.5),
        'b_route_g': nrm((L, N_GROUPS), 0.01),
        'w_route_e': nrm((L, D, N_EXPERTS), D ** -0.5),
        'b_route_e': nrm((L, N_EXPERTS), 0.01),
        'w_e_gate': nrm((L, N_EXPERTS, D, D_EXPERT), D ** -0.5),
        'w_e_up': nrm((L, N_EXPERTS, D, D_EXPERT), D ** -0.5),
        'w_e_down': nrm((L, N_EXPERTS, D_EXPERT, D), D_EXPERT ** -0.5),
        'g_final': 1.0 + nrm((D,), 0.02),
    }


def reference(x, c, ctx, c_ctx, w_mod, b_mod, g_norm1, g_norm2, w_in, diff_lambda, g_diff_subln,
              w_gmlp_s, b_gmlp_s, g_gmlp_v, w_conv_m, b_conv_m, w_qkv_m, w_if_m, b_if_m,
              g_mlstm_norm, skip_m, w_branch, w_out, w_route_g, b_route_g, w_route_e, b_route_e,
              w_e_gate, w_e_up, w_e_down, g_final):
    B, T, D = x.shape
    tc = ctx.shape[1]
    ang_r, ang_c = axial_angles(T)
    xc = ctx
    for l in range(DEPTH):
        last = l == DEPTH - 1
        mod = (jax.nn.silu(c) @ w_mod[l] + b_mod[l]).reshape(B, N_MOD, 1, D)
        mod_c = (jax.nn.silu(c_ctx) @ w_mod[l] + b_mod[l]).reshape(N_MOD, D)

        h = modulate(rmsnorm(x, g_norm1[l]), mod[:, 0], mod[:, 1])
        hc = modulate(rmsnorm(xc, g_norm1[l]), mod_c[0], mod_c[1])
        p = h @ w_in[l]
        pc = hc @ (w_in[l, :, :MEM_COLS] if last else w_in[l])
        lam, lam_init = diff_lambda_value(diff_lambda[l], l)

        q_lat = apply_axial_rope(p[..., A_Q0:A_Q0 + QK_W].reshape(B, T, H_A, 2, DK), ang_r, ang_c)
        k_lat = apply_axial_rope(p[..., A_K0:A_K0 + QK_W].reshape(B, T, H_A, 2, DK), ang_r, ang_c)
        v_lat = p[..., A_V0:A_V0 + W_A].reshape(B, T, H_A, DV)
        k_ctx = pc[..., A_K0:A_K0 + QK_W].reshape(B, tc, H_A, 2, DK)
        v_ctx = pc[..., A_V0:A_V0 + W_A].reshape(B, tc, H_A, DV)
        o_a = blocked_diff_attention(q_lat, jnp.concatenate([k_ctx, k_lat], axis=1),
                                     jnp.concatenate([v_ctx, v_lat], axis=1), lam)
        y_a = diff_heads_out(o_a, g_diff_subln[l], lam_init)

        y_b = chunk_spatial_gate(jax.nn.gelu(p[..., B_UV0:B_UV0 + 2 * W_B]), g_gmlp_v[l], w_gmlp_s[l], b_gmlp_s[l])

        mparams = (w_conv_m[l], b_conv_m[l], w_qkv_m[l], w_if_m[l], b_if_m[l])
        xconv_c, q_c, k_c, v_c, gates_c = mlstm_features(pc[..., C_X0:C_X0 + W_C], *mparams)
        zero = mlstm_zero_state(B)
        h_mc, st_f, st_b = mlstm_bidir(q_c, k_c, v_c, gates_c, zero, zero, not last)
        xconv, q_m, k_m, v_m, gates_m = mlstm_features(p[..., C_X0:C_X0 + W_C], *mparams)
        h_m, _, _ = mlstm_bidir(q_m, k_m, v_m, gates_m, st_f, st_b, True)
        y_c = mlstm_out(h_m, xconv, p[..., C_Z0:C_Z0 + W_C], g_mlstm_norm[l], skip_m[l])

        y = merge_branches((y_a, y_b, y_c), p[..., GATE0:], w_branch[l], w_out[l])
        x = x + mod[:, 2] * y

        if not last:
            q_ctx = pc[..., A_Q0:A_Q0 + QK_W].reshape(B, tc, H_A, 2, DK)
            yc_a = diff_heads_out(diff_attention(q_ctx, k_ctx, v_ctx, lam), g_diff_subln[l], lam_init)
            yc_b = chunk_spatial_gate(jax.nn.gelu(pc[..., B_UV0:B_UV0 + 2 * W_B]), g_gmlp_v[l],
                                      w_gmlp_s[l], b_gmlp_s[l])
            yc_c = mlstm_out(h_mc, xconv_c, pc[..., C_Z0:C_Z0 + W_C], g_mlstm_norm[l], skip_m[l])
            yc = merge_branches((yc_a, yc_b, yc_c), pc[..., GATE0:], w_branch[l], w_out[l])
            xc = xc + mod_c[2] * yc

        h2 = modulate(rmsnorm(x, g_norm2[l]), mod[:, 3], mod[:, 4]).reshape(B * T, D)
        if last:
            tokens = h2
        else:
            hc2 = modulate(rmsnorm(xc, g_norm2[l]), mod_c[3], mod_c[4]).reshape(B * tc, D)
            tokens = jnp.concatenate([hc2, h2], axis=0)
        eid, wt = hier_route(tokens, w_route_g[l], b_route_g[l], w_route_e[l], b_route_e[l])
        f = moe_experts(tokens, eid, wt, w_e_gate[l], w_e_up[l], w_e_down[l])
        if not last:
            xc = xc + mod_c[5] * f[:B * tc].reshape(B, tc, D)
        x = x + mod[:, 5] * f[f.shape[0] - B * T:].reshape(B, T, D)

    return rmsnorm(x, g_final)
```

```cpp
#include <hip/hip_runtime.h>
#include <cstdio>
#include <cstdint>

#define LAS __attribute__((address_space(3)))
typedef unsigned short bf16_t;
typedef short bf16x8 __attribute__((ext_vector_type(8)));
typedef short s16x4 __attribute__((ext_vector_type(4)));
typedef float f32x2 __attribute__((ext_vector_type(2)));
typedef float f32x4 __attribute__((ext_vector_type(4)));
typedef float f32x16 __attribute__((ext_vector_type(16)));
typedef unsigned u32x2 __attribute__((ext_vector_type(2)));
typedef unsigned u32x4 __attribute__((ext_vector_type(4)));

constexpr int DM = 1024, NBATCH = 16, SEQ = 2048, CTXL = 256, NCOL = 6656;
constexpr int HBAT = 8;
constexpr int MH = HBAT * (SEQ + CTXL);
constexpr int MTOT = 2 * MH;
constexpr int CTXROWS = HBAT * CTXL;
constexpr int NJ = 18;
constexpr int NEXP = 32, DEXP = 512;
constexpr int SLOTS = 81920;
constexpr float EPS = 1e-6f;
constexpr float LOG2E = 1.4426950408889634f;
constexpr float QSCALE = 0.125f * LOG2E;
constexpr int NTHR = 512;
constexpr int LDS_BYTES = 155648;
constexpr int TLD = 136;
constexpr int TILE_B = 128 * TLD * 2;

constexpr size_t AL(size_t x) { return (x + 255) / 256 * 256; }
constexpr size_t WS_CTL   = 0;
constexpr size_t CTL_BYTES = 262144;
constexpr size_t WS_MOD   = WS_CTL + CTL_BYTES;
constexpr size_t WS_WFOLD = WS_MOD + AL((size_t)2 * 17 * 6144 * 4);
constexpr size_t WS_ROPE  = WS_WFOLD + AL((size_t)2 * 16 * 1024 * 4);
constexpr size_t WS_LAM   = WS_ROPE + AL((size_t)2 * 64 * 16 * 4);
constexpr size_t WS_WRT   = WS_LAM + 256;
constexpr size_t WS_WTIN  = WS_WRT + AL((size_t)2 * 2 * 48 * 1024 * 2);
constexpr size_t WS_WTBR  = WS_WTIN + AL((size_t)2 * NCOL * 1024 * 2);
constexpr size_t WS_WTO   = WS_WTBR + AL((size_t)2 * 3072 * 512 * 2);
constexpr size_t WS_WTQKV = WS_WTO + AL((size_t)2 * 1024 * 1024 * 2);
constexpr size_t WS_WSB   = WS_WTQKV + AL((size_t)2 * 12 * 16384 * 2);
constexpr size_t WS_WTGU  = WS_WSB + AL((size_t)2 * 4 * 16384 * 2);
constexpr size_t WS_WTD   = WS_WTGU + AL((size_t)32 * 1024 * 1024 * 2);
constexpr size_t WS_XC    = WS_WTD + AL((size_t)32 * 1024 * 512 * 2);
constexpr size_t WS_H     = WS_XC + AL((size_t)4096 * 1024 * 4);
constexpr size_t WS_EID   = WS_H + AL((size_t)MTOT * 1024 * 2);
constexpr size_t WS_WTK   = WS_EID + AL((size_t)MTOT * 8);
constexpr size_t WS_POS   = WS_WTK + AL((size_t)MTOT * 8);
constexpr size_t WS_WTS   = WS_POS + AL((size_t)MTOT * 8);
constexpr size_t WS_P     = WS_WTS + AL((size_t)SLOTS * 4);
constexpr size_t S1B      = (size_t)MH * 512 * 2;
constexpr size_t P_KB = 0, P_VB = S1B, P_XMB = 2 * S1B, P_QB = 3 * S1B, P_UB = 4 * S1B, P_ZB = 5 * S1B, P_VGB = 6 * S1B;
constexpr size_t P_GB   = 7 * S1B;
constexpr size_t P_MQ   = P_GB + (size_t)3 * MH * 1024 * 2;
constexpr size_t P_MK   = P_MQ + S1B, P_MVT = P_MK + S1B, P_XCV = P_MVT + S1B;
constexpr size_t P_GATES = P_XCV + S1B;
constexpr size_t P_CLOC = P_GATES + AL((size_t)MH * 16 * 4);
constexpr size_t P_NLOC = P_CLOC + (size_t)64 * NJ * 16384 * 4;
constexpr size_t P_MST  = P_NLOC + AL((size_t)64 * NJ * 128 * 4);
constexpr size_t P_END  = P_MST + AL((size_t)64 * NJ * 4 * 4);
constexpr size_t P_XB   = 0;
constexpr size_t P_ACT  = (size_t)SLOTS * 1024 * 2;
constexpr size_t P_MOE_END = P_ACT + (size_t)SLOTS * 512 * 2;
constexpr size_t WS_END = WS_P + (P_END > P_MOE_END ? P_END : P_MOE_END);
constexpr int CW_EXPCNT = 0;
constexpr int CW_HIST = 32768;
constexpr int CW_BAR = 1024;

__device__ __forceinline__ unsigned cvtpk(float lo, float hi) { unsigned r; asm volatile("v_cvt_pk_bf16_f32 %0, %1, %2" : "=v"(r) : "v"(lo), "v"(hi)); return r; }
__device__ __forceinline__ float bf_lo(unsigned w) { return __uint_as_float(w << 16); }
__device__ __forceinline__ float bf_hi(unsigned w) { return __uint_as_float(w & 0xffff0000u); }
__device__ __forceinline__ float bf2f(bf16_t b) { return __uint_as_float(((unsigned)b) << 16); }
__device__ __forceinline__ bf16_t f2bf(float f) { unsigned u = __float_as_uint(f); u += 0x7FFFu + ((u >> 16) & 1u); return (bf16_t)(u >> 16); }
__device__ __forceinline__ float sigmoid_f(float x) { return __builtin_amdgcn_rcpf(1.0f + __builtin_amdgcn_exp2f(-x * LOG2E)); }
__device__ __forceinline__ float gelu_tanh_f(float x) { const float u = 0.7978845608028654f * (x + 0.044715f * x * x * x); return x * sigmoid_f(2.0f * u); }
__device__ __forceinline__ float silu_f(float x) { return x * sigmoid_f(x); }
__device__ __forceinline__ float logsigmoid_f(float x) { return x < 0.f ? x - log1pf(__expf(x)) : -log1pf(__expf(-x)); }
__device__ __forceinline__ int crow(int r, int hi) { return (r & 3) + 8 * (r >> 2) + 4 * hi; }
__device__ __forceinline__ f32x16 mfma32(bf16x8 a, bf16x8 b, f32x16 c) { return __builtin_amdgcn_mfma_f32_32x32x16_bf16(a, b, c, 0, 0, 0); }
__device__ __forceinline__ float wave_sum(float v) { for (int o = 32; o >= 1; o >>= 1) v += __shfl_xor(v, o); return v; }
__device__ __forceinline__ float wave_max(float v) { for (int o = 32; o >= 1; o >>= 1) v = fmaxf(v, __shfl_xor(v, o)); return v; }

__device__ __forceinline__ int opaque_tid() { int t = threadIdx.x; asm volatile("" : "+v"(t)); return t; }
struct Params {
    const float* in[31];
    float* out;
    unsigned char* ws;
    int ph_lo, ph_hi;
};
enum { I_X = 0, I_C, I_CTX, I_CCTX, I_WMOD, I_BMOD, I_GN1, I_GN2, I_WIN, I_DLAM, I_GSUBLN, I_WGS, I_BGS, I_GGV, I_WCONV, I_BCONV, I_WQKV, I_WIF, I_BIF,
       I_GMN, I_SKIP, I_WBR, I_WOUT, I_WRG, I_BRG, I_WRE, I_BRE, I_WEG, I_WEU, I_WED, I_GFIN };

struct RowInfo { int hf, r, isctx, b, t; };
__device__ __forceinline__ RowInfo row_info(int R) {
    RowInfo q; q.hf = R >= MH ? 1 : 0; q.r = R - q.hf * MH;
    if (q.r < CTXROWS) { q.isctx = 1; q.b = q.hf * HBAT + (q.r >> 8); q.t = q.r & 255; }
    else { q.isctx = 0; const int s = q.r - CTXROWS; q.b = q.hf * HBAT + (s >> 11); q.t = s & 2047; }
    return q;
}
#define XB_TMO      128
#define XB_XCNT(j)  (256  + 64 * (j))
#define XB_XSUB(j)  (1280 + 64 * (j))
#define XB_XGEN(j)  (2304 + 64 * (j))
#define XB_TOP      3328
#define XB_TOPGEN   3392
#define XCD_BAR_WORDS 3456
#define XB_SPIN_CAP (1u << 18)

__device__ __forceinline__ unsigned xb_ld(unsigned* p)              { return __hip_atomic_load(p, __ATOMIC_RELAXED, __HIP_MEMORY_SCOPE_AGENT); }
__device__ __forceinline__ unsigned xb_add(unsigned* p, unsigned v) { return __hip_atomic_fetch_add(p, v, __ATOMIC_RELAXED, __HIP_MEMORY_SCOPE_AGENT); }
__device__ __forceinline__ unsigned xb_xcc_id() { return (unsigned)__builtin_amdgcn_s_getreg((3 << 11) | 20) & 0xFu; }
#define XB_SPIN(cond, bar) do { unsigned _sp = 0; while (cond) { __builtin_amdgcn_s_sleep(1); \
    if ((++_sp & 255u) == 0u) { if (xb_ld(&(bar)[XB_TMO])) break; if (_sp > XB_SPIN_CAP) { atomicAdd(&(bar)[XB_TMO], 1u); break; } } } } while (0)

struct XcdBarrier {
    unsigned* bar; unsigned x;
    volatile LAS unsigned* st;
};

__device__ __forceinline__ XcdBarrier xcd_barrier_post(unsigned* bar, volatile LAS unsigned* st) {
    XcdBarrier b; b.bar = bar; b.x = xb_xcc_id(); b.st = st;
    if (threadIdx.x == 0) (void)xb_add(&bar[XB_XCNT(b.x)], 1u);
    return b;
}
__device__ __forceinline__ void xcd_barrier_complete(unsigned* bar, unsigned x, unsigned& nloc, unsigned& nx) {
    const unsigned G = gridDim.x * gridDim.y * gridDim.z;
    unsigned sum, cnt, mine, sp = 0u;
    for (;;) {
        sum = 0u; cnt = 0u; mine = 0u;
#pragma unroll
        for (unsigned j = 0; j < 16; ++j) { const unsigned c = xb_ld(&bar[XB_XCNT(j)]); sum += c; cnt += (c > 0u) ? 1u : 0u; mine = (j == x) ? c : mine; }
        if (sum == G) break;
        __builtin_amdgcn_s_sleep(1);
        if ((++sp & 255u) == 0u) { if (xb_ld(&bar[XB_TMO])) break; if (sp > XB_SPIN_CAP) { atomicAdd(&bar[XB_TMO], 1u); break; } }
    }
    nloc = mine > 0u ? mine : 1u; nx = cnt > 0u ? cnt : 1u;
}

__device__ __forceinline__ void xcd_barrier(const XcdBarrier& b) {
    asm volatile("s_waitcnt vmcnt(0)" ::: "memory");
    __syncthreads();
    if (threadIdx.x == 0) {
        unsigned* bar = b.bar;
        __builtin_amdgcn_s_waitcnt(0);
        unsigned nloc = b.st[0], nx = b.st[1];
        if (nloc == 0u) { xcd_barrier_complete(bar, b.x, nloc, nx); b.st[0] = nloc; b.st[1] = nx; }
        const unsigned old = xb_add(&bar[XB_XSUB(b.x)], 1u);
        const unsigned gen = old / nloc;
        if (old + 1u == (gen + 1u) * nloc) {
            __builtin_amdgcn_fence(__ATOMIC_RELEASE, "agent");
            asm volatile("s_waitcnt vmcnt(0)" ::: "memory");
            const unsigned og = xb_add(&bar[XB_TOP], 1u);
            const unsigned tg = og / nx;
            if (og + 1u == (tg + 1u) * nx) xb_add(&bar[XB_TOPGEN], 1u);
            else XB_SPIN(xb_ld(&bar[XB_TOPGEN]) == tg, bar);
            __builtin_amdgcn_fence(__ATOMIC_ACQUIRE, "agent");
            xb_add(&bar[XB_XGEN(b.x)], 1u);
            asm volatile("s_waitcnt vmcnt(0)" ::: "memory");
        } else {
            XB_SPIN(xb_ld(&bar[XB_XGEN(b.x)]) == gen, bar);
            __builtin_amdgcn_fence(__ATOMIC_ACQUIRE, "agent");
            asm volatile("s_waitcnt vmcnt(0)" ::: "memory");
        }
    }
    __syncthreads();
}
namespace pg8 {
#define PG8_LAS __attribute__((address_space(3)))
typedef unsigned short bf16_t;
typedef short bf16x8 __attribute__((ext_vector_type(8)));
typedef float f32x4 __attribute__((ext_vector_type(4)));
typedef unsigned u32x4 __attribute__((ext_vector_type(4)));
constexpr int BM = 256, BK = 64, HALF = 128, HTB = HALF * BK * 2  , STAGE_BYTES = 8 * HTB, NXCD = 8, WGM = 8;

__host__ __device__ __forceinline__ int lds_byte(int r, int c) { const int st = (r >> 4) * 2 + (c >> 5), rr = r & 15, cc = c & 31, ob = rr * 64 + cc * 2; return st * 1024 + (ob ^ (((ob >> 9) & 1) << 5)); }
__host__ __device__ __forceinline__ void stage_rc(int b, int& R, int& C) { const int st = b / 1024, sb = b % 1024, swz = sb ^ (((sb >> 9) & 1) << 5); R = (st >> 1) * 16 + swz / 64; C = (st & 1) * 32 + (swz % 64) / 2; }
__host__ __device__ __forceinline__ int perm32(int rho) { const int n = rho >> 4, i = rho & 15; return 8 * (i >> 2) + 4 * n + (i & 3); }

struct Unit { int pm, pn; };
struct Gemm { const bf16_t* A; const bf16_t* Bt; int M, N, K; };

struct StaticOrder {
    int nM, nN, nwg, G, c;
    __host__ __device__ void init(int M, int N, int G_, int c_) { nM = M / BM; nN = N / BM; nwg = nM * nN; G = G_; c = c_; }
    __host__ __device__ bool next(int i, Unit& u) const {
        const long L = (long)i * G + c; if (L >= nwg) return false;
        int wgid = (int)L; { const int q = nwg / NXCD, r = nwg % NXCD, xcd = wgid % NXCD, off = wgid / NXCD; wgid = (xcd < r ? xcd * (q + 1) : r * (q + 1) + (xcd - r) * q) + off; }
        const int nig = WGM * nN, gid = wgid / nig, fm = gid * WGM, gsz = (nM - fm) < WGM ? (nM - fm) : WGM;
        u.pm = fm + ((wgid % nig) % gsz); u.pn = (wgid % nig) / gsz; return true;
    }
    __device__ __forceinline__ void a_ready(const Unit&) const {}
    __device__ __forceinline__ void done(const Unit&) const {}
};
__device__ __forceinline__ unsigned cvt_pk_bf16(float lo, float hi) { unsigned r; asm volatile("v_cvt_pk_bf16_f32 %0, %1, %2" : "=v"(r) : "v"(lo), "v"(hi)); return r; }
typedef float f32x2 __attribute__((ext_vector_type(2)));
__device__ __forceinline__ f32x2 gelu_pk(f32x2 v) {
    const f32x2 av = __builtin_elementwise_abs(v), d = av * 0.2316418882f + 1.0f;
    f32x2 t; t.x = __builtin_amdgcn_rcpf(d.x); t.y = __builtin_amdgcn_rcpf(d.y);
    f32x2 q = t * 0.5307027145f + (-0.7265760135f); q = q * t + 0.7107068705f; q = q * t + (-0.142248368f); q = q * t + 0.127414796f; q = q * t;
    const f32x2 s = (v * v) * (-0.72134752044f);
    f32x2 e; e.x = __builtin_amdgcn_exp2f(s.x); e.y = __builtin_amdgcn_exp2f(s.y);
    const f32x2 m = v * (q * e), r = v - m;
    f32x2 o; o.x = v.x < 0.f ? m.x : r.x; o.y = v.y < 0.f ? m.y : r.y; return o;
}

template <class Epi, class Sched, bool STAMP = false>
__device__ __forceinline__ void gemm_phase(PG8_LAS unsigned char* lds, const Gemm g, const Sched& S, const Epi& E, unsigned long long* stamps) {
    int tid_o = threadIdx.x; asm volatile("" : "+v"(tid_o));
    const int tid = tid_o, wid = __builtin_amdgcn_readfirstlane(tid >> 6), lane = tid & 63, wr = wid >> 2, wc = wid & 3, fr = lane & 15, fq = lane >> 4;
    const int K = g.K, nt = K / BK;
    int ts_lo = 0, ts_hi = 0, nts = 0; const unsigned long long rt_entry = STAMP ? (unsigned long long)wall_clock64() : 0ull;
#define PG8_STAMP() do { if (STAMP && wid == 0 && nts < 64) { const unsigned long long _c = (unsigned long long)clock64(); \
        ts_lo = (lane == nts) ? (int)(unsigned)_c : ts_lo; ts_hi = (lane == nts) ? (int)(unsigned)(_c >> 32) : ts_hi; ++nts; } } while (0)
    PG8_STAMP();
    unsigned voffA[2], voffB[2];
#pragma unroll
    for (int i = 0; i < 2; ++i) { int R, C; stage_rc(tid * 16 + i * 8192, R, C); const int Rb = Epi::PERM ? ((R & ~31) + perm32(R & 31)) : R;
        voffA[i] = (unsigned)(R * K + C) * 2u; voffB[i] = (unsigned)(Rb * K + C) * 2u; }
    const size_t kstep = (size_t)(BK * 2);
    const size_t hstep = (size_t)HALF * K * 2;
    const size_t tstep = 2 * hstep;
    const unsigned ldsw = (unsigned)wid * 1024u;
    const int aoff = lds_byte(wr * 64 + fr, fq * 8), boff = lds_byte(wc * 32 + fr, fq * 8);
#define PG8_SA(b, h) (((b) * 2 + (h)) * HTB)
#define PG8_SB(b, h) ((4 + (b) * 2 + (h)) * HTB)
#define PG8_STAGE(bufoff, gbase, voff) do { _Pragma("unroll") for (int _i = 0; _i < 2; ++_i) \
        __builtin_amdgcn_global_load_lds((const unsigned*)((const char*)(gbase) + (voff)[_i]), (PG8_LAS unsigned*)(lds + (bufoff) + ldsw + _i * 8192), 16, 0, 0); } while (0)
#define PG8_LDA(dst, b, h) do { _Pragma("unroll") for (int m = 0; m < 4; ++m) _Pragma("unroll") for (int k = 0; k < 2; ++k) dst[m][k] = *(const PG8_LAS bf16x8*)(lds + PG8_SA(b, h) + aoff + m * 2048 + k * 1024); } while (0)
#define PG8_LDB(dst, b, h) do { _Pragma("unroll") for (int n = 0; n < 2; ++n) _Pragma("unroll") for (int k = 0; k < 2; ++k) dst[n][k] = *(const PG8_LAS bf16x8*)(lds + PG8_SB(b, h) + boff + n * 2048 + k * 1024); } while (0)
#define PG8_MMA(ai, bj, At, Bt) do { __builtin_amdgcn_s_setprio(1); _Pragma("unroll") for (int m = 0; m < 4; ++m) _Pragma("unroll") for (int n = 0; n < 2; ++n) _Pragma("unroll") for (int k = 0; k < 2; ++k) \
        acc[ai][bj][m][n] = __builtin_amdgcn_mfma_f32_16x16x32_bf16(Bt[n][k], At[m][k], acc[ai][bj][m][n], 0, 0, 0); __builtin_amdgcn_s_setprio(0); } while (0)
#define PG8_WAIT_V(n) asm volatile("s_waitcnt vmcnt(" #n ")" ::: "memory")
#define PG8_WAIT_L(n) asm volatile("s_waitcnt lgkmcnt(" #n ")" ::: "memory")
#define PG8_BAR __builtin_amdgcn_s_barrier()
#define PG8_SCHED __builtin_amdgcn_sched_barrier(0)
    Unit cur, nxt; int ui = 0;
    if (!S.next(0, cur)) return;
    f32x4 acc[2][2][4][2];
#pragma unroll
    for (int a = 0; a < 2; ++a)
#pragma unroll
        for (int b = 0; b < 2; ++b)
#pragma unroll
            for (int m = 0; m < 4; ++m)
#pragma unroll
                for (int n = 0; n < 2; ++n) acc[a][b][m][n] = (f32x4){0.f, 0.f, 0.f, 0.f};
    bf16x8 At[4][2], B0[2][2], B1[2][2];
    const char* cA = (const char*)g.A + (size_t)cur.pm * tstep; const char* cB = (const char*)g.Bt + (size_t)cur.pn * tstep;
    S.a_ready(cur);
    PG8_STAGE(PG8_SB(0, 0), cB, voffB); PG8_STAGE(PG8_SA(0, 0), cA, voffA); PG8_STAGE(PG8_SB(0, 1), cB + hstep, voffB); PG8_STAGE(PG8_SA(0, 1), cA + hstep, voffA);
    if (wr == 1) PG8_BAR;
    PG8_WAIT_V(4); PG8_BAR;
    PG8_STAGE(PG8_SB(1, 0), cB + kstep, voffB); PG8_STAGE(PG8_SA(1, 0), cA + kstep, voffA); PG8_STAGE(PG8_SB(1, 1), cB + hstep + kstep, voffB);
    PG8_WAIT_V(6); PG8_BAR;
    PG8_STAMP();
    for (;;) {
        const bool has_next = S.next(ui + 1, nxt);
        const char* nA = has_next ? (const char*)g.A + (size_t)nxt.pm * tstep : cA; const char* nB = has_next ? (const char*)g.Bt + (size_t)nxt.pn * tstep : cB;
        for (int t = 0; t < nt; t += 2) {
            const bool last = (t == nt - 2);
            const char* a1 = cA + (size_t)(t + 1) * kstep;
            const char* a2 = last ? nA : cA + (size_t)(t + 2) * kstep; const char* b2 = last ? nB : cB + (size_t)(t + 2) * kstep;
            const char* a3 = a2 + kstep; const char* b3 = b2 + kstep;
            if (last && has_next) S.a_ready(nxt);
            PG8_LDB(B0, 0, 0); PG8_SCHED; PG8_LDA(At, 0, 0); PG8_STAGE(PG8_SA(1, 1), a1 + hstep, voffA);
            PG8_WAIT_L(8); PG8_BAR; PG8_WAIT_L(0); PG8_MMA(0, 0, At, B0); PG8_BAR; PG8_SCHED;
            PG8_LDB(B1, 0, 1); PG8_STAGE(PG8_SB(0, 0), b2, voffB);
            PG8_BAR; PG8_WAIT_L(0); PG8_MMA(0, 1, At, B1); PG8_BAR;
            PG8_LDA(At, 0, 1); PG8_STAGE(PG8_SA(0, 0), a2, voffA);
            PG8_BAR; PG8_WAIT_L(0); PG8_MMA(1, 0, At, B0); PG8_BAR; PG8_SCHED;
            PG8_STAGE(PG8_SB(0, 1), b2 + hstep, voffB);
            PG8_WAIT_V(6); PG8_BAR; PG8_MMA(1, 1, At, B1); PG8_BAR;
            PG8_LDB(B0, 1, 0); PG8_SCHED; PG8_LDA(At, 1, 0); PG8_STAGE(PG8_SA(0, 1), a2 + hstep, voffA);
            PG8_WAIT_L(8); PG8_BAR; PG8_WAIT_L(0); PG8_MMA(0, 0, At, B0); PG8_BAR; PG8_SCHED;
            PG8_LDB(B1, 1, 1); PG8_STAGE(PG8_SB(1, 0), b3, voffB);
            PG8_BAR; PG8_WAIT_L(0); PG8_MMA(0, 1, At, B1); PG8_BAR;
            PG8_LDA(At, 1, 1); PG8_STAGE(PG8_SA(1, 0), a3, voffA);
            PG8_BAR; PG8_WAIT_L(0); PG8_MMA(1, 0, At, B0); PG8_BAR; PG8_SCHED;
            PG8_STAGE(PG8_SB(1, 1), b3 + hstep, voffB);
            PG8_WAIT_V(6); PG8_BAR; PG8_MMA(1, 1, At, B1); PG8_BAR;
        }
        PG8_STAMP();
        const bool keep_acc = E(acc, cur, wr, wc, fr, fq); S.done(cur);
        PG8_STAMP();
        if (!has_next) break;
        if (!keep_acc)
#pragma unroll
        for (int a = 0; a < 2; ++a)
#pragma unroll
            for (int b = 0; b < 2; ++b)
#pragma unroll
                for (int m = 0; m < 4; ++m)
#pragma unroll
                    for (int n = 0; n < 2; ++n) acc[a][b][m][n] = (f32x4){0.f, 0.f, 0.f, 0.f};
        cur = nxt; cA = nA; cB = nB; ++ui;
    }
    PG8_WAIT_V(0);
    if (wr == 0) PG8_BAR;
    PG8_BAR;
    PG8_STAMP();
    if (STAMP && wid == 0) { stamps[lane] = lane < nts ? (((unsigned long long)(unsigned)ts_hi << 32) | (unsigned)ts_lo) : 0ull;
        if (lane == 62) stamps[62] = rt_entry; if (lane == 63) stamps[63] = (unsigned long long)wall_clock64(); }
#undef PG8_STAMP
#undef PG8_SA
#undef PG8_SB
#undef PG8_STAGE
#undef PG8_LDA
#undef PG8_LDB
#undef PG8_MMA
#undef PG8_WAIT_V
#undef PG8_WAIT_L
#undef PG8_BAR
#undef PG8_SCHED
}
}
struct RectOrder {
    pg8::StaticOrder so; int offA, nwgA, nMb, nNb, offB, nwgB, G, c;
    __device__ void init(int nMa, int nNa, int offA_, int nMb_, int nNb_, int offB_, int G_, int c_) {
        so.init(nMa * 256, nNa * 256, G_, c_); offA = offA_; nwgA = nMa * nNa; nMb = nMb_; nNb = nNb_; offB = offB_; nwgB = nMb_ * nNb_; G = G_; c = c_; }
    __device__ bool next(int i, pg8::Unit& u) const {
        const int L = i * G + c;
        if (L < nwgA) { so.next(i, u); u.pm += offA; return true; }
        const int Lb = L - nwgA; if (Lb >= nwgB) return false;
        u.pm = offB + Lb % nMb; u.pn = Lb / nMb; return true;
    }
    __device__ __forceinline__ void a_ready(const pg8::Unit&) const {}
    __device__ __forceinline__ void done(const pg8::Unit&) const {}
};
struct MergeOrder {
    pg8::StaticOrder so; int off, G, c;
    __device__ void init(int nM, int off_, int G_, int c_) { so.init(nM * 256, 1024, G_, c_); off = off_; G = G_; c = c_; }
    __device__ bool next(int i, pg8::Unit& u) const {
        const int ti = i / 3, br = i - ti * 3;
        if (!so.next(ti, u)) return false;
        u.pm += off + br * (MH / 256); u.pn += br * 4; return true;
    }
    __device__ __forceinline__ void a_ready(const pg8::Unit&) const {}
    __device__ __forceinline__ void done(const pg8::Unit&) const {}
};
struct MoeOrder {
    int e0, e1, e2, e3, e4, e5, ntiles, G, c;
    __device__ __forceinline__ int look(const LAS int* tile_e, int i) const { const int pm = (i * G + c) >> 2; return __builtin_amdgcn_readfirstlane(pm < ntiles ? tile_e[pm] : 0); }
    __device__ __forceinline__ void init(const LAS int* tile_e, int nt, int G_, int c_) { ntiles = nt; G = G_; c = c_;
        e0 = look(tile_e, 0); e1 = look(tile_e, 1); e2 = look(tile_e, 2); e3 = look(tile_e, 3); e4 = look(tile_e, 4); e5 = look(tile_e, 5); }
    __device__ __forceinline__ bool next(int i, pg8::Unit& u) const {
        const int L = i * G + c; const int pm = L >> 2; if (pm >= ntiles || i >= 6) return false;
        const int e = i == 0 ? e0 : i == 1 ? e1 : i == 2 ? e2 : i == 3 ? e3 : i == 4 ? e4 : e5;
        u.pm = pm; u.pn = e * 4 + (L & 3); return true;
    }
    __device__ __forceinline__ void a_ready(const pg8::Unit&) const {}
    __device__ __forceinline__ void done(const pg8::Unit&) const {}
};

struct EpiIn {
    static constexpr bool PERM = true, AFTER_DRAIN = false;
    bf16_t* P; bf16_t* GB; const float* cosT; const float* sinT;
    __device__ __forceinline__ bool operator()(pg8::f32x4 (&acc)[2][2][4][2], const pg8::Unit& u, int wr, int wc, int fr, int fq) const {
        const int pn = u.pn, rbase = u.pm * 256 + wr * 64 + fr;
        int act, ld; bf16_t* dst; int cb; bool rope = false; float scl = 1.0f;
        if (pn < 14) {
            const int kind = pn >> 1;
            const int bufidx = kind == 5 ? 6 : (kind == 6 ? 5 : kind);
            dst = P + (size_t)bufidx * ((size_t)MH * 512); ld = 512; cb = (pn & 1) * 256 + wc * 32 + 8 * fq;
            act = (kind == 4 || kind == 5) ? 1 : (kind == 6 ? 2 : 0);
            rope = (kind == 0 || kind == 3) && (u.pm >= 8);
            if (kind == 3) scl = QSCALE;
        } else {
            const int gi = (pn - 14) >> 2;
            dst = GB + (size_t)gi * ((size_t)MH * 1024); ld = 1024; cb = ((pn - 14) & 3) * 256 + wc * 32 + 8 * fq; act = 2;
        }
#pragma unroll
        for (int ai = 0; ai < 2; ++ai)
#pragma unroll
            for (int m = 0; m < 4; ++m) {
                const int row = rbase + ai * 128 + m * 16;
                pg8::f32x4 cs = {1.f, 1.f, 1.f, 1.f}, sn = {0.f, 0.f, 0.f, 0.f};
                if (rope) { const int t = (row - CTXROWS) & 2047; const int pos = (wc & 1) ? (t & 63) : (t >> 6);
                    cs = *(const pg8::f32x4*)(cosT + pos * 16 + 4 * fq); sn = *(const pg8::f32x4*)(sinT + pos * 16 + 4 * fq); }
                bf16_t* rowp = dst + (size_t)row * ld + cb;
#pragma unroll
                for (int bj = 0; bj < 2; ++bj) {
                    pg8::f32x4 v0 = acc[ai][bj][m][0], v1 = acc[ai][bj][m][1];
                    if (rope) { const pg8::f32x4 o0 = v0 * cs - v1 * sn, o1 = v0 * sn + v1 * cs; v0 = o0; v1 = o1; }
                    v0 *= scl; v1 *= scl;
                    if (act == 1) {
#pragma unroll
                        for (int j = 0; j < 4; ++j) { v0[j] = gelu_tanh_f(v0[j]); v1[j] = gelu_tanh_f(v1[j]); } }
                    else if (act == 2) {
#pragma unroll
                        for (int j = 0; j < 4; ++j) { v0[j] = fmaxf(sigmoid_f(v0[j]), 1e-6f); v1[j] = fmaxf(sigmoid_f(v1[j]), 1e-6f); } }
                    u32x4 w; w.x = cvtpk(v0[0], v0[1]); w.y = cvtpk(v0[2], v0[3]); w.z = cvtpk(v1[0], v1[1]); w.w = cvtpk(v1[2], v1[3]);
                    *(u32x4*)(rowp + bj * 128) = w;
                }
            }
        return false;
    }
};
struct EpiMerge {
    static constexpr bool PERM = true, AFTER_DRAIN = false;
    const bf16_t* GB; bf16_t* OUT;
    __device__ __forceinline__ bool operator()(pg8::f32x4 (&acc)[2][2][4][2], const pg8::Unit& u, int wr, int wc, int fr, int fq) const {
        const int br = u.pn >> 2, pn = u.pn & 3, pm = u.pm - br * (MH / 256);
        const int rbase = pm * 256 + wr * 64 + fr, cb = pn * 256 + wc * 32 + 8 * fq;
        const bf16_t* g0 = GB + (size_t)br * ((size_t)MH * 1024);
        const bf16_t* g1 = g0 + (size_t)MH * 1024;
#pragma unroll
        for (int ai = 0; ai < 2; ++ai)
#pragma unroll
            for (int m = 0; m < 4; ++m) {
                const size_t off = (size_t)(rbase + ai * 128 + m * 16) * 1024 + cb;
#pragma unroll
                for (int bj = 0; bj < 2; ++bj) {
                    const u32x4 a = *(const u32x4*)(g0 + off + bj * 128);
                    float ga[8] = {bf_lo(a.x), bf_hi(a.x), bf_lo(a.y), bf_hi(a.y), bf_lo(a.z), bf_hi(a.z), bf_lo(a.w), bf_hi(a.w)};
                    if (br < 2) {
                        const u32x4 b = *(const u32x4*)(g1 + off + bj * 128);
                        const float gb[8] = {bf_lo(b.x), bf_hi(b.x), bf_lo(b.y), bf_hi(b.y), bf_lo(b.z), bf_hi(b.z), bf_lo(b.w), bf_hi(b.w)};
#pragma unroll
                        for (int j = 0; j < 8; ++j) ga[j] = ga[j] * __builtin_amdgcn_rcpf(gb[j]);
                    }
                    pg8::f32x4 v0 = acc[ai][bj][m][0], v1 = acc[ai][bj][m][1];
#pragma unroll
                    for (int j = 0; j < 4; ++j) { v0[j] *= ga[j]; v1[j] *= ga[4 + j]; }
                    if (br < 2) { acc[ai][bj][m][0] = v0; acc[ai][bj][m][1] = v1; }
                    else { u32x4 w; w.x = cvtpk(v0[0], v0[1]); w.y = cvtpk(v0[2], v0[3]); w.z = cvtpk(v1[0], v1[1]); w.w = cvtpk(v1[2], v1[3]);
                        *(u32x4*)(OUT + off + bj * 128) = w; }
                }
            }
        return br < 2;
    }
};
struct EpiOut {
    static constexpr bool PERM = false, AFTER_DRAIN = false;
    const float* xres_lat; const float* xres_ctx; float* xs_lat; float* xs_ctx; const float* mod; int hf;
    __device__ __forceinline__ bool operator()(pg8::f32x4 (&acc)[2][2][4][2], const pg8::Unit& u, int wr, int wc, int fr, int fq) const {
        const int pm = u.pm; const float* src; float* dst; int b;
        if (pm < 8) { b = 16; const size_t o = (size_t)((hf * HBAT + pm) * 256) * 1024; src = xres_ctx + o; dst = xs_ctx + o; }
        else { const int q = pm - 8; b = hf * HBAT + (q >> 3); const size_t o = ((size_t)b * 2048 + (size_t)(q & 7) * 256) * 1024; src = xres_lat + o; dst = xs_lat + o; }
        const int col0 = u.pn * 256 + wc * 32 + 4 * fq;
        const float* mrow = mod + (size_t)b * 6144 + 2 * 1024 + col0;
        pg8::f32x4 mv[2][2];
#pragma unroll
        for (int bj = 0; bj < 2; ++bj)
#pragma unroll
            for (int n = 0; n < 2; ++n) mv[bj][n] = *(const pg8::f32x4*)(mrow + bj * 128 + n * 16);
#pragma unroll
        for (int ai = 0; ai < 2; ++ai)
#pragma unroll
            for (int m = 0; m < 4; ++m) {
                const size_t off = (size_t)(wr * 64 + fr + ai * 128 + m * 16) * 1024 + col0;
#pragma unroll
                for (int bj = 0; bj < 2; ++bj)
#pragma unroll
                    for (int n = 0; n < 2; ++n) { const pg8::f32x4 xr = *(const pg8::f32x4*)(src + off + bj * 128 + n * 16);
                        *(pg8::f32x4*)(dst + off + bj * 128 + n * 16) = xr + mv[bj][n] * acc[ai][bj][m][n]; }
                asm volatile("" ::: "memory");
            }
        return false;
    }
};
struct EpiGU {
    static constexpr bool PERM = true, AFTER_DRAIN = false;
    bf16_t* ACT;
    __device__ __forceinline__ bool operator()(pg8::f32x4 (&acc)[2][2][4][2], const pg8::Unit& u, int wr, int wc, int fr, int fq) const {
        const int rbase = u.pm * 256 + wr * 64 + fr, cb = (u.pn & 3) * 128 + wc * 32 + 8 * fq;
#pragma unroll
        for (int ai = 0; ai < 2; ++ai)
#pragma unroll
            for (int m = 0; m < 4; ++m) {
                float o[8];
#pragma unroll
                for (int n = 0; n < 2; ++n)
#pragma unroll
                    for (int j = 0; j < 4; ++j) o[4 * n + j] = silu_f(acc[ai][0][m][n][j]) * acc[ai][1][m][n][j];
                u32x4 w; w.x = cvtpk(o[0], o[1]); w.y = cvtpk(o[2], o[3]); w.z = cvtpk(o[4], o[5]); w.w = cvtpk(o[6], o[7]);
                *(u32x4*)(ACT + (size_t)(rbase + ai * 128 + m * 16) * 512 + cb) = w;
            }
        return false;
    }
};
struct EpiDown {
    static constexpr bool PERM = true, AFTER_DRAIN = false;
    bf16_t* YS; const float* WTS;
    __device__ __forceinline__ bool operator()(pg8::f32x4 (&acc)[2][2][4][2], const pg8::Unit& u, int wr, int wc, int fr, int fq) const {
        const int rbase = u.pm * 256 + wr * 64 + fr, cb = (u.pn & 3) * 256 + wc * 32 + 8 * fq;
#pragma unroll
        for (int ai = 0; ai < 2; ++ai)
#pragma unroll
            for (int m = 0; m < 4; ++m) {
                const int row = rbase + ai * 128 + m * 16; const float w8 = 1.0f; (void)WTS;
#pragma unroll
                for (int bj = 0; bj < 2; ++bj) { const pg8::f32x4 v0 = acc[ai][bj][m][0] * w8, v1 = acc[ai][bj][m][1] * w8;
                    u32x4 w; w.x = cvtpk(v0[0], v0[1]); w.y = cvtpk(v0[2], v0[3]); w.z = cvtpk(v1[0], v1[1]); w.w = cvtpk(v1[2], v1[3]);
                    *(u32x4*)(YS + (size_t)row * 1024 + cb + bj * 128) = w; }
            }
        return false;
    }
};
template <class ColMap>
__device__ __forceinline__ void cvt_tile_T(const float* __restrict__ src, int ldsrc, bf16_t* __restrict__ dst, int K, int k0, int n0, const ColMap& cm, float scale, LAS float* tile) {
    const int tid = opaque_tid();
    {
        const int n = tid & 63, kb = tid >> 6; const int sc = cm(n0 + n);
#pragma unroll
        for (int i = 0; i < 8; ++i) { const int k = kb + 8 * i; tile[k * 65 + n] = src[(size_t)(k0 + k) * ldsrc + sc] * scale; }
    }
    __syncthreads();
    {
        const int kp = (tid & 31) * 2, nb = tid >> 5;
#pragma unroll
        for (int i = 0; i < 4; ++i) { const int n = nb + 16 * i; *(unsigned*)(dst + (size_t)(n0 + n) * K + k0 + kp) = cvtpk(tile[kp * 65 + n], tile[(kp + 1) * 65 + n]); }
    }
    __syncthreads();
}
struct CmIdent { int off; __device__ __forceinline__ int operator()(int n) const { return n + off; } };
struct CmWin {
    __device__ __forceinline__ int operator()(int n) const {
        if (n < 512 || (n >= 1536 && n < 2048)) { const int c = n & 31, f = c >> 3, j = c & 7; return (n & ~31) + ((j < 4) ? (4 * f + j) : (16 + 4 * f + (j - 4))); }
        return n; }
};
struct CmGU {
    __device__ __forceinline__ int operator()(int n) const { return 128 * (n >> 8) + (n & 127); }
};

__device__ __forceinline__ void phase_prologue(const Params& p, LAS unsigned char* lds) {
    LAS float* tile = (LAS float*)lds;
    const int tid = opaque_tid(), G = gridDim.x, bid = blockIdx.x;
    unsigned char* ws = p.ws;
    for (int u = bid; u < 4704; u += G) {
        if (u < 3328) { const int l = u / 1664, r = u % 1664, kt = r / 104, nt = r % 104;
            cvt_tile_T(p.in[I_WIN] + (size_t)l * 1024 * NCOL, NCOL, (bf16_t*)(ws + WS_WTIN) + (size_t)l * NCOL * 1024, 1024, kt * 64, nt * 64, CmWin{}, 1.0f, tile); }
        else if (u < 4096) { const int v = u - 3328, li = v / 128, r = v % 128, kt = r / 16, nt = r % 16;
            cvt_tile_T(p.in[I_WBR] + (size_t)li * 512 * 1024, 1024, (bf16_t*)(ws + WS_WTBR) + (size_t)li * 1024 * 512, 512, kt * 64, nt * 64, CmIdent{0}, 1.0f, tile); }
        else if (u < 4608) { const int v = u - 4096, l = v / 256, r = v % 256, kt = r / 16, nt = r % 16;
            cvt_tile_T(p.in[I_WOUT] + (size_t)l * 1024 * 1024, 1024, (bf16_t*)(ws + WS_WTO) + (size_t)l * 1024 * 1024, 1024, kt * 64, nt * 64, CmIdent{0}, 1.0f, tile); }
        else { const int v = u - 4608, m = v / 4, r = v % 4, kt = r >> 1, nt = r & 1;
            const int j = (m >> 2) % 3;
            cvt_tile_T(p.in[I_WQKV] + (size_t)m * 16384, 128, (bf16_t*)(ws + WS_WTQKV) + (size_t)m * 16384, 128, kt * 64, nt * 64, CmIdent{0}, j == 1 ? 0.08838834764831845f : 1.0f, tile); }
    }
    const int gt = bid * NTHR + tid, gn = G * NTHR;
    for (int i = gt; i < 2 * 4 * 16384; i += gn) ((bf16_t*)(ws + WS_WSB))[i] = f2bf(p.in[I_WGS][i]);
    for (int i = gt; i < 2 * 48 * 1024; i += gn) {
        const int l = i / (48 * 1024), r = i % (48 * 1024), n = r >> 10, k = r & 1023;
        float w = 0.f; if (n < 4) w = p.in[I_WRG][((size_t)l * 1024 + k) * 4 + n]; else if (n < 36) w = p.in[I_WRE][((size_t)l * 1024 + k) * 32 + (n - 4)];
        const bf16_t hi = f2bf(w); const bf16_t lo = f2bf(w - bf2f(hi));
        bf16_t* d = (bf16_t*)(ws + WS_WRT) + (size_t)l * 2 * 48 * 1024;
        d[r] = hi; d[48 * 1024 + r] = lo;
    }
    for (int i = gt; i < 1024; i += gn) { const int pos = i >> 4, f = i & 15; const float inv = powf(10000.0f, -(float)f / 16.0f); const float a = (float)pos * inv;
        ((float*)(ws + WS_ROPE))[i] = cosf(a); ((float*)(ws + WS_ROPE))[1024 + i] = sinf(a); }
    if (gt < 2) { const int l = gt; const float* lp = p.in[I_DLAM] + l * 256; float s01 = 0.f, s23 = 0.f;
        for (int i = 0; i < 64; ++i) { s01 += lp[i] * lp[64 + i]; s23 += lp[128 + i] * lp[192 + i]; }
        const float lam_init = 0.8f - 0.6f * expf(-0.3f * (float)l);
        float* o = (float*)(ws + WS_LAM) + l * 4; o[0] = expf(s01) - expf(s23) + lam_init; o[1] = 1.0f - lam_init; }
    for (int i = gt; i < 2 * 16 * 1024; i += gn) {
        const int l = i >> 14, gc = (i >> 10) & 15, ch = i & 1023, part = ch >> 9, c = ch & 511, h = c >> 7, d = c & 127;
        const float* wif = p.in[I_WIF] + (size_t)l * 1536 * 16; const float* wq = p.in[I_WQKV] + (size_t)l * 3 * 4 * 16384;
        float s = 0.f;
        if (part == 0) { const float* a = wq + ((size_t)(0 * 4 + h) * 128 + d) * 128; const float* b = wq + ((size_t)(1 * 4 + h) * 128 + d) * 128;
            for (int e = 0; e < 128; ++e) s += a[e] * wif[(size_t)(h * 128 + e) * 16 + gc] + b[e] * wif[(size_t)(512 + h * 128 + e) * 16 + gc]; }
        else { const float* a = wq + ((size_t)(2 * 4 + h) * 128 + d) * 128;
            for (int e = 0; e < 128; ++e) s += a[e] * wif[(size_t)(1024 + h * 128 + e) * 16 + gc]; }
        ((float*)(ws + WS_WFOLD))[i] = s;
    }
    {
        LAS float* sc = (LAS float*)lds;
        LAS float* red = sc + 17 * 1024;
        bool loaded = false;
        for (int u = bid; u < 96; u += G) {
            if (!loaded) { for (int i = tid; i < 17 * 1024; i += NTHR) { const float v = i < 16384 ? p.in[I_C][i] : p.in[I_CCTX][i - 16384]; sc[i] = silu_f(v); } loaded = true; }
            __syncthreads();
            const int l = u / 48, cbk = u % 48, col = cbk * 128 + (tid & 127), kq = tid >> 7;
            float a[17];
#pragma unroll
            for (int b = 0; b < 17; ++b) a[b] = 0.f;
            const float* wp = p.in[I_WMOD] + (size_t)l * 1024 * 6144 + col;
            for (int k = kq * 256; k < kq * 256 + 256; ++k) { const float w = wp[(size_t)k * 6144];
#pragma unroll
                for (int b = 0; b < 17; ++b) a[b] += sc[b * 1024 + k] * w; }
#pragma unroll
            for (int b = 0; b < 17; ++b) red[(kq * 17 + b) * 128 + (tid & 127)] = a[b];
            __syncthreads();
            for (int i = tid; i < 17 * 128; i += NTHR) { const int b = i >> 7, c = i & 127;
                const float s = red[(0 * 17 + b) * 128 + c] + red[(1 * 17 + b) * 128 + c] + red[(2 * 17 + b) * 128 + c] + red[(3 * 17 + b) * 128 + c];
                ((float*)(ws + WS_MOD))[((size_t)l * 17 + b) * 6144 + cbk * 128 + c] = s + p.in[I_BMOD][(size_t)l * 6144 + cbk * 128 + c]; }
            __syncthreads();
        }
    }
}

__device__ __forceinline__ void phase_cvt_experts(const Params& p, int l, LAS unsigned char* lds) {
    LAS float* tile = (LAS float*)lds; const int G = gridDim.x, bid = blockIdx.x; unsigned char* ws = p.ws;
    for (int u = bid; u < 32 * 256 + 32 * 128; u += G) {
        if (u < 8192) { const int e = u >> 8, r = u & 255, kt = r >> 4, nt = r & 15;
            const bool up = (nt & 2) != 0; const float* src = (up ? p.in[I_WEU] : p.in[I_WEG]) + ((size_t)l * 32 + e) * 1024 * 512;
            cvt_tile_T(src, 512, (bf16_t*)(ws + WS_WTGU) + (size_t)e * 1024 * 1024, 1024, kt * 64, nt * 64, CmGU{}, 1.0f, tile); }
        else { const int v = u - 8192, e = v >> 7, r = v & 127, kt = r >> 4, nt = r & 15;
            cvt_tile_T(p.in[I_WED] + ((size_t)l * 32 + e) * 512 * 1024, 1024, (bf16_t*)(ws + WS_WTD) + (size_t)e * 1024 * 512, 512, kt * 64, nt * 64, CmIdent{0}, 1.0f, tile); }
    }
}

__device__ __forceinline__ void ld_row_f32(const float* src, int lane, float (&v)[16]) {
    const f32x4 a = *(const f32x4*)(src + 8 * lane), b = *(const f32x4*)(src + 8 * lane + 4), c = *(const f32x4*)(src + 512 + 8 * lane), d = *(const f32x4*)(src + 512 + 8 * lane + 4);
#pragma unroll
    for (int j = 0; j < 4; ++j) { v[j] = a[j]; v[4 + j] = b[j]; v[8 + j] = c[j]; v[12 + j] = d[j]; }
}
__device__ __forceinline__ void st_row_f32(float* dst, int lane, const float (&v)[16]) {
    *(f32x4*)(dst + 8 * lane) = (f32x4){v[0], v[1], v[2], v[3]}; *(f32x4*)(dst + 8 * lane + 4) = (f32x4){v[4], v[5], v[6], v[7]};
    *(f32x4*)(dst + 512 + 8 * lane) = (f32x4){v[8], v[9], v[10], v[11]}; *(f32x4*)(dst + 512 + 8 * lane + 4) = (f32x4){v[12], v[13], v[14], v[15]};
}
__device__ __forceinline__ void ld_row_bf16(const bf16_t* src, int lane, float (&v)[16]) {
    const u32x4 a = *(const u32x4*)(src + 8 * lane), b = *(const u32x4*)(src + 512 + 8 * lane);
    v[0] = bf_lo(a.x); v[1] = bf_hi(a.x); v[2] = bf_lo(a.y); v[3] = bf_hi(a.y); v[4] = bf_lo(a.z); v[5] = bf_hi(a.z); v[6] = bf_lo(a.w); v[7] = bf_hi(a.w);
    v[8] = bf_lo(b.x); v[9] = bf_hi(b.x); v[10] = bf_lo(b.y); v[11] = bf_hi(b.y); v[12] = bf_lo(b.z); v[13] = bf_hi(b.z); v[14] = bf_lo(b.w); v[15] = bf_hi(b.w);
}
__device__ __forceinline__ void st_row_bf16(bf16_t* dst, int lane, const float (&v)[16]) {
    u32x4 a, b; a.x = cvtpk(v[0], v[1]); a.y = cvtpk(v[2], v[3]); a.z = cvtpk(v[4], v[5]); a.w = cvtpk(v[6], v[7]);
    b.x = cvtpk(v[8], v[9]); b.y = cvtpk(v[10], v[11]); b.z = cvtpk(v[12], v[13]); b.w = cvtpk(v[14], v[15]);
    *(u32x4*)(dst + 8 * lane) = a; *(u32x4*)(dst + 512 + 8 * lane) = b;
}
__device__ __forceinline__ void load_resid(const Params& p, int R, const RowInfo& q, int mode, int lmoe, int lane, float (&v)[16]) {
    const float* src; float* dst;
    if (q.isctx) { const size_t o = ((size_t)q.b * 256 + q.t) * 1024; src = (mode == 0 ? p.in[I_CTX] : (const float*)(p.ws + WS_XC)) + o; dst = (float*)(p.ws + WS_XC) + o; }
    else { const size_t o = ((size_t)q.b * 2048 + q.t) * 1024; src = (mode == 0 ? p.in[I_X] : (const float*)p.out) + o; dst = p.out + o; }
    ld_row_f32(src, lane, v);
    if (mode == 1 || mode == 3) {
        const int* slot = (const int*)(p.ws + WS_POS) + 2 * (size_t)R; const int s1 = slot[0], s2 = slot[1];
        const bf16_t* ys = (const bf16_t*)(p.ws + WS_P + P_XB);
        float y1[16], y2[16], m5[16]; ld_row_bf16(ys + (size_t)s1 * 1024, lane, y1); ld_row_bf16(ys + (size_t)s2 * 1024, lane, y2);
        ld_row_f32((const float*)(p.ws + WS_MOD) + ((size_t)lmoe * 17 + (q.isctx ? 16 : q.b)) * 6144 + 5 * 1024, lane, m5);
        const float wa = ((const float*)(p.ws + WS_WTK))[2 * (size_t)R], wb = ((const float*)(p.ws + WS_WTK))[2 * (size_t)R + 1];
#pragma unroll
        for (int j = 0; j < 16; ++j) v[j] += m5[j] * (wa * y1[j] + wb * y2[j]);
        if (mode == 1) st_row_f32(dst, lane, v);
    }
}
__device__ __forceinline__ void norm_mod_row(const Params& p, int l, int which, const RowInfo& q, int lane, const float (&v)[16], bf16_t* hrow) {
    float ss = 0.f;
#pragma unroll
    for (int j = 0; j < 16; ++j) ss += v[j] * v[j];
    ss = wave_sum(ss); const float rs = rsqrtf(ss * (1.0f / 1024.0f) + EPS);
    const float* mrow = (const float*)(p.ws + WS_MOD) + ((size_t)l * 17 + (q.isctx ? 16 : q.b)) * 6144;
    float g[16], sh[16], sc[16], o[16];
    ld_row_f32(p.in[which ? I_GN2 : I_GN1] + (size_t)l * 1024, lane, g);
    ld_row_f32(mrow + (which ? 3 : 0) * 1024, lane, sh); ld_row_f32(mrow + (which ? 4 : 1) * 1024, lane, sc);
#pragma unroll
    for (int j = 0; j < 16; ++j) o[j] = v[j] * rs * g[j] * (1.0f + sc[j]) + sh[j];
    st_row_bf16(hrow, lane, o);
}
__device__ __forceinline__ void phase_norm1(const Params& p, int l) {
    const int tid = opaque_tid(), wid = tid >> 6, lane = tid & 63;
    for (int R = blockIdx.x * 8 + wid; R < MTOT; R += gridDim.x * 8) {
        const RowInfo q = row_info(R); float v[16];
#ifdef EXP_NOMOE
        load_resid(p, R, q, l == 0 ? 0 : 2, l - 1, lane, v);
#else
        load_resid(p, R, q, l == 0 ? 0 : 1, l - 1, lane, v);
#endif
        norm_mod_row(p, l, 0, q, lane, v, (bf16_t*)(p.ws + WS_H) + (size_t)R * 1024);
    }
}
__device__ __forceinline__ void phase_final(const Params& p) {
    const int tid = opaque_tid(), wid = tid >> 6, lane = tid & 63;
    for (int a = blockIdx.x * 8 + wid; a < NBATCH * SEQ; a += gridDim.x * 8) {
        const int R = (a >> 14) * MH + CTXROWS + (a & 16383);
        const RowInfo q = row_info(R); float v[16];
#ifdef EXP_NOMOE
        load_resid(p, R, q, 2, 1, lane, v);
#else
        load_resid(p, R, q, 3, 1, lane, v);
#endif
        float ss = 0.f;
#pragma unroll
        for (int j = 0; j < 16; ++j) ss += v[j] * v[j];
        ss = wave_sum(ss); const float rs = rsqrtf(ss * (1.0f / 1024.0f) + EPS);
        float g[16]; ld_row_f32(p.in[I_GFIN], lane, g);
#pragma unroll
        for (int j = 0; j < 16; ++j) v[j] = v[j] * rs * g[j];
        st_row_f32(p.out + ((size_t)q.b * 2048 + q.t) * 1024, lane, v);
    }
}
__device__ __forceinline__ int active_row(int l, int a) { return l == 0 ? a : (a >> 14) * MH + CTXROWS + (a & 16383); }
typedef float f32x4v __attribute__((ext_vector_type(4)));
__device__ __forceinline__ void phase_norm2_router(const Params& p, int l, LAS unsigned char* lds) {
    const int tid = opaque_tid(), wid = tid >> 6, lane = tid & 63, G = gridDim.x, bid = blockIdx.x;
    const int NA = l == 0 ? MTOT : NBATCH * SEQ;
    const int chunk = (((NA + G - 1) / G) + 15) & ~15;
    const int a0 = bid * chunk, a1 = (a0 + chunk < NA) ? a0 + chunk : NA, na = a1 > a0 ? a1 - a0 : 0;
    LAS float* lg = (LAS float*)lds;
    LAS int* re = (LAS int*)(lds + 24576);
    LAS float* rw = (LAS float*)(lds + 24576 + 2048);
    LAS int* rr = (LAS int*)(lds + 24576 + 4096);
    LAS int* hist = (LAS int*)(lds + 24576 + 6144);
    LAS int* base = hist + 32;
    if (tid < 32) hist[tid] = 0;
    bf16_t* H = (bf16_t*)(p.ws + WS_H);
    for (int g = wid; g * 16 < na; g += 8)
        for (int i = 0; i < 16; ++i) { const int a = a0 + g * 16 + i; if (a >= a1) break;
            const int R = active_row(l, a); const RowInfo q = row_info(R); float v[16];
            load_resid(p, R, q, 2, 0, lane, v);
            norm_mod_row(p, l, 1, q, lane, v, H + (size_t)R * 1024); }
    asm volatile("s_waitcnt vmcnt(0)" ::: "memory"); __syncthreads();
    const bf16_t* Wr = (const bf16_t*)(p.ws + WS_WRT) + (size_t)l * 2 * 48 * 1024;
    const float* brg = p.in[I_BRG] + l * 4; const float* bre = p.in[I_BRE] + l * 32;
    for (int g = wid; g * 16 < na; g += 8) {
        int ar = a0 + g * 16 + (lane & 15); if (ar >= a1) ar = a1 - 1;
        const bf16_t* ap = H + (size_t)active_row(l, ar) * 1024 + 8 * (lane >> 4);
        f32x4v acc[3] = {{0.f, 0.f, 0.f, 0.f}, {0.f, 0.f, 0.f, 0.f}, {0.f, 0.f, 0.f, 0.f}};
        const bf16_t* bp = Wr + (size_t)(lane & 15) * 1024 + 8 * (lane >> 4);
#pragma unroll 2
        for (int ks = 0; ks < 32; ++ks) {
            const bf16x8 a = *(const bf16x8*)(ap + ks * 32);
#pragma unroll
            for (int ct = 0; ct < 3; ++ct) { const bf16x8 bh = *(const bf16x8*)(bp + (size_t)ct * 16 * 1024 + ks * 32), bl = *(const bf16x8*)(bp + (size_t)(48 + ct * 16) * 1024 + ks * 32);
                acc[ct] = __builtin_amdgcn_mfma_f32_16x16x32_bf16(a, bh, acc[ct], 0, 0, 0); acc[ct] = __builtin_amdgcn_mfma_f32_16x16x32_bf16(a, bl, acc[ct], 0, 0, 0); }
        }
        LAS float* lw = lg + wid * 16 * 48;
#pragma unroll
        for (int ct = 0; ct < 3; ++ct)
#pragma unroll
            for (int r = 0; r < 4; ++r) lw[((lane >> 4) * 4 + r) * 48 + ct * 16 + (lane & 15)] = acc[ct][r];
        asm volatile("s_waitcnt lgkmcnt(0)" ::: "memory");
        if (lane < 16) {
            const int a = a0 + g * 16 + lane;
            if (a < a1) {
                const LAS float* x = lw + lane * 48;
                float gl[4]; int gs = 0; float gmax;
#pragma unroll
                for (int j = 0; j < 4; ++j) gl[j] = x[j] + brg[j];
                gmax = gl[0];
#pragma unroll
                for (int j = 1; j < 4; ++j) if (gl[j] > gmax) { gmax = gl[j]; gs = j; }
                float gsum = 0.f;
#pragma unroll
                for (int j = 0; j < 4; ++j) gsum += __expf(gl[j] - gmax);
                const float pg = 1.0f / gsum;
                float v1 = -3.0e38f, v2 = -3.0e38f; int i1 = 0, i2 = 0;
                for (int j = 0; j < 8; ++j) { const float e = x[4 + gs * 8 + j] + bre[gs * 8 + j];
                    if (e > v1) { v2 = v1; i2 = i1; v1 = e; i1 = j; } else if (e > v2) { v2 = e; i2 = j; } }
                const float t = __expf(v2 - v1); const float w1 = pg / (1.0f + t), w2 = pg * t / (1.0f + t);
                const int e1 = gs * 8 + i1, e2 = gs * 8 + i2, i = a - a0;
                re[i] = e1; re[256 + i] = e2; rw[i] = w1; rw[256 + i] = w2;
            }
        }
        asm volatile("s_waitcnt lgkmcnt(0)" ::: "memory");
    }
    __syncthreads();
    if (tid < 32) { int c = 0; for (int i = 0; i < na; ++i) { if (re[i] == tid) rr[i] = c++; if (re[256 + i] == tid) rr[256 + i] = c++; } hist[tid] = c; }
    __syncthreads();
    int* hg = (int*)(p.ws + WS_CTL) + CW_HIST + (l * 256 + bid) * 32;
    if (tid < 32) hg[tid] = hist[tid];
    (void)base;
    int* EID = (int*)(p.ws + WS_EID); float* WTK = (float*)(p.ws + WS_WTK); int* POS = (int*)(p.ws + WS_POS);
    for (int i = tid; i < na; i += NTHR) { const size_t R = (size_t)active_row(l, a0 + i);
        EID[2 * R] = re[i]; EID[2 * R + 1] = re[256 + i]; WTK[2 * R] = rw[i]; WTK[2 * R + 1] = rw[256 + i];
        POS[2 * R] = rr[i]; POS[2 * R + 1] = rr[256 + i]; }
    __syncthreads();
}
__device__ __forceinline__ void moe_segments(const Params& p, int l, LAS int* seg, int myblk) {
    const int tid = opaque_tid(); LAS int* cnt = seg + 40; LAS int* pre = seg + 80;
    if (tid < 32) { const int* hg = (const int*)(p.ws + WS_CTL) + CW_HIST + l * 256 * 32 + tid; int tot = 0, pr = 0; const int nb = (int)gridDim.x;
        for (int b = 0; b < nb; ++b) { const int c = hg[b * 32]; if (b < myblk) pr += c; tot += c; }
        cnt[tid] = tot; pre[tid] = pr; }
    __syncthreads();
    if (tid == 0) { int s = 0; for (int e = 0; e < 32; ++e) { seg[e] = s; s += (cnt[e] + 255) & ~255; } if (s > SLOTS) s = SLOTS; seg[32] = s; }
    __syncthreads();
}
__device__ __forceinline__ void phase_dispatch(const Params& p, int l, LAS unsigned char* lds) {
    const int tid = opaque_tid(), wid = tid >> 6, lane = tid & 63, G = gridDim.x, bid = blockIdx.x;
    LAS int* seg = (LAS int*)lds; moe_segments(p, l, seg, bid); const LAS int* pre = seg + 80;
    const int NA = l == 0 ? MTOT : NBATCH * SEQ;
    const int chunk = (((NA + G - 1) / G) + 15) & ~15;
    const int a0 = bid * chunk, a1 = (a0 + chunk < NA) ? a0 + chunk : NA;
    const bf16_t* H = (const bf16_t*)(p.ws + WS_H); bf16_t* XB = (bf16_t*)(p.ws + WS_P + P_XB);
    const int* EID = (const int*)(p.ws + WS_EID); const float* WTK = (const float*)(p.ws + WS_WTK); int* POS = (int*)(p.ws + WS_POS); float* WTS = (float*)(p.ws + WS_WTS);
    for (int a = a0 + wid; a < a1; a += 8) {
        const size_t R = (size_t)active_row(l, a);
        const u32x4 h0 = *(const u32x4*)(H + R * 1024 + 8 * lane), h1 = *(const u32x4*)(H + R * 1024 + 512 + 8 * lane);
        const int e0 = EID[2 * R], e1 = EID[2 * R + 1], p0 = POS[2 * R], p1 = POS[2 * R + 1];
        const int s0 = seg[e0] + pre[e0] + p0, s1 = seg[e1] + pre[e1] + p1;
        *(u32x4*)(XB + (size_t)s0 * 1024 + 8 * lane) = h0; *(u32x4*)(XB + (size_t)s0 * 1024 + 512 + 8 * lane) = h1;
        *(u32x4*)(XB + (size_t)s1 * 1024 + 8 * lane) = h0; *(u32x4*)(XB + (size_t)s1 * 1024 + 512 + 8 * lane) = h1;
        if (lane == 0) { POS[2 * R] = s0; POS[2 * R + 1] = s1; WTS[s0] = WTK[2 * R]; WTS[s1] = WTK[2 * R + 1]; }
    }
    __syncthreads();
}
__device__ __forceinline__ int moe_tile_table(const Params& p, int l, LAS int* seg, LAS int* tile_e) {
    moe_segments(p, l, seg, 0);
    const int nt = seg[32] >> 8;
    for (int i = opaque_tid(); i < nt; i += NTHR) { int e = 0; for (int k = 1; k < 32; ++k) if ((i << 8) >= seg[k]) e = k; tile_e[i] = e; }
    __syncthreads();
    return __builtin_amdgcn_readfirstlane(nt);
}
__device__ __forceinline__ void lds_addf(LAS float* a, float v) { (void)__hip_atomic_fetch_add(a, v, __ATOMIC_RELAXED, __HIP_MEMORY_SCOPE_WORKGROUP); }
__device__ __forceinline__ bf16_t* pbuf(const Params& p, size_t off) { return (bf16_t*)(p.ws + WS_P + off); }
__device__ __forceinline__ void unpack8(const u32x4 w, float (&o)[8]) { o[0] = bf_lo(w.x); o[1] = bf_hi(w.x); o[2] = bf_lo(w.y); o[3] = bf_hi(w.y); o[4] = bf_lo(w.z); o[5] = bf_hi(w.z); o[6] = bf_lo(w.w); o[7] = bf_hi(w.w); }
__device__ __forceinline__ u32x4 pack8(const float (&v)[8]) { u32x4 w; w.x = cvtpk(v[0], v[1]); w.y = cvtpk(v[2], v[3]); w.z = cvtpk(v[4], v[5]); w.w = cvtpk(v[6], v[7]); return w; }
#ifndef MMU
#define MMU 2
#endif
__device__ __forceinline__ void mm128(const LAS bf16_t* A, const LAS bf16_t* Bt, f32x16 (&acc)[2], int wid, int lane) {
    const int r32 = lane & 31, hi = lane >> 5;
    const LAS bf16_t* ap = A + (32 * (wid >> 1) + r32) * TLD + hi * 8;
    const LAS bf16_t* bp = Bt + (64 * (wid & 1) + r32) * TLD + hi * 8;
#pragma unroll MMU
    for (int ks = 0; ks < 8; ++ks) {
        const bf16x8 a = *(const LAS bf16x8*)(ap + ks * 16), b0 = *(const LAS bf16x8*)(bp + ks * 16), b1 = *(const LAS bf16x8*)(bp + 32 * TLD + ks * 16);
        acc[0] = mfma32(a, b0, acc[0]); acc[1] = mfma32(a, b1, acc[1]);
    }
}
__device__ __forceinline__ void mm128_gB(const LAS bf16_t* A, const bf16_t* __restrict__ Bg, f32x16 (&acc)[2], int wid, int lane) {
    const int r32 = lane & 31, hi = lane >> 5;
    const LAS bf16_t* ap = A + (32 * (wid >> 1) + r32) * TLD + hi * 8;
    const bf16_t* bp = Bg + (64 * (wid & 1) + r32) * 128 + hi * 8;
#pragma unroll MMU
    for (int ks = 0; ks < 8; ++ks) {
        const bf16x8 a = *(const LAS bf16x8*)(ap + ks * 16), b0 = *(const bf16x8*)(bp + ks * 16), b1 = *(const bf16x8*)(bp + 32 * 128 + ks * 16);
        acc[0] = mfma32(a, b0, acc[0]); acc[1] = mfma32(a, b1, acc[1]);
    }
}
__device__ __forceinline__ void st_acc_T(LAS bf16_t* T, const f32x16 (&acc)[2], int wid, int lane) {
    const int r32 = lane & 31, hi = lane >> 5;
#pragma unroll
    for (int tl = 0; tl < 2; ++tl)
#pragma unroll
        for (int g = 0; g < 4; ++g) { u32x2 w; w.x = cvtpk(acc[tl][4 * g], acc[tl][4 * g + 1]); w.y = cvtpk(acc[tl][4 * g + 2], acc[tl][4 * g + 3]);
            *(LAS u32x2*)(T + (64 * (wid & 1) + 32 * tl + r32) * TLD + 32 * (wid >> 1) + 8 * g + 4 * hi) = w; }
}

__device__ __forceinline__ void st_acc_rm(LAS bf16_t* T, const f32x16 (&acc)[2], int wid, int lane) {
    const int r32 = lane & 31, hi = lane >> 5;
    LAS bf16_t* b = T + (32 * (wid >> 1) + 4 * hi) * TLD + 64 * (wid & 1) + r32;
#pragma unroll
    for (int tl = 0; tl < 2; ++tl)
#pragma unroll
        for (int r = 0; r < 16; ++r) b[((r & 3) + 8 * (r >> 2)) * TLD + 32 * tl] = (bf16_t)(cvtpk(acc[tl][r], acc[tl][r]) & 0xffffu);
}
constexpr int FLD = 132;
__device__ __forceinline__ void st_acc_f32(LAS float* F, const f32x16 (&acc)[2], int wid, int lane) {
    const int r32 = lane & 31, hi = lane >> 5;
    LAS float* b = F + (32 * (wid >> 1) + 4 * hi) * FLD + 64 * (wid & 1) + r32;
#pragma unroll
    for (int tl = 0; tl < 2; ++tl)
#pragma unroll
        for (int r = 0; r < 16; ++r) b[((r & 3) + 8 * (r >> 2)) * FLD + 32 * tl] = acc[tl][r];
}
__device__ __forceinline__ void copy_tile_out(const LAS bf16_t* T, bf16_t* dst, int ld) {
    const int tx = opaque_tid(), t = tx >> 2, c0 = (tx & 3) * 32;
#pragma unroll
    for (int i = 0; i < 4; ++i) *(u32x4*)(dst + (size_t)t * ld + c0 + 8 * i) = *(const LAS u32x4*)(T + t * TLD + c0 + 8 * i);
}

__device__ __forceinline__ void gmlp_unit(const Params& p, int l, int r0, LAS unsigned char* lds) {
    int tid_ = threadIdx.x; asm volatile("" : "+v"(tid_));
    const int tid = tid_, wid = __builtin_amdgcn_readfirstlane(tid >> 6), lane = tid & 63, r32 = lane & 31, hi = lane >> 5;
    LAS bf16_t* TA = (LAS bf16_t*)lds; LAS bf16_t* TB = (LAS bf16_t*)(lds + TILE_B); LAS float* rstd = (LAS float*)(lds + 2 * TILE_B);
    const bf16_t* VG = pbuf(p, P_VGB); bf16_t* UB = pbuf(p, P_UB);
    {
        const int s = tid >> 2, part = tid & 3; const bf16_t* src = VG + (size_t)(r0 + s) * 512 + part * 128; float ss = 0.f;
#pragma unroll
        for (int i = 0; i < 16; ++i) { float v[8]; unpack8(*(const u32x4*)(src + 8 * i), v);
#pragma unroll
            for (int j = 0; j < 8; ++j) ss += v[j] * v[j]; }
        ss += __shfl_xor(ss, 1); ss += __shfl_xor(ss, 2);
        if (part == 0) rstd[s] = rsqrtf(ss * (1.0f / 512.0f) + EPS);
    }
    __syncthreads();
    const bf16_t* Wsb = (const bf16_t*)(p.ws + WS_WSB) + (size_t)l * 4 * 16384;
    for (int g = 0; g < 4; ++g) {
        {
            const int t = tid >> 2, s0 = (tid & 3) * 32; const bf16_t* src = Wsb + (size_t)g * 16384 + t * 128 + s0;
#pragma unroll
            for (int i = 0; i < 4; ++i) { float v[8]; unpack8(*(const u32x4*)(src + 8 * i), v);
#pragma unroll
                for (int j = 0; j < 8; ++j) v[j] *= rstd[s0 + 8 * i + j];
                *(LAS u32x4*)(TA + t * TLD + s0 + 8 * i) = pack8(v); }
        }
        {
            const int s = tid >> 2, d0 = (tid & 3) * 32; const bf16_t* src = VG + (size_t)(r0 + s) * 512 + g * 128 + d0;
#pragma unroll
            for (int i = 0; i < 4; ++i) { const u32x4 w = *(const u32x4*)(src + 8 * i); const unsigned ww[4] = {w.x, w.y, w.z, w.w};
#pragma unroll
                for (int j = 0; j < 4; ++j) { TB[(d0 + 8 * i + 2 * j) * TLD + s] = (bf16_t)(ww[j] & 0xffffu); TB[(d0 + 8 * i + 2 * j + 1) * TLD + s] = (bf16_t)(ww[j] >> 16); } }
        }
        __syncthreads();
        f32x16 acc[2] = {}; mm128(TA, TB, acc, wid, lane);
        const float* gv = p.in[I_GGV] + l * 512 + g * 128; const float* bs = p.in[I_BGS] + (l * 4 + g) * 128;
#pragma unroll
        for (int tl = 0; tl < 2; ++tl) { const float gvd = gv[64 * (wid & 1) + 32 * tl + r32];
#pragma unroll
            for (int r = 0; r < 16; ++r) acc[tl][r] = acc[tl][r] * gvd + bs[32 * (wid >> 1) + crow(r, hi)]; }
        __syncthreads();
        LAS float* F = (LAS float*)lds; st_acc_f32(F, acc, wid, lane);
        __syncthreads();
        { const int t = tid >> 2, c0 = (tid & 3) * 32; bf16_t* up = UB + (size_t)(r0 + t) * 512 + g * 128 + c0;
#pragma unroll
          for (int i = 0; i < 4; ++i) { float u8[8]; unpack8(*(const u32x4*)(up + 8 * i), u8);
              const f32x4 m0 = *(const LAS f32x4*)(F + t * FLD + c0 + 8 * i), m1 = *(const LAS f32x4*)(F + t * FLD + c0 + 8 * i + 4);
#pragma unroll
              for (int j = 0; j < 4; ++j) { u8[j] *= m0[j]; u8[4 + j] *= m1[j]; }
              *(u32x4*)(up + 8 * i) = pack8(u8); } }
        __syncthreads();
    }
}

__device__ __forceinline__ void ld8row(const bf16_t* base, int pos, int seqlen, float (&o)[8]) {
    if (pos < 0 || pos >= seqlen) {
#pragma unroll
        for (int j = 0; j < 8; ++j) o[j] = 0.f; }
    else unpack8(*(const u32x4*)(base + (size_t)pos * 512), o);
}
__device__ __forceinline__ void mlstm_a_unit(const Params& p, int l, int bl, int J, int h, LAS unsigned char* lds) {
    int tid_ = threadIdx.x; asm volatile("" : "+v"(tid_));
    const int tid = tid_, wid = __builtin_amdgcn_readfirstlane(tid >> 6), lane = tid & 63, r32 = lane & 31, hi = lane >> 5;
    LAS bf16_t* T0 = (LAS bf16_t*)lds; LAS bf16_t* T1 = (LAS bf16_t*)(lds + TILE_B); LAS bf16_t* T2 = (LAS bf16_t*)(lds + 2 * TILE_B); LAS bf16_t* T3 = (LAS bf16_t*)(lds + 3 * TILE_B);
    LAS float* gl = (LAS float*)(lds + 4 * TILE_B);
    LAS float* wend = gl + 512;
    const int seqlen = J < 2 ? 256 : 2048, cpos = J < 2 ? J * 128 : (J - 2) * 128;
    const int rseq = J < 2 ? bl * 256 : CTXROWS + bl * 2048, r0 = rseq + cpos;
    const bf16_t* XM = pbuf(p, P_XMB); bf16_t* XCV = pbuf(p, P_XCV);
    {
        const int cg = lane, c0 = 8 * cg;
        float w0[8], w1[8], w2[8], bc[8];
        const float* wc = p.in[I_WCONV] + (size_t)l * 3 * 512 + c0; const float* bcp = p.in[I_BCONV] + (size_t)l * 512 + c0;
#pragma unroll
        for (int j = 0; j < 8; ++j) { w0[j] = wc[j]; w1[j] = wc[512 + j]; w2[j] = wc[1024 + j]; bc[j] = bcp[j]; }
        float bif[4];
        LAS float* wfl = (LAS float*)T3;
#pragma unroll
        for (int gi = 0; gi < 4; ++gi) { bif[gi] = p.in[I_BIF][l * 16 + gi * 4 + h];
            const float* wf = (const float*)(p.ws + WS_WFOLD) + ((size_t)l * 16 + gi * 4 + h) * 1024;
            for (int i = tid; i < 256; i += NTHR) *(LAS f32x4*)(wfl + gi * 1024 + 4 * i) = *(const f32x4*)(wf + 4 * i); }
        __syncthreads();
        const bf16_t* xb = XM + (size_t)rseq * 512 + c0;
        float xp[8], xc[8], xn[8]; int pos = cpos + 16 * wid;
        ld8row(xb, pos - 1, seqlen, xp); ld8row(xb, pos, seqlen, xc);
        const bool mine = (cg >> 4) == h;
        for (int i = 0; i < 16; ++i) {
            ld8row(xb, pos + 1, seqlen, xn);
            float y[8];
#pragma unroll
            for (int j = 0; j < 8; ++j) y[j] = silu_f(w0[j] * xp[j] + w1[j] * xc[j] + w2[j] * xn[j] + bc[j]);
            const int t = 16 * wid + i;
#pragma unroll
            for (int gi = 0; gi < 4; ++gi) { float s = 0.f;
                const f32x4 a0 = *(const LAS f32x4*)(wfl + gi * 1024 + c0), a1 = *(const LAS f32x4*)(wfl + gi * 1024 + c0 + 4), b0 = *(const LAS f32x4*)(wfl + gi * 1024 + 512 + c0), b1 = *(const LAS f32x4*)(wfl + gi * 1024 + 512 + c0 + 4);
#pragma unroll
                for (int j = 0; j < 4; ++j) s += y[j] * a0[j] + y[4 + j] * a1[j] + xc[j] * b0[j] + xc[4 + j] * b1[j];
                s = wave_sum(s); if (lane == 0) gl[t * 4 + gi] = s + bif[gi]; }
            if (mine) { const u32x4 yw = pack8(y); *(LAS u32x4*)(T0 + t * TLD + 8 * (cg & 15)) = yw; *(LAS u32x4*)(T1 + t * TLD + 8 * (cg & 15)) = pack8(xc);
                *(u32x4*)(XCV + (size_t)(r0 + t) * 512 + c0) = yw; }
#pragma unroll
            for (int j = 0; j < 8; ++j) { xp[j] = xc[j]; xc[j] = xn[j]; }
            ++pos;
        }
    }
    __syncthreads();
    if (tid < 128) *(f32x4*)((float*)(p.ws + WS_P + P_GATES) + (size_t)(r0 + tid) * 16 + h * 4) = *(const LAS f32x4*)(gl + tid * 4);
    const bf16_t* Wq = (const bf16_t*)(p.ws + WS_WTQKV) + ((size_t)(l * 3 + 0) * 4 + h) * 16384;
    {
        f32x16 acc[2] = {}; mm128_gB(T0, Wq, acc, wid, lane);
        st_acc_rm(T3, acc, wid, lane);
        __syncthreads();
        copy_tile_out(T3, pbuf(p, P_MQ) + (size_t)r0 * 512 + h * 128, 512);
        __syncthreads();
        acc[0] = f32x16{}; acc[1] = f32x16{}; mm128_gB(T0, Wq + (size_t)4 * 16384, acc, wid, lane);
        st_acc_T(T2, acc, wid, lane); st_acc_rm(T3, acc, wid, lane);
        __syncthreads();
        copy_tile_out(T3, pbuf(p, P_MK) + (size_t)r0 * 512 + h * 128, 512);
        __syncthreads();
        acc[0] = f32x16{}; acc[1] = f32x16{}; mm128_gB(T1, Wq + (size_t)8 * 16384, acc, wid, lane);
        st_acc_T(T3, acc, wid, lane);
    }
    if (wid < 2) {
        const int dir = wid, p0 = 2 * lane, p1 = p0 + 1, s0 = dir ? 127 - p0 : p0, s1 = dir ? 127 - p1 : p1;
        const float ig0 = gl[s0 * 4 + 2 * dir], ig1 = gl[s1 * 4 + 2 * dir];
        const float lf0 = logsigmoid_f(gl[s0 * 4 + 2 * dir + 1]), lf1 = logsigmoid_f(gl[s1 * 4 + 2 * dir + 1]);
        float incl = lf0 + lf1;
        for (int o = 1; o < 64; o <<= 1) { const float t = __shfl_up(incl, o); if (lane >= o) incl += t; }
        const float bc1 = incl, bc0 = incl - lf1, gg = __shfl(incl, 63);
        const float ae0 = gg - bc0 + ig0, ae1 = gg - bc1 + ig1; const float ml = wave_max(fmaxf(ae0, ae1));
        wend[dir * 128 + s0] = __expf(ae0 - ml); wend[dir * 128 + s1] = __expf(ae1 - ml);
        if (lane == 0) { float* mst = (float*)(p.ws + WS_P + P_MST) + ((size_t)(((bl * 4 + h) * 2 + dir) * NJ + J)) * 4; mst[0] = ml; mst[1] = gg; }
    }
    __syncthreads();
    {
        bf16_t* MVT = pbuf(p, P_MVT) + ((size_t)((bl * NJ + J) * 4 + h)) * 16384; const int d = tid >> 2, s0 = (tid & 3) * 32;
#pragma unroll
        for (int i = 0; i < 4; ++i) *(u32x4*)(MVT + d * 128 + s0 + 8 * i) = *(const LAS u32x4*)(T3 + d * TLD + s0 + 8 * i);
    }
#pragma unroll 1
    for (int dir = 0; dir < 2; ++dir) {
        const int combo = (bl * 4 + h) * 2 + dir;
        f32x16 acc[2] = {};
        const LAS bf16_t* ap = T3 + (32 * (wid >> 1) + r32) * TLD + hi * 8; const LAS bf16_t* bp = T2 + (64 * (wid & 1) + r32) * TLD + hi * 8;
        const LAS float* wv = wend + dir * 128 + hi * 8;
#pragma unroll
        for (int ks = 0; ks < 8; ++ks) {
            float a8[8]; unpack8(*(const LAS u32x4*)(ap + ks * 16), a8);
            const f32x4 wa = *(const LAS f32x4*)(wv + ks * 16), wb = *(const LAS f32x4*)(wv + ks * 16 + 4);
#pragma unroll
            for (int j = 0; j < 4; ++j) { a8[j] *= wa[j]; a8[4 + j] *= wb[j]; }
            const u32x4 aw = pack8(a8); const bf16x8 a = *(const bf16x8*)&aw;
            const bf16x8 b0 = *(const LAS bf16x8*)(bp + ks * 16), b1 = *(const LAS bf16x8*)(bp + 32 * TLD + ks * 16);
            acc[0] = mfma32(a, b0, acc[0]); acc[1] = mfma32(a, b1, acc[1]);
        }
        float* CL = (float*)(p.ws + WS_P + P_CLOC) + ((size_t)combo * NJ + J) * 16384;
        LAS float* F = (LAS float*)lds;
        st_acc_f32(F, acc, wid, lane);
        __syncthreads();
        { const int d = tid >> 2, e0 = (tid & 3) * 32;
#pragma unroll
          for (int i = 0; i < 8; ++i) *(f32x4*)(CL + d * 128 + e0 + 4 * i) = *(const LAS f32x4*)(F + d * FLD + e0 + 4 * i); }
        __syncthreads();
    }
    if (tid < 256) { const int dir = tid >> 7, e = tid & 127; float s = 0.f;
        for (int j = 0; j < 128; ++j) s += wend[dir * 128 + j] * bf2f(T2[e * TLD + j]);
        ((float*)(p.ws + WS_P + P_NLOC))[((size_t)(((bl * 4 + h) * 2 + dir) * NJ + J)) * 128 + e] = s; }
    __syncthreads();
}

__device__ __forceinline__ int scan_J(int dir, int pidx) { return dir == 0 ? pidx : (pidx == 0 ? 1 : (pidx == 1 ? 0 : 19 - pidx)); }
__device__ __forceinline__ void phase_scan(const Params& p) {
    const int NIT = 64 * 4128;
    float* CL = (float*)(p.ws + WS_P + P_CLOC); float* NL = (float*)(p.ws + WS_P + P_NLOC); float* MST = (float*)(p.ws + WS_P + P_MST);
    const int tid = opaque_tid();
    for (int w = blockIdx.x * NTHR + tid; w < NIT; w += gridDim.x * NTHR) {
        const int combo = w / 4128, q = w - combo * 4128, dir = combo & 1;
        float* base = q < 4096 ? CL + (size_t)combo * NJ * 16384 + 4 * q : NL + (size_t)combo * NJ * 128 + 4 * (q - 4096);
        const size_t cs = q < 4096 ? 16384 : 128;
        f32x4 st = {0.f, 0.f, 0.f, 0.f}; float m_st = 0.f;
        f32x4 vn = *(const f32x4*)(base + (size_t)scan_J(dir, 0) * cs);
#pragma unroll 1
        for (int i = 0; i < NJ; ++i) {
            const int J = scan_J(dir, i); float* ms = MST + ((size_t)combo * NJ + J) * 4;
            const f32x4 vc = vn; if (i + 1 < NJ) vn = *(const f32x4*)(base + (size_t)scan_J(dir, i + 1) * cs);
            const float ml = ms[0], gg = ms[1];
            const float m_new = fmaxf(gg + m_st, ml), a_old = __expf(gg + m_st - m_new), a_new = __expf(ml - m_new);
            *(f32x4*)(base + (size_t)J * cs) = st;
            if (q == 0) ms[2] = m_st;
            st = st * a_old + vc * a_new; m_st = m_new;
        }
    }
}

template <int dir>
__device__ __forceinline__ void mlstm_c_dir(const Params& p, int bl, int J, int h, const f32x16 (&as)[2], f32x16 (&acc)[2], LAS bf16_t* Tq, LAS bf16_t* Tv, LAS bf16_t* Ts,
                                            LAS float* av, LAS float* Mv, LAS float* wi, LAS float* denp, int tid, int wid, int lane) {
    const int r32 = lane & 31, hi = lane >> 5;

        const int combo = (bl * 4 + h) * 2 + dir;
        const float* C0 = (const float*)(p.ws + WS_P + P_CLOC) + ((size_t)combo * NJ + J) * 16384;
        const float* N0 = (const float*)(p.ws + WS_P + P_NLOC) + ((size_t)combo * NJ + J) * 128;
        acc[0] = f32x16{}; acc[1] = f32x16{};
        {
            const LAS bf16_t* ap = Tq + (32 * (wid >> 1) + r32) * TLD + hi * 8; const float* bp = C0 + (size_t)(64 * (wid & 1) + r32) * 128 + hi * 8;
#pragma unroll 2
            for (int ks = 0; ks < 8; ++ks) {
                const bf16x8 a = *(const LAS bf16x8*)(ap + ks * 16);
                const f32x4 c0 = *(const f32x4*)(bp + ks * 16), c1 = *(const f32x4*)(bp + ks * 16 + 4), c2 = *(const f32x4*)(bp + 32 * 128 + ks * 16), c3 = *(const f32x4*)(bp + 32 * 128 + ks * 16 + 4);
                u32x4 w0, w1; w0.x = cvtpk(c0[0], c0[1]); w0.y = cvtpk(c0[2], c0[3]); w0.z = cvtpk(c1[0], c1[1]); w0.w = cvtpk(c1[2], c1[3]);
                w1.x = cvtpk(c2[0], c2[1]); w1.y = cvtpk(c2[2], c2[3]); w1.z = cvtpk(c3[0], c3[1]); w1.w = cvtpk(c3[2], c3[3]);
                acc[0] = mfma32(a, *(const bf16x8*)&w0, acc[0]); acc[1] = mfma32(a, *(const bf16x8*)&w1, acc[1]);
            }
#pragma unroll
            for (int r = 0; r < 16; ++r) { const float w = wi[dir * 128 + 32 * (wid >> 1) + crow(r, hi)]; acc[0][r] *= w; acc[1][r] *= w; }
        }
        if (tid < 128) { float s = 0.f; for (int e = 0; e < 128; ++e) s += N0[e] * bf2f(Tq[tid * TLD + e]); denp[(dir * 5 + 4) * 128 + tid] = s * wi[dir * 128 + tid]; }
#pragma unroll
        for (int tl = 0; tl < 2; ++tl) { const int t = 64 * (wid & 1) + 32 * tl + r32; const float Mt = Mv[dir * 128 + t]; float part = 0.f;
#pragma unroll
            for (int g = 0; g < 4; ++g) { float o[4];
#pragma unroll
                for (int j = 0; j < 4; ++j) { const int s = 32 * (wid >> 1) + 8 * g + 4 * hi + j; const bool ok = dir ? (s >= t) : (s <= t);
                    o[j] = ok ? as[tl][4 * g + j] * __expf(av[dir * 128 + s] - Mt) : 0.f; part += o[j]; }
                u32x2 w; w.x = cvtpk(o[0], o[1]); w.y = cvtpk(o[2], o[3]);
                *(LAS u32x2*)(Ts + t * TLD + 32 * (wid >> 1) + 8 * g + 4 * hi) = w; }
            part += __shfl_xor(part, 32);
            if (hi == 0) denp[(dir * 5 + (wid >> 1)) * 128 + t] = part; }
        __syncthreads();
        mm128(Ts, Tv, acc, wid, lane);
        __syncthreads();
    }
__device__ __forceinline__ void mlstm_c_unit(const Params& p, int l, int bl, int J, int h, LAS unsigned char* lds) {
    int tid_ = threadIdx.x; asm volatile("" : "+v"(tid_));
    const int tid = tid_, wid = __builtin_amdgcn_readfirstlane(tid >> 6), lane = tid & 63, r32 = lane & 31, hi = lane >> 5;
    LAS bf16_t* Tq = (LAS bf16_t*)lds; LAS bf16_t* Tk = (LAS bf16_t*)(lds + TILE_B); LAS bf16_t* Tv = (LAS bf16_t*)(lds + 2 * TILE_B); LAS bf16_t* Ts = (LAS bf16_t*)(lds + 3 * TILE_B);
    LAS float* sc = (LAS float*)(lds + 4 * TILE_B);
    LAS float* gl = sc;
    LAS float* av = sc + 512;
    LAS float* Mv = sc + 768;
    LAS float* wi = sc + 1024;
    LAS float* fl = sc + 1280;
    LAS float* ssq = sc + 1536;
    LAS float* denp = sc + 1664;
    const int rseq = J < 2 ? bl * 256 : CTXROWS + bl * 2048, r0 = rseq + (J < 2 ? J * 128 : (J - 2) * 128);
    {
        const int t = tid >> 2, c0 = (tid & 3) * 32;
        const bf16_t* q = pbuf(p, P_MQ) + (size_t)(r0 + t) * 512 + h * 128 + c0; const bf16_t* k = pbuf(p, P_MK) + (size_t)(r0 + t) * 512 + h * 128 + c0;
        const bf16_t* v = pbuf(p, P_MVT) + ((size_t)((bl * NJ + J) * 4 + h)) * 16384 + t * 128 + c0;
#pragma unroll
        for (int i = 0; i < 4; ++i) { *(LAS u32x4*)(Tq + t * TLD + c0 + 8 * i) = *(const u32x4*)(q + 8 * i); *(LAS u32x4*)(Tk + t * TLD + c0 + 8 * i) = *(const u32x4*)(k + 8 * i);
            *(LAS u32x4*)(Tv + t * TLD + c0 + 8 * i) = *(const u32x4*)(v + 8 * i); }
        if (tid < 128) { *(LAS f32x4*)(gl + tid * 4) = *(const f32x4*)((const float*)(p.ws + WS_P + P_GATES) + (size_t)(r0 + tid) * 16 + h * 4); ssq[tid] = 0.f; }
    }
    __syncthreads();
    const float* MST = (const float*)(p.ws + WS_P + P_MST);
    if (wid < 2) {
        const int dir = wid, p0 = 2 * lane, p1 = p0 + 1, s0 = dir ? 127 - p0 : p0, s1 = dir ? 127 - p1 : p1;
        const float m0 = MST[((size_t)(((bl * 4 + h) * 2 + dir) * NJ + J)) * 4 + 2];
        const float ig0 = gl[s0 * 4 + 2 * dir], ig1 = gl[s1 * 4 + 2 * dir];
        const float lf0 = logsigmoid_f(gl[s0 * 4 + 2 * dir + 1]), lf1 = logsigmoid_f(gl[s1 * 4 + 2 * dir + 1]);
        float incl = lf0 + lf1;
        for (int o = 1; o < 64; o <<= 1) { const float t = __shfl_up(incl, o); if (lane >= o) incl += t; }
        const float bc1 = incl, bc0 = incl - lf1;
        const float a0 = ig0 - bc0, a1 = ig1 - bc1;
        float mx = fmaxf(a0, a1);
        for (int o = 1; o < 64; o <<= 1) { const float t = __shfl_up(mx, o); if (lane >= o) mx = fmaxf(mx, t); }
        float mxprev = __shfl_up(mx, 1); if (lane == 0) mxprev = -3.0e38f;
        const float M0 = fmaxf(m0, fmaxf(mxprev, a0)), M1 = fmaxf(m0, mx);
        av[dir * 128 + s0] = a0; av[dir * 128 + s1] = a1; Mv[dir * 128 + s0] = M0; Mv[dir * 128 + s1] = M1;
        wi[dir * 128 + s0] = __expf(m0 - M0); wi[dir * 128 + s1] = __expf(m0 - M1);
        fl[dir * 128 + s0] = __expf(-bc0 - M0); fl[dir * 128 + s1] = __expf(-bc1 - M1);
    }
    f32x16 as[2] = {}; mm128(Tk, Tq, as, wid, lane);
    __syncthreads();
    f32x16 ao0[2], ao1[2];
    mlstm_c_dir<0>(p, bl, J, h, as, ao0, Tq, Tv, Ts, av, Mv, wi, denp, tid, wid, lane);
    mlstm_c_dir<1>(p, bl, J, h, as, ao1, Tq, Tv, Ts, av, Mv, wi, denp, tid, wid, lane);
    float hv[2][16];
#pragma unroll
    for (int r = 0; r < 16; ++r) { const int t = 32 * (wid >> 1) + crow(r, hi);
        const float df = (((denp[t] + denp[128 + t]) + denp[256 + t]) + denp[384 + t]) + denp[512 + t], db = (((denp[640 + t] + denp[768 + t]) + denp[896 + t]) + denp[1024 + t]) + denp[1152 + t];
        const float rf = 1.0f / fmaxf(fabsf(df), fl[t]), rb = 1.0f / fmaxf(fabsf(db), fl[128 + t]);
        hv[0][r] = ao0[0][r] * rf + ao1[0][r] * rb; hv[1][r] = ao0[1][r] * rf + ao1[1][r] * rb;
        float q = hv[0][r] * hv[0][r] + hv[1][r] * hv[1][r];
        q += __shfl_xor(q, 1); q += __shfl_xor(q, 2); q += __shfl_xor(q, 4); q += __shfl_xor(q, 8); q += __shfl_xor(q, 16);
        if (r32 == 0) lds_addf(&ssq[t], q); }
    __syncthreads();
    const float* gm = p.in[I_GMN] + l * 512 + h * 128; const float* sk = p.in[I_SKIP] + l * 512 + h * 128;
    f32x16 hn[2];
#pragma unroll
    for (int tl = 0; tl < 2; ++tl) { const float gd = gm[64 * (wid & 1) + 32 * tl + r32];
#pragma unroll
        for (int r = 0; r < 16; ++r) hn[tl][r] = hv[tl][r] * rsqrtf(ssq[32 * (wid >> 1) + crow(r, hi)] * (1.0f / 128.0f) + EPS) * gd; }
    LAS float* F = (LAS float*)lds;
    st_acc_f32(F, hn, wid, lane);
    __syncthreads();
    { const int t = tid >> 2, c0 = (tid & 3) * 32; const size_t o = (size_t)(r0 + t) * 512 + h * 128 + c0;
      const bf16_t* xcv = pbuf(p, P_XCV) + o; bf16_t* zb = pbuf(p, P_ZB) + o;
#pragma unroll
      for (int i = 0; i < 4; ++i) { float x8[8], z8[8]; unpack8(*(const u32x4*)(xcv + 8 * i), x8); unpack8(*(const u32x4*)(zb + 8 * i), z8);
          const f32x4 h0 = *(const LAS f32x4*)(F + t * FLD + c0 + 8 * i), h1 = *(const LAS f32x4*)(F + t * FLD + c0 + 8 * i + 4);
          const f32x4 s0 = *(const f32x4*)(sk + c0 + 8 * i), s1 = *(const f32x4*)(sk + c0 + 8 * i + 4);
#pragma unroll
          for (int j = 0; j < 4; ++j) { z8[j] = (h0[j] + s0[j] * x8[j]) * z8[j]; z8[4 + j] = (h1[j] + s1[j] * x8[4 + j]) * z8[4 + j]; }
          *(u32x4*)(zb + 8 * i) = pack8(z8); } }
    __syncthreads();
}
namespace att {
constexpr int SHM_V = 64 * 128 * 2, SHM_K = 64 * 64 * 2, OFF_K = 2 * SHM_V, OFF_WS = OFF_K + 2 * SHM_K, OFF_ST = OFF_WS + 8 * 64 * 4, LDS_NEED = OFF_ST + 32 * 512 * 4;
static_assert(LDS_NEED <= LDS_BYTES - 64, "attention LDS");
constexpr float THR2 = 11.5f;
#define KSWZ64(row, colB) ((row) * 128 + ((colB) ^ (((row) & 7) << 4)))
#define ASBAR() __builtin_amdgcn_sched_barrier(0)
__device__ __forceinline__ void partialSM(f32x16& p0, f32x16& p1, float& m_reg, float& mn, float& alpha) {
    float pmax = p0[0];
#pragma unroll
    for (int r = 1; r < 16; ++r) pmax = fmaxf(pmax, p0[r]);
#pragma unroll
    for (int r = 0; r < 16; ++r) pmax = fmaxf(pmax, p1[r]);
    { auto rr = __builtin_amdgcn_permlane32_swap(__float_as_uint(pmax), __float_as_uint(pmax), false, false); pmax = fmaxf(__uint_as_float(rr[0]), __uint_as_float(rr[1])); }
    if (__builtin_expect(__all(pmax - m_reg <= THR2), 1)) { mn = m_reg; alpha = 1.f; }
    else { mn = fmaxf(m_reg, pmax); alpha = __builtin_amdgcn_exp2f(m_reg - mn); m_reg = mn; }
#pragma unroll
    for (int r = 0; r < 16; ++r) { p0[r] -= mn; p1[r] -= mn; }
#pragma unroll
    for (int r = 0; r < 16; ++r) p0[r] = __builtin_amdgcn_exp2f(p0[r]);
}
__device__ __forceinline__ void finishSM(f32x16& p0, f32x16& p1, float alpha, float& l_reg, bf16x8& pa0, bf16x8& pa1, bf16x8& pa2, bf16x8& pa3) {
#pragma unroll
    for (int r = 0; r < 16; ++r) p1[r] = __builtin_amdgcn_exp2f(p1[r]);
    float ps = 0;
#pragma unroll
    for (int r = 0; r < 16; ++r) ps += p0[r];
#pragma unroll
    for (int r = 0; r < 16; ++r) ps += p1[r];
    { auto rr = __builtin_amdgcn_permlane32_swap(__float_as_uint(ps), __float_as_uint(ps), false, false); ps = __uint_as_float(rr[0]) + __uint_as_float(rr[1]); }
    l_reg = l_reg * alpha + ps;
#define PK4(P, BASE, OUT) do { unsigned a0 = cvtpk(P[BASE + 0], P[BASE + 1]), a1 = cvtpk(P[BASE + 2], P[BASE + 3]);   \
    unsigned b0 = cvtpk(P[BASE + 4], P[BASE + 5]), b1 = cvtpk(P[BASE + 6], P[BASE + 7]);                              \
    auto r0 = __builtin_amdgcn_permlane32_swap(a0, b0, false, false); auto r1 = __builtin_amdgcn_permlane32_swap(a1, b1, false, false); \
    u32x4 w = {r0[0], r1[0], r0[1], r1[1]}; OUT = *reinterpret_cast<bf16x8*>(&w); } while (0)
    PK4(p0, 0, pa0); PK4(p0, 8, pa1); PK4(p1, 0, pa2); PK4(p1, 8, pa3);
#undef PK4
}
__device__ __forceinline__ void qkt(f32x16& p0, f32x16& p1, const LAS char* Ks, const bf16x8 (&qr)[4], int r32, int hi) {
    p0 = f32x16{}; p1 = f32x16{};
#pragma unroll
    for (int d0 = 0; d0 < 4; ++d0) { const int cb = (d0 * 16 + hi * 8) * 2;
        const bf16x8 b0 = *reinterpret_cast<const LAS bf16x8*>(Ks + KSWZ64(r32, cb));
        const bf16x8 b1 = *reinterpret_cast<const LAS bf16x8*>(Ks + KSWZ64(32 + r32, cb));
        p0 = mfma32(b0, qr[d0], p0); p1 = mfma32(b1, qr[d0], p1); }
}
__device__ __forceinline__ int v_st(int k, int c) { const int kk = (k & ~0xC) | ((k & 4) << 1) | ((k & 8) >> 1); return ((kk >> 3) * 4 + (c >> 5)) * 512 + ((kk & 7) * 32 + (c & 31)) * 2; }
__device__ __forceinline__ int v_rd_base(int lane) { return ((lane & 3) << 3) | (((lane >> 2) & 3) << 6) | (((lane >> 4) & 1) << 5) | (((lane >> 5) & 1) << 8); }
constexpr int v_rd_off(int d0, int ks, int half) { return d0 * 512 + ks * 4096 + half * 2048; }
template <int OFF> __device__ __forceinline__ s16x4 tr_read(int vb) { s16x4 r; asm volatile("ds_read_b64_tr_b16 %0, %1 offset:%2" : "=&v"(r) : "v"(vb), "i"(OFF) : "memory"); return r; }
template <int D0> __device__ __forceinline__ void pv_one(f32x16& od, int vb, bf16x8 pa0, bf16x8 pa1, bf16x8 pa2, bf16x8 pa3) {
    const s16x4 l0 = tr_read<v_rd_off(D0, 0, 0)>(vb), h0 = tr_read<v_rd_off(D0, 0, 1)>(vb), l1 = tr_read<v_rd_off(D0, 1, 0)>(vb), h1 = tr_read<v_rd_off(D0, 1, 1)>(vb);
    const s16x4 l2 = tr_read<v_rd_off(D0, 2, 0)>(vb), h2 = tr_read<v_rd_off(D0, 2, 1)>(vb), l3 = tr_read<v_rd_off(D0, 3, 0)>(vb), h3 = tr_read<v_rd_off(D0, 3, 1)>(vb);
    asm volatile("s_waitcnt lgkmcnt(0)" ::: "memory"); ASBAR();
#define PKV(L, H) (bf16x8){L[0], L[1], L[2], L[3], H[0], H[1], H[2], H[3]}
    od = mfma32(pa0, PKV(l0, h0), od); od = mfma32(pa1, PKV(l1, h1), od); od = mfma32(pa2, PKV(l2, h2), od); od = mfma32(pa3, PKV(l3, h3), od);
#undef PKV
}
__device__ __forceinline__ void pv_d0(f32x16 (&o)[4], int vb, bf16x8 pa0, bf16x8 pa1, bf16x8 pa2, bf16x8 pa3) {
    pv_one<0>(o[0], vb, pa0, pa1, pa2, pa3); pv_one<1>(o[1], vb, pa0, pa1, pa2, pa3); pv_one<2>(o[2], vb, pa0, pa1, pa2, pa3); pv_one<3>(o[3], vb, pa0, pa1, pa2, pa3);
}
__device__ __forceinline__ int krow(int j, int rc, int rl) { return j < 4 ? rc + 64 * j : rl + 64 * (j - 4); }

__device__ __forceinline__ void attn_unit(const Params& p, int l, int h, int qrow0, int rc, int rl, int NT, LAS unsigned char* lds8) {
    int tid_ = threadIdx.x; asm volatile("" : "+v"(tid_));
    const int tid = tid_, wid = __builtin_amdgcn_readfirstlane(tid >> 6), lane = tid & 63, r32 = lane & 31, hi = lane >> 5;
    LAS char* V_lds = (LAS char*)lds8; LAS char* K_lds = (LAS char*)lds8 + OFF_K;
    LAS float* wsx = (LAS float*)(lds8 + OFF_WS) + wid * 64; LAS float* li_l = wsx; LAS float* al_l = wsx + 32;
    LAS unsigned* stash = (LAS unsigned*)(lds8 + OFF_ST);
    bf16_t* QB = pbuf(p, P_QB); const bf16_t* KB = pbuf(p, P_KB); const bf16_t* VB = pbuf(p, P_VB);
    const int sr = tid >> 4, sc = (tid & 15) * 8, vst0 = v_st(sr, sc);
    const int kr = tid >> 3, kc = (tid & 7) * 8, kst = KSWZ64(kr, kc * 2);
    const int vb0 = (int)(uintptr_t)V_lds + v_rd_base(lane);
    f32x16 o[4];
#pragma unroll 1
    for (int m = 0; m < 2; ++m) {
        const unsigned voV0 = (unsigned)((sr * 512 + h * 128 + sc) * 2), voK = (unsigned)((kr * 512 + h * 128 + m * 64 + kc) * 2);
        float m_reg = -1e30f, l_reg = 0.f;
#pragma unroll
        for (int d = 0; d < 4; ++d) o[d] = f32x16{};
        bf16x8 qr[4];
        { const bf16_t* Qw = QB + (size_t)(qrow0 + wid * 32 + r32) * 512 + h * 128 + m * 64 + hi * 8;
#pragma unroll
          for (int d0 = 0; d0 < 4; ++d0) qr[d0] = *(const bf16x8*)(Qw + d0 * 16); }
        struct { bf16x8 vs0, vs1, ks0; } sr_[2];
#define SLOAD(i, j) do { const int _r = __builtin_amdgcn_readfirstlane(krow((j), rc, rl)); const char* _vb = (const char*)(VB + (size_t)_r * 512); const char* _kb = (const char*)(KB + (size_t)_r * 512); \
    sr_[i].vs0 = *(const bf16x8*)(_vb + voV0); sr_[i].vs1 = *(const bf16x8*)(_vb + 32 * 512 * 2 + voV0); sr_[i].ks0 = *(const bf16x8*)(_kb + voK); } while (0)
#define SWRITE(b, i) do { *(LAS bf16x8*)(V_lds + (b) * SHM_V + vst0) = sr_[i].vs0; *(LAS bf16x8*)(V_lds + (b) * SHM_V + 8192 + vst0) = sr_[i].vs1; \
    *(LAS bf16x8*)(K_lds + (b) * SHM_K + kst) = sr_[i].ks0; } while (0)
#define SWAIT() asm volatile("s_waitcnt vmcnt(3)" ::: "memory")
#define RESC(a) do { if (__any((a) < 1.f)) { if (hi == 0) al_l[r32] = (a); asm volatile("s_waitcnt lgkmcnt(0)" ::: "memory"); \
    _Pragma("unroll") for (int d = 0; d < 4; ++d) _Pragma("unroll") for (int r = 0; r < 16; ++r) o[d][r] *= al_l[crow(r, hi)]; } } while (0)
        f32x16 pA0, pA1, pB0, pB1; float mnA, mnB, alA, alB; bf16x8 pa0, pa1, pa2, pa3;
        SLOAD(0, 0); asm volatile("s_waitcnt vmcnt(0)" ::: "memory"); SWRITE(0, 0); __syncthreads();
        qkt(pA0, pA1, K_lds, qr, r32, hi); partialSM(pA0, pA1, m_reg, mnA, alA);
        SLOAD(1, 1); if (2 < NT) SLOAD(0, 2);
        SWAIT(); SWRITE(1, 1); __syncthreads();
        for (int j = 1; j + 1 < NT; j += 2) {
            ASBAR(); qkt(pB0, pB1, K_lds + SHM_K, qr, r32, hi);
            finishSM(pA0, pA1, alA, l_reg, pa0, pa1, pa2, pa3); ASBAR();
            SLOAD(1, j + 2); ASBAR();
            pv_d0(o, vb0, pa0, pa1, pa2, pa3); partialSM(pB0, pB1, m_reg, mnB, alB);
            __syncthreads(); SWAIT(); SWRITE(0, 0);
            RESC(alB); __syncthreads();
            ASBAR(); qkt(pA0, pA1, K_lds, qr, r32, hi);
            finishSM(pB0, pB1, alB, l_reg, pa0, pa1, pa2, pa3); ASBAR();
            if (j + 3 < NT) SLOAD(0, j + 3); ASBAR();
            pv_d0(o, vb0 + SHM_V, pa0, pa1, pa2, pa3); partialSM(pA0, pA1, m_reg, mnA, alA);
            __syncthreads(); SWAIT(); SWRITE(1, 1);
            RESC(alA); __syncthreads();
        }
        ASBAR(); qkt(pB0, pB1, K_lds + SHM_K, qr, r32, hi);
        finishSM(pA0, pA1, alA, l_reg, pa0, pa1, pa2, pa3); ASBAR();
        pv_d0(o, vb0, pa0, pa1, pa2, pa3); partialSM(pB0, pB1, m_reg, mnB, alB);
        __syncthreads(); RESC(alB);
        finishSM(pB0, pB1, alB, l_reg, pa0, pa1, pa2, pa3); ASBAR();
        pv_d0(o, vb0 + SHM_V, pa0, pa1, pa2, pa3);
#undef SLOAD
#undef SWRITE
#undef SWAIT
#undef RESC
        int lane_e = lane; asm volatile("" : "+v"(lane_e)); const int r32e = lane_e & 31, hie = lane_e >> 5;
        if (hie == 0) li_l[r32e] = l_reg; asm volatile("s_waitcnt lgkmcnt(0)" ::: "memory");
        float rli[16];
#pragma unroll
        for (int r = 0; r < 16; ++r) rli[r] = __builtin_amdgcn_rcpf(li_l[crow(r, hie)]);
        if (m == 0) {
#pragma unroll
            for (int d0 = 0; d0 < 4; ++d0)
#pragma unroll
                for (int r = 0; r < 16; r += 2) stash[(wid * 32 + d0 * 8 + (r >> 1)) * 64 + lane_e] = cvtpk(o[d0][r] * rli[r], o[d0][r + 1] * rli[r + 1]);
        } else {
            const float lam = ((const float*)(p.ws + WS_LAM))[l * 4], oml = ((const float*)(p.ws + WS_LAM))[l * 4 + 1];
            float ss[16];
#pragma unroll
            for (int r = 0; r < 16; ++r) ss[r] = 0.f;
#pragma unroll
            for (int d0 = 0; d0 < 4; ++d0)
#pragma unroll
                for (int r = 0; r < 16; r += 2) { const unsigned w = stash[(wid * 32 + d0 * 8 + (r >> 1)) * 64 + lane_e];
                    o[d0][r] = bf_lo(w) - lam * o[d0][r] * rli[r]; o[d0][r + 1] = bf_hi(w) - lam * o[d0][r + 1] * rli[r + 1];
                    ss[r] += o[d0][r] * o[d0][r]; ss[r + 1] += o[d0][r + 1] * o[d0][r + 1]; }
#pragma unroll
            for (int r = 0; r < 16; ++r) { float q = ss[r]; q += __shfl_xor(q, 1); q += __shfl_xor(q, 2); q += __shfl_xor(q, 4); q += __shfl_xor(q, 8); q += __shfl_xor(q, 16);
                ss[r] = rsqrtf(q * (1.0f / 128.0f) + EPS) * oml; }
            const float* gs = p.in[I_GSUBLN] + l * 128;
            asm volatile("s_waitcnt lgkmcnt(0)" ::: "memory");
            LAS bf16_t* ot = (LAS bf16_t*)(stash + wid * 32 * 64);
#pragma unroll
            for (int d0 = 0; d0 < 4; ++d0) { const float g = gs[d0 * 32 + r32e];
#pragma unroll
                for (int r = 0; r < 16; ++r) ot[((r & 3) + 8 * (r >> 2) + 4 * hie) * 128 + d0 * 32 + r32e] = (bf16_t)(cvtpk(o[d0][r] * ss[r] * g, 0.f) & 0xffffu); }
            asm volatile("s_waitcnt lgkmcnt(0)" ::: "memory");
            { bf16_t* dst = QB + (size_t)(qrow0 + wid * 32) * 512 + h * 128;
#pragma unroll
              for (int i = 0; i < 8; ++i) { const int row = i * 4 + (lane_e >> 4), pc = (lane_e & 15) * 8;
                  *(u32x4*)(dst + (size_t)row * 512 + pc) = *(const LAS u32x4*)(ot + row * 128 + pc); } }
        }
        __syncthreads();
    }
}
}
constexpr int N_PHASES = 36;
typedef const __attribute__((address_space(4))) Params* KParams;
#define PHASE_P() const Params& p = *(const Params*)opaque_kp()
__device__ __forceinline__ KParams opaque_kp() { KParams q = (KParams)__builtin_amdgcn_kernarg_segment_ptr(); asm volatile("" : "+s"(q)); return q; }
__global__ void __launch_bounds__(NTHR, 2) mk_fwd(Params p_arg, int bar_region) {
    extern __shared__ __attribute__((aligned(16))) unsigned char lds_raw[];
    LAS unsigned char* lds = (LAS unsigned char*)lds_raw;
    const int tid = threadIdx.x, G = gridDim.x, bid = blockIdx.x;
    volatile LAS unsigned* xbw = (volatile LAS unsigned*)(lds + LDS_BYTES - 16);
    if (tid == 0) { xbw[0] = 0u; xbw[1] = 0u; xbw[2] = 0u; xbw[3] = 0u; }
    __syncthreads();
    (void)xcd_barrier_post((unsigned*)(p_arg.ws + WS_CTL) + CW_BAR + bar_region * 4096, xbw);
    const int lo = p_arg.ph_lo, hi = p_arg.ph_hi;
#define IN(k) (lo <= (k) && (k) < hi)
#define SEAM(k) do { if (IN(k) && IN((k) + 1)) { KParams kq = opaque_kp(); XcdBarrier b_; b_.bar = (unsigned*)(kq->ws + WS_CTL) + CW_BAR + ((const __attribute__((address_space(4))) int*)(kq + 1))[0] * 4096; b_.x = xb_xcc_id(); b_.st = xbw; xcd_barrier(b_); } } while (0)

#if !defined(ONLY) || ONLY == 0
    if (IN(0)) { PHASE_P(); phase_prologue(p, lds); }
#endif
    SEAM(0);
    for (int l = 0; l < 2; ++l) {
        const int base = 1 + 17 * l;
#if !defined(ONLY) || ONLY == 1
        if (IN(base)) { PHASE_P(); phase_norm1(p, l); }
#endif
        SEAM(base);
        for (int hf = 0; hf < 2; ++hf) {
            const int hb = base + 1 + 6 * hf;
#if !defined(ONLY) || ONLY == 2
            if (IN(hb)) {
                PHASE_P(); unsigned char* ws = p.ws; bf16_t* Hh = (bf16_t*)(ws + WS_H) + (size_t)hf * MH * 1024; (void)Hh;
                const float* cosT = (const float*)(ws + WS_ROPE); const float* sinT = cosT + 1024;
                pg8::Gemm g{Hh, (const bf16_t*)(ws + WS_WTIN) + (size_t)l * NCOL * 1024, MH, NCOL, 1024};
                RectOrder S; if (l == 0) S.init(72, 26, 0, 0, 0, 0, G, bid); else S.init(64, 26, 8, 8, 6, 0, G, bid);
                EpiIn E{pbuf(p, 0), pbuf(p, P_GB), cosT, sinT};
                pg8::gemm_phase<EpiIn, RectOrder>((PG8_LAS unsigned char*)lds, g, S, E, nullptr);
            }
#endif
            SEAM(hb);
#if !defined(ONLY) || ONLY == 3
            if (IN(hb + 1)) {
                PHASE_P();
                const int n_a = HBAT * NJ * 4, n_g = HBAT * 16 + (l == 0 ? HBAT * 2 : 0);
                for (int u = bid; u < n_a + n_g; u += G) {
                    if (u < n_a) { const int bl = u / (NJ * 4), rem = u % (NJ * 4); mlstm_a_unit(p, l, bl, rem >> 2, rem & 3, lds); }
                    else { const int v = u - n_a; int r0; if (v < HBAT * 16) r0 = CTXROWS + (v >> 4) * 2048 + (v & 15) * 128; else { const int w = v - HBAT * 16; r0 = (w >> 1) * 256 + (w & 1) * 128; }
                        gmlp_unit(p, l, r0, lds); }
                }
            }
#endif
            SEAM(hb + 1);
#if !defined(ONLY) || ONLY == 4
            if (IN(hb + 2)) {
                PHASE_P();
                phase_scan(p);
                __syncthreads();
                const int n_l = HBAT * 4 * 8, n_c = (l == 0 ? HBAT * 4 : 0);
                for (int u = bid; u < n_l + n_c; u += G) {
                    int h, qrow0, rc, rl, NT;
                    if (u < n_l) { const int bl = u >> 5, qb = u & 7; h = (u >> 3) & 3; qrow0 = CTXROWS + bl * 2048 + qb * 256; rc = bl * 256; rl = CTXROWS + bl * 2048; NT = 36; }
                    else { const int v = u - n_l, bl = v >> 2; h = v & 3; qrow0 = bl * 256; rc = bl * 256; rl = 0; NT = 4; }
                    att::attn_unit(p, l, h, qrow0, rc, rl, NT, lds);
                }
            }
#endif
            SEAM(hb + 2);
#if !defined(ONLY) || ONLY == 5
            if (IN(hb + 3)) {
                PHASE_P();
                const int n_l = HBAT * 16 * 4, n_c = (l == 0 ? HBAT * 2 * 4 : 0);
                for (int u = bid; u < n_l + n_c; u += G) {
                    int bl, J, h;
                    if (u < n_l) { const int rem = u & 63; bl = u >> 6; J = 2 + (rem >> 2); h = rem & 3; }
                    else { const int v = u - n_l, rem = v & 7; bl = v >> 3; J = rem >> 2; h = rem & 3; }
                    mlstm_c_unit(p, l, bl, J, h, lds);
                }
            }
#endif
            SEAM(hb + 3);
#if !defined(ONLY) || ONLY == 6
            if (IN(hb + 4)) {
                PHASE_P(); unsigned char* ws = p.ws; bf16_t* Hh = (bf16_t*)(ws + WS_H) + (size_t)hf * MH * 1024; (void)Hh;
                pg8::Gemm g{pbuf(p, P_QB), (const bf16_t*)(ws + WS_WTBR) + (size_t)l * 3072 * 512, 3 * MH, 3072, 512};
                MergeOrder S; S.init(l == 0 ? 72 : 64, l == 0 ? 0 : 8, G, bid);
                EpiMerge E{pbuf(p, P_GB), Hh};
                pg8::gemm_phase<EpiMerge, MergeOrder>((PG8_LAS unsigned char*)lds, g, S, E, nullptr);
            }
#endif
            SEAM(hb + 4);
#if !defined(ONLY) || ONLY == 7
            if (IN(hb + 5)) {
                PHASE_P(); unsigned char* ws = p.ws; bf16_t* Hh = (bf16_t*)(ws + WS_H) + (size_t)hf * MH * 1024; (void)Hh;
                pg8::Gemm g{Hh, (const bf16_t*)(ws + WS_WTO) + (size_t)l * 1024 * 1024, MH, 1024, 1024};
                RectOrder S; S.init(l == 0 ? 72 : 64, 4, l == 0 ? 0 : 8, 0, 0, 0, G, bid);
                EpiOut E{l == 0 ? p.in[I_X] : (const float*)p.out, l == 0 ? p.in[I_CTX] : (const float*)(ws + WS_XC), p.out, (float*)(ws + WS_XC), (const float*)(ws + WS_MOD) + (size_t)l * 17 * 6144, hf};
                pg8::gemm_phase<EpiOut, RectOrder>((PG8_LAS unsigned char*)lds, g, S, E, nullptr);
            }
#endif
            SEAM(hb + 5);
        }
#if !defined(ONLY) || ONLY == 8
        if (IN(base + 13)) { PHASE_P(); phase_norm2_router(p, l, lds); phase_cvt_experts(p, l, lds); }
#endif
        SEAM(base + 13);
#if !defined(ONLY) || ONLY == 9
        if (IN(base + 14)) { PHASE_P(); phase_dispatch(p, l, lds); }
#endif
        SEAM(base + 14);
#if !defined(ONLY) || ONLY == 10
        if (IN(base + 15)) {
            PHASE_P(); unsigned char* ws = p.ws;
            LAS int* seg = (LAS int*)(lds + 131072); LAS int* tile_e = seg + 128;
            const int nt = moe_tile_table(p, l, seg, tile_e);
            pg8::Gemm g{pbuf(p, P_XB), (const bf16_t*)(ws + WS_WTGU), SLOTS, 32 * 1024, 1024};
            MoeOrder S; S.init(tile_e, nt, G, bid); __syncthreads(); EpiGU E{pbuf(p, P_ACT)};
            pg8::gemm_phase<EpiGU, MoeOrder>((PG8_LAS unsigned char*)lds, g, S, E, nullptr);
        }
#endif
        SEAM(base + 15);
#if !defined(ONLY) || ONLY == 11
        if (IN(base + 16)) {
            PHASE_P(); unsigned char* ws = p.ws;
            LAS int* seg = (LAS int*)(lds + 131072); LAS int* tile_e = seg + 128;
            const int nt = moe_tile_table(p, l, seg, tile_e);
            pg8::Gemm g{pbuf(p, P_ACT), (const bf16_t*)(ws + WS_WTD), SLOTS, 32 * 1024, 512};
            MoeOrder S; S.init(tile_e, nt, G, bid); __syncthreads(); EpiDown E{pbuf(p, P_XB), (const float*)(ws + WS_WTS)};
            pg8::gemm_phase<EpiDown, MoeOrder>((PG8_LAS unsigned char*)lds, g, S, E, nullptr);
        }
#endif
        SEAM(base + 16);
    }
#if !defined(ONLY) || ONLY == 12
    if (IN(35)) { PHASE_P(); phase_final(p); }
#endif
#undef IN
#undef SEAM
}

#ifndef MK_CUTS
#define MK_CUTS 0
#endif
extern "C" void kernel_launch(void* const* d_in, const int* in_sizes, int n_in, void* d_out, int out_size, void* d_ws, size_t ws_size, hipStream_t stream) {
    static int grid = 0;
    if (grid == 0) {
        if (n_in != 31 || in_sizes[0] != NBATCH * SEQ * DM || out_size != NBATCH * SEQ * DM || ws_size < WS_END) {
            fprintf(stderr, "kernel_launch: unexpected shapes or workspace (n_in %d, ws %zu, need %zu); nothing launched\n", n_in, ws_size, (size_t)WS_END); grid = -1; return; }
        int dev = 0, cus = 0, per_cu = 0;
        if (hipGetDevice(&dev) != hipSuccess || hipDeviceGetAttribute(&cus, hipDeviceAttributeMultiprocessorCount, dev) != hipSuccess) { grid = -1; return; }
        if (hipFuncSetAttribute((const void*)mk_fwd, hipFuncAttributeMaxDynamicSharedMemorySize, LDS_BYTES) != hipSuccess) { fprintf(stderr, "kernel_launch: hipFuncSetAttribute failed\n"); grid = -1; return; }
        if (hipOccupancyMaxActiveBlocksPerMultiprocessor(&per_cu, (const void*)mk_fwd, NTHR, LDS_BYTES) != hipSuccess || per_cu < 1) { fprintf(stderr, "kernel_launch: occupancy query says %d\n", per_cu); }
        (void)hipGetLastError();
        grid = cus;
    }
    if (grid < 0) return;
    if (hipMemsetAsync((char*)d_ws + WS_CTL, 0, CTL_BYTES, stream) != hipSuccess) return;
    Params p{};
    for (int i = 0; i < 31; ++i) p.in[i] = (const float*)d_in[i];
    p.out = (float*)d_out; p.ws = (unsigned char*)d_ws;
#if MK_CUTS == 0
    p.ph_lo = 0; p.ph_hi = N_PHASES;
    hipLaunchKernelGGL(mk_fwd, dim3(grid), dim3(NTHR), LDS_BYTES, stream, p, 0);
#else
    for (int k = 0; k < N_PHASES; ++k) {
#ifdef EXP_NOMOE
        if ((k >= 14 && k <= 17) || (k >= 31 && k <= 34)) continue;
#endif
#ifdef EXP_NOEXPERT
        if (k == 16 || k == 17 || k == 33 || k == 34) continue;
#endif
#ifdef EXP_NOGU
        if (k == 16 || k == 33) continue;
#endif
#ifdef EXP_NOMIX
        if ((k >= 2 && k <= 13) || (k >= 19 && k <= 30)) continue;
#endif
#ifdef EXP_ZEROXB
        if (k == 15 || k == 32) { hipMemsetAsync((char*)d_ws + WS_P + P_XB, 0, P_MOE_END, stream); hipMemsetAsync((char*)d_ws + WS_WTS, 0, (size_t)SLOTS * 4, stream); }
#endif
        p.ph_lo = k; p.ph_hi = k + 1; hipLaunchKernelGGL(mk_fwd, dim3(grid), dim3(NTHR), LDS_BYTES, stream, p, 0); }
#endif
}
```

```cpp
#include <hip/hip_runtime.h>
#include <cstdio>
#include <cstdint>

#define LAS __attribute__((address_space(3)))
typedef unsigned short bf16_t;
typedef short bf16x8 __attribute__((ext_vector_type(8)));
typedef short s16x4 __attribute__((ext_vector_type(4)));
typedef float f32x2 __attribute__((ext_vector_type(2)));
typedef float f32x4 __attribute__((ext_vector_type(4)));
typedef float f32x16 __attribute__((ext_vector_type(16)));
typedef unsigned u32x2 __attribute__((ext_vector_type(2)));
typedef unsigned u32x4 __attribute__((ext_vector_type(4)));

constexpr int DM = 1024, NBATCH = 16, SEQ = 2048, CTXL = 256, NCOL = 6656;
constexpr int HBAT = 8;
constexpr int MH = HBAT * (SEQ + CTXL);
constexpr int MTOT = 2 * MH;
constexpr int CTXROWS = HBAT * CTXL;
constexpr int NJ = 18;
constexpr int NEXP = 32, DEXP = 512;
constexpr int SLOTS = 81920;
constexpr float EPS = 1e-6f;
constexpr float LOG2E = 1.4426950408889634f;
constexpr float QSCALE = 0.125f * LOG2E;
constexpr int NTHR = 512;
constexpr int LDS_BYTES = 155648;
constexpr int TLD = 136;
constexpr int TILE_B = 128 * TLD * 2;

constexpr size_t AL(size_t x) { return (x + 255) / 256 * 256; }
constexpr size_t WS_CTL   = 0;
constexpr size_t CTL_BYTES = 262144;
constexpr size_t WS_MOD   = WS_CTL + CTL_BYTES;
constexpr size_t WS_WFOLD = WS_MOD + AL((size_t)2 * 17 * 6144 * 4);
constexpr size_t WS_ROPE  = WS_WFOLD + AL((size_t)2 * 16 * 1024 * 4);
constexpr size_t WS_LAM   = WS_ROPE + AL((size_t)2 * 64 * 16 * 4);
constexpr size_t WS_WRT   = WS_LAM + 256;
constexpr size_t WS_WTIN  = WS_WRT + AL((size_t)2 * 2 * 48 * 1024 * 2);
constexpr size_t WS_WTBR  = WS_WTIN + AL((size_t)2 * NCOL * 1024 * 2);
constexpr size_t WS_WTO   = WS_WTBR + AL((size_t)2 * 3072 * 512 * 2);
constexpr size_t WS_WTQKV = WS_WTO + AL((size_t)2 * 1024 * 1024 * 2);
constexpr size_t WS_WSB   = WS_WTQKV + AL((size_t)2 * 12 * 16384 * 2);
constexpr size_t WS_WTGU  = WS_WSB + AL((size_t)2 * 4 * 16384 * 2);
constexpr size_t WS_WTD   = WS_WTGU + AL((size_t)32 * 1024 * 1024 * 2);
constexpr size_t WS_XC    = WS_WTD + AL((size_t)32 * 1024 * 512 * 2);
constexpr size_t WS_H     = WS_XC + AL((size_t)4096 * 1024 * 4);
constexpr size_t WS_H8    = WS_H + AL((size_t)MTOT * 1024 * 2);
constexpr size_t WS_WTIN8 = WS_H8 + AL((size_t)MTOT * 1024);
constexpr size_t WS_EID   = WS_WTIN8 + AL((size_t)2 * 3072 * 1024);
constexpr size_t WS_WTK   = WS_EID + AL((size_t)MTOT * 8);
constexpr size_t WS_POS   = WS_WTK + AL((size_t)MTOT * 8);
constexpr size_t WS_WTS   = WS_POS + AL((size_t)MTOT * 8);
constexpr size_t WS_P     = WS_WTS + AL((size_t)SLOTS * 4);
constexpr size_t S1B      = (size_t)MH * 512 * 2;
constexpr size_t P_KB = 0, P_VB = S1B, P_XMB = 2 * S1B, P_QB = 3 * S1B, P_UB = 4 * S1B, P_ZB = 5 * S1B, P_VGB = 6 * S1B;
constexpr size_t P_GB   = 7 * S1B;
constexpr size_t P_MQ   = P_GB + (size_t)3 * MH * 1024;
constexpr size_t P_MK   = P_MQ + S1B, P_MVT = P_MK + S1B, P_XCV = P_MVT + S1B;
constexpr size_t P_GATES = P_XCV + S1B;
constexpr size_t P_CLOC = P_GATES + AL((size_t)MH * 16 * 4);
constexpr size_t P_NLOC = P_CLOC + (size_t)64 * NJ * 16384 * 2;
constexpr size_t P_MST  = P_NLOC + AL((size_t)64 * NJ * 128 * 4);
constexpr size_t P_END  = P_MST + AL((size_t)64 * NJ * 4 * 4);
constexpr size_t P_XB   = 0;
constexpr size_t P_ACT  = (size_t)SLOTS * 1024;
constexpr size_t P_YS   = P_ACT + (size_t)SLOTS * 512;
constexpr size_t P_MOE_END = P_YS + (size_t)SLOTS * 1024 * 2;
constexpr float WSCALE8 = 635.0f, HSCALE8 = 10.5f, ASCALE8 = 16.0f;
constexpr size_t WS_END = WS_P + (P_END > P_MOE_END ? P_END : P_MOE_END);
constexpr int CW_EXPCNT = 0;
constexpr int CW_HIST = 32768;
constexpr int CW_BAR = 1024;

__device__ __forceinline__ unsigned cvtpk(float lo, float hi) { unsigned r; asm volatile("v_cvt_pk_bf16_f32 %0, %1, %2" : "=v"(r) : "v"(lo), "v"(hi)); return r; }
__device__ __forceinline__ float bf_lo(unsigned w) { return __uint_as_float(w << 16); }
__device__ __forceinline__ float bf_hi(unsigned w) { return __uint_as_float(w & 0xffff0000u); }
__device__ __forceinline__ float bf2f(bf16_t b) { return __uint_as_float(((unsigned)b) << 16); }
__device__ __forceinline__ bf16_t f2bf(float f) { unsigned u = __float_as_uint(f); u += 0x7FFFu + ((u >> 16) & 1u); return (bf16_t)(u >> 16); }
__device__ __forceinline__ float sigmoid_f(float x) { return __builtin_amdgcn_rcpf(1.0f + __builtin_amdgcn_exp2f(-x * LOG2E)); }
__device__ __forceinline__ float gelu_tanh_f(float x) { const float u = 0.7978845608028654f * (x + 0.044715f * x * x * x); return x * sigmoid_f(2.0f * u); }
__device__ __forceinline__ float silu_f(float x) { return x * sigmoid_f(x); }
__device__ __forceinline__ float logsigmoid_f(float x) { return fminf(x, 0.f) - 0.6931471805599453f * __builtin_amdgcn_logf(1.0f + __builtin_amdgcn_exp2f(-fabsf(x) * LOG2E)); }
__device__ __forceinline__ int crow(int r, int hi) { return (r & 3) + 8 * (r >> 2) + 4 * hi; }
__device__ __forceinline__ f32x16 mfma32(bf16x8 a, bf16x8 b, f32x16 c) { return __builtin_amdgcn_mfma_f32_32x32x16_bf16(a, b, c, 0, 0, 0); }
__device__ __forceinline__ float wave_sum(float v) { for (int o = 32; o >= 1; o >>= 1) v += __shfl_xor(v, o); return v; }
template <int CTRL, int ROWMASK> __device__ __forceinline__ float dpp_add(float v) {
    return v + __builtin_bit_cast(float, __builtin_amdgcn_update_dpp(0, __builtin_bit_cast(int, v), CTRL, ROWMASK, 0xf, true)); }
__device__ __forceinline__ float wave_sum63(float v) {
    v = dpp_add<0x111, 0xf>(v); v = dpp_add<0x112, 0xf>(v); v = dpp_add<0x114, 0xf>(v); v = dpp_add<0x118, 0xf>(v);
    v = dpp_add<0x142, 0xa>(v);
    v = dpp_add<0x143, 0xc>(v);
    return v; }
__device__ __forceinline__ float half_sum31(float v) {
    v = dpp_add<0x111, 0xf>(v); v = dpp_add<0x112, 0xf>(v); v = dpp_add<0x114, 0xf>(v); v = dpp_add<0x118, 0xf>(v);
    v = dpp_add<0x142, 0xa>(v); return v; }
__device__ __forceinline__ float wave_max(float v) { for (int o = 32; o >= 1; o >>= 1) v = fmaxf(v, __shfl_xor(v, o)); return v; }

__device__ __forceinline__ void unpack8(const u32x4 w, float (&o)[8]) { o[0] = bf_lo(w.x); o[1] = bf_hi(w.x); o[2] = bf_lo(w.y); o[3] = bf_hi(w.y); o[4] = bf_lo(w.z); o[5] = bf_hi(w.z); o[6] = bf_lo(w.w); o[7] = bf_hi(w.w); }
__device__ __forceinline__ u32x4 pack8(const float (&v)[8]) { u32x4 w; w.x = cvtpk(v[0], v[1]); w.y = cvtpk(v[2], v[3]); w.z = cvtpk(v[4], v[5]); w.w = cvtpk(v[6], v[7]); return w; }
__device__ __forceinline__ int ld_i32_dev(const int* p) { return __hip_atomic_load(p, __ATOMIC_RELAXED, __HIP_MEMORY_SCOPE_AGENT); }
__device__ __forceinline__ float ld_f32_dev(const float* p) { return __hip_atomic_load(p, __ATOMIC_RELAXED, __HIP_MEMORY_SCOPE_AGENT); }
__device__ __forceinline__ unsigned q8(float x) { return (unsigned)(int)fminf(fmaxf(rintf(x), -127.0f), 127.0f) & 0xffu; }
__device__ __forceinline__ unsigned pk4_fp8(float a, float b, float c, float d) { return q8(a) | (q8(b) << 8) | (q8(c) << 16) | (q8(d) << 24); }
#define LBAR() do { asm volatile("s_waitcnt lgkmcnt(0)" ::: "memory"); __builtin_amdgcn_s_barrier(); asm volatile("" ::: "memory"); } while (0)
__device__ __forceinline__ int opaque_tid() { int t = threadIdx.x; asm volatile("" : "+v"(t)); return t; }
#ifdef PROBE
__device__ __forceinline__ unsigned long long* probe_epi_counter() {
    unsigned char* ws = *(unsigned char* const __attribute__((address_space(4)))*)((const __attribute__((address_space(4))) char*)__builtin_amdgcn_kernarg_segment_ptr() + 256);
    const int ph = *(volatile LAS int*)(uintptr_t)(LDS_BYTES - 32);
    return (unsigned long long*)ws + 30100 + ph; }
#endif
#ifdef PROBE
#define PSEC_BEGIN() unsigned pt_ = 0; if (PROBE_SEC == 1) pt_ = (unsigned)__builtin_amdgcn_s_memrealtime()
#define PSEC_BEGINN(n) unsigned pt_ = 0; if (PROBE_SEC == (n)) pt_ = (unsigned)__builtin_amdgcn_s_memrealtime()
#define PSEC_BEGIN6() unsigned pt_ = 0; if (PROBE_SEC == 6) pt_ = (unsigned)__builtin_amdgcn_s_memrealtime()
#define PSEC_BEGIN8() unsigned pt_ = 0; if (PROBE_SEC == 8) pt_ = (unsigned)__builtin_amdgcn_s_memrealtime()
#define PSEC(id) do { if (PROBE_SEC == (id)) { const unsigned pn_ = (unsigned)__builtin_amdgcn_s_memrealtime(); if (blockIdx.x == PROBE_BLK && tid == 0) *probe_epi_counter() += (unsigned long long)(pn_ - pt_); } if (PROBE_SEC == (id) + 1) pt_ = (unsigned)__builtin_amdgcn_s_memrealtime(); } while (0)
#else
#define PSEC_BEGIN() do { } while (0)
#define PSEC_BEGIN6() do { } while (0)
#define PSEC_BEGINN(n) do { } while (0)
#define PSEC_BEGIN8() do { } while (0)
#define PSEC(id) do { } while (0)
#endif
struct Params {
    const float* in[31];
    float* out;
    unsigned char* ws;
    int ph_lo, ph_hi;
};
enum { I_X = 0, I_C, I_CTX, I_CCTX, I_WMOD, I_BMOD, I_GN1, I_GN2, I_WIN, I_DLAM, I_GSUBLN, I_WGS, I_BGS, I_GGV, I_WCONV, I_BCONV, I_WQKV, I_WIF, I_BIF,
       I_GMN, I_SKIP, I_WBR, I_WOUT, I_WRG, I_BRG, I_WRE, I_BRE, I_WEG, I_WEU, I_WED, I_GFIN };

struct RowInfo { int hf, r, isctx, b, t; };
__device__ __forceinline__ RowInfo row_info(int R) {
    RowInfo q; q.hf = R >= MH ? 1 : 0; q.r = R - q.hf * MH;
    if (q.r < CTXROWS) { q.isctx = 1; q.b = q.hf * HBAT + (q.r >> 8); q.t = q.r & 255; }
    else { q.isctx = 0; const int s = q.r - CTXROWS; q.b = q.hf * HBAT + (s >> 11); q.t = s & 2047; }
    return q;
}
#define XB_TMO      128
#define XB_XCNT(j)  (256  + 64 * (j))
#define XB_XSUB(j)  (1280 + 64 * (j))
#define XB_XGEN(j)  (2304 + 64 * (j))
#define XB_TOP      3328
#define XB_TOPGEN   3392
#define XCD_BAR_WORDS 3456
#define XB_SPIN_CAP (1u << 18)

__device__ __forceinline__ unsigned xb_ld(unsigned* p)              { return __hip_atomic_load(p, __ATOMIC_RELAXED, __HIP_MEMORY_SCOPE_AGENT); }
__device__ __forceinline__ unsigned xb_add(unsigned* p, unsigned v) { return __hip_atomic_fetch_add(p, v, __ATOMIC_RELAXED, __HIP_MEMORY_SCOPE_AGENT); }
__device__ __forceinline__ unsigned xb_xcc_id() { return (unsigned)__builtin_amdgcn_s_getreg((3 << 11) | 20) & 0xFu; }
#define XB_SPIN(cond, bar) do { unsigned _sp = 0; while (cond) { __builtin_amdgcn_s_sleep(1); \
    if ((++_sp & 255u) == 0u) { if (xb_ld(&(bar)[XB_TMO])) break; if (_sp > XB_SPIN_CAP) { atomicAdd(&(bar)[XB_TMO], 1u); break; } } } } while (0)

struct XcdBarrier {
    unsigned* bar; unsigned x;
    volatile LAS unsigned* st;
};

__device__ __forceinline__ XcdBarrier xcd_barrier_post(unsigned* bar, volatile LAS unsigned* st) {
    XcdBarrier b; b.bar = bar; b.x = xb_xcc_id(); b.st = st;
    if (threadIdx.x == 0) (void)xb_add(&bar[XB_XCNT(b.x)], 1u);
    return b;
}
__device__ __forceinline__ void xcd_barrier_complete(unsigned* bar, unsigned x, unsigned& nloc, unsigned& nx) {
    const unsigned G = gridDim.x * gridDim.y * gridDim.z;
    unsigned sum, cnt, mine, sp = 0u;
    for (;;) {
        sum = 0u; cnt = 0u; mine = 0u;
#pragma unroll
        for (unsigned j = 0; j < 16; ++j) { const unsigned c = xb_ld(&bar[XB_XCNT(j)]); sum += c; cnt += (c > 0u) ? 1u : 0u; mine = (j == x) ? c : mine; }
        if (sum == G) break;
        __builtin_amdgcn_s_sleep(1);
        if ((++sp & 255u) == 0u) { if (xb_ld(&bar[XB_TMO])) break; if (sp > XB_SPIN_CAP) { atomicAdd(&bar[XB_TMO], 1u); break; } }
    }
    nloc = mine > 0u ? mine : 1u; nx = cnt > 0u ? cnt : 1u;
}

__device__ __forceinline__ void xcd_barrier(const XcdBarrier& b) {
    asm volatile("s_waitcnt vmcnt(0)" ::: "memory");
    __syncthreads();
    if (threadIdx.x == 0) {
        unsigned* bar = b.bar;
        __builtin_amdgcn_s_waitcnt(0);
        unsigned nloc = b.st[0], nx = b.st[1];
        if (nloc == 0u) { xcd_barrier_complete(bar, b.x, nloc, nx); b.st[0] = nloc; b.st[1] = nx; }
        const unsigned old = xb_add(&bar[XB_XSUB(b.x)], 1u);
        const unsigned gen = old / nloc;
        if (old + 1u == (gen + 1u) * nloc) {
            __builtin_amdgcn_fence(__ATOMIC_RELEASE, "agent");
            asm volatile("s_waitcnt vmcnt(0)" ::: "memory");
            const unsigned og = xb_add(&bar[XB_TOP], 1u);
            const unsigned tg = og / nx;
            if (og + 1u == (tg + 1u) * nx) xb_add(&bar[XB_TOPGEN], 1u);
            else XB_SPIN(xb_ld(&bar[XB_TOPGEN]) == tg, bar);
            __builtin_amdgcn_fence(__ATOMIC_ACQUIRE, "agent");
            xb_add(&bar[XB_XGEN(b.x)], 1u);
            asm volatile("s_waitcnt vmcnt(0)" ::: "memory");
        } else {
            XB_SPIN(xb_ld(&bar[XB_XGEN(b.x)]) == gen, bar);
            __builtin_amdgcn_fence(__ATOMIC_ACQUIRE, "agent");
            asm volatile("s_waitcnt vmcnt(0)" ::: "memory");
        }
    }
    __syncthreads();
}
namespace pg8 {
#define PG8_LAS __attribute__((address_space(3)))
typedef unsigned short bf16_t;
typedef short bf16x8 __attribute__((ext_vector_type(8)));
typedef float f32x4 __attribute__((ext_vector_type(4)));
typedef unsigned u32x4 __attribute__((ext_vector_type(4)));
constexpr int BM = 256, BK = 64, HALF = 128, HTB = HALF * BK * 2  , STAGE_BYTES = 8 * HTB, NXCD = 8, WGM = 8;

__host__ __device__ __forceinline__ int lds_byte(int r, int c) { const int st = (r >> 4) * 2 + (c >> 5), rr = r & 15, cc = c & 31, ob = rr * 64 + cc * 2; return st * 1024 + (ob ^ (((ob >> 9) & 1) << 5)); }
__host__ __device__ __forceinline__ void stage_rc(int b, int& R, int& C) { const int st = b / 1024, sb = b % 1024, swz = sb ^ (((sb >> 9) & 1) << 5); R = (st >> 1) * 16 + swz / 64; C = (st & 1) * 32 + (swz % 64) / 2; }
__host__ __device__ __forceinline__ int perm32(int rho) { const int n = rho >> 4, i = rho & 15; return 8 * (i >> 2) + 4 * n + (i & 3); }

struct Unit { int pm, pn; };
struct Gemm { const bf16_t* A; const bf16_t* Bt; int M, N, K; };

struct StaticOrder {
    int nM, nN, nwg, G, c;
    __host__ __device__ void init(int M, int N, int G_, int c_) { nM = M / BM; nN = N / BM; nwg = nM * nN; G = G_; c = c_; }
    __host__ __device__ bool next(int i, Unit& u) const {
        const long L = (long)i * G + c; if (L >= nwg) return false;
        int wgid = (int)L; { const int q = nwg / NXCD, r = nwg % NXCD, xcd = wgid % NXCD, off = wgid / NXCD; wgid = (xcd < r ? xcd * (q + 1) : r * (q + 1) + (xcd - r) * q) + off; }
        const int nig = WGM * nN, gid = wgid / nig, fm = gid * WGM, gsz = (nM - fm) < WGM ? (nM - fm) : WGM;
        u.pm = fm + ((wgid % nig) % gsz); u.pn = (wgid % nig) / gsz; return true;
    }
    __device__ __forceinline__ void a_ready(const Unit&) const {}
    __device__ __forceinline__ void done(const Unit&) const {}
};
__device__ __forceinline__ unsigned cvt_pk_bf16(float lo, float hi) { unsigned r; asm volatile("v_cvt_pk_bf16_f32 %0, %1, %2" : "=v"(r) : "v"(lo), "v"(hi)); return r; }
typedef float f32x2 __attribute__((ext_vector_type(2)));
__device__ __forceinline__ f32x2 gelu_pk(f32x2 v) {
    const f32x2 av = __builtin_elementwise_abs(v), d = av * 0.2316418882f + 1.0f;
    f32x2 t; t.x = __builtin_amdgcn_rcpf(d.x); t.y = __builtin_amdgcn_rcpf(d.y);
    f32x2 q = t * 0.5307027145f + (-0.7265760135f); q = q * t + 0.7107068705f; q = q * t + (-0.142248368f); q = q * t + 0.127414796f; q = q * t;
    const f32x2 s = (v * v) * (-0.72134752044f);
    f32x2 e; e.x = __builtin_amdgcn_exp2f(s.x); e.y = __builtin_amdgcn_exp2f(s.y);
    const f32x2 m = v * (q * e), r = v - m;
    f32x2 o; o.x = v.x < 0.f ? m.x : r.x; o.y = v.y < 0.f ? m.y : r.y; return o;
}

typedef int pg8_i32x4 __attribute__((ext_vector_type(4)));
template <bool F8> struct Frag { bf16x8 k[2]; };
template <class Epi, class Sched, bool STAMP = false, bool F8 = false>
__device__ __forceinline__ void gemm_phase(PG8_LAS unsigned char* lds, const Gemm g, const Sched& S, const Epi& E, unsigned long long* stamps) {
    int tid_o = threadIdx.x; asm volatile("" : "+v"(tid_o));
    const int tid = tid_o, wid = __builtin_amdgcn_readfirstlane(tid >> 6), lane = tid & 63, wr = wid >> 2, wc = wid & 3, fr = lane & 15, fq = lane >> 4;
    const int K = g.K, nt = K / BK;
    int ts_lo = 0, ts_hi = 0, nts = 0; const unsigned long long rt_entry = STAMP ? (unsigned long long)wall_clock64() : 0ull;
#define PG8_STAMP() do { if (STAMP && wid == 0 && nts < 64) { const unsigned long long _c = (unsigned long long)clock64(); \
        ts_lo = (lane == nts) ? (int)(unsigned)_c : ts_lo; ts_hi = (lane == nts) ? (int)(unsigned)(_c >> 32) : ts_hi; ++nts; } } while (0)
    PG8_STAMP();
    unsigned voffA[2], voffB[2];
#pragma unroll
    for (int i = 0; i < 2; ++i) { int R, C; stage_rc(tid * 16 + i * 8192, R, C); const int Rb = Epi::PERM ? ((R & ~31) + perm32(R & 31)) : R;
        voffA[i] = (unsigned)(R * K + C) * 2u; voffB[i] = (unsigned)(Rb * K + C) * 2u; }
    const size_t pstep = (size_t)64 * K * 2;
    const size_t kstep = (size_t)(BK * 2);
    const size_t hstep = (size_t)HALF * K * 2;
    const size_t tstep = 2 * hstep;
    const unsigned ldsw = (unsigned)wid * 1024u;
    const int aoff = lds_byte(wr * 64 + fr, fq * 8), boff = lds_byte(wc * 32 + fr, fq * 8);
#define PG8_SA(b, h) (((b) * 2 + (h)) * HTB)
#define PG8_SB(b, h) ((4 + (b) * 2 + (h)) * HTB)
#define PG8_STAGE(bufoff, gbase, voff) do { const char* _b0 = (const char*)(gbase); const char* _b1 = _b0 + pstep; asm volatile("" : "+s"(_b0), "+s"(_b1)); \
        __builtin_amdgcn_global_load_lds((const unsigned*)(_b0 + (voff)[0]), (PG8_LAS unsigned*)(lds + (bufoff) + ldsw), 16, 0, 0); \
        __builtin_amdgcn_global_load_lds((const unsigned*)(_b1 + (voff)[0]), (PG8_LAS unsigned*)(lds + (bufoff) + ldsw + 8192), 16, 0, 0); } while (0)
#define PG8_LDF(dstf, addr) do { (dstf).k[0] = *(const PG8_LAS bf16x8*)(addr); (dstf).k[1] = *(const PG8_LAS bf16x8*)((addr) + 1024); } while (0)
#define PG8_LDA(dst, b, h) do { _Pragma("unroll") for (int m = 0; m < 4; ++m) PG8_LDF(dst[m], lds + PG8_SA(b, h) + aoff + m * 2048); } while (0)
#define PG8_LDB(dst, b, h) do { _Pragma("unroll") for (int n = 0; n < 2; ++n) PG8_LDF(dst[n], lds + PG8_SB(b, h) + boff + n * 2048); } while (0)
#define PG8_MMA(ai, bj, At, Bt) do { __builtin_amdgcn_s_setprio(1); _Pragma("unroll") for (int m = 0; m < 4; ++m) _Pragma("unroll") for (int n = 0; n < 2; ++n) _Pragma("unroll") for (int k = 0; k < 2; ++k) { \
        if constexpr (F8) acc[ai][bj][m][n] = __builtin_bit_cast(f32x4, __builtin_amdgcn_mfma_i32_16x16x64_i8(__builtin_bit_cast(pg8_i32x4, Bt[n].k[k]), __builtin_bit_cast(pg8_i32x4, At[m].k[k]), __builtin_bit_cast(pg8_i32x4, acc[ai][bj][m][n]), 0, 0, 0)); \
        else acc[ai][bj][m][n] = __builtin_amdgcn_mfma_f32_16x16x32_bf16(Bt[n].k[k], At[m].k[k], acc[ai][bj][m][n], 0, 0, 0); } \
        __builtin_amdgcn_s_setprio(0); } while (0)
#define PG8_WAIT_V(n) asm volatile("s_waitcnt vmcnt(" #n ")" ::: "memory")
#define PG8_WAIT_L(n) asm volatile("s_waitcnt lgkmcnt(" #n ")" ::: "memory")
#define PG8_BAR __builtin_amdgcn_s_barrier()
#define PG8_SCHED __builtin_amdgcn_sched_barrier(0)
    Unit cur, nxt; int ui = 0;
    if (!S.next(0, cur)) return;
    f32x4 acc[2][2][4][2];
#pragma unroll
    for (int a = 0; a < 2; ++a)
#pragma unroll
        for (int b = 0; b < 2; ++b)
#pragma unroll
            for (int m = 0; m < 4; ++m)
#pragma unroll
                for (int n = 0; n < 2; ++n) acc[a][b][m][n] = (f32x4){0.f, 0.f, 0.f, 0.f};
    Frag<F8> At[4], B0[2], B1[2];
    const char* cA = (const char*)g.A + (size_t)cur.pm * tstep; const char* cB = (const char*)g.Bt + (size_t)cur.pn * tstep;
    S.a_ready(cur);
    PG8_STAGE(PG8_SB(0, 0), cB, voffB); PG8_STAGE(PG8_SA(0, 0), cA, voffA); PG8_STAGE(PG8_SB(0, 1), cB + hstep, voffB); PG8_STAGE(PG8_SA(0, 1), cA + hstep, voffA);
    if (wr == 1) PG8_BAR;
    PG8_WAIT_V(4); PG8_BAR;
    PG8_STAGE(PG8_SB(1, 0), cB + kstep, voffB); PG8_STAGE(PG8_SA(1, 0), cA + kstep, voffA); PG8_STAGE(PG8_SB(1, 1), cB + hstep + kstep, voffB);
    PG8_WAIT_V(6); PG8_BAR;
    PG8_STAMP();
    for (;;) {
        const bool has_next = S.next(ui + 1, nxt);
        const char* nA = has_next ? (const char*)g.A + (size_t)nxt.pm * tstep : cA; const char* nB = has_next ? (const char*)g.Bt + (size_t)nxt.pn * tstep : cB;
        for (int t = 0; t < nt; t += 2) {
            const bool last = (t == nt - 2);
            const char* a1 = cA + (size_t)(t + 1) * kstep;
            const char* a2 = last ? nA : cA + (size_t)(t + 2) * kstep; const char* b2 = last ? nB : cB + (size_t)(t + 2) * kstep;
            const char* a3 = a2 + kstep; const char* b3 = b2 + kstep;
            if (last && has_next) S.a_ready(nxt);
            PG8_LDB(B0, 0, 0); PG8_SCHED; PG8_LDA(At, 0, 0); PG8_STAGE(PG8_SA(1, 1), a1 + hstep, voffA);
            PG8_WAIT_L(8); PG8_BAR; PG8_WAIT_L(0); PG8_MMA(0, 0, At, B0); PG8_BAR; PG8_SCHED;
            PG8_LDB(B1, 0, 1); PG8_STAGE(PG8_SB(0, 0), b2, voffB);
            PG8_BAR; PG8_WAIT_L(0); PG8_MMA(0, 1, At, B1); PG8_BAR;
            PG8_LDA(At, 0, 1); PG8_STAGE(PG8_SA(0, 0), a2, voffA);
            PG8_BAR; PG8_WAIT_L(0); PG8_MMA(1, 0, At, B0); PG8_BAR; PG8_SCHED;
            PG8_STAGE(PG8_SB(0, 1), b2 + hstep, voffB);
            PG8_WAIT_V(6); PG8_BAR; PG8_MMA(1, 1, At, B1); PG8_BAR;
            PG8_LDB(B0, 1, 0); PG8_SCHED; PG8_LDA(At, 1, 0); PG8_STAGE(PG8_SA(0, 1), a2 + hstep, voffA);
            PG8_WAIT_L(8); PG8_BAR; PG8_WAIT_L(0); PG8_MMA(0, 0, At, B0); PG8_BAR; PG8_SCHED;
            PG8_LDB(B1, 1, 1); PG8_STAGE(PG8_SB(1, 0), b3, voffB);
            PG8_BAR; PG8_WAIT_L(0); PG8_MMA(0, 1, At, B1); PG8_BAR;
            PG8_LDA(At, 1, 1); PG8_STAGE(PG8_SA(1, 0), a3, voffA);
            PG8_BAR; PG8_WAIT_L(0); PG8_MMA(1, 0, At, B0); PG8_BAR; PG8_SCHED;
            PG8_STAGE(PG8_SB(1, 1), b3 + hstep, voffB);
            PG8_WAIT_V(6); PG8_BAR; PG8_MMA(1, 1, At, B1); PG8_BAR;
        }
        PG8_STAMP();
#ifdef PROBE_EPI
        const unsigned long long te0_ = __builtin_amdgcn_s_memrealtime();
#endif
        const bool keep_acc = E(acc, cur, wr, wc, fr, fq); S.done(cur);
#ifdef PROBE_EPI
        if (blockIdx.x == 0 && tid == 0) { unsigned long long* ec_ = probe_epi_counter(); *ec_ += __builtin_amdgcn_s_memrealtime() - te0_; }
#endif
        PG8_STAMP();
        if (!has_next) break;
        if (!keep_acc)
#pragma unroll
        for (int a = 0; a < 2; ++a)
#pragma unroll
            for (int b = 0; b < 2; ++b)
#pragma unroll
                for (int m = 0; m < 4; ++m)
#pragma unroll
                    for (int n = 0; n < 2; ++n) acc[a][b][m][n] = (f32x4){0.f, 0.f, 0.f, 0.f};
        cur = nxt; cA = nA; cB = nB; ++ui;
    }
    PG8_WAIT_V(0);
    if (wr == 0) PG8_BAR;
    PG8_BAR;
    PG8_STAMP();
    if (STAMP && wid == 0) { stamps[lane] = lane < nts ? (((unsigned long long)(unsigned)ts_hi << 32) | (unsigned)ts_lo) : 0ull;
        if (lane == 62) stamps[62] = rt_entry; if (lane == 63) stamps[63] = (unsigned long long)wall_clock64(); }
#undef PG8_STAMP
#undef PG8_SA
#undef PG8_SB
#undef PG8_STAGE
#undef PG8_LDA
#undef PG8_LDF
#undef PG8_LDB
#undef PG8_MMA
#undef PG8_WAIT_V
#undef PG8_WAIT_L
#undef PG8_BAR
#undef PG8_SCHED
}
}
struct RectOrder {
    pg8::StaticOrder so; int offA, nwgA, nMb, nNb, offB, nwgB, G, c;
    __device__ void init(int nMa, int nNa, int offA_, int nMb_, int nNb_, int offB_, int G_, int c_) {
        so.init(nMa * 256, nNa * 256, G_, c_); offA = offA_; nwgA = nMa * nNa; nMb = nMb_; nNb = nNb_; offB = offB_; nwgB = nMb_ * nNb_; G = G_; c = c_; }
    __device__ bool next(int i, pg8::Unit& u) const {
        const int L = i * G + c;
        if (L < nwgA) { so.next(i, u); u.pm += offA; return true; }
        const int Lb = L - nwgA; if (Lb >= nwgB) return false;
        u.pm = offB + Lb % nMb; u.pn = Lb / nMb; return true;
    }
    __device__ __forceinline__ void a_ready(const pg8::Unit&) const {}
    __device__ __forceinline__ void done(const pg8::Unit&) const {}
};
struct MergeOrder {
    pg8::StaticOrder so; int off, G, c;
    __device__ void init(int nM, int off_, int G_, int c_) { so.init(nM * 256, 1024, G_, c_); off = off_; G = G_; c = c_; }
    __device__ bool next(int i, pg8::Unit& u) const {
        const int ti = i / 3, br = i - ti * 3;
        if (!so.next(ti, u)) return false;
        u.pm += off + br * (MH / 256); u.pn += br * 4; return true;
    }
    __device__ __forceinline__ void a_ready(const pg8::Unit&) const {}
    __device__ __forceinline__ void done(const pg8::Unit&) const {}
};
struct MoeOrder {
    int e0, e1, e2, e3, e4, e5, ntiles, G, c;
    __device__ __forceinline__ void unit_of(int i, int& pm, int& pn) const {
        if ((G & 31) == 0) { const int j = c >> 3; pm = i * (G >> 2) + (c & 7) * (G >> 5) + (j >> 2); pn = j & 3; }
        else { const int L = i * G + c; pm = L >> 2; pn = L & 3; } }
    __device__ __forceinline__ int look(const LAS int* tile_e, int i) const { int pm, pn; unit_of(i, pm, pn); return __builtin_amdgcn_readfirstlane(pm < ntiles ? tile_e[pm] : 0); }
    __device__ __forceinline__ void init(const LAS int* tile_e, int nt, int G_, int c_) { ntiles = nt; G = G_; c = c_;
        e0 = look(tile_e, 0); e1 = look(tile_e, 1); e2 = look(tile_e, 2); e3 = look(tile_e, 3); e4 = look(tile_e, 4); e5 = look(tile_e, 5); }
    __device__ __forceinline__ bool next(int i, pg8::Unit& u) const {
        int pm, pn; unit_of(i, pm, pn); if (pm >= ntiles || i >= 6) return false;
        const int e = i == 0 ? e0 : i == 1 ? e1 : i == 2 ? e2 : i == 3 ? e3 : i == 4 ? e4 : e5;
        u.pm = pm; u.pn = e * 4 + pn; return true;
    }
    __device__ __forceinline__ void a_ready(const pg8::Unit&) const {}
    __device__ __forceinline__ void done(const pg8::Unit&) const {}
};

struct EpiIn {
    static constexpr bool PERM = true, AFTER_DRAIN = false;
    bf16_t* P; bf16_t* GB; const float* cosT; const float* sinT;
    __device__ __forceinline__ bool operator()(pg8::f32x4 (&acc)[2][2][4][2], const pg8::Unit& u, int wr, int wc, int fr, int fq) const {
        const int pn = u.pn, rbase = u.pm * 256 + wr * 64 + fr;
        int act, ld; bf16_t* dst; int cb; bool rope = false; float scl = 1.0f;
        if (pn < 14) {
            const int kind = pn >> 1;
            const int bufidx = kind == 5 ? 6 : (kind == 6 ? 5 : kind);
            dst = P + (size_t)bufidx * ((size_t)MH * 512); ld = 512; cb = (pn & 1) * 256 + wc * 32 + 8 * fq;
            act = (kind == 4 || kind == 5) ? 1 : (kind == 6 ? 2 : 0);
            rope = (kind == 0 || kind == 3) && (u.pm >= 8);
            if (kind == 3) scl = QSCALE;
        } else {
            const int gi = (pn - 14) >> 2, pnl = (pn - 14) & 3, tid = (wr * 4 + wc) * 64 + fq * 16 + fr;
            u32x2* gdst = (u32x2*)GB + ((size_t)((gi * (MH / 256) + u.pm) * 4 + pnl) * 16) * 512 + tid;
#pragma unroll
            for (int ai = 0; ai < 2; ++ai)
#pragma unroll
                for (int m = 0; m < 4; ++m)
#pragma unroll
                    for (int bj = 0; bj < 2; ++bj) { unsigned q[8];
#pragma unroll
                        for (int j = 0; j < 4; ++j) { q[j] = (unsigned)fminf(fmaxf(sigmoid_f(acc[ai][bj][m][0][j]) * 255.0f + 0.5f, 1.0f), 255.0f); q[4 + j] = (unsigned)fminf(fmaxf(sigmoid_f(acc[ai][bj][m][1][j]) * 255.0f + 0.5f, 1.0f), 255.0f); }
                        u32x2 w; w.x = q[0] | (q[1] << 8) | (q[2] << 16) | (q[3] << 24); w.y = q[4] | (q[5] << 8) | (q[6] << 16) | (q[7] << 24);
                        gdst[(size_t)((ai * 4 + m) * 2 + bj) * 512] = w; }
            return false;
        }
        pg8::f32x4 csv[8], snv[8];
#pragma unroll
        for (int i = 0; i < 8; ++i) { csv[i] = (pg8::f32x4){1.f, 1.f, 1.f, 1.f}; snv[i] = (pg8::f32x4){0.f, 0.f, 0.f, 0.f}; }
        if (rope) {
#pragma unroll
            for (int i = 0; i < 8; ++i) { const int row = rbase + (i >> 2) * 128 + (i & 3) * 16; const int t = (row - CTXROWS) & 2047; const int pos = (wc & 1) ? (t & 63) : (t >> 6);
                csv[i] = *(const pg8::f32x4*)(cosT + pos * 16 + 4 * fq); snv[i] = *(const pg8::f32x4*)(sinT + pos * 16 + 4 * fq); } }
#pragma unroll
        for (int ai = 0; ai < 2; ++ai)
#pragma unroll
            for (int m = 0; m < 4; ++m) {
                const int row = rbase + ai * 128 + m * 16;
                const pg8::f32x4 cs = csv[ai * 4 + m], sn = snv[ai * 4 + m];
                bf16_t* rowp = dst + (size_t)row * ld + cb;
#pragma unroll
                for (int bj = 0; bj < 2; ++bj) {
                    pg8::f32x4 v0 = acc[ai][bj][m][0], v1 = acc[ai][bj][m][1];
                    if (rope) { const pg8::f32x4 o0 = v0 * cs - v1 * sn, o1 = v0 * sn + v1 * cs; v0 = o0; v1 = o1; }
                    v0 *= scl; v1 *= scl;
                    if (act == 1) {
#pragma unroll
                        for (int j = 0; j < 4; ++j) { v0[j] = gelu_tanh_f(v0[j]); v1[j] = gelu_tanh_f(v1[j]); } }
                    else if (act == 2) {
#pragma unroll
                        for (int j = 0; j < 4; ++j) { v0[j] = fmaxf(sigmoid_f(v0[j]), 1e-6f); v1[j] = fmaxf(sigmoid_f(v1[j]), 1e-6f); } }
                    u32x4 w; w.x = cvtpk(v0[0], v0[1]); w.y = cvtpk(v0[2], v0[3]); w.z = cvtpk(v1[0], v1[1]); w.w = cvtpk(v1[2], v1[3]);
                    *(u32x4*)(rowp + bj * 128) = w;
                }
            }
        return false;
    }
};
struct EpiGate8 {
    static constexpr bool PERM = true, AFTER_DRAIN = false;
    bf16_t* GB;
    __device__ __forceinline__ bool operator()(pg8::f32x4 (&acc)[2][2][4][2], const pg8::Unit& u, int wr, int wc, int fr, int fq) const {
        const int gi = u.pn >> 2, pnl = u.pn & 3, tid = (wr * 4 + wc) * 64 + fq * 16 + fr; const float sc = 1.0f / (HSCALE8 * WSCALE8);
        u32x2* gdst = (u32x2*)GB + ((size_t)((gi * (MH / 256) + u.pm) * 4 + pnl) * 16) * 512 + tid;
#pragma unroll
        for (int ai = 0; ai < 2; ++ai)
#pragma unroll
            for (int m = 0; m < 4; ++m)
#pragma unroll
                for (int bj = 0; bj < 2; ++bj) { unsigned q[8];
#pragma unroll
                    for (int j = 0; j < 4; ++j) { q[j] = (unsigned)fminf(fmaxf(sigmoid_f((float)__float_as_int(acc[ai][bj][m][0][j]) * sc) * 255.0f + 0.5f, 1.0f), 255.0f);
                        q[4 + j] = (unsigned)fminf(fmaxf(sigmoid_f((float)__float_as_int(acc[ai][bj][m][1][j]) * sc) * 255.0f + 0.5f, 1.0f), 255.0f); }
                    u32x2 w; w.x = q[0] | (q[1] << 8) | (q[2] << 16) | (q[3] << 24); w.y = q[4] | (q[5] << 8) | (q[6] << 16) | (q[7] << 24);
                    gdst[(size_t)((ai * 4 + m) * 2 + bj) * 512] = w; }
        return false;
    }
};
struct EpiMerge {
    static constexpr bool PERM = true, AFTER_DRAIN = false;
    const bf16_t* GB; bf16_t* OUT;
    __device__ __forceinline__ bool operator()(pg8::f32x4 (&acc)[2][2][4][2], const pg8::Unit& u, int wr, int wc, int fr, int fq) const {
        const int br = u.pn >> 2, pn = u.pn & 3, pm = u.pm - br * (MH / 256), tid = (wr * 4 + wc) * 64 + fq * 16 + fr;
        const int rbase = pm * 256 + wr * 64 + fr, cb = pn * 256 + wc * 32 + 8 * fq;
        const u32x2* g0 = (const u32x2*)GB + ((size_t)((br * (MH / 256) + pm) * 4 + pn) * 16) * 512 + tid;
        const u32x2* g1 = g0 + (size_t)(MH / 256) * 4 * 16 * 512;
        u32x2 ga_[16], gb_[16];
#pragma unroll
        for (int s = 0; s < 16; ++s) { ga_[s] = g0[(size_t)s * 512]; gb_[s] = (br < 2) ? g1[(size_t)s * 512] : (u32x2){0x01010101u, 0x01010101u}; }
#pragma unroll
        for (int ai = 0; ai < 2; ++ai)
#pragma unroll
            for (int m = 0; m < 4; ++m) {
                const size_t off = (size_t)(rbase + ai * 128 + m * 16) * 1024 + cb;
#pragma unroll
                for (int bj = 0; bj < 2; ++bj) {
                    const int slot = (ai * 4 + m) * 2 + bj;
                    const u32x2 a = ga_[slot], b = gb_[slot];
                    float ga[8];
#pragma unroll
                    for (int j = 0; j < 4; ++j) { ga[j] = (float)((a.x >> (8 * j)) & 0xffu); ga[4 + j] = (float)((a.y >> (8 * j)) & 0xffu); }
                    if (br < 2) {
#pragma unroll
                        for (int j = 0; j < 4; ++j) { ga[j] *= __builtin_amdgcn_rcpf((float)((b.x >> (8 * j)) & 0xffu)); ga[4 + j] *= __builtin_amdgcn_rcpf((float)((b.y >> (8 * j)) & 0xffu)); }
                    } else {
#pragma unroll
                        for (int j = 0; j < 8; ++j) ga[j] *= (1.0f / 255.0f);
                    }
                    pg8::f32x4 v0 = acc[ai][bj][m][0], v1 = acc[ai][bj][m][1];
#pragma unroll
                    for (int j = 0; j < 4; ++j) { v0[j] *= ga[j]; v1[j] *= ga[4 + j]; }
                    if (br < 2) { acc[ai][bj][m][0] = v0; acc[ai][bj][m][1] = v1; }
                    else { u32x4 w; w.x = cvtpk(v0[0], v0[1]); w.y = cvtpk(v0[2], v0[3]); w.z = cvtpk(v1[0], v1[1]); w.w = cvtpk(v1[2], v1[3]);
                        *(u32x4*)(OUT + off + bj * 128) = w; }
                }
            }
        return br < 2;
    }
};
struct EpiOut {
    static constexpr bool PERM = false, AFTER_DRAIN = false;
    const float* xres_lat; const float* xres_ctx; float* xs_lat; float* xs_ctx; const float* mod; int hf;
    __device__ __forceinline__ bool operator()(pg8::f32x4 (&acc)[2][2][4][2], const pg8::Unit& u, int wr, int wc, int fr, int fq) const {
        const int pm = u.pm; const float* src; float* dst; int b;
        if (pm < 8) { b = 16; const size_t o = (size_t)((hf * HBAT + pm) * 256) * 1024; src = xres_ctx + o; dst = xs_ctx + o; }
        else { const int q = pm - 8; b = hf * HBAT + (q >> 3); const size_t o = ((size_t)b * 2048 + (size_t)(q & 7) * 256) * 1024; src = xres_lat + o; dst = xs_lat + o; }
        const int col0 = u.pn * 256 + wc * 32 + 4 * fq;
        const float* mrow = mod + (size_t)b * 6144 + 2 * 1024 + col0;
        pg8::f32x4 mv[2][2];
#pragma unroll
        for (int bj = 0; bj < 2; ++bj)
#pragma unroll
            for (int n = 0; n < 2; ++n) mv[bj][n] = *(const pg8::f32x4*)(mrow + bj * 128 + n * 16);
#pragma unroll
        for (int ai = 0; ai < 2; ++ai) {
            pg8::f32x4 xr[4][2][2];
#pragma unroll
            for (int m = 0; m < 4; ++m) { const size_t off = (size_t)(wr * 64 + fr + ai * 128 + m * 16) * 1024 + col0;
#pragma unroll
                for (int bj = 0; bj < 2; ++bj)
#pragma unroll
                    for (int n = 0; n < 2; ++n) xr[m][bj][n] = *(const pg8::f32x4*)(src + off + bj * 128 + n * 16); }
#pragma unroll
            for (int m = 0; m < 4; ++m) { const size_t off = (size_t)(wr * 64 + fr + ai * 128 + m * 16) * 1024 + col0;
#pragma unroll
                for (int bj = 0; bj < 2; ++bj)
#pragma unroll
                    for (int n = 0; n < 2; ++n) *(pg8::f32x4*)(dst + off + bj * 128 + n * 16) = xr[m][bj][n] + mv[bj][n] * acc[ai][bj][m][n]; }
            asm volatile("" ::: "memory");
        }
        return false;
    }
};
struct EpiGU {
    static constexpr bool PERM = true, AFTER_DRAIN = false;
    unsigned char* ACT;
    __device__ __forceinline__ bool operator()(pg8::f32x4 (&acc)[2][2][4][2], const pg8::Unit& u, int wr, int wc, int fr, int fq) const {
        const int rbase = u.pm * 256 + wr * 64 + fr, cb = (u.pn & 3) * 128 + wc * 32 + 8 * fq;
        const float sc = 1.0f / (HSCALE8 * WSCALE8);
#pragma unroll
        for (int ai = 0; ai < 2; ++ai)
#pragma unroll
            for (int m = 0; m < 4; ++m) {
                float o[8];
#pragma unroll
                for (int n = 0; n < 2; ++n)
#pragma unroll
                    for (int j = 0; j < 4; ++j) o[4 * n + j] = silu_f((float)__float_as_int(acc[ai][0][m][n][j]) * sc) * ((float)__float_as_int(acc[ai][1][m][n][j]) * (sc * ASCALE8));
                u32x2 w; w.x = pk4_fp8(o[0], o[1], o[2], o[3]); w.y = pk4_fp8(o[4], o[5], o[6], o[7]);
                *(u32x2*)(ACT + (size_t)(rbase + ai * 128 + m * 16) * 512 + cb) = w;
            }
        return false;
    }
};
struct EpiDown {
    static constexpr bool PERM = true, AFTER_DRAIN = false;
    bf16_t* YS;
    __device__ __forceinline__ bool operator()(pg8::f32x4 (&acc)[2][2][4][2], const pg8::Unit& u, int wr, int wc, int fr, int fq) const {
        const int rbase = u.pm * 256 + wr * 64 + fr, cb = (u.pn & 3) * 256 + wc * 32 + 8 * fq;
#pragma unroll
        for (int ai = 0; ai < 2; ++ai)
#pragma unroll
            for (int m = 0; m < 4; ++m) {
                const int row = rbase + ai * 128 + m * 16;
#pragma unroll
                for (int bj = 0; bj < 2; ++bj) { const float s8 = 1.0f / (ASCALE8 * WSCALE8); u32x4 w;
                    w.x = cvtpk((float)__float_as_int(acc[ai][bj][m][0][0]) * s8, (float)__float_as_int(acc[ai][bj][m][0][1]) * s8); w.y = cvtpk((float)__float_as_int(acc[ai][bj][m][0][2]) * s8, (float)__float_as_int(acc[ai][bj][m][0][3]) * s8);
                    w.z = cvtpk((float)__float_as_int(acc[ai][bj][m][1][0]) * s8, (float)__float_as_int(acc[ai][bj][m][1][1]) * s8); w.w = cvtpk((float)__float_as_int(acc[ai][bj][m][1][2]) * s8, (float)__float_as_int(acc[ai][bj][m][1][3]) * s8);
                    *(u32x4*)(YS + (size_t)row * 1024 + cb + bj * 128) = w; }
            }
        return false;
    }
};
template <class ColMap>
__device__ __forceinline__ void cvt_tile_T(const float* __restrict__ src, int ldsrc, bf16_t* __restrict__ dst, int K, int k0, int n0, const ColMap& cm, float scale, LAS float* tile) {
    const int tid = opaque_tid();
    {
        const int n = tid & 63, kb = tid >> 6; const int sc = cm(n0 + n);
#pragma unroll
        for (int i = 0; i < 8; ++i) { const int k = kb + 8 * i; tile[k * 65 + n] = src[(size_t)(k0 + k) * ldsrc + sc] * scale; }
    }
    __syncthreads();
    {
        const int kp = (tid & 31) * 2, nb = tid >> 5;
#pragma unroll
        for (int i = 0; i < 4; ++i) { const int n = nb + 16 * i; *(unsigned*)(dst + (size_t)(n0 + n) * K + k0 + kp) = cvtpk(tile[kp * 65 + n], tile[(kp + 1) * 65 + n]); }
    }
    __syncthreads();
}
struct CmIdent { int off; __device__ __forceinline__ int operator()(int n) const { return n + off; } };
struct CmWin {
    __device__ __forceinline__ int operator()(int n) const {
        if (n < 512 || (n >= 1536 && n < 2048)) { const int c = n & 31, f = c >> 3, j = c & 7; return (n & ~31) + ((j < 4) ? (4 * f + j) : (16 + 4 * f + (j - 4))); }
        return n; }
};
struct CmGU {
    __device__ __forceinline__ int operator()(int n) const { return 128 * (n >> 8) + (n & 127); }
};

template <int MODE, bool OUT8 = false>
__device__ __forceinline__ void cvt_tile_T256(const float* __restrict__ baseA, const float* __restrict__ baseB, int ldsrc, void* __restrict__ dstv, int K, int k0, int n0, float scale, LAS float* tile) {
    const int tid = opaque_tid();
    {
        const int n = tid & 255, kb = tid >> 8, ng = n0 + n;
        const float* sp = (MODE == 2 ? ((ng & 128) ? baseB : baseA) + 128 * (ng >> 8) + (ng & 127) : MODE == 1 ? baseA + CmWin{}(ng) : baseA + ng) + (size_t)(k0 + kb) * ldsrc;
        float v[32];
#pragma unroll
        for (int i = 0; i < 32; ++i) v[i] = sp[(size_t)(2 * i) * ldsrc];
#pragma unroll
        for (int i = 0; i < 32; ++i) tile[(kb + 2 * i) * 257 + n] = v[i] * scale;
    }
    __syncthreads();
    {
        const int n = tid >> 1, kh = (tid & 1) * 32;
        if constexpr (OUT8) { unsigned char* dp = (unsigned char*)dstv + (size_t)(n0 + n) * K + k0 + kh;
#pragma unroll
            for (int i = 0; i < 2; ++i) { float f[16];
#pragma unroll
                for (int j = 0; j < 16; ++j) f[j] = tile[(kh + 16 * i + j) * 257 + n];
                u32x4 w; w.x = pk4_fp8(f[0], f[1], f[2], f[3]); w.y = pk4_fp8(f[4], f[5], f[6], f[7]); w.z = pk4_fp8(f[8], f[9], f[10], f[11]); w.w = pk4_fp8(f[12], f[13], f[14], f[15]);
                *(u32x4*)(dp + 16 * i) = w; } }
        else { bf16_t* dp = (bf16_t*)dstv + (size_t)(n0 + n) * K + k0 + kh;
#pragma unroll
            for (int i = 0; i < 4; ++i) { float f[8];
#pragma unroll
                for (int j = 0; j < 8; ++j) f[j] = tile[(kh + 8 * i + j) * 257 + n];
                *(u32x4*)(dp + 8 * i) = pack8(f); } }
    }
    __syncthreads();
}

__device__ __forceinline__ void phase_prologue(const Params& p, LAS unsigned char* lds) {
    LAS float* tile = (LAS float*)lds;
    const int tid = opaque_tid(), G = gridDim.x, bid = blockIdx.x;
    unsigned char* ws = p.ws;
    for (int u = bid; u < 1248; u += G) {
        if (u < 448) { const int l = u / 224, r = u % 224, kt = r / 14, nt = r % 14;
            cvt_tile_T256<1>(p.in[I_WIN] + (size_t)l * 1024 * NCOL, nullptr, NCOL, (bf16_t*)(ws + WS_WTIN) + (size_t)l * NCOL * 1024, 1024, kt * 64, nt * 256, 1.0f, tile); }
        else if (u < 832) { const int v = u - 448, l = v / 192, r = v % 192, kt = r / 12, nt = r % 12;
            cvt_tile_T256<0, true>(p.in[I_WIN] + (size_t)l * 1024 * NCOL + 3584, nullptr, NCOL, ws + WS_WTIN8 + (size_t)l * 3072 * 1024, 1024, kt * 64, nt * 256, WSCALE8, tile); }
        else if (u < 1024) { const int v = u - 832, li = v / 32, r = v % 32, kt = r / 4, nt = r % 4;
            cvt_tile_T256<0>(p.in[I_WBR] + (size_t)li * 512 * 1024, nullptr, 1024, (bf16_t*)(ws + WS_WTBR) + (size_t)li * 1024 * 512, 512, kt * 64, nt * 256, 1.0f, tile); }
        else if (u < 1152) { const int v = u - 1024, l = v / 64, r = v % 64, kt = r / 4, nt = r % 4;
            cvt_tile_T256<0>(p.in[I_WOUT] + (size_t)l * 1024 * 1024, nullptr, 1024, (bf16_t*)(ws + WS_WTO) + (size_t)l * 1024 * 1024, 1024, kt * 64, nt * 256, 1.0f, tile); }
        else { const int v = u - 1152, m = v / 4, r = v % 4, kt = r >> 1, nt = r & 1;
            const int j = (m >> 2) % 3;
            cvt_tile_T(p.in[I_WQKV] + (size_t)m * 16384, 128, (bf16_t*)(ws + WS_WTQKV) + (size_t)m * 16384, 128, kt * 64, nt * 64, CmIdent{0}, j == 1 ? 0.08838834764831845f : 1.0f, tile); }
    }
    const int gt = bid * NTHR + tid, gn = G * NTHR;
    for (int i = gt; i < 2 * 4 * 16384; i += gn) ((bf16_t*)(ws + WS_WSB))[i] = f2bf(p.in[I_WGS][i]);
    for (int i = gt; i < 2 * 48 * 1024; i += gn) {
        const int l = i / (48 * 1024), r = i % (48 * 1024), n = r >> 10, k = r & 1023;
        float w = 0.f; if (n < 4) w = p.in[I_WRG][((size_t)l * 1024 + k) * 4 + n]; else if (n < 36) w = p.in[I_WRE][((size_t)l * 1024 + k) * 32 + (n - 4)];
        const bf16_t hi = f2bf(w); const bf16_t lo = f2bf(w - bf2f(hi));
        bf16_t* d = (bf16_t*)(ws + WS_WRT) + (size_t)l * 2 * 48 * 1024;
        d[r] = hi; d[48 * 1024 + r] = lo;
    }
    for (int i = gt; i < 1024; i += gn) { const int pos = i >> 4, f = i & 15; const float inv = powf(10000.0f, -(float)f / 16.0f); const float a = (float)pos * inv;
        ((float*)(ws + WS_ROPE))[i] = cosf(a); ((float*)(ws + WS_ROPE))[1024 + i] = sinf(a); }
    if (gt < 2) { const int l = gt; const float* lp = p.in[I_DLAM] + l * 256; float s01 = 0.f, s23 = 0.f;
        for (int i = 0; i < 64; ++i) { s01 += lp[i] * lp[64 + i]; s23 += lp[128 + i] * lp[192 + i]; }
        const float lam_init = 0.8f - 0.6f * expf(-0.3f * (float)l);
        float* o = (float*)(ws + WS_LAM) + l * 4; o[0] = expf(s01) - expf(s23) + lam_init; o[1] = 1.0f - lam_init; }
    for (int i = gt; i < 2 * 16 * 1024; i += gn) {
        const int l = i >> 14, gc = (i >> 10) & 15, ch = i & 1023, part = ch >> 9, c = ch & 511, h = c >> 7, d = c & 127;
        const float* wif = p.in[I_WIF] + (size_t)l * 1536 * 16; const float* wq = p.in[I_WQKV] + (size_t)l * 3 * 4 * 16384;
        float s = 0.f;
        if (part == 0) { const float* a = wq + ((size_t)(0 * 4 + h) * 128 + d) * 128; const float* b = wq + ((size_t)(1 * 4 + h) * 128 + d) * 128;
            for (int e = 0; e < 128; ++e) s += a[e] * wif[(size_t)(h * 128 + e) * 16 + gc] + b[e] * wif[(size_t)(512 + h * 128 + e) * 16 + gc]; }
        else { const float* a = wq + ((size_t)(2 * 4 + h) * 128 + d) * 128;
            for (int e = 0; e < 128; ++e) s += a[e] * wif[(size_t)(1024 + h * 128 + e) * 16 + gc]; }
        ((float*)(ws + WS_WFOLD))[i] = s;
    }
    {
        LAS float* sc = (LAS float*)lds;
        LAS float* red = sc + 17 * 1024;
        bool loaded = false;
        for (int u = bid; u < 192; u += G) {
            if (!loaded) { for (int i = tid; i < 17 * 1024; i += NTHR) { const float v = i < 16384 ? p.in[I_C][i] : p.in[I_CCTX][i - 16384]; sc[i] = silu_f(v); } loaded = true; }
            __syncthreads();
            const int l = u / 96, cbk = u % 96, col = cbk * 64 + (tid & 63), kq = tid >> 6;
            float a[17];
#pragma unroll
            for (int b = 0; b < 17; ++b) a[b] = 0.f;
            const float* wp = p.in[I_WMOD] + (size_t)l * 1024 * 6144 + col;
            for (int k0 = kq * 128; k0 < kq * 128 + 128; k0 += 8) { float w[8];
#pragma unroll
                for (int j = 0; j < 8; ++j) w[j] = wp[(size_t)(k0 + j) * 6144];
#pragma unroll
                for (int j = 0; j < 8; ++j)
#pragma unroll
                    for (int b = 0; b < 17; ++b) a[b] += sc[b * 1024 + k0 + j] * w[j]; }
#pragma unroll
            for (int b = 0; b < 17; ++b) red[(kq * 17 + b) * 64 + (tid & 63)] = a[b];
            __syncthreads();
            for (int i = tid; i < 17 * 64; i += NTHR) { const int b = i >> 6, c = i & 63; float s2 = 0.f;
#pragma unroll
                for (int k = 0; k < 8; ++k) s2 += red[(k * 17 + b) * 64 + c];
                ((float*)(ws + WS_MOD))[((size_t)l * 17 + b) * 6144 + cbk * 64 + c] = s2 + p.in[I_BMOD][(size_t)l * 6144 + cbk * 64 + c]; }
            __syncthreads();
        }
    }
}

constexpr int CVT_TILES = 3072;
struct CvtT { const float* a; const float* b; unsigned char* dst; int ldsrc, K, k0, n0; };
__device__ __forceinline__ CvtT cvt_decode(const Params& p, int t) {
    const int l = t >= CVT_TILES ? 1 : 0, u = t - l * CVT_TILES; CvtT c;
    if (u < 2048) { const int e = u >> 6, q = u & 63; const size_t eo = ((size_t)l * 32 + e) * 1024 * 512;
        c.a = p.in[I_WEG] + eo; c.b = p.in[I_WEU] + eo; c.dst = p.ws + WS_WTGU + ((size_t)l * 32 + e) * 1024 * 1024; c.ldsrc = 512; c.K = 1024; c.k0 = (q >> 2) * 64; c.n0 = (q & 3) * 256; }
    else { const int v = u - 2048, e = v >> 5, q = v & 31;
        c.a = p.in[I_WED] + ((size_t)l * 32 + e) * 512 * 1024; c.b = nullptr; c.dst = p.ws + WS_WTD + ((size_t)l * 32 + e) * 1024 * 512; c.ldsrc = 1024; c.K = 512; c.k0 = (q >> 2) * 64; c.n0 = (q & 3) * 256; }
    return c;
}
__device__ __forceinline__ void cvt_load(const CvtT& c, float (&v)[32]) {
    const int tid = opaque_tid(), n = tid & 255, kb = tid >> 8, ng = c.n0 + n;
    const float* sp = (c.b ? ((ng & 128) ? c.b : c.a) + 128 * (ng >> 8) + (ng & 127) : c.a + ng) + (size_t)(c.k0 + kb) * c.ldsrc;
#pragma unroll
    for (int i = 0; i < 32; ++i) v[i] = sp[(size_t)(2 * i) * c.ldsrc];
}
__device__ __forceinline__ void cvt_finish(const CvtT& c, const float (&v)[32], LAS float* tile) {
    const int tid = opaque_tid();
    { const int n = tid & 255, kb = tid >> 8;
#pragma unroll
      for (int i = 0; i < 32; ++i) tile[(kb + 2 * i) * 257 + n] = v[i] * WSCALE8; }
    __syncthreads();
    { const int n = tid >> 1, kh = (tid & 1) * 32; unsigned char* dp = c.dst + (size_t)(c.n0 + n) * c.K + c.k0 + kh;
#pragma unroll
      for (int i = 0; i < 2; ++i) { float f[16];
#pragma unroll
          for (int j = 0; j < 16; ++j) f[j] = tile[(kh + 16 * i + j) * 257 + n];
          u32x4 w; w.x = pk4_fp8(f[0], f[1], f[2], f[3]); w.y = pk4_fp8(f[4], f[5], f[6], f[7]); w.z = pk4_fp8(f[8], f[9], f[10], f[11]); w.w = pk4_fp8(f[12], f[13], f[14], f[15]);
          *(u32x4*)(dp + 16 * i) = w; } }
}
__device__ __forceinline__ void cvt_fill(const Params& p, LAS unsigned char* lds, int t0, int t1, int r, int nr) {
    LAS float* tA = (LAS float*)lds; LAS float* tB = tA + 64 * 257 + 64;
    asm volatile("" : "+s"(r));
    float va[32], vb[32]; int t = t0 + r;
    if (t < t1) cvt_load(cvt_decode(p, t), va);
    for (; t < t1; t += 2 * nr) {
        if (t + nr < t1) cvt_load(cvt_decode(p, t + nr), vb);
        cvt_finish(cvt_decode(p, t), va, tA);
        if (t + 2 * nr < t1) cvt_load(cvt_decode(p, t + 2 * nr), va);
        if (t + nr < t1) cvt_finish(cvt_decode(p, t + nr), vb, tB);
    }
    __syncthreads();
}
constexpr int CVT_Q0 = 0, CVT_Q1 = 2240, CVT_Q2 = 2240, CVT_Q3 = 4480, CVT_Q4 = 5600;

__device__ __forceinline__ void ld_row_f32(const float* src, int lane, float (&v)[16]) {
    const f32x4 a = *(const f32x4*)(src + 8 * lane), b = *(const f32x4*)(src + 8 * lane + 4), c = *(const f32x4*)(src + 512 + 8 * lane), d = *(const f32x4*)(src + 512 + 8 * lane + 4);
#pragma unroll
    for (int j = 0; j < 4; ++j) { v[j] = a[j]; v[4 + j] = b[j]; v[8 + j] = c[j]; v[12 + j] = d[j]; }
}
__device__ __forceinline__ void st_row_f32(float* dst, int lane, const float (&v)[16]) {
    *(f32x4*)(dst + 8 * lane) = (f32x4){v[0], v[1], v[2], v[3]}; *(f32x4*)(dst + 8 * lane + 4) = (f32x4){v[4], v[5], v[6], v[7]};
    *(f32x4*)(dst + 512 + 8 * lane) = (f32x4){v[8], v[9], v[10], v[11]}; *(f32x4*)(dst + 512 + 8 * lane + 4) = (f32x4){v[12], v[13], v[14], v[15]};
}
__device__ __forceinline__ void ld_row_bf16(const bf16_t* src, int lane, float (&v)[16]) {
    const u32x4 a = *(const u32x4*)(src + 8 * lane), b = *(const u32x4*)(src + 512 + 8 * lane);
    v[0] = bf_lo(a.x); v[1] = bf_hi(a.x); v[2] = bf_lo(a.y); v[3] = bf_hi(a.y); v[4] = bf_lo(a.z); v[5] = bf_hi(a.z); v[6] = bf_lo(a.w); v[7] = bf_hi(a.w);
    v[8] = bf_lo(b.x); v[9] = bf_hi(b.x); v[10] = bf_lo(b.y); v[11] = bf_hi(b.y); v[12] = bf_lo(b.z); v[13] = bf_hi(b.z); v[14] = bf_lo(b.w); v[15] = bf_hi(b.w);
}
__device__ __forceinline__ void st_row_bf16(bf16_t* dst, int lane, const float (&v)[16]) {
    u32x4 a, b; a.x = cvtpk(v[0], v[1]); a.y = cvtpk(v[2], v[3]); a.z = cvtpk(v[4], v[5]); a.w = cvtpk(v[6], v[7]);
    b.x = cvtpk(v[8], v[9]); b.y = cvtpk(v[10], v[11]); b.z = cvtpk(v[12], v[13]); b.w = cvtpk(v[14], v[15]);
    *(u32x4*)(dst + 8 * lane) = a; *(u32x4*)(dst + 512 + 8 * lane) = b;
}
template <int MODE>
__device__ __forceinline__ void load_resid4(const Params& p, int R0, const RowInfo& q, int lmoe, int lane, float (&v)[4][16]) {
    const float* src; float* dst;
    if (q.isctx) { const size_t o = ((size_t)q.b * 256 + q.t) * 1024; src = (MODE == 0 ? p.in[I_CTX] : (const float*)(p.ws + WS_XC)) + o; dst = (float*)(p.ws + WS_XC) + o; }
    else { const size_t o = ((size_t)q.b * 2048 + q.t) * 1024; src = (MODE == 0 ? p.in[I_X] : (const float*)p.out) + o; dst = p.out + o; }
#pragma unroll
    for (int i = 0; i < 4; ++i) ld_row_f32(src + (size_t)i * 1024, lane, v[i]);
    if (MODE == 1 || MODE == 3) {
        const int* slot = (const int*)(p.ws + WS_POS) + 2 * (size_t)R0; const float* wk = (const float*)(p.ws + WS_WTK) + 2 * (size_t)R0;
        const bf16_t* ys = (const bf16_t*)(p.ws + WS_P + P_YS);
        int sl[8]; float ww[8];
#pragma unroll
        for (int i = 0; i < 8; ++i) { sl[i] = ld_i32_dev(slot + i); ww[i] = ld_f32_dev(wk + i); }
        float m5[16]; ld_row_f32((const float*)(p.ws + WS_MOD) + ((size_t)lmoe * 17 + (q.isctx ? 16 : q.b)) * 6144 + 5 * 1024, lane, m5);
        u32x4 ya[4][2], yb[4][2];
#pragma unroll
        for (int i = 0; i < 4; ++i) { const bf16_t* r1 = ys + (size_t)sl[2 * i] * 1024; const bf16_t* r2 = ys + (size_t)sl[2 * i + 1] * 1024;
            ya[i][0] = *(const u32x4*)(r1 + 8 * lane); ya[i][1] = *(const u32x4*)(r1 + 512 + 8 * lane); yb[i][0] = *(const u32x4*)(r2 + 8 * lane); yb[i][1] = *(const u32x4*)(r2 + 512 + 8 * lane); }
#pragma unroll
        for (int i = 0; i < 4; ++i) { float y1[8], y2[8];
#pragma unroll
            for (int hh = 0; hh < 2; ++hh) { unpack8(ya[i][hh], y1); unpack8(yb[i][hh], y2);
#pragma unroll
                for (int j = 0; j < 8; ++j) v[i][8 * hh + j] += m5[8 * hh + j] * (ww[2 * i] * y1[j] + ww[2 * i + 1] * y2[j]); }
            if (MODE == 1) st_row_f32(dst + (size_t)i * 1024, lane, v[i]); }
    }
}
struct RowPar { float g[16], sh[16], sc[16]; };
__device__ __forceinline__ void load_rowpar(const Params& p, int l, int which, const RowInfo& q, int lane, RowPar& rp) {
    const float* mrow = (const float*)(p.ws + WS_MOD) + ((size_t)l * 17 + (q.isctx ? 16 : q.b)) * 6144;
    ld_row_f32(p.in[which ? I_GN2 : I_GN1] + (size_t)l * 1024, lane, rp.g);
    ld_row_f32(mrow + (which ? 3 : 0) * 1024, lane, rp.sh); ld_row_f32(mrow + (which ? 4 : 1) * 1024, lane, rp.sc);
}
__device__ __forceinline__ void norm_mod_row(const RowPar& rp, int lane, const float (&v)[16], bf16_t* hrow, unsigned char* h8row = nullptr) {
    float ss = 0.f;
#pragma unroll
    for (int j = 0; j < 16; ++j) ss += v[j] * v[j];
    ss = wave_sum(ss); const float rs = rsqrtf(ss * (1.0f / 1024.0f) + EPS);
    float o[16];
#pragma unroll
    for (int j = 0; j < 16; ++j) o[j] = v[j] * rs * rp.g[j] * (1.0f + rp.sc[j]) + rp.sh[j];
    st_row_bf16(hrow, lane, o);
    if (h8row) { u32x2 a, b; a.x = pk4_fp8(o[0] * HSCALE8, o[1] * HSCALE8, o[2] * HSCALE8, o[3] * HSCALE8); a.y = pk4_fp8(o[4] * HSCALE8, o[5] * HSCALE8, o[6] * HSCALE8, o[7] * HSCALE8);
        b.x = pk4_fp8(o[8] * HSCALE8, o[9] * HSCALE8, o[10] * HSCALE8, o[11] * HSCALE8); b.y = pk4_fp8(o[12] * HSCALE8, o[13] * HSCALE8, o[14] * HSCALE8, o[15] * HSCALE8);
        *(u32x2*)(h8row + 8 * lane) = a; *(u32x2*)(h8row + 512 + 8 * lane) = b; }
}
__device__ __forceinline__ void phase_norm1(const Params& p, int l) {
    const int tid = opaque_tid(), wid = __builtin_amdgcn_readfirstlane(tid >> 6), lane = tid & 63;
    for (int gq = blockIdx.x * 8 + wid; gq < MTOT / 4; gq += gridDim.x * 8) {
        const int R0 = 4 * gq; const RowInfo q = row_info(R0); float v[4][16]; RowPar rp;
        load_rowpar(p, l, 0, q, lane, rp);
        if (l == 0) load_resid4<0>(p, R0, q, 0, lane, v); else load_resid4<1>(p, R0, q, l - 1, lane, v);
#pragma unroll
        for (int i = 0; i < 4; ++i) norm_mod_row(rp, lane, v[i], (bf16_t*)(p.ws + WS_H) + (size_t)(R0 + i) * 1024, p.ws + WS_H8 + (size_t)(R0 + i) * 1024);
    }
}
__device__ __forceinline__ void phase_final(const Params& p) {
    const int tid = opaque_tid(), wid = __builtin_amdgcn_readfirstlane(tid >> 6), lane = tid & 63;
    float g[16]; ld_row_f32(p.in[I_GFIN], lane, g);
    for (int gq = blockIdx.x * 8 + wid; gq < NBATCH * SEQ / 4; gq += gridDim.x * 8) {
        const int a = 4 * gq, R0 = (a >> 14) * MH + CTXROWS + (a & 16383);
        const RowInfo q = row_info(R0); float v[4][16];
        load_resid4<3>(p, R0, q, 1, lane, v);
#pragma unroll
        for (int i = 0; i < 4; ++i) { float ss = 0.f;
#pragma unroll
            for (int j = 0; j < 16; ++j) ss += v[i][j] * v[i][j];
            ss = wave_sum(ss); const float rs = rsqrtf(ss * (1.0f / 1024.0f) + EPS);
#pragma unroll
            for (int j = 0; j < 16; ++j) v[i][j] = v[i][j] * rs * g[j];
            st_row_f32(p.out + ((size_t)q.b * 2048 + q.t + i) * 1024, lane, v[i]); }
    }
}
__device__ __forceinline__ int active_row(int l, int a) { return l == 0 ? a : (a >> 14) * MH + CTXROWS + (a & 16383); }
typedef float f32x4v __attribute__((ext_vector_type(4)));
__device__ __forceinline__ void phase_norm2_router(const Params& p, int l, LAS unsigned char* lds) {
    const int tid = opaque_tid(), wid = tid >> 6, lane = tid & 63, G = gridDim.x, bid = blockIdx.x;
    const int NA = l == 0 ? MTOT : NBATCH * SEQ;
    const int chunk = (((NA + G - 1) / G) + 15) & ~15;
    const int a0 = bid * chunk, a1 = (a0 + chunk < NA) ? a0 + chunk : NA, na = a1 > a0 ? a1 - a0 : 0;
    LAS float* lg = (LAS float*)lds;
    LAS float* lgs = (LAS float*)(lds + 73728);
    LAS int* re = (LAS int*)(lds + 83968);
    LAS float* rw = (LAS float*)(lds + 83968 + 2048);
    LAS int* rr = (LAS int*)(lds + 83968 + 4096);
    LAS int* hist = (LAS int*)(lds + 83968 + 6144);
    LAS int* base = hist + 32;
    if (tid < 32) hist[tid] = 0;
    bf16_t* H = (bf16_t*)(p.ws + WS_H);
    PSEC_BEGINN(11);
    for (int g = wid; g * 16 < na; g += 8)
        for (int i = 0; i < 16; i += 4) { const int a = a0 + g * 16 + i; if (a >= a1) break;
            const int R0 = active_row(l, a); const RowInfo q = row_info(R0); float v[4][16]; RowPar rp;
            load_rowpar(p, l, 1, q, lane, rp);
            load_resid4<2>(p, R0, q, 0, lane, v);
#pragma unroll
            for (int k = 0; k < 4; ++k) norm_mod_row(rp, lane, v[k], H + (size_t)(R0 + k) * 1024); }
    asm volatile("s_waitcnt vmcnt(0)" ::: "memory"); __syncthreads();
    PSEC(11);
    const bf16_t* Wr = (const bf16_t*)(p.ws + WS_WRT) + (size_t)l * 2 * 48 * 1024;
    const float* brg = p.in[I_BRG] + l * 4; const float* bre = p.in[I_BRE] + l * 32;
    const int ng = (na + 15) >> 4, r16 = lane & 15, kq = lane >> 4;
    LAS float* brl = (LAS float*)(lds + 83968 + 6144 + 512);
    if (tid < 36) brl[tid] = tid < 4 ? brg[tid] : bre[tid - 4];
    if (ng > 0) {
        bf16x8 bh[4][3], bl[4][3];
        { const bf16_t* bp = Wr + (size_t)r16 * 1024 + 128 * wid + 8 * kq;
#pragma unroll
          for (int ks = 0; ks < 4; ++ks)
#pragma unroll
              for (int ct = 0; ct < 3; ++ct) { bh[ks][ct] = *(const bf16x8*)(bp + (size_t)ct * 16 * 1024 + ks * 32); bl[ks][ct] = *(const bf16x8*)(bp + (size_t)(48 + ct * 16) * 1024 + ks * 32); } }
        __builtin_amdgcn_sched_barrier(0);
#pragma unroll 1
        for (int g0 = 0; g0 < ng; g0 += 3) {
            bf16x8 a[3][4];
#pragma unroll
            for (int gq = 0; gq < 3; ++gq) { int ar = a0 + (g0 + gq) * 16 + r16; if (ar >= a1) ar = a1 - 1;
                const bf16_t* ap = H + (size_t)active_row(l, ar) * 1024 + 128 * wid + 8 * kq;
#pragma unroll
                for (int ks = 0; ks < 4; ++ks) a[gq][ks] = *(const bf16x8*)(ap + ks * 32); }
            __builtin_amdgcn_sched_barrier(0);
#pragma unroll
            for (int gq = 0; gq < 3; ++gq) {
                f32x4v acc[3] = {{0.f, 0.f, 0.f, 0.f}, {0.f, 0.f, 0.f, 0.f}, {0.f, 0.f, 0.f, 0.f}};
#pragma unroll
                for (int ks = 0; ks < 4; ++ks)
#pragma unroll
                    for (int ct = 0; ct < 3; ++ct) { acc[ct] = __builtin_amdgcn_mfma_f32_16x16x32_bf16(a[gq][ks], bh[ks][ct], acc[ct], 0, 0, 0); acc[ct] = __builtin_amdgcn_mfma_f32_16x16x32_bf16(a[gq][ks], bl[ks][ct], acc[ct], 0, 0, 0); }
#pragma unroll
                for (int ct = 0; ct < 3; ++ct)
#pragma unroll
                    for (int r = 0; r < 4; ++r) lg[((gq * 8 + wid) * 16 + 4 * kq + r) * 48 + ct * 16 + r16] = acc[ct][r];
            }
            __syncthreads();
            for (int o = tid; o < 3 * 768; o += NTHR) { const int gq = o >= 1536 ? 2 : (o >= 768 ? 1 : 0), rem = o - gq * 768; float s = 0.f;
#pragma unroll
                for (int w = 0; w < 8; ++w) s += lg[(gq * 8 + w) * 768 + rem];
                lgs[o] = s; }
            __syncthreads();
            if (tid < 48) {
                const int a = a0 + (g0 + (tid >> 4)) * 16 + (tid & 15);
                if (g0 + (tid >> 4) < ng && a < a1) {
                    const LAS float* x = lgs + tid * 48;
                    float gl[4]; int gs = 0; float gmax;
#pragma unroll
                    for (int j = 0; j < 4; ++j) gl[j] = x[j] + brl[j];
                    gmax = gl[0];
#pragma unroll
                    for (int j = 1; j < 4; ++j) if (gl[j] > gmax) { gmax = gl[j]; gs = j; }
                    float gsum = 0.f;
#pragma unroll
                    for (int j = 0; j < 4; ++j) gsum += __expf(gl[j] - gmax);
                    const float pg = 1.0f / gsum;
                    float v1 = -3.0e38f, v2 = -3.0e38f; int i1 = 0, i2 = 0;
                    for (int j = 0; j < 8; ++j) { const float ev = x[4 + gs * 8 + j] + brl[4 + gs * 8 + j];
                        if (ev > v1) { v2 = v1; i2 = i1; v1 = ev; i1 = j; } else if (ev > v2) { v2 = ev; i2 = j; } }
                    const float t = __expf(v2 - v1); const float w1 = pg / (1.0f + t), w2 = pg * t / (1.0f + t);
                    const int e1 = gs * 8 + i1, e2 = gs * 8 + i2, i = a - a0;
                    re[i] = e1; re[256 + i] = e2; rw[i] = w1; rw[256 + i] = w2;
                }
            }
            __syncthreads();
        }
    }
    __syncthreads();
    PSEC(12);
    if (tid < 32) { int c = 0; for (int i = 0; i < na; ++i) { if (re[i] == tid) rr[i] = c++; if (re[256 + i] == tid) rr[256 + i] = c++; } hist[tid] = c; }
    __syncthreads();
    int* hg = (int*)(p.ws + WS_CTL) + CW_HIST + (l * 256 + bid) * 32;
    if (tid < 32) hg[tid] = hist[tid];
    (void)base;
    int* EID = (int*)(p.ws + WS_EID); float* WTK = (float*)(p.ws + WS_WTK); int* POS = (int*)(p.ws + WS_POS);
    for (int i = tid; i < na; i += NTHR) { const size_t R = (size_t)active_row(l, a0 + i);
        EID[2 * R] = re[i]; EID[2 * R + 1] = re[256 + i]; WTK[2 * R] = rw[i]; WTK[2 * R + 1] = rw[256 + i];
        POS[2 * R] = rr[i]; POS[2 * R + 1] = rr[256 + i]; }
    __syncthreads();
    PSEC(13);
}
__device__ __forceinline__ void moe_segments(const Params& p, int l, LAS int* seg, int myblk) {
    const int tid = opaque_tid(); LAS int* cnt = seg + 40; LAS int* pre = seg + 80;
    if (tid < 32) { const int* hg = (const int*)(p.ws + WS_CTL) + CW_HIST + l * 256 * 32 + tid; int tot = 0, pr = 0; const int nb = (int)gridDim.x;
        for (int b = 0; b < nb; ++b) { const int c = hg[b * 32]; if (b < myblk) pr += c; tot += c; }
        cnt[tid] = tot; pre[tid] = pr; }
    __syncthreads();
    if (tid == 0) { int s = 0; for (int e = 0; e < 32; ++e) { seg[e] = s; s += (cnt[e] + 255) & ~255; } if (s > SLOTS) s = SLOTS; seg[32] = s; }
    __syncthreads();
}
__device__ __forceinline__ void phase_dispatch(const Params& p, int l, LAS unsigned char* lds) {
    const int tid = opaque_tid(), wid = tid >> 6, lane = tid & 63, G = gridDim.x, bid = blockIdx.x;
    LAS int* seg = (LAS int*)lds; moe_segments(p, l, seg, bid); const LAS int* pre = seg + 80;
    const int NA = l == 0 ? MTOT : NBATCH * SEQ;
    const int chunk = (((NA + G - 1) / G) + 15) & ~15;
    const int a0 = bid * chunk, a1 = (a0 + chunk < NA) ? a0 + chunk : NA;
    const bf16_t* H = (const bf16_t*)(p.ws + WS_H); unsigned char* XB = p.ws + WS_P + P_XB;
    const int* EID = (const int*)(p.ws + WS_EID); const float* WTK = (const float*)(p.ws + WS_WTK); int* POS = (int*)(p.ws + WS_POS); float* WTS = (float*)(p.ws + WS_WTS);
    for (int a = a0 + 4 * wid; a < a1; a += 32) {
        const size_t R0 = (size_t)active_row(l, a);
        u32x2 h0[4], h1[4]; int ee[8], pp[8]; float ww[8];
#pragma unroll
        for (int i = 0; i < 4; ++i) { float a[8], b[8]; unpack8(*(const u32x4*)(H + (R0 + i) * 1024 + 8 * lane), a); unpack8(*(const u32x4*)(H + (R0 + i) * 1024 + 512 + 8 * lane), b);

#pragma unroll
            for (int j = 0; j < 8; ++j) { a[j] *= HSCALE8; b[j] *= HSCALE8; }
            h0[i].x = pk4_fp8(a[0], a[1], a[2], a[3]); h0[i].y = pk4_fp8(a[4], a[5], a[6], a[7]); h1[i].x = pk4_fp8(b[0], b[1], b[2], b[3]); h1[i].y = pk4_fp8(b[4], b[5], b[6], b[7]); }
#pragma unroll
        for (int i = 0; i < 8; ++i) { ee[i] = ld_i32_dev(EID + 2 * R0 + i); pp[i] = ld_i32_dev(POS + 2 * R0 + i); ww[i] = ld_f32_dev(WTK + 2 * R0 + i); }
#pragma unroll
        for (int i = 0; i < 8; ++i) { const int s = seg[ee[i]] + pre[ee[i]] + pp[i];
            *(u32x2*)(XB + (size_t)s * 1024 + 8 * lane) = h0[i >> 1]; *(u32x2*)(XB + (size_t)s * 1024 + 512 + 8 * lane) = h1[i >> 1];
            if (lane == 0) { POS[2 * R0 + i] = s; WTS[s] = ww[i]; } }
    }
    __syncthreads();
}
__device__ __forceinline__ int moe_tile_table(const Params& p, int l, LAS int* seg, LAS int* tile_e) {
    moe_segments(p, l, seg, 0);
    const int nt = seg[32] >> 8;
    for (int i = opaque_tid(); i < nt; i += NTHR) { int e = 0; for (int k = 1; k < 32; ++k) if ((i << 8) >= seg[k]) e = k; tile_e[i] = e; }
    __syncthreads();
    return __builtin_amdgcn_readfirstlane(nt);
}
__device__ __forceinline__ void lds_addf(LAS float* a, float v) { (void)__hip_atomic_fetch_add(a, v, __ATOMIC_RELAXED, __HIP_MEMORY_SCOPE_WORKGROUP); }
__device__ __forceinline__ bf16_t* pbuf(const Params& p, size_t off) { return (bf16_t*)(p.ws + WS_P + off); }
#ifndef MMU
#define MMU 2
#endif
__device__ __forceinline__ void mm128(const LAS bf16_t* A, const LAS bf16_t* Bt, f32x16 (&acc)[2], int wid, int lane) {
    const int r32 = lane & 31, hi = lane >> 5;
    const LAS bf16_t* ap = A + (32 * (wid >> 1) + r32) * TLD + hi * 8;
    const LAS bf16_t* bp = Bt + (64 * (wid & 1) + r32) * TLD + hi * 8;
#pragma unroll MMU
    for (int ks = 0; ks < 8; ++ks) {
        const bf16x8 a = *(const LAS bf16x8*)(ap + ks * 16), b0 = *(const LAS bf16x8*)(bp + ks * 16), b1 = *(const LAS bf16x8*)(bp + 32 * TLD + ks * 16);
        acc[0] = mfma32(a, b0, acc[0]); acc[1] = mfma32(a, b1, acc[1]);
    }
}
__device__ __forceinline__ void mm128_gB(const LAS bf16_t* A, const bf16_t* __restrict__ Bg, f32x16 (&acc)[2], int wid, int lane) {
    const int r32 = lane & 31, hi = lane >> 5;
    const LAS bf16_t* ap = A + (32 * (wid >> 1) + r32) * TLD + hi * 8;
    const bf16_t* bp = Bg + (64 * (wid & 1) + r32) * 128 + hi * 8;
#pragma unroll MMU
    for (int ks = 0; ks < 8; ++ks) {
        const bf16x8 a = *(const LAS bf16x8*)(ap + ks * 16), b0 = *(const bf16x8*)(bp + ks * 16), b1 = *(const bf16x8*)(bp + 32 * 128 + ks * 16);
        acc[0] = mfma32(a, b0, acc[0]); acc[1] = mfma32(a, b1, acc[1]);
    }
}
__device__ __forceinline__ void st_acc_T(LAS bf16_t* T, const f32x16 (&acc)[2], int wid, int lane) {
    const int r32 = lane & 31, hi = lane >> 5;
#pragma unroll
    for (int tl = 0; tl < 2; ++tl)
#pragma unroll
        for (int g = 0; g < 4; ++g) { u32x2 w; w.x = cvtpk(acc[tl][4 * g], acc[tl][4 * g + 1]); w.y = cvtpk(acc[tl][4 * g + 2], acc[tl][4 * g + 3]);
            *(LAS u32x2*)(T + (64 * (wid & 1) + 32 * tl + r32) * TLD + 32 * (wid >> 1) + 8 * g + 4 * hi) = w; }
}

__device__ __forceinline__ void st_acc_rm(LAS bf16_t* T, const f32x16 (&acc)[2], int wid, int lane) {
    const int r32 = lane & 31, hi = lane >> 5;
    LAS bf16_t* b = T + (32 * (wid >> 1) + 4 * hi) * TLD + 64 * (wid & 1) + r32;
#pragma unroll
    for (int tl = 0; tl < 2; ++tl)
#pragma unroll
        for (int r = 0; r < 16; ++r) b[((r & 3) + 8 * (r >> 2)) * TLD + 32 * tl] = (bf16_t)(cvtpk(acc[tl][r], acc[tl][r]) & 0xffffu);
}
constexpr int FLD = 132;
__device__ __forceinline__ void st_acc_f32(LAS float* F, const f32x16 (&acc)[2], int wid, int lane) {
    const int r32 = lane & 31, hi = lane >> 5;
    LAS float* b = F + (32 * (wid >> 1) + 4 * hi) * FLD + 64 * (wid & 1) + r32;
#pragma unroll
    for (int tl = 0; tl < 2; ++tl)
#pragma unroll
        for (int r = 0; r < 16; ++r) b[((r & 3) + 8 * (r >> 2)) * FLD + 32 * tl] = acc[tl][r];
}
__device__ __forceinline__ void copy_tile_out(const LAS bf16_t* T, bf16_t* dst, int ld) {
    const int tx = opaque_tid(), t = tx >> 2, c0 = (tx & 3) * 32;
#pragma unroll
    for (int i = 0; i < 4; ++i) *(u32x4*)(dst + (size_t)t * ld + c0 + 8 * i) = *(const LAS u32x4*)(T + t * TLD + c0 + 8 * i);
}

__device__ __forceinline__ bool seq_start(int r) { return r < CTXROWS ? (r & 255) == 0 : ((r - CTXROWS) & 2047) == 0; }
template <int CTRL> __device__ __forceinline__ u32x4 dpp4(const u32x4 v) { u32x4 o;
    o.x = (unsigned)__builtin_amdgcn_update_dpp(0, (int)v.x, CTRL, 0xf, 0xf, true); o.y = (unsigned)__builtin_amdgcn_update_dpp(0, (int)v.y, CTRL, 0xf, 0xf, true);
    o.z = (unsigned)__builtin_amdgcn_update_dpp(0, (int)v.z, CTRL, 0xf, 0xf, true); o.w = (unsigned)__builtin_amdgcn_update_dpp(0, (int)v.w, CTRL, 0xf, 0xf, true); return o; }
__device__ __forceinline__ void phase_conv(const Params& p, int l, LAS unsigned char* lds) {
    const int tid = opaque_tid(), wid = __builtin_amdgcn_readfirstlane(tid >> 6), lane = tid & 63, r16 = lane & 15, kg = lane >> 4, G = gridDim.x, bid = blockIdx.x;
    constexpr int NG = MH / 16, NU = 5;
    const bf16_t* XM = pbuf(p, P_XMB); bf16_t* XCV = pbuf(p, P_XCV); float* GT = (float*)(p.ws + WS_P + P_GATES);
    LAS float* PX = (LAS float*)lds;
    for (int g0 = bid; g0 < NG; g0 += NU * G) {
        f32x4v acc[NU];
#pragma unroll
        for (int u = 0; u < NU; ++u) acc[u] = (f32x4v){0.f, 0.f, 0.f, 0.f};
#pragma unroll 1
        for (int ks = 0; ks < 2; ++ks) {
            const int c = 64 * wid + 32 * ks + 8 * kg;
            u32x4 cur[NU], edge[NU];
#pragma unroll
            for (int u = 0; u < NU; ++u) { const int g = g0 + G * u; const bool valid = g < NG; const int row = 16 * g + r16;
                cur[u] = valid ? *(const u32x4*)(XM + (size_t)row * 512 + c) : (u32x4){0u, 0u, 0u, 0u};
                const bool he = valid && ((r16 == 0 && !seq_start(16 * g)) || (r16 == 15 && !seq_start(16 * g + 16)));
                const int er = r16 == 0 ? row - 1 : row + 1;
                edge[u] = he ? *(const u32x4*)(XM + (size_t)er * 512 + c) : (u32x4){0u, 0u, 0u, 0u}; }
            float w0[8], w1[8], w2[8], bc[8];
            { const float* wc = p.in[I_WCONV] + (size_t)l * 3 * 512 + c; const float* bcp = p.in[I_BCONV] + (size_t)l * 512 + c;
#pragma unroll
              for (int j = 0; j < 8; ++j) { w0[j] = wc[j]; w1[j] = wc[512 + j]; w2[j] = wc[1024 + j]; bc[j] = bcp[j]; } }
            bf16x8 wyh, wyl, wxh, wxl;
            { const float* wf = (const float*)(p.ws + WS_WFOLD) + ((size_t)l * 16 + r16) * 1024 + c; float a[8], b[8], t8[8];
#pragma unroll
              for (int j = 0; j < 8; ++j) { a[j] = wf[j]; b[j] = wf[512 + j]; }
              u32x4 hh = pack8(a); unpack8(hh, t8);
#pragma unroll
              for (int j = 0; j < 8; ++j) t8[j] = a[j] - t8[j];
              u32x4 ll = pack8(t8); wyh = *(const bf16x8*)&hh; wyl = *(const bf16x8*)&ll;
              hh = pack8(b); unpack8(hh, t8);
#pragma unroll
              for (int j = 0; j < 8; ++j) t8[j] = b[j] - t8[j];
              ll = pack8(t8); wxh = *(const bf16x8*)&hh; wxl = *(const bf16x8*)&ll; }
#pragma unroll
            for (int u = 0; u < NU; ++u) { const int g = g0 + G * u;
                const u32x4 sp = dpp4<0x111>(cur[u]), sn = dpp4<0x101>(cur[u]);
                u32x4 pw, nw;
                pw.x = r16 == 0 ? edge[u].x : sp.x; pw.y = r16 == 0 ? edge[u].y : sp.y; pw.z = r16 == 0 ? edge[u].z : sp.z; pw.w = r16 == 0 ? edge[u].w : sp.w;
                nw.x = r16 == 15 ? edge[u].x : sn.x; nw.y = r16 == 15 ? edge[u].y : sn.y; nw.z = r16 == 15 ? edge[u].z : sn.z; nw.w = r16 == 15 ? edge[u].w : sn.w;
                float xp[8], xc[8], xn[8], y[8], yl[8]; unpack8(pw, xp); unpack8(cur[u], xc); unpack8(nw, xn);
#pragma unroll
                for (int j = 0; j < 8; ++j) y[j] = silu_f(w0[j] * xp[j] + w1[j] * xc[j] + w2[j] * xn[j] + bc[j]);
                const u32x4 yh = pack8(y); unpack8(yh, yl);
#pragma unroll
                for (int j = 0; j < 8; ++j) yl[j] = y[j] - yl[j];
                const u32x4 ylw = pack8(yl);
                const bf16x8 ah = *(const bf16x8*)&yh, al = *(const bf16x8*)&ylw, ax = *(const bf16x8*)&cur[u];
                acc[u] = __builtin_amdgcn_mfma_f32_16x16x32_bf16(ah, wyh, acc[u], 0, 0, 0); acc[u] = __builtin_amdgcn_mfma_f32_16x16x32_bf16(ah, wyl, acc[u], 0, 0, 0);
                acc[u] = __builtin_amdgcn_mfma_f32_16x16x32_bf16(al, wyh, acc[u], 0, 0, 0);
                acc[u] = __builtin_amdgcn_mfma_f32_16x16x32_bf16(ax, wxh, acc[u], 0, 0, 0); acc[u] = __builtin_amdgcn_mfma_f32_16x16x32_bf16(ax, wxl, acc[u], 0, 0, 0);
                if (g < NG) *(u32x4*)(XCV + (size_t)(16 * g + r16) * 512 + c) = yh; }
        }
#pragma unroll
        for (int u = 0; u < NU; ++u)
#pragma unroll
            for (int r = 0; r < 4; ++r) PX[((u * 8 + wid) * 16 + 4 * kg + r) * 16 + r16] = acc[u][r];
        __syncthreads();
        for (int o = tid; o < NU * 256; o += NTHR) { const int u = o >> 8, row = (o >> 4) & 15, n = o & 15, g = g0 + G * u; float s = p.in[I_BIF][l * 16 + n];
#pragma unroll
            for (int w = 0; w < 8; ++w) s += PX[((u * 8 + w) * 16 + row) * 16 + n];
            if (g < NG) GT[(size_t)(16 * g + row) * 16 + (n & 3) * 4 + (n >> 2)] = s; }
        __syncthreads();
    }
}
__device__ __forceinline__ void ld8row(const bf16_t* base, int pos, int seqlen, float (&o)[8]) {
    if (pos < 0 || pos >= seqlen) {
#pragma unroll
        for (int j = 0; j < 8; ++j) o[j] = 0.f; }
    else unpack8(*(const u32x4*)(base + (size_t)pos * 512), o);
}
__device__ __forceinline__ void mlstm_a_ids(int u, int& bl, int& J, int& h, int& r0) {
    bl = u / (NJ * 4); const int rem = u - bl * (NJ * 4); J = rem >> 2; h = rem & 3;
    r0 = (J < 2 ? bl * 256 : CTXROWS + bl * 2048) + (J < 2 ? J * 128 : (J - 2) * 128);
}
#define APRE_PARAMS u32x4 (&qa)[4], u32x4 (&qb)[4], u32x4 (&qwq)[4], u32x4 (&qwk)[4], u32x4 (&qwv)[4], f32x4& qg
#define APRE_ARGS qa, qb, qwq, qwk, qwv, qg
__device__ __forceinline__ void mlstm_a_load(const Params& p, int l, int u, APRE_PARAMS) {
    const int tid = opaque_tid(); int bl, J, h, r0; mlstm_a_ids(u, bl, J, h, r0);
    const int t = tid >> 2, cc = (tid & 3) * 32; const size_t o = (size_t)(r0 + t) * 512 + h * 128 + cc;
    const bf16_t* XM = pbuf(p, P_XMB) + o; const bf16_t* XCV = pbuf(p, P_XCV) + o;
    const bf16_t* Wq = (const bf16_t*)(p.ws + WS_WTQKV) + ((size_t)(l * 3) * 4 + h) * 16384 + t * 128 + cc;
#pragma unroll
    for (int i = 0; i < 4; ++i) { qa[i] = *(const u32x4*)(XCV + 8 * i); qb[i] = *(const u32x4*)(XM + 8 * i);
        qwq[i] = *(const u32x4*)(Wq + 8 * i); qwk[i] = *(const u32x4*)(Wq + (size_t)4 * 16384 + 8 * i); qwv[i] = *(const u32x4*)(Wq + (size_t)8 * 16384 + 8 * i); }
    qg = *(const f32x4*)((const float*)(p.ws + WS_P + P_GATES) + (size_t)(r0 + (tid & 127)) * 16 + h * 4);
}
__device__ __forceinline__ void mlstm_a_unit(const Params& p, int l, int u, int unext, int n_a, APRE_PARAMS, LAS unsigned char* lds) {
    int tid_ = threadIdx.x; asm volatile("" : "+v"(tid_));
    const int tid = tid_, wid = __builtin_amdgcn_readfirstlane(tid >> 6), lane = tid & 63, r32 = lane & 31, hi = lane >> 5;
    LAS bf16_t* T0 = (LAS bf16_t*)lds; LAS bf16_t* T1 = (LAS bf16_t*)(lds + TILE_B); LAS bf16_t* T2 = (LAS bf16_t*)(lds + 2 * TILE_B); LAS bf16_t* T3 = (LAS bf16_t*)(lds + 3 * TILE_B);
    LAS float* gl = (LAS float*)(lds + 4 * TILE_B);
    LAS float* wend = gl + 512;
    int bl, J, h, r0; mlstm_a_ids(u, bl, J, h, r0);
    const int wr_ = tid >> 2, wc_ = (tid & 3) * 32;
    u32x4 wv_[4];
#pragma unroll
    for (int i = 0; i < 4; ++i) { *(LAS u32x4*)(T0 + wr_ * TLD + wc_ + 8 * i) = qa[i]; *(LAS u32x4*)(T1 + wr_ * TLD + wc_ + 8 * i) = qb[i];
        *(LAS u32x4*)(T2 + wr_ * TLD + wc_ + 8 * i) = qwq[i]; *(LAS u32x4*)(T3 + wr_ * TLD + wc_ + 8 * i) = qwk[i]; wv_[i] = qwv[i]; }
    if (tid < 128) *(LAS f32x4*)(gl + tid * 4) = qg;
    LBAR();
    if (wid < 2) {
        const int dir = wid, p0 = 2 * lane, p1 = p0 + 1, s0 = dir ? 127 - p0 : p0, s1 = dir ? 127 - p1 : p1;
        const float ig0 = gl[s0 * 4 + 2 * dir], ig1 = gl[s1 * 4 + 2 * dir];
        const float lf0 = logsigmoid_f(gl[s0 * 4 + 2 * dir + 1]), lf1 = logsigmoid_f(gl[s1 * 4 + 2 * dir + 1]);
        float incl = lf0 + lf1;
        for (int o = 1; o < 64; o <<= 1) { const float t = __shfl_up(incl, o); if (lane >= o) incl += t; }
        const float bc1 = incl, bc0 = incl - lf1, gg = __shfl(incl, 63);
        const float ae0 = gg - bc0 + ig0, ae1 = gg - bc1 + ig1; const float ml = wave_max(fmaxf(ae0, ae1));
        wend[dir * 128 + s0] = __expf(ae0 - ml); wend[dir * 128 + s1] = __expf(ae1 - ml);
        if (lane == 0) { float* mst = (float*)(p.ws + WS_P + P_MST) + ((size_t)(((bl * 4 + h) * 2 + dir) * NJ + J)) * 4; mst[0] = ml; mst[1] = gg; }
    }
    f32x16 ack[2] = {};
    {
        f32x16 acq[2] = {}, akp[2] = {};
        mm128(T2, T0, acq, wid, lane); mm128(T0, T3, ack, wid, lane); mm128(T3, T0, akp, wid, lane);
        LBAR();
        st_acc_T(T2, acq, wid, lane); st_acc_T(T3, akp, wid, lane);
#pragma unroll
        for (int i = 0; i < 4; ++i) *(LAS u32x4*)(T0 + wr_ * TLD + wc_ + 8 * i) = wv_[i];
    }
    LBAR();
    copy_tile_out(T2, pbuf(p, P_MQ) + (size_t)r0 * 512 + h * 128, 512);
    copy_tile_out(T3, pbuf(p, P_MK) + (size_t)r0 * 512 + h * 128, 512);
    {
        f32x16 acv[2] = {}; mm128(T1, T0, acv, wid, lane);
        LBAR();
        st_acc_T(T2, ack, wid, lane); st_acc_T(T3, acv, wid, lane);
    }
    mlstm_a_load(p, l, unext < n_a ? unext : u, APRE_ARGS);
    LBAR();
    {
        bf16_t* MVT = pbuf(p, P_MVT) + ((size_t)((bl * NJ + J) * 4 + h)) * 16384; const int d = tid >> 2, s0 = (tid & 3) * 32;
#pragma unroll
        for (int i = 0; i < 4; ++i) *(u32x4*)(MVT + d * 128 + s0 + 8 * i) = *(const LAS u32x4*)(T3 + d * TLD + s0 + 8 * i);
    }
#pragma unroll 1
    for (int dir = 0; dir < 2; ++dir) {
        const int combo = (bl * 4 + h) * 2 + dir;
        f32x16 acc[2] = {};
        const LAS bf16_t* ap = T3 + (32 * (wid >> 1) + r32) * TLD + hi * 8; const LAS bf16_t* bp = T2 + (64 * (wid & 1) + r32) * TLD + hi * 8;
        const LAS float* wv = wend + dir * 128 + hi * 8;
#pragma unroll
        for (int ks = 0; ks < 8; ++ks) {
            float a8[8]; unpack8(*(const LAS u32x4*)(ap + ks * 16), a8);
            const f32x4 wa = *(const LAS f32x4*)(wv + ks * 16), wb = *(const LAS f32x4*)(wv + ks * 16 + 4);
#pragma unroll
            for (int j = 0; j < 4; ++j) { a8[j] *= wa[j]; a8[4 + j] *= wb[j]; }
            const u32x4 aw = pack8(a8); const bf16x8 a = *(const bf16x8*)&aw;
            const bf16x8 b0 = *(const LAS bf16x8*)(bp + ks * 16), b1 = *(const LAS bf16x8*)(bp + 32 * TLD + ks * 16);
            acc[0] = mfma32(a, b0, acc[0]); acc[1] = mfma32(a, b1, acc[1]);
        }
        bf16_t* CL = (bf16_t*)(p.ws + WS_P + P_CLOC) + ((size_t)combo * NJ + J) * 16384;
        LAS float* F = (LAS float*)lds;
        st_acc_f32(F, acc, wid, lane);
        LBAR();
        { const int d = tid >> 2, e0 = (tid & 3) * 32;
#pragma unroll
          for (int i = 0; i < 4; ++i) { const f32x4 a = *(const LAS f32x4*)(F + d * FLD + e0 + 8 * i), b = *(const LAS f32x4*)(F + d * FLD + e0 + 8 * i + 4);
              u32x4 w; w.x = cvtpk(a[0], a[1]); w.y = cvtpk(a[2], a[3]); w.z = cvtpk(b[0], b[1]); w.w = cvtpk(b[2], b[3]);
              *(u32x4*)(CL + d * 128 + e0 + 8 * i) = w; } }
        LBAR();
    }
    if (tid < 256) { const int dir = tid >> 7, e = tid & 127; float s = 0.f;
#pragma unroll 4
        for (int j = 0; j < 128; j += 8) { float k8[8]; unpack8(*(const LAS u32x4*)(T2 + e * TLD + j), k8);
            const f32x4 wa = *(const LAS f32x4*)(wend + dir * 128 + j), wb = *(const LAS f32x4*)(wend + dir * 128 + j + 4);
#pragma unroll
            for (int i = 0; i < 4; ++i) s += wa[i] * k8[i] + wb[i] * k8[4 + i]; }
        ((float*)(p.ws + WS_P + P_NLOC))[((size_t)(((bl * 4 + h) * 2 + dir) * NJ + J)) * 128 + e] = s; }
    LBAR();
}

__device__ __forceinline__ int scan_J(int dir, int pidx) { return dir == 0 ? pidx : (pidx == 0 ? 1 : (pidx == 1 ? 0 : 19 - pidx)); }
__device__ __forceinline__ void phase_scan(const Params& p) {
    const int NIT = 64 * 2112;
    bf16_t* CL = (bf16_t*)(p.ws + WS_P + P_CLOC); float* NL = (float*)(p.ws + WS_P + P_NLOC); float* MST = (float*)(p.ws + WS_P + P_MST);
    const int tid = opaque_tid();
    for (int w = blockIdx.x * NTHR + tid; w < NIT; w += gridDim.x * NTHR) {
        const int combo = w / 2112, q = w - combo * 2112, dir = combo & 1;
        float m_st = 0.f;
        if (q < 2048) {
            float st[8];
#pragma unroll
            for (int j = 0; j < 8; ++j) st[j] = 0.f;
            bf16_t* base = CL + (size_t)combo * NJ * 16384 + 8 * q;
#pragma unroll 1
            for (int i = 0; i < NJ; ++i) {
                const int J = scan_J(dir, i); float* ms = MST + ((size_t)combo * NJ + J) * 4;
                const u32x4 vc = *(const u32x4*)(base + (size_t)J * 16384);
                const float ml = ms[0], gg = ms[1];
                const float m_new = fmaxf(gg + m_st, ml), a_old = __expf(gg + m_st - m_new), a_new = __expf(ml - m_new);
                *(u32x4*)(base + (size_t)J * 16384) = pack8(st);
                if (q == 0) ms[2] = m_st;
                float c8[8]; unpack8(vc, c8);
#pragma unroll
                for (int j = 0; j < 8; ++j) st[j] = st[j] * a_old + c8[j] * a_new;
                m_st = m_new;
            }
        } else if (q < 2080) {
            float* base = NL + (size_t)combo * NJ * 128 + 4 * (q - 2048);
            f32x4 s4 = {0.f, 0.f, 0.f, 0.f};
#pragma unroll 1
            for (int i = 0; i < NJ; ++i) {
                const int J = scan_J(dir, i); const float* ms = MST + ((size_t)combo * NJ + J) * 4;
                const f32x4 vc = *(const f32x4*)(base + (size_t)J * 128);
                const float ml = ms[0], gg = ms[1];
                const float m_new = fmaxf(gg + m_st, ml), a_old = __expf(gg + m_st - m_new), a_new = __expf(ml - m_new);
                *(f32x4*)(base + (size_t)J * 128) = s4;
                s4 = s4 * a_old + vc * a_new; m_st = m_new;
            }
        }
    }
}

__device__ __forceinline__ unsigned zap_nf(unsigned w) { if ((w & 0x7f80u) >= 0x4980u) w &= 0xffff0000u; if ((w & 0x7f800000u) >= 0x49800000u) w &= 0x0000ffffu; return w; }
template <int dir>
__device__ __forceinline__ void mlstm_c_dir(const unsigned (&Xp)[4][8], f32x16 (&acc)[2], const LAS bf16_t* Tq, const LAS bf16_t* Tc, const LAS bf16_t* Tv,
                                            const LAS float* av, const LAS float* Mv, const LAS float* wi, LAS float* denw, const LAS float* n0l, int wid, int lane) {
    const int r32 = lane & 31, hi = lane >> 5, tb = wid >> 1, t = 32 * tb + r32;
    acc[0] = f32x16{}; acc[1] = f32x16{};
    mm128(Tq, Tc, acc, wid, lane);
#pragma unroll
    for (int r = 0; r < 16; ++r) { const float w = wi[dir * 128 + 32 * tb + crow(r, hi)]; acc[0][r] *= w; acc[1][r] *= w; }
    float nq = 0.f;
#pragma unroll
    for (int i = 0; i < 8; ++i) { float q8[8]; unpack8(*(const LAS u32x4*)(Tq + t * TLD + 64 * hi + 8 * i), q8);
        const f32x4 na = *(const LAS f32x4*)(n0l + dir * 128 + 64 * hi + 8 * i), nb = *(const LAS f32x4*)(n0l + dir * 128 + 64 * hi + 8 * i + 4);
#pragma unroll
        for (int j = 0; j < 4; ++j) nq += na[j] * q8[j] + nb[j] * q8[4 + j]; }
    const float Mt = Mv[dir * 128 + t]; float den = 0.f;
    const LAS bf16_t* vp = Tv + (64 * (wid & 1) + r32) * TLD + 4 * hi;
#pragma unroll
    for (int sb = 0; sb < 4; ++sb) {
        float o[16];
#pragma unroll
        for (int r = 0; r < 16; ++r) { const int s = 32 * sb + crow(r, hi); const bool ok = dir ? (s >= t) : (s <= t);
            const float xs = (r & 1) ? bf_hi(Xp[sb][r >> 1]) : bf_lo(Xp[sb][r >> 1]);
            const float ev = xs * __builtin_amdgcn_exp2f((av[dir * 128 + s] - Mt) * LOG2E);
            o[r] = ok ? ev : 0.f; den += o[r]; }
#pragma unroll
        for (int s2 = 0; s2 < 2; ++s2) {
            u32x4 aw; aw.x = cvtpk(o[8 * s2 + 0], o[8 * s2 + 1]); aw.y = cvtpk(o[8 * s2 + 2], o[8 * s2 + 3]); aw.z = cvtpk(o[8 * s2 + 4], o[8 * s2 + 5]); aw.w = cvtpk(o[8 * s2 + 6], o[8 * s2 + 7]);
            const bf16x8 af = *(const bf16x8*)&aw;
#pragma unroll
            for (int tl = 0; tl < 2; ++tl) { const LAS bf16_t* bp = vp + 32 * tl * TLD + 32 * sb + 16 * s2;
                const u32x2 b0 = *(const LAS u32x2*)bp, b1 = *(const LAS u32x2*)(bp + 8); u32x4 bw; bw.x = b0.x; bw.y = b0.y; bw.z = b1.x; bw.w = b1.y;
                acc[tl] = mfma32(af, *(const bf16x8*)&bw, acc[tl]); }
        }
        __builtin_amdgcn_sched_barrier(0);
    }
    { auto rr = __builtin_amdgcn_permlane32_swap(__float_as_uint(den), __float_as_uint(den), false, false); den = __uint_as_float(rr[0]) + __uint_as_float(rr[1]); }
    { auto rr = __builtin_amdgcn_permlane32_swap(__float_as_uint(nq), __float_as_uint(nq), false, false); nq = __uint_as_float(rr[0]) + __uint_as_float(rr[1]); }
    if (hi == 0) denw[(wid * 2 + dir) * 32 + r32] = den + wi[dir * 128 + t] * nq;
}
__device__ __forceinline__ void mlstm_c_unit(const Params& p, int l, int bl, int J, int h, LAS unsigned char* lds) {
    int tid_ = threadIdx.x; asm volatile("" : "+v"(tid_));
    const int tid = tid_, wid = __builtin_amdgcn_readfirstlane(tid >> 6), lane = tid & 63, r32 = lane & 31, hi = lane >> 5;
    LAS bf16_t* Tq = (LAS bf16_t*)lds; LAS bf16_t* Tk = (LAS bf16_t*)(lds + TILE_B); LAS bf16_t* Tv = (LAS bf16_t*)(lds + 2 * TILE_B); LAS bf16_t* Ts = (LAS bf16_t*)(lds + 3 * TILE_B);
    LAS float* sc = (LAS float*)(lds + 4 * TILE_B);
    LAS float* gl = sc;
    LAS float* av = sc + 512;
    LAS float* Mv = sc + 768;
    LAS float* wi = sc + 1024;
    LAS float* fl = sc + 1280;
    LAS float* ssq = sc + 1536;
    LAS float* denp = sc + 1664;
    LAS float* n0l = sc + 2944;
    const int rseq = J < 2 ? bl * 256 : CTXROWS + bl * 2048, r0 = rseq + (J < 2 ? J * 128 : (J - 2) * 128);
    u32x4 cf_[4], cbp_[4];
    { const int d_ = tid >> 2, e_ = (tid & 3) * 32; const bf16_t* c0f = (const bf16_t*)(p.ws + WS_P + P_CLOC) + ((size_t)((bl * 4 + h) * 2) * NJ + J) * 16384 + d_ * 128 + e_;
#pragma unroll
      for (int i = 0; i < 4; ++i) { cf_[i] = *(const u32x4*)(c0f + 8 * i); cbp_[i] = *(const u32x4*)(c0f + (size_t)NJ * 16384 + 8 * i); } }
    {
        const int t = tid >> 2, c0 = (tid & 3) * 32;
        const bf16_t* q = pbuf(p, P_MQ) + (size_t)(r0 + t) * 512 + h * 128 + c0; const bf16_t* k = pbuf(p, P_MK) + (size_t)(r0 + t) * 512 + h * 128 + c0;
        const bf16_t* v = pbuf(p, P_MVT) + ((size_t)((bl * NJ + J) * 4 + h)) * 16384 + t * 128 + c0;
#pragma unroll
        for (int i = 0; i < 4; ++i) { *(LAS u32x4*)(Tq + t * TLD + c0 + 8 * i) = *(const u32x4*)(q + 8 * i); *(LAS u32x4*)(Tk + t * TLD + c0 + 8 * i) = *(const u32x4*)(k + 8 * i);
            *(LAS u32x4*)(Tv + t * TLD + c0 + 8 * i) = *(const u32x4*)(v + 8 * i); }
        if (tid < 128) { *(LAS f32x4*)(gl + tid * 4) = *(const f32x4*)((const float*)(p.ws + WS_P + P_GATES) + (size_t)(r0 + tid) * 16 + h * 4); ssq[tid] = 0.f; }
        if (tid < 256) n0l[tid] = ((const float*)(p.ws + WS_P + P_NLOC))[((size_t)(((bl * 4 + h) * 2 + (tid >> 7)) * NJ + J)) * 128 + (tid & 127)];
    }
    __syncthreads();
    { const int d_ = tid >> 2, e_ = (tid & 3) * 32;
#pragma unroll
      for (int i = 0; i < 4; ++i) *(LAS u32x4*)(Ts + d_ * TLD + e_ + 8 * i) = cf_[i]; }
    const float* MST = (const float*)(p.ws + WS_P + P_MST);
    if (wid < 2) {
        const int dir = wid, p0 = 2 * lane, p1 = p0 + 1, s0 = dir ? 127 - p0 : p0, s1 = dir ? 127 - p1 : p1;
        const float m0 = ld_f32_dev(MST + ((size_t)(((bl * 4 + h) * 2 + dir) * NJ + J)) * 4 + 2);
        const float ig0 = gl[s0 * 4 + 2 * dir], ig1 = gl[s1 * 4 + 2 * dir];
        const float lf0 = logsigmoid_f(gl[s0 * 4 + 2 * dir + 1]), lf1 = logsigmoid_f(gl[s1 * 4 + 2 * dir + 1]);
        float incl = lf0 + lf1;
        for (int o = 1; o < 64; o <<= 1) { const float t = __shfl_up(incl, o); if (lane >= o) incl += t; }
        const float bc1 = incl, bc0 = incl - lf1;
        const float a0 = ig0 - bc0, a1 = ig1 - bc1;
        float mx = fmaxf(a0, a1);
        for (int o = 1; o < 64; o <<= 1) { const float t = __shfl_up(mx, o); if (lane >= o) mx = fmaxf(mx, t); }
        float mxprev = __shfl_up(mx, 1); if (lane == 0) mxprev = -3.0e38f;
        const float M0 = fmaxf(m0, fmaxf(mxprev, a0)), M1 = fmaxf(m0, mx);
        av[dir * 128 + s0] = a0; av[dir * 128 + s1] = a1; Mv[dir * 128 + s0] = M0; Mv[dir * 128 + s1] = M1;
        wi[dir * 128 + s0] = __expf(m0 - M0); wi[dir * 128 + s1] = __expf(m0 - M1);
        fl[dir * 128 + s0] = __expf(-bc0 - M0); fl[dir * 128 + s1] = __expf(-bc1 - M1);
    }
    __builtin_amdgcn_sched_barrier(0);
    unsigned Xp[4][8];
    {
    f32x16 X[4] = {};
    { const LAS bf16_t* bq = Tq + (32 * (wid >> 1) + r32) * TLD + hi * 8; const LAS bf16_t* ak = Tk + r32 * TLD + hi * 8;
#pragma unroll 2
      for (int ks = 0; ks < 8; ++ks) { const bf16x8 b = *(const LAS bf16x8*)(bq + ks * 16);
#pragma unroll
          for (int sb = 0; sb < 4; ++sb) X[sb] = mfma32(*(const LAS bf16x8*)(ak + 32 * sb * TLD + ks * 16), b, X[sb]); } }
#pragma unroll
    for (int sb = 0; sb < 4; ++sb)
#pragma unroll
        for (int i = 0; i < 8; ++i) Xp[sb][i] = cvtpk(X[sb][2 * i], X[sb][2 * i + 1]);
    }
    __syncthreads();
    { const int d_ = tid >> 2, e_ = (tid & 3) * 32;
#pragma unroll
      for (int i = 0; i < 4; ++i) *(LAS u32x4*)(Tk + d_ * TLD + e_ + 8 * i) = cbp_[i]; }
    __syncthreads();
    f32x16 ao0[2], ao1[2];
    LAS float* denw = denp;
    mlstm_c_dir<0>(Xp, ao0, Tq, Ts, Tv, av, Mv, wi, denw, n0l, wid, lane);
    mlstm_c_dir<1>(Xp, ao1, Tq, Tk, Tv, av, Mv, wi, denw, n0l, wid, lane);
    float hv[2][16];
#pragma unroll
    for (int r = 0; r < 16; ++r) { const int t = 32 * (wid >> 1) + crow(r, hi);
        const float df = denw[(wid * 2 + 0) * 32 + crow(r, hi)], db = denw[(wid * 2 + 1) * 32 + crow(r, hi)];
        const float rf = 1.0f / fmaxf(fabsf(df), fl[t]), rb = 1.0f / fmaxf(fabsf(db), fl[128 + t]);
        hv[0][r] = ao0[0][r] * rf + ao1[0][r] * rb; hv[1][r] = ao0[1][r] * rf + ao1[1][r] * rb;
        float q = hv[0][r] * hv[0][r] + hv[1][r] * hv[1][r];
        q = half_sum31(q);
        if (r32 == 31) lds_addf(&ssq[t], q); }
    __syncthreads();
    const float* gm = p.in[I_GMN] + l * 512 + h * 128; const float* sk = p.in[I_SKIP] + l * 512 + h * 128;
    f32x16 hn[2];
#pragma unroll
    for (int tl = 0; tl < 2; ++tl) { const float gd = gm[64 * (wid & 1) + 32 * tl + r32];
#pragma unroll
        for (int r = 0; r < 16; ++r) hn[tl][r] = hv[tl][r] * rsqrtf(ssq[32 * (wid >> 1) + crow(r, hi)] * (1.0f / 128.0f) + EPS) * gd; }
    LAS float* F = (LAS float*)lds;
    st_acc_f32(F, hn, wid, lane);
    __syncthreads();
    { int te_ = tid; asm volatile("" : "+v"(te_));
      const int t = te_ >> 2, c0 = (te_ & 3) * 32; const size_t o = (size_t)(r0 + t) * 512 + h * 128 + c0;
      const bf16_t* xcv = pbuf(p, P_XCV) + o; bf16_t* zb = pbuf(p, P_ZB) + o;
      u32x4 xw[4], zw[4]; f32x4 s0[4], s1[4];
#pragma unroll
      for (int i = 0; i < 4; ++i) { xw[i] = *(const u32x4*)(xcv + 8 * i); zw[i] = *(const u32x4*)(zb + 8 * i); s0[i] = *(const f32x4*)(sk + c0 + 8 * i); s1[i] = *(const f32x4*)(sk + c0 + 8 * i + 4); }
#pragma unroll
      for (int i = 0; i < 4; ++i) { float x8[8], z8[8]; unpack8(xw[i], x8); unpack8(zw[i], z8);
          const f32x4 h0 = *(const LAS f32x4*)(F + t * FLD + c0 + 8 * i), h1 = *(const LAS f32x4*)(F + t * FLD + c0 + 8 * i + 4);
#pragma unroll
          for (int j = 0; j < 4; ++j) { z8[j] = (h0[j] + s0[i][j] * x8[j]) * z8[j]; z8[4 + j] = (h1[j] + s1[i][j] * x8[4 + j]) * z8[4 + j]; }
          zw[i] = pack8(z8); }
#pragma unroll
      for (int i = 0; i < 4; ++i) *(u32x4*)(zb + 8 * i) = zw[i]; }
    __syncthreads();
}
namespace att {
constexpr int SHM_V = 64 * 128 * 2, SHM_K = 64 * 64 * 2, OFF_K = 2 * SHM_V, OFF_WS = OFF_K + 2 * SHM_K, OFF_ST = OFF_WS + 8 * 64 * 4, LDS_NEED = OFF_ST + 32 * 512 * 4;
static_assert(LDS_NEED <= LDS_BYTES - 64, "attention LDS");
constexpr float THR2 = 11.5f;
#define KSWZ64(row, colB) ((row) * 128 + ((colB) ^ (((row) & 7) << 4)))
#define ASBAR() __builtin_amdgcn_sched_barrier(0)
__device__ __forceinline__ void partialSM(f32x16& p0, f32x16& p1, float& m_reg, float& mn, float& alpha) {
    float pmax = p0[0];
#pragma unroll
    for (int r = 1; r < 16; ++r) pmax = fmaxf(pmax, p0[r]);
#pragma unroll
    for (int r = 0; r < 16; ++r) pmax = fmaxf(pmax, p1[r]);
    { auto rr = __builtin_amdgcn_permlane32_swap(__float_as_uint(pmax), __float_as_uint(pmax), false, false); pmax = fmaxf(__uint_as_float(rr[0]), __uint_as_float(rr[1])); }
    if (__builtin_expect(__all(pmax - m_reg <= THR2), 1)) { mn = m_reg; alpha = 1.f; }
    else { mn = fmaxf(m_reg, pmax); alpha = __builtin_amdgcn_exp2f(m_reg - mn); m_reg = mn; }
#pragma unroll
    for (int r = 0; r < 16; ++r) { p0[r] -= mn; p1[r] -= mn; }
#pragma unroll
    for (int r = 0; r < 16; ++r) p0[r] = __builtin_amdgcn_exp2f(p0[r]);
}
__device__ __forceinline__ void finishSM(f32x16& p0, f32x16& p1, float alpha, float& l_reg, bf16x8& pa0, bf16x8& pa1, bf16x8& pa2, bf16x8& pa3) {
#pragma unroll
    for (int r = 0; r < 16; ++r) p1[r] = __builtin_amdgcn_exp2f(p1[r]);
    float ps = 0;
#pragma unroll
    for (int r = 0; r < 16; ++r) ps += p0[r];
#pragma unroll
    for (int r = 0; r < 16; ++r) ps += p1[r];
    { auto rr = __builtin_amdgcn_permlane32_swap(__float_as_uint(ps), __float_as_uint(ps), false, false); ps = __uint_as_float(rr[0]) + __uint_as_float(rr[1]); }
    l_reg = l_reg * alpha + ps;
#define PK4(P, BASE, OUT) do { unsigned a0 = cvtpk(P[BASE + 0], P[BASE + 1]), a1 = cvtpk(P[BASE + 2], P[BASE + 3]);   \
    unsigned b0 = cvtpk(P[BASE + 4], P[BASE + 5]), b1 = cvtpk(P[BASE + 6], P[BASE + 7]);                              \
    auto r0 = __builtin_amdgcn_permlane32_swap(a0, b0, false, false); auto r1 = __builtin_amdgcn_permlane32_swap(a1, b1, false, false); \
    u32x4 w = {r0[0], r1[0], r0[1], r1[1]}; OUT = *reinterpret_cast<bf16x8*>(&w); } while (0)
    PK4(p0, 0, pa0); PK4(p0, 8, pa1); PK4(p1, 0, pa2); PK4(p1, 8, pa3);
#undef PK4
}
__device__ __forceinline__ void qkt(f32x16& p0, f32x16& p1, const LAS char* Ks, const bf16x8 (&qr)[4], int r32, int hi) {
    p0 = f32x16{}; p1 = f32x16{};
#pragma unroll
    for (int d0 = 0; d0 < 4; ++d0) { const int cb = (d0 * 16 + hi * 8) * 2;
        const bf16x8 b0 = *reinterpret_cast<const LAS bf16x8*>(Ks + KSWZ64(r32, cb));
        const bf16x8 b1 = *reinterpret_cast<const LAS bf16x8*>(Ks + KSWZ64(32 + r32, cb));
        p0 = mfma32(b0, qr[d0], p0); p1 = mfma32(b1, qr[d0], p1); }
}
__device__ __forceinline__ int v_st(int k, int c) { const int kk = (k & ~0xC) | ((k & 4) << 1) | ((k & 8) >> 1); return ((kk >> 3) * 4 + (c >> 5)) * 512 + ((kk & 7) * 32 + (c & 31)) * 2; }
__device__ __forceinline__ int v_rd_base(int lane) { return ((lane & 3) << 3) | (((lane >> 2) & 3) << 6) | (((lane >> 4) & 1) << 5) | (((lane >> 5) & 1) << 8); }
constexpr int v_rd_off(int d0, int ks, int half) { return d0 * 512 + ks * 4096 + half * 2048; }
template <int OFF> __device__ __forceinline__ s16x4 tr_read(int vb) { s16x4 r; asm volatile("ds_read_b64_tr_b16 %0, %1 offset:%2" : "=&v"(r) : "v"(vb), "i"(OFF) : "memory"); return r; }
template <int D0> __device__ __forceinline__ void pv_one(f32x16& od, int vb, bf16x8 pa0, bf16x8 pa1, bf16x8 pa2, bf16x8 pa3) {
    const s16x4 l0 = tr_read<v_rd_off(D0, 0, 0)>(vb), h0 = tr_read<v_rd_off(D0, 0, 1)>(vb), l1 = tr_read<v_rd_off(D0, 1, 0)>(vb), h1 = tr_read<v_rd_off(D0, 1, 1)>(vb);
    const s16x4 l2 = tr_read<v_rd_off(D0, 2, 0)>(vb), h2 = tr_read<v_rd_off(D0, 2, 1)>(vb), l3 = tr_read<v_rd_off(D0, 3, 0)>(vb), h3 = tr_read<v_rd_off(D0, 3, 1)>(vb);
    asm volatile("s_waitcnt lgkmcnt(0)" ::: "memory"); ASBAR();
#define PKV(L, H) (bf16x8){L[0], L[1], L[2], L[3], H[0], H[1], H[2], H[3]}
    od = mfma32(pa0, PKV(l0, h0), od); od = mfma32(pa1, PKV(l1, h1), od); od = mfma32(pa2, PKV(l2, h2), od); od = mfma32(pa3, PKV(l3, h3), od);
#undef PKV
}
__device__ __forceinline__ void pv_d0(f32x16 (&o)[4], int vb, bf16x8 pa0, bf16x8 pa1, bf16x8 pa2, bf16x8 pa3) {
    pv_one<0>(o[0], vb, pa0, pa1, pa2, pa3); pv_one<1>(o[1], vb, pa0, pa1, pa2, pa3); pv_one<2>(o[2], vb, pa0, pa1, pa2, pa3); pv_one<3>(o[3], vb, pa0, pa1, pa2, pa3);
}
__device__ __forceinline__ int krow(int j, int rc, int rl) { return j < 4 ? rc + 64 * j : rl + 64 * (j - 4); }

__device__ __forceinline__ void attn_unit(const Params& p, int l, int h, int qrow0, int rc, int rl, int NT, LAS unsigned char* lds8) {
    int tid_ = threadIdx.x; asm volatile("" : "+v"(tid_));
    const int tid = tid_, wid = __builtin_amdgcn_readfirstlane(tid >> 6), lane = tid & 63, r32 = lane & 31, hi = lane >> 5;
    LAS char* V_lds = (LAS char*)lds8; LAS char* K_lds = (LAS char*)lds8 + OFF_K;
    LAS float* wsx = (LAS float*)(lds8 + OFF_WS) + wid * 64; LAS float* li_l = wsx; LAS float* al_l = wsx + 32;
    LAS unsigned* stash = (LAS unsigned*)(lds8 + OFF_ST);
    bf16_t* QB = pbuf(p, P_QB); const bf16_t* KB = pbuf(p, P_KB); const bf16_t* VB = pbuf(p, P_VB);
    const int sr = tid >> 4, sc = (tid & 15) * 8, vst0 = v_st(sr, sc);
    const int kr = tid >> 3, kc = (tid & 7) * 8, kst = KSWZ64(kr, kc * 2);
    const int vb0 = (int)(uintptr_t)V_lds + v_rd_base(lane);
    f32x16 o[4];
#pragma unroll 1
    for (int m = 0; m < 2; ++m) {
        const unsigned voV0 = (unsigned)((sr * 512 + h * 128 + sc) * 2), voK = (unsigned)((kr * 512 + h * 128 + m * 64 + kc) * 2);
        float m_reg = -1e30f, l_reg = 0.f;
#pragma unroll
        for (int d = 0; d < 4; ++d) o[d] = f32x16{};
        bf16x8 qr[4];
        { const bf16_t* Qw = QB + (size_t)(qrow0 + wid * 32 + r32) * 512 + h * 128 + m * 64 + hi * 8;
#pragma unroll
          for (int d0 = 0; d0 < 4; ++d0) qr[d0] = *(const bf16x8*)(Qw + d0 * 16); }
        struct { bf16x8 vs0, vs1, ks0; } sr_[2];
#define SLOAD(i, j) do { const int _r = __builtin_amdgcn_readfirstlane(krow((j), rc, rl)); const char* _vb = (const char*)(VB + (size_t)_r * 512); const char* _kb = (const char*)(KB + (size_t)_r * 512); \
    sr_[i].vs0 = *(const bf16x8*)(_vb + voV0); sr_[i].vs1 = *(const bf16x8*)(_vb + 32 * 512 * 2 + voV0); sr_[i].ks0 = *(const bf16x8*)(_kb + voK); } while (0)
#define SWRITE(b, i) do { *(LAS bf16x8*)(V_lds + (b) * SHM_V + vst0) = sr_[i].vs0; *(LAS bf16x8*)(V_lds + (b) * SHM_V + 8192 + vst0) = sr_[i].vs1; \
    *(LAS bf16x8*)(K_lds + (b) * SHM_K + kst) = sr_[i].ks0; } while (0)
#define SWAIT() asm volatile("s_waitcnt vmcnt(3)" ::: "memory")
#define RESC(a) do { if (__any((a) < 1.f)) { if (hi == 0) al_l[r32] = (a); asm volatile("s_waitcnt lgkmcnt(0)" ::: "memory"); \
    _Pragma("unroll") for (int d = 0; d < 4; ++d) _Pragma("unroll") for (int r = 0; r < 16; ++r) o[d][r] *= al_l[crow(r, hi)]; } } while (0)
        f32x16 pA0, pA1, pB0, pB1; float mnA, mnB, alA, alB; bf16x8 pa0, pa1, pa2, pa3;
        SLOAD(0, 0); asm volatile("s_waitcnt vmcnt(0)" ::: "memory"); SWRITE(0, 0); __syncthreads();
        qkt(pA0, pA1, K_lds, qr, r32, hi); partialSM(pA0, pA1, m_reg, mnA, alA);
        SLOAD(1, 1); if (2 < NT) SLOAD(0, 2);
        SWAIT(); SWRITE(1, 1); __syncthreads();
        for (int j = 1; j + 1 < NT; j += 2) {
            ASBAR(); qkt(pB0, pB1, K_lds + SHM_K, qr, r32, hi);
            finishSM(pA0, pA1, alA, l_reg, pa0, pa1, pa2, pa3); ASBAR();
            SLOAD(1, j + 2); ASBAR();
            pv_d0(o, vb0, pa0, pa1, pa2, pa3); partialSM(pB0, pB1, m_reg, mnB, alB);
            __syncthreads(); SWAIT(); SWRITE(0, 0);
            RESC(alB); __syncthreads();
            ASBAR(); qkt(pA0, pA1, K_lds, qr, r32, hi);
            finishSM(pB0, pB1, alB, l_reg, pa0, pa1, pa2, pa3); ASBAR();
            if (j + 3 < NT) SLOAD(0, j + 3); ASBAR();
            pv_d0(o, vb0 + SHM_V, pa0, pa1, pa2, pa3); partialSM(pA0, pA1, m_reg, mnA, alA);
            __syncthreads(); SWAIT(); SWRITE(1, 1);
            RESC(alA); __syncthreads();
        }
        ASBAR(); qkt(pB0, pB1, K_lds + SHM_K, qr, r32, hi);
        finishSM(pA0, pA1, alA, l_reg, pa0, pa1, pa2, pa3); ASBAR();
        pv_d0(o, vb0, pa0, pa1, pa2, pa3); partialSM(pB0, pB1, m_reg, mnB, alB);
        __syncthreads(); RESC(alB);
        finishSM(pB0, pB1, alB, l_reg, pa0, pa1, pa2, pa3); ASBAR();
        pv_d0(o, vb0 + SHM_V, pa0, pa1, pa2, pa3);
#undef SLOAD
#undef SWRITE
#undef SWAIT
#undef RESC
        int lane_e = lane; asm volatile("" : "+v"(lane_e)); const int r32e = lane_e & 31, hie = lane_e >> 5;
        if (hie == 0) li_l[r32e] = l_reg; asm volatile("s_waitcnt lgkmcnt(0)" ::: "memory");
        float rli[16];
#pragma unroll
        for (int r = 0; r < 16; ++r) rli[r] = __builtin_amdgcn_rcpf(li_l[crow(r, hie)]);
        if (m == 0) {
#pragma unroll
            for (int d0 = 0; d0 < 4; ++d0)
#pragma unroll
                for (int r = 0; r < 16; r += 2) stash[(wid * 32 + d0 * 8 + (r >> 1)) * 64 + lane_e] = cvtpk(o[d0][r] * rli[r], o[d0][r + 1] * rli[r + 1]);
        } else {
            const float lam = ld_f32_dev((const float*)(p.ws + WS_LAM) + l * 4), oml = ld_f32_dev((const float*)(p.ws + WS_LAM) + l * 4 + 1);
            float ss[16];
#pragma unroll
            for (int r = 0; r < 16; ++r) ss[r] = 0.f;
#pragma unroll
            for (int d0 = 0; d0 < 4; ++d0)
#pragma unroll
                for (int r = 0; r < 16; r += 2) { const unsigned w = stash[(wid * 32 + d0 * 8 + (r >> 1)) * 64 + lane_e];
                    o[d0][r] = bf_lo(w) - lam * o[d0][r] * rli[r]; o[d0][r + 1] = bf_hi(w) - lam * o[d0][r + 1] * rli[r + 1];
                    ss[r] += o[d0][r] * o[d0][r]; ss[r + 1] += o[d0][r + 1] * o[d0][r + 1]; }
#pragma unroll
            for (int r = 0; r < 16; ++r) { float q = ss[r]; q += __shfl_xor(q, 1); q += __shfl_xor(q, 2); q += __shfl_xor(q, 4); q += __shfl_xor(q, 8); q += __shfl_xor(q, 16);
                ss[r] = rsqrtf(q * (1.0f / 128.0f) + EPS) * oml; }
            const float* gs = p.in[I_GSUBLN] + l * 128;
            asm volatile("s_waitcnt lgkmcnt(0)" ::: "memory");
            LAS bf16_t* ot = (LAS bf16_t*)(stash + wid * 32 * 64);
#pragma unroll
            for (int d0 = 0; d0 < 4; ++d0) { const float g = gs[d0 * 32 + r32e];
#pragma unroll
                for (int r = 0; r < 16; ++r) ot[((r & 3) + 8 * (r >> 2) + 4 * hie) * 128 + d0 * 32 + r32e] = (bf16_t)(cvtpk(o[d0][r] * ss[r] * g, 0.f) & 0xffffu); }
            asm volatile("s_waitcnt lgkmcnt(0)" ::: "memory");
            { bf16_t* dst = QB + (size_t)(qrow0 + wid * 32) * 512 + h * 128;
#pragma unroll
              for (int i = 0; i < 8; ++i) { const int row = i * 4 + (lane_e >> 4), pc = (lane_e & 15) * 8;
                  *(u32x4*)(dst + (size_t)row * 512 + pc) = *(const LAS u32x4*)(ot + row * 128 + pc); } }
        }
        __syncthreads();
    }
}
}
__device__ __forceinline__ void gmlp_unit(const Params& p, int l, int r0, LAS unsigned char* lds) {
    int tid_ = threadIdx.x; asm volatile("" : "+v"(tid_));
    const int tid = tid_, wid = __builtin_amdgcn_readfirstlane(tid >> 6), lane = tid & 63, r32 = lane & 31, hi = lane >> 5;
    const bf16_t* VG = pbuf(p, P_VGB); bf16_t* UB = pbuf(p, P_UB);
    PSEC_BEGIN8();
    {
        const int sr = tid >> 4, sc = (tid & 15) * 8, vst0 = att::v_st(sr, sc);
        u32x4 x[4][4]; float rs[4];
#pragma unroll
        for (int k = 0; k < 4; ++k)
#pragma unroll
            for (int g = 0; g < 4; ++g) x[k][g] = *(const u32x4*)(VG + (size_t)(r0 + sr + 32 * k) * 512 + g * 128 + sc);
#pragma unroll
        for (int k = 0; k < 4; ++k) { float ss = 0.f;
#pragma unroll
            for (int g = 0; g < 4; ++g) { float v[8]; unpack8(x[k][g], v);
#pragma unroll
                for (int j = 0; j < 8; ++j) ss += v[j] * v[j]; }
            ss += __shfl_xor(ss, 1); ss += __shfl_xor(ss, 2); ss += __shfl_xor(ss, 4); ss += __shfl_xor(ss, 8);
            rs[k] = rsqrtf(ss * (1.0f / 512.0f) + EPS); }
#pragma unroll
        for (int k = 0; k < 4; ++k)
#pragma unroll
            for (int g = 0; g < 4; ++g) { float v[8]; unpack8(x[k][g], v);
#pragma unroll
                for (int j = 0; j < 8; ++j) v[j] *= rs[k];
                *(LAS u32x4*)(lds + (g * 2 + (k >> 1)) * att::SHM_V + (k & 1) * 8192 + vst0) = pack8(v); }
    }
    __syncthreads();
    const int rb = wid >> 1, dh = wid & 1;
    const int vb0 = (int)(uintptr_t)lds + att::v_rd_base(lane) + dh * 1024;
    LAS float* F = (LAS float*)(lds + 8 * att::SHM_V) + wid * 576;
    const bf16_t* Wsb = (const bf16_t*)(p.ws + WS_WSB) + (size_t)l * 4 * 16384 + (size_t)(32 * rb + r32) * 128 + 8 * hi;
#pragma unroll 1
    for (int g = 0; g < 4; ++g) {
        bf16x8 pa[2][4];
#pragma unroll
        for (int kt = 0; kt < 2; ++kt)
#pragma unroll
            for (int k4 = 0; k4 < 4; ++k4) pa[kt][k4] = *(const bf16x8*)(Wsb + (size_t)g * 16384 + 64 * kt + 16 * k4);
        bf16_t* up = UB + (size_t)(r0 + 32 * rb + (lane >> 2)) * 512 + g * 128 + 64 * dh + 8 * (lane & 3);
        u32x4 uu[2][2];
#pragma unroll
        for (int d0 = 0; d0 < 2; ++d0)
#pragma unroll
            for (int rd = 0; rd < 2; ++rd) uu[d0][rd] = *(const u32x4*)(up + (size_t)(16 * rd) * 512 + 32 * d0);
        const float* gv = p.in[I_GGV] + l * 512 + g * 128 + 64 * dh + r32; const float* bs = p.in[I_BGS] + (l * 4 + g) * 128 + 32 * rb;
        const float gv0 = gv[0], gv1 = gv[32];
        float bsv[16];
#pragma unroll
        for (int r = 0; r < 16; ++r) bsv[r] = bs[crow(r, hi)];
        __builtin_amdgcn_sched_barrier(0);
        f32x16 o[2] = {};
        att::pv_one<0>(o[0], vb0 + (g * 2) * att::SHM_V, pa[0][0], pa[0][1], pa[0][2], pa[0][3]); att::pv_one<1>(o[1], vb0 + (g * 2) * att::SHM_V, pa[0][0], pa[0][1], pa[0][2], pa[0][3]);
        att::pv_one<0>(o[0], vb0 + (g * 2 + 1) * att::SHM_V, pa[1][0], pa[1][1], pa[1][2], pa[1][3]); att::pv_one<1>(o[1], vb0 + (g * 2 + 1) * att::SHM_V, pa[1][0], pa[1][1], pa[1][2], pa[1][3]);
#pragma unroll
        for (int d0 = 0; d0 < 2; ++d0)
#pragma unroll
            for (int rd = 0; rd < 2; ++rd) {
#pragma unroll
                for (int r = 0; r < 8; ++r) { const int rr = 8 * rd + r; F[((r & 3) + 8 * ((r >> 2) & 1) + 4 * hi) * 36 + r32] = o[d0][rr] * (d0 ? gv1 : gv0) + bsv[rr]; }
                asm volatile("s_waitcnt lgkmcnt(0)" ::: "memory");
                const f32x4 m0 = *(const LAS f32x4*)(F + (lane >> 2) * 36 + 8 * (lane & 3)), m1 = *(const LAS f32x4*)(F + (lane >> 2) * 36 + 8 * (lane & 3) + 4);
                float u8[8]; unpack8(uu[d0][rd], u8);
#pragma unroll
                for (int j = 0; j < 4; ++j) { u8[j] *= m0[j]; u8[4 + j] *= m1[j]; }
                *(u32x4*)(up + (size_t)(16 * rd) * 512 + 32 * d0) = pack8(u8);
                asm volatile("s_waitcnt lgkmcnt(0)" ::: "memory");
            }
    }
    __syncthreads();
    PSEC(8);
}
constexpr int N_PHASES = 36;
typedef const __attribute__((address_space(4))) Params* KParams;
#define PHASE_P() const Params& p = *(const Params*)opaque_kp()
__device__ __forceinline__ KParams opaque_kp() { KParams q = (KParams)__builtin_amdgcn_kernarg_segment_ptr(); asm volatile("" : "+s"(q)); return q; }
__global__ void __launch_bounds__(NTHR, 2) mk_fwd(Params p_arg, int bar_region) {
    extern __shared__ __attribute__((aligned(16))) unsigned char lds_raw[];
    LAS unsigned char* lds = (LAS unsigned char*)lds_raw;
    const int tid = threadIdx.x, G = gridDim.x, bid = blockIdx.x;
    volatile LAS unsigned* xbw = (volatile LAS unsigned*)(lds + LDS_BYTES - 16);
    if (tid == 0) { xbw[0] = 0u; xbw[1] = 0u; xbw[2] = 0u; xbw[3] = 0u; }
    __syncthreads();
    (void)xcd_barrier_post((unsigned*)(p_arg.ws + WS_CTL) + CW_BAR + bar_region * 4096, xbw);
    const int lo = p_arg.ph_lo, hi = p_arg.ph_hi;
#define IN(k) (lo <= (k) && (k) < hi)
#ifdef PROBE
#define STAMP(k) do { if (tid == 0) { if (bid == 0) ((unsigned long long*)(opaque_kp()->ws + WS_CTL))[30000 + (k)] = __builtin_amdgcn_s_memrealtime(); *(volatile LAS int*)(lds + LDS_BYTES - 32) = (k); } __syncthreads(); } while (0)
#else
#define STAMP(k) do { } while (0)
#endif
#define GRID_BARRIER() do { KParams kq = opaque_kp(); XcdBarrier b_; b_.bar = (unsigned*)(kq->ws + WS_CTL) + CW_BAR + ((const __attribute__((address_space(4))) int*)(kq + 1))[0] * 4096; b_.x = xb_xcc_id(); b_.st = xbw; xcd_barrier(b_); } while (0)
#define SEAM(k) do { if (IN(k) && IN((k) + 1)) { GRID_BARRIER(); STAMP((k) + 1); } } while (0)

    STAMP(0);
#if !defined(ONLY) || ONLY == 0
    if (IN(0)) { PHASE_P(); phase_prologue(p, lds); }
#endif
    SEAM(0);
    for (int l = 0; l < 2; ++l) {
        const int base = 1 + 17 * l;
#if !defined(ONLY) || ONLY == 1
        if (IN(base)) { PHASE_P(); phase_norm1(p, l); }
#endif
        SEAM(base);
        for (int hf = 0; hf < 2; ++hf) {
            const int hb = base + 1 + 6 * hf;
#if !defined(ONLY) || ONLY == 2
            if (IN(hb)) {
                PHASE_P(); unsigned char* ws = p.ws; bf16_t* Hh = (bf16_t*)(ws + WS_H) + (size_t)hf * MH * 1024; (void)Hh;
                const float* cosT = (const float*)(ws + WS_ROPE); const float* sinT = cosT + 1024;
                pg8::Gemm g{Hh, (const bf16_t*)(ws + WS_WTIN) + (size_t)l * NCOL * 1024, MH, NCOL, 1024};
                int cin = bid; if (hf == 1) { cin += G >> 1; if (cin >= G) cin -= G; }
                RectOrder S; if (l == 0) S.init(72, 14, 0, 0, 0, 0, G, cin); else S.init(64, 14, 8, 8, 6, 0, G, cin);
                EpiIn E{pbuf(p, 0), pbuf(p, P_GB), cosT, sinT};
                pg8::gemm_phase<EpiIn, RectOrder>((PG8_LAS unsigned char*)lds, g, S, E, nullptr);
                pg8::Gemm g8{(const bf16_t*)(ws + WS_H8 + (size_t)hf * MH * 1024), (const bf16_t*)(ws + WS_WTIN8 + (size_t)l * 3072 * 1024), MH, 3072, 512};
                RectOrder S8; S8.init(l == 0 ? 72 : 64, 12, l == 0 ? 0 : 8, 0, 0, 0, G, G - 1 - cin);
                EpiGate8 E8{pbuf(p, P_GB)};
                pg8::gemm_phase<EpiGate8, RectOrder, false, true>((PG8_LAS unsigned char*)lds, g8, S8, E8, nullptr);
            }
#endif
            SEAM(hb);
#if !defined(ONLY) || ONLY == 3
            if (IN(hb + 1)) {
                PSEC_BEGIN6();
                { PHASE_P(); phase_conv(p, l, lds); }
                PSEC(6);
                GRID_BARRIER(); PSEC(7);
                PHASE_P();
                const int n_a = HBAT * NJ * 4, n_g = HBAT * 16 + (l == 0 ? HBAT * 2 : 0);
                const int bidx = (G == 256) ? ((bid & 7) * 32 + (bid >> 3)) : bid;
                int u = bidx;
                PSEC(13);
                { u32x4 qa[4], qb[4], qwq[4], qwk[4], qwv[4]; f32x4 qg; mlstm_a_load(p, l, u < n_a ? u : 0, APRE_ARGS);
                  for (; u < n_a; u += G) mlstm_a_unit(p, l, u, u + G, n_a, APRE_ARGS, lds); }
                PSEC(14);
                for (; u < n_a + n_g; u += G) { const int v = u - n_a; int r0; if (v < HBAT * 16) r0 = CTXROWS + (v >> 4) * 2048 + (v & 15) * 128; else { const int w = v - HBAT * 16; r0 = (w >> 1) * 256 + (w & 1) * 128; }
                    gmlp_unit(p, l, r0, lds); }
            }
#endif
            SEAM(hb + 1);
#if !defined(ONLY) || ONLY == 4
            if (IN(hb + 2)) {
                PHASE_P();
                phase_scan(p);
            }
#endif
            SEAM(hb + 2);
#if !defined(ONLY) || ONLY == 5
            if (IN(hb + 3)) {
                PHASE_P();
                const int n_l = HBAT * 4 * 8, n_c = (l == 0 ? HBAT * 4 : 0);
                for (int u = bid; u < n_l + n_c; u += G) {
                    int h, qrow0, rc, rl, NT;
                    if (u < n_l) { const int ue = (G == 256) ? ((((u & 7) * 4 + (u >> 6)) << 3) | ((u >> 3) & 7)) : u;
                        const int bl = ue >> 5, qb = ue & 7; h = (ue >> 3) & 3; qrow0 = CTXROWS + bl * 2048 + qb * 256; rc = bl * 256; rl = CTXROWS + bl * 2048; NT = 36; }
                    else { const int v = u - n_l, bl = v >> 2; h = v & 3; qrow0 = bl * 256; rc = bl * 256; rl = 0; NT = 4; }
                    PSEC_BEGINN(9); att::attn_unit(p, l, h, qrow0, rc, rl, NT, lds); PSEC(9);
                }
                const int m_l = HBAT * 16 * 4, m_c = (l == 0 ? HBAT * 2 * 4 : 0);
                int u0 = bid + 192; if (u0 >= G) u0 -= G;
                for (int u = u0; u < m_l + m_c; u += G) {
                    int bl, J, h;
                    if (u < m_l) { const int rem = u & 63; bl = u >> 6; J = 2 + (rem >> 2); h = rem & 3; }
                    else { const int v = u - m_l, rem = v & 7; bl = v >> 3; J = rem >> 2; h = rem & 3; }
                    PSEC_BEGINN(10); mlstm_c_unit(p, l, bl, J, h, lds); PSEC(10);
                }
                if (l == 0 && G == 256 && !(bid >= 64 && bid < 128)) cvt_fill(p, lds, hf == 0 ? 0 : CVT_Q1, hf == 0 ? CVT_Q0 : CVT_Q2, bid < 64 ? bid : bid - 64, 192);
                else if (l == 0 && G != 256) cvt_fill(p, lds, hf == 0 ? 0 : CVT_Q1, hf == 0 ? CVT_Q0 : CVT_Q2, bid, G);
            }
#endif
            SEAM(hb + 3);
#if !defined(ONLY) || ONLY == 6
            if (IN(hb + 4)) {
                PHASE_P(); unsigned char* ws = p.ws; bf16_t* Hh = (bf16_t*)(ws + WS_H) + (size_t)hf * MH * 1024; (void)Hh;
                pg8::Gemm g{pbuf(p, P_QB), (const bf16_t*)(ws + WS_WTBR) + (size_t)l * 3072 * 512, 3 * MH, 3072, 512};
                MergeOrder S; S.init(l == 0 ? 72 : 64, l == 0 ? 0 : 8, G, bid);
                EpiMerge E{pbuf(p, P_GB), Hh};
                pg8::gemm_phase<EpiMerge, MergeOrder>((PG8_LAS unsigned char*)lds, g, S, E, nullptr);
                if (l == 0) { const int skip = G > 64 ? 32 : 0; __syncthreads(); if (bid >= skip) cvt_fill(p, lds, hf == 0 ? CVT_Q0 : CVT_Q2, hf == 0 ? CVT_Q1 : CVT_Q3, bid - skip, G - skip); }
            }
#endif
            SEAM(hb + 4);
#if !defined(ONLY) || ONLY == 7
            if (IN(hb + 5)) {
                PHASE_P(); unsigned char* ws = p.ws; bf16_t* Hh = (bf16_t*)(ws + WS_H) + (size_t)hf * MH * 1024; (void)Hh;
                pg8::Gemm g{Hh, (const bf16_t*)(ws + WS_WTO) + (size_t)l * 1024 * 1024, MH, 1024, 1024};
                RectOrder S; S.init(l == 0 ? 72 : 64, 4, l == 0 ? 0 : 8, 0, 0, 0, G, bid);
                EpiOut E{l == 0 ? p.in[I_X] : (const float*)p.out, l == 0 ? p.in[I_CTX] : (const float*)(ws + WS_XC), p.out, (float*)(ws + WS_XC), (const float*)(ws + WS_MOD) + (size_t)l * 17 * 6144, hf};
                pg8::gemm_phase<EpiOut, RectOrder>((PG8_LAS unsigned char*)lds, g, S, E, nullptr);
                if (l == 0 && hf == 1) { const int skip = G > 64 ? 32 : 0; __syncthreads(); if (bid >= skip) cvt_fill(p, lds, CVT_Q3, CVT_Q4, bid - skip, G - skip); }
            }
#endif
            if (hf == 1) SEAM(hb + 5);
        }
#if !defined(ONLY) || ONLY == 8
        if (IN(base + 13)) { PHASE_P(); phase_norm2_router(p, l, lds); if (l == 1) cvt_fill(p, lds, CVT_Q4, 2 * CVT_TILES, bid, G); }
#endif
        SEAM(base + 13);
#if !defined(ONLY) || ONLY == 9
        if (IN(base + 14)) { PHASE_P(); phase_dispatch(p, l, lds); }
#endif
        SEAM(base + 14);
#if !defined(ONLY) || ONLY == 10
        if (IN(base + 15)) {
            PHASE_P(); unsigned char* ws = p.ws;
            LAS int* seg = (LAS int*)(lds + 131072); LAS int* tile_e = seg + 128;
            const int nt = moe_tile_table(p, l, seg, tile_e);
            pg8::Gemm g{pbuf(p, P_XB), (const bf16_t*)(ws + WS_WTGU + (size_t)l * 32 * 1024 * 1024), SLOTS, 32 * 1024, 512};
            MoeOrder S; S.init(tile_e, nt, G, bid); __syncthreads(); EpiGU E{ws + WS_P + P_ACT};
            pg8::gemm_phase<EpiGU, MoeOrder, false, true>((PG8_LAS unsigned char*)lds, g, S, E, nullptr);
        }
#endif
        SEAM(base + 15);
#if !defined(ONLY) || ONLY == 11
        if (IN(base + 16)) {
            PHASE_P(); unsigned char* ws = p.ws;
            LAS int* seg = (LAS int*)(lds + 131072); LAS int* tile_e = seg + 128;
            const int nt = moe_tile_table(p, l, seg, tile_e);
            pg8::Gemm g{pbuf(p, P_ACT), (const bf16_t*)(ws + WS_WTD + (size_t)l * 32 * 1024 * 512), SLOTS, 32 * 1024, 256};
            MoeOrder S; S.init(tile_e, nt, G, bid); __syncthreads(); EpiDown E{pbuf(p, P_YS)};
            pg8::gemm_phase<EpiDown, MoeOrder, false, true>((PG8_LAS unsigned char*)lds, g, S, E, nullptr);
        }
#endif
        SEAM(base + 16);
    }
#if !defined(ONLY) || ONLY == 12
    if (IN(35)) { PHASE_P(); phase_final(p); }
#endif
#ifdef PROBE
    if (bid == 0 && tid == 0) {
        asm volatile("s_waitcnt vmcnt(0)" ::: "memory");
        const unsigned long long tend = __builtin_amdgcn_s_memrealtime();
        volatile unsigned long long* st = (volatile unsigned long long*)(opaque_kp()->ws + WS_CTL) + 30000;
        unsigned long long ta = 0, tb = 0;
        for (int k = 0; k < N_PHASES; ++k) { const unsigned long long t0 = st[k], t1 = (k == N_PHASES - 1) ? tend : st[k + 1]; const unsigned long long d = t1 - t0;
            if ((PROBE_A >> k) & 1ull) ta += d; if ((PROBE_B >> k) & 1ull) tb += st[100 + k]; }
        const unsigned long long spin = ((ta + tb) / 1000ull) * 100000ull;
        while (__builtin_amdgcn_s_memrealtime() - tend < spin) __builtin_amdgcn_s_sleep(32);
    }
#endif
#undef IN
#undef SEAM
}

#ifndef MK_CUTS
#define MK_CUTS 0
#endif
extern "C" void kernel_launch(void* const* d_in, const int* in_sizes, int n_in, void* d_out, int out_size, void* d_ws, size_t ws_size, hipStream_t stream) {
    static int grid = 0;
    if (grid == 0) {
        if (n_in != 31 || in_sizes[0] != NBATCH * SEQ * DM || out_size != NBATCH * SEQ * DM || ws_size < WS_END) {
            fprintf(stderr, "kernel_launch: unexpected shapes or workspace (n_in %d, ws %zu, need %zu); nothing launched\n", n_in, ws_size, (size_t)WS_END); grid = -1; return; }
        int dev = 0, cus = 0, per_cu = 0;
        if (hipGetDevice(&dev) != hipSuccess || hipDeviceGetAttribute(&cus, hipDeviceAttributeMultiprocessorCount, dev) != hipSuccess) { grid = -1; return; }
        if (hipFuncSetAttribute((const void*)mk_fwd, hipFuncAttributeMaxDynamicSharedMemorySize, LDS_BYTES) != hipSuccess) { fprintf(stderr, "kernel_launch: hipFuncSetAttribute failed\n"); grid = -1; return; }
        if (hipOccupancyMaxActiveBlocksPerMultiprocessor(&per_cu, (const void*)mk_fwd, NTHR, LDS_BYTES) != hipSuccess || per_cu < 1) { fprintf(stderr, "kernel_launch: occupancy query says %d\n", per_cu); }
        (void)hipGetLastError();
        grid = cus;
    }
    if (grid < 0) return;
    if (hipMemsetAsync((char*)d_ws + WS_CTL, 0, CTL_BYTES, stream) != hipSuccess) return;
    Params p{};
    for (int i = 0; i < 31; ++i) p.in[i] = (const float*)d_in[i];
    p.out = (float*)d_out; p.ws = (unsigned char*)d_ws;
#if MK_CUTS == 0
    p.ph_lo = 0; p.ph_hi = N_PHASES;
    hipLaunchKernelGGL(mk_fwd, dim3(grid), dim3(NTHR), LDS_BYTES, stream, p, 0);
#else
    for (int k = 0; k < N_PHASES; ++k) {
#ifdef EXP_NOMOE
        if ((k >= 14 && k <= 17) || (k >= 31 && k <= 34)) continue;
#endif
#ifdef EXP_NOEXPERT
        if (k == 16 || k == 17 || k == 33 || k == 34) continue;
#endif
#ifdef EXP_NOGU
        if (k == 16 || k == 33) continue;
#endif
#ifdef EXP_NOMIX
        if ((k >= 2 && k <= 13) || (k >= 19 && k <= 30)) continue;
#endif
#ifdef EXP_ZEROXB
        if (k == 15 || k == 32) { hipMemsetAsync((char*)d_ws + WS_P + P_XB, 0, P_MOE_END, stream); hipMemsetAsync((char*)d_ws + WS_WTS, 0, (size_t)SLOTS * 4, stream); }
#endif
        p.ph_lo = k; p.ph_hi = k + 1; hipLaunchKernelGGL(mk_fwd, dim3(grid), dim3(NTHR), LDS_BYTES, stream, p, 0); }
#endif
}
```

```cpp
#include <hip/hip_runtime.h>
#include <cstdio>
#include <cstdint>

#define LAS __attribute__((address_space(3)))
typedef unsigned short bf16_t;
typedef short bf16x8 __attribute__((ext_vector_type(8)));
typedef short s16x4 __attribute__((ext_vector_type(4)));
typedef float f32x2 __attribute__((ext_vector_type(2)));
typedef float f32x4 __attribute__((ext_vector_type(4)));
typedef float f32x16 __attribute__((ext_vector_type(16)));
typedef unsigned u32x2 __attribute__((ext_vector_type(2)));
typedef unsigned u32x4 __attribute__((ext_vector_type(4)));

constexpr int DM = 1024, NBATCH = 16, SEQ = 2048, CTXL = 256, NCOL = 6656;
constexpr int HBAT = 8;
constexpr int MH = HBAT * (SEQ + CTXL);
constexpr int MTOT = 2 * MH;
constexpr int CTXROWS = HBAT * CTXL;
constexpr int NJ = 18;
constexpr int NEXP = 32, DEXP = 512;
constexpr int SLOTS = 81920;
constexpr float EPS = 1e-6f;
constexpr float LOG2E = 1.4426950408889634f;
constexpr float QSCALE = 0.125f * LOG2E;
constexpr int NTHR = 512;
constexpr int LDS_BYTES = 155648;
constexpr int TLD = 136;
constexpr int TILE_B = 128 * TLD * 2;

constexpr size_t AL(size_t x) { return (x + 255) / 256 * 256; }
constexpr size_t WS_CTL   = 0;
constexpr size_t CTL_BYTES = 262144;
constexpr size_t WS_MOD   = WS_CTL + CTL_BYTES;
constexpr size_t WS_WFOLD = WS_MOD + AL((size_t)2 * 17 * 6144 * 4);
constexpr size_t WS_ROPE  = WS_WFOLD + AL((size_t)2 * 16 * 1024 * 4);
constexpr size_t WS_LAM   = WS_ROPE + AL((size_t)2 * 64 * 16 * 4);
constexpr size_t WS_WRT   = WS_LAM + 256;
constexpr size_t WS_WTIN  = WS_WRT + AL((size_t)2 * 2 * 48 * 1024 * 2);
constexpr size_t WS_WTBR  = WS_WTIN + AL((size_t)2 * NCOL * 1024 * 2);
constexpr size_t WS_WTO   = WS_WTBR + AL((size_t)2 * 3072 * 512 * 2);
constexpr size_t WS_WTQKV = WS_WTO + AL((size_t)2 * 1024 * 1024 * 2);
constexpr size_t WS_WSB   = WS_WTQKV + AL((size_t)2 * 12 * 16384 * 2);
constexpr size_t WS_WTGU  = WS_WSB + AL((size_t)2 * 4 * 16384 * 2);
constexpr size_t WS_WTD   = WS_WTGU + AL((size_t)32 * 1024 * 1024 * 2);
constexpr size_t WS_XC    = WS_WTD + AL((size_t)32 * 1024 * 512 * 2);
constexpr size_t WS_H     = WS_XC + AL((size_t)4096 * 1024 * 4);
constexpr size_t WS_H8    = WS_H + AL((size_t)MTOT * 1024 * 2);
constexpr size_t WS_WTIN8 = WS_H8 + AL((size_t)MTOT * 1024);
constexpr size_t WS_EID   = WS_WTIN8 + AL((size_t)2 * 3072 * 1024);
constexpr size_t WS_WTK   = WS_EID + AL((size_t)MTOT * 8);
constexpr size_t WS_POS   = WS_WTK + AL((size_t)MTOT * 8);
constexpr size_t WS_WTS   = WS_POS + AL((size_t)MTOT * 8);
constexpr size_t WS_SRC   = WS_WTS + AL((size_t)SLOTS * 4);
constexpr size_t WS_P     = WS_SRC + AL((size_t)SLOTS * 4);
constexpr size_t S1B      = (size_t)MH * 512 * 2;
constexpr size_t P_KB = 0, P_VB = S1B, P_XMB = 2 * S1B, P_QB = 3 * S1B, P_UB = 4 * S1B, P_ZB = 5 * S1B, P_VGB = 6 * S1B;
constexpr size_t P_GB   = 7 * S1B;
constexpr size_t P_MQ   = P_GB + (size_t)3 * MH * 1024;
constexpr size_t P_MK   = P_MQ + S1B, P_MVT = P_MK + S1B, P_XCV = P_MVT + S1B;
constexpr size_t P_GATES = P_XCV + S1B;
constexpr size_t P_CLOC = P_GATES + AL((size_t)MH * 16 * 4);
constexpr size_t P_NLOC = P_CLOC + (size_t)64 * NJ * 16384 * 2;
constexpr size_t P_MST  = P_NLOC + AL((size_t)64 * NJ * 128 * 4);
constexpr size_t P_END  = P_MST + AL((size_t)64 * NJ * 4 * 4);
constexpr size_t P_XB   = 0;
constexpr size_t P_ACT  = (size_t)SLOTS * 1024;
constexpr size_t P_YS   = P_ACT + (size_t)SLOTS * 512;
constexpr size_t P_MOE_END = P_YS + (size_t)SLOTS * 1024 * 2;
constexpr float WSCALE8 = 635.0f, HSCALE8 = 10.5f, ASCALE8 = 16.0f;
constexpr size_t WS_END = WS_P + (P_END > P_MOE_END ? P_END : P_MOE_END);
constexpr int CW_EXPCNT = 0;
constexpr int CW_HIST = 32768;
constexpr int CW_BAR = 1024;

__device__ __forceinline__ unsigned cvtpk(float lo, float hi) { unsigned r; asm volatile("v_cvt_pk_bf16_f32 %0, %1, %2" : "=v"(r) : "v"(lo), "v"(hi)); return r; }
__device__ __forceinline__ float bf_lo(unsigned w) { return __uint_as_float(w << 16); }
__device__ __forceinline__ float bf_hi(unsigned w) { return __uint_as_float(w & 0xffff0000u); }
__device__ __forceinline__ float bf2f(bf16_t b) { return __uint_as_float(((unsigned)b) << 16); }
__device__ __forceinline__ bf16_t f2bf(float f) { unsigned u = __float_as_uint(f); u += 0x7FFFu + ((u >> 16) & 1u); return (bf16_t)(u >> 16); }
__device__ __forceinline__ float sigmoid_f(float x) { return __builtin_amdgcn_rcpf(1.0f + __builtin_amdgcn_exp2f(-x * LOG2E)); }
__device__ __forceinline__ float gelu_tanh_f(float x) { const float u = 0.7978845608028654f * (x + 0.044715f * x * x * x); return x * sigmoid_f(2.0f * u); }
__device__ __forceinline__ float silu_f(float x) { return x * sigmoid_f(x); }
__device__ __forceinline__ float logsigmoid_f(float x) { return fminf(x, 0.f) - 0.6931471805599453f * __builtin_amdgcn_logf(1.0f + __builtin_amdgcn_exp2f(-fabsf(x) * LOG2E)); }
__device__ __forceinline__ int crow(int r, int hi) { return (r & 3) + 8 * (r >> 2) + 4 * hi; }
__device__ __forceinline__ f32x16 mfma32(bf16x8 a, bf16x8 b, f32x16 c) { return __builtin_amdgcn_mfma_f32_32x32x16_bf16(a, b, c, 0, 0, 0); }
__device__ __forceinline__ float wave_sum(float v) { for (int o = 32; o >= 1; o >>= 1) v += __shfl_xor(v, o); return v; }
template <int CTRL, int ROWMASK> __device__ __forceinline__ float dpp_add(float v) {
    return v + __builtin_bit_cast(float, __builtin_amdgcn_update_dpp(0, __builtin_bit_cast(int, v), CTRL, ROWMASK, 0xf, true)); }
__device__ __forceinline__ float wave_sum63(float v) {
    v = dpp_add<0x111, 0xf>(v); v = dpp_add<0x112, 0xf>(v); v = dpp_add<0x114, 0xf>(v); v = dpp_add<0x118, 0xf>(v);
    v = dpp_add<0x142, 0xa>(v);
    v = dpp_add<0x143, 0xc>(v);
    return v; }
__device__ __forceinline__ float half_sum31(float v) {
    v = dpp_add<0x111, 0xf>(v); v = dpp_add<0x112, 0xf>(v); v = dpp_add<0x114, 0xf>(v); v = dpp_add<0x118, 0xf>(v);
    v = dpp_add<0x142, 0xa>(v); return v; }
__device__ __forceinline__ float wave_max(float v) { for (int o = 32; o >= 1; o >>= 1) v = fmaxf(v, __shfl_xor(v, o)); return v; }

__device__ __forceinline__ void unpack8(const u32x4 w, float (&o)[8]) { o[0] = bf_lo(w.x); o[1] = bf_hi(w.x); o[2] = bf_lo(w.y); o[3] = bf_hi(w.y); o[4] = bf_lo(w.z); o[5] = bf_hi(w.z); o[6] = bf_lo(w.w); o[7] = bf_hi(w.w); }
__device__ __forceinline__ u32x4 pack8(const float (&v)[8]) { u32x4 w; w.x = cvtpk(v[0], v[1]); w.y = cvtpk(v[2], v[3]); w.z = cvtpk(v[4], v[5]); w.w = cvtpk(v[6], v[7]); return w; }
__device__ __forceinline__ int ld_i32_dev(const int* p) { return __hip_atomic_load(p, __ATOMIC_RELAXED, __HIP_MEMORY_SCOPE_AGENT); }
__device__ __forceinline__ float ld_f32_dev(const float* p) { return __hip_atomic_load(p, __ATOMIC_RELAXED, __HIP_MEMORY_SCOPE_AGENT); }
__device__ __forceinline__ unsigned q8(float x) { return (unsigned)(int)fminf(fmaxf(rintf(x), -127.0f), 127.0f) & 0xffu; }
__device__ __forceinline__ unsigned pk4_fp8(float a, float b, float c, float d) { return q8(a) | (q8(b) << 8) | (q8(c) << 16) | (q8(d) << 24); }
#define LBAR() do { asm volatile("s_waitcnt lgkmcnt(0)" ::: "memory"); __builtin_amdgcn_s_barrier(); asm volatile("" ::: "memory"); } while (0)
__device__ __forceinline__ int opaque_tid() { int t = threadIdx.x; asm volatile("" : "+v"(t)); return t; }
#ifdef PROBE
__device__ __forceinline__ unsigned long long* probe_epi_counter() {
    unsigned char* ws = *(unsigned char* const __attribute__((address_space(4)))*)((const __attribute__((address_space(4))) char*)__builtin_amdgcn_kernarg_segment_ptr() + 256);
    const int ph = *(volatile LAS int*)(uintptr_t)(LDS_BYTES - 32);
    return (unsigned long long*)ws + 30100 + ph; }
#endif
#ifdef PROBE
#define PSEC_BEGIN() unsigned pt_ = 0; if (PROBE_SEC == 1) pt_ = (unsigned)__builtin_amdgcn_s_memrealtime()
#define PSEC_BEGINN(n) unsigned pt_ = 0; if (PROBE_SEC == (n)) pt_ = (unsigned)__builtin_amdgcn_s_memrealtime()
#define PSEC_BEGIN6() unsigned pt_ = 0; if (PROBE_SEC == 6) pt_ = (unsigned)__builtin_amdgcn_s_memrealtime()
#define PSEC_BEGIN8() unsigned pt_ = 0; if (PROBE_SEC == 8) pt_ = (unsigned)__builtin_amdgcn_s_memrealtime()
#define PSEC(id) do { if (PROBE_SEC == (id)) { const unsigned pn_ = (unsigned)__builtin_amdgcn_s_memrealtime(); if (blockIdx.x == PROBE_BLK && tid == 0) *probe_epi_counter() += (unsigned long long)(pn_ - pt_); } if (PROBE_SEC == (id) + 1) pt_ = (unsigned)__builtin_amdgcn_s_memrealtime(); } while (0)
#else
#define PSEC_BEGIN() do { } while (0)
#define PSEC_BEGIN6() do { } while (0)
#define PSEC_BEGINN(n) do { } while (0)
#define PSEC_BEGIN8() do { } while (0)
#define PSEC(id) do { } while (0)
#endif
struct Params {
    const float* in[31];
    float* out;
    unsigned char* ws;
    int ph_lo, ph_hi;
};
enum { I_X = 0, I_C, I_CTX, I_CCTX, I_WMOD, I_BMOD, I_GN1, I_GN2, I_WIN, I_DLAM, I_GSUBLN, I_WGS, I_BGS, I_GGV, I_WCONV, I_BCONV, I_WQKV, I_WIF, I_BIF,
       I_GMN, I_SKIP, I_WBR, I_WOUT, I_WRG, I_BRG, I_WRE, I_BRE, I_WEG, I_WEU, I_WED, I_GFIN };

struct RowInfo { int hf, r, isctx, b, t; };
__device__ __forceinline__ RowInfo row_info(int R) {
    RowInfo q; q.hf = R >= MH ? 1 : 0; q.r = R - q.hf * MH;
    if (q.r < CTXROWS) { q.isctx = 1; q.b = q.hf * HBAT + (q.r >> 8); q.t = q.r & 255; }
    else { q.isctx = 0; const int s = q.r - CTXROWS; q.b = q.hf * HBAT + (s >> 11); q.t = s & 2047; }
    return q;
}
#define XB_TMO      128
#define XB_XCNT(j)  (256  + 64 * (j))
#define XB_XSUB(j)  (1280 + 64 * (j))
#define XB_XGEN(j)  (2304 + 64 * (j))
#define XB_TOP      3328
#define XB_TOPGEN   3392
#define XCD_BAR_WORDS 3456
#define XB_SPIN_CAP (1u << 18)

__device__ __forceinline__ unsigned xb_ld(unsigned* p)              { return __hip_atomic_load(p, __ATOMIC_RELAXED, __HIP_MEMORY_SCOPE_AGENT); }
__device__ __forceinline__ unsigned xb_add(unsigned* p, unsigned v) { return __hip_atomic_fetch_add(p, v, __ATOMIC_RELAXED, __HIP_MEMORY_SCOPE_AGENT); }
__device__ __forceinline__ unsigned xb_xcc_id() { return (unsigned)__builtin_amdgcn_s_getreg((3 << 11) | 20) & 0xFu; }
#define XB_SPIN(cond, bar) do { unsigned _sp = 0; while (cond) { __builtin_amdgcn_s_sleep(1); \
    if ((++_sp & 255u) == 0u) { if (xb_ld(&(bar)[XB_TMO])) break; if (_sp > XB_SPIN_CAP) { atomicAdd(&(bar)[XB_TMO], 1u); break; } } } } while (0)

struct XcdBarrier {
    unsigned* bar; unsigned x;
    volatile LAS unsigned* st;
};

__device__ __forceinline__ XcdBarrier xcd_barrier_post(unsigned* bar, volatile LAS unsigned* st) {
    XcdBarrier b; b.bar = bar; b.x = xb_xcc_id(); b.st = st;
    if (threadIdx.x == 0) (void)xb_add(&bar[XB_XCNT(b.x)], 1u);
    return b;
}
__device__ __forceinline__ void xcd_barrier_complete(unsigned* bar, unsigned x, unsigned& nloc, unsigned& nx) {
    const unsigned G = gridDim.x * gridDim.y * gridDim.z;
    unsigned sum, cnt, mine, sp = 0u;
    for (;;) {
        sum = 0u; cnt = 0u; mine = 0u;
#pragma unroll
        for (unsigned j = 0; j < 16; ++j) { const unsigned c = xb_ld(&bar[XB_XCNT(j)]); sum += c; cnt += (c > 0u) ? 1u : 0u; mine = (j == x) ? c : mine; }
        if (sum == G) break;
        __builtin_amdgcn_s_sleep(1);
        if ((++sp & 255u) == 0u) { if (xb_ld(&bar[XB_TMO])) break; if (sp > XB_SPIN_CAP) { atomicAdd(&bar[XB_TMO], 1u); break; } }
    }
    nloc = mine > 0u ? mine : 1u; nx = cnt > 0u ? cnt : 1u;
}

__device__ __forceinline__ void xcd_barrier(const XcdBarrier& b) {
    asm volatile("s_waitcnt vmcnt(0)" ::: "memory");
    __syncthreads();
    if (threadIdx.x == 0) {
        unsigned* bar = b.bar;
        __builtin_amdgcn_s_waitcnt(0);
        unsigned nloc = b.st[0], nx = b.st[1];
        if (nloc == 0u) { xcd_barrier_complete(bar, b.x, nloc, nx); b.st[0] = nloc; b.st[1] = nx; }
        const unsigned old = xb_add(&bar[XB_XSUB(b.x)], 1u);
        const unsigned gen = old / nloc;
        if (old + 1u == (gen + 1u) * nloc) {
            __builtin_amdgcn_fence(__ATOMIC_RELEASE, "agent");
            asm volatile("s_waitcnt vmcnt(0)" ::: "memory");
            const unsigned og = xb_add(&bar[XB_TOP], 1u);
            const unsigned tg = og / nx;
            if (og + 1u == (tg + 1u) * nx) xb_add(&bar[XB_TOPGEN], 1u);
            else XB_SPIN(xb_ld(&bar[XB_TOPGEN]) == tg, bar);
            __builtin_amdgcn_fence(__ATOMIC_ACQUIRE, "agent");
            xb_add(&bar[XB_XGEN(b.x)], 1u);
            asm volatile("s_waitcnt vmcnt(0)" ::: "memory");
        } else {
            XB_SPIN(xb_ld(&bar[XB_XGEN(b.x)]) == gen, bar);
            __builtin_amdgcn_fence(__ATOMIC_ACQUIRE, "agent");
            asm volatile("s_waitcnt vmcnt(0)" ::: "memory");
        }
    }
    __syncthreads();
}
namespace pg8 {
#define PG8_LAS __attribute__((address_space(3)))
typedef unsigned short bf16_t;
typedef short bf16x8 __attribute__((ext_vector_type(8)));
typedef float f32x4 __attribute__((ext_vector_type(4)));
typedef unsigned u32x4 __attribute__((ext_vector_type(4)));
constexpr int BM = 256, BK = 64, HALF = 128, HTB = HALF * BK * 2  , STAGE_BYTES = 8 * HTB, NXCD = 8, WGM = 8;

__host__ __device__ __forceinline__ int lds_byte(int r, int c) { const int st = (r >> 4) * 2 + (c >> 5), rr = r & 15, cc = c & 31, ob = rr * 64 + cc * 2; return st * 1024 + (ob ^ (((ob >> 9) & 1) << 5)); }
__host__ __device__ __forceinline__ void stage_rc(int b, int& R, int& C) { const int st = b / 1024, sb = b % 1024, swz = sb ^ (((sb >> 9) & 1) << 5); R = (st >> 1) * 16 + swz / 64; C = (st & 1) * 32 + (swz % 64) / 2; }
__host__ __device__ __forceinline__ int perm32(int rho) { const int n = rho >> 4, i = rho & 15; return 8 * (i >> 2) + 4 * n + (i & 3); }

struct Unit { int pm, pn; };
struct Gemm { const bf16_t* A; const bf16_t* Bt; int M, N, K; };

struct StaticOrder {
    int nM, nN, nwg, G, c;
    __host__ __device__ void init(int M, int N, int G_, int c_) { nM = M / BM; nN = N / BM; nwg = nM * nN; G = G_; c = c_; }
    __host__ __device__ bool next(int i, Unit& u) const {
        const long L = (long)i * G + c; if (L >= nwg) return false;
        int wgid = (int)L; { const int q = nwg / NXCD, r = nwg % NXCD, xcd = wgid % NXCD, off = wgid / NXCD; wgid = (xcd < r ? xcd * (q + 1) : r * (q + 1) + (xcd - r) * q) + off; }
        const int nig = WGM * nN, gid = wgid / nig, fm = gid * WGM, gsz = (nM - fm) < WGM ? (nM - fm) : WGM;
        u.pm = fm + ((wgid % nig) % gsz); u.pn = (wgid % nig) / gsz; return true;
    }
    __device__ __forceinline__ void a_ready(const Unit&) const {}
    __device__ __forceinline__ void done(const Unit&) const {}
};
__device__ __forceinline__ unsigned cvt_pk_bf16(float lo, float hi) { unsigned r; asm volatile("v_cvt_pk_bf16_f32 %0, %1, %2" : "=v"(r) : "v"(lo), "v"(hi)); return r; }
typedef float f32x2 __attribute__((ext_vector_type(2)));
__device__ __forceinline__ f32x2 gelu_pk(f32x2 v) {
    const f32x2 av = __builtin_elementwise_abs(v), d = av * 0.2316418882f + 1.0f;
    f32x2 t; t.x = __builtin_amdgcn_rcpf(d.x); t.y = __builtin_amdgcn_rcpf(d.y);
    f32x2 q = t * 0.5307027145f + (-0.7265760135f); q = q * t + 0.7107068705f; q = q * t + (-0.142248368f); q = q * t + 0.127414796f; q = q * t;
    const f32x2 s = (v * v) * (-0.72134752044f);
    f32x2 e; e.x = __builtin_amdgcn_exp2f(s.x); e.y = __builtin_amdgcn_exp2f(s.y);
    const f32x2 m = v * (q * e), r = v - m;
    f32x2 o; o.x = v.x < 0.f ? m.x : r.x; o.y = v.y < 0.f ? m.y : r.y; return o;
}

typedef int pg8_i32x4 __attribute__((ext_vector_type(4)));
template <bool F8> struct Frag { bf16x8 k[2]; };
template <class Epi, class Sched, bool STAMP = false, bool F8 = false, bool GA = false>
__device__ __forceinline__ void gemm_phase(PG8_LAS unsigned char* lds, const Gemm g, const Sched& S, const Epi& E, unsigned long long* stamps) {
    int tid_o = threadIdx.x; asm volatile("" : "+v"(tid_o));
    const int tid = tid_o, wid = __builtin_amdgcn_readfirstlane(tid >> 6), lane = tid & 63, wr = wid >> 2, wc = wid & 3, fr = lane & 15, fq = lane >> 4;
    const int K = g.K, nt = K / BK;
    int ts_lo = 0, ts_hi = 0, nts = 0; const unsigned long long rt_entry = STAMP ? (unsigned long long)wall_clock64() : 0ull;
#define PG8_STAMP() do { if (STAMP && wid == 0 && nts < 64) { const unsigned long long _c = (unsigned long long)clock64(); \
        ts_lo = (lane == nts) ? (int)(unsigned)_c : ts_lo; ts_hi = (lane == nts) ? (int)(unsigned)(_c >> 32) : ts_hi; ++nts; } } while (0)
    PG8_STAMP();
    unsigned voffA[2], voffB[2];
#pragma unroll
    for (int i = 0; i < 2; ++i) { int R, C; stage_rc(tid * 16 + i * 8192, R, C); const int Rb = Epi::PERM ? ((R & ~31) + perm32(R & 31)) : R;
        voffA[i] = (unsigned)(R * K + C) * 2u; voffB[i] = (unsigned)(Rb * K + C) * 2u; }
    const size_t pstep = (size_t)64 * K * 2;
    const size_t kstep = (size_t)(BK * 2);
    const size_t hstep = (size_t)HALF * K * 2;
    const size_t tstep = 2 * hstep;
    const unsigned ldsw = (unsigned)wid * 1024u;
    const int aoff = lds_byte(wr * 64 + fr, fq * 8), boff = lds_byte(wc * 32 + fr, fq * 8);
#define PG8_SA(b, h) (((b) * 2 + (h)) * HTB)
#define PG8_SB(b, h) ((4 + (b) * 2 + (h)) * HTB)
#define PG8_STAGE(bufoff, gbase, voff) do { const char* _b0 = (const char*)(gbase); const char* _b1 = _b0 + pstep; asm volatile("" : "+s"(_b0), "+s"(_b1)); \
        __builtin_amdgcn_global_load_lds((const unsigned*)(_b0 + (voff)[0]), (PG8_LAS unsigned*)(lds + (bufoff) + ldsw), 16, 0, 0); \
        __builtin_amdgcn_global_load_lds((const unsigned*)(_b1 + (voff)[0]), (PG8_LAS unsigned*)(lds + (bufoff) + ldsw + 8192), 16, 0, 0); } while (0)
    unsigned gC[4] = {0u, 0u, 0u, 0u}, gN[4] = {0u, 0u, 0u, 0u}; int gR = 0, gCol = 0; stage_rc(tid * 16, gR, gCol);
#define PG8_GOFF(dst, ui_) do { _Pragma("unroll") for (int _j = 0; _j < 4; ++_j) dst[_j] = (unsigned)S.src_row((ui_), gR + 64 * _j) * (unsigned)(K * 2) + (unsigned)(gCol * 2); } while (0)
#define PG8_STAGE_G(bufoff, kptr, h, nx) do { const char* _b = (const char*)(kptr); asm volatile("" : "+s"(_b)); const unsigned _o0 = (nx) ? gN[2 * (h)] : gC[2 * (h)], _o1 = (nx) ? gN[2 * (h) + 1] : gC[2 * (h) + 1]; \
        __builtin_amdgcn_global_load_lds((const unsigned*)(_b + _o0), (PG8_LAS unsigned*)(lds + (bufoff) + ldsw), 16, 0, 0); \
        __builtin_amdgcn_global_load_lds((const unsigned*)(_b + _o1), (PG8_LAS unsigned*)(lds + (bufoff) + ldsw + 8192), 16, 0, 0); } while (0)
#define PG8_LDF(dstf, addr) do { (dstf).k[0] = *(const PG8_LAS bf16x8*)(addr); (dstf).k[1] = *(const PG8_LAS bf16x8*)((addr) + 1024); } while (0)
#define PG8_LDA(dst, b, h) do { _Pragma("unroll") for (int m = 0; m < 4; ++m) PG8_LDF(dst[m], lds + PG8_SA(b, h) + aoff + m * 2048); } while (0)
#define PG8_LDB(dst, b, h) do { _Pragma("unroll") for (int n = 0; n < 2; ++n) PG8_LDF(dst[n], lds + PG8_SB(b, h) + boff + n * 2048); } while (0)
#define PG8_MMA(ai, bj, At, Bt) do { __builtin_amdgcn_s_setprio(1); _Pragma("unroll") for (int m = 0; m < 4; ++m) _Pragma("unroll") for (int n = 0; n < 2; ++n) _Pragma("unroll") for (int k = 0; k < 2; ++k) { \
        if constexpr (F8) acc[ai][bj][m][n] = __builtin_bit_cast(f32x4, __builtin_amdgcn_mfma_i32_16x16x64_i8(__builtin_bit_cast(pg8_i32x4, Bt[n].k[k]), __builtin_bit_cast(pg8_i32x4, At[m].k[k]), __builtin_bit_cast(pg8_i32x4, acc[ai][bj][m][n]), 0, 0, 0)); \
        else acc[ai][bj][m][n] = __builtin_amdgcn_mfma_f32_16x16x32_bf16(Bt[n].k[k], At[m].k[k], acc[ai][bj][m][n], 0, 0, 0); } \
        __builtin_amdgcn_s_setprio(0); } while (0)
#define PG8_WAIT_V(n) asm volatile("s_waitcnt vmcnt(" #n ")" ::: "memory")
#define PG8_WAIT_L(n) asm volatile("s_waitcnt lgkmcnt(" #n ")" ::: "memory")
#define PG8_BAR __builtin_amdgcn_s_barrier()
#define PG8_SCHED __builtin_amdgcn_sched_barrier(0)
    Unit cur, nxt; int ui = 0;
    if (!S.next(0, cur)) return;
    f32x4 acc[2][2][4][2];
#pragma unroll
    for (int a = 0; a < 2; ++a)
#pragma unroll
        for (int b = 0; b < 2; ++b)
#pragma unroll
            for (int m = 0; m < 4; ++m)
#pragma unroll
                for (int n = 0; n < 2; ++n) acc[a][b][m][n] = (f32x4){0.f, 0.f, 0.f, 0.f};
    Frag<F8> At[4], B0[2], B1[2];
    const char* cA = (const char*)g.A + (size_t)cur.pm * tstep; const char* cB = (const char*)g.Bt + (size_t)cur.pn * tstep;
    S.a_ready(cur);
    const char* A0 = (const char*)g.A; if constexpr (GA) PG8_GOFF(gC, 0);
    PG8_STAGE(PG8_SB(0, 0), cB, voffB); if constexpr (GA) PG8_STAGE_G(PG8_SA(0, 0), A0, 0, false); else PG8_STAGE(PG8_SA(0, 0), cA, voffA);
    PG8_STAGE(PG8_SB(0, 1), cB + hstep, voffB); if constexpr (GA) PG8_STAGE_G(PG8_SA(0, 1), A0, 1, false); else PG8_STAGE(PG8_SA(0, 1), cA + hstep, voffA);
    if (wr == 1) PG8_BAR;
    PG8_WAIT_V(4); PG8_BAR;
    PG8_STAGE(PG8_SB(1, 0), cB + kstep, voffB); if constexpr (GA) PG8_STAGE_G(PG8_SA(1, 0), A0 + kstep, 0, false); else PG8_STAGE(PG8_SA(1, 0), cA + kstep, voffA);
    PG8_STAGE(PG8_SB(1, 1), cB + hstep + kstep, voffB);
    PG8_WAIT_V(6); PG8_BAR;
    PG8_STAMP();
    for (;;) {
        const bool has_next = S.next(ui + 1, nxt);
        const char* nA = has_next ? (const char*)g.A + (size_t)nxt.pm * tstep : cA; const char* nB = has_next ? (const char*)g.Bt + (size_t)nxt.pn * tstep : cB;
        if constexpr (GA) { if (has_next) PG8_GOFF(gN, ui + 1); else { gN[0] = gC[0]; gN[1] = gC[1]; gN[2] = gC[2]; gN[3] = gC[3]; } }
        for (int t = 0; t < nt; t += 2) {
            const bool last = (t == nt - 2);
            const char* a1 = cA + (size_t)(t + 1) * kstep;
            const char* a2 = last ? nA : cA + (size_t)(t + 2) * kstep; const char* b2 = last ? nB : cB + (size_t)(t + 2) * kstep;
            const char* a3 = a2 + kstep; const char* b3 = b2 + kstep;
            const char* kA1 = A0 + (size_t)(t + 1) * kstep; const char* kA2 = last ? A0 : A0 + (size_t)(t + 2) * kstep; const char* kA3 = kA2 + kstep;
            if (last && has_next) S.a_ready(nxt);
            PG8_LDB(B0, 0, 0); PG8_SCHED; PG8_LDA(At, 0, 0); if constexpr (GA) PG8_STAGE_G(PG8_SA(1, 1), kA1, 1, false); else PG8_STAGE(PG8_SA(1, 1), a1 + hstep, voffA);
            PG8_WAIT_L(8); PG8_BAR; PG8_WAIT_L(0); PG8_MMA(0, 0, At, B0); PG8_BAR; PG8_SCHED;
            PG8_LDB(B1, 0, 1); PG8_STAGE(PG8_SB(0, 0), b2, voffB);
            PG8_BAR; PG8_WAIT_L(0); PG8_MMA(0, 1, At, B1); PG8_BAR;
            PG8_LDA(At, 0, 1); if constexpr (GA) PG8_STAGE_G(PG8_SA(0, 0), kA2, 0, last); else PG8_STAGE(PG8_SA(0, 0), a2, voffA);
            PG8_BAR; PG8_WAIT_L(0); PG8_MMA(1, 0, At, B0); PG8_BAR; PG8_SCHED;
            PG8_STAGE(PG8_SB(0, 1), b2 + hstep, voffB);
            PG8_WAIT_V(6); PG8_BAR; PG8_MMA(1, 1, At, B1); PG8_BAR;
            PG8_LDB(B0, 1, 0); PG8_SCHED; PG8_LDA(At, 1, 0); if constexpr (GA) PG8_STAGE_G(PG8_SA(0, 1), kA2, 1, last); else PG8_STAGE(PG8_SA(0, 1), a2 + hstep, voffA);
            PG8_WAIT_L(8); PG8_BAR; PG8_WAIT_L(0); PG8_MMA(0, 0, At, B0); PG8_BAR; PG8_SCHED;
            PG8_LDB(B1, 1, 1); PG8_STAGE(PG8_SB(1, 0), b3, voffB);
            PG8_BAR; PG8_WAIT_L(0); PG8_MMA(0, 1, At, B1); PG8_BAR;
            PG8_LDA(At, 1, 1); if constexpr (GA) PG8_STAGE_G(PG8_SA(1, 0), kA3, 0, last); else PG8_STAGE(PG8_SA(1, 0), a3, voffA);
            PG8_BAR; PG8_WAIT_L(0); PG8_MMA(1, 0, At, B0); PG8_BAR; PG8_SCHED;
            PG8_STAGE(PG8_SB(1, 1), b3 + hstep, voffB);
            PG8_WAIT_V(6); PG8_BAR; PG8_MMA(1, 1, At, B1); PG8_BAR;
        }
        PG8_STAMP();
#ifdef PROBE_EPI
        const unsigned long long te0_ = __builtin_amdgcn_s_memrealtime();
#endif
        const bool keep_acc = E(acc, cur, wr, wc, fr, fq); S.done(cur);
#ifdef PROBE_EPI
        if (blockIdx.x == 0 && tid == 0) { unsigned long long* ec_ = probe_epi_counter(); *ec_ += __builtin_amdgcn_s_memrealtime() - te0_; }
#endif
        PG8_STAMP();
        if (!has_next) break;
        if (!keep_acc)
#pragma unroll
        for (int a = 0; a < 2; ++a)
#pragma unroll
            for (int b = 0; b < 2; ++b)
#pragma unroll
                for (int m = 0; m < 4; ++m)
#pragma unroll
                    for (int n = 0; n < 2; ++n) acc[a][b][m][n] = (f32x4){0.f, 0.f, 0.f, 0.f};
        cur = nxt; cA = nA; cB = nB; ++ui;
        if constexpr (GA) { gC[0] = gN[0]; gC[1] = gN[1]; gC[2] = gN[2]; gC[3] = gN[3]; }
    }
    PG8_WAIT_V(0);
    if (wr == 0) PG8_BAR;
    PG8_BAR;
    PG8_STAMP();
    if (STAMP && wid == 0) { stamps[lane] = lane < nts ? (((unsigned long long)(unsigned)ts_hi << 32) | (unsigned)ts_lo) : 0ull;
        if (lane == 62) stamps[62] = rt_entry; if (lane == 63) stamps[63] = (unsigned long long)wall_clock64(); }
#undef PG8_STAMP
#undef PG8_SA
#undef PG8_SB
#undef PG8_STAGE
#undef PG8_STAGE_G
#undef PG8_GOFF
#undef PG8_LDA
#undef PG8_LDF
#undef PG8_LDB
#undef PG8_MMA
#undef PG8_WAIT_V
#undef PG8_WAIT_L
#undef PG8_BAR
#undef PG8_SCHED
}
}
struct RectOrder {
    pg8::StaticOrder so; int offA, nwgA, nMb, nNb, offB, nwgB, G, c;
    __device__ void init(int nMa, int nNa, int offA_, int nMb_, int nNb_, int offB_, int G_, int c_) {
        so.init(nMa * 256, nNa * 256, G_, c_); offA = offA_; nwgA = nMa * nNa; nMb = nMb_; nNb = nNb_; offB = offB_; nwgB = nMb_ * nNb_; G = G_; c = c_; }
    __device__ bool next(int i, pg8::Unit& u) const {
        const int L = i * G + c;
        if (L < nwgA) { so.next(i, u); u.pm += offA; return true; }
        const int Lb = L - nwgA; if (Lb >= nwgB) return false;
        u.pm = offB + Lb % nMb; u.pn = Lb / nMb; return true;
    }
    __device__ __forceinline__ void a_ready(const pg8::Unit&) const {}
    __device__ __forceinline__ void done(const pg8::Unit&) const {}
};
struct MergeOrder {
    pg8::StaticOrder so; int off, G, c;
    __device__ void init(int nM, int off_, int G_, int c_) { so.init(nM * 256, 1024, G_, c_); off = off_; G = G_; c = c_; }
    __device__ bool next(int i, pg8::Unit& u) const {
        const int ti = i / 3, br = i - ti * 3;
        if (!so.next(ti, u)) return false;
        u.pm += off + br * (MH / 256); u.pn += br * 4; return true;
    }
    __device__ __forceinline__ void a_ready(const pg8::Unit&) const {}
    __device__ __forceinline__ void done(const pg8::Unit&) const {}
};
struct MoeOrder {
    const LAS int* srcl = nullptr;
    __device__ __forceinline__ int src_row(int i, int r) const { return srcl[i * 256 + r]; }
    int e0, e1, e2, e3, e4, e5, ntiles, G, c;
    __device__ __forceinline__ void unit_of(int i, int& pm, int& pn) const {
        if ((G & 31) == 0) { const int j = c >> 3; pm = i * (G >> 2) + (c & 7) * (G >> 5) + (j >> 2); pn = j & 3; }
        else { const int L = i * G + c; pm = L >> 2; pn = L & 3; } }
    __device__ __forceinline__ int look(const LAS int* tile_e, int i) const { int pm, pn; unit_of(i, pm, pn); return __builtin_amdgcn_readfirstlane(pm < ntiles ? tile_e[pm] : 0); }
    __device__ __forceinline__ void init(const LAS int* tile_e, int nt, int G_, int c_) { ntiles = nt; G = G_; c = c_;
        e0 = look(tile_e, 0); e1 = look(tile_e, 1); e2 = look(tile_e, 2); e3 = look(tile_e, 3); e4 = look(tile_e, 4); e5 = look(tile_e, 5); }
    __device__ __forceinline__ bool next(int i, pg8::Unit& u) const {
        int pm, pn; unit_of(i, pm, pn); if (pm >= ntiles || i >= 6) return false;
        const int e = i == 0 ? e0 : i == 1 ? e1 : i == 2 ? e2 : i == 3 ? e3 : i == 4 ? e4 : e5;
        u.pm = pm; u.pn = e * 4 + pn; return true;
    }
    __device__ __forceinline__ void a_ready(const pg8::Unit&) const {}
    __device__ __forceinline__ void done(const pg8::Unit&) const {}
};

struct EpiIn {
    static constexpr bool PERM = true, AFTER_DRAIN = false;
    bf16_t* P; bf16_t* GB; const float* cosT; const float* sinT;
    __device__ __forceinline__ bool operator()(pg8::f32x4 (&acc)[2][2][4][2], const pg8::Unit& u, int wr, int wc, int fr, int fq) const {
        const int pn = u.pn, rbase = u.pm * 256 + wr * 64 + fr;
        int act, ld; bf16_t* dst; int cb; bool rope = false; float scl = 1.0f;
        if (pn < 14) {
            const int kind = pn >> 1;
            const int bufidx = kind == 5 ? 6 : (kind == 6 ? 5 : kind);
            dst = P + (size_t)bufidx * ((size_t)MH * 512); ld = 512; cb = (pn & 1) * 256 + wc * 32 + 8 * fq;
            act = (kind == 4 || kind == 5) ? 1 : (kind == 6 ? 2 : 0);
            rope = (kind == 0 || kind == 3) && (u.pm >= 8);
            if (kind == 3) scl = QSCALE;
        } else {
            const int gi = (pn - 14) >> 2, pnl = (pn - 14) & 3, tid = (wr * 4 + wc) * 64 + fq * 16 + fr;
            u32x2* gdst = (u32x2*)GB + ((size_t)((gi * (MH / 256) + u.pm) * 4 + pnl) * 16) * 512 + tid;
#pragma unroll
            for (int ai = 0; ai < 2; ++ai)
#pragma unroll
                for (int m = 0; m < 4; ++m)
#pragma unroll
                    for (int bj = 0; bj < 2; ++bj) { unsigned q[8];
#pragma unroll
                        for (int j = 0; j < 4; ++j) { q[j] = (unsigned)fminf(fmaxf(sigmoid_f(acc[ai][bj][m][0][j]) * 255.0f + 0.5f, 1.0f), 255.0f); q[4 + j] = (unsigned)fminf(fmaxf(sigmoid_f(acc[ai][bj][m][1][j]) * 255.0f + 0.5f, 1.0f), 255.0f); }
                        u32x2 w; w.x = q[0] | (q[1] << 8) | (q[2] << 16) | (q[3] << 24); w.y = q[4] | (q[5] << 8) | (q[6] << 16) | (q[7] << 24);
                        gdst[(size_t)((ai * 4 + m) * 2 + bj) * 512] = w; }
            return false;
        }
        pg8::f32x4 csv[8], snv[8];
#pragma unroll
        for (int i = 0; i < 8; ++i) { csv[i] = (pg8::f32x4){1.f, 1.f, 1.f, 1.f}; snv[i] = (pg8::f32x4){0.f, 0.f, 0.f, 0.f}; }
        if (rope) {
#pragma unroll
            for (int i = 0; i < 8; ++i) { const int row = rbase + (i >> 2) * 128 + (i & 3) * 16; const int t = (row - CTXROWS) & 2047; const int pos = (wc & 1) ? (t & 63) : (t >> 6);
                csv[i] = *(const pg8::f32x4*)(cosT + pos * 16 + 4 * fq); snv[i] = *(const pg8::f32x4*)(sinT + pos * 16 + 4 * fq); } }
#pragma unroll
        for (int ai = 0; ai < 2; ++ai)
#pragma unroll
            for (int m = 0; m < 4; ++m) {
                const int row = rbase + ai * 128 + m * 16;
                const pg8::f32x4 cs = csv[ai * 4 + m], sn = snv[ai * 4 + m];
                bf16_t* rowp = dst + (size_t)row * ld + cb;
#pragma unroll
                for (int bj = 0; bj < 2; ++bj) {
                    pg8::f32x4 v0 = acc[ai][bj][m][0], v1 = acc[ai][bj][m][1];
                    if (rope) { const pg8::f32x4 o0 = v0 * cs - v1 * sn, o1 = v0 * sn + v1 * cs; v0 = o0; v1 = o1; }
                    v0 *= scl; v1 *= scl;
                    if (act == 1) {
#pragma unroll
                        for (int j = 0; j < 4; ++j) { v0[j] = gelu_tanh_f(v0[j]); v1[j] = gelu_tanh_f(v1[j]); } }
                    else if (act == 2) {
#pragma unroll
                        for (int j = 0; j < 4; ++j) { v0[j] = fmaxf(sigmoid_f(v0[j]), 1e-6f); v1[j] = fmaxf(sigmoid_f(v1[j]), 1e-6f); } }
                    u32x4 w; w.x = cvtpk(v0[0], v0[1]); w.y = cvtpk(v0[2], v0[3]); w.z = cvtpk(v1[0], v1[1]); w.w = cvtpk(v1[2], v1[3]);
                    *(u32x4*)(rowp + bj * 128) = w;
                }
            }
        return false;
    }
};
struct EpiGate8 {
    static constexpr bool PERM = true, AFTER_DRAIN = false;
    bf16_t* GB;
    __device__ __forceinline__ bool operator()(pg8::f32x4 (&acc)[2][2][4][2], const pg8::Unit& u, int wr, int wc, int fr, int fq) const {
        const int gi = u.pn >> 2, pnl = u.pn & 3, tid = (wr * 4 + wc) * 64 + fq * 16 + fr; const float sc = 1.0f / (HSCALE8 * WSCALE8);
        u32x2* gdst = (u32x2*)GB + ((size_t)((gi * (MH / 256) + u.pm) * 4 + pnl) * 16) * 512 + tid;
#pragma unroll
        for (int ai = 0; ai < 2; ++ai)
#pragma unroll
            for (int m = 0; m < 4; ++m)
#pragma unroll
                for (int bj = 0; bj < 2; ++bj) { unsigned q[8];
#pragma unroll
                    for (int j = 0; j < 4; ++j) { q[j] = (unsigned)fminf(fmaxf(sigmoid_f((float)__float_as_int(acc[ai][bj][m][0][j]) * sc) * 255.0f + 0.5f, 1.0f), 255.0f);
                        q[4 + j] = (unsigned)fminf(fmaxf(sigmoid_f((float)__float_as_int(acc[ai][bj][m][1][j]) * sc) * 255.0f + 0.5f, 1.0f), 255.0f); }
                    u32x2 w; w.x = q[0] | (q[1] << 8) | (q[2] << 16) | (q[3] << 24); w.y = q[4] | (q[5] << 8) | (q[6] << 16) | (q[7] << 24);
                    gdst[(size_t)((ai * 4 + m) * 2 + bj) * 512] = w; }
        return false;
    }
};
struct EpiMerge {
    static constexpr bool PERM = true, AFTER_DRAIN = false;
    const bf16_t* GB; bf16_t* OUT;
    __device__ __forceinline__ bool operator()(pg8::f32x4 (&acc)[2][2][4][2], const pg8::Unit& u, int wr, int wc, int fr, int fq) const {
        const int br = u.pn >> 2, pn = u.pn & 3, pm = u.pm - br * (MH / 256), tid = (wr * 4 + wc) * 64 + fq * 16 + fr;
        const int rbase = pm * 256 + wr * 64 + fr, cb = pn * 256 + wc * 32 + 8 * fq;
        const u32x2* g0 = (const u32x2*)GB + ((size_t)((br * (MH / 256) + pm) * 4 + pn) * 16) * 512 + tid;
        const u32x2* g1 = g0 + (size_t)(MH / 256) * 4 * 16 * 512;
        u32x2 ga_[16], gb_[16];
#pragma unroll
        for (int s = 0; s < 16; ++s) { ga_[s] = g0[(size_t)s * 512]; gb_[s] = (br < 2) ? g1[(size_t)s * 512] : (u32x2){0x01010101u, 0x01010101u}; }
#pragma unroll
        for (int ai = 0; ai < 2; ++ai)
#pragma unroll
            for (int m = 0; m < 4; ++m) {
                const size_t off = (size_t)(rbase + ai * 128 + m * 16) * 1024 + cb;
#pragma unroll
                for (int bj = 0; bj < 2; ++bj) {
                    const int slot = (ai * 4 + m) * 2 + bj;
                    const u32x2 a = ga_[slot], b = gb_[slot];
                    float ga[8];
#pragma unroll
                    for (int j = 0; j < 4; ++j) { ga[j] = (float)((a.x >> (8 * j)) & 0xffu); ga[4 + j] = (float)((a.y >> (8 * j)) & 0xffu); }
                    if (br < 2) {
#pragma unroll
                        for (int j = 0; j < 4; ++j) { ga[j] *= __builtin_amdgcn_rcpf((float)((b.x >> (8 * j)) & 0xffu)); ga[4 + j] *= __builtin_amdgcn_rcpf((float)((b.y >> (8 * j)) & 0xffu)); }
                    } else {
#pragma unroll
                        for (int j = 0; j < 8; ++j) ga[j] *= (1.0f / 255.0f);
                    }
                    pg8::f32x4 v0 = acc[ai][bj][m][0], v1 = acc[ai][bj][m][1];
#pragma unroll
                    for (int j = 0; j < 4; ++j) { v0[j] *= ga[j]; v1[j] *= ga[4 + j]; }
                    if (br < 2) { acc[ai][bj][m][0] = v0; acc[ai][bj][m][1] = v1; }
                    else { u32x4 w; w.x = cvtpk(v0[0], v0[1]); w.y = cvtpk(v0[2], v0[3]); w.z = cvtpk(v1[0], v1[1]); w.w = cvtpk(v1[2], v1[3]);
                        *(u32x4*)(OUT + off + bj * 128) = w; }
                }
            }
        return br < 2;
    }
};
struct EpiOut {
    static constexpr bool PERM = false, AFTER_DRAIN = false;
    const float* xres_lat; const float* xres_ctx; float* xs_lat; float* xs_ctx; const float* mod; int hf;
    __device__ __forceinline__ bool operator()(pg8::f32x4 (&acc)[2][2][4][2], const pg8::Unit& u, int wr, int wc, int fr, int fq) const {
        const int pm = u.pm; const float* src; float* dst; int b;
        if (pm < 8) { b = 16; const size_t o = (size_t)((hf * HBAT + pm) * 256) * 1024; src = xres_ctx + o; dst = xs_ctx + o; }
        else { const int q = pm - 8; b = hf * HBAT + (q >> 3); const size_t o = ((size_t)b * 2048 + (size_t)(q & 7) * 256) * 1024; src = xres_lat + o; dst = xs_lat + o; }
        const int col0 = u.pn * 256 + wc * 32 + 4 * fq;
        const float* mrow = mod + (size_t)b * 6144 + 2 * 1024 + col0;
        pg8::f32x4 mv[2][2];
#pragma unroll
        for (int bj = 0; bj < 2; ++bj)
#pragma unroll
            for (int n = 0; n < 2; ++n) mv[bj][n] = *(const pg8::f32x4*)(mrow + bj * 128 + n * 16);
#pragma unroll
        for (int ai = 0; ai < 2; ++ai) {
            pg8::f32x4 xr[4][2][2];
#pragma unroll
            for (int m = 0; m < 4; ++m) { const size_t off = (size_t)(wr * 64 + fr + ai * 128 + m * 16) * 1024 + col0;
#pragma unroll
                for (int bj = 0; bj < 2; ++bj)
#pragma unroll
                    for (int n = 0; n < 2; ++n) xr[m][bj][n] = *(const pg8::f32x4*)(src + off + bj * 128 + n * 16); }
#pragma unroll
            for (int m = 0; m < 4; ++m) { const size_t off = (size_t)(wr * 64 + fr + ai * 128 + m * 16) * 1024 + col0;
#pragma unroll
                for (int bj = 0; bj < 2; ++bj)
#pragma unroll
                    for (int n = 0; n < 2; ++n) *(pg8::f32x4*)(dst + off + bj * 128 + n * 16) = xr[m][bj][n] + mv[bj][n] * acc[ai][bj][m][n]; }
            asm volatile("" ::: "memory");
        }
        return false;
    }
};
struct EpiGU {
    static constexpr bool PERM = true, AFTER_DRAIN = false;
    unsigned char* ACT;
    __device__ __forceinline__ bool operator()(pg8::f32x4 (&acc)[2][2][4][2], const pg8::Unit& u, int wr, int wc, int fr, int fq) const {
        const int rbase = u.pm * 256 + wr * 64 + fr, cb = (u.pn & 3) * 128 + wc * 32 + 8 * fq;
        const float sc = 1.0f / (HSCALE8 * WSCALE8);
#pragma unroll
        for (int ai = 0; ai < 2; ++ai)
#pragma unroll
            for (int m = 0; m < 4; ++m) {
                float o[8];
#pragma unroll
                for (int n = 0; n < 2; ++n)
#pragma unroll
                    for (int j = 0; j < 4; ++j) o[4 * n + j] = silu_f((float)__float_as_int(acc[ai][0][m][n][j]) * sc) * ((float)__float_as_int(acc[ai][1][m][n][j]) * (sc * ASCALE8));
                u32x2 w; w.x = pk4_fp8(o[0], o[1], o[2], o[3]); w.y = pk4_fp8(o[4], o[5], o[6], o[7]);
                *(u32x2*)(ACT + (size_t)(rbase + ai * 128 + m * 16) * 512 + cb) = w;
            }
        return false;
    }
};
struct EpiDown {
    static constexpr bool PERM = true, AFTER_DRAIN = false;
    bf16_t* YS;
    __device__ __forceinline__ bool operator()(pg8::f32x4 (&acc)[2][2][4][2], const pg8::Unit& u, int wr, int wc, int fr, int fq) const {
        const int rbase = u.pm * 256 + wr * 64 + fr, cb = (u.pn & 3) * 256 + wc * 32 + 8 * fq;
#pragma unroll
        for (int ai = 0; ai < 2; ++ai)
#pragma unroll
            for (int m = 0; m < 4; ++m) {
                const int row = rbase + ai * 128 + m * 16;
#pragma unroll
                for (int bj = 0; bj < 2; ++bj) { const float s8 = 1.0f / (ASCALE8 * WSCALE8); u32x4 w;
                    w.x = cvtpk((float)__float_as_int(acc[ai][bj][m][0][0]) * s8, (float)__float_as_int(acc[ai][bj][m][0][1]) * s8); w.y = cvtpk((float)__float_as_int(acc[ai][bj][m][0][2]) * s8, (float)__float_as_int(acc[ai][bj][m][0][3]) * s8);
                    w.z = cvtpk((float)__float_as_int(acc[ai][bj][m][1][0]) * s8, (float)__float_as_int(acc[ai][bj][m][1][1]) * s8); w.w = cvtpk((float)__float_as_int(acc[ai][bj][m][1][2]) * s8, (float)__float_as_int(acc[ai][bj][m][1][3]) * s8);
                    *(u32x4*)(YS + (size_t)row * 1024 + cb + bj * 128) = w; }
            }
        return false;
    }
};
template <class ColMap>
__device__ __forceinline__ void cvt_tile_T(const float* __restrict__ src, int ldsrc, bf16_t* __restrict__ dst, int K, int k0, int n0, const ColMap& cm, float scale, LAS float* tile) {
    const int tid = opaque_tid();
    {
        const int n = tid & 63, kb = tid >> 6; const int sc = cm(n0 + n);
#pragma unroll
        for (int i = 0; i < 8; ++i) { const int k = kb + 8 * i; tile[k * 65 + n] = src[(size_t)(k0 + k) * ldsrc + sc] * scale; }
    }
    __syncthreads();
    {
        const int kp = (tid & 31) * 2, nb = tid >> 5;
#pragma unroll
        for (int i = 0; i < 4; ++i) { const int n = nb + 16 * i; *(unsigned*)(dst + (size_t)(n0 + n) * K + k0 + kp) = cvtpk(tile[kp * 65 + n], tile[(kp + 1) * 65 + n]); }
    }
    __syncthreads();
}
struct CmIdent { int off; __device__ __forceinline__ int operator()(int n) const { return n + off; } };
struct CmWin {
    __device__ __forceinline__ int operator()(int n) const {
        if (n < 512 || (n >= 1536 && n < 2048)) { const int c = n & 31, f = c >> 3, j = c & 7; return (n & ~31) + ((j < 4) ? (4 * f + j) : (16 + 4 * f + (j - 4))); }
        return n; }
};
struct CmGU {
    __device__ __forceinline__ int operator()(int n) const { return 128 * (n >> 8) + (n & 127); }
};

template <int MODE, bool OUT8 = false>
__device__ __forceinline__ void cvt_tile_T256(const float* __restrict__ baseA, const float* __restrict__ baseB, int ldsrc, void* __restrict__ dstv, int K, int k0, int n0, float scale, LAS float* tile) {
    const int tid = opaque_tid();
    {
        const int n = tid & 255, kb = tid >> 8, ng = n0 + n;
        const float* sp = (MODE == 2 ? ((ng & 128) ? baseB : baseA) + 128 * (ng >> 8) + (ng & 127) : MODE == 1 ? baseA + CmWin{}(ng) : baseA + ng) + (size_t)(k0 + kb) * ldsrc;
        float v[32];
#pragma unroll
        for (int i = 0; i < 32; ++i) v[i] = sp[(size_t)(2 * i) * ldsrc];
#pragma unroll
        for (int i = 0; i < 32; ++i) tile[(kb + 2 * i) * 257 + n] = v[i] * scale;
    }
    __syncthreads();
    {
        const int n = tid >> 1, kh = (tid & 1) * 32;
        if constexpr (OUT8) { unsigned char* dp = (unsigned char*)dstv + (size_t)(n0 + n) * K + k0 + kh;
#pragma unroll
            for (int i = 0; i < 2; ++i) { float f[16];
#pragma unroll
                for (int j = 0; j < 16; ++j) f[j] = tile[(kh + 16 * i + j) * 257 + n];
                u32x4 w; w.x = pk4_fp8(f[0], f[1], f[2], f[3]); w.y = pk4_fp8(f[4], f[5], f[6], f[7]); w.z = pk4_fp8(f[8], f[9], f[10], f[11]); w.w = pk4_fp8(f[12], f[13], f[14], f[15]);
                *(u32x4*)(dp + 16 * i) = w; } }
        else { bf16_t* dp = (bf16_t*)dstv + (size_t)(n0 + n) * K + k0 + kh;
#pragma unroll
            for (int i = 0; i < 4; ++i) { float f[8];
#pragma unroll
                for (int j = 0; j < 8; ++j) f[j] = tile[(kh + 8 * i + j) * 257 + n];
                *(u32x4*)(dp + 8 * i) = pack8(f); } }
    }
    __syncthreads();
}

__device__ __forceinline__ void phase_prologue(const Params& p, LAS unsigned char* lds) {
    LAS float* tile = (LAS float*)lds;
    const int tid = opaque_tid(), G = gridDim.x, bid = blockIdx.x;
    unsigned char* ws = p.ws;
    for (int u = bid; u < 1248; u += G) {
        if (u < 448) { const int l = u / 224, r = u % 224, kt = r / 14, nt = r % 14;
            cvt_tile_T256<1>(p.in[I_WIN] + (size_t)l * 1024 * NCOL, nullptr, NCOL, (bf16_t*)(ws + WS_WTIN) + (size_t)l * NCOL * 1024, 1024, kt * 64, nt * 256, 1.0f, tile); }
        else if (u < 832) { const int v = u - 448, l = v / 192, r = v % 192, kt = r / 12, nt = r % 12;
            cvt_tile_T256<0, true>(p.in[I_WIN] + (size_t)l * 1024 * NCOL + 3584, nullptr, NCOL, ws + WS_WTIN8 + (size_t)l * 3072 * 1024, 1024, kt * 64, nt * 256, WSCALE8, tile); }
        else if (u < 1024) { const int v = u - 832, li = v / 32, r = v % 32, kt = r / 4, nt = r % 4;
            cvt_tile_T256<0>(p.in[I_WBR] + (size_t)li * 512 * 1024, nullptr, 1024, (bf16_t*)(ws + WS_WTBR) + (size_t)li * 1024 * 512, 512, kt * 64, nt * 256, 1.0f, tile); }
        else if (u < 1152) { const int v = u - 1024, l = v / 64, r = v % 64, kt = r / 4, nt = r % 4;
            cvt_tile_T256<0>(p.in[I_WOUT] + (size_t)l * 1024 * 1024, nullptr, 1024, (bf16_t*)(ws + WS_WTO) + (size_t)l * 1024 * 1024, 1024, kt * 64, nt * 256, 1.0f, tile); }
        else { const int v = u - 1152, m = v / 4, r = v % 4, kt = r >> 1, nt = r & 1;
            const int j = (m >> 2) % 3;
            cvt_tile_T(p.in[I_WQKV] + (size_t)m * 16384, 128, (bf16_t*)(ws + WS_WTQKV) + (size_t)m * 16384, 128, kt * 64, nt * 64, CmIdent{0}, j == 1 ? 0.08838834764831845f : 1.0f, tile); }
    }
    const int gt = bid * NTHR + tid, gn = G * NTHR;
    for (int i = gt; i < 2 * 4 * 16384; i += gn) ((bf16_t*)(ws + WS_WSB))[i] = f2bf(p.in[I_WGS][i]);
    for (int i = gt; i < 2 * 48 * 1024; i += gn) {
        const int l = i / (48 * 1024), r = i % (48 * 1024), n = r >> 10, k = r & 1023;
        float w = 0.f; if (n < 4) w = p.in[I_WRG][((size_t)l * 1024 + k) * 4 + n]; else if (n < 36) w = p.in[I_WRE][((size_t)l * 1024 + k) * 32 + (n - 4)];
        const bf16_t hi = f2bf(w); const bf16_t lo = f2bf(w - bf2f(hi));
        bf16_t* d = (bf16_t*)(ws + WS_WRT) + (size_t)l * 2 * 48 * 1024;
        d[r] = hi; d[48 * 1024 + r] = lo;
    }
    for (int i = gt; i < 1024; i += gn) { const int pos = i >> 4, f = i & 15; const float inv = powf(10000.0f, -(float)f / 16.0f); const float a = (float)pos * inv;
        ((float*)(ws + WS_ROPE))[i] = cosf(a); ((float*)(ws + WS_ROPE))[1024 + i] = sinf(a); }
    if (gt < 2) { const int l = gt; const float* lp = p.in[I_DLAM] + l * 256; float s01 = 0.f, s23 = 0.f;
        for (int i = 0; i < 64; ++i) { s01 += lp[i] * lp[64 + i]; s23 += lp[128 + i] * lp[192 + i]; }
        const float lam_init = 0.8f - 0.6f * expf(-0.3f * (float)l);
        float* o = (float*)(ws + WS_LAM) + l * 4; o[0] = expf(s01) - expf(s23) + lam_init; o[1] = 1.0f - lam_init; }
    for (int i = gt; i < 2 * 16 * 1024; i += gn) {
        const int l = i >> 14, gc = (i >> 10) & 15, ch = i & 1023, part = ch >> 9, c = ch & 511, h = c >> 7, d = c & 127;
        const float* wif = p.in[I_WIF] + (size_t)l * 1536 * 16; const float* wq = p.in[I_WQKV] + (size_t)l * 3 * 4 * 16384;
        float s = 0.f;
        if (part == 0) { const float* a = wq + ((size_t)(0 * 4 + h) * 128 + d) * 128; const float* b = wq + ((size_t)(1 * 4 + h) * 128 + d) * 128;
            for (int e = 0; e < 128; ++e) s += a[e] * wif[(size_t)(h * 128 + e) * 16 + gc] + b[e] * wif[(size_t)(512 + h * 128 + e) * 16 + gc]; }
        else { const float* a = wq + ((size_t)(2 * 4 + h) * 128 + d) * 128;
            for (int e = 0; e < 128; ++e) s += a[e] * wif[(size_t)(1024 + h * 128 + e) * 16 + gc]; }
        ((float*)(ws + WS_WFOLD))[i] = s;
    }
    {
        LAS float* sc = (LAS float*)lds;
        LAS float* red = sc + 17 * 1024;
        bool loaded = false;
        for (int u = bid; u < 192; u += G) {
            if (!loaded) { for (int i = tid; i < 17 * 1024; i += NTHR) { const float v = i < 16384 ? p.in[I_C][i] : p.in[I_CCTX][i - 16384]; sc[i] = silu_f(v); } loaded = true; }
            __syncthreads();
            const int l = u / 96, cbk = u % 96, col = cbk * 64 + (tid & 63), kq = tid >> 6;
            float a[17];
#pragma unroll
            for (int b = 0; b < 17; ++b) a[b] = 0.f;
            const float* wp = p.in[I_WMOD] + (size_t)l * 1024 * 6144 + col;
            for (int k0 = kq * 128; k0 < kq * 128 + 128; k0 += 8) { float w[8];
#pragma unroll
                for (int j = 0; j < 8; ++j) w[j] = wp[(size_t)(k0 + j) * 6144];
#pragma unroll
                for (int j = 0; j < 8; ++j)
#pragma unroll
                    for (int b = 0; b < 17; ++b) a[b] += sc[b * 1024 + k0 + j] * w[j]; }
#pragma unroll
            for (int b = 0; b < 17; ++b) red[(kq * 17 + b) * 64 + (tid & 63)] = a[b];
            __syncthreads();
            for (int i = tid; i < 17 * 64; i += NTHR) { const int b = i >> 6, c = i & 63; float s2 = 0.f;
#pragma unroll
                for (int k = 0; k < 8; ++k) s2 += red[(k * 17 + b) * 64 + c];
                ((float*)(ws + WS_MOD))[((size_t)l * 17 + b) * 6144 + cbk * 64 + c] = s2 + p.in[I_BMOD][(size_t)l * 6144 + cbk * 64 + c]; }
            __syncthreads();
        }
    }
}

constexpr int CVT_TILES = 3072;
struct CvtT { const float* a; const float* b; unsigned char* dst; int ldsrc, K, k0, n0; };
__device__ __forceinline__ CvtT cvt_decode(const Params& p, int t) {
    const int l = t >= CVT_TILES ? 1 : 0, u = t - l * CVT_TILES; CvtT c;
    if (u < 2048) { const int e = u >> 6, q = u & 63; const size_t eo = ((size_t)l * 32 + e) * 1024 * 512;
        c.a = p.in[I_WEG] + eo; c.b = p.in[I_WEU] + eo; c.dst = p.ws + WS_WTGU + ((size_t)l * 32 + e) * 1024 * 1024; c.ldsrc = 512; c.K = 1024; c.k0 = (q >> 2) * 64; c.n0 = (q & 3) * 256; }
    else { const int v = u - 2048, e = v >> 5, q = v & 31;
        c.a = p.in[I_WED] + ((size_t)l * 32 + e) * 512 * 1024; c.b = nullptr; c.dst = p.ws + WS_WTD + ((size_t)l * 32 + e) * 1024 * 512; c.ldsrc = 1024; c.K = 512; c.k0 = (q >> 2) * 64; c.n0 = (q & 3) * 256; }
    return c;
}
__device__ __forceinline__ void cvt_load(const CvtT& c, float (&v)[32]) {
    const int tid = opaque_tid(), n = tid & 255, kb = tid >> 8, ng = c.n0 + n;
    const float* sp = (c.b ? ((ng & 128) ? c.b : c.a) + 128 * (ng >> 8) + (ng & 127) : c.a + ng) + (size_t)(c.k0 + kb) * c.ldsrc;
#pragma unroll
    for (int i = 0; i < 32; ++i) v[i] = sp[(size_t)(2 * i) * c.ldsrc];
}
__device__ __forceinline__ void cvt_finish(const CvtT& c, const float (&v)[32], LAS float* tile) {
    const int tid = opaque_tid();
    { const int n = tid & 255, kb = tid >> 8;
#pragma unroll
      for (int i = 0; i < 32; ++i) tile[(kb + 2 * i) * 257 + n] = v[i] * WSCALE8; }
    __syncthreads();
    { const int n = tid >> 1, kh = (tid & 1) * 32; unsigned char* dp = c.dst + (size_t)(c.n0 + n) * c.K + c.k0 + kh;
#pragma unroll
      for (int i = 0; i < 2; ++i) { float f[16];
#pragma unroll
          for (int j = 0; j < 16; ++j) f[j] = tile[(kh + 16 * i + j) * 257 + n];
          u32x4 w; w.x = pk4_fp8(f[0], f[1], f[2], f[3]); w.y = pk4_fp8(f[4], f[5], f[6], f[7]); w.z = pk4_fp8(f[8], f[9], f[10], f[11]); w.w = pk4_fp8(f[12], f[13], f[14], f[15]);
          *(u32x4*)(dp + 16 * i) = w; } }
}
__device__ __forceinline__ void cvt_fill(const Params& p, LAS unsigned char* lds, int t0, int t1, int r, int nr) {
    LAS float* tA = (LAS float*)lds; LAS float* tB = tA + 64 * 257 + 64;
    asm volatile("" : "+s"(r));
    float va[32], vb[32]; int t = t0 + r;
    if (t < t1) cvt_load(cvt_decode(p, t), va);
    for (; t < t1; t += 2 * nr) {
        if (t + nr < t1) cvt_load(cvt_decode(p, t + nr), vb);
        cvt_finish(cvt_decode(p, t), va, tA);
        if (t + 2 * nr < t1) cvt_load(cvt_decode(p, t + 2 * nr), va);
        if (t + nr < t1) cvt_finish(cvt_decode(p, t + nr), vb, tB);
    }
    __syncthreads();
}
constexpr int CVT_Q0 = 0, CVT_Q1 = 2240, CVT_Q2 = 2240, CVT_Q3 = 4480, CVT_Q4 = 5600;

__device__ __forceinline__ void ld_row_f32(const float* src, int lane, float (&v)[16]) {
    const f32x4 a = *(const f32x4*)(src + 8 * lane), b = *(const f32x4*)(src + 8 * lane + 4), c = *(const f32x4*)(src + 512 + 8 * lane), d = *(const f32x4*)(src + 512 + 8 * lane + 4);
#pragma unroll
    for (int j = 0; j < 4; ++j) { v[j] = a[j]; v[4 + j] = b[j]; v[8 + j] = c[j]; v[12 + j] = d[j]; }
}
__device__ __forceinline__ void st_row_f32(float* dst, int lane, const float (&v)[16]) {
    *(f32x4*)(dst + 8 * lane) = (f32x4){v[0], v[1], v[2], v[3]}; *(f32x4*)(dst + 8 * lane + 4) = (f32x4){v[4], v[5], v[6], v[7]};
    *(f32x4*)(dst + 512 + 8 * lane) = (f32x4){v[8], v[9], v[10], v[11]}; *(f32x4*)(dst + 512 + 8 * lane + 4) = (f32x4){v[12], v[13], v[14], v[15]};
}
__device__ __forceinline__ void ld_row_bf16(const bf16_t* src, int lane, float (&v)[16]) {
    const u32x4 a = *(const u32x4*)(src + 8 * lane), b = *(const u32x4*)(src + 512 + 8 * lane);
    v[0] = bf_lo(a.x); v[1] = bf_hi(a.x); v[2] = bf_lo(a.y); v[3] = bf_hi(a.y); v[4] = bf_lo(a.z); v[5] = bf_hi(a.z); v[6] = bf_lo(a.w); v[7] = bf_hi(a.w);
    v[8] = bf_lo(b.x); v[9] = bf_hi(b.x); v[10] = bf_lo(b.y); v[11] = bf_hi(b.y); v[12] = bf_lo(b.z); v[13] = bf_hi(b.z); v[14] = bf_lo(b.w); v[15] = bf_hi(b.w);
}
__device__ __forceinline__ void st_row_bf16(bf16_t* dst, int lane, const float (&v)[16]) {
    u32x4 a, b; a.x = cvtpk(v[0], v[1]); a.y = cvtpk(v[2], v[3]); a.z = cvtpk(v[4], v[5]); a.w = cvtpk(v[6], v[7]);
    b.x = cvtpk(v[8], v[9]); b.y = cvtpk(v[10], v[11]); b.z = cvtpk(v[12], v[13]); b.w = cvtpk(v[14], v[15]);
    *(u32x4*)(dst + 8 * lane) = a; *(u32x4*)(dst + 512 + 8 * lane) = b;
}
template <int MODE>
__device__ __forceinline__ void load_resid4(const Params& p, int R0, const RowInfo& q, int lmoe, int lane, float (&v)[4][16]) {
    const float* src; float* dst;
    if (q.isctx) { const size_t o = ((size_t)q.b * 256 + q.t) * 1024; src = (MODE == 0 ? p.in[I_CTX] : (const float*)(p.ws + WS_XC)) + o; dst = (float*)(p.ws + WS_XC) + o; }
    else { const size_t o = ((size_t)q.b * 2048 + q.t) * 1024; src = (MODE == 0 ? p.in[I_X] : (const float*)p.out) + o; dst = p.out + o; }
#pragma unroll
    for (int i = 0; i < 4; ++i) ld_row_f32(src + (size_t)i * 1024, lane, v[i]);
    if (MODE == 1 || MODE == 3) {
        const int* slot = (const int*)(p.ws + WS_POS) + 2 * (size_t)R0; const float* wk = (const float*)(p.ws + WS_WTK) + 2 * (size_t)R0;
        const bf16_t* ys = (const bf16_t*)(p.ws + WS_P + P_YS);
        int sl[8]; float ww[8];
#pragma unroll
        for (int i = 0; i < 8; ++i) { sl[i] = ld_i32_dev(slot + i); ww[i] = ld_f32_dev(wk + i); }
        float m5[16]; ld_row_f32((const float*)(p.ws + WS_MOD) + ((size_t)lmoe * 17 + (q.isctx ? 16 : q.b)) * 6144 + 5 * 1024, lane, m5);
        u32x4 ya[4][2], yb[4][2];
#pragma unroll
        for (int i = 0; i < 4; ++i) { const bf16_t* r1 = ys + (size_t)sl[2 * i] * 1024; const bf16_t* r2 = ys + (size_t)sl[2 * i + 1] * 1024;
            ya[i][0] = *(const u32x4*)(r1 + 8 * lane); ya[i][1] = *(const u32x4*)(r1 + 512 + 8 * lane); yb[i][0] = *(const u32x4*)(r2 + 8 * lane); yb[i][1] = *(const u32x4*)(r2 + 512 + 8 * lane); }
#pragma unroll
        for (int i = 0; i < 4; ++i) { float y1[8], y2[8];
#pragma unroll
            for (int hh = 0; hh < 2; ++hh) { unpack8(ya[i][hh], y1); unpack8(yb[i][hh], y2);
#pragma unroll
                for (int j = 0; j < 8; ++j) v[i][8 * hh + j] += m5[8 * hh + j] * (ww[2 * i] * y1[j] + ww[2 * i + 1] * y2[j]); }
            if (MODE == 1) st_row_f32(dst + (size_t)i * 1024, lane, v[i]); }
    }
}
struct RowPar { float g[16], sh[16], sc[16]; };
__device__ __forceinline__ void load_rowpar(const Params& p, int l, int which, const RowInfo& q, int lane, RowPar& rp) {
    const float* mrow = (const float*)(p.ws + WS_MOD) + ((size_t)l * 17 + (q.isctx ? 16 : q.b)) * 6144;
    ld_row_f32(p.in[which ? I_GN2 : I_GN1] + (size_t)l * 1024, lane, rp.g);
    ld_row_f32(mrow + (which ? 3 : 0) * 1024, lane, rp.sh); ld_row_f32(mrow + (which ? 4 : 1) * 1024, lane, rp.sc);
}
__device__ __forceinline__ void norm_mod_row(const RowPar& rp, int lane, const float (&v)[16], bf16_t* hrow, unsigned char* h8row = nullptr) {
    float ss = 0.f;
#pragma unroll
    for (int j = 0; j < 16; ++j) ss += v[j] * v[j];
    ss = wave_sum(ss); const float rs = rsqrtf(ss * (1.0f / 1024.0f) + EPS);
    float o[16];
#pragma unroll
    for (int j = 0; j < 16; ++j) o[j] = v[j] * rs * rp.g[j] * (1.0f + rp.sc[j]) + rp.sh[j];
    st_row_bf16(hrow, lane, o);
    if (h8row) { u32x2 a, b; a.x = pk4_fp8(o[0] * HSCALE8, o[1] * HSCALE8, o[2] * HSCALE8, o[3] * HSCALE8); a.y = pk4_fp8(o[4] * HSCALE8, o[5] * HSCALE8, o[6] * HSCALE8, o[7] * HSCALE8);
        b.x = pk4_fp8(o[8] * HSCALE8, o[9] * HSCALE8, o[10] * HSCALE8, o[11] * HSCALE8); b.y = pk4_fp8(o[12] * HSCALE8, o[13] * HSCALE8, o[14] * HSCALE8, o[15] * HSCALE8);
        *(u32x2*)(h8row + 8 * lane) = a; *(u32x2*)(h8row + 512 + 8 * lane) = b; }
}
__device__ __forceinline__ void phase_norm1(const Params& p, int l) {
    const int tid = opaque_tid(), wid = __builtin_amdgcn_readfirstlane(tid >> 6), lane = tid & 63;
    for (int gq = blockIdx.x * 8 + wid; gq < MTOT / 4; gq += gridDim.x * 8) {
        const int R0 = 4 * gq; const RowInfo q = row_info(R0); float v[4][16]; RowPar rp;
        load_rowpar(p, l, 0, q, lane, rp);
        if (l == 0) load_resid4<0>(p, R0, q, 0, lane, v); else load_resid4<1>(p, R0, q, l - 1, lane, v);
#pragma unroll
        for (int i = 0; i < 4; ++i) norm_mod_row(rp, lane, v[i], (bf16_t*)(p.ws + WS_H) + (size_t)(R0 + i) * 1024, p.ws + WS_H8 + (size_t)(R0 + i) * 1024);
    }
}
__device__ __forceinline__ void phase_final(const Params& p) {
    const int tid = opaque_tid(), wid = __builtin_amdgcn_readfirstlane(tid >> 6), lane = tid & 63;
    float g[16]; ld_row_f32(p.in[I_GFIN], lane, g);
    for (int gq = blockIdx.x * 8 + wid; gq < NBATCH * SEQ / 4; gq += gridDim.x * 8) {
        const int a = 4 * gq, R0 = (a >> 14) * MH + CTXROWS + (a & 16383);
        const RowInfo q = row_info(R0); float v[4][16];
        load_resid4<3>(p, R0, q, 1, lane, v);
#pragma unroll
        for (int i = 0; i < 4; ++i) { float ss = 0.f;
#pragma unroll
            for (int j = 0; j < 16; ++j) ss += v[i][j] * v[i][j];
            ss = wave_sum(ss); const float rs = rsqrtf(ss * (1.0f / 1024.0f) + EPS);
#pragma unroll
            for (int j = 0; j < 16; ++j) v[i][j] = v[i][j] * rs * g[j];
            st_row_f32(p.out + ((size_t)q.b * 2048 + q.t + i) * 1024, lane, v[i]); }
    }
}
__device__ __forceinline__ int active_row(int l, int a) { return l == 0 ? a : (a >> 14) * MH + CTXROWS + (a & 16383); }
typedef float f32x4v __attribute__((ext_vector_type(4)));
__device__ __forceinline__ void phase_norm2_router(const Params& p, int l, LAS unsigned char* lds) {
    const int tid = opaque_tid(), wid = tid >> 6, lane = tid & 63, G = gridDim.x, bid = blockIdx.x;
    const int NA = l == 0 ? MTOT : NBATCH * SEQ;
    const int chunk = (((NA + G - 1) / G) + 15) & ~15;
    const int a0 = bid * chunk, a1 = (a0 + chunk < NA) ? a0 + chunk : NA, na = a1 > a0 ? a1 - a0 : 0;
    LAS float* lg = (LAS float*)lds;
    LAS float* lgs = (LAS float*)(lds + 73728);
    LAS int* re = (LAS int*)(lds + 83968);
    LAS float* rw = (LAS float*)(lds + 83968 + 2048);
    LAS int* rr = (LAS int*)(lds + 83968 + 4096);
    LAS int* hist = (LAS int*)(lds + 83968 + 6144);
    LAS int* base = hist + 32;
    if (tid < 32) hist[tid] = 0;
    bf16_t* H = (bf16_t*)(p.ws + WS_H);
    PSEC_BEGINN(11);
    for (int g = wid; g * 16 < na; g += 8)
        for (int i = 0; i < 16; i += 4) { const int a = a0 + g * 16 + i; if (a >= a1) break;
            const int R0 = active_row(l, a); const RowInfo q = row_info(R0); float v[4][16]; RowPar rp;
            load_rowpar(p, l, 1, q, lane, rp);
            load_resid4<2>(p, R0, q, 0, lane, v);
#pragma unroll
            for (int k = 0; k < 4; ++k) norm_mod_row(rp, lane, v[k], H + (size_t)(R0 + k) * 1024, p.ws + WS_H8 + (size_t)(R0 + k) * 1024); }
    asm volatile("s_waitcnt vmcnt(0)" ::: "memory"); __syncthreads();
    PSEC(11);
    const bf16_t* Wr = (const bf16_t*)(p.ws + WS_WRT) + (size_t)l * 2 * 48 * 1024;
    const float* brg = p.in[I_BRG] + l * 4; const float* bre = p.in[I_BRE] + l * 32;
    const int ng = (na + 15) >> 4, r16 = lane & 15, kq = lane >> 4;
    LAS float* brl = (LAS float*)(lds + 83968 + 6144 + 512);
    if (tid < 36) brl[tid] = tid < 4 ? brg[tid] : bre[tid - 4];
    if (ng > 0) {
        bf16x8 bh[4][3], bl[4][3];
        { const bf16_t* bp = Wr + (size_t)r16 * 1024 + 128 * wid + 8 * kq;
#pragma unroll
          for (int ks = 0; ks < 4; ++ks)
#pragma unroll
              for (int ct = 0; ct < 3; ++ct) { bh[ks][ct] = *(const bf16x8*)(bp + (size_t)ct * 16 * 1024 + ks * 32); bl[ks][ct] = *(const bf16x8*)(bp + (size_t)(48 + ct * 16) * 1024 + ks * 32); } }
        __builtin_amdgcn_sched_barrier(0);
#pragma unroll 1
        for (int g0 = 0; g0 < ng; g0 += 3) {
            bf16x8 a[3][4];
#pragma unroll
            for (int gq = 0; gq < 3; ++gq) { int ar = a0 + (g0 + gq) * 16 + r16; if (ar >= a1) ar = a1 - 1;
                const bf16_t* ap = H + (size_t)active_row(l, ar) * 1024 + 128 * wid + 8 * kq;
#pragma unroll
                for (int ks = 0; ks < 4; ++ks) a[gq][ks] = *(const bf16x8*)(ap + ks * 32); }
            __builtin_amdgcn_sched_barrier(0);
#pragma unroll
            for (int gq = 0; gq < 3; ++gq) {
                f32x4v acc[3] = {{0.f, 0.f, 0.f, 0.f}, {0.f, 0.f, 0.f, 0.f}, {0.f, 0.f, 0.f, 0.f}};
#pragma unroll
                for (int ks = 0; ks < 4; ++ks)
#pragma unroll
                    for (int ct = 0; ct < 3; ++ct) { acc[ct] = __builtin_amdgcn_mfma_f32_16x16x32_bf16(a[gq][ks], bh[ks][ct], acc[ct], 0, 0, 0); acc[ct] = __builtin_amdgcn_mfma_f32_16x16x32_bf16(a[gq][ks], bl[ks][ct], acc[ct], 0, 0, 0); }
#pragma unroll
                for (int ct = 0; ct < 3; ++ct)
#pragma unroll
                    for (int r = 0; r < 4; ++r) lg[((gq * 8 + wid) * 16 + 4 * kq + r) * 48 + ct * 16 + r16] = acc[ct][r];
            }
            __syncthreads();
            for (int o = tid; o < 3 * 768; o += NTHR) { const int gq = o >= 1536 ? 2 : (o >= 768 ? 1 : 0), rem = o - gq * 768; float s = 0.f;
#pragma unroll
                for (int w = 0; w < 8; ++w) s += lg[(gq * 8 + w) * 768 + rem];
                lgs[o] = s; }
            __syncthreads();
            if (tid < 48) {
                const int a = a0 + (g0 + (tid >> 4)) * 16 + (tid & 15);
                if (g0 + (tid >> 4) < ng && a < a1) {
                    const LAS float* x = lgs + tid * 48;
                    float gl[4]; int gs = 0; float gmax;
#pragma unroll
                    for (int j = 0; j < 4; ++j) gl[j] = x[j] + brl[j];
                    gmax = gl[0];
#pragma unroll
                    for (int j = 1; j < 4; ++j) if (gl[j] > gmax) { gmax = gl[j]; gs = j; }
                    float gsum = 0.f;
#pragma unroll
                    for (int j = 0; j < 4; ++j) gsum += __expf(gl[j] - gmax);
                    const float pg = 1.0f / gsum;
                    float v1 = -3.0e38f, v2 = -3.0e38f; int i1 = 0, i2 = 0;
                    for (int j = 0; j < 8; ++j) { const float ev = x[4 + gs * 8 + j] + brl[4 + gs * 8 + j];
                        if (ev > v1) { v2 = v1; i2 = i1; v1 = ev; i1 = j; } else if (ev > v2) { v2 = ev; i2 = j; } }
                    const float t = __expf(v2 - v1); const float w1 = pg / (1.0f + t), w2 = pg * t / (1.0f + t);
                    const int e1 = gs * 8 + i1, e2 = gs * 8 + i2, i = a - a0;
                    re[i] = e1; re[256 + i] = e2; rw[i] = w1; rw[256 + i] = w2;
                }
            }
            __syncthreads();
        }
    }
    __syncthreads();
    PSEC(12);
    if (tid < 32) { int c = 0; for (int i = 0; i < na; ++i) { if (re[i] == tid) rr[i] = c++; if (re[256 + i] == tid) rr[256 + i] = c++; } hist[tid] = c; }
    __syncthreads();
    int* hg = (int*)(p.ws + WS_CTL) + CW_HIST + (l * 256 + bid) * 32;
    if (tid < 32) hg[tid] = hist[tid];
    (void)base;
    int* EID = (int*)(p.ws + WS_EID); float* WTK = (float*)(p.ws + WS_WTK); int* POS = (int*)(p.ws + WS_POS);
    for (int i = tid; i < na; i += NTHR) { const size_t R = (size_t)active_row(l, a0 + i);
        EID[2 * R] = re[i]; EID[2 * R + 1] = re[256 + i]; WTK[2 * R] = rw[i]; WTK[2 * R + 1] = rw[256 + i];
        POS[2 * R] = rr[i]; POS[2 * R + 1] = rr[256 + i]; }
    __syncthreads();
    PSEC(13);
}
__device__ __forceinline__ void moe_segments(const Params& p, int l, LAS int* seg, int myblk) {
    const int tid = opaque_tid(); LAS int* cnt = seg + 40; LAS int* pre = seg + 80;
    if (tid < 32) { const int* hg = (const int*)(p.ws + WS_CTL) + CW_HIST + l * 256 * 32 + tid; int tot = 0, pr = 0; const int nb = (int)gridDim.x;
        for (int b = 0; b < nb; ++b) { const int c = hg[b * 32]; if (b < myblk) pr += c; tot += c; }
        cnt[tid] = tot; pre[tid] = pr; }
    __syncthreads();
    if (tid == 0) { int s = 0; for (int e = 0; e < 32; ++e) { seg[e] = s; s += (cnt[e] + 255) & ~255; } if (s > SLOTS) s = SLOTS; seg[32] = s; }
    __syncthreads();
}
__device__ __forceinline__ void phase_dispatch(const Params& p, int l, LAS unsigned char* lds) {
    const int tid = opaque_tid(), G = gridDim.x, bid = blockIdx.x;
    LAS int* seg = (LAS int*)lds; moe_segments(p, l, seg, bid); const LAS int* cnt = seg + 40; const LAS int* pre = seg + 80;
    const int NA = l == 0 ? MTOT : NBATCH * SEQ;
    const int chunk = (((NA + G - 1) / G) + 15) & ~15;
    const int a0 = bid * chunk, a1 = (a0 + chunk < NA) ? a0 + chunk : NA;
    const int* EID = (const int*)(p.ws + WS_EID); const float* WTK = (const float*)(p.ws + WS_WTK); int* POS = (int*)(p.ws + WS_POS); float* WTS = (float*)(p.ws + WS_WTS); int* SRC = (int*)(p.ws + WS_SRC);
    for (int i = tid; i < 2 * (a1 - a0); i += NTHR) {
        const int R = active_row(l, a0 + (i >> 1)); const size_t x = 2 * (size_t)R + (i & 1);
        const int e = EID[x], ps = POS[x]; const float w = WTK[x];
        const int s = seg[e] + pre[e] + ps;
        SRC[s] = R; POS[x] = s; WTS[s] = w; }
    for (int e = bid; e < 32; e += G)
        for (int s = seg[e] + cnt[e] + tid; s < seg[e + 1]; s += NTHR) SRC[s] = 0;
    __syncthreads();
}
__device__ __forceinline__ int moe_tile_table(const Params& p, int l, LAS int* seg, LAS int* tile_e) {
    moe_segments(p, l, seg, 0);
    const int nt = seg[32] >> 8;
    for (int i = opaque_tid(); i < nt; i += NTHR) { int e = 0; for (int k = 1; k < 32; ++k) if ((i << 8) >= seg[k]) e = k; tile_e[i] = e; }
    __syncthreads();
    return __builtin_amdgcn_readfirstlane(nt);
}
__device__ __forceinline__ void lds_addf(LAS float* a, float v) { (void)__hip_atomic_fetch_add(a, v, __ATOMIC_RELAXED, __HIP_MEMORY_SCOPE_WORKGROUP); }
__device__ __forceinline__ bf16_t* pbuf(const Params& p, size_t off) { return (bf16_t*)(p.ws + WS_P + off); }
#ifndef MMU
#define MMU 2
#endif
__device__ __forceinline__ void mm128(const LAS bf16_t* A, const LAS bf16_t* Bt, f32x16 (&acc)[2], int wid, int lane) {
    const int r32 = lane & 31, hi = lane >> 5;
    const LAS bf16_t* ap = A + (32 * (wid >> 1) + r32) * TLD + hi * 8;
    const LAS bf16_t* bp = Bt + (64 * (wid & 1) + r32) * TLD + hi * 8;
#pragma unroll MMU
    for (int ks = 0; ks < 8; ++ks) {
        const bf16x8 a = *(const LAS bf16x8*)(ap + ks * 16), b0 = *(const LAS bf16x8*)(bp + ks * 16), b1 = *(const LAS bf16x8*)(bp + 32 * TLD + ks * 16);
        acc[0] = mfma32(a, b0, acc[0]); acc[1] = mfma32(a, b1, acc[1]);
    }
}
__device__ __forceinline__ void mm128_gB(const LAS bf16_t* A, const bf16_t* __restrict__ Bg, f32x16 (&acc)[2], int wid, int lane) {
    const int r32 = lane & 31, hi = lane >> 5;
    const LAS bf16_t* ap = A + (32 * (wid >> 1) + r32) * TLD + hi * 8;
    const bf16_t* bp = Bg + (64 * (wid & 1) + r32) * 128 + hi * 8;
#pragma unroll MMU
    for (int ks = 0; ks < 8; ++ks) {
        const bf16x8 a = *(const LAS bf16x8*)(ap + ks * 16), b0 = *(const bf16x8*)(bp + ks * 16), b1 = *(const bf16x8*)(bp + 32 * 128 + ks * 16);
        acc[0] = mfma32(a, b0, acc[0]); acc[1] = mfma32(a, b1, acc[1]);
    }
}
__device__ __forceinline__ void st_acc_T(LAS bf16_t* T, const f32x16 (&acc)[2], int wid, int lane) {
    const int r32 = lane & 31, hi = lane >> 5;
#pragma unroll
    for (int tl = 0; tl < 2; ++tl)
#pragma unroll
        for (int g = 0; g < 4; ++g) { u32x2 w; w.x = cvtpk(acc[tl][4 * g], acc[tl][4 * g + 1]); w.y = cvtpk(acc[tl][4 * g + 2], acc[tl][4 * g + 3]);
            *(LAS u32x2*)(T + (64 * (wid & 1) + 32 * tl + r32) * TLD + 32 * (wid >> 1) + 8 * g + 4 * hi) = w; }
}

__device__ __forceinline__ void st_acc_rm(LAS bf16_t* T, const f32x16 (&acc)[2], int wid, int lane) {
    const int r32 = lane & 31, hi = lane >> 5;
    LAS bf16_t* b = T + (32 * (wid >> 1) + 4 * hi) * TLD + 64 * (wid & 1) + r32;
#pragma unroll
    for (int tl = 0; tl < 2; ++tl)
#pragma unroll
        for (int r = 0; r < 16; ++r) b[((r & 3) + 8 * (r >> 2)) * TLD + 32 * tl] = (bf16_t)(cvtpk(acc[tl][r], acc[tl][r]) & 0xffffu);
}
constexpr int FLD = 132;
__device__ __forceinline__ void st_acc_f32(LAS float* F, const f32x16 (&acc)[2], int wid, int lane) {
    const int r32 = lane & 31, hi = lane >> 5;
    LAS float* b = F + (32 * (wid >> 1) + 4 * hi) * FLD + 64 * (wid & 1) + r32;
#pragma unroll
    for (int tl = 0; tl < 2; ++tl)
#pragma unroll
        for (int r = 0; r < 16; ++r) b[((r & 3) + 8 * (r >> 2)) * FLD + 32 * tl] = acc[tl][r];
}
__device__ __forceinline__ void copy_tile_out(const LAS bf16_t* T, bf16_t* dst, int ld) {
    const int tx = opaque_tid(), t = tx >> 2, c0 = (tx & 3) * 32;
#pragma unroll
    for (int i = 0; i < 4; ++i) *(u32x4*)(dst + (size_t)t * ld + c0 + 8 * i) = *(const LAS u32x4*)(T + t * TLD + c0 + 8 * i);
}

__device__ __forceinline__ bool seq_start(int r) { return r < CTXROWS ? (r & 255) == 0 : ((r - CTXROWS) & 2047) == 0; }
template <int CTRL> __device__ __forceinline__ u32x4 dpp4(const u32x4 v) { u32x4 o;
    o.x = (unsigned)__builtin_amdgcn_update_dpp(0, (int)v.x, CTRL, 0xf, 0xf, true); o.y = (unsigned)__builtin_amdgcn_update_dpp(0, (int)v.y, CTRL, 0xf, 0xf, true);
    o.z = (unsigned)__builtin_amdgcn_update_dpp(0, (int)v.z, CTRL, 0xf, 0xf, true); o.w = (unsigned)__builtin_amdgcn_update_dpp(0, (int)v.w, CTRL, 0xf, 0xf, true); return o; }
__device__ __forceinline__ void phase_conv(const Params& p, int l, LAS unsigned char* lds) {
    const int tid = opaque_tid(), wid = __builtin_amdgcn_readfirstlane(tid >> 6), lane = tid & 63, r16 = lane & 15, kg = lane >> 4, G = gridDim.x, bid = blockIdx.x;
    constexpr int NG = MH / 16, NU = 5;
    const bf16_t* XM = pbuf(p, P_XMB); bf16_t* XCV = pbuf(p, P_XCV); float* GT = (float*)(p.ws + WS_P + P_GATES);
    LAS float* PX = (LAS float*)lds;
    for (int g0 = bid; g0 < NG; g0 += NU * G) {
        f32x4v acc[NU];
#pragma unroll
        for (int u = 0; u < NU; ++u) acc[u] = (f32x4v){0.f, 0.f, 0.f, 0.f};
#pragma unroll 1
        for (int ks = 0; ks < 2; ++ks) {
            const int c = 64 * wid + 32 * ks + 8 * kg;
            u32x4 cur[NU], edge[NU];
#pragma unroll
            for (int u = 0; u < NU; ++u) { const int g = g0 + G * u; const bool valid = g < NG; const int row = 16 * g + r16;
                cur[u] = valid ? *(const u32x4*)(XM + (size_t)row * 512 + c) : (u32x4){0u, 0u, 0u, 0u};
                const bool he = valid && ((r16 == 0 && !seq_start(16 * g)) || (r16 == 15 && !seq_start(16 * g + 16)));
                const int er = r16 == 0 ? row - 1 : row + 1;
                edge[u] = he ? *(const u32x4*)(XM + (size_t)er * 512 + c) : (u32x4){0u, 0u, 0u, 0u}; }
            float w0[8], w1[8], w2[8], bc[8];
            { const float* wc = p.in[I_WCONV] + (size_t)l * 3 * 512 + c; const float* bcp = p.in[I_BCONV] + (size_t)l * 512 + c;
#pragma unroll
              for (int j = 0; j < 8; ++j) { w0[j] = wc[j]; w1[j] = wc[512 + j]; w2[j] = wc[1024 + j]; bc[j] = bcp[j]; } }
            bf16x8 wyh, wyl, wxh, wxl;
            { const float* wf = (const float*)(p.ws + WS_WFOLD) + ((size_t)l * 16 + r16) * 1024 + c; float a[8], b[8], t8[8];
#pragma unroll
              for (int j = 0; j < 8; ++j) { a[j] = wf[j]; b[j] = wf[512 + j]; }
              u32x4 hh = pack8(a); unpack8(hh, t8);
#pragma unroll
              for (int j = 0; j < 8; ++j) t8[j] = a[j] - t8[j];
              u32x4 ll = pack8(t8); wyh = *(const bf16x8*)&hh; wyl = *(const bf16x8*)&ll;
              hh = pack8(b); unpack8(hh, t8);
#pragma unroll
              for (int j = 0; j < 8; ++j) t8[j] = b[j] - t8[j];
              ll = pack8(t8); wxh = *(const bf16x8*)&hh; wxl = *(const bf16x8*)&ll; }
#pragma unroll
            for (int u = 0; u < NU; ++u) { const int g = g0 + G * u;
                const u32x4 sp = dpp4<0x111>(cur[u]), sn = dpp4<0x101>(cur[u]);
                u32x4 pw, nw;
                pw.x = r16 == 0 ? edge[u].x : sp.x; pw.y = r16 == 0 ? edge[u].y : sp.y; pw.z = r16 == 0 ? edge[u].z : sp.z; pw.w = r16 == 0 ? edge[u].w : sp.w;
                nw.x = r16 == 15 ? edge[u].x : sn.x; nw.y = r16 == 15 ? edge[u].y : sn.y; nw.z = r16 == 15 ? edge[u].z : sn.z; nw.w = r16 == 15 ? edge[u].w : sn.w;
                float xp[8], xc[8], xn[8], y[8], yl[8]; unpack8(pw, xp); unpack8(cur[u], xc); unpack8(nw, xn);
#pragma unroll
                for (int j = 0; j < 8; ++j) y[j] = silu_f(w0[j] * xp[j] + w1[j] * xc[j] + w2[j] * xn[j] + bc[j]);
                const u32x4 yh = pack8(y); unpack8(yh, yl);
#pragma unroll
                for (int j = 0; j < 8; ++j) yl[j] = y[j] - yl[j];
                const u32x4 ylw = pack8(yl);
                const bf16x8 ah = *(const bf16x8*)&yh, al = *(const bf16x8*)&ylw, ax = *(const bf16x8*)&cur[u];
                acc[u] = __builtin_amdgcn_mfma_f32_16x16x32_bf16(ah, wyh, acc[u], 0, 0, 0); acc[u] = __builtin_amdgcn_mfma_f32_16x16x32_bf16(ah, wyl, acc[u], 0, 0, 0);
                acc[u] = __builtin_amdgcn_mfma_f32_16x16x32_bf16(al, wyh, acc[u], 0, 0, 0);
                acc[u] = __builtin_amdgcn_mfma_f32_16x16x32_bf16(ax, wxh, acc[u], 0, 0, 0); acc[u] = __builtin_amdgcn_mfma_f32_16x16x32_bf16(ax, wxl, acc[u], 0, 0, 0);
                if (g < NG) *(u32x4*)(XCV + (size_t)(16 * g + r16) * 512 + c) = yh; }
        }
#pragma unroll
        for (int u = 0; u < NU; ++u)
#pragma unroll
            for (int r = 0; r < 4; ++r) PX[((u * 8 + wid) * 16 + 4 * kg + r) * 16 + r16] = acc[u][r];
        __syncthreads();
        for (int o = tid; o < NU * 256; o += NTHR) { const int u = o >> 8, row = (o >> 4) & 15, n = o & 15, g = g0 + G * u; float s = p.in[I_BIF][l * 16 + n];
#pragma unroll
            for (int w = 0; w < 8; ++w) s += PX[((u * 8 + w) * 16 + row) * 16 + n];
            if (g < NG) GT[(size_t)(16 * g + row) * 16 + (n & 3) * 4 + (n >> 2)] = s; }
        __syncthreads();
    }
}
__device__ __forceinline__ void ld8row(const bf16_t* base, int pos, int seqlen, float (&o)[8]) {
    if (pos < 0 || pos >= seqlen) {
#pragma unroll
        for (int j = 0; j < 8; ++j) o[j] = 0.f; }
    else unpack8(*(const u32x4*)(base + (size_t)pos * 512), o);
}
__device__ __forceinline__ void mlstm_a_ids(int u, int& bl, int& J, int& h, int& r0) {
    bl = u / (NJ * 4); const int rem = u - bl * (NJ * 4); J = rem >> 2; h = rem & 3;
    r0 = (J < 2 ? bl * 256 : CTXROWS + bl * 2048) + (J < 2 ? J * 128 : (J - 2) * 128);
}
#define APRE_PARAMS u32x4 (&qa)[4], u32x4 (&qb)[4], u32x4 (&qwq)[4], u32x4 (&qwk)[4], u32x4 (&qwv)[4], f32x4& qg
#define APRE_ARGS qa, qb, qwq, qwk, qwv, qg
__device__ __forceinline__ void mlstm_a_load(const Params& p, int l, int u, APRE_PARAMS) {
    const int tid = opaque_tid(); int bl, J, h, r0; mlstm_a_ids(u, bl, J, h, r0);
    const int t = tid >> 2, cc = (tid & 3) * 32; const size_t o = (size_t)(r0 + t) * 512 + h * 128 + cc;
    const bf16_t* XM = pbuf(p, P_XMB) + o; const bf16_t* XCV = pbuf(p, P_XCV) + o;
    const bf16_t* Wq = (const bf16_t*)(p.ws + WS_WTQKV) + ((size_t)(l * 3) * 4 + h) * 16384 + t * 128 + cc;
#pragma unroll
    for (int i = 0; i < 4; ++i) { qa[i] = *(const u32x4*)(XCV + 8 * i); qb[i] = *(const u32x4*)(XM + 8 * i);
        qwq[i] = *(const u32x4*)(Wq + 8 * i); qwk[i] = *(const u32x4*)(Wq + (size_t)4 * 16384 + 8 * i); qwv[i] = *(const u32x4*)(Wq + (size_t)8 * 16384 + 8 * i); }
    qg = *(const f32x4*)((const float*)(p.ws + WS_P + P_GATES) + (size_t)(r0 + (tid & 127)) * 16 + h * 4);
}
__device__ __forceinline__ void mlstm_a_unit(const Params& p, int l, int u, int unext, int n_a, APRE_PARAMS, LAS unsigned char* lds) {
    int tid_ = threadIdx.x; asm volatile("" : "+v"(tid_));
    const int tid = tid_, wid = __builtin_amdgcn_readfirstlane(tid >> 6), lane = tid & 63, r32 = lane & 31, hi = lane >> 5;
    LAS bf16_t* T0 = (LAS bf16_t*)lds; LAS bf16_t* T1 = (LAS bf16_t*)(lds + TILE_B); LAS bf16_t* T2 = (LAS bf16_t*)(lds + 2 * TILE_B); LAS bf16_t* T3 = (LAS bf16_t*)(lds + 3 * TILE_B);
    LAS float* gl = (LAS float*)(lds + 4 * TILE_B);
    LAS float* wend = gl + 512;
    int bl, J, h, r0; mlstm_a_ids(u, bl, J, h, r0);
    const int wr_ = tid >> 2, wc_ = (tid & 3) * 32;
    u32x4 wv_[4];
#pragma unroll
    for (int i = 0; i < 4; ++i) { *(LAS u32x4*)(T0 + wr_ * TLD + wc_ + 8 * i) = qa[i]; *(LAS u32x4*)(T1 + wr_ * TLD + wc_ + 8 * i) = qb[i];
        *(LAS u32x4*)(T2 + wr_ * TLD + wc_ + 8 * i) = qwq[i]; *(LAS u32x4*)(T3 + wr_ * TLD + wc_ + 8 * i) = qwk[i]; wv_[i] = qwv[i]; }
    if (tid < 128) *(LAS f32x4*)(gl + tid * 4) = qg;
    LBAR();
    if (wid < 2) {
        const int dir = wid, p0 = 2 * lane, p1 = p0 + 1, s0 = dir ? 127 - p0 : p0, s1 = dir ? 127 - p1 : p1;
        const float ig0 = gl[s0 * 4 + 2 * dir], ig1 = gl[s1 * 4 + 2 * dir];
        const float lf0 = logsigmoid_f(gl[s0 * 4 + 2 * dir + 1]), lf1 = logsigmoid_f(gl[s1 * 4 + 2 * dir + 1]);
        float incl = lf0 + lf1;
        for (int o = 1; o < 64; o <<= 1) { const float t = __shfl_up(incl, o); if (lane >= o) incl += t; }
        const float bc1 = incl, bc0 = incl - lf1, gg = __shfl(incl, 63);
        const float ae0 = gg - bc0 + ig0, ae1 = gg - bc1 + ig1; const float ml = wave_max(fmaxf(ae0, ae1));
        wend[dir * 128 + s0] = __expf(ae0 - ml); wend[dir * 128 + s1] = __expf(ae1 - ml);
        if (lane == 0) { float* mst = (float*)(p.ws + WS_P + P_MST) + ((size_t)(((bl * 4 + h) * 2 + dir) * NJ + J)) * 4; mst[0] = ml; mst[1] = gg; }
    }
    f32x16 ack[2] = {};
    {
        f32x16 acq[2] = {}, akp[2] = {};
        mm128(T2, T0, acq, wid, lane); mm128(T0, T3, ack, wid, lane); mm128(T3, T0, akp, wid, lane);
        LBAR();
        st_acc_T(T2, acq, wid, lane); st_acc_T(T3, akp, wid, lane);
#pragma unroll
        for (int i = 0; i < 4; ++i) *(LAS u32x4*)(T0 + wr_ * TLD + wc_ + 8 * i) = wv_[i];
    }
    LBAR();
    copy_tile_out(T2, pbuf(p, P_MQ) + (size_t)r0 * 512 + h * 128, 512);
    copy_tile_out(T3, pbuf(p, P_MK) + (size_t)r0 * 512 + h * 128, 512);
    {
        f32x16 acv[2] = {}; mm128(T1, T0, acv, wid, lane);
        LBAR();
        st_acc_T(T2, ack, wid, lane); st_acc_T(T3, acv, wid, lane);
    }
    mlstm_a_load(p, l, unext < n_a ? unext : u, APRE_ARGS);
    LBAR();
    {
        bf16_t* MVT = pbuf(p, P_MVT) + ((size_t)((bl * NJ + J) * 4 + h)) * 16384; const int d = tid >> 2, s0 = (tid & 3) * 32;
#pragma unroll
        for (int i = 0; i < 4; ++i) *(u32x4*)(MVT + d * 128 + s0 + 8 * i) = *(const LAS u32x4*)(T3 + d * TLD + s0 + 8 * i);
    }
#pragma unroll 1
    for (int dir = 0; dir < 2; ++dir) {
        const int combo = (bl * 4 + h) * 2 + dir;
        f32x16 acc[2] = {};
        const LAS bf16_t* ap = T3 + (32 * (wid >> 1) + r32) * TLD + hi * 8; const LAS bf16_t* bp = T2 + (64 * (wid & 1) + r32) * TLD + hi * 8;
        const LAS float* wv = wend + dir * 128 + hi * 8;
#pragma unroll
        for (int ks = 0; ks < 8; ++ks) {
            float a8[8]; unpack8(*(const LAS u32x4*)(ap + ks * 16), a8);
            const f32x4 wa = *(const LAS f32x4*)(wv + ks * 16), wb = *(const LAS f32x4*)(wv + ks * 16 + 4);
#pragma unroll
            for (int j = 0; j < 4; ++j) { a8[j] *= wa[j]; a8[4 + j] *= wb[j]; }
            const u32x4 aw = pack8(a8); const bf16x8 a = *(const bf16x8*)&aw;
            const bf16x8 b0 = *(const LAS bf16x8*)(bp + ks * 16), b1 = *(const LAS bf16x8*)(bp + 32 * TLD + ks * 16);
            acc[0] = mfma32(a, b0, acc[0]); acc[1] = mfma32(a, b1, acc[1]);
        }
        bf16_t* CL = (bf16_t*)(p.ws + WS_P + P_CLOC) + ((size_t)combo * NJ + J) * 16384;
        LAS float* F = (LAS float*)lds;
        st_acc_f32(F, acc, wid, lane);
        LBAR();
        { const int d = tid >> 2, e0 = (tid & 3) * 32;
#pragma unroll
          for (int i = 0; i < 4; ++i) { const f32x4 a = *(const LAS f32x4*)(F + d * FLD + e0 + 8 * i), b = *(const LAS f32x4*)(F + d * FLD + e0 + 8 * i + 4);
              u32x4 w; w.x = cvtpk(a[0], a[1]); w.y = cvtpk(a[2], a[3]); w.z = cvtpk(b[0], b[1]); w.w = cvtpk(b[2], b[3]);
              *(u32x4*)(CL + d * 128 + e0 + 8 * i) = w; } }
        LBAR();
    }
    if (tid < 256) { const int dir = tid >> 7, e = tid & 127; float s = 0.f;
#pragma unroll 4
        for (int j = 0; j < 128; j += 8) { float k8[8]; unpack8(*(const LAS u32x4*)(T2 + e * TLD + j), k8);
            const f32x4 wa = *(const LAS f32x4*)(wend + dir * 128 + j), wb = *(const LAS f32x4*)(wend + dir * 128 + j + 4);
#pragma unroll
            for (int i = 0; i < 4; ++i) s += wa[i] * k8[i] + wb[i] * k8[4 + i]; }
        ((float*)(p.ws + WS_P + P_NLOC))[((size_t)(((bl * 4 + h) * 2 + dir) * NJ + J)) * 128 + e] = s; }
    LBAR();
}

__device__ __forceinline__ int scan_J(int dir, int pidx) { return dir == 0 ? pidx : (pidx == 0 ? 1 : (pidx == 1 ? 0 : 19 - pidx)); }
__device__ __forceinline__ void phase_scan(const Params& p) {
    const int NIT = 64 * 2112;
    bf16_t* CL = (bf16_t*)(p.ws + WS_P + P_CLOC); float* NL = (float*)(p.ws + WS_P + P_NLOC); float* MST = (float*)(p.ws + WS_P + P_MST);
    const int tid = opaque_tid();
    for (int w = blockIdx.x * NTHR + tid; w < NIT; w += gridDim.x * NTHR) {
        const int combo = w / 2112, q = w - combo * 2112, dir = combo & 1;
        float m_st = 0.f;
        if (q < 2048) {
            float st[8];
#pragma unroll
            for (int j = 0; j < 8; ++j) st[j] = 0.f;
            bf16_t* base = CL + (size_t)combo * NJ * 16384 + 8 * q;
#pragma unroll 1
            for (int i = 0; i < NJ; ++i) {
                const int J = scan_J(dir, i); float* ms = MST + ((size_t)combo * NJ + J) * 4;
                const u32x4 vc = *(const u32x4*)(base + (size_t)J * 16384);
                const float ml = ms[0], gg = ms[1];
                const float m_new = fmaxf(gg + m_st, ml), a_old = __expf(gg + m_st - m_new), a_new = __expf(ml - m_new);
                *(u32x4*)(base + (size_t)J * 16384) = pack8(st);
                if (q == 0) ms[2] = m_st;
                float c8[8]; unpack8(vc, c8);
#pragma unroll
                for (int j = 0; j < 8; ++j) st[j] = st[j] * a_old + c8[j] * a_new;
                m_st = m_new;
            }
        } else if (q < 2080) {
            float* base = NL + (size_t)combo * NJ * 128 + 4 * (q - 2048);
            f32x4 s4 = {0.f, 0.f, 0.f, 0.f};
#pragma unroll 1
            for (int i = 0; i < NJ; ++i) {
                const int J = scan_J(dir, i); const float* ms = MST + ((size_t)combo * NJ + J) * 4;
                const f32x4 vc = *(const f32x4*)(base + (size_t)J * 128);
                const float ml = ms[0], gg = ms[1];
                const float m_new = fmaxf(gg + m_st, ml), a_old = __expf(gg + m_st - m_new), a_new = __expf(ml - m_new);
                *(f32x4*)(base + (size_t)J * 128) = s4;
                s4 = s4 * a_old + vc * a_new; m_st = m_new;
            }
        }
    }
}

__device__ __forceinline__ unsigned zap_nf(unsigned w) { if ((w & 0x7f80u) >= 0x4980u) w &= 0xffff0000u; if ((w & 0x7f800000u) >= 0x49800000u) w &= 0x0000ffffu; return w; }
template <int dir>
__device__ __forceinline__ void mlstm_c_dir(const unsigned (&Xp)[4][8], f32x16 (&acc)[2], const LAS bf16_t* Tq, const LAS bf16_t* Tc, const LAS bf16_t* Tv,
                                            const LAS float* av, const LAS float* Mv, const LAS float* wi, LAS float* denw, const LAS float* n0l, int wid, int lane) {
    const int r32 = lane & 31, hi = lane >> 5, tb = wid >> 1, t = 32 * tb + r32;
    acc[0] = f32x16{}; acc[1] = f32x16{};
    mm128(Tq, Tc, acc, wid, lane);
#pragma unroll
    for (int r = 0; r < 16; ++r) { const float w = wi[dir * 128 + 32 * tb + crow(r, hi)]; acc[0][r] *= w; acc[1][r] *= w; }
    float nq = 0.f;
#pragma unroll
    for (int i = 0; i < 8; ++i) { float q8[8]; unpack8(*(const LAS u32x4*)(Tq + t * TLD + 64 * hi + 8 * i), q8);
        const f32x4 na = *(const LAS f32x4*)(n0l + dir * 128 + 64 * hi + 8 * i), nb = *(const LAS f32x4*)(n0l + dir * 128 + 64 * hi + 8 * i + 4);
#pragma unroll
        for (int j = 0; j < 4; ++j) nq += na[j] * q8[j] + nb[j] * q8[4 + j]; }
    const float Mt = Mv[dir * 128 + t]; float den = 0.f;
    const LAS bf16_t* vp = Tv + (64 * (wid & 1) + r32) * TLD + 4 * hi;
#pragma unroll
    for (int sb = 0; sb < 4; ++sb) {
        float o[16];
#pragma unroll
        for (int r = 0; r < 16; ++r) { const int s = 32 * sb + crow(r, hi); const bool ok = dir ? (s >= t) : (s <= t);
            const float xs = (r & 1) ? bf_hi(Xp[sb][r >> 1]) : bf_lo(Xp[sb][r >> 1]);
            const float ev = xs * __builtin_amdgcn_exp2f((av[dir * 128 + s] - Mt) * LOG2E);
            o[r] = ok ? ev : 0.f; den += o[r]; }
#pragma unroll
        for (int s2 = 0; s2 < 2; ++s2) {
            u32x4 aw; aw.x = cvtpk(o[8 * s2 + 0], o[8 * s2 + 1]); aw.y = cvtpk(o[8 * s2 + 2], o[8 * s2 + 3]); aw.z = cvtpk(o[8 * s2 + 4], o[8 * s2 + 5]); aw.w = cvtpk(o[8 * s2 + 6], o[8 * s2 + 7]);
            const bf16x8 af = *(const bf16x8*)&aw;
#pragma unroll
            for (int tl = 0; tl < 2; ++tl) { const LAS bf16_t* bp = vp + 32 * tl * TLD + 32 * sb + 16 * s2;
                const u32x2 b0 = *(const LAS u32x2*)bp, b1 = *(const LAS u32x2*)(bp + 8); u32x4 bw; bw.x = b0.x; bw.y = b0.y; bw.z = b1.x; bw.w = b1.y;
                acc[tl] = mfma32(af, *(const bf16x8*)&bw, acc[tl]); }
        }
        __builtin_amdgcn_sched_barrier(0);
    }
    { auto rr = __builtin_amdgcn_permlane32_swap(__float_as_uint(den), __float_as_uint(den), false, false); den = __uint_as_float(rr[0]) + __uint_as_float(rr[1]); }
    { auto rr = __builtin_amdgcn_permlane32_swap(__float_as_uint(nq), __float_as_uint(nq), false, false); nq = __uint_as_float(rr[0]) + __uint_as_float(rr[1]); }
    if (hi == 0) denw[(wid * 2 + dir) * 32 + r32] = den + wi[dir * 128 + t] * nq;
}
__device__ __forceinline__ void mlstm_c_unit(const Params& p, int l, int bl, int J, int h, LAS unsigned char* lds) {
    int tid_ = threadIdx.x; asm volatile("" : "+v"(tid_));
    const int tid = tid_, wid = __builtin_amdgcn_readfirstlane(tid >> 6), lane = tid & 63, r32 = lane & 31, hi = lane >> 5;
    LAS bf16_t* Tq = (LAS bf16_t*)lds; LAS bf16_t* Tk = (LAS bf16_t*)(lds + TILE_B); LAS bf16_t* Tv = (LAS bf16_t*)(lds + 2 * TILE_B); LAS bf16_t* Ts = (LAS bf16_t*)(lds + 3 * TILE_B);
    LAS float* sc = (LAS float*)(lds + 4 * TILE_B);
    LAS float* gl = sc;
    LAS float* av = sc + 512;
    LAS float* Mv = sc + 768;
    LAS float* wi = sc + 1024;
    LAS float* fl = sc + 1280;
    LAS float* ssq = sc + 1536;
    LAS float* denp = sc + 1664;
    LAS float* n0l = sc + 2944;
    const int rseq = J < 2 ? bl * 256 : CTXROWS + bl * 2048, r0 = rseq + (J < 2 ? J * 128 : (J - 2) * 128);
    u32x4 cf_[4], cbp_[4];
    { const int d_ = tid >> 2, e_ = (tid & 3) * 32; const bf16_t* c0f = (const bf16_t*)(p.ws + WS_P + P_CLOC) + ((size_t)((bl * 4 + h) * 2) * NJ + J) * 16384 + d_ * 128 + e_;
#pragma unroll
      for (int i = 0; i < 4; ++i) { cf_[i] = *(const u32x4*)(c0f + 8 * i); cbp_[i] = *(const u32x4*)(c0f + (size_t)NJ * 16384 + 8 * i); } }
    {
        const int t = tid >> 2, c0 = (tid & 3) * 32;
        const bf16_t* q = pbuf(p, P_MQ) + (size_t)(r0 + t) * 512 + h * 128 + c0; const bf16_t* k = pbuf(p, P_MK) + (size_t)(r0 + t) * 512 + h * 128 + c0;
        const bf16_t* v = pbuf(p, P_MVT) + ((size_t)((bl * NJ + J) * 4 + h)) * 16384 + t * 128 + c0;
#pragma unroll
        for (int i = 0; i < 4; ++i) { *(LAS u32x4*)(Tq + t * TLD + c0 + 8 * i) = *(const u32x4*)(q + 8 * i); *(LAS u32x4*)(Tk + t * TLD + c0 + 8 * i) = *(const u32x4*)(k + 8 * i);
            *(LAS u32x4*)(Tv + t * TLD + c0 + 8 * i) = *(const u32x4*)(v + 8 * i); }
        if (tid < 128) { *(LAS f32x4*)(gl + tid * 4) = *(const f32x4*)((const float*)(p.ws + WS_P + P_GATES) + (size_t)(r0 + tid) * 16 + h * 4); ssq[tid] = 0.f; }
        if (tid < 256) n0l[tid] = ((const float*)(p.ws + WS_P + P_NLOC))[((size_t)(((bl * 4 + h) * 2 + (tid >> 7)) * NJ + J)) * 128 + (tid & 127)];
    }
    __syncthreads();
    { const int d_ = tid >> 2, e_ = (tid & 3) * 32;
#pragma unroll
      for (int i = 0; i < 4; ++i) *(LAS u32x4*)(Ts + d_ * TLD + e_ + 8 * i) = cf_[i]; }
    const float* MST = (const float*)(p.ws + WS_P + P_MST);
    if (wid < 2) {
        const int dir = wid, p0 = 2 * lane, p1 = p0 + 1, s0 = dir ? 127 - p0 : p0, s1 = dir ? 127 - p1 : p1;
        const float m0 = ld_f32_dev(MST + ((size_t)(((bl * 4 + h) * 2 + dir) * NJ + J)) * 4 + 2);
        const float ig0 = gl[s0 * 4 + 2 * dir], ig1 = gl[s1 * 4 + 2 * dir];
        const float lf0 = logsigmoid_f(gl[s0 * 4 + 2 * dir + 1]), lf1 = logsigmoid_f(gl[s1 * 4 + 2 * dir + 1]);
        float incl = lf0 + lf1;
        for (int o = 1; o < 64; o <<= 1) { const float t = __shfl_up(incl, o); if (lane >= o) incl += t; }
        const float bc1 = incl, bc0 = incl - lf1;
        const float a0 = ig0 - bc0, a1 = ig1 - bc1;
        float mx = fmaxf(a0, a1);
        for (int o = 1; o < 64; o <<= 1) { const float t = __shfl_up(mx, o); if (lane >= o) mx = fmaxf(mx, t); }
        float mxprev = __shfl_up(mx, 1); if (lane == 0) mxprev = -3.0e38f;
        const float M0 = fmaxf(m0, fmaxf(mxprev, a0)), M1 = fmaxf(m0, mx);
        av[dir * 128 + s0] = a0; av[dir * 128 + s1] = a1; Mv[dir * 128 + s0] = M0; Mv[dir * 128 + s1] = M1;
        wi[dir * 128 + s0] = __expf(m0 - M0); wi[dir * 128 + s1] = __expf(m0 - M1);
        fl[dir * 128 + s0] = __expf(-bc0 - M0); fl[dir * 128 + s1] = __expf(-bc1 - M1);
    }
    __builtin_amdgcn_sched_barrier(0);
    unsigned Xp[4][8];
    {
    f32x16 X[4] = {};
    { const LAS bf16_t* bq = Tq + (32 * (wid >> 1) + r32) * TLD + hi * 8; const LAS bf16_t* ak = Tk + r32 * TLD + hi * 8;
#pragma unroll 2
      for (int ks = 0; ks < 8; ++ks) { const bf16x8 b = *(const LAS bf16x8*)(bq + ks * 16);
#pragma unroll
          for (int sb = 0; sb < 4; ++sb) X[sb] = mfma32(*(const LAS bf16x8*)(ak + 32 * sb * TLD + ks * 16), b, X[sb]); } }
#pragma unroll
    for (int sb = 0; sb < 4; ++sb)
#pragma unroll
        for (int i = 0; i < 8; ++i) Xp[sb][i] = cvtpk(X[sb][2 * i], X[sb][2 * i + 1]);
    }
    __syncthreads();
    { const int d_ = tid >> 2, e_ = (tid & 3) * 32;
#pragma unroll
      for (int i = 0; i < 4; ++i) *(LAS u32x4*)(Tk + d_ * TLD + e_ + 8 * i) = cbp_[i]; }
    __syncthreads();
    f32x16 ao0[2], ao1[2];
    LAS float* denw = denp;
    mlstm_c_dir<0>(Xp, ao0, Tq, Ts, Tv, av, Mv, wi, denw, n0l, wid, lane);
    mlstm_c_dir<1>(Xp, ao1, Tq, Tk, Tv, av, Mv, wi, denw, n0l, wid, lane);
    float hv[2][16];
#pragma unroll
    for (int r = 0; r < 16; ++r) { const int t = 32 * (wid >> 1) + crow(r, hi);
        const float df = denw[(wid * 2 + 0) * 32 + crow(r, hi)], db = denw[(wid * 2 + 1) * 32 + crow(r, hi)];
        const float rf = 1.0f / fmaxf(fabsf(df), fl[t]), rb = 1.0f / fmaxf(fabsf(db), fl[128 + t]);
        hv[0][r] = ao0[0][r] * rf + ao1[0][r] * rb; hv[1][r] = ao0[1][r] * rf + ao1[1][r] * rb;
        float q = hv[0][r] * hv[0][r] + hv[1][r] * hv[1][r];
        q = half_sum31(q);
        if (r32 == 31) lds_addf(&ssq[t], q); }
    __syncthreads();
    const float* gm = p.in[I_GMN] + l * 512 + h * 128; const float* sk = p.in[I_SKIP] + l * 512 + h * 128;
    f32x16 hn[2];
#pragma unroll
    for (int tl = 0; tl < 2; ++tl) { const float gd = gm[64 * (wid & 1) + 32 * tl + r32];
#pragma unroll
        for (int r = 0; r < 16; ++r) hn[tl][r] = hv[tl][r] * rsqrtf(ssq[32 * (wid >> 1) + crow(r, hi)] * (1.0f / 128.0f) + EPS) * gd; }
    LAS float* F = (LAS float*)lds;
    st_acc_f32(F, hn, wid, lane);
    __syncthreads();
    { int te_ = tid; asm volatile("" : "+v"(te_));
      const int t = te_ >> 2, c0 = (te_ & 3) * 32; const size_t o = (size_t)(r0 + t) * 512 + h * 128 + c0;
      const bf16_t* xcv = pbuf(p, P_XCV) + o; bf16_t* zb = pbuf(p, P_ZB) + o;
      u32x4 xw[4], zw[4]; f32x4 s0[4], s1[4];
#pragma unroll
      for (int i = 0; i < 4; ++i) { xw[i] = *(const u32x4*)(xcv + 8 * i); zw[i] = *(const u32x4*)(zb + 8 * i); s0[i] = *(const f32x4*)(sk + c0 + 8 * i); s1[i] = *(const f32x4*)(sk + c0 + 8 * i + 4); }
#pragma unroll
      for (int i = 0; i < 4; ++i) { float x8[8], z8[8]; unpack8(xw[i], x8); unpack8(zw[i], z8);
          const f32x4 h0 = *(const LAS f32x4*)(F + t * FLD + c0 + 8 * i), h1 = *(const LAS f32x4*)(F + t * FLD + c0 + 8 * i + 4);
#pragma unroll
          for (int j = 0; j < 4; ++j) { z8[j] = (h0[j] + s0[i][j] * x8[j]) * z8[j]; z8[4 + j] = (h1[j] + s1[i][j] * x8[4 + j]) * z8[4 + j]; }
          zw[i] = pack8(z8); }
#pragma unroll
      for (int i = 0; i < 4; ++i) *(u32x4*)(zb + 8 * i) = zw[i]; }
    __syncthreads();
}
namespace att {
constexpr int SHM_V = 64 * 128 * 2, SHM_K = 64 * 64 * 2, OFF_K = 2 * SHM_V, OFF_WS = OFF_K + 2 * SHM_K, OFF_ST = OFF_WS + 8 * 64 * 4, LDS_NEED = OFF_ST + 32 * 512 * 4;
static_assert(LDS_NEED <= LDS_BYTES - 64, "attention LDS");
constexpr float THR2 = 11.5f;
#define KSWZ64(row, colB) ((row) * 128 + ((colB) ^ (((row) & 7) << 4)))
#define ASBAR() __builtin_amdgcn_sched_barrier(0)
__device__ __forceinline__ void partialSM(f32x16& p0, f32x16& p1, float& m_reg, float& mn, float& alpha) {
    float pmax = p0[0];
#pragma unroll
    for (int r = 1; r < 16; ++r) pmax = fmaxf(pmax, p0[r]);
#pragma unroll
    for (int r = 0; r < 16; ++r) pmax = fmaxf(pmax, p1[r]);
    { auto rr = __builtin_amdgcn_permlane32_swap(__float_as_uint(pmax), __float_as_uint(pmax), false, false); pmax = fmaxf(__uint_as_float(rr[0]), __uint_as_float(rr[1])); }
    if (__builtin_expect(__all(pmax - m_reg <= THR2), 1)) { mn = m_reg; alpha = 1.f; }
    else { mn = fmaxf(m_reg, pmax); alpha = __builtin_amdgcn_exp2f(m_reg - mn); m_reg = mn; }
#pragma unroll
    for (int r = 0; r < 16; ++r) { p0[r] -= mn; p1[r] -= mn; }
#pragma unroll
    for (int r = 0; r < 16; ++r) p0[r] = __builtin_amdgcn_exp2f(p0[r]);
}
__device__ __forceinline__ void finishSM(f32x16& p0, f32x16& p1, float alpha, float& l_reg, bf16x8& pa0, bf16x8& pa1, bf16x8& pa2, bf16x8& pa3) {
#pragma unroll
    for (int r = 0; r < 16; ++r) p1[r] = __builtin_amdgcn_exp2f(p1[r]);
    float ps = 0;
#pragma unroll
    for (int r = 0; r < 16; ++r) ps += p0[r];
#pragma unroll
    for (int r = 0; r < 16; ++r) ps += p1[r];
    { auto rr = __builtin_amdgcn_permlane32_swap(__float_as_uint(ps), __float_as_uint(ps), false, false); ps = __uint_as_float(rr[0]) + __uint_as_float(rr[1]); }
    l_reg = l_reg * alpha + ps;
#define PK4(P, BASE, OUT) do { unsigned a0 = cvtpk(P[BASE + 0], P[BASE + 1]), a1 = cvtpk(P[BASE + 2], P[BASE + 3]);   \
    unsigned b0 = cvtpk(P[BASE + 4], P[BASE + 5]), b1 = cvtpk(P[BASE + 6], P[BASE + 7]);                              \
    auto r0 = __builtin_amdgcn_permlane32_swap(a0, b0, false, false); auto r1 = __builtin_amdgcn_permlane32_swap(a1, b1, false, false); \
    u32x4 w = {r0[0], r1[0], r0[1], r1[1]}; OUT = *reinterpret_cast<bf16x8*>(&w); } while (0)
    PK4(p0, 0, pa0); PK4(p0, 8, pa1); PK4(p1, 0, pa2); PK4(p1, 8, pa3);
#undef PK4
}
__device__ __forceinline__ void qkt(f32x16& p0, f32x16& p1, const LAS char* Ks, const bf16x8 (&qr)[4], int r32, int hi) {
    p0 = f32x16{}; p1 = f32x16{};
#pragma unroll
    for (int d0 = 0; d0 < 4; ++d0) { const int cb = (d0 * 16 + hi * 8) * 2;
        const bf16x8 b0 = *reinterpret_cast<const LAS bf16x8*>(Ks + KSWZ64(r32, cb));
        const bf16x8 b1 = *reinterpret_cast<const LAS bf16x8*>(Ks + KSWZ64(32 + r32, cb));
        p0 = mfma32(b0, qr[d0], p0); p1 = mfma32(b1, qr[d0], p1); }
}
__device__ __forceinline__ int v_st(int k, int c) { const int kk = (k & ~0xC) | ((k & 4) << 1) | ((k & 8) >> 1); return ((kk >> 3) * 4 + (c >> 5)) * 512 + ((kk & 7) * 32 + (c & 31)) * 2; }
__device__ __forceinline__ int v_rd_base(int lane) { return ((lane & 3) << 3) | (((lane >> 2) & 3) << 6) | (((lane >> 4) & 1) << 5) | (((lane >> 5) & 1) << 8); }
constexpr int v_rd_off(int d0, int ks, int half) { return d0 * 512 + ks * 4096 + half * 2048; }
template <int OFF> __device__ __forceinline__ s16x4 tr_read(int vb) { s16x4 r; asm volatile("ds_read_b64_tr_b16 %0, %1 offset:%2" : "=&v"(r) : "v"(vb), "i"(OFF) : "memory"); return r; }
template <int D0> __device__ __forceinline__ void pv_one(f32x16& od, int vb, bf16x8 pa0, bf16x8 pa1, bf16x8 pa2, bf16x8 pa3) {
    const s16x4 l0 = tr_read<v_rd_off(D0, 0, 0)>(vb), h0 = tr_read<v_rd_off(D0, 0, 1)>(vb), l1 = tr_read<v_rd_off(D0, 1, 0)>(vb), h1 = tr_read<v_rd_off(D0, 1, 1)>(vb);
    const s16x4 l2 = tr_read<v_rd_off(D0, 2, 0)>(vb), h2 = tr_read<v_rd_off(D0, 2, 1)>(vb), l3 = tr_read<v_rd_off(D0, 3, 0)>(vb), h3 = tr_read<v_rd_off(D0, 3, 1)>(vb);
    asm volatile("s_waitcnt lgkmcnt(0)" ::: "memory"); ASBAR();
#define PKV(L, H) (bf16x8){L[0], L[1], L[2], L[3], H[0], H[1], H[2], H[3]}
    od = mfma32(pa0, PKV(l0, h0), od); od = mfma32(pa1, PKV(l1, h1), od); od = mfma32(pa2, PKV(l2, h2), od); od = mfma32(pa3, PKV(l3, h3), od);
#undef PKV
}
__device__ __forceinline__ void pv_d0(f32x16 (&o)[4], int vb, bf16x8 pa0, bf16x8 pa1, bf16x8 pa2, bf16x8 pa3) {
    pv_one<0>(o[0], vb, pa0, pa1, pa2, pa3); pv_one<1>(o[1], vb, pa0, pa1, pa2, pa3); pv_one<2>(o[2], vb, pa0, pa1, pa2, pa3); pv_one<3>(o[3], vb, pa0, pa1, pa2, pa3);
}
__device__ __forceinline__ int krow(int j, int rc, int rl) { return j < 4 ? rc + 64 * j : rl + 64 * (j - 4); }

__device__ __forceinline__ void attn_unit(const Params& p, int l, int h, int qrow0, int rc, int rl, int NT, LAS unsigned char* lds8) {
    int tid_ = threadIdx.x; asm volatile("" : "+v"(tid_));
    const int tid = tid_, wid = __builtin_amdgcn_readfirstlane(tid >> 6), lane = tid & 63, r32 = lane & 31, hi = lane >> 5;
    LAS char* V_lds = (LAS char*)lds8; LAS char* K_lds = (LAS char*)lds8 + OFF_K;
    LAS float* wsx = (LAS float*)(lds8 + OFF_WS) + wid * 64; LAS float* li_l = wsx; LAS float* al_l = wsx + 32;
    LAS unsigned* stash = (LAS unsigned*)(lds8 + OFF_ST);
    bf16_t* QB = pbuf(p, P_QB); const bf16_t* KB = pbuf(p, P_KB); const bf16_t* VB = pbuf(p, P_VB);
    const int sr = tid >> 4, sc = (tid & 15) * 8, vst0 = v_st(sr, sc);
    const int kr = tid >> 3, kc = (tid & 7) * 8, kst = KSWZ64(kr, kc * 2);
    const int vb0 = (int)(uintptr_t)V_lds + v_rd_base(lane);
    f32x16 o[4];
#pragma unroll 1
    for (int m = 0; m < 2; ++m) {
        const unsigned voV0 = (unsigned)((sr * 512 + h * 128 + sc) * 2), voK = (unsigned)((kr * 512 + h * 128 + m * 64 + kc) * 2);
        float m_reg = -1e30f, l_reg = 0.f;
#pragma unroll
        for (int d = 0; d < 4; ++d) o[d] = f32x16{};
        bf16x8 qr[4];
        { const bf16_t* Qw = QB + (size_t)(qrow0 + wid * 32 + r32) * 512 + h * 128 + m * 64 + hi * 8;
#pragma unroll
          for (int d0 = 0; d0 < 4; ++d0) qr[d0] = *(const bf16x8*)(Qw + d0 * 16); }
        struct { bf16x8 vs0, vs1, ks0; } sr_[2];
#define SLOAD(i, j) do { const int _r = __builtin_amdgcn_readfirstlane(krow((j), rc, rl)); const char* _vb = (const char*)(VB + (size_t)_r * 512); const char* _kb = (const char*)(KB + (size_t)_r * 512); \
    sr_[i].vs0 = *(const bf16x8*)(_vb + voV0); sr_[i].vs1 = *(const bf16x8*)(_vb + 32 * 512 * 2 + voV0); sr_[i].ks0 = *(const bf16x8*)(_kb + voK); } while (0)
#define SWRITE(b, i) do { *(LAS bf16x8*)(V_lds + (b) * SHM_V + vst0) = sr_[i].vs0; *(LAS bf16x8*)(V_lds + (b) * SHM_V + 8192 + vst0) = sr_[i].vs1; \
    *(LAS bf16x8*)(K_lds + (b) * SHM_K + kst) = sr_[i].ks0; } while (0)
#define SWAIT() asm volatile("s_waitcnt vmcnt(3)" ::: "memory")
#define RESC(a) do { if (__any((a) < 1.f)) { if (hi == 0) al_l[r32] = (a); asm volatile("s_waitcnt lgkmcnt(0)" ::: "memory"); \
    _Pragma("unroll") for (int d = 0; d < 4; ++d) _Pragma("unroll") for (int r = 0; r < 16; ++r) o[d][r] *= al_l[crow(r, hi)]; } } while (0)
        f32x16 pA0, pA1, pB0, pB1; float mnA, mnB, alA, alB; bf16x8 pa0, pa1, pa2, pa3;
        SLOAD(0, 0); asm volatile("s_waitcnt vmcnt(0)" ::: "memory"); SWRITE(0, 0); __syncthreads();
        qkt(pA0, pA1, K_lds, qr, r32, hi); partialSM(pA0, pA1, m_reg, mnA, alA);
        SLOAD(1, 1); if (2 < NT) SLOAD(0, 2);
        SWAIT(); SWRITE(1, 1); __syncthreads();
        for (int j = 1; j + 1 < NT; j += 2) {
            ASBAR(); qkt(pB0, pB1, K_lds + SHM_K, qr, r32, hi);
            finishSM(pA0, pA1, alA, l_reg, pa0, pa1, pa2, pa3); ASBAR();
            SLOAD(1, j + 2); ASBAR();
            pv_d0(o, vb0, pa0, pa1, pa2, pa3); partialSM(pB0, pB1, m_reg, mnB, alB);
            __syncthreads(); SWAIT(); SWRITE(0, 0);
            RESC(alB); __syncthreads();
            ASBAR(); qkt(pA0, pA1, K_lds, qr, r32, hi);
            finishSM(pB0, pB1, alB, l_reg, pa0, pa1, pa2, pa3); ASBAR();
            if (j + 3 < NT) SLOAD(0, j + 3); ASBAR();
            pv_d0(o, vb0 + SHM_V, pa0, pa1, pa2, pa3); partialSM(pA0, pA1, m_reg, mnA, alA);
            __syncthreads(); SWAIT(); SWRITE(1, 1);
            RESC(alA); __syncthreads();
        }
        ASBAR(); qkt(pB0, pB1, K_lds + SHM_K, qr, r32, hi);
        finishSM(pA0, pA1, alA, l_reg, pa0, pa1, pa2, pa3); ASBAR();
        pv_d0(o, vb0, pa0, pa1, pa2, pa3); partialSM(pB0, pB1, m_reg, mnB, alB);
        __syncthreads(); RESC(alB);
        finishSM(pB0, pB1, alB, l_reg, pa0, pa1, pa2, pa3); ASBAR();
        pv_d0(o, vb0 + SHM_V, pa0, pa1, pa2, pa3);
#undef SLOAD
#undef SWRITE
#undef SWAIT
#undef RESC
        int lane_e = lane; asm volatile("" : "+v"(lane_e)); const int r32e = lane_e & 31, hie = lane_e >> 5;
        if (hie == 0) li_l[r32e] = l_reg; asm volatile("s_waitcnt lgkmcnt(0)" ::: "memory");
        float rli[16];
#pragma unroll
        for (int r = 0; r < 16; ++r) rli[r] = __builtin_amdgcn_rcpf(li_l[crow(r, hie)]);
        if (m == 0) {
#pragma unroll
            for (int d0 = 0; d0 < 4; ++d0)
#pragma unroll
                for (int r = 0; r < 16; r += 2) stash[(wid * 32 + d0 * 8 + (r >> 1)) * 64 + lane_e] = cvtpk(o[d0][r] * rli[r], o[d0][r + 1] * rli[r + 1]);
        } else {
            const float lam = ld_f32_dev((const float*)(p.ws + WS_LAM) + l * 4), oml = ld_f32_dev((const float*)(p.ws + WS_LAM) + l * 4 + 1);
            float ss[16];
#pragma unroll
            for (int r = 0; r < 16; ++r) ss[r] = 0.f;
#pragma unroll
            for (int d0 = 0; d0 < 4; ++d0)
#pragma unroll
                for (int r = 0; r < 16; r += 2) { const unsigned w = stash[(wid * 32 + d0 * 8 + (r >> 1)) * 64 + lane_e];
                    o[d0][r] = bf_lo(w) - lam * o[d0][r] * rli[r]; o[d0][r + 1] = bf_hi(w) - lam * o[d0][r + 1] * rli[r + 1];
                    ss[r] += o[d0][r] * o[d0][r]; ss[r + 1] += o[d0][r + 1] * o[d0][r + 1]; }
#pragma unroll
            for (int r = 0; r < 16; ++r) { float q = ss[r]; q += __shfl_xor(q, 1); q += __shfl_xor(q, 2); q += __shfl_xor(q, 4); q += __shfl_xor(q, 8); q += __shfl_xor(q, 16);
                ss[r] = rsqrtf(q * (1.0f / 128.0f) + EPS) * oml; }
            const float* gs = p.in[I_GSUBLN] + l * 128;
            asm volatile("s_waitcnt lgkmcnt(0)" ::: "memory");
            LAS bf16_t* ot = (LAS bf16_t*)(stash + wid * 32 * 64);
#pragma unroll
            for (int d0 = 0; d0 < 4; ++d0) { const float g = gs[d0 * 32 + r32e];
#pragma unroll
                for (int r = 0; r < 16; ++r) ot[((r & 3) + 8 * (r >> 2) + 4 * hie) * 128 + d0 * 32 + r32e] = (bf16_t)(cvtpk(o[d0][r] * ss[r] * g, 0.f) & 0xffffu); }
            asm volatile("s_waitcnt lgkmcnt(0)" ::: "memory");
            { bf16_t* dst = QB + (size_t)(qrow0 + wid * 32) * 512 + h * 128;
#pragma unroll
              for (int i = 0; i < 8; ++i) { const int row = i * 4 + (lane_e >> 4), pc = (lane_e & 15) * 8;
                  *(u32x4*)(dst + (size_t)row * 512 + pc) = *(const LAS u32x4*)(ot + row * 128 + pc); } }
        }
        __syncthreads();
    }
}
}
__device__ __forceinline__ void gmlp_unit(const Params& p, int l, int r0, LAS unsigned char* lds) {
    int tid_ = threadIdx.x; asm volatile("" : "+v"(tid_));
    const int tid = tid_, wid = __builtin_amdgcn_readfirstlane(tid >> 6), lane = tid & 63, r32 = lane & 31, hi = lane >> 5;
    const bf16_t* VG = pbuf(p, P_VGB); bf16_t* UB = pbuf(p, P_UB);
    PSEC_BEGIN8();
    {
        const int sr = tid >> 4, sc = (tid & 15) * 8, vst0 = att::v_st(sr, sc);
        u32x4 x[4][4]; float rs[4];
#pragma unroll
        for (int k = 0; k < 4; ++k)
#pragma unroll
            for (int g = 0; g < 4; ++g) x[k][g] = *(const u32x4*)(VG + (size_t)(r0 + sr + 32 * k) * 512 + g * 128 + sc);
#pragma unroll
        for (int k = 0; k < 4; ++k) { float ss = 0.f;
#pragma unroll
            for (int g = 0; g < 4; ++g) { float v[8]; unpack8(x[k][g], v);
#pragma unroll
                for (int j = 0; j < 8; ++j) ss += v[j] * v[j]; }
            ss += __shfl_xor(ss, 1); ss += __shfl_xor(ss, 2); ss += __shfl_xor(ss, 4); ss += __shfl_xor(ss, 8);
            rs[k] = rsqrtf(ss * (1.0f / 512.0f) + EPS); }
#pragma unroll
        for (int k = 0; k < 4; ++k)
#pragma unroll
            for (int g = 0; g < 4; ++g) { float v[8]; unpack8(x[k][g], v);
#pragma unroll
                for (int j = 0; j < 8; ++j) v[j] *= rs[k];
                *(LAS u32x4*)(lds + (g * 2 + (k >> 1)) * att::SHM_V + (k & 1) * 8192 + vst0) = pack8(v); }
    }
    __syncthreads();
    const int rb = wid >> 1, dh = wid & 1;
    const int vb0 = (int)(uintptr_t)lds + att::v_rd_base(lane) + dh * 1024;
    LAS float* F = (LAS float*)(lds + 8 * att::SHM_V) + wid * 576;
    const bf16_t* Wsb = (const bf16_t*)(p.ws + WS_WSB) + (size_t)l * 4 * 16384 + (size_t)(32 * rb + r32) * 128 + 8 * hi;
#pragma unroll 1
    for (int g = 0; g < 4; ++g) {
        bf16x8 pa[2][4];
#pragma unroll
        for (int kt = 0; kt < 2; ++kt)
#pragma unroll
            for (int k4 = 0; k4 < 4; ++k4) pa[kt][k4] = *(const bf16x8*)(Wsb + (size_t)g * 16384 + 64 * kt + 16 * k4);
        bf16_t* up = UB + (size_t)(r0 + 32 * rb + (lane >> 2)) * 512 + g * 128 + 64 * dh + 8 * (lane & 3);
        u32x4 uu[2][2];
#pragma unroll
        for (int d0 = 0; d0 < 2; ++d0)
#pragma unroll
            for (int rd = 0; rd < 2; ++rd) uu[d0][rd] = *(const u32x4*)(up + (size_t)(16 * rd) * 512 + 32 * d0);
        const float* gv = p.in[I_GGV] + l * 512 + g * 128 + 64 * dh + r32; const float* bs = p.in[I_BGS] + (l * 4 + g) * 128 + 32 * rb;
        const float gv0 = gv[0], gv1 = gv[32];
        float bsv[16];
#pragma unroll
        for (int r = 0; r < 16; ++r) bsv[r] = bs[crow(r, hi)];
        __builtin_amdgcn_sched_barrier(0);
        f32x16 o[2] = {};
        att::pv_one<0>(o[0], vb0 + (g * 2) * att::SHM_V, pa[0][0], pa[0][1], pa[0][2], pa[0][3]); att::pv_one<1>(o[1], vb0 + (g * 2) * att::SHM_V, pa[0][0], pa[0][1], pa[0][2], pa[0][3]);
        att::pv_one<0>(o[0], vb0 + (g * 2 + 1) * att::SHM_V, pa[1][0], pa[1][1], pa[1][2], pa[1][3]); att::pv_one<1>(o[1], vb0 + (g * 2 + 1) * att::SHM_V, pa[1][0], pa[1][1], pa[1][2], pa[1][3]);
#pragma unroll
        for (int d0 = 0; d0 < 2; ++d0)
#pragma unroll
            for (int rd = 0; rd < 2; ++rd) {
#pragma unroll
                for (int r = 0; r < 8; ++r) { const int rr = 8 * rd + r; F[((r & 3) + 8 * ((r >> 2) & 1) + 4 * hi) * 36 + r32] = o[d0][rr] * (d0 ? gv1 : gv0) + bsv[rr]; }
                asm volatile("s_waitcnt lgkmcnt(0)" ::: "memory");
                const f32x4 m0 = *(const LAS f32x4*)(F + (lane >> 2) * 36 + 8 * (lane & 3)), m1 = *(const LAS f32x4*)(F + (lane >> 2) * 36 + 8 * (lane & 3) + 4);
                float u8[8]; unpack8(uu[d0][rd], u8);
#pragma unroll
                for (int j = 0; j < 4; ++j) { u8[j] *= m0[j]; u8[4 + j] *= m1[j]; }
                *(u32x4*)(up + (size_t)(16 * rd) * 512 + 32 * d0) = pack8(u8);
                asm volatile("s_waitcnt lgkmcnt(0)" ::: "memory");
            }
    }
    __syncthreads();
    PSEC(8);
}
constexpr int N_PHASES = 36;
typedef const __attribute__((address_space(4))) Params* KParams;
#define PHASE_P() const Params& p = *(const Params*)opaque_kp()
__device__ __forceinline__ KParams opaque_kp() { KParams q = (KParams)__builtin_amdgcn_kernarg_segment_ptr(); asm volatile("" : "+s"(q)); return q; }
__global__ void __launch_bounds__(NTHR, 2) mk_fwd(Params p_arg, int bar_region) {
    extern __shared__ __attribute__((aligned(16))) unsigned char lds_raw[];
    LAS unsigned char* lds = (LAS unsigned char*)lds_raw;
    const int tid = threadIdx.x, G = gridDim.x, bid = blockIdx.x;
    volatile LAS unsigned* xbw = (volatile LAS unsigned*)(lds + LDS_BYTES - 16);
    if (tid == 0) { xbw[0] = 0u; xbw[1] = 0u; xbw[2] = 0u; xbw[3] = 0u; }
    __syncthreads();
    (void)xcd_barrier_post((unsigned*)(p_arg.ws + WS_CTL) + CW_BAR + bar_region * 4096, xbw);
    const int lo = p_arg.ph_lo, hi = p_arg.ph_hi;
#define IN(k) (lo <= (k) && (k) < hi)
#ifdef PROBE
#define STAMP(k) do { if (tid == 0) { if (bid == 0) ((unsigned long long*)(opaque_kp()->ws + WS_CTL))[30000 + (k)] = __builtin_amdgcn_s_memrealtime(); *(volatile LAS int*)(lds + LDS_BYTES - 32) = (k); } __syncthreads(); } while (0)
#else
#define STAMP(k) do { } while (0)
#endif
#define GRID_BARRIER() do { KParams kq = opaque_kp(); XcdBarrier b_; b_.bar = (unsigned*)(kq->ws + WS_CTL) + CW_BAR + ((const __attribute__((address_space(4))) int*)(kq + 1))[0] * 4096; b_.x = xb_xcc_id(); b_.st = xbw; xcd_barrier(b_); } while (0)
#define SEAM(k) do { if (IN(k) && IN((k) + 1)) { GRID_BARRIER(); STAMP((k) + 1); } } while (0)

    STAMP(0);
#if !defined(ONLY) || ONLY == 0
    if (IN(0)) { PHASE_P(); phase_prologue(p, lds); }
#endif
    SEAM(0);
    for (int l = 0; l < 2; ++l) {
        const int base = 1 + 17 * l;
#if !defined(ONLY) || ONLY == 1
        if (IN(base)) { PHASE_P(); phase_norm1(p, l); }
#endif
        SEAM(base);
        for (int hf = 0; hf < 2; ++hf) {
            const int hb = base + 1 + 6 * hf;
#if !defined(ONLY) || ONLY == 2
            if (IN(hb)) {
                PHASE_P(); unsigned char* ws = p.ws; bf16_t* Hh = (bf16_t*)(ws + WS_H) + (size_t)hf * MH * 1024; (void)Hh;
                const float* cosT = (const float*)(ws + WS_ROPE); const float* sinT = cosT + 1024;
                pg8::Gemm g{Hh, (const bf16_t*)(ws + WS_WTIN) + (size_t)l * NCOL * 1024, MH, NCOL, 1024};
                int cin = bid; if (hf == 1) { cin += G >> 1; if (cin >= G) cin -= G; }
                RectOrder S; if (l == 0) S.init(72, 14, 0, 0, 0, 0, G, cin); else S.init(64, 14, 8, 8, 6, 0, G, cin);
                EpiIn E{pbuf(p, 0), pbuf(p, P_GB), cosT, sinT};
                pg8::gemm_phase<EpiIn, RectOrder>((PG8_LAS unsigned char*)lds, g, S, E, nullptr);
                pg8::Gemm g8{(const bf16_t*)(ws + WS_H8 + (size_t)hf * MH * 1024), (const bf16_t*)(ws + WS_WTIN8 + (size_t)l * 3072 * 1024), MH, 3072, 512};
                RectOrder S8; S8.init(l == 0 ? 72 : 64, 12, l == 0 ? 0 : 8, 0, 0, 0, G, G - 1 - cin);
                EpiGate8 E8{pbuf(p, P_GB)};
                pg8::gemm_phase<EpiGate8, RectOrder, false, true>((PG8_LAS unsigned char*)lds, g8, S8, E8, nullptr);
            }
#endif
            SEAM(hb);
#if !defined(ONLY) || ONLY == 3
            if (IN(hb + 1)) {
                PSEC_BEGIN6();
                { PHASE_P(); phase_conv(p, l, lds); }
                PSEC(6);
                GRID_BARRIER(); PSEC(7);
                PHASE_P();
                const int n_a = HBAT * NJ * 4, n_g = HBAT * 16 + (l == 0 ? HBAT * 2 : 0);
                const int bidx = (G == 256) ? ((bid & 7) * 32 + (bid >> 3)) : bid;
                int u = bidx;
                PSEC(13);
                { u32x4 qa[4], qb[4], qwq[4], qwk[4], qwv[4]; f32x4 qg; mlstm_a_load(p, l, u < n_a ? u : 0, APRE_ARGS);
                  for (; u < n_a; u += G) mlstm_a_unit(p, l, u, u + G, n_a, APRE_ARGS, lds); }
                PSEC(14);
                for (; u < n_a + n_g; u += G) { const int v = u - n_a; int r0; if (v < HBAT * 16) r0 = CTXROWS + (v >> 4) * 2048 + (v & 15) * 128; else { const int w = v - HBAT * 16; r0 = (w >> 1) * 256 + (w & 1) * 128; }
                    gmlp_unit(p, l, r0, lds); }
            }
#endif
            SEAM(hb + 1);
#if !defined(ONLY) || ONLY == 4
            if (IN(hb + 2)) {
                PHASE_P();
                phase_scan(p);
            }
#endif
            SEAM(hb + 2);
#if !defined(ONLY) || ONLY == 5
            if (IN(hb + 3)) {
                PHASE_P();
                const int n_l = HBAT * 4 * 8, n_c = (l == 0 ? HBAT * 4 : 0);
                for (int u = bid; u < n_l + n_c; u += G) {
                    int h, qrow0, rc, rl, NT;
                    if (u < n_l) { const int ue = (G == 256) ? ((((u & 7) * 4 + (u >> 6)) << 3) | ((u >> 3) & 7)) : u;
                        const int bl = ue >> 5, qb = ue & 7; h = (ue >> 3) & 3; qrow0 = CTXROWS + bl * 2048 + qb * 256; rc = bl * 256; rl = CTXROWS + bl * 2048; NT = 36; }
                    else { const int v = u - n_l, bl = v >> 2; h = v & 3; qrow0 = bl * 256; rc = bl * 256; rl = 0; NT = 4; }
                    PSEC_BEGINN(9); att::attn_unit(p, l, h, qrow0, rc, rl, NT, lds); PSEC(9);
                }
                const int m_l = HBAT * 16 * 4, m_c = (l == 0 ? HBAT * 2 * 4 : 0);
                int u0 = bid + 192; if (u0 >= G) u0 -= G;
                for (int u = u0; u < m_l + m_c; u += G) {
                    int bl, J, h;
                    if (u < m_l) { const int rem = u & 63; bl = u >> 6; J = 2 + (rem >> 2); h = rem & 3; }
                    else { const int v = u - m_l, rem = v & 7; bl = v >> 3; J = rem >> 2; h = rem & 3; }
                    PSEC_BEGINN(10); mlstm_c_unit(p, l, bl, J, h, lds); PSEC(10);
                }
                if (l == 0 && G == 256 && !(bid >= 64 && bid < 128)) cvt_fill(p, lds, hf == 0 ? 0 : CVT_Q1, hf == 0 ? CVT_Q0 : CVT_Q2, bid < 64 ? bid : bid - 64, 192);
                else if (l == 0 && G != 256) cvt_fill(p, lds, hf == 0 ? 0 : CVT_Q1, hf == 0 ? CVT_Q0 : CVT_Q2, bid, G);
            }
#endif
            SEAM(hb + 3);
#if !defined(ONLY) || ONLY == 6
            if (IN(hb + 4)) {
                PHASE_P(); unsigned char* ws = p.ws; bf16_t* Hh = (bf16_t*)(ws + WS_H) + (size_t)hf * MH * 1024; (void)Hh;
                pg8::Gemm g{pbuf(p, P_QB), (const bf16_t*)(ws + WS_WTBR) + (size_t)l * 3072 * 512, 3 * MH, 3072, 512};
                MergeOrder S; S.init(l == 0 ? 72 : 64, l == 0 ? 0 : 8, G, bid);
                EpiMerge E{pbuf(p, P_GB), Hh};
                pg8::gemm_phase<EpiMerge, MergeOrder>((PG8_LAS unsigned char*)lds, g, S, E, nullptr);
                if (l == 0) { const int skip = G > 64 ? 32 : 0; __syncthreads(); if (bid >= skip) cvt_fill(p, lds, hf == 0 ? CVT_Q0 : CVT_Q2, hf == 0 ? CVT_Q1 : CVT_Q3, bid - skip, G - skip); }
            }
#endif
            SEAM(hb + 4);
#if !defined(ONLY) || ONLY == 7
            if (IN(hb + 5)) {
                PHASE_P(); unsigned char* ws = p.ws; bf16_t* Hh = (bf16_t*)(ws + WS_H) + (size_t)hf * MH * 1024; (void)Hh;
                pg8::Gemm g{Hh, (const bf16_t*)(ws + WS_WTO) + (size_t)l * 1024 * 1024, MH, 1024, 1024};
                RectOrder S; S.init(l == 0 ? 72 : 64, 4, l == 0 ? 0 : 8, 0, 0, 0, G, bid);
                EpiOut E{l == 0 ? p.in[I_X] : (const float*)p.out, l == 0 ? p.in[I_CTX] : (const float*)(ws + WS_XC), p.out, (float*)(ws + WS_XC), (const float*)(ws + WS_MOD) + (size_t)l * 17 * 6144, hf};
                pg8::gemm_phase<EpiOut, RectOrder>((PG8_LAS unsigned char*)lds, g, S, E, nullptr);
                if (l == 0 && hf == 1) { const int skip = G > 64 ? 32 : 0; __syncthreads(); if (bid >= skip) cvt_fill(p, lds, CVT_Q3, CVT_Q4, bid - skip, G - skip); }
            }
#endif
            if (hf == 1) SEAM(hb + 5);
        }
#if !defined(ONLY) || ONLY == 8
        if (IN(base + 13)) { PHASE_P(); phase_norm2_router(p, l, lds); if (l == 1) cvt_fill(p, lds, CVT_Q4, 2 * CVT_TILES, bid, G); }
#endif
        SEAM(base + 13);
#if !defined(ONLY) || ONLY == 9
        if (IN(base + 14)) { PHASE_P(); phase_dispatch(p, l, lds); }
#endif
        SEAM(base + 14);
#if !defined(ONLY) || ONLY == 10
        if (IN(base + 15)) {
            PHASE_P(); unsigned char* ws = p.ws;
            LAS int* seg = (LAS int*)(lds + 131072); LAS int* tile_e = seg + 128;
            const int nt = moe_tile_table(p, l, seg, tile_e);
            pg8::Gemm g{(const bf16_t*)(ws + WS_H8), (const bf16_t*)(ws + WS_WTGU + (size_t)l * 32 * 1024 * 1024), SLOTS, 32 * 1024, 512};
            MoeOrder S; S.init(tile_e, nt, G, bid);
            { LAS int* srcl = (LAS int*)(lds + 131072 + 2048); const int* SRC = (const int*)(ws + WS_SRC);
              for (int i = 0; i < 6; ++i) { int pm, pn; S.unit_of(i, pm, pn); for (int r = opaque_tid(); r < 256; r += NTHR) srcl[i * 256 + r] = pm < nt ? SRC[pm * 256 + r] : 0; }
              S.srcl = srcl; }
            __syncthreads(); EpiGU E{ws + WS_P + P_ACT};
            pg8::gemm_phase<EpiGU, MoeOrder, false, true, true>((PG8_LAS unsigned char*)lds, g, S, E, nullptr);
        }
#endif
        SEAM(base + 15);
#if !defined(ONLY) || ONLY == 11
        if (IN(base + 16)) {
            PHASE_P(); unsigned char* ws = p.ws;
            LAS int* seg = (LAS int*)(lds + 131072); LAS int* tile_e = seg + 128;
            const int nt = moe_tile_table(p, l, seg, tile_e);
            pg8::Gemm g{pbuf(p, P_ACT), (const bf16_t*)(ws + WS_WTD + (size_t)l * 32 * 1024 * 512), SLOTS, 32 * 1024, 256};
            MoeOrder S; S.init(tile_e, nt, G, bid); __syncthreads(); EpiDown E{pbuf(p, P_YS)};
            pg8::gemm_phase<EpiDown, MoeOrder, false, true>((PG8_LAS unsigned char*)lds, g, S, E, nullptr);
        }
#endif
        SEAM(base + 16);
    }
#if !defined(ONLY) || ONLY == 12
    if (IN(35)) { PHASE_P(); phase_final(p); }
#endif
#ifdef PROBE
    if (bid == 0 && tid == 0) {
        asm volatile("s_waitcnt vmcnt(0)" ::: "memory");
        const unsigned long long tend = __builtin_amdgcn_s_memrealtime();
        volatile unsigned long long* st = (volatile unsigned long long*)(opaque_kp()->ws + WS_CTL) + 30000;
        unsigned long long ta = 0, tb = 0;
        for (int k = 0; k < N_PHASES; ++k) { const unsigned long long t0 = st[k], t1 = (k == N_PHASES - 1) ? tend : st[k + 1]; const unsigned long long d = t1 - t0;
            if ((PROBE_A >> k) & 1ull) ta += d; if ((PROBE_B >> k) & 1ull) tb += st[100 + k]; }
        const unsigned long long spin = ((ta + tb) / 1000ull) * 100000ull;
        while (__builtin_amdgcn_s_memrealtime() - tend < spin) __builtin_amdgcn_s_sleep(32);
    }
#endif
#undef IN
#undef SEAM
}

#ifndef MK_CUTS
#define MK_CUTS 0
#endif
extern "C" void kernel_launch(void* const* d_in, const int* in_sizes, int n_in, void* d_out, int out_size, void* d_ws, size_t ws_size, hipStream_t stream) {
    static int grid = 0;
    if (grid == 0) {
        if (n_in != 31 || in_sizes[0] != NBATCH * SEQ * DM || out_size != NBATCH * SEQ * DM || ws_size < WS_END) {
            fprintf(stderr, "kernel_launch: unexpected shapes or workspace (n_in %d, ws %zu, need %zu); nothing launched\n", n_in, ws_size, (size_t)WS_END); grid = -1; return; }
        int dev = 0, cus = 0, per_cu = 0;
        if (hipGetDevice(&dev) != hipSuccess || hipDeviceGetAttribute(&cus, hipDeviceAttributeMultiprocessorCount, dev) != hipSuccess) { grid = -1; return; }
        if (hipFuncSetAttribute((const void*)mk_fwd, hipFuncAttributeMaxDynamicSharedMemorySize, LDS_BYTES) != hipSuccess) { fprintf(stderr, "kernel_launch: hipFuncSetAttribute failed\n"); grid = -1; return; }
        if (hipOccupancyMaxActiveBlocksPerMultiprocessor(&per_cu, (const void*)mk_fwd, NTHR, LDS_BYTES) != hipSuccess || per_cu < 1) { fprintf(stderr, "kernel_launch: occupancy query says %d\n", per_cu); }
        (void)hipGetLastError();
        grid = cus;
    }
    if (grid < 0) return;
    if (hipMemsetAsync((char*)d_ws + WS_CTL, 0, CTL_BYTES, stream) != hipSuccess) return;
    Params p{};
    for (int i = 0; i < 31; ++i) p.in[i] = (const float*)d_in[i];
    p.out = (float*)d_out; p.ws = (unsigned char*)d_ws;
#if MK_CUTS == 0
    p.ph_lo = 0; p.ph_hi = N_PHASES;
    hipLaunchKernelGGL(mk_fwd, dim3(grid), dim3(NTHR), LDS_BYTES, stream, p, 0);
#else
    for (int k = 0; k < N_PHASES; ++k) {
#ifdef EXP_NOMOE
        if ((k >= 14 && k <= 17) || (k >= 31 && k <= 34)) continue;
#endif
#ifdef EXP_NOEXPERT
        if (k == 16 || k == 17 || k == 33 || k == 34) continue;
#endif
#ifdef EXP_NOGU
        if (k == 16 || k == 33) continue;
#endif
#ifdef EXP_NOMIX
        if ((k >= 2 && k <= 13) || (k >= 19 && k <= 30)) continue;
#endif
#ifdef EXP_ZEROXB
        if (k == 15 || k == 32) { hipMemsetAsync((char*)d_ws + WS_P + P_XB, 0, P_MOE_END, stream); hipMemsetAsync((char*)d_ws + WS_WTS, 0, (size_t)SLOTS * 4, stream); }
#endif
        p.ph_lo = k; p.ph_hi = k + 1; hipLaunchKernelGGL(mk_fwd, dim3(grid), dim3(NTHR), LDS_BYTES, stream, p, 0); }
#endif
}
```

```cpp
#include <hip/hip_runtime.h>
#include <cstdio>
#include <cstdint>

#define LAS __attribute__((address_space(3)))
typedef unsigned short bf16_t;
typedef short bf16x8 __attribute__((ext_vector_type(8)));
typedef short s16x4 __attribute__((ext_vector_type(4)));
typedef float f32x2 __attribute__((ext_vector_type(2)));
typedef float f32x4 __attribute__((ext_vector_type(4)));
typedef float f32x16 __attribute__((ext_vector_type(16)));
typedef unsigned u32x2 __attribute__((ext_vector_type(2)));
typedef unsigned u32x4 __attribute__((ext_vector_type(4)));

constexpr int DM = 1024, NBATCH = 16, SEQ = 2048, CTXL = 256, NCOL = 6656;
constexpr int HBAT = 8;
constexpr int MH = HBAT * (SEQ + CTXL);
constexpr int MTOT = 2 * MH;
constexpr int CTXROWS = HBAT * CTXL;
constexpr int NJ = 18;
constexpr int NEXP = 32, DEXP = 512;
constexpr int SLOTS = 81920;
constexpr float EPS = 1e-6f;
constexpr float LOG2E = 1.4426950408889634f;
constexpr float QSCALE = 0.125f * LOG2E;
constexpr int NTHR = 512;
constexpr int LDS_BYTES = 155648;
constexpr int TLD = 136;
constexpr int TILE_B = 128 * TLD * 2;

constexpr size_t AL(size_t x) { return (x + 255) / 256 * 256; }
constexpr size_t WS_CTL   = 0;
constexpr size_t CTL_BYTES = 262144;
constexpr size_t WS_MOD   = WS_CTL + CTL_BYTES;
constexpr size_t WS_WFOLD = WS_MOD + AL((size_t)2 * 17 * 6144 * 4);
constexpr size_t WS_ROPE  = WS_WFOLD + AL((size_t)2 * 16 * 1024 * 4);
constexpr size_t WS_LAM   = WS_ROPE + AL((size_t)2 * 64 * 16 * 4);
constexpr size_t WS_WRT   = WS_LAM + 256;
constexpr size_t WS_WTIN  = WS_WRT + AL((size_t)2 * 2 * 48 * 1024 * 2);
constexpr size_t WS_WTBR  = WS_WTIN + AL((size_t)2 * NCOL * 1024 * 2);
constexpr size_t WS_WTO   = WS_WTBR + AL((size_t)2 * 3072 * 512 * 2);
constexpr size_t WS_WTQKV = WS_WTO + AL((size_t)2 * 1024 * 1024 * 2);
constexpr size_t WS_WSB   = WS_WTQKV + AL((size_t)2 * 12 * 16384 * 2);
constexpr size_t WS_WTGU  = WS_WSB + AL((size_t)2 * 4 * 16384 * 2);
constexpr size_t WS_WTD   = WS_WTGU + AL((size_t)32 * 1024 * 1024 * 2);
constexpr size_t WS_XC    = WS_WTD + AL((size_t)32 * 1024 * 512 * 2);
constexpr size_t WS_H     = WS_XC + AL((size_t)4096 * 1024 * 4);
constexpr size_t WS_H8    = WS_H + AL((size_t)MTOT * 1024 * 2);
constexpr size_t WS_WTIN8 = WS_H8 + AL((size_t)MTOT * 1024);
constexpr size_t WS_EID   = WS_WTIN8 + AL((size_t)2 * 3072 * 1024);
constexpr size_t WS_WTK   = WS_EID + AL((size_t)MTOT * 8);
constexpr size_t WS_POS   = WS_WTK + AL((size_t)MTOT * 8);
constexpr size_t WS_WTS   = WS_POS + AL((size_t)MTOT * 8);
constexpr size_t WS_SRC   = WS_WTS + AL((size_t)SLOTS * 4);
constexpr size_t WS_P     = WS_SRC + AL((size_t)SLOTS * 4);
constexpr size_t S1B      = (size_t)MH * 512 * 2;
constexpr size_t P_KB = 0, P_VB = S1B, P_XMB = 2 * S1B, P_QB = 3 * S1B, P_UB = 4 * S1B, P_ZB = 5 * S1B, P_VGB = 6 * S1B;
constexpr size_t P_GB   = 7 * S1B;
constexpr size_t P_MQ   = P_GB + (size_t)3 * MH * 1024;
constexpr size_t P_MK   = P_MQ + S1B, P_MVT = P_MK + S1B, P_XCV = P_MVT + S1B;
constexpr size_t P_GATES = P_XCV + S1B;
constexpr size_t P_CLOC = P_GATES + AL((size_t)MH * 16 * 4);
constexpr size_t P_NLOC = P_CLOC + (size_t)64 * NJ * 16384 * 2;
constexpr size_t P_MST  = P_NLOC + AL((size_t)64 * NJ * 128 * 4);
constexpr size_t P_END  = P_MST + AL((size_t)64 * NJ * 4 * 4);
constexpr size_t P_XB   = 0;
constexpr size_t P_ACT  = (size_t)SLOTS * 1024;
constexpr size_t P_YS   = P_ACT + (size_t)SLOTS * 512;
constexpr size_t P_MOE_END = P_YS + (size_t)SLOTS * 1024 * 2;
constexpr float WSCALE8 = 635.0f, HSCALE8 = 10.5f, ASCALE8 = 16.0f;
constexpr size_t WS_END = WS_P + (P_END > P_MOE_END ? P_END : P_MOE_END);
constexpr int CW_EXPCNT = 0;
constexpr int CW_HIST = 32768;
constexpr int CW_BAR = 1024;

__device__ __forceinline__ unsigned cvtpk(float lo, float hi) { unsigned r; asm volatile("v_cvt_pk_bf16_f32 %0, %1, %2" : "=v"(r) : "v"(lo), "v"(hi)); return r; }
__device__ __forceinline__ float bf_lo(unsigned w) { return __uint_as_float(w << 16); }
__device__ __forceinline__ float bf_hi(unsigned w) { return __uint_as_float(w & 0xffff0000u); }
__device__ __forceinline__ float bf2f(bf16_t b) { return __uint_as_float(((unsigned)b) << 16); }
__device__ __forceinline__ bf16_t f2bf(float f) { unsigned u = __float_as_uint(f); u += 0x7FFFu + ((u >> 16) & 1u); return (bf16_t)(u >> 16); }
__device__ __forceinline__ float sigmoid_f(float x) { return __builtin_amdgcn_rcpf(1.0f + __builtin_amdgcn_exp2f(-x * LOG2E)); }
__device__ __forceinline__ float gelu_tanh_f(float x) { const float u = 0.7978845608028654f * (x + 0.044715f * x * x * x); return x * sigmoid_f(2.0f * u); }
__device__ __forceinline__ float silu_f(float x) { return x * sigmoid_f(x); }
__device__ __forceinline__ float logsigmoid_f(float x) { return fminf(x, 0.f) - 0.6931471805599453f * __builtin_amdgcn_logf(1.0f + __builtin_amdgcn_exp2f(-fabsf(x) * LOG2E)); }
__device__ __forceinline__ int crow(int r, int hi) { return (r & 3) + 8 * (r >> 2) + 4 * hi; }
__device__ __forceinline__ f32x16 mfma32(bf16x8 a, bf16x8 b, f32x16 c) { return __builtin_amdgcn_mfma_f32_32x32x16_bf16(a, b, c, 0, 0, 0); }
__device__ __forceinline__ float wave_sum(float v) { for (int o = 32; o >= 1; o >>= 1) v += __shfl_xor(v, o); return v; }
template <int CTRL, int ROWMASK> __device__ __forceinline__ float dpp_add(float v) {
    return v + __builtin_bit_cast(float, __builtin_amdgcn_update_dpp(0, __builtin_bit_cast(int, v), CTRL, ROWMASK, 0xf, true)); }
__device__ __forceinline__ float wave_sum63(float v) {
    v = dpp_add<0x111, 0xf>(v); v = dpp_add<0x112, 0xf>(v); v = dpp_add<0x114, 0xf>(v); v = dpp_add<0x118, 0xf>(v);
    v = dpp_add<0x142, 0xa>(v);
    v = dpp_add<0x143, 0xc>(v);
    return v; }
__device__ __forceinline__ float half_sum31(float v) {
    v = dpp_add<0x111, 0xf>(v); v = dpp_add<0x112, 0xf>(v); v = dpp_add<0x114, 0xf>(v); v = dpp_add<0x118, 0xf>(v);
    v = dpp_add<0x142, 0xa>(v); return v; }
__device__ __forceinline__ float wave_max(float v) { for (int o = 32; o >= 1; o >>= 1) v = fmaxf(v, __shfl_xor(v, o)); return v; }

__device__ __forceinline__ void unpack8(const u32x4 w, float (&o)[8]) { o[0] = bf_lo(w.x); o[1] = bf_hi(w.x); o[2] = bf_lo(w.y); o[3] = bf_hi(w.y); o[4] = bf_lo(w.z); o[5] = bf_hi(w.z); o[6] = bf_lo(w.w); o[7] = bf_hi(w.w); }
__device__ __forceinline__ u32x4 pack8(const float (&v)[8]) { u32x4 w; w.x = cvtpk(v[0], v[1]); w.y = cvtpk(v[2], v[3]); w.z = cvtpk(v[4], v[5]); w.w = cvtpk(v[6], v[7]); return w; }
__device__ __forceinline__ int ld_i32_dev(const int* p) { return __hip_atomic_load(p, __ATOMIC_RELAXED, __HIP_MEMORY_SCOPE_AGENT); }
__device__ __forceinline__ float ld_f32_dev(const float* p) { return __hip_atomic_load(p, __ATOMIC_RELAXED, __HIP_MEMORY_SCOPE_AGENT); }
__device__ __forceinline__ unsigned q8(float x) { return (unsigned)(int)fminf(fmaxf(rintf(x), -127.0f), 127.0f) & 0xffu; }
__device__ __forceinline__ unsigned pk4_fp8(float a, float b, float c, float d) { return q8(a) | (q8(b) << 8) | (q8(c) << 16) | (q8(d) << 24); }
#define LBAR() do { asm volatile("s_waitcnt lgkmcnt(0)" ::: "memory"); __builtin_amdgcn_s_barrier(); asm volatile("" ::: "memory"); } while (0)
__device__ __forceinline__ int opaque_tid() { int t = threadIdx.x; asm volatile("" : "+v"(t)); return t; }
#ifdef PROBE
__device__ __forceinline__ unsigned long long* probe_epi_counter() {
    unsigned char* ws = *(unsigned char* const __attribute__((address_space(4)))*)((const __attribute__((address_space(4))) char*)__builtin_amdgcn_kernarg_segment_ptr() + 256);
    const int ph = *(volatile LAS int*)(uintptr_t)(LDS_BYTES - 32);
    return (unsigned long long*)ws + 30100 + ph; }
#endif
#ifdef PROBE
#define PSEC_BEGIN() unsigned pt_ = 0; if (PROBE_SEC == 1) pt_ = (unsigned)__builtin_amdgcn_s_memrealtime()
#define PSEC_BEGINN(n) unsigned pt_ = 0; if (PROBE_SEC == (n)) pt_ = (unsigned)__builtin_amdgcn_s_memrealtime()
#define PSEC_BEGIN6() unsigned pt_ = 0; if (PROBE_SEC == 6) pt_ = (unsigned)__builtin_amdgcn_s_memrealtime()
#define PSEC_BEGIN8() unsigned pt_ = 0; if (PROBE_SEC == 8) pt_ = (unsigned)__builtin_amdgcn_s_memrealtime()
#define PSEC(id) do { if (PROBE_SEC == (id)) { const unsigned pn_ = (unsigned)__builtin_amdgcn_s_memrealtime(); if (blockIdx.x == PROBE_BLK && tid == 0) *probe_epi_counter() += (unsigned long long)(pn_ - pt_); } if (PROBE_SEC == (id) + 1) pt_ = (unsigned)__builtin_amdgcn_s_memrealtime(); } while (0)
#else
#define PSEC_BEGIN() do { } while (0)
#define PSEC_BEGIN6() do { } while (0)
#define PSEC_BEGINN(n) do { } while (0)
#define PSEC_BEGIN8() do { } while (0)
#define PSEC(id) do { } while (0)
#endif
struct Params {
    const float* in[31];
    float* out;
    unsigned char* ws;
    int ph_lo, ph_hi;
};
enum { I_X = 0, I_C, I_CTX, I_CCTX, I_WMOD, I_BMOD, I_GN1, I_GN2, I_WIN, I_DLAM, I_GSUBLN, I_WGS, I_BGS, I_GGV, I_WCONV, I_BCONV, I_WQKV, I_WIF, I_BIF,
       I_GMN, I_SKIP, I_WBR, I_WOUT, I_WRG, I_BRG, I_WRE, I_BRE, I_WEG, I_WEU, I_WED, I_GFIN };

struct RowInfo { int hf, r, isctx, b, t; };
__device__ __forceinline__ RowInfo row_info(int R) {
    RowInfo q; q.hf = R >= MH ? 1 : 0; q.r = R - q.hf * MH;
    if (q.r < CTXROWS) { q.isctx = 1; q.b = q.hf * HBAT + (q.r >> 8); q.t = q.r & 255; }
    else { q.isctx = 0; const int s = q.r - CTXROWS; q.b = q.hf * HBAT + (s >> 11); q.t = s & 2047; }
    return q;
}
#define XB_TMO      128
#define XB_XCNT(j)  (256  + 64 * (j))
#define XB_XSUB(j)  (1280 + 64 * (j))
#define XB_XGEN(j)  (2304 + 64 * (j))
#define XB_TOP      3328
#define XB_TOPGEN   3392
#define XCD_BAR_WORDS 3456
#define XB_SPIN_CAP (1u << 18)

__device__ __forceinline__ unsigned xb_ld(unsigned* p)              { return __hip_atomic_load(p, __ATOMIC_RELAXED, __HIP_MEMORY_SCOPE_AGENT); }
__device__ __forceinline__ unsigned xb_add(unsigned* p, unsigned v) { return __hip_atomic_fetch_add(p, v, __ATOMIC_RELAXED, __HIP_MEMORY_SCOPE_AGENT); }
__device__ __forceinline__ unsigned xb_xcc_id() { return (unsigned)__builtin_amdgcn_s_getreg((3 << 11) | 20) & 0xFu; }
#define XB_SPIN(cond, bar) do { unsigned _sp = 0; while (cond) { __builtin_amdgcn_s_sleep(1); \
    if ((++_sp & 255u) == 0u) { if (xb_ld(&(bar)[XB_TMO])) break; if (_sp > XB_SPIN_CAP) { atomicAdd(&(bar)[XB_TMO], 1u); break; } } } } while (0)

struct XcdBarrier {
    unsigned* bar; unsigned x;
    volatile LAS unsigned* st;
};

__device__ __forceinline__ XcdBarrier xcd_barrier_post(unsigned* bar, volatile LAS unsigned* st) {
    XcdBarrier b; b.bar = bar; b.x = xb_xcc_id(); b.st = st;
    if (threadIdx.x == 0) (void)xb_add(&bar[XB_XCNT(b.x)], 1u);
    return b;
}
__device__ __forceinline__ void xcd_barrier_complete(unsigned* bar, unsigned x, unsigned& nloc, unsigned& nx) {
    const unsigned G = gridDim.x * gridDim.y * gridDim.z;
    unsigned sum, cnt, mine, sp = 0u;
    for (;;) {
        sum = 0u; cnt = 0u; mine = 0u;
#pragma unroll
        for (unsigned j = 0; j < 16; ++j) { const unsigned c = xb_ld(&bar[XB_XCNT(j)]); sum += c; cnt += (c > 0u) ? 1u : 0u; mine = (j == x) ? c : mine; }
        if (sum == G) break;
        __builtin_amdgcn_s_sleep(1);
        if ((++sp & 255u) == 0u) { if (xb_ld(&bar[XB_TMO])) break; if (sp > XB_SPIN_CAP) { atomicAdd(&bar[XB_TMO], 1u); break; } }
    }
    nloc = mine > 0u ? mine : 1u; nx = cnt > 0u ? cnt : 1u;
}

__device__ __forceinline__ void xcd_barrier(const XcdBarrier& b) {
    asm volatile("s_waitcnt vmcnt(0)" ::: "memory");
    __syncthreads();
    if (threadIdx.x == 0) {
        unsigned* bar = b.bar;
        __builtin_amdgcn_s_waitcnt(0);
        unsigned nloc = b.st[0], nx = b.st[1];
        if (nloc == 0u) { xcd_barrier_complete(bar, b.x, nloc, nx); b.st[0] = nloc; b.st[1] = nx; }
        const unsigned old = xb_add(&bar[XB_XSUB(b.x)], 1u);
        const unsigned gen = old / nloc;
        if (old + 1u == (gen + 1u) * nloc) {
            __builtin_amdgcn_fence(__ATOMIC_RELEASE, "agent");
            asm volatile("s_waitcnt vmcnt(0)" ::: "memory");
            const unsigned og = xb_add(&bar[XB_TOP], 1u);
            const unsigned tg = og / nx;
            if (og + 1u == (tg + 1u) * nx) xb_add(&bar[XB_TOPGEN], 1u);
            else XB_SPIN(xb_ld(&bar[XB_TOPGEN]) == tg, bar);
            __builtin_amdgcn_fence(__ATOMIC_ACQUIRE, "agent");
            xb_add(&bar[XB_XGEN(b.x)], 1u);
            asm volatile("s_waitcnt vmcnt(0)" ::: "memory");
        } else {
            XB_SPIN(xb_ld(&bar[XB_XGEN(b.x)]) == gen, bar);
            __builtin_amdgcn_fence(__ATOMIC_ACQUIRE, "agent");
            asm volatile("s_waitcnt vmcnt(0)" ::: "memory");
        }
    }
    __syncthreads();
}
namespace pg8 {
#define PG8_LAS __attribute__((address_space(3)))
typedef unsigned short bf16_t;
typedef short bf16x8 __attribute__((ext_vector_type(8)));
typedef float f32x4 __attribute__((ext_vector_type(4)));
typedef unsigned u32x4 __attribute__((ext_vector_type(4)));
constexpr int BM = 256, BK = 64, HALF = 128, HTB = HALF * BK * 2  , STAGE_BYTES = 8 * HTB, NXCD = 8, WGM = 8;

__host__ __device__ __forceinline__ int lds_byte(int r, int c) { const int st = (r >> 4) * 2 + (c >> 5), rr = r & 15, cc = c & 31, ob = rr * 64 + cc * 2; return st * 1024 + (ob ^ (((ob >> 9) & 1) << 5)); }
__host__ __device__ __forceinline__ void stage_rc(int b, int& R, int& C) { const int st = b / 1024, sb = b % 1024, swz = sb ^ (((sb >> 9) & 1) << 5); R = (st >> 1) * 16 + swz / 64; C = (st & 1) * 32 + (swz % 64) / 2; }
__host__ __device__ __forceinline__ int perm32(int rho) { const int n = rho >> 4, i = rho & 15; return 8 * (i >> 2) + 4 * n + (i & 3); }

struct Unit { int pm, pn; };
struct Gemm { const bf16_t* A; const bf16_t* Bt; int M, N, K; };

struct StaticOrder {
    int nM, nN, nwg, G, c;
    __host__ __device__ void init(int M, int N, int G_, int c_) { nM = M / BM; nN = N / BM; nwg = nM * nN; G = G_; c = c_; }
    __host__ __device__ bool next(int i, Unit& u) const {
        const long L = (long)i * G + c; if (L >= nwg) return false;
        int wgid = (int)L; { const int q = nwg / NXCD, r = nwg % NXCD, xcd = wgid % NXCD, off = wgid / NXCD; wgid = (xcd < r ? xcd * (q + 1) : r * (q + 1) + (xcd - r) * q) + off; }
        const int nig = WGM * nN, gid = wgid / nig, fm = gid * WGM, gsz = (nM - fm) < WGM ? (nM - fm) : WGM;
        u.pm = fm + ((wgid % nig) % gsz); u.pn = (wgid % nig) / gsz; return true;
    }
    __device__ __forceinline__ void a_ready(const Unit&) const {}
    __device__ __forceinline__ void done(const Unit&) const {}
};
__device__ __forceinline__ unsigned cvt_pk_bf16(float lo, float hi) { unsigned r; asm volatile("v_cvt_pk_bf16_f32 %0, %1, %2" : "=v"(r) : "v"(lo), "v"(hi)); return r; }
typedef float f32x2 __attribute__((ext_vector_type(2)));
__device__ __forceinline__ f32x2 gelu_pk(f32x2 v) {
    const f32x2 av = __builtin_elementwise_abs(v), d = av * 0.2316418882f + 1.0f;
    f32x2 t; t.x = __builtin_amdgcn_rcpf(d.x); t.y = __builtin_amdgcn_rcpf(d.y);
    f32x2 q = t * 0.5307027145f + (-0.7265760135f); q = q * t + 0.7107068705f; q = q * t + (-0.142248368f); q = q * t + 0.127414796f; q = q * t;
    const f32x2 s = (v * v) * (-0.72134752044f);
    f32x2 e; e.x = __builtin_amdgcn_exp2f(s.x); e.y = __builtin_amdgcn_exp2f(s.y);
    const f32x2 m = v * (q * e), r = v - m;
    f32x2 o; o.x = v.x < 0.f ? m.x : r.x; o.y = v.y < 0.f ? m.y : r.y; return o;
}

typedef int pg8_i32x4 __attribute__((ext_vector_type(4)));
template <bool F8> struct Frag { bf16x8 k[2]; };
template <class Epi, class Sched, bool STAMP = false, bool F8 = false, bool GA = false>
__device__ __forceinline__ void gemm_phase(PG8_LAS unsigned char* lds, const Gemm g, const Sched& S, const Epi& E, unsigned long long* stamps) {
    int tid_o = threadIdx.x; asm volatile("" : "+v"(tid_o));
    const int tid = tid_o, wid = __builtin_amdgcn_readfirstlane(tid >> 6), lane = tid & 63, wr = wid >> 2, wc = wid & 3, fr = lane & 15, fq = lane >> 4;
    const int K = g.K, nt = K / BK;
    int ts_lo = 0, ts_hi = 0, nts = 0; const unsigned long long rt_entry = STAMP ? (unsigned long long)wall_clock64() : 0ull;
#define PG8_STAMP() do { if (STAMP && wid == 0 && nts < 64) { const unsigned long long _c = (unsigned long long)clock64(); \
        ts_lo = (lane == nts) ? (int)(unsigned)_c : ts_lo; ts_hi = (lane == nts) ? (int)(unsigned)(_c >> 32) : ts_hi; ++nts; } } while (0)
    PG8_STAMP();
    unsigned voffA[2], voffB[2];
#pragma unroll
    for (int i = 0; i < 2; ++i) { int R, C; stage_rc(tid * 16 + i * 8192, R, C); const int Rb = Epi::PERM ? ((R & ~31) + perm32(R & 31)) : R;
        voffA[i] = (unsigned)(R * K + C) * 2u; voffB[i] = (unsigned)(Rb * K + C) * 2u; }
    const size_t pstep = (size_t)64 * K * 2;
    const size_t kstep = (size_t)(BK * 2);
    const size_t hstep = (size_t)HALF * K * 2;
    const size_t tstep = 2 * hstep;
    const unsigned ldsw = (unsigned)wid * 1024u;
    const int aoff = lds_byte(wr * 64 + fr, fq * 8), boff = lds_byte(wc * 32 + fr, fq * 8);
#define PG8_SA(b, h) (((b) * 2 + (h)) * HTB)
#define PG8_SB(b, h) ((4 + (b) * 2 + (h)) * HTB)
#define PG8_STAGE(bufoff, gbase, voff) do { const char* _b0 = (const char*)(gbase); const char* _b1 = _b0 + pstep; asm volatile("" : "+s"(_b0), "+s"(_b1)); \
        __builtin_amdgcn_global_load_lds((const unsigned*)(_b0 + (voff)[0]), (PG8_LAS unsigned*)(lds + (bufoff) + ldsw), 16, 0, 0); \
        __builtin_amdgcn_global_load_lds((const unsigned*)(_b1 + (voff)[0]), (PG8_LAS unsigned*)(lds + (bufoff) + ldsw + 8192), 16, 0, 0); } while (0)
    unsigned gC[4] = {0u, 0u, 0u, 0u}, gN[4] = {0u, 0u, 0u, 0u}; int gR = 0, gCol = 0; stage_rc(tid * 16, gR, gCol);
#define PG8_GOFF(dst, ui_) do { _Pragma("unroll") for (int _j = 0; _j < 4; ++_j) dst[_j] = (unsigned)S.src_row((ui_), gR + 64 * _j) * (unsigned)(K * 2) + (unsigned)(gCol * 2); } while (0)
#define PG8_STAGE_G(bufoff, kptr, h, nx) do { const char* _b = (const char*)(kptr); asm volatile("" : "+s"(_b)); const unsigned _o0 = (nx) ? gN[2 * (h)] : gC[2 * (h)], _o1 = (nx) ? gN[2 * (h) + 1] : gC[2 * (h) + 1]; \
        __builtin_amdgcn_global_load_lds((const unsigned*)(_b + _o0), (PG8_LAS unsigned*)(lds + (bufoff) + ldsw), 16, 0, 0); \
        __builtin_amdgcn_global_load_lds((const unsigned*)(_b + _o1), (PG8_LAS unsigned*)(lds + (bufoff) + ldsw + 8192), 16, 0, 0); } while (0)
#define PG8_LDF(dstf, addr) do { (dstf).k[0] = *(const PG8_LAS bf16x8*)(addr); (dstf).k[1] = *(const PG8_LAS bf16x8*)((addr) + 1024); } while (0)
#define PG8_LDA(dst, b, h) do { _Pragma("unroll") for (int m = 0; m < 4; ++m) PG8_LDF(dst[m], lds + PG8_SA(b, h) + aoff + m * 2048); } while (0)
#define PG8_LDB(dst, b, h) do { _Pragma("unroll") for (int n = 0; n < 2; ++n) PG8_LDF(dst[n], lds + PG8_SB(b, h) + boff + n * 2048); } while (0)
#define PG8_MMA(ai, bj, At, Bt) do { __builtin_amdgcn_s_setprio(1); _Pragma("unroll") for (int m = 0; m < 4; ++m) _Pragma("unroll") for (int n = 0; n < 2; ++n) _Pragma("unroll") for (int k = 0; k < 2; ++k) { \
        if constexpr (F8) acc[ai][bj][m][n] = __builtin_bit_cast(f32x4, __builtin_amdgcn_mfma_i32_16x16x64_i8(__builtin_bit_cast(pg8_i32x4, Bt[n].k[k]), __builtin_bit_cast(pg8_i32x4, At[m].k[k]), __builtin_bit_cast(pg8_i32x4, acc[ai][bj][m][n]), 0, 0, 0)); \
        else acc[ai][bj][m][n] = __builtin_amdgcn_mfma_f32_16x16x32_bf16(Bt[n].k[k], At[m].k[k], acc[ai][bj][m][n], 0, 0, 0); } \
        __builtin_amdgcn_s_setprio(0); } while (0)
#define PG8_WAIT_V(n) asm volatile("s_waitcnt vmcnt(" #n ")" ::: "memory")
#define PG8_WAIT_L(n) asm volatile("s_waitcnt lgkmcnt(" #n ")" ::: "memory")
#define PG8_BAR __builtin_amdgcn_s_barrier()
#define PG8_SCHED __builtin_amdgcn_sched_barrier(0)
    Unit cur, nxt; int ui = 0;
    if (!S.next(0, cur)) return;
    f32x4 acc[2][2][4][2];
#pragma unroll
    for (int a = 0; a < 2; ++a)
#pragma unroll
        for (int b = 0; b < 2; ++b)
#pragma unroll
            for (int m = 0; m < 4; ++m)
#pragma unroll
                for (int n = 0; n < 2; ++n) acc[a][b][m][n] = (f32x4){0.f, 0.f, 0.f, 0.f};
    Frag<F8> At[4], B0[2], B1[2];
    const char* cA = (const char*)g.A + (size_t)cur.pm * tstep; const char* cB = (const char*)g.Bt + (size_t)cur.pn * tstep;
    S.a_ready(cur);
    const char* A0 = (const char*)g.A; if constexpr (GA) PG8_GOFF(gC, 0);
    PG8_STAGE(PG8_SB(0, 0), cB, voffB); if constexpr (GA) PG8_STAGE_G(PG8_SA(0, 0), A0, 0, false); else PG8_STAGE(PG8_SA(0, 0), cA, voffA);
    PG8_STAGE(PG8_SB(0, 1), cB + hstep, voffB); if constexpr (GA) PG8_STAGE_G(PG8_SA(0, 1), A0, 1, false); else PG8_STAGE(PG8_SA(0, 1), cA + hstep, voffA);
    if (wr == 1) PG8_BAR;
    PG8_WAIT_V(4); PG8_BAR;
    PG8_STAGE(PG8_SB(1, 0), cB + kstep, voffB); if constexpr (GA) PG8_STAGE_G(PG8_SA(1, 0), A0 + kstep, 0, false); else PG8_STAGE(PG8_SA(1, 0), cA + kstep, voffA);
    PG8_STAGE(PG8_SB(1, 1), cB + hstep + kstep, voffB);
    PG8_WAIT_V(6); PG8_BAR;
    PG8_STAMP();
    for (;;) {
        const bool has_next = S.next(ui + 1, nxt);
        const char* nA = has_next ? (const char*)g.A + (size_t)nxt.pm * tstep : cA; const char* nB = has_next ? (const char*)g.Bt + (size_t)nxt.pn * tstep : cB;
        if constexpr (GA) { if (has_next) PG8_GOFF(gN, ui + 1); else { gN[0] = gC[0]; gN[1] = gC[1]; gN[2] = gC[2]; gN[3] = gC[3]; } }
        for (int t = 0; t < nt; t += 2) {
            const bool last = (t == nt - 2);
            const char* a1 = cA + (size_t)(t + 1) * kstep;
            const char* a2 = last ? nA : cA + (size_t)(t + 2) * kstep; const char* b2 = last ? nB : cB + (size_t)(t + 2) * kstep;
            const char* a3 = a2 + kstep; const char* b3 = b2 + kstep;
            const char* kA1 = A0 + (size_t)(t + 1) * kstep; const char* kA2 = last ? A0 : A0 + (size_t)(t + 2) * kstep; const char* kA3 = kA2 + kstep;
            if (last && has_next) S.a_ready(nxt);
            PG8_LDB(B0, 0, 0); PG8_SCHED; PG8_LDA(At, 0, 0); if constexpr (GA) PG8_STAGE_G(PG8_SA(1, 1), kA1, 1, false); else PG8_STAGE(PG8_SA(1, 1), a1 + hstep, voffA);
            PG8_WAIT_L(8); PG8_BAR; PG8_WAIT_L(0); PG8_MMA(0, 0, At, B0); PG8_BAR; PG8_SCHED;
            PG8_LDB(B1, 0, 1); PG8_STAGE(PG8_SB(0, 0), b2, voffB);
            PG8_BAR; PG8_WAIT_L(0); PG8_MMA(0, 1, At, B1); PG8_BAR;
            PG8_LDA(At, 0, 1); if constexpr (GA) PG8_STAGE_G(PG8_SA(0, 0), kA2, 0, last); else PG8_STAGE(PG8_SA(0, 0), a2, voffA);
            PG8_BAR; PG8_WAIT_L(0); PG8_MMA(1, 0, At, B0); PG8_BAR; PG8_SCHED;
            PG8_STAGE(PG8_SB(0, 1), b2 + hstep, voffB);
            PG8_WAIT_V(6); PG8_BAR; PG8_MMA(1, 1, At, B1); PG8_BAR;
            PG8_LDB(B0, 1, 0); PG8_SCHED; PG8_LDA(At, 1, 0); if constexpr (GA) PG8_STAGE_G(PG8_SA(0, 1), kA2, 1, last); else PG8_STAGE(PG8_SA(0, 1), a2 + hstep, voffA);
            PG8_WAIT_L(8); PG8_BAR; PG8_WAIT_L(0); PG8_MMA(0, 0, At, B0); PG8_BAR; PG8_SCHED;
            PG8_LDB(B1, 1, 1); PG8_STAGE(PG8_SB(1, 0), b3, voffB);
            PG8_BAR; PG8_WAIT_L(0); PG8_MMA(0, 1, At, B1); PG8_BAR;
            PG8_LDA(At, 1, 1); if constexpr (GA) PG8_STAGE_G(PG8_SA(1, 0), kA3, 0, last); else PG8_STAGE(PG8_SA(1, 0), a3, voffA);
            PG8_BAR; PG8_WAIT_L(0); PG8_MMA(1, 0, At, B0); PG8_BAR; PG8_SCHED;
            PG8_STAGE(PG8_SB(1, 1), b3 + hstep, voffB);
            PG8_WAIT_V(6); PG8_BAR; PG8_MMA(1, 1, At, B1); PG8_BAR;
        }
        PG8_STAMP();
#ifdef PROBE_EPI
        const unsigned long long te0_ = __builtin_amdgcn_s_memrealtime();
#endif
        const bool keep_acc = E(acc, cur, wr, wc, fr, fq); S.done(cur);
#ifdef PROBE_EPI
        if (blockIdx.x == 0 && tid == 0) { unsigned long long* ec_ = probe_epi_counter(); *ec_ += __builtin_amdgcn_s_memrealtime() - te0_; }
#endif
        PG8_STAMP();
        if (!has_next) break;
        if (!keep_acc)
#pragma unroll
        for (int a = 0; a < 2; ++a)
#pragma unroll
            for (int b = 0; b < 2; ++b)
#pragma unroll
                for (int m = 0; m < 4; ++m)
#pragma unroll
                    for (int n = 0; n < 2; ++n) acc[a][b][m][n] = (f32x4){0.f, 0.f, 0.f, 0.f};
        cur = nxt; cA = nA; cB = nB; ++ui;
        if constexpr (GA) { gC[0] = gN[0]; gC[1] = gN[1]; gC[2] = gN[2]; gC[3] = gN[3]; }
    }
    PG8_WAIT_V(0);
    if (wr == 0) PG8_BAR;
    PG8_BAR;
    PG8_STAMP();
    if (STAMP && wid == 0) { stamps[lane] = lane < nts ? (((unsigned long long)(unsigned)ts_hi << 32) | (unsigned)ts_lo) : 0ull;
        if (lane == 62) stamps[62] = rt_entry; if (lane == 63) stamps[63] = (unsigned long long)wall_clock64(); }
#undef PG8_STAMP
#undef PG8_SA
#undef PG8_SB
#undef PG8_STAGE
#undef PG8_STAGE_G
#undef PG8_GOFF
#undef PG8_LDA
#undef PG8_LDF
#undef PG8_LDB
#undef PG8_MMA
#undef PG8_WAIT_V
#undef PG8_WAIT_L
#undef PG8_BAR
#undef PG8_SCHED
}
}
struct RectOrder {
    pg8::StaticOrder so; int offA, nwgA, nMb, nNb, offB, nwgB, G, c;
    __device__ void init(int nMa, int nNa, int offA_, int nMb_, int nNb_, int offB_, int G_, int c_) {
        so.init(nMa * 256, nNa * 256, G_, c_); offA = offA_; nwgA = nMa * nNa; nMb = nMb_; nNb = nNb_; offB = offB_; nwgB = nMb_ * nNb_; G = G_; c = c_; }
    __device__ bool next(int i, pg8::Unit& u) const {
        const int L = i * G + c;
        if (L < nwgA) { so.next(i, u); u.pm += offA; return true; }
        const int Lb = L - nwgA; if (Lb >= nwgB) return false;
        u.pm = offB + Lb % nMb; u.pn = Lb / nMb; return true;
    }
    __device__ __forceinline__ void a_ready(const pg8::Unit&) const {}
    __device__ __forceinline__ void done(const pg8::Unit&) const {}
};
struct MergeOrder {
    pg8::StaticOrder so; int off, G, c;
    __device__ void init(int nM, int off_, int G_, int c_) { so.init(nM * 256, 1024, G_, c_); off = off_; G = G_; c = c_; }
    __device__ bool next(int i, pg8::Unit& u) const {
        const int ti = i / 3, br = i - ti * 3;
        if (!so.next(ti, u)) return false;
        u.pm += off + br * (MH / 256); u.pn += br * 4; return true;
    }
    __device__ __forceinline__ void a_ready(const pg8::Unit&) const {}
    __device__ __forceinline__ void done(const pg8::Unit&) const {}
};
struct MoeOrder {
    const LAS int* srcl = nullptr;
    __device__ __forceinline__ int src_row(int i, int r) const { return srcl[i * 256 + r]; }
    int e0, e1, e2, e3, e4, e5, ntiles, G, c;
    __device__ __forceinline__ void unit_of(int i, int& pm, int& pn) const {
        if ((G & 31) == 0) { const int j = c >> 3; pm = i * (G >> 2) + (c & 7) * (G >> 5) + (j >> 2); pn = j & 3; }
        else { const int L = i * G + c; pm = L >> 2; pn = L & 3; } }
    __device__ __forceinline__ int look(const LAS int* tile_e, int i) const { int pm, pn; unit_of(i, pm, pn); return __builtin_amdgcn_readfirstlane(pm < ntiles ? tile_e[pm] : 0); }
    __device__ __forceinline__ void init(const LAS int* tile_e, int nt, int G_, int c_) { ntiles = nt; G = G_; c = c_;
        e0 = look(tile_e, 0); e1 = look(tile_e, 1); e2 = look(tile_e, 2); e3 = look(tile_e, 3); e4 = look(tile_e, 4); e5 = look(tile_e, 5); }
    __device__ __forceinline__ bool next(int i, pg8::Unit& u) const {
        int pm, pn; unit_of(i, pm, pn); if (pm >= ntiles || i >= 6) return false;
        const int e = i == 0 ? e0 : i == 1 ? e1 : i == 2 ? e2 : i == 3 ? e3 : i == 4 ? e4 : e5;
        u.pm = pm; u.pn = e * 4 + pn; return true;
    }
    __device__ __forceinline__ void a_ready(const pg8::Unit&) const {}
    __device__ __forceinline__ void done(const pg8::Unit&) const {}
};

struct EpiIn {
    static constexpr bool PERM = true, AFTER_DRAIN = false;
    bf16_t* P; bf16_t* GB; const float* cosT; const float* sinT;
    __device__ __forceinline__ bool operator()(pg8::f32x4 (&acc)[2][2][4][2], const pg8::Unit& u, int wr, int wc, int fr, int fq) const {
        const int pn = u.pn, rbase = u.pm * 256 + wr * 64 + fr;
        int act, ld; bf16_t* dst; int cb; bool rope = false; float scl = 1.0f;
        if (pn < 14) {
            const int kind = pn >> 1;
            const int bufidx = kind == 5 ? 6 : (kind == 6 ? 5 : kind);
            dst = P + (size_t)bufidx * ((size_t)MH * 512); ld = 512; cb = (pn & 1) * 256 + wc * 32 + 8 * fq;
            act = (kind == 4 || kind == 5) ? 1 : (kind == 6 ? 2 : 0);
            rope = (kind == 0 || kind == 3) && (u.pm >= 8);
            if (kind == 3) scl = QSCALE;
        } else {
            const int gi = (pn - 14) >> 2, pnl = (pn - 14) & 3, tid = (wr * 4 + wc) * 64 + fq * 16 + fr;
            u32x2* gdst = (u32x2*)GB + ((size_t)((gi * (MH / 256) + u.pm) * 4 + pnl) * 16) * 512 + tid;
#pragma unroll
            for (int ai = 0; ai < 2; ++ai)
#pragma unroll
                for (int m = 0; m < 4; ++m)
#pragma unroll
                    for (int bj = 0; bj < 2; ++bj) { unsigned q[8];
#pragma unroll
                        for (int j = 0; j < 4; ++j) { q[j] = (unsigned)fminf(fmaxf(sigmoid_f(acc[ai][bj][m][0][j]) * 255.0f + 0.5f, 1.0f), 255.0f); q[4 + j] = (unsigned)fminf(fmaxf(sigmoid_f(acc[ai][bj][m][1][j]) * 255.0f + 0.5f, 1.0f), 255.0f); }
                        u32x2 w; w.x = q[0] | (q[1] << 8) | (q[2] << 16) | (q[3] << 24); w.y = q[4] | (q[5] << 8) | (q[6] << 16) | (q[7] << 24);
                        gdst[(size_t)((ai * 4 + m) * 2 + bj) * 512] = w; }
            return false;
        }
        pg8::f32x4 csv[8], snv[8];
#pragma unroll
        for (int i = 0; i < 8; ++i) { csv[i] = (pg8::f32x4){1.f, 1.f, 1.f, 1.f}; snv[i] = (pg8::f32x4){0.f, 0.f, 0.f, 0.f}; }
        if (rope) {
#pragma unroll
            for (int i = 0; i < 8; ++i) { const int row = rbase + (i >> 2) * 128 + (i & 3) * 16; const int t = (row - CTXROWS) & 2047; const int pos = (wc & 1) ? (t & 63) : (t >> 6);
                csv[i] = *(const pg8::f32x4*)(cosT + pos * 16 + 4 * fq); snv[i] = *(const pg8::f32x4*)(sinT + pos * 16 + 4 * fq); } }
#pragma unroll
        for (int ai = 0; ai < 2; ++ai)
#pragma unroll
            for (int m = 0; m < 4; ++m) {
                const int row = rbase + ai * 128 + m * 16;
                const pg8::f32x4 cs = csv[ai * 4 + m], sn = snv[ai * 4 + m];
                bf16_t* rowp = dst + (size_t)row * ld + cb;
#pragma unroll
                for (int bj = 0; bj < 2; ++bj) {
                    pg8::f32x4 v0 = acc[ai][bj][m][0], v1 = acc[ai][bj][m][1];
                    if (rope) { const pg8::f32x4 o0 = v0 * cs - v1 * sn, o1 = v0 * sn + v1 * cs; v0 = o0; v1 = o1; }
                    v0 *= scl; v1 *= scl;
                    if (act == 1) {
#pragma unroll
                        for (int j = 0; j < 4; ++j) { v0[j] = gelu_tanh_f(v0[j]); v1[j] = gelu_tanh_f(v1[j]); } }
                    else if (act == 2) {
#pragma unroll
                        for (int j = 0; j < 4; ++j) { v0[j] = fmaxf(sigmoid_f(v0[j]), 1e-6f); v1[j] = fmaxf(sigmoid_f(v1[j]), 1e-6f); } }
                    u32x4 w; w.x = cvtpk(v0[0], v0[1]); w.y = cvtpk(v0[2], v0[3]); w.z = cvtpk(v1[0], v1[1]); w.w = cvtpk(v1[2], v1[3]);
                    *(u32x4*)(rowp + bj * 128) = w;
                }
            }
        return false;
    }
};
struct EpiGate8 {
    static constexpr bool PERM = true, AFTER_DRAIN = false;
    bf16_t* GB;
    __device__ __forceinline__ bool operator()(pg8::f32x4 (&acc)[2][2][4][2], const pg8::Unit& u, int wr, int wc, int fr, int fq) const {
        const int gi = u.pn >> 2, pnl = u.pn & 3, tid = (wr * 4 + wc) * 64 + fq * 16 + fr; const float sc = 1.0f / (HSCALE8 * WSCALE8);
        u32x2* gdst = (u32x2*)GB + ((size_t)((gi * (MH / 256) + u.pm) * 4 + pnl) * 16) * 512 + tid;
#pragma unroll
        for (int ai = 0; ai < 2; ++ai)
#pragma unroll
            for (int m = 0; m < 4; ++m)
#pragma unroll
                for (int bj = 0; bj < 2; ++bj) { unsigned q[8];
#pragma unroll
                    for (int j = 0; j < 4; ++j) { q[j] = (unsigned)fminf(fmaxf(sigmoid_f((float)__float_as_int(acc[ai][bj][m][0][j]) * sc) * 255.0f + 0.5f, 1.0f), 255.0f);
                        q[4 + j] = (unsigned)fminf(fmaxf(sigmoid_f((float)__float_as_int(acc[ai][bj][m][1][j]) * sc) * 255.0f + 0.5f, 1.0f), 255.0f); }
                    u32x2 w; w.x = q[0] | (q[1] << 8) | (q[2] << 16) | (q[3] << 24); w.y = q[4] | (q[5] << 8) | (q[6] << 16) | (q[7] << 24);
                    gdst[(size_t)((ai * 4 + m) * 2 + bj) * 512] = w; }
        return false;
    }
};
struct EpiMerge {
    static constexpr bool PERM = true, AFTER_DRAIN = false;
    const bf16_t* GB; bf16_t* OUT;
    __device__ __forceinline__ bool operator()(pg8::f32x4 (&acc)[2][2][4][2], const pg8::Unit& u, int wr, int wc, int fr, int fq) const {
        const int br = u.pn >> 2, pn = u.pn & 3, pm = u.pm - br * (MH / 256), tid = (wr * 4 + wc) * 64 + fq * 16 + fr;
        const int rbase = pm * 256 + wr * 64 + fr, cb = pn * 256 + wc * 32 + 8 * fq;
        const u32x2* g0 = (const u32x2*)GB + ((size_t)((br * (MH / 256) + pm) * 4 + pn) * 16) * 512 + tid;
        const u32x2* g1 = g0 + (size_t)(MH / 256) * 4 * 16 * 512;
        u32x2 ga_[16], gb_[16];
#pragma unroll
        for (int s = 0; s < 16; ++s) { ga_[s] = g0[(size_t)s * 512]; gb_[s] = (br < 2) ? g1[(size_t)s * 512] : (u32x2){0x01010101u, 0x01010101u}; }
#pragma unroll
        for (int ai = 0; ai < 2; ++ai)
#pragma unroll
            for (int m = 0; m < 4; ++m) {
                const size_t off = (size_t)(rbase + ai * 128 + m * 16) * 1024 + cb;
#pragma unroll
                for (int bj = 0; bj < 2; ++bj) {
                    const int slot = (ai * 4 + m) * 2 + bj;
                    const u32x2 a = ga_[slot], b = gb_[slot];
                    float ga[8];
#pragma unroll
                    for (int j = 0; j < 4; ++j) { ga[j] = (float)((a.x >> (8 * j)) & 0xffu); ga[4 + j] = (float)((a.y >> (8 * j)) & 0xffu); }
                    if (br < 2) {
#pragma unroll
                        for (int j = 0; j < 4; ++j) { ga[j] *= __builtin_amdgcn_rcpf((float)((b.x >> (8 * j)) & 0xffu)); ga[4 + j] *= __builtin_amdgcn_rcpf((float)((b.y >> (8 * j)) & 0xffu)); }
                    } else {
#pragma unroll
                        for (int j = 0; j < 8; ++j) ga[j] *= (1.0f / 255.0f);
                    }
                    pg8::f32x4 v0 = acc[ai][bj][m][0], v1 = acc[ai][bj][m][1];
#pragma unroll
                    for (int j = 0; j < 4; ++j) { v0[j] *= ga[j]; v1[j] *= ga[4 + j]; }
                    if (br < 2) { acc[ai][bj][m][0] = v0; acc[ai][bj][m][1] = v1; }
                    else { u32x4 w; w.x = cvtpk(v0[0], v0[1]); w.y = cvtpk(v0[2], v0[3]); w.z = cvtpk(v1[0], v1[1]); w.w = cvtpk(v1[2], v1[3]);
                        *(u32x4*)(OUT + off + bj * 128) = w; }
                }
            }
        return br < 2;
    }
};
struct EpiOut {
    static constexpr bool PERM = false, AFTER_DRAIN = false;
    const float* xres_lat; const float* xres_ctx; float* xs_lat; float* xs_ctx; const float* mod; int hf;
    __device__ __forceinline__ bool operator()(pg8::f32x4 (&acc)[2][2][4][2], const pg8::Unit& u, int wr, int wc, int fr, int fq) const {
        const int pm = u.pm; const float* src; float* dst; int b;
        if (pm < 8) { b = 16; const size_t o = (size_t)((hf * HBAT + pm) * 256) * 1024; src = xres_ctx + o; dst = xs_ctx + o; }
        else { const int q = pm - 8; b = hf * HBAT + (q >> 3); const size_t o = ((size_t)b * 2048 + (size_t)(q & 7) * 256) * 1024; src = xres_lat + o; dst = xs_lat + o; }
        const int col0 = u.pn * 256 + wc * 32 + 4 * fq;
        const float* mrow = mod + (size_t)b * 6144 + 2 * 1024 + col0;
        pg8::f32x4 mv[2][2];
#pragma unroll
        for (int bj = 0; bj < 2; ++bj)
#pragma unroll
            for (int n = 0; n < 2; ++n) mv[bj][n] = *(const pg8::f32x4*)(mrow + bj * 128 + n * 16);
#pragma unroll
        for (int ai = 0; ai < 2; ++ai) {
            pg8::f32x4 xr[4][2][2];
#pragma unroll
            for (int m = 0; m < 4; ++m) { const size_t off = (size_t)(wr * 64 + fr + ai * 128 + m * 16) * 1024 + col0;
#pragma unroll
                for (int bj = 0; bj < 2; ++bj)
#pragma unroll
                    for (int n = 0; n < 2; ++n) xr[m][bj][n] = *(const pg8::f32x4*)(src + off + bj * 128 + n * 16); }
#pragma unroll
            for (int m = 0; m < 4; ++m) { const size_t off = (size_t)(wr * 64 + fr + ai * 128 + m * 16) * 1024 + col0;
#pragma unroll
                for (int bj = 0; bj < 2; ++bj)
#pragma unroll
                    for (int n = 0; n < 2; ++n) *(pg8::f32x4*)(dst + off + bj * 128 + n * 16) = xr[m][bj][n] + mv[bj][n] * acc[ai][bj][m][n]; }
            asm volatile("" ::: "memory");
        }
        return false;
    }
};
struct EpiGU {
    static constexpr bool PERM = true, AFTER_DRAIN = false;
    unsigned char* ACT;
    __device__ __forceinline__ bool operator()(pg8::f32x4 (&acc)[2][2][4][2], const pg8::Unit& u, int wr, int wc, int fr, int fq) const {
        const int rbase = u.pm * 256 + wr * 64 + fr, cb = (u.pn & 3) * 128 + wc * 32 + 8 * fq;
        const float sc = 1.0f / (HSCALE8 * WSCALE8);
#pragma unroll
        for (int ai = 0; ai < 2; ++ai)
#pragma unroll
            for (int m = 0; m < 4; ++m) {
                float o[8];
#pragma unroll
                for (int n = 0; n < 2; ++n)
#pragma unroll
                    for (int j = 0; j < 4; ++j) o[4 * n + j] = silu_f((float)__float_as_int(acc[ai][0][m][n][j]) * sc) * ((float)__float_as_int(acc[ai][1][m][n][j]) * (sc * ASCALE8));
                u32x2 w; w.x = pk4_fp8(o[0], o[1], o[2], o[3]); w.y = pk4_fp8(o[4], o[5], o[6], o[7]);
                *(u32x2*)(ACT + (size_t)(rbase + ai * 128 + m * 16) * 512 + cb) = w;
            }
        return false;
    }
};
struct EpiDown {
    static constexpr bool PERM = true, AFTER_DRAIN = false;
    bf16_t* YS;
    __device__ __forceinline__ bool operator()(pg8::f32x4 (&acc)[2][2][4][2], const pg8::Unit& u, int wr, int wc, int fr, int fq) const {
        const int rbase = u.pm * 256 + wr * 64 + fr, cb = (u.pn & 3) * 256 + wc * 32 + 8 * fq;
#pragma unroll
        for (int ai = 0; ai < 2; ++ai)
#pragma unroll
            for (int m = 0; m < 4; ++m) {
                const int row = rbase + ai * 128 + m * 16;
#pragma unroll
                for (int bj = 0; bj < 2; ++bj) { const float s8 = 1.0f / (ASCALE8 * WSCALE8); u32x4 w;
                    w.x = cvtpk((float)__float_as_int(acc[ai][bj][m][0][0]) * s8, (float)__float_as_int(acc[ai][bj][m][0][1]) * s8); w.y = cvtpk((float)__float_as_int(acc[ai][bj][m][0][2]) * s8, (float)__float_as_int(acc[ai][bj][m][0][3]) * s8);
                    w.z = cvtpk((float)__float_as_int(acc[ai][bj][m][1][0]) * s8, (float)__float_as_int(acc[ai][bj][m][1][1]) * s8); w.w = cvtpk((float)__float_as_int(acc[ai][bj][m][1][2]) * s8, (float)__float_as_int(acc[ai][bj][m][1][3]) * s8);
                    *(u32x4*)(YS + (size_t)row * 1024 + cb + bj * 128) = w; }
            }
        return false;
    }
};
template <class ColMap>
__device__ __forceinline__ void cvt_tile_T(const float* __restrict__ src, int ldsrc, bf16_t* __restrict__ dst, int K, int k0, int n0, const ColMap& cm, float scale, LAS float* tile) {
    const int tid = opaque_tid();
    {
        const int n = tid & 63, kb = tid >> 6; const int sc = cm(n0 + n);
#pragma unroll
        for (int i = 0; i < 8; ++i) { const int k = kb + 8 * i; tile[k * 65 + n] = src[(size_t)(k0 + k) * ldsrc + sc] * scale; }
    }
    __syncthreads();
    {
        const int kp = (tid & 31) * 2, nb = tid >> 5;
#pragma unroll
        for (int i = 0; i < 4; ++i) { const int n = nb + 16 * i; *(unsigned*)(dst + (size_t)(n0 + n) * K + k0 + kp) = cvtpk(tile[kp * 65 + n], tile[(kp + 1) * 65 + n]); }
    }
    __syncthreads();
}
struct CmIdent { int off; __device__ __forceinline__ int operator()(int n) const { return n + off; } };
struct CmWin {
    __device__ __forceinline__ int operator()(int n) const {
        if (n < 512 || (n >= 1536 && n < 2048)) { const int c = n & 31, f = c >> 3, j = c & 7; return (n & ~31) + ((j < 4) ? (4 * f + j) : (16 + 4 * f + (j - 4))); }
        return n; }
};
struct CmGU {
    __device__ __forceinline__ int operator()(int n) const { return 128 * (n >> 8) + (n & 127); }
};

template <int MODE, bool OUT8 = false>
__device__ __forceinline__ void cvt_tile_T256(const float* __restrict__ baseA, const float* __restrict__ baseB, int ldsrc, void* __restrict__ dstv, int K, int k0, int n0, float scale, LAS float* tile) {
    const int tid = opaque_tid();
    {
        const int n = tid & 255, kb = tid >> 8, ng = n0 + n;
        const float* sp = (MODE == 2 ? ((ng & 128) ? baseB : baseA) + 128 * (ng >> 8) + (ng & 127) : MODE == 1 ? baseA + CmWin{}(ng) : baseA + ng) + (size_t)(k0 + kb) * ldsrc;
        float v[32];
#pragma unroll
        for (int i = 0; i < 32; ++i) v[i] = sp[(size_t)(2 * i) * ldsrc];
#pragma unroll
        for (int i = 0; i < 32; ++i) tile[(kb + 2 * i) * 257 + n] = v[i] * scale;
    }
    __syncthreads();
    {
        const int n = tid >> 1, kh = (tid & 1) * 32;
        if constexpr (OUT8) { unsigned char* dp = (unsigned char*)dstv + (size_t)(n0 + n) * K + k0 + kh;
#pragma unroll
            for (int i = 0; i < 2; ++i) { float f[16];
#pragma unroll
                for (int j = 0; j < 16; ++j) f[j] = tile[(kh + 16 * i + j) * 257 + n];
                u32x4 w; w.x = pk4_fp8(f[0], f[1], f[2], f[3]); w.y = pk4_fp8(f[4], f[5], f[6], f[7]); w.z = pk4_fp8(f[8], f[9], f[10], f[11]); w.w = pk4_fp8(f[12], f[13], f[14], f[15]);
                *(u32x4*)(dp + 16 * i) = w; } }
        else { bf16_t* dp = (bf16_t*)dstv + (size_t)(n0 + n) * K + k0 + kh;
#pragma unroll
            for (int i = 0; i < 4; ++i) { float f[8];
#pragma unroll
                for (int j = 0; j < 8; ++j) f[j] = tile[(kh + 8 * i + j) * 257 + n];
                *(u32x4*)(dp + 8 * i) = pack8(f); } }
    }
    __syncthreads();
}

__device__ __forceinline__ void phase_prologue(const Params& p, LAS unsigned char* lds) {
    LAS float* tile = (LAS float*)lds;
    const int tid = opaque_tid(), G = gridDim.x, bid = blockIdx.x;
    unsigned char* ws = p.ws;
    for (int u = bid; u < 1248; u += G) {
        if (u < 448) { const int l = u / 224, r = u % 224, kt = r / 14, nt = r % 14;
            cvt_tile_T256<1>(p.in[I_WIN] + (size_t)l * 1024 * NCOL, nullptr, NCOL, (bf16_t*)(ws + WS_WTIN) + (size_t)l * NCOL * 1024, 1024, kt * 64, nt * 256, 1.0f, tile); }
        else if (u < 832) { const int v = u - 448, l = v / 192, r = v % 192, kt = r / 12, nt = r % 12;
            cvt_tile_T256<0, true>(p.in[I_WIN] + (size_t)l * 1024 * NCOL + 3584, nullptr, NCOL, ws + WS_WTIN8 + (size_t)l * 3072 * 1024, 1024, kt * 64, nt * 256, WSCALE8, tile); }
        else if (u < 1024) { const int v = u - 832, li = v / 32, r = v % 32, kt = r / 4, nt = r % 4;
            cvt_tile_T256<0>(p.in[I_WBR] + (size_t)li * 512 * 1024, nullptr, 1024, (bf16_t*)(ws + WS_WTBR) + (size_t)li * 1024 * 512, 512, kt * 64, nt * 256, 1.0f, tile); }
        else if (u < 1152) { const int v = u - 1024, l = v / 64, r = v % 64, kt = r / 4, nt = r % 4;
            cvt_tile_T256<0>(p.in[I_WOUT] + (size_t)l * 1024 * 1024, nullptr, 1024, (bf16_t*)(ws + WS_WTO) + (size_t)l * 1024 * 1024, 1024, kt * 64, nt * 256, 1.0f, tile); }
        else { const int v = u - 1152, m = v / 4, r = v % 4, kt = r >> 1, nt = r & 1;
            const int j = (m >> 2) % 3;
            cvt_tile_T(p.in[I_WQKV] + (size_t)m * 16384, 128, (bf16_t*)(ws + WS_WTQKV) + (size_t)m * 16384, 128, kt * 64, nt * 64, CmIdent{0}, j == 1 ? 0.08838834764831845f : 1.0f, tile); }
    }
    const int gt = bid * NTHR + tid, gn = G * NTHR;
    for (int i = gt; i < 2 * 4 * 16384; i += gn) ((bf16_t*)(ws + WS_WSB))[i] = f2bf(p.in[I_WGS][i]);
    for (int i = gt; i < 2 * 48 * 1024; i += gn) {
        const int l = i / (48 * 1024), r = i % (48 * 1024), n = r >> 10, k = r & 1023;
        float w = 0.f; if (n < 4) w = p.in[I_WRG][((size_t)l * 1024 + k) * 4 + n]; else if (n < 36) w = p.in[I_WRE][((size_t)l * 1024 + k) * 32 + (n - 4)];
        const bf16_t hi = f2bf(w); const bf16_t lo = f2bf(w - bf2f(hi));
        bf16_t* d = (bf16_t*)(ws + WS_WRT) + (size_t)l * 2 * 48 * 1024;
        d[r] = hi; d[48 * 1024 + r] = lo;
    }
    for (int i = gt; i < 1024; i += gn) { const int pos = i >> 4, f = i & 15; const float inv = powf(10000.0f, -(float)f / 16.0f); const float a = (float)pos * inv;
        ((float*)(ws + WS_ROPE))[i] = cosf(a); ((float*)(ws + WS_ROPE))[1024 + i] = sinf(a); }
    if (gt < 2) { const int l = gt; const float* lp = p.in[I_DLAM] + l * 256; float s01 = 0.f, s23 = 0.f;
        for (int i = 0; i < 64; ++i) { s01 += lp[i] * lp[64 + i]; s23 += lp[128 + i] * lp[192 + i]; }
        const float lam_init = 0.8f - 0.6f * expf(-0.3f * (float)l);
        float* o = (float*)(ws + WS_LAM) + l * 4; o[0] = expf(s01) - expf(s23) + lam_init; o[1] = 1.0f - lam_init; }
    for (int i = gt; i < 2 * 16 * 1024; i += gn) {
        const int l = i >> 14, gc = (i >> 10) & 15, ch = i & 1023, part = ch >> 9, c = ch & 511, h = c >> 7, d = c & 127;
        const float* wif = p.in[I_WIF] + (size_t)l * 1536 * 16; const float* wq = p.in[I_WQKV] + (size_t)l * 3 * 4 * 16384;
        float s = 0.f;
        if (part == 0) { const float* a = wq + ((size_t)(0 * 4 + h) * 128 + d) * 128; const float* b = wq + ((size_t)(1 * 4 + h) * 128 + d) * 128;
            for (int e = 0; e < 128; ++e) s += a[e] * wif[(size_t)(h * 128 + e) * 16 + gc] + b[e] * wif[(size_t)(512 + h * 128 + e) * 16 + gc]; }
        else { const float* a = wq + ((size_t)(2 * 4 + h) * 128 + d) * 128;
            for (int e = 0; e < 128; ++e) s += a[e] * wif[(size_t)(1024 + h * 128 + e) * 16 + gc]; }
        ((float*)(ws + WS_WFOLD))[i] = s;
    }
    {
        LAS float* sc = (LAS float*)lds;
        LAS float* red = sc + 17 * 1024;
        bool loaded = false;
        for (int u = bid; u < 192; u += G) {
            if (!loaded) { for (int i = tid; i < 17 * 1024; i += NTHR) { const float v = i < 16384 ? p.in[I_C][i] : p.in[I_CCTX][i - 16384]; sc[i] = silu_f(v); } loaded = true; }
            __syncthreads();
            const int l = u / 96, cbk = u % 96, col = cbk * 64 + (tid & 63), kq = tid >> 6;
            float a[17];
#pragma unroll
            for (int b = 0; b < 17; ++b) a[b] = 0.f;
            const float* wp = p.in[I_WMOD] + (size_t)l * 1024 * 6144 + col;
            for (int k0 = kq * 128; k0 < kq * 128 + 128; k0 += 8) { float w[8];
#pragma unroll
                for (int j = 0; j < 8; ++j) w[j] = wp[(size_t)(k0 + j) * 6144];
#pragma unroll
                for (int j = 0; j < 8; ++j)
#pragma unroll
                    for (int b = 0; b < 17; ++b) a[b] += sc[b * 1024 + k0 + j] * w[j]; }
#pragma unroll
            for (int b = 0; b < 17; ++b) red[(kq * 17 + b) * 64 + (tid & 63)] = a[b];
            __syncthreads();
            for (int i = tid; i < 17 * 64; i += NTHR) { const int b = i >> 6, c = i & 63; float s2 = 0.f;
#pragma unroll
                for (int k = 0; k < 8; ++k) s2 += red[(k * 17 + b) * 64 + c];
                ((float*)(ws + WS_MOD))[((size_t)l * 17 + b) * 6144 + cbk * 64 + c] = s2 + p.in[I_BMOD][(size_t)l * 6144 + cbk * 64 + c]; }
            __syncthreads();
        }
    }
}

constexpr int CVT_TILES = 3072;
struct CvtT { const float* a; const float* b; unsigned char* dst; int ldsrc, K, k0, n0; };
__device__ __forceinline__ CvtT cvt_decode(const Params& p, int t) {
    const int l = t >= CVT_TILES ? 1 : 0, u = t - l * CVT_TILES; CvtT c;
    if (u < 2048) { const int e = u >> 6, q = u & 63; const size_t eo = ((size_t)l * 32 + e) * 1024 * 512;
        c.a = p.in[I_WEG] + eo; c.b = p.in[I_WEU] + eo; c.dst = p.ws + WS_WTGU + ((size_t)l * 32 + e) * 1024 * 1024; c.ldsrc = 512; c.K = 1024; c.k0 = (q >> 2) * 64; c.n0 = (q & 3) * 256; }
    else { const int v = u - 2048, e = v >> 5, q = v & 31;
        c.a = p.in[I_WED] + ((size_t)l * 32 + e) * 512 * 1024; c.b = nullptr; c.dst = p.ws + WS_WTD + ((size_t)l * 32 + e) * 1024 * 512; c.ldsrc = 1024; c.K = 512; c.k0 = (q >> 2) * 64; c.n0 = (q & 3) * 256; }
    return c;
}
__device__ __forceinline__ void cvt_load(const CvtT& c, float (&v)[32]) {
    const int tid = opaque_tid(), n = tid & 255, kb = tid >> 8, ng = c.n0 + n;
    const float* sp = (c.b ? ((ng & 128) ? c.b : c.a) + 128 * (ng >> 8) + (ng & 127) : c.a + ng) + (size_t)(c.k0 + kb) * c.ldsrc;
#pragma unroll
    for (int i = 0; i < 32; ++i) v[i] = sp[(size_t)(2 * i) * c.ldsrc];
}
__device__ __forceinline__ void cvt_finish(const CvtT& c, const float (&v)[32], LAS float* tile) {
    const int tid = opaque_tid();
    { const int n = tid & 255, kb = tid >> 8;
#pragma unroll
      for (int i = 0; i < 32; ++i) tile[(kb + 2 * i) * 257 + n] = v[i] * WSCALE8; }
    __syncthreads();
    { const int n = tid >> 1, kh = (tid & 1) * 32; unsigned char* dp = c.dst + (size_t)(c.n0 + n) * c.K + c.k0 + kh;
#pragma unroll
      for (int i = 0; i < 2; ++i) { float f[16];
#pragma unroll
          for (int j = 0; j < 16; ++j) f[j] = tile[(kh + 16 * i + j) * 257 + n];
          u32x4 w; w.x = pk4_fp8(f[0], f[1], f[2], f[3]); w.y = pk4_fp8(f[4], f[5], f[6], f[7]); w.z = pk4_fp8(f[8], f[9], f[10], f[11]); w.w = pk4_fp8(f[12], f[13], f[14], f[15]);
          *(u32x4*)(dp + 16 * i) = w; } }
}
__device__ __forceinline__ void cvt_fill(const Params& p, LAS unsigned char* lds, int t0, int t1, int r, int nr) {
    LAS float* tA = (LAS float*)lds; LAS float* tB = tA + 64 * 257 + 64;
    asm volatile("" : "+s"(r));
    float va[32], vb[32]; int t = t0 + r;
    if (t < t1) cvt_load(cvt_decode(p, t), va);
    for (; t < t1; t += 2 * nr) {
        if (t + nr < t1) cvt_load(cvt_decode(p, t + nr), vb);
        cvt_finish(cvt_decode(p, t), va, tA);
        if (t + 2 * nr < t1) cvt_load(cvt_decode(p, t + 2 * nr), va);
        if (t + nr < t1) cvt_finish(cvt_decode(p, t + nr), vb, tB);
    }
    __syncthreads();
}
constexpr int CVT_Q0 = 0, CVT_Q1 = 2240, CVT_Q2 = 2240, CVT_Q3 = 4480, CVT_Q4 = 5600;

__device__ __forceinline__ void ld_row_f32(const float* src, int lane, float (&v)[16]) {
    const f32x4 a = *(const f32x4*)(src + 8 * lane), b = *(const f32x4*)(src + 8 * lane + 4), c = *(const f32x4*)(src + 512 + 8 * lane), d = *(const f32x4*)(src + 512 + 8 * lane + 4);
#pragma unroll
    for (int j = 0; j < 4; ++j) { v[j] = a[j]; v[4 + j] = b[j]; v[8 + j] = c[j]; v[12 + j] = d[j]; }
}
__device__ __forceinline__ void st_row_f32(float* dst, int lane, const float (&v)[16]) {
    *(f32x4*)(dst + 8 * lane) = (f32x4){v[0], v[1], v[2], v[3]}; *(f32x4*)(dst + 8 * lane + 4) = (f32x4){v[4], v[5], v[6], v[7]};
    *(f32x4*)(dst + 512 + 8 * lane) = (f32x4){v[8], v[9], v[10], v[11]}; *(f32x4*)(dst + 512 + 8 * lane + 4) = (f32x4){v[12], v[13], v[14], v[15]};
}
__device__ __forceinline__ void ld_row_bf16(const bf16_t* src, int lane, float (&v)[16]) {
    const u32x4 a = *(const u32x4*)(src + 8 * lane), b = *(const u32x4*)(src + 512 + 8 * lane);
    v[0] = bf_lo(a.x); v[1] = bf_hi(a.x); v[2] = bf_lo(a.y); v[3] = bf_hi(a.y); v[4] = bf_lo(a.z); v[5] = bf_hi(a.z); v[6] = bf_lo(a.w); v[7] = bf_hi(a.w);
    v[8] = bf_lo(b.x); v[9] = bf_hi(b.x); v[10] = bf_lo(b.y); v[11] = bf_hi(b.y); v[12] = bf_lo(b.z); v[13] = bf_hi(b.z); v[14] = bf_lo(b.w); v[15] = bf_hi(b.w);
}
__device__ __forceinline__ void st_row_bf16(bf16_t* dst, int lane, const float (&v)[16]) {
    u32x4 a, b; a.x = cvtpk(v[0], v[1]); a.y = cvtpk(v[2], v[3]); a.z = cvtpk(v[4], v[5]); a.w = cvtpk(v[6], v[7]);
    b.x = cvtpk(v[8], v[9]); b.y = cvtpk(v[10], v[11]); b.z = cvtpk(v[12], v[13]); b.w = cvtpk(v[14], v[15]);
    *(u32x4*)(dst + 8 * lane) = a; *(u32x4*)(dst + 512 + 8 * lane) = b;
}
template <int MODE>
__device__ __forceinline__ void load_resid4(const Params& p, int R0, const RowInfo& q, int lmoe, int lane, float (&v)[4][16]) {
    const float* src; float* dst;
    if (q.isctx) { const size_t o = ((size_t)q.b * 256 + q.t) * 1024; src = (MODE == 0 ? p.in[I_CTX] : (const float*)(p.ws + WS_XC)) + o; dst = (float*)(p.ws + WS_XC) + o; }
    else { const size_t o = ((size_t)q.b * 2048 + q.t) * 1024; src = (MODE == 0 ? p.in[I_X] : (const float*)p.out) + o; dst = p.out + o; }
#pragma unroll
    for (int i = 0; i < 4; ++i) ld_row_f32(src + (size_t)i * 1024, lane, v[i]);
    if (MODE == 1 || MODE == 3) {
        const int* slot = (const int*)(p.ws + WS_POS) + 2 * (size_t)R0; const float* wk = (const float*)(p.ws + WS_WTK) + 2 * (size_t)R0;
        const bf16_t* ys = (const bf16_t*)(p.ws + WS_P + P_YS);
        int sl[8]; float ww[8];
#pragma unroll
        for (int i = 0; i < 8; ++i) { sl[i] = ld_i32_dev(slot + i); ww[i] = ld_f32_dev(wk + i); }
        float m5[16]; ld_row_f32((const float*)(p.ws + WS_MOD) + ((size_t)lmoe * 17 + (q.isctx ? 16 : q.b)) * 6144 + 5 * 1024, lane, m5);
        u32x4 ya[4][2], yb[4][2];
#pragma unroll
        for (int i = 0; i < 4; ++i) { const bf16_t* r1 = ys + (size_t)sl[2 * i] * 1024; const bf16_t* r2 = ys + (size_t)sl[2 * i + 1] * 1024;
            ya[i][0] = *(const u32x4*)(r1 + 8 * lane); ya[i][1] = *(const u32x4*)(r1 + 512 + 8 * lane); yb[i][0] = *(const u32x4*)(r2 + 8 * lane); yb[i][1] = *(const u32x4*)(r2 + 512 + 8 * lane); }
#pragma unroll
        for (int i = 0; i < 4; ++i) { float y1[8], y2[8];
#pragma unroll
            for (int hh = 0; hh < 2; ++hh) { unpack8(ya[i][hh], y1); unpack8(yb[i][hh], y2);
#pragma unroll
                for (int j = 0; j < 8; ++j) v[i][8 * hh + j] += m5[8 * hh + j] * (ww[2 * i] * y1[j] + ww[2 * i + 1] * y2[j]); }
            if (MODE == 1) st_row_f32(dst + (size_t)i * 1024, lane, v[i]); }
    }
}
struct RowPar { float g[16], sh[16], sc[16]; };
__device__ __forceinline__ void load_rowpar(const Params& p, int l, int which, const RowInfo& q, int lane, RowPar& rp) {
    const float* mrow = (const float*)(p.ws + WS_MOD) + ((size_t)l * 17 + (q.isctx ? 16 : q.b)) * 6144;
    ld_row_f32(p.in[which ? I_GN2 : I_GN1] + (size_t)l * 1024, lane, rp.g);
    ld_row_f32(mrow + (which ? 3 : 0) * 1024, lane, rp.sh); ld_row_f32(mrow + (which ? 4 : 1) * 1024, lane, rp.sc);
}
__device__ __forceinline__ void norm_mod_row(const RowPar& rp, int lane, const float (&v)[16], bf16_t* hrow, unsigned char* h8row = nullptr) {
    float ss = 0.f;
#pragma unroll
    for (int j = 0; j < 16; ++j) ss += v[j] * v[j];
    ss = wave_sum(ss); const float rs = rsqrtf(ss * (1.0f / 1024.0f) + EPS);
    float o[16];
#pragma unroll
    for (int j = 0; j < 16; ++j) o[j] = v[j] * rs * rp.g[j] * (1.0f + rp.sc[j]) + rp.sh[j];
    st_row_bf16(hrow, lane, o);
    if (h8row) { u32x2 a, b; a.x = pk4_fp8(o[0] * HSCALE8, o[1] * HSCALE8, o[2] * HSCALE8, o[3] * HSCALE8); a.y = pk4_fp8(o[4] * HSCALE8, o[5] * HSCALE8, o[6] * HSCALE8, o[7] * HSCALE8);
        b.x = pk4_fp8(o[8] * HSCALE8, o[9] * HSCALE8, o[10] * HSCALE8, o[11] * HSCALE8); b.y = pk4_fp8(o[12] * HSCALE8, o[13] * HSCALE8, o[14] * HSCALE8, o[15] * HSCALE8);
        *(u32x2*)(h8row + 8 * lane) = a; *(u32x2*)(h8row + 512 + 8 * lane) = b; }
}
__device__ __forceinline__ void phase_norm1(const Params& p, int l) {
    const int tid = opaque_tid(), wid = __builtin_amdgcn_readfirstlane(tid >> 6), lane = tid & 63;
    for (int gq = blockIdx.x * 8 + wid; gq < MTOT / 4; gq += gridDim.x * 8) {
        const int R0 = 4 * gq; const RowInfo q = row_info(R0); float v[4][16]; RowPar rp;
        load_rowpar(p, l, 0, q, lane, rp);
        if (l == 0) load_resid4<0>(p, R0, q, 0, lane, v); else load_resid4<1>(p, R0, q, l - 1, lane, v);
#pragma unroll
        for (int i = 0; i < 4; ++i) norm_mod_row(rp, lane, v[i], (bf16_t*)(p.ws + WS_H) + (size_t)(R0 + i) * 1024, p.ws + WS_H8 + (size_t)(R0 + i) * 1024);
    }
}
__device__ __forceinline__ void phase_final(const Params& p) {
    const int tid = opaque_tid(), wid = __builtin_amdgcn_readfirstlane(tid >> 6), lane = tid & 63;
    float g[16]; ld_row_f32(p.in[I_GFIN], lane, g);
    for (int gq = blockIdx.x * 8 + wid; gq < NBATCH * SEQ / 4; gq += gridDim.x * 8) {
        const int a = 4 * gq, R0 = (a >> 14) * MH + CTXROWS + (a & 16383);
        const RowInfo q = row_info(R0); float v[4][16];
        load_resid4<3>(p, R0, q, 1, lane, v);
#pragma unroll
        for (int i = 0; i < 4; ++i) { float ss = 0.f;
#pragma unroll
            for (int j = 0; j < 16; ++j) ss += v[i][j] * v[i][j];
            ss = wave_sum(ss); const float rs = rsqrtf(ss * (1.0f / 1024.0f) + EPS);
#pragma unroll
            for (int j = 0; j < 16; ++j) v[i][j] = v[i][j] * rs * g[j];
            st_row_f32(p.out + ((size_t)q.b * 2048 + q.t + i) * 1024, lane, v[i]); }
    }
}
__device__ __forceinline__ int active_row(int l, int a) { return l == 0 ? a : (a >> 14) * MH + CTXROWS + (a & 16383); }
typedef float f32x4v __attribute__((ext_vector_type(4)));
__device__ __forceinline__ void phase_norm2_router(const Params& p, int l, LAS unsigned char* lds) {
    const int tid = opaque_tid(), wid = tid >> 6, lane = tid & 63, G = gridDim.x, bid = blockIdx.x;
    const int NA = l == 0 ? MTOT : NBATCH * SEQ;
    const int chunk = (((NA + G - 1) / G) + 15) & ~15;
    const int a0 = bid * chunk, a1 = (a0 + chunk < NA) ? a0 + chunk : NA, na = a1 > a0 ? a1 - a0 : 0;
    LAS float* lg = (LAS float*)lds;
    LAS float* lgs = (LAS float*)(lds + 73728);
    LAS int* re = (LAS int*)(lds + 83968);
    LAS float* rw = (LAS float*)(lds + 83968 + 2048);
    LAS int* rr = (LAS int*)(lds + 83968 + 4096);
    LAS int* hist = (LAS int*)(lds + 83968 + 6144);
    LAS int* base = hist + 32;
    if (tid < 32) hist[tid] = 0;
    bf16_t* H = (bf16_t*)(p.ws + WS_H);
    PSEC_BEGINN(11);
    for (int g = wid; g * 16 < na; g += 8)
        for (int i = 0; i < 16; i += 4) { const int a = a0 + g * 16 + i; if (a >= a1) break;
            const int R0 = active_row(l, a); const RowInfo q = row_info(R0); float v[4][16]; RowPar rp;
            load_rowpar(p, l, 1, q, lane, rp);
            load_resid4<2>(p, R0, q, 0, lane, v);
#pragma unroll
            for (int k = 0; k < 4; ++k) norm_mod_row(rp, lane, v[k], H + (size_t)(R0 + k) * 1024, p.ws + WS_H8 + (size_t)(R0 + k) * 1024); }
    asm volatile("s_waitcnt vmcnt(0)" ::: "memory"); __syncthreads();
    PSEC(11);
    const bf16_t* Wr = (const bf16_t*)(p.ws + WS_WRT) + (size_t)l * 2 * 48 * 1024;
    const float* brg = p.in[I_BRG] + l * 4; const float* bre = p.in[I_BRE] + l * 32;
    const int ng = (na + 15) >> 4, r16 = lane & 15, kq = lane >> 4;
    LAS float* brl = (LAS float*)(lds + 83968 + 6144 + 512);
    if (tid < 36) brl[tid] = tid < 4 ? brg[tid] : bre[tid - 4];
    if (ng > 0) {
        bf16x8 bh[4][3], bl[4][3];
        { const bf16_t* bp = Wr + (size_t)r16 * 1024 + 128 * wid + 8 * kq;
#pragma unroll
          for (int ks = 0; ks < 4; ++ks)
#pragma unroll
              for (int ct = 0; ct < 3; ++ct) { bh[ks][ct] = *(const bf16x8*)(bp + (size_t)ct * 16 * 1024 + ks * 32); bl[ks][ct] = *(const bf16x8*)(bp + (size_t)(48 + ct * 16) * 1024 + ks * 32); } }
        __builtin_amdgcn_sched_barrier(0);
#pragma unroll 1
        for (int g0 = 0; g0 < ng; g0 += 3) {
            bf16x8 a[3][4];
#pragma unroll
            for (int gq = 0; gq < 3; ++gq) { int ar = a0 + (g0 + gq) * 16 + r16; if (ar >= a1) ar = a1 - 1;
                const bf16_t* ap = H + (size_t)active_row(l, ar) * 1024 + 128 * wid + 8 * kq;
#pragma unroll
                for (int ks = 0; ks < 4; ++ks) a[gq][ks] = *(const bf16x8*)(ap + ks * 32); }
            __builtin_amdgcn_sched_barrier(0);
#pragma unroll
            for (int gq = 0; gq < 3; ++gq) {
                f32x4v acc[3] = {{0.f, 0.f, 0.f, 0.f}, {0.f, 0.f, 0.f, 0.f}, {0.f, 0.f, 0.f, 0.f}};
#pragma unroll
                for (int ks = 0; ks < 4; ++ks)
#pragma unroll
                    for (int ct = 0; ct < 3; ++ct) { acc[ct] = __builtin_amdgcn_mfma_f32_16x16x32_bf16(a[gq][ks], bh[ks][ct], acc[ct], 0, 0, 0); acc[ct] = __builtin_amdgcn_mfma_f32_16x16x32_bf16(a[gq][ks], bl[ks][ct], acc[ct], 0, 0, 0); }
#pragma unroll
                for (int ct = 0; ct < 3; ++ct)
#pragma unroll
                    for (int r = 0; r < 4; ++r) lg[((gq * 8 + wid) * 16 + 4 * kq + r) * 48 + ct * 16 + r16] = acc[ct][r];
            }
            __syncthreads();
            for (int o = tid; o < 3 * 768; o += NTHR) { const int gq = o >= 1536 ? 2 : (o >= 768 ? 1 : 0), rem = o - gq * 768; float s = 0.f;
#pragma unroll
                for (int w = 0; w < 8; ++w) s += lg[(gq * 8 + w) * 768 + rem];
                lgs[o] = s; }
            __syncthreads();
            if (tid < 48) {
                const int a = a0 + (g0 + (tid >> 4)) * 16 + (tid & 15);
                if (g0 + (tid >> 4) < ng && a < a1) {
                    const LAS float* x = lgs + tid * 48;
                    float gl[4]; int gs = 0; float gmax;
#pragma unroll
                    for (int j = 0; j < 4; ++j) gl[j] = x[j] + brl[j];
                    gmax = gl[0];
#pragma unroll
                    for (int j = 1; j < 4; ++j) if (gl[j] > gmax) { gmax = gl[j]; gs = j; }
                    float gsum = 0.f;
#pragma unroll
                    for (int j = 0; j < 4; ++j) gsum += __expf(gl[j] - gmax);
                    const float pg = 1.0f / gsum;
                    float v1 = -3.0e38f, v2 = -3.0e38f; int i1 = 0, i2 = 0;
                    for (int j = 0; j < 8; ++j) { const float ev = x[4 + gs * 8 + j] + brl[4 + gs * 8 + j];
                        if (ev > v1) { v2 = v1; i2 = i1; v1 = ev; i1 = j; } else if (ev > v2) { v2 = ev; i2 = j; } }
                    const float t = __expf(v2 - v1); const float w1 = pg / (1.0f + t), w2 = pg * t / (1.0f + t);
                    const int e1 = gs * 8 + i1, e2 = gs * 8 + i2, i = a - a0;
                    re[i] = e1; re[256 + i] = e2; rw[i] = w1; rw[256 + i] = w2;
                }
            }
            __syncthreads();
        }
    }
    __syncthreads();
    PSEC(12);
    if (tid < 32) { int c = 0; for (int i = 0; i < na; ++i) { if (re[i] == tid) rr[i] = c++; if (re[256 + i] == tid) rr[256 + i] = c++; } hist[tid] = c; }
    __syncthreads();
    int* hg = (int*)(p.ws + WS_CTL) + CW_HIST + (l * 256 + bid) * 32;
    if (tid < 32) hg[tid] = hist[tid];
    (void)base;
    int* EID = (int*)(p.ws + WS_EID); float* WTK = (float*)(p.ws + WS_WTK); int* POS = (int*)(p.ws + WS_POS);
    for (int i = tid; i < na; i += NTHR) { const size_t R = (size_t)active_row(l, a0 + i);
        EID[2 * R] = re[i]; EID[2 * R + 1] = re[256 + i]; WTK[2 * R] = rw[i]; WTK[2 * R + 1] = rw[256 + i];
        POS[2 * R] = rr[i]; POS[2 * R + 1] = rr[256 + i]; }
    __syncthreads();
    PSEC(13);
}
__device__ __forceinline__ void moe_segments(const Params& p, int l, LAS int* seg, int myblk) {
    const int tid = opaque_tid(); LAS int* cnt = seg + 40; LAS int* pre = seg + 80; LAS int* part = seg + 4096;
    { const int e = tid & 31, pt = tid >> 5, nb = (int)gridDim.x, per = (nb + 15) >> 4;
      const int* hg = (const int*)(p.ws + WS_CTL) + CW_HIST + l * 256 * 32 + e; int tot = 0, pr = 0;
      for (int b = pt * per; b < (pt + 1) * per && b < nb; ++b) { const int c = hg[b * 32]; if (b < myblk) pr += c; tot += c; }
      part[(pt * 2) * 32 + e] = tot; part[(pt * 2 + 1) * 32 + e] = pr; }
    __syncthreads();
    if (tid < 32) { int tot = 0, pr = 0;
#pragma unroll
        for (int pt = 0; pt < 16; ++pt) { tot += part[(pt * 2) * 32 + tid]; pr += part[(pt * 2 + 1) * 32 + tid]; }
        cnt[tid] = tot; pre[tid] = pr; }
    __syncthreads();
    if (tid == 0) { int s = 0; for (int e = 0; e < 32; ++e) { seg[e] = s; s += (cnt[e] + 255) & ~255; } if (s > SLOTS) s = SLOTS; seg[32] = s; }
    __syncthreads();
}
__device__ __forceinline__ void phase_dispatch(const Params& p, int l, LAS unsigned char* lds) {
    const int tid = opaque_tid(), G = gridDim.x, bid = blockIdx.x;
    LAS int* seg = (LAS int*)lds; moe_segments(p, l, seg, bid); const LAS int* cnt = seg + 40; const LAS int* pre = seg + 80;
    const int NA = l == 0 ? MTOT : NBATCH * SEQ;
    const int chunk = (((NA + G - 1) / G) + 15) & ~15;
    const int a0 = bid * chunk, a1 = (a0 + chunk < NA) ? a0 + chunk : NA;
    const int* EID = (const int*)(p.ws + WS_EID); const float* WTK = (const float*)(p.ws + WS_WTK); int* POS = (int*)(p.ws + WS_POS); float* WTS = (float*)(p.ws + WS_WTS); int* SRC = (int*)(p.ws + WS_SRC);
    for (int i = tid; i < 2 * (a1 - a0); i += NTHR) {
        const int R = active_row(l, a0 + (i >> 1)); const size_t x = 2 * (size_t)R + (i & 1);
        const int e = EID[x], ps = POS[x]; const float w = WTK[x];
        const int s = seg[e] + pre[e] + ps;
        SRC[s] = R; POS[x] = s; WTS[s] = w; }
    for (int e = bid; e < 32; e += G)
        for (int s = seg[e] + cnt[e] + tid; s < seg[e + 1]; s += NTHR) SRC[s] = 0;
    __syncthreads();
}
__device__ __forceinline__ int moe_tile_table(const Params& p, int l, LAS int* seg, LAS int* tile_e) {
    moe_segments(p, l, seg, 0);
    const int nt = seg[32] >> 8;
    for (int i = opaque_tid(); i < nt; i += NTHR) { int e = 0; for (int k = 1; k < 32; ++k) if ((i << 8) >= seg[k]) e = k; tile_e[i] = e; }
    __syncthreads();
    return __builtin_amdgcn_readfirstlane(nt);
}
__device__ __forceinline__ void lds_addf(LAS float* a, float v) { (void)__hip_atomic_fetch_add(a, v, __ATOMIC_RELAXED, __HIP_MEMORY_SCOPE_WORKGROUP); }
__device__ __forceinline__ bf16_t* pbuf(const Params& p, size_t off) { return (bf16_t*)(p.ws + WS_P + off); }
#ifndef MMU
#define MMU 2
#endif
__device__ __forceinline__ void mm128(const LAS bf16_t* A, const LAS bf16_t* Bt, f32x16 (&acc)[2], int wid, int lane) {
    const int r32 = lane & 31, hi = lane >> 5;
    const LAS bf16_t* ap = A + (32 * (wid >> 1) + r32) * TLD + hi * 8;
    const LAS bf16_t* bp = Bt + (64 * (wid & 1) + r32) * TLD + hi * 8;
#pragma unroll MMU
    for (int ks = 0; ks < 8; ++ks) {
        const bf16x8 a = *(const LAS bf16x8*)(ap + ks * 16), b0 = *(const LAS bf16x8*)(bp + ks * 16), b1 = *(const LAS bf16x8*)(bp + 32 * TLD + ks * 16);
        acc[0] = mfma32(a, b0, acc[0]); acc[1] = mfma32(a, b1, acc[1]);
    }
}
__device__ __forceinline__ void mm128_gB(const LAS bf16_t* A, const bf16_t* __restrict__ Bg, f32x16 (&acc)[2], int wid, int lane) {
    const int r32 = lane & 31, hi = lane >> 5;
    const LAS bf16_t* ap = A + (32 * (wid >> 1) + r32) * TLD + hi * 8;
    const bf16_t* bp = Bg + (64 * (wid & 1) + r32) * 128 + hi * 8;
#pragma unroll MMU
    for (int ks = 0; ks < 8; ++ks) {
        const bf16x8 a = *(const LAS bf16x8*)(ap + ks * 16), b0 = *(const bf16x8*)(bp + ks * 16), b1 = *(const bf16x8*)(bp + 32 * 128 + ks * 16);
        acc[0] = mfma32(a, b0, acc[0]); acc[1] = mfma32(a, b1, acc[1]);
    }
}
__device__ __forceinline__ void st_acc_T(LAS bf16_t* T, const f32x16 (&acc)[2], int wid, int lane) {
    const int r32 = lane & 31, hi = lane >> 5;
#pragma unroll
    for (int tl = 0; tl < 2; ++tl)
#pragma unroll
        for (int g = 0; g < 4; ++g) { u32x2 w; w.x = cvtpk(acc[tl][4 * g], acc[tl][4 * g + 1]); w.y = cvtpk(acc[tl][4 * g + 2], acc[tl][4 * g + 3]);
            *(LAS u32x2*)(T + (64 * (wid & 1) + 32 * tl + r32) * TLD + 32 * (wid >> 1) + 8 * g + 4 * hi) = w; }
}

__device__ __forceinline__ void st_acc_rm(LAS bf16_t* T, const f32x16 (&acc)[2], int wid, int lane) {
    const int r32 = lane & 31, hi = lane >> 5;
    LAS bf16_t* b = T + (32 * (wid >> 1) + 4 * hi) * TLD + 64 * (wid & 1) + r32;
#pragma unroll
    for (int tl = 0; tl < 2; ++tl)
#pragma unroll
        for (int r = 0; r < 16; ++r) b[((r & 3) + 8 * (r >> 2)) * TLD + 32 * tl] = (bf16_t)(cvtpk(acc[tl][r], acc[tl][r]) & 0xffffu);
}
constexpr int FLD = 132;
__device__ __forceinline__ void st_acc_f32(LAS float* F, const f32x16 (&acc)[2], int wid, int lane) {
    const int r32 = lane & 31, hi = lane >> 5;
    LAS float* b = F + (32 * (wid >> 1) + 4 * hi) * FLD + 64 * (wid & 1) + r32;
#pragma unroll
    for (int tl = 0; tl < 2; ++tl)
#pragma unroll
        for (int r = 0; r < 16; ++r) b[((r & 3) + 8 * (r >> 2)) * FLD + 32 * tl] = acc[tl][r];
}
__device__ __forceinline__ void copy_tile_out(const LAS bf16_t* T, bf16_t* dst, int ld) {
    const int tx = opaque_tid(), t = tx >> 2, c0 = (tx & 3) * 32;
#pragma unroll
    for (int i = 0; i < 4; ++i) *(u32x4*)(dst + (size_t)t * ld + c0 + 8 * i) = *(const LAS u32x4*)(T + t * TLD + c0 + 8 * i);
}

__device__ __forceinline__ bool seq_start(int r) { return r < CTXROWS ? (r & 255) == 0 : ((r - CTXROWS) & 2047) == 0; }
template <int CTRL> __device__ __forceinline__ u32x4 dpp4(const u32x4 v) { u32x4 o;
    o.x = (unsigned)__builtin_amdgcn_update_dpp(0, (int)v.x, CTRL, 0xf, 0xf, true); o.y = (unsigned)__builtin_amdgcn_update_dpp(0, (int)v.y, CTRL, 0xf, 0xf, true);
    o.z = (unsigned)__builtin_amdgcn_update_dpp(0, (int)v.z, CTRL, 0xf, 0xf, true); o.w = (unsigned)__builtin_amdgcn_update_dpp(0, (int)v.w, CTRL, 0xf, 0xf, true); return o; }
__device__ __forceinline__ void phase_conv(const Params& p, int l, LAS unsigned char* lds) {
    const int tid = opaque_tid(), wid = __builtin_amdgcn_readfirstlane(tid >> 6), lane = tid & 63, r16 = lane & 15, kg = lane >> 4, G = gridDim.x, bid = blockIdx.x;
    constexpr int NG = MH / 16, NU = 5;
    const bf16_t* XM = pbuf(p, P_XMB); bf16_t* XCV = pbuf(p, P_XCV); float* GT = (float*)(p.ws + WS_P + P_GATES);
    LAS float* PX = (LAS float*)lds;
    for (int g0 = bid; g0 < NG; g0 += NU * G) {
        f32x4v acc[NU];
#pragma unroll
        for (int u = 0; u < NU; ++u) acc[u] = (f32x4v){0.f, 0.f, 0.f, 0.f};
#pragma unroll 1
        for (int ks = 0; ks < 2; ++ks) {
            const int c = 64 * wid + 32 * ks + 8 * kg;
            u32x4 cur[NU], edge[NU];
#pragma unroll
            for (int u = 0; u < NU; ++u) { const int g = g0 + G * u; const bool valid = g < NG; const int row = 16 * g + r16;
                cur[u] = valid ? *(const u32x4*)(XM + (size_t)row * 512 + c) : (u32x4){0u, 0u, 0u, 0u};
                const bool he = valid && ((r16 == 0 && !seq_start(16 * g)) || (r16 == 15 && !seq_start(16 * g + 16)));
                const int er = r16 == 0 ? row - 1 : row + 1;
                edge[u] = he ? *(const u32x4*)(XM + (size_t)er * 512 + c) : (u32x4){0u, 0u, 0u, 0u}; }
            float w0[8], w1[8], w2[8], bc[8];
            { const float* wc = p.in[I_WCONV] + (size_t)l * 3 * 512 + c; const float* bcp = p.in[I_BCONV] + (size_t)l * 512 + c;
#pragma unroll
              for (int j = 0; j < 8; ++j) { w0[j] = wc[j]; w1[j] = wc[512 + j]; w2[j] = wc[1024 + j]; bc[j] = bcp[j]; } }
            bf16x8 wyh, wyl, wxh, wxl;
            { const float* wf = (const float*)(p.ws + WS_WFOLD) + ((size_t)l * 16 + r16) * 1024 + c; float a[8], b[8], t8[8];
#pragma unroll
              for (int j = 0; j < 8; ++j) { a[j] = wf[j]; b[j] = wf[512 + j]; }
              u32x4 hh = pack8(a); unpack8(hh, t8);
#pragma unroll
              for (int j = 0; j < 8; ++j) t8[j] = a[j] - t8[j];
              u32x4 ll = pack8(t8); wyh = *(const bf16x8*)&hh; wyl = *(const bf16x8*)&ll;
              hh = pack8(b); unpack8(hh, t8);
#pragma unroll
              for (int j = 0; j < 8; ++j) t8[j] = b[j] - t8[j];
              ll = pack8(t8); wxh = *(const bf16x8*)&hh; wxl = *(const bf16x8*)&ll; }
#pragma unroll
            for (int u = 0; u < NU; ++u) { const int g = g0 + G * u;
                const u32x4 sp = dpp4<0x111>(cur[u]), sn = dpp4<0x101>(cur[u]);
                u32x4 pw, nw;
                pw.x = r16 == 0 ? edge[u].x : sp.x; pw.y = r16 == 0 ? edge[u].y : sp.y; pw.z = r16 == 0 ? edge[u].z : sp.z; pw.w = r16 == 0 ? edge[u].w : sp.w;
                nw.x = r16 == 15 ? edge[u].x : sn.x; nw.y = r16 == 15 ? edge[u].y : sn.y; nw.z = r16 == 15 ? edge[u].z : sn.z; nw.w = r16 == 15 ? edge[u].w : sn.w;
                float xp[8], xc[8], xn[8], y[8], yl[8]; unpack8(pw, xp); unpack8(cur[u], xc); unpack8(nw, xn);
#pragma unroll
                for (int j = 0; j < 8; ++j) y[j] = silu_f(w0[j] * xp[j] + w1[j] * xc[j] + w2[j] * xn[j] + bc[j]);
                const u32x4 yh = pack8(y); unpack8(yh, yl);
#pragma unroll
                for (int j = 0; j < 8; ++j) yl[j] = y[j] - yl[j];
                const u32x4 ylw = pack8(yl);
                const bf16x8 ah = *(const bf16x8*)&yh, al = *(const bf16x8*)&ylw, ax = *(const bf16x8*)&cur[u];
                acc[u] = __builtin_amdgcn_mfma_f32_16x16x32_bf16(ah, wyh, acc[u], 0, 0, 0); acc[u] = __builtin_amdgcn_mfma_f32_16x16x32_bf16(ah, wyl, acc[u], 0, 0, 0);
                acc[u] = __builtin_amdgcn_mfma_f32_16x16x32_bf16(al, wyh, acc[u], 0, 0, 0);
                acc[u] = __builtin_amdgcn_mfma_f32_16x16x32_bf16(ax, wxh, acc[u], 0, 0, 0); acc[u] = __builtin_amdgcn_mfma_f32_16x16x32_bf16(ax, wxl, acc[u], 0, 0, 0);
                if (g < NG) *(u32x4*)(XCV + (size_t)(16 * g + r16) * 512 + c) = yh; }
        }
#pragma unroll
        for (int u = 0; u < NU; ++u)
#pragma unroll
            for (int r = 0; r < 4; ++r) PX[((u * 8 + wid) * 16 + 4 * kg + r) * 16 + r16] = acc[u][r];
        __syncthreads();
        for (int o = tid; o < NU * 256; o += NTHR) { const int u = o >> 8, row = (o >> 4) & 15, n = o & 15, g = g0 + G * u; float s = p.in[I_BIF][l * 16 + n];
#pragma unroll
            for (int w = 0; w < 8; ++w) s += PX[((u * 8 + w) * 16 + row) * 16 + n];
            if (g < NG) GT[(size_t)(16 * g + row) * 16 + (n & 3) * 4 + (n >> 2)] = s; }
        __syncthreads();
    }
}
__device__ __forceinline__ void ld8row(const bf16_t* base, int pos, int seqlen, float (&o)[8]) {
    if (pos < 0 || pos >= seqlen) {
#pragma unroll
        for (int j = 0; j < 8; ++j) o[j] = 0.f; }
    else unpack8(*(const u32x4*)(base + (size_t)pos * 512), o);
}
__device__ __forceinline__ void mlstm_a_ids(int u, int& bl, int& J, int& h, int& r0) {
    bl = u / (NJ * 4); const int rem = u - bl * (NJ * 4); J = rem >> 2; h = rem & 3;
    r0 = (J < 2 ? bl * 256 : CTXROWS + bl * 2048) + (J < 2 ? J * 128 : (J - 2) * 128);
}
#define APRE_PARAMS u32x4 (&qa)[4], u32x4 (&qb)[4], u32x4 (&qwq)[4], u32x4 (&qwk)[4], u32x4 (&qwv)[4], f32x4& qg
#define APRE_ARGS qa, qb, qwq, qwk, qwv, qg
__device__ __forceinline__ void mlstm_a_load(const Params& p, int l, int u, APRE_PARAMS) {
    const int tid = opaque_tid(); int bl, J, h, r0; mlstm_a_ids(u, bl, J, h, r0);
    const int t = tid >> 2, cc = (tid & 3) * 32; const size_t o = (size_t)(r0 + t) * 512 + h * 128 + cc;
    const bf16_t* XM = pbuf(p, P_XMB) + o; const bf16_t* XCV = pbuf(p, P_XCV) + o;
    const bf16_t* Wq = (const bf16_t*)(p.ws + WS_WTQKV) + ((size_t)(l * 3) * 4 + h) * 16384 + t * 128 + cc;
#pragma unroll
    for (int i = 0; i < 4; ++i) { qa[i] = *(const u32x4*)(XCV + 8 * i); qb[i] = *(const u32x4*)(XM + 8 * i);
        qwq[i] = *(const u32x4*)(Wq + 8 * i); qwk[i] = *(const u32x4*)(Wq + (size_t)4 * 16384 + 8 * i); qwv[i] = *(const u32x4*)(Wq + (size_t)8 * 16384 + 8 * i); }
    qg = *(const f32x4*)((const float*)(p.ws + WS_P + P_GATES) + (size_t)(r0 + (tid & 127)) * 16 + h * 4);
}
__device__ __forceinline__ void mlstm_a_unit(const Params& p, int l, int u, int unext, int n_a, APRE_PARAMS, LAS unsigned char* lds) {
    int tid_ = threadIdx.x; asm volatile("" : "+v"(tid_));
    const int tid = tid_, wid = __builtin_amdgcn_readfirstlane(tid >> 6), lane = tid & 63, r32 = lane & 31, hi = lane >> 5;
    LAS bf16_t* T0 = (LAS bf16_t*)lds; LAS bf16_t* T1 = (LAS bf16_t*)(lds + TILE_B); LAS bf16_t* T2 = (LAS bf16_t*)(lds + 2 * TILE_B); LAS bf16_t* T3 = (LAS bf16_t*)(lds + 3 * TILE_B);
    LAS float* gl = (LAS float*)(lds + 4 * TILE_B);
    LAS float* wend = gl + 512;
    int bl, J, h, r0; mlstm_a_ids(u, bl, J, h, r0);
    const int wr_ = tid >> 2, wc_ = (tid & 3) * 32;
    u32x4 wv_[4];
#pragma unroll
    for (int i = 0; i < 4; ++i) { *(LAS u32x4*)(T0 + wr_ * TLD + wc_ + 8 * i) = qa[i]; *(LAS u32x4*)(T1 + wr_ * TLD + wc_ + 8 * i) = qb[i];
        *(LAS u32x4*)(T2 + wr_ * TLD + wc_ + 8 * i) = qwq[i]; *(LAS u32x4*)(T3 + wr_ * TLD + wc_ + 8 * i) = qwk[i]; wv_[i] = qwv[i]; }
    if (tid < 128) *(LAS f32x4*)(gl + tid * 4) = qg;
    LBAR();
    if (wid < 2) {
        const int dir = wid, p0 = 2 * lane, p1 = p0 + 1, s0 = dir ? 127 - p0 : p0, s1 = dir ? 127 - p1 : p1;
        const float ig0 = gl[s0 * 4 + 2 * dir], ig1 = gl[s1 * 4 + 2 * dir];
        const float lf0 = logsigmoid_f(gl[s0 * 4 + 2 * dir + 1]), lf1 = logsigmoid_f(gl[s1 * 4 + 2 * dir + 1]);
        float incl = lf0 + lf1;
        for (int o = 1; o < 64; o <<= 1) { const float t = __shfl_up(incl, o); if (lane >= o) incl += t; }
        const float bc1 = incl, bc0 = incl - lf1, gg = __shfl(incl, 63);
        const float ae0 = gg - bc0 + ig0, ae1 = gg - bc1 + ig1; const float ml = wave_max(fmaxf(ae0, ae1));
        wend[dir * 128 + s0] = __expf(ae0 - ml); wend[dir * 128 + s1] = __expf(ae1 - ml);
        if (lane == 0) { float* mst = (float*)(p.ws + WS_P + P_MST) + ((size_t)(((bl * 4 + h) * 2 + dir) * NJ + J)) * 4; mst[0] = ml; mst[1] = gg; }
    }
    f32x16 ack[2] = {};
    {
        f32x16 acq[2] = {}, akp[2] = {};
        mm128(T2, T0, acq, wid, lane); mm128(T0, T3, ack, wid, lane); mm128(T3, T0, akp, wid, lane);
        LBAR();
        st_acc_T(T2, acq, wid, lane); st_acc_T(T3, akp, wid, lane);
#pragma unroll
        for (int i = 0; i < 4; ++i) *(LAS u32x4*)(T0 + wr_ * TLD + wc_ + 8 * i) = wv_[i];
    }
    LBAR();
    copy_tile_out(T2, pbuf(p, P_MQ) + (size_t)r0 * 512 + h * 128, 512);
    copy_tile_out(T3, pbuf(p, P_MK) + (size_t)r0 * 512 + h * 128, 512);
    {
        f32x16 acv[2] = {}; mm128(T1, T0, acv, wid, lane);
        LBAR();
        st_acc_T(T2, ack, wid, lane); st_acc_T(T3, acv, wid, lane);
    }
    mlstm_a_load(p, l, unext < n_a ? unext : u, APRE_ARGS);
    LBAR();
    {
        bf16_t* MVT = pbuf(p, P_MVT) + ((size_t)((bl * NJ + J) * 4 + h)) * 16384; const int d = tid >> 2, s0 = (tid & 3) * 32;
#pragma unroll
        for (int i = 0; i < 4; ++i) *(u32x4*)(MVT + d * 128 + s0 + 8 * i) = *(const LAS u32x4*)(T3 + d * TLD + s0 + 8 * i);
    }
#pragma unroll 1
    for (int dir = 0; dir < 2; ++dir) {
        const int combo = (bl * 4 + h) * 2 + dir;
        f32x16 acc[2] = {};
        const LAS bf16_t* ap = T3 + (32 * (wid >> 1) + r32) * TLD + hi * 8; const LAS bf16_t* bp = T2 + (64 * (wid & 1) + r32) * TLD + hi * 8;
        const LAS float* wv = wend + dir * 128 + hi * 8;
#pragma unroll
        for (int ks = 0; ks < 8; ++ks) {
            float a8[8]; unpack8(*(const LAS u32x4*)(ap + ks * 16), a8);
            const f32x4 wa = *(const LAS f32x4*)(wv + ks * 16), wb = *(const LAS f32x4*)(wv + ks * 16 + 4);
#pragma unroll
            for (int j = 0; j < 4; ++j) { a8[j] *= wa[j]; a8[4 + j] *= wb[j]; }
            const u32x4 aw = pack8(a8); const bf16x8 a = *(const bf16x8*)&aw;
            const bf16x8 b0 = *(const LAS bf16x8*)(bp + ks * 16), b1 = *(const LAS bf16x8*)(bp + 32 * TLD + ks * 16);
            acc[0] = mfma32(a, b0, acc[0]); acc[1] = mfma32(a, b1, acc[1]);
        }
        bf16_t* CL = (bf16_t*)(p.ws + WS_P + P_CLOC) + ((size_t)combo * NJ + J) * 16384;
        LAS float* F = (LAS float*)lds;
        st_acc_f32(F, acc, wid, lane);
        LBAR();
        { const int d = tid >> 2, e0 = (tid & 3) * 32;
#pragma unroll
          for (int i = 0; i < 4; ++i) { const f32x4 a = *(const LAS f32x4*)(F + d * FLD + e0 + 8 * i), b = *(const LAS f32x4*)(F + d * FLD + e0 + 8 * i + 4);
              u32x4 w; w.x = cvtpk(a[0], a[1]); w.y = cvtpk(a[2], a[3]); w.z = cvtpk(b[0], b[1]); w.w = cvtpk(b[2], b[3]);
              *(u32x4*)(CL + d * 128 + e0 + 8 * i) = w; } }
        LBAR();
    }
    if (tid < 256) { const int dir = tid >> 7, e = tid & 127; float s = 0.f;
#pragma unroll 4
        for (int j = 0; j < 128; j += 8) { float k8[8]; unpack8(*(const LAS u32x4*)(T2 + e * TLD + j), k8);
            const f32x4 wa = *(const LAS f32x4*)(wend + dir * 128 + j), wb = *(const LAS f32x4*)(wend + dir * 128 + j + 4);
#pragma unroll
            for (int i = 0; i < 4; ++i) s += wa[i] * k8[i] + wb[i] * k8[4 + i]; }
        ((float*)(p.ws + WS_P + P_NLOC))[((size_t)(((bl * 4 + h) * 2 + dir) * NJ + J)) * 128 + e] = s; }
    LBAR();
}

__device__ __forceinline__ int scan_J(int dir, int pidx) { return dir == 0 ? pidx : (pidx == 0 ? 1 : (pidx == 1 ? 0 : 19 - pidx)); }
__device__ __forceinline__ void phase_scan(const Params& p) {
    const int NIT = 64 * 2112;
    bf16_t* CL = (bf16_t*)(p.ws + WS_P + P_CLOC); float* NL = (float*)(p.ws + WS_P + P_NLOC); float* MST = (float*)(p.ws + WS_P + P_MST);
    const int tid = opaque_tid();
    for (int w = blockIdx.x * NTHR + tid; w < NIT; w += gridDim.x * NTHR) {
        const int combo = w / 2112, q = w - combo * 2112, dir = combo & 1;
        float m_st = 0.f;
        if (q < 2048) {
            float st[8];
#pragma unroll
            for (int j = 0; j < 8; ++j) st[j] = 0.f;
            bf16_t* base = CL + (size_t)combo * NJ * 16384 + 8 * q;
#pragma unroll 1
            for (int i = 0; i < NJ; ++i) {
                const int J = scan_J(dir, i); float* ms = MST + ((size_t)combo * NJ + J) * 4;
                const u32x4 vc = *(const u32x4*)(base + (size_t)J * 16384);
                const float ml = ms[0], gg = ms[1];
                const float m_new = fmaxf(gg + m_st, ml), a_old = __expf(gg + m_st - m_new), a_new = __expf(ml - m_new);
                *(u32x4*)(base + (size_t)J * 16384) = pack8(st);
                if (q == 0) ms[2] = m_st;
                float c8[8]; unpack8(vc, c8);
#pragma unroll
                for (int j = 0; j < 8; ++j) st[j] = st[j] * a_old + c8[j] * a_new;
                m_st = m_new;
            }
        } else if (q < 2080) {
            float* base = NL + (size_t)combo * NJ * 128 + 4 * (q - 2048);
            f32x4 s4 = {0.f, 0.f, 0.f, 0.f};
#pragma unroll 1
            for (int i = 0; i < NJ; ++i) {
                const int J = scan_J(dir, i); const float* ms = MST + ((size_t)combo * NJ + J) * 4;
                const f32x4 vc = *(const f32x4*)(base + (size_t)J * 128);
                const float ml = ms[0], gg = ms[1];
                const float m_new = fmaxf(gg + m_st, ml), a_old = __expf(gg + m_st - m_new), a_new = __expf(ml - m_new);
                *(f32x4*)(base + (size_t)J * 128) = s4;
                s4 = s4 * a_old + vc * a_new; m_st = m_new;
            }
        }
    }
}

__device__ __forceinline__ unsigned zap_nf(unsigned w) { if ((w & 0x7f80u) >= 0x4980u) w &= 0xffff0000u; if ((w & 0x7f800000u) >= 0x49800000u) w &= 0x0000ffffu; return w; }
template <int dir>
__device__ __forceinline__ void mlstm_c_dir(const unsigned (&Xp)[4][8], f32x16 (&acc)[2], const LAS bf16_t* Tq, const LAS bf16_t* Tc, const LAS bf16_t* Tv,
                                            const LAS float* av, const LAS float* Mv, const LAS float* wi, LAS float* denw, const LAS float* n0l, int wid, int lane) {
    const int r32 = lane & 31, hi = lane >> 5, tb = wid >> 1, t = 32 * tb + r32;
    acc[0] = f32x16{}; acc[1] = f32x16{};
    mm128(Tq, Tc, acc, wid, lane);
#pragma unroll
    for (int r = 0; r < 16; ++r) { const float w = wi[dir * 128 + 32 * tb + crow(r, hi)]; acc[0][r] *= w; acc[1][r] *= w; }
    float nq = 0.f;
#pragma unroll
    for (int i = 0; i < 8; ++i) { float q8[8]; unpack8(*(const LAS u32x4*)(Tq + t * TLD + 64 * hi + 8 * i), q8);
        const f32x4 na = *(const LAS f32x4*)(n0l + dir * 128 + 64 * hi + 8 * i), nb = *(const LAS f32x4*)(n0l + dir * 128 + 64 * hi + 8 * i + 4);
#pragma unroll
        for (int j = 0; j < 4; ++j) nq += na[j] * q8[j] + nb[j] * q8[4 + j]; }
    const float Mt = Mv[dir * 128 + t]; float den = 0.f;
    const LAS bf16_t* vp = Tv + (64 * (wid & 1) + r32) * TLD + 4 * hi;
#pragma unroll
    for (int sb = 0; sb < 4; ++sb) {
        float o[16];
#pragma unroll
        for (int r = 0; r < 16; ++r) { const int s = 32 * sb + crow(r, hi); const bool ok = dir ? (s >= t) : (s <= t);
            const float xs = (r & 1) ? bf_hi(Xp[sb][r >> 1]) : bf_lo(Xp[sb][r >> 1]);
            const float ev = xs * __builtin_amdgcn_exp2f((av[dir * 128 + s] - Mt) * LOG2E);
            o[r] = ok ? ev : 0.f; den += o[r]; }
#pragma unroll
        for (int s2 = 0; s2 < 2; ++s2) {
            u32x4 aw; aw.x = cvtpk(o[8 * s2 + 0], o[8 * s2 + 1]); aw.y = cvtpk(o[8 * s2 + 2], o[8 * s2 + 3]); aw.z = cvtpk(o[8 * s2 + 4], o[8 * s2 + 5]); aw.w = cvtpk(o[8 * s2 + 6], o[8 * s2 + 7]);
            const bf16x8 af = *(const bf16x8*)&aw;
#pragma unroll
            for (int tl = 0; tl < 2; ++tl) { const LAS bf16_t* bp = vp + 32 * tl * TLD + 32 * sb + 16 * s2;
                const u32x2 b0 = *(const LAS u32x2*)bp, b1 = *(const LAS u32x2*)(bp + 8); u32x4 bw; bw.x = b0.x; bw.y = b0.y; bw.z = b1.x; bw.w = b1.y;
                acc[tl] = mfma32(af, *(const bf16x8*)&bw, acc[tl]); }
        }
        __builtin_amdgcn_sched_barrier(0);
    }
    { auto rr = __builtin_amdgcn_permlane32_swap(__float_as_uint(den), __float_as_uint(den), false, false); den = __uint_as_float(rr[0]) + __uint_as_float(rr[1]); }
    { auto rr = __builtin_amdgcn_permlane32_swap(__float_as_uint(nq), __float_as_uint(nq), false, false); nq = __uint_as_float(rr[0]) + __uint_as_float(rr[1]); }
    if (hi == 0) denw[(wid * 2 + dir) * 32 + r32] = den + wi[dir * 128 + t] * nq;
}
__device__ __forceinline__ void mlstm_c_unit(const Params& p, int l, int bl, int J, int h, LAS unsigned char* lds) {
    int tid_ = threadIdx.x; asm volatile("" : "+v"(tid_));
    const int tid = tid_, wid = __builtin_amdgcn_readfirstlane(tid >> 6), lane = tid & 63, r32 = lane & 31, hi = lane >> 5;
    LAS bf16_t* Tq = (LAS bf16_t*)lds; LAS bf16_t* Tk = (LAS bf16_t*)(lds + TILE_B); LAS bf16_t* Tv = (LAS bf16_t*)(lds + 2 * TILE_B); LAS bf16_t* Ts = (LAS bf16_t*)(lds + 3 * TILE_B);
    LAS float* sc = (LAS float*)(lds + 4 * TILE_B);
    LAS float* gl = sc;
    LAS float* av = sc + 512;
    LAS float* Mv = sc + 768;
    LAS float* wi = sc + 1024;
    LAS float* fl = sc + 1280;
    LAS float* ssq = sc + 1536;
    LAS float* denp = sc + 1664;
    LAS float* n0l = sc + 2944;
    const int rseq = J < 2 ? bl * 256 : CTXROWS + bl * 2048, r0 = rseq + (J < 2 ? J * 128 : (J - 2) * 128);
    u32x4 cf_[4], cbp_[4];
    { const int d_ = tid >> 2, e_ = (tid & 3) * 32; const bf16_t* c0f = (const bf16_t*)(p.ws + WS_P + P_CLOC) + ((size_t)((bl * 4 + h) * 2) * NJ + J) * 16384 + d_ * 128 + e_;
#pragma unroll
      for (int i = 0; i < 4; ++i) { cf_[i] = *(const u32x4*)(c0f + 8 * i); cbp_[i] = *(const u32x4*)(c0f + (size_t)NJ * 16384 + 8 * i); } }
    {
        const int t = tid >> 2, c0 = (tid & 3) * 32;
        const bf16_t* q = pbuf(p, P_MQ) + (size_t)(r0 + t) * 512 + h * 128 + c0; const bf16_t* k = pbuf(p, P_MK) + (size_t)(r0 + t) * 512 + h * 128 + c0;
        const bf16_t* v = pbuf(p, P_MVT) + ((size_t)((bl * NJ + J) * 4 + h)) * 16384 + t * 128 + c0;
#pragma unroll
        for (int i = 0; i < 4; ++i) { *(LAS u32x4*)(Tq + t * TLD + c0 + 8 * i) = *(const u32x4*)(q + 8 * i); *(LAS u32x4*)(Tk + t * TLD + c0 + 8 * i) = *(const u32x4*)(k + 8 * i);
            *(LAS u32x4*)(Tv + t * TLD + c0 + 8 * i) = *(const u32x4*)(v + 8 * i); }
        if (tid < 128) { *(LAS f32x4*)(gl + tid * 4) = *(const f32x4*)((const float*)(p.ws + WS_P + P_GATES) + (size_t)(r0 + tid) * 16 + h * 4); ssq[tid] = 0.f; }
        if (tid < 256) n0l[tid] = ((const float*)(p.ws + WS_P + P_NLOC))[((size_t)(((bl * 4 + h) * 2 + (tid >> 7)) * NJ + J)) * 128 + (tid & 127)];
    }
    __syncthreads();
    { const int d_ = tid >> 2, e_ = (tid & 3) * 32;
#pragma unroll
      for (int i = 0; i < 4; ++i) *(LAS u32x4*)(Ts + d_ * TLD + e_ + 8 * i) = cf_[i]; }
    const float* MST = (const float*)(p.ws + WS_P + P_MST);
    if (wid < 2) {
        const int dir = wid, p0 = 2 * lane, p1 = p0 + 1, s0 = dir ? 127 - p0 : p0, s1 = dir ? 127 - p1 : p1;
        const float m0 = ld_f32_dev(MST + ((size_t)(((bl * 4 + h) * 2 + dir) * NJ + J)) * 4 + 2);
        const float ig0 = gl[s0 * 4 + 2 * dir], ig1 = gl[s1 * 4 + 2 * dir];
        const float lf0 = logsigmoid_f(gl[s0 * 4 + 2 * dir + 1]), lf1 = logsigmoid_f(gl[s1 * 4 + 2 * dir + 1]);
        float incl = lf0 + lf1;
        for (int o = 1; o < 64; o <<= 1) { const float t = __shfl_up(incl, o); if (lane >= o) incl += t; }
        const float bc1 = incl, bc0 = incl - lf1;
        const float a0 = ig0 - bc0, a1 = ig1 - bc1;
        float mx = fmaxf(a0, a1);
        for (int o = 1; o < 64; o <<= 1) { const float t = __shfl_up(mx, o); if (lane >= o) mx = fmaxf(mx, t); }
        float mxprev = __shfl_up(mx, 1); if (lane == 0) mxprev = -3.0e38f;
        const float M0 = fmaxf(m0, fmaxf(mxprev, a0)), M1 = fmaxf(m0, mx);
        av[dir * 128 + s0] = a0; av[dir * 128 + s1] = a1; Mv[dir * 128 + s0] = M0; Mv[dir * 128 + s1] = M1;
        wi[dir * 128 + s0] = __expf(m0 - M0); wi[dir * 128 + s1] = __expf(m0 - M1);
        fl[dir * 128 + s0] = __expf(-bc0 - M0); fl[dir * 128 + s1] = __expf(-bc1 - M1);
    }
    __builtin_amdgcn_sched_barrier(0);
    unsigned Xp[4][8];
    {
    f32x16 X[4] = {};
    { const LAS bf16_t* bq = Tq + (32 * (wid >> 1) + r32) * TLD + hi * 8; const LAS bf16_t* ak = Tk + r32 * TLD + hi * 8;
#pragma unroll 2
      for (int ks = 0; ks < 8; ++ks) { const bf16x8 b = *(const LAS bf16x8*)(bq + ks * 16);
#pragma unroll
          for (int sb = 0; sb < 4; ++sb) X[sb] = mfma32(*(const LAS bf16x8*)(ak + 32 * sb * TLD + ks * 16), b, X[sb]); } }
#pragma unroll
    for (int sb = 0; sb < 4; ++sb)
#pragma unroll
        for (int i = 0; i < 8; ++i) Xp[sb][i] = cvtpk(X[sb][2 * i], X[sb][2 * i + 1]);
    }
    __syncthreads();
    { const int d_ = tid >> 2, e_ = (tid & 3) * 32;
#pragma unroll
      for (int i = 0; i < 4; ++i) *(LAS u32x4*)(Tk + d_ * TLD + e_ + 8 * i) = cbp_[i]; }
    __syncthreads();
    f32x16 ao0[2], ao1[2];
    LAS float* denw = denp;
    mlstm_c_dir<0>(Xp, ao0, Tq, Ts, Tv, av, Mv, wi, denw, n0l, wid, lane);
    mlstm_c_dir<1>(Xp, ao1, Tq, Tk, Tv, av, Mv, wi, denw, n0l, wid, lane);
    float hv[2][16];
#pragma unroll
    for (int r = 0; r < 16; ++r) { const int t = 32 * (wid >> 1) + crow(r, hi);
        const float df = denw[(wid * 2 + 0) * 32 + crow(r, hi)], db = denw[(wid * 2 + 1) * 32 + crow(r, hi)];
        const float rf = 1.0f / fmaxf(fabsf(df), fl[t]), rb = 1.0f / fmaxf(fabsf(db), fl[128 + t]);
        hv[0][r] = ao0[0][r] * rf + ao1[0][r] * rb; hv[1][r] = ao0[1][r] * rf + ao1[1][r] * rb;
        float q = hv[0][r] * hv[0][r] + hv[1][r] * hv[1][r];
        q = half_sum31(q);
        if (r32 == 31) lds_addf(&ssq[t], q); }
    __syncthreads();
    const float* gm = p.in[I_GMN] + l * 512 + h * 128; const float* sk = p.in[I_SKIP] + l * 512 + h * 128;
    f32x16 hn[2];
#pragma unroll
    for (int tl = 0; tl < 2; ++tl) { const float gd = gm[64 * (wid & 1) + 32 * tl + r32];
#pragma unroll
        for (int r = 0; r < 16; ++r) hn[tl][r] = hv[tl][r] * rsqrtf(ssq[32 * (wid >> 1) + crow(r, hi)] * (1.0f / 128.0f) + EPS) * gd; }
    LAS float* F = (LAS float*)lds;
    st_acc_f32(F, hn, wid, lane);
    __syncthreads();
    { int te_ = tid; asm volatile("" : "+v"(te_));
      const int t = te_ >> 2, c0 = (te_ & 3) * 32; const size_t o = (size_t)(r0 + t) * 512 + h * 128 + c0;
      const bf16_t* xcv = pbuf(p, P_XCV) + o; bf16_t* zb = pbuf(p, P_ZB) + o;
      u32x4 xw[4], zw[4]; f32x4 s0[4], s1[4];
#pragma unroll
      for (int i = 0; i < 4; ++i) { xw[i] = *(const u32x4*)(xcv + 8 * i); zw[i] = *(const u32x4*)(zb + 8 * i); s0[i] = *(const f32x4*)(sk + c0 + 8 * i); s1[i] = *(const f32x4*)(sk + c0 + 8 * i + 4); }
#pragma unroll
      for (int i = 0; i < 4; ++i) { float x8[8], z8[8]; unpack8(xw[i], x8); unpack8(zw[i], z8);
          const f32x4 h0 = *(const LAS f32x4*)(F + t * FLD + c0 + 8 * i), h1 = *(const LAS f32x4*)(F + t * FLD + c0 + 8 * i + 4);
#pragma unroll
          for (int j = 0; j < 4; ++j) { z8[j] = (h0[j] + s0[i][j] * x8[j]) * z8[j]; z8[4 + j] = (h1[j] + s1[i][j] * x8[4 + j]) * z8[4 + j]; }
          zw[i] = pack8(z8); }
#pragma unroll
      for (int i = 0; i < 4; ++i) *(u32x4*)(zb + 8 * i) = zw[i]; }
    __syncthreads();
}
namespace att {
constexpr int SHM_V = 64 * 128 * 2, SHM_K = 64 * 64 * 2, OFF_K = 2 * SHM_V, OFF_WS = OFF_K + 2 * SHM_K, OFF_ST = OFF_WS + 8 * 64 * 4, LDS_NEED = OFF_ST + 32 * 512 * 4;
static_assert(LDS_NEED <= LDS_BYTES - 64, "attention LDS");
constexpr float THR2 = 11.5f;
#define KSWZ64(row, colB) ((row) * 128 + ((colB) ^ (((row) & 7) << 4)))
#define ASBAR() __builtin_amdgcn_sched_barrier(0)
__device__ __forceinline__ void partialSM(f32x16& p0, f32x16& p1, float& m_reg, float& mn, float& alpha) {
    float pmax = p0[0];
#pragma unroll
    for (int r = 1; r < 16; ++r) pmax = fmaxf(pmax, p0[r]);
#pragma unroll
    for (int r = 0; r < 16; ++r) pmax = fmaxf(pmax, p1[r]);
    { auto rr = __builtin_amdgcn_permlane32_swap(__float_as_uint(pmax), __float_as_uint(pmax), false, false); pmax = fmaxf(__uint_as_float(rr[0]), __uint_as_float(rr[1])); }
    if (__builtin_expect(__all(pmax - m_reg <= THR2), 1)) { mn = m_reg; alpha = 1.f; }
    else { mn = fmaxf(m_reg, pmax); alpha = __builtin_amdgcn_exp2f(m_reg - mn); m_reg = mn; }
#pragma unroll
    for (int r = 0; r < 16; ++r) { p0[r] -= mn; p1[r] -= mn; }
#pragma unroll
    for (int r = 0; r < 16; ++r) p0[r] = __builtin_amdgcn_exp2f(p0[r]);
}
__device__ __forceinline__ void finishSM(f32x16& p0, f32x16& p1, float alpha, float& l_reg, bf16x8& pa0, bf16x8& pa1, bf16x8& pa2, bf16x8& pa3) {
#pragma unroll
    for (int r = 0; r < 16; ++r) p1[r] = __builtin_amdgcn_exp2f(p1[r]);
    float ps = 0;
#pragma unroll
    for (int r = 0; r < 16; ++r) ps += p0[r];
#pragma unroll
    for (int r = 0; r < 16; ++r) ps += p1[r];
    { auto rr = __builtin_amdgcn_permlane32_swap(__float_as_uint(ps), __float_as_uint(ps), false, false); ps = __uint_as_float(rr[0]) + __uint_as_float(rr[1]); }
    l_reg = l_reg * alpha + ps;
#define PK4(P, BASE, OUT) do { unsigned a0 = cvtpk(P[BASE + 0], P[BASE + 1]), a1 = cvtpk(P[BASE + 2], P[BASE + 3]);   \
    unsigned b0 = cvtpk(P[BASE + 4], P[BASE + 5]), b1 = cvtpk(P[BASE + 6], P[BASE + 7]);                              \
    auto r0 = __builtin_amdgcn_permlane32_swap(a0, b0, false, false); auto r1 = __builtin_amdgcn_permlane32_swap(a1, b1, false, false); \
    u32x4 w = {r0[0], r1[0], r0[1], r1[1]}; OUT = *reinterpret_cast<bf16x8*>(&w); } while (0)
    PK4(p0, 0, pa0); PK4(p0, 8, pa1); PK4(p1, 0, pa2); PK4(p1, 8, pa3);
#undef PK4
}
__device__ __forceinline__ void qkt(f32x16& p0, f32x16& p1, const LAS char* Ks, const bf16x8 (&qr)[4], int r32, int hi) {
    p0 = f32x16{}; p1 = f32x16{};
#pragma unroll
    for (int d0 = 0; d0 < 4; ++d0) { const int cb = (d0 * 16 + hi * 8) * 2;
        const bf16x8 b0 = *reinterpret_cast<const LAS bf16x8*>(Ks + KSWZ64(r32, cb));
        const bf16x8 b1 = *reinterpret_cast<const LAS bf16x8*>(Ks + KSWZ64(32 + r32, cb));
        p0 = mfma32(b0, qr[d0], p0); p1 = mfma32(b1, qr[d0], p1); }
}
__device__ __forceinline__ int v_st(int k, int c) { const int kk = (k & ~0xC) | ((k & 4) << 1) | ((k & 8) >> 1); return ((kk >> 3) * 4 + (c >> 5)) * 512 + ((kk & 7) * 32 + (c & 31)) * 2; }
__device__ __forceinline__ int v_rd_base(int lane) { return ((lane & 3) << 3) | (((lane >> 2) & 3) << 6) | (((lane >> 4) & 1) << 5) | (((lane >> 5) & 1) << 8); }
constexpr int v_rd_off(int d0, int ks, int half) { return d0 * 512 + ks * 4096 + half * 2048; }
template <int OFF> __device__ __forceinline__ s16x4 tr_read(int vb) { s16x4 r; asm volatile("ds_read_b64_tr_b16 %0, %1 offset:%2" : "=&v"(r) : "v"(vb), "i"(OFF) : "memory"); return r; }
template <int D0> __device__ __forceinline__ void pv_one(f32x16& od, int vb, bf16x8 pa0, bf16x8 pa1, bf16x8 pa2, bf16x8 pa3) {
    const s16x4 l0 = tr_read<v_rd_off(D0, 0, 0)>(vb), h0 = tr_read<v_rd_off(D0, 0, 1)>(vb), l1 = tr_read<v_rd_off(D0, 1, 0)>(vb), h1 = tr_read<v_rd_off(D0, 1, 1)>(vb);
    const s16x4 l2 = tr_read<v_rd_off(D0, 2, 0)>(vb), h2 = tr_read<v_rd_off(D0, 2, 1)>(vb), l3 = tr_read<v_rd_off(D0, 3, 0)>(vb), h3 = tr_read<v_rd_off(D0, 3, 1)>(vb);
    asm volatile("s_waitcnt lgkmcnt(0)" ::: "memory"); ASBAR();
#define PKV(L, H) (bf16x8){L[0], L[1], L[2], L[3], H[0], H[1], H[2], H[3]}
    od = mfma32(pa0, PKV(l0, h0), od); od = mfma32(pa1, PKV(l1, h1), od); od = mfma32(pa2, PKV(l2, h2), od); od = mfma32(pa3, PKV(l3, h3), od);
#undef PKV
}
__device__ __forceinline__ void pv_d0(f32x16 (&o)[4], int vb, bf16x8 pa0, bf16x8 pa1, bf16x8 pa2, bf16x8 pa3) {
    pv_one<0>(o[0], vb, pa0, pa1, pa2, pa3); pv_one<1>(o[1], vb, pa0, pa1, pa2, pa3); pv_one<2>(o[2], vb, pa0, pa1, pa2, pa3); pv_one<3>(o[3], vb, pa0, pa1, pa2, pa3);
}
__device__ __forceinline__ int krow(int j, int rc, int rl) { return j < 4 ? rc + 64 * j : rl + 64 * (j - 4); }

__device__ __forceinline__ void attn_unit(const Params& p, int l, int h, int qrow0, int rc, int rl, int NT, LAS unsigned char* lds8) {
    int tid_ = threadIdx.x; asm volatile("" : "+v"(tid_));
    const int tid = tid_, wid = __builtin_amdgcn_readfirstlane(tid >> 6), lane = tid & 63, r32 = lane & 31, hi = lane >> 5;
    LAS char* V_lds = (LAS char*)lds8; LAS char* K_lds = (LAS char*)lds8 + OFF_K;
    LAS float* wsx = (LAS float*)(lds8 + OFF_WS) + wid * 64; LAS float* li_l = wsx; LAS float* al_l = wsx + 32;
    LAS unsigned* stash = (LAS unsigned*)(lds8 + OFF_ST);
    bf16_t* QB = pbuf(p, P_QB); const bf16_t* KB = pbuf(p, P_KB); const bf16_t* VB = pbuf(p, P_VB);
    const int sr = tid >> 4, sc = (tid & 15) * 8, vst0 = v_st(sr, sc);
    const int kr = tid >> 3, kc = (tid & 7) * 8, kst = KSWZ64(kr, kc * 2);
    const int vb0 = (int)(uintptr_t)V_lds + v_rd_base(lane);
    f32x16 o[4];
#pragma unroll 1
    for (int m = 0; m < 2; ++m) {
        const unsigned voV0 = (unsigned)((sr * 512 + h * 128 + sc) * 2), voK = (unsigned)((kr * 512 + h * 128 + m * 64 + kc) * 2);
        float m_reg = -1e30f, l_reg = 0.f;
#pragma unroll
        for (int d = 0; d < 4; ++d) o[d] = f32x16{};
        bf16x8 qr[4];
        { const bf16_t* Qw = QB + (size_t)(qrow0 + wid * 32 + r32) * 512 + h * 128 + m * 64 + hi * 8;
#pragma unroll
          for (int d0 = 0; d0 < 4; ++d0) qr[d0] = *(const bf16x8*)(Qw + d0 * 16); }
        struct { bf16x8 vs0, vs1, ks0; } sr_[2];
#define SLOAD(i, j) do { const int _r = __builtin_amdgcn_readfirstlane(krow((j), rc, rl)); const char* _vb = (const char*)(VB + (size_t)_r * 512); const char* _kb = (const char*)(KB + (size_t)_r * 512); \
    sr_[i].vs0 = *(const bf16x8*)(_vb + voV0); sr_[i].vs1 = *(const bf16x8*)(_vb + 32 * 512 * 2 + voV0); sr_[i].ks0 = *(const bf16x8*)(_kb + voK); } while (0)
#define SWRITE(b, i) do { *(LAS bf16x8*)(V_lds + (b) * SHM_V + vst0) = sr_[i].vs0; *(LAS bf16x8*)(V_lds + (b) * SHM_V + 8192 + vst0) = sr_[i].vs1; \
    *(LAS bf16x8*)(K_lds + (b) * SHM_K + kst) = sr_[i].ks0; } while (0)
#define SWAIT() asm volatile("s_waitcnt vmcnt(3)" ::: "memory")
#define RESC(a) do { if (__any((a) < 1.f)) { if (hi == 0) al_l[r32] = (a); asm volatile("s_waitcnt lgkmcnt(0)" ::: "memory"); \
    _Pragma("unroll") for (int d = 0; d < 4; ++d) _Pragma("unroll") for (int r = 0; r < 16; ++r) o[d][r] *= al_l[crow(r, hi)]; } } while (0)
        f32x16 pA0, pA1, pB0, pB1; float mnA, mnB, alA, alB; bf16x8 pa0, pa1, pa2, pa3;
        SLOAD(0, 0); asm volatile("s_waitcnt vmcnt(0)" ::: "memory"); SWRITE(0, 0); __syncthreads();
        qkt(pA0, pA1, K_lds, qr, r32, hi); partialSM(pA0, pA1, m_reg, mnA, alA);
        SLOAD(1, 1); if (2 < NT) SLOAD(0, 2);
        SWAIT(); SWRITE(1, 1); __syncthreads();
        for (int j = 1; j + 1 < NT; j += 2) {
            ASBAR(); qkt(pB0, pB1, K_lds + SHM_K, qr, r32, hi);
            finishSM(pA0, pA1, alA, l_reg, pa0, pa1, pa2, pa3); ASBAR();
            SLOAD(1, j + 2); ASBAR();
            pv_d0(o, vb0, pa0, pa1, pa2, pa3); partialSM(pB0, pB1, m_reg, mnB, alB);
            __syncthreads(); SWAIT(); SWRITE(0, 0);
            RESC(alB); __syncthreads();
            ASBAR(); qkt(pA0, pA1, K_lds, qr, r32, hi);
            finishSM(pB0, pB1, alB, l_reg, pa0, pa1, pa2, pa3); ASBAR();
            if (j + 3 < NT) SLOAD(0, j + 3); ASBAR();
            pv_d0(o, vb0 + SHM_V, pa0, pa1, pa2, pa3); partialSM(pA0, pA1, m_reg, mnA, alA);
            __syncthreads(); SWAIT(); SWRITE(1, 1);
            RESC(alA); __syncthreads();
        }
        ASBAR(); qkt(pB0, pB1, K_lds + SHM_K, qr, r32, hi);
        finishSM(pA0, pA1, alA, l_reg, pa0, pa1, pa2, pa3); ASBAR();
        pv_d0(o, vb0, pa0, pa1, pa2, pa3); partialSM(pB0, pB1, m_reg, mnB, alB);
        __syncthreads(); RESC(alB);
        finishSM(pB0, pB1, alB, l_reg, pa0, pa1, pa2, pa3); ASBAR();
        pv_d0(o, vb0 + SHM_V, pa0, pa1, pa2, pa3);
#undef SLOAD
#undef SWRITE
#undef SWAIT
#undef RESC
        int lane_e = lane; asm volatile("" : "+v"(lane_e)); const int r32e = lane_e & 31, hie = lane_e >> 5;
        if (hie == 0) li_l[r32e] = l_reg; asm volatile("s_waitcnt lgkmcnt(0)" ::: "memory");
        float rli[16];
#pragma unroll
        for (int r = 0; r < 16; ++r) rli[r] = __builtin_amdgcn_rcpf(li_l[crow(r, hie)]);
        if (m == 0) {
#pragma unroll
            for (int d0 = 0; d0 < 4; ++d0)
#pragma unroll
                for (int r = 0; r < 16; r += 2) stash[(wid * 32 + d0 * 8 + (r >> 1)) * 64 + lane_e] = cvtpk(o[d0][r] * rli[r], o[d0][r + 1] * rli[r + 1]);
        } else {
            const float lam = ld_f32_dev((const float*)(p.ws + WS_LAM) + l * 4), oml = ld_f32_dev((const float*)(p.ws + WS_LAM) + l * 4 + 1);
            float ss[16];
#pragma unroll
            for (int r = 0; r < 16; ++r) ss[r] = 0.f;
#pragma unroll
            for (int d0 = 0; d0 < 4; ++d0)
#pragma unroll
                for (int r = 0; r < 16; r += 2) { const unsigned w = stash[(wid * 32 + d0 * 8 + (r >> 1)) * 64 + lane_e];
                    o[d0][r] = bf_lo(w) - lam * o[d0][r] * rli[r]; o[d0][r + 1] = bf_hi(w) - lam * o[d0][r + 1] * rli[r + 1];
                    ss[r] += o[d0][r] * o[d0][r]; ss[r + 1] += o[d0][r + 1] * o[d0][r + 1]; }
#pragma unroll
            for (int r = 0; r < 16; ++r) { float q = ss[r]; q += __shfl_xor(q, 1); q += __shfl_xor(q, 2); q += __shfl_xor(q, 4); q += __shfl_xor(q, 8); q += __shfl_xor(q, 16);
                ss[r] = rsqrtf(q * (1.0f / 128.0f) + EPS) * oml; }
            const float* gs = p.in[I_GSUBLN] + l * 128;
            asm volatile("s_waitcnt lgkmcnt(0)" ::: "memory");
            LAS bf16_t* ot = (LAS bf16_t*)(stash + wid * 32 * 64);
#pragma unroll
            for (int d0 = 0; d0 < 4; ++d0) { const float g = gs[d0 * 32 + r32e];
#pragma unroll
                for (int r = 0; r < 16; ++r) ot[((r & 3) + 8 * (r >> 2) + 4 * hie) * 128 + d0 * 32 + r32e] = (bf16_t)(cvtpk(o[d0][r] * ss[r] * g, 0.f) & 0xffffu); }
            asm volatile("s_waitcnt lgkmcnt(0)" ::: "memory");
            { bf16_t* dst = QB + (size_t)(qrow0 + wid * 32) * 512 + h * 128;
#pragma unroll
              for (int i = 0; i < 8; ++i) { const int row = i * 4 + (lane_e >> 4), pc = (lane_e & 15) * 8;
                  *(u32x4*)(dst + (size_t)row * 512 + pc) = *(const LAS u32x4*)(ot + row * 128 + pc); } }
        }
        __syncthreads();
    }
}
}
__device__ __forceinline__ void gmlp_unit(const Params& p, int l, int r0, LAS unsigned char* lds) {
    int tid_ = threadIdx.x; asm volatile("" : "+v"(tid_));
    const int tid = tid_, wid = __builtin_amdgcn_readfirstlane(tid >> 6), lane = tid & 63, r32 = lane & 31, hi = lane >> 5;
    const bf16_t* VG = pbuf(p, P_VGB); bf16_t* UB = pbuf(p, P_UB);
    PSEC_BEGIN8();
    {
        const int sr = tid >> 4, sc = (tid & 15) * 8, vst0 = att::v_st(sr, sc);
        u32x4 x[4][4]; float rs[4];
#pragma unroll
        for (int k = 0; k < 4; ++k)
#pragma unroll
            for (int g = 0; g < 4; ++g) x[k][g] = *(const u32x4*)(VG + (size_t)(r0 + sr + 32 * k) * 512 + g * 128 + sc);
#pragma unroll
        for (int k = 0; k < 4; ++k) { float ss = 0.f;
#pragma unroll
            for (int g = 0; g < 4; ++g) { float v[8]; unpack8(x[k][g], v);
#pragma unroll
                for (int j = 0; j < 8; ++j) ss += v[j] * v[j]; }
            ss += __shfl_xor(ss, 1); ss += __shfl_xor(ss, 2); ss += __shfl_xor(ss, 4); ss += __shfl_xor(ss, 8);
            rs[k] = rsqrtf(ss * (1.0f / 512.0f) + EPS); }
#pragma unroll
        for (int k = 0; k < 4; ++k)
#pragma unroll
            for (int g = 0; g < 4; ++g) { float v[8]; unpack8(x[k][g], v);
#pragma unroll
                for (int j = 0; j < 8; ++j) v[j] *= rs[k];
                *(LAS u32x4*)(lds + (g * 2 + (k >> 1)) * att::SHM_V + (k & 1) * 8192 + vst0) = pack8(v); }
    }
    __syncthreads();
    const int rb = wid >> 1, dh = wid & 1;
    const int vb0 = (int)(uintptr_t)lds + att::v_rd_base(lane) + dh * 1024;
    LAS float* F = (LAS float*)(lds + 8 * att::SHM_V) + wid * 576;
    const bf16_t* Wsb = (const bf16_t*)(p.ws + WS_WSB) + (size_t)l * 4 * 16384 + (size_t)(32 * rb + r32) * 128 + 8 * hi;
#pragma unroll 1
    for (int g = 0; g < 4; ++g) {
        bf16x8 pa[2][4];
#pragma unroll
        for (int kt = 0; kt < 2; ++kt)
#pragma unroll
            for (int k4 = 0; k4 < 4; ++k4) pa[kt][k4] = *(const bf16x8*)(Wsb + (size_t)g * 16384 + 64 * kt + 16 * k4);
        bf16_t* up = UB + (size_t)(r0 + 32 * rb + (lane >> 2)) * 512 + g * 128 + 64 * dh + 8 * (lane & 3);
        u32x4 uu[2][2];
#pragma unroll
        for (int d0 = 0; d0 < 2; ++d0)
#pragma unroll
            for (int rd = 0; rd < 2; ++rd) uu[d0][rd] = *(const u32x4*)(up + (size_t)(16 * rd) * 512 + 32 * d0);
        const float* gv = p.in[I_GGV] + l * 512 + g * 128 + 64 * dh + r32; const float* bs = p.in[I_BGS] + (l * 4 + g) * 128 + 32 * rb;
        const float gv0 = gv[0], gv1 = gv[32];
        float bsv[16];
#pragma unroll
        for (int r = 0; r < 16; ++r) bsv[r] = bs[crow(r, hi)];
        __builtin_amdgcn_sched_barrier(0);
        f32x16 o[2] = {};
        att::pv_one<0>(o[0], vb0 + (g * 2) * att::SHM_V, pa[0][0], pa[0][1], pa[0][2], pa[0][3]); att::pv_one<1>(o[1], vb0 + (g * 2) * att::SHM_V, pa[0][0], pa[0][1], pa[0][2], pa[0][3]);
        att::pv_one<0>(o[0], vb0 + (g * 2 + 1) * att::SHM_V, pa[1][0], pa[1][1], pa[1][2], pa[1][3]); att::pv_one<1>(o[1], vb0 + (g * 2 + 1) * att::SHM_V, pa[1][0], pa[1][1], pa[1][2], pa[1][3]);
#pragma unroll
        for (int d0 = 0; d0 < 2; ++d0)
#pragma unroll
            for (int rd = 0; rd < 2; ++rd) {
#pragma unroll
                for (int r = 0; r < 8; ++r) { const int rr = 8 * rd + r; F[((r & 3) + 8 * ((r >> 2) & 1) + 4 * hi) * 36 + r32] = o[d0][rr] * (d0 ? gv1 : gv0) + bsv[rr]; }
                asm volatile("s_waitcnt lgkmcnt(0)" ::: "memory");
                const f32x4 m0 = *(const LAS f32x4*)(F + (lane >> 2) * 36 + 8 * (lane & 3)), m1 = *(const LAS f32x4*)(F + (lane >> 2) * 36 + 8 * (lane & 3) + 4);
                float u8[8]; unpack8(uu[d0][rd], u8);
#pragma unroll
                for (int j = 0; j < 4; ++j) { u8[j] *= m0[j]; u8[4 + j] *= m1[j]; }
                *(u32x4*)(up + (size_t)(16 * rd) * 512 + 32 * d0) = pack8(u8);
                asm volatile("s_waitcnt lgkmcnt(0)" ::: "memory");
            }
    }
    __syncthreads();
    PSEC(8);
}
constexpr int N_PHASES = 36;
typedef const __attribute__((address_space(4))) Params* KParams;
#define PHASE_P() const Params& p = *(const Params*)opaque_kp()
__device__ __forceinline__ KParams opaque_kp() { KParams q = (KParams)__builtin_amdgcn_kernarg_segment_ptr(); asm volatile("" : "+s"(q)); return q; }
__global__ void __launch_bounds__(NTHR, 2) mk_fwd(Params p_arg, int bar_region) {
    extern __shared__ __attribute__((aligned(16))) unsigned char lds_raw[];
    LAS unsigned char* lds = (LAS unsigned char*)lds_raw;
    const int tid = threadIdx.x, G = gridDim.x, bid = blockIdx.x;
    volatile LAS unsigned* xbw = (volatile LAS unsigned*)(lds + LDS_BYTES - 16);
    if (tid == 0) { xbw[0] = 0u; xbw[1] = 0u; xbw[2] = 0u; xbw[3] = 0u; }
    __syncthreads();
    (void)xcd_barrier_post((unsigned*)(p_arg.ws + WS_CTL) + CW_BAR + bar_region * 4096, xbw);
    const int lo = p_arg.ph_lo, hi = p_arg.ph_hi;
#define IN(k) (lo <= (k) && (k) < hi)
#ifdef PROBE
#define STAMP(k) do { if (tid == 0) { if (bid == 0) ((unsigned long long*)(opaque_kp()->ws + WS_CTL))[30000 + (k)] = __builtin_amdgcn_s_memrealtime(); *(volatile LAS int*)(lds + LDS_BYTES - 32) = (k); } __syncthreads(); } while (0)
#else
#define STAMP(k) do { } while (0)
#endif
#define GRID_BARRIER() do { KParams kq = opaque_kp(); XcdBarrier b_; b_.bar = (unsigned*)(kq->ws + WS_CTL) + CW_BAR + ((const __attribute__((address_space(4))) int*)(kq + 1))[0] * 4096; b_.x = xb_xcc_id(); b_.st = xbw; xcd_barrier(b_); } while (0)
#define SEAM(k) do { if (IN(k) && IN((k) + 1)) { GRID_BARRIER(); STAMP((k) + 1); } } while (0)

    STAMP(0);
#if !defined(ONLY) || ONLY == 0
    if (IN(0)) { PHASE_P(); phase_prologue(p, lds); }
#endif
    SEAM(0);
    for (int l = 0; l < 2; ++l) {
        const int base = 1 + 17 * l;
#if !defined(ONLY) || ONLY == 1
        if (IN(base)) { PHASE_P(); phase_norm1(p, l); }
#endif
        SEAM(base);
        for (int hf = 0; hf < 2; ++hf) {
            const int hb = base + 1 + 6 * hf;
#if !defined(ONLY) || ONLY == 2
            if (IN(hb)) {
                PHASE_P(); unsigned char* ws = p.ws; bf16_t* Hh = (bf16_t*)(ws + WS_H) + (size_t)hf * MH * 1024; (void)Hh;
                const float* cosT = (const float*)(ws + WS_ROPE); const float* sinT = cosT + 1024;
                pg8::Gemm g{Hh, (const bf16_t*)(ws + WS_WTIN) + (size_t)l * NCOL * 1024, MH, NCOL, 1024};
                int cin = bid; if (hf == 1) { cin += G >> 1; if (cin >= G) cin -= G; }
                RectOrder S; if (l == 0) S.init(72, 14, 0, 0, 0, 0, G, cin); else S.init(64, 14, 8, 8, 6, 0, G, cin);
                EpiIn E{pbuf(p, 0), pbuf(p, P_GB), cosT, sinT};
                pg8::gemm_phase<EpiIn, RectOrder>((PG8_LAS unsigned char*)lds, g, S, E, nullptr);
                pg8::Gemm g8{(const bf16_t*)(ws + WS_H8 + (size_t)hf * MH * 1024), (const bf16_t*)(ws + WS_WTIN8 + (size_t)l * 3072 * 1024), MH, 3072, 512};
                RectOrder S8; S8.init(l == 0 ? 72 : 64, 12, l == 0 ? 0 : 8, 0, 0, 0, G, G - 1 - cin);
                EpiGate8 E8{pbuf(p, P_GB)};
                pg8::gemm_phase<EpiGate8, RectOrder, false, true>((PG8_LAS unsigned char*)lds, g8, S8, E8, nullptr);
            }
#endif
            SEAM(hb);
#if !defined(ONLY) || ONLY == 3
            if (IN(hb + 1)) {
                PSEC_BEGIN6();
                { PHASE_P(); phase_conv(p, l, lds); }
                PSEC(6);
                GRID_BARRIER(); PSEC(7);
                PHASE_P();
                const int n_a = HBAT * NJ * 4, n_g = HBAT * 16 + (l == 0 ? HBAT * 2 : 0);
                const int bidx = (G == 256) ? ((bid & 7) * 32 + (bid >> 3)) : bid;
                int u = bidx;
                PSEC(13);
                { u32x4 qa[4], qb[4], qwq[4], qwk[4], qwv[4]; f32x4 qg; mlstm_a_load(p, l, u < n_a ? u : 0, APRE_ARGS);
                  for (; u < n_a; u += G) mlstm_a_unit(p, l, u, u + G, n_a, APRE_ARGS, lds); }
                PSEC(14);
                for (; u < n_a + n_g; u += G) { const int v = u - n_a; int r0; if (v < HBAT * 16) r0 = CTXROWS + (v >> 4) * 2048 + (v & 15) * 128; else { const int w = v - HBAT * 16; r0 = (w >> 1) * 256 + (w & 1) * 128; }
                    gmlp_unit(p, l, r0, lds); }
            }
#endif
            SEAM(hb + 1);
#if !defined(ONLY) || ONLY == 4
            if (IN(hb + 2)) {
                PHASE_P();
                phase_scan(p);
            }
#endif
            SEAM(hb + 2);
#if !defined(ONLY) || ONLY == 5
            if (IN(hb + 3)) {
                PHASE_P();
                const int n_l = HBAT * 4 * 8, n_c = (l == 0 ? HBAT * 4 : 0);
                for (int u = bid; u < n_l + n_c; u += G) {
                    int h, qrow0, rc, rl, NT;
                    if (u < n_l) { const int ue = (G == 256) ? ((((u & 7) * 4 + (u >> 6)) << 3) | ((u >> 3) & 7)) : u;
                        const int bl = ue >> 5, qb = ue & 7; h = (ue >> 3) & 3; qrow0 = CTXROWS + bl * 2048 + qb * 256; rc = bl * 256; rl = CTXROWS + bl * 2048; NT = 36; }
                    else { const int v = u - n_l, bl = v >> 2; h = v & 3; qrow0 = bl * 256; rc = bl * 256; rl = 0; NT = 4; }
                    PSEC_BEGINN(9); att::attn_unit(p, l, h, qrow0, rc, rl, NT, lds); PSEC(9);
                }
                const int m_l = HBAT * 16 * 4, m_c = (l == 0 ? HBAT * 2 * 4 : 0);
                int u0 = bid + 192; if (u0 >= G) u0 -= G;
                for (int u = u0; u < m_l + m_c; u += G) {
                    int bl, J, h;
                    if (u < m_l) { const int rem = u & 63; bl = u >> 6; J = 2 + (rem >> 2); h = rem & 3; }
                    else { const int v = u - m_l, rem = v & 7; bl = v >> 3; J = rem >> 2; h = rem & 3; }
                    PSEC_BEGINN(10); mlstm_c_unit(p, l, bl, J, h, lds); PSEC(10);
                }
                if (l == 0 && G == 256 && !(bid >= 64 && bid < 128)) cvt_fill(p, lds, hf == 0 ? 0 : CVT_Q1, hf == 0 ? CVT_Q0 : CVT_Q2, bid < 64 ? bid : bid - 64, 192);
                else if (l == 0 && G != 256) cvt_fill(p, lds, hf == 0 ? 0 : CVT_Q1, hf == 0 ? CVT_Q0 : CVT_Q2, bid, G);
            }
#endif
            SEAM(hb + 3);
#if !defined(ONLY) || ONLY == 6
            if (IN(hb + 4)) {
                PHASE_P(); unsigned char* ws = p.ws; bf16_t* Hh = (bf16_t*)(ws + WS_H) + (size_t)hf * MH * 1024; (void)Hh;
                pg8::Gemm g{pbuf(p, P_QB), (const bf16_t*)(ws + WS_WTBR) + (size_t)l * 3072 * 512, 3 * MH, 3072, 512};
                MergeOrder S; S.init(l == 0 ? 72 : 64, l == 0 ? 0 : 8, G, bid);
                EpiMerge E{pbuf(p, P_GB), Hh};
                pg8::gemm_phase<EpiMerge, MergeOrder>((PG8_LAS unsigned char*)lds, g, S, E, nullptr);
                if (l == 0) { const int skip = G > 64 ? 32 : 0; __syncthreads(); if (bid >= skip) cvt_fill(p, lds, hf == 0 ? CVT_Q0 : CVT_Q2, hf == 0 ? CVT_Q1 : CVT_Q3, bid - skip, G - skip); }
            }
#endif
            SEAM(hb + 4);
#if !defined(ONLY) || ONLY == 7
            if (IN(hb + 5)) {
                PHASE_P(); unsigned char* ws = p.ws; bf16_t* Hh = (bf16_t*)(ws + WS_H) + (size_t)hf * MH * 1024; (void)Hh;
                pg8::Gemm g{Hh, (const bf16_t*)(ws + WS_WTO) + (size_t)l * 1024 * 1024, MH, 1024, 1024};
                RectOrder S; S.init(l == 0 ? 72 : 64, 4, l == 0 ? 0 : 8, 0, 0, 0, G, bid);
                EpiOut E{l == 0 ? p.in[I_X] : (const float*)p.out, l == 0 ? p.in[I_CTX] : (const float*)(ws + WS_XC), p.out, (float*)(ws + WS_XC), (const float*)(ws + WS_MOD) + (size_t)l * 17 * 6144, hf};
                pg8::gemm_phase<EpiOut, RectOrder>((PG8_LAS unsigned char*)lds, g, S, E, nullptr);
                if (l == 0 && hf == 1) { const int skip = G > 64 ? 32 : 0; __syncthreads(); if (bid >= skip) cvt_fill(p, lds, CVT_Q3, CVT_Q4, bid - skip, G - skip); }
            }
#endif
            if (hf == 1) SEAM(hb + 5);
        }
#if !defined(ONLY) || ONLY == 8
        if (IN(base + 13)) { PHASE_P(); phase_norm2_router(p, l, lds); if (l == 1) cvt_fill(p, lds, CVT_Q4, 2 * CVT_TILES, bid, G); }
#endif
        SEAM(base + 13);
#if !defined(ONLY) || ONLY == 9
        if (IN(base + 14)) { PHASE_P(); phase_dispatch(p, l, lds); }
#endif
        SEAM(base + 14);
#if !defined(ONLY) || ONLY == 10
        if (IN(base + 15)) {
            PHASE_P(); unsigned char* ws = p.ws;
            LAS int* seg = (LAS int*)(lds + 131072); LAS int* tile_e = seg + 128;
            const int nt = moe_tile_table(p, l, seg, tile_e);
            pg8::Gemm g{(const bf16_t*)(ws + WS_H8), (const bf16_t*)(ws + WS_WTGU + (size_t)l * 32 * 1024 * 1024), SLOTS, 32 * 1024, 512};
            MoeOrder S; S.init(tile_e, nt, G, bid);
            { LAS int* srcl = (LAS int*)(lds + 131072 + 2048); const int* SRC = (const int*)(ws + WS_SRC);
              for (int i = 0; i < 6; ++i) { int pm, pn; S.unit_of(i, pm, pn); for (int r = opaque_tid(); r < 256; r += NTHR) srcl[i * 256 + r] = pm < nt ? SRC[pm * 256 + r] : 0; }
              S.srcl = srcl; }
            __syncthreads(); EpiGU E{ws + WS_P + P_ACT};
            pg8::gemm_phase<EpiGU, MoeOrder, false, true, true>((PG8_LAS unsigned char*)lds, g, S, E, nullptr);
        }
#endif
        SEAM(base + 15);
#if !defined(ONLY) || ONLY == 11
        if (IN(base + 16)) {
            PHASE_P(); unsigned char* ws = p.ws;
            LAS int* seg = (LAS int*)(lds + 131072); LAS int* tile_e = seg + 128;
            const int nt = moe_tile_table(p, l, seg, tile_e);
            pg8::Gemm g{pbuf(p, P_ACT), (const bf16_t*)(ws + WS_WTD + (size_t)l * 32 * 1024 * 512), SLOTS, 32 * 1024, 256};
            MoeOrder S; S.init(tile_e, nt, G, bid); __syncthreads(); EpiDown E{pbuf(p, P_YS)};
            pg8::gemm_phase<EpiDown, MoeOrder, false, true>((PG8_LAS unsigned char*)lds, g, S, E, nullptr);
        }
#endif
        SEAM(base + 16);
    }
#if !defined(ONLY) || ONLY == 12
    if (IN(35)) { PHASE_P(); phase_final(p); }
#endif
#ifdef PROBE
    if (bid == 0 && tid == 0) {
        asm volatile("s_waitcnt vmcnt(0)" ::: "memory");
        const unsigned long long tend = __builtin_amdgcn_s_memrealtime();
        volatile unsigned long long* st = (volatile unsigned long long*)(opaque_kp()->ws + WS_CTL) + 30000;
        unsigned long long ta = 0, tb = 0;
        for (int k = 0; k < N_PHASES; ++k) { const unsigned long long t0 = st[k], t1 = (k == N_PHASES - 1) ? tend : st[k + 1]; const unsigned long long d = t1 - t0;
            if ((PROBE_A >> k) & 1ull) ta += d; if ((PROBE_B >> k) & 1ull) tb += st[100 + k]; }
        const unsigned long long spin = ((ta + tb) / 1000ull) * 100000ull;
        while (__builtin_amdgcn_s_memrealtime() - tend < spin) __builtin_amdgcn_s_sleep(32);
    }
#endif
#undef IN
#undef SEAM
}

#ifndef MK_CUTS
#define MK_CUTS 0
#endif
extern "C" void kernel_launch(void* const* d_in, const int* in_sizes, int n_in, void* d_out, int out_size, void* d_ws, size_t ws_size, hipStream_t stream) {
    static int grid = 0;
    if (grid == 0) {
        if (n_in != 31 || in_sizes[0] != NBATCH * SEQ * DM || out_size != NBATCH * SEQ * DM || ws_size < WS_END) {
            fprintf(stderr, "kernel_launch: unexpected shapes or workspace (n_in %d, ws %zu, need %zu); nothing launched\n", n_in, ws_size, (size_t)WS_END); grid = -1; return; }
        int dev = 0, cus = 0, per_cu = 0;
        if (hipGetDevice(&dev) != hipSuccess || hipDeviceGetAttribute(&cus, hipDeviceAttributeMultiprocessorCount, dev) != hipSuccess) { grid = -1; return; }
        if (hipFuncSetAttribute((const void*)mk_fwd, hipFuncAttributeMaxDynamicSharedMemorySize, LDS_BYTES) != hipSuccess) { fprintf(stderr, "kernel_launch: hipFuncSetAttribute failed\n"); grid = -1; return; }
        if (hipOccupancyMaxActiveBlocksPerMultiprocessor(&per_cu, (const void*)mk_fwd, NTHR, LDS_BYTES) != hipSuccess || per_cu < 1) { fprintf(stderr, "kernel_launch: occupancy query says %d\n", per_cu); }
        (void)hipGetLastError();
        grid = cus;
    }
    if (grid < 0) return;
    if (hipMemsetAsync((char*)d_ws + WS_CTL, 0, CTL_BYTES, stream) != hipSuccess) return;
    Params p{};
    for (int i = 0; i < 31; ++i) p.in[i] = (const float*)d_in[i];
    p.out = (float*)d_out; p.ws = (unsigned char*)d_ws;
#if MK_CUTS == 0
    p.ph_lo = 0; p.ph_hi = N_PHASES;
    hipLaunchKernelGGL(mk_fwd, dim3(grid), dim3(NTHR), LDS_BYTES, stream, p, 0);
#else
    for (int k = 0; k < N_PHASES; ++k) {
#ifdef EXP_NOMOE
        if ((k >= 14 && k <= 17) || (k >= 31 && k <= 34)) continue;
#endif
#ifdef EXP_NOEXPERT
        if (k == 16 || k == 17 || k == 33 || k == 34) continue;
#endif
#ifdef EXP_NOGU
        if (k == 16 || k == 33) continue;
#endif
#ifdef EXP_NOMIX
        if ((k >= 2 && k <= 13) || (k >= 19 && k <= 30)) continue;
#endif
#ifdef EXP_ZEROXB
        if (k == 15 || k == 32) { hipMemsetAsync((char*)d_ws + WS_P + P_XB, 0, P_MOE_END, stream); hipMemsetAsync((char*)d_ws + WS_WTS, 0, (size_t)SLOTS * 4, stream); }
#endif
        p.ph_lo = k; p.ph_hi = k + 1; hipLaunchKernelGGL(mk_fwd, dim3(grid), dim3(NTHR), LDS_BYTES, stream, p, 0); }
#endif
}
```

```cpp
#include <hip/hip_runtime.h>
#include <cstdio>
#include <cstdint>

#define LAS __attribute__((address_space(3)))
typedef unsigned short bf16_t;
typedef short bf16x8 __attribute__((ext_vector_type(8)));
typedef short s16x4 __attribute__((ext_vector_type(4)));
typedef float f32x2 __attribute__((ext_vector_type(2)));
typedef float f32x4 __attribute__((ext_vector_type(4)));
typedef float f32x16 __attribute__((ext_vector_type(16)));
typedef unsigned u32x2 __attribute__((ext_vector_type(2)));
typedef unsigned u32x4 __attribute__((ext_vector_type(4)));

constexpr int DM = 1024, NBATCH = 16, SEQ = 2048, CTXL = 256, NCOL = 6656;
constexpr int HBAT = 8;
constexpr int MH = HBAT * (SEQ + CTXL);
constexpr int MTOT = 2 * MH;
constexpr int CTXROWS = HBAT * CTXL;
constexpr int NJ = 18;
constexpr int NEXP = 32, DEXP = 512;
constexpr int SLOTS = 81920;
constexpr float EPS = 1e-6f;
constexpr float LOG2E = 1.4426950408889634f;
constexpr float QSCALE = 0.125f * LOG2E;
constexpr int NTHR = 512;
constexpr int LDS_BYTES = 155648;
constexpr int TLD = 136;
constexpr int TILE_B = 128 * TLD * 2;

constexpr size_t AL(size_t x) { return (x + 255) / 256 * 256; }
constexpr size_t WS_CTL   = 0;
constexpr size_t CTL_BYTES = 262144;
constexpr size_t WS_MOD   = WS_CTL + CTL_BYTES;
constexpr size_t WS_WFOLD = WS_MOD + AL((size_t)2 * 17 * 6144 * 4);
constexpr size_t WS_ROPE  = WS_WFOLD + AL((size_t)2 * 16 * 1024 * 4);
constexpr size_t WS_LAM   = WS_ROPE + AL((size_t)2 * 64 * 16 * 4);
constexpr size_t WS_WRT   = WS_LAM + 256;
constexpr size_t WS_WTIN  = WS_WRT + AL((size_t)2 * 2 * 48 * 1024 * 2);
constexpr size_t WS_WTBR  = WS_WTIN + AL((size_t)2 * NCOL * 1024 * 2);
constexpr size_t WS_WTO   = WS_WTBR + AL((size_t)2 * 3072 * 512 * 2);
constexpr size_t WS_WTQKV = WS_WTO + AL((size_t)2 * 1024 * 1024 * 2);
constexpr size_t WS_WSB   = WS_WTQKV + AL((size_t)2 * 12 * 16384 * 2);
constexpr size_t WS_WTGU  = WS_WSB + AL((size_t)2 * 4 * 16384 * 2);
constexpr size_t WS_WTD   = WS_WTGU + AL((size_t)32 * 1024 * 1024 * 2);
constexpr size_t WS_XC    = WS_WTD + AL((size_t)32 * 1024 * 512 * 2);
constexpr size_t WS_H     = WS_XC + AL((size_t)4096 * 1024 * 4);
constexpr size_t WS_H8    = WS_H + AL((size_t)MTOT * 1024 * 2);
constexpr size_t WS_WTIN8 = WS_H8 + AL((size_t)MTOT * 1024);
constexpr size_t WS_EID   = WS_WTIN8 + AL((size_t)2 * 3072 * 1024);
constexpr size_t WS_WTK   = WS_EID + AL((size_t)MTOT * 8);
constexpr size_t WS_POS   = WS_WTK + AL((size_t)MTOT * 8);
constexpr size_t WS_WTS   = WS_POS + AL((size_t)MTOT * 8);
constexpr size_t WS_SRC   = WS_WTS + AL((size_t)SLOTS * 4);
constexpr size_t WS_P     = WS_SRC + AL((size_t)SLOTS * 4);
constexpr size_t S1B      = (size_t)MH * 512 * 2;
constexpr size_t P_KB = 0, P_VB = S1B, P_XMB = 2 * S1B, P_QB = 3 * S1B, P_UB = 4 * S1B, P_ZB = 5 * S1B, P_VGB = 6 * S1B;
constexpr size_t P_GB   = 7 * S1B;
constexpr size_t P_MQ   = P_GB + (size_t)3 * MH * 1024;
constexpr size_t P_MK   = P_MQ + S1B, P_MVT = P_MK + S1B, P_XCV = P_MVT + S1B;
constexpr size_t P_GATES = P_XCV + S1B;
constexpr size_t P_CLOC = P_GATES + AL((size_t)MH * 16 * 4);
constexpr size_t P_NLOC = P_CLOC + (size_t)64 * NJ * 16384 * 2;
constexpr size_t P_MST  = P_NLOC + AL((size_t)64 * NJ * 128 * 4);
constexpr size_t P_END  = P_MST + AL((size_t)64 * NJ * 4 * 4);
constexpr size_t P_XB   = 0;
constexpr size_t P_ACT  = (size_t)SLOTS * 1024;
constexpr size_t P_YS   = P_ACT + (size_t)SLOTS * 512;
constexpr size_t P_MOE_END = P_YS + (size_t)SLOTS * 1024 * 2;
constexpr float WSCALE8 = 635.0f, HSCALE8 = 10.5f, ASCALE8 = 16.0f;
constexpr size_t WS_END = WS_P + (P_END > P_MOE_END ? P_END : P_MOE_END);
constexpr int CW_EXPCNT = 0;
constexpr int CW_HIST = 32768;
constexpr int CW_BAR = 1024;

__device__ __forceinline__ unsigned cvtpk(float lo, float hi) { unsigned r; asm volatile("v_cvt_pk_bf16_f32 %0, %1, %2" : "=v"(r) : "v"(lo), "v"(hi)); return r; }
__device__ __forceinline__ float bf_lo(unsigned w) { return __uint_as_float(w << 16); }
__device__ __forceinline__ float bf_hi(unsigned w) { return __uint_as_float(w & 0xffff0000u); }
__device__ __forceinline__ float bf2f(bf16_t b) { return __uint_as_float(((unsigned)b) << 16); }
__device__ __forceinline__ bf16_t f2bf(float f) { unsigned u = __float_as_uint(f); u += 0x7FFFu + ((u >> 16) & 1u); return (bf16_t)(u >> 16); }
__device__ __forceinline__ float sigmoid_f(float x) { return __builtin_amdgcn_rcpf(1.0f + __builtin_amdgcn_exp2f(-x * LOG2E)); }
__device__ __forceinline__ float gelu_tanh_f(float x) { const float u = 0.7978845608028654f * (x + 0.044715f * x * x * x); return x * sigmoid_f(2.0f * u); }
__device__ __forceinline__ float silu_f(float x) { return x * sigmoid_f(x); }
__device__ __forceinline__ float logsigmoid_f(float x) { return fminf(x, 0.f) - 0.6931471805599453f * __builtin_amdgcn_logf(1.0f + __builtin_amdgcn_exp2f(-fabsf(x) * LOG2E)); }
__device__ __forceinline__ int crow(int r, int hi) { return (r & 3) + 8 * (r >> 2) + 4 * hi; }
__device__ __forceinline__ f32x16 mfma32(bf16x8 a, bf16x8 b, f32x16 c) { return __builtin_amdgcn_mfma_f32_32x32x16_bf16(a, b, c, 0, 0, 0); }
__device__ __forceinline__ float wave_sum(float v) { for (int o = 32; o >= 1; o >>= 1) v += __shfl_xor(v, o); return v; }
template <int CTRL, int ROWMASK> __device__ __forceinline__ float dpp_add(float v) {
    return v + __builtin_bit_cast(float, __builtin_amdgcn_update_dpp(0, __builtin_bit_cast(int, v), CTRL, ROWMASK, 0xf, true)); }
__device__ __forceinline__ float wave_sum63(float v) {
    v = dpp_add<0x111, 0xf>(v); v = dpp_add<0x112, 0xf>(v); v = dpp_add<0x114, 0xf>(v); v = dpp_add<0x118, 0xf>(v);
    v = dpp_add<0x142, 0xa>(v);
    v = dpp_add<0x143, 0xc>(v);
    return v; }
__device__ __forceinline__ float half_sum31(float v) {
    v = dpp_add<0x111, 0xf>(v); v = dpp_add<0x112, 0xf>(v); v = dpp_add<0x114, 0xf>(v); v = dpp_add<0x118, 0xf>(v);
    v = dpp_add<0x142, 0xa>(v); return v; }
__device__ __forceinline__ float wave_max(float v) { for (int o = 32; o >= 1; o >>= 1) v = fmaxf(v, __shfl_xor(v, o)); return v; }

__device__ __forceinline__ void unpack8(const u32x4 w, float (&o)[8]) { o[0] = bf_lo(w.x); o[1] = bf_hi(w.x); o[2] = bf_lo(w.y); o[3] = bf_hi(w.y); o[4] = bf_lo(w.z); o[5] = bf_hi(w.z); o[6] = bf_lo(w.w); o[7] = bf_hi(w.w); }
__device__ __forceinline__ u32x4 pack8(const float (&v)[8]) { u32x4 w; w.x = cvtpk(v[0], v[1]); w.y = cvtpk(v[2], v[3]); w.z = cvtpk(v[4], v[5]); w.w = cvtpk(v[6], v[7]); return w; }
__device__ __forceinline__ int ld_i32_dev(const int* p) { return __hip_atomic_load(p, __ATOMIC_RELAXED, __HIP_MEMORY_SCOPE_AGENT); }
__device__ __forceinline__ float ld_f32_dev(const float* p) { return __hip_atomic_load(p, __ATOMIC_RELAXED, __HIP_MEMORY_SCOPE_AGENT); }
__device__ __forceinline__ unsigned q8(float x) { return (unsigned)(int)fminf(fmaxf(rintf(x), -127.0f), 127.0f) & 0xffu; }
__device__ __forceinline__ unsigned pk4_fp8(float a, float b, float c, float d) { return q8(a) | (q8(b) << 8) | (q8(c) << 16) | (q8(d) << 24); }
#define LBAR() do { asm volatile("s_waitcnt lgkmcnt(0)" ::: "memory"); __builtin_amdgcn_s_barrier(); asm volatile("" ::: "memory"); } while (0)
__device__ __forceinline__ int opaque_tid() { int t = threadIdx.x; asm volatile("" : "+v"(t)); return t; }
#ifdef PROBE
__device__ __forceinline__ unsigned long long* probe_epi_counter() {
    unsigned char* ws = *(unsigned char* const __attribute__((address_space(4)))*)((const __attribute__((address_space(4))) char*)__builtin_amdgcn_kernarg_segment_ptr() + 256);
    const int ph = *(volatile LAS int*)(uintptr_t)(LDS_BYTES - 32);
    return (unsigned long long*)ws + 30100 + ph; }
#endif
#ifdef PROBE
#define PSEC_BEGIN() unsigned pt_ = 0; if (PROBE_SEC == 1) pt_ = (unsigned)__builtin_amdgcn_s_memrealtime()
#define PSEC_BEGINN(n) unsigned pt_ = 0; if (PROBE_SEC == (n)) pt_ = (unsigned)__builtin_amdgcn_s_memrealtime()
#define PSEC_BEGIN6() unsigned pt_ = 0; if (PROBE_SEC == 6) pt_ = (unsigned)__builtin_amdgcn_s_memrealtime()
#define PSEC_BEGIN8() unsigned pt_ = 0; if (PROBE_SEC == 8) pt_ = (unsigned)__builtin_amdgcn_s_memrealtime()
#define PSEC(id) do { if (PROBE_SEC == (id)) { const unsigned pn_ = (unsigned)__builtin_amdgcn_s_memrealtime(); if (blockIdx.x == PROBE_BLK && tid == 0) *probe_epi_counter() += (unsigned long long)(pn_ - pt_); } if (PROBE_SEC == (id) + 1) pt_ = (unsigned)__builtin_amdgcn_s_memrealtime(); } while (0)
#else
#define PSEC_BEGIN() do { } while (0)
#define PSEC_BEGIN6() do { } while (0)
#define PSEC_BEGINN(n) do { } while (0)
#define PSEC_BEGIN8() do { } while (0)
#define PSEC(id) do { } while (0)
#endif
struct Params {
    const float* in[31];
    float* out;
    unsigned char* ws;
    int ph_lo, ph_hi;
};
enum { I_X = 0, I_C, I_CTX, I_CCTX, I_WMOD, I_BMOD, I_GN1, I_GN2, I_WIN, I_DLAM, I_GSUBLN, I_WGS, I_BGS, I_GGV, I_WCONV, I_BCONV, I_WQKV, I_WIF, I_BIF,
       I_GMN, I_SKIP, I_WBR, I_WOUT, I_WRG, I_BRG, I_WRE, I_BRE, I_WEG, I_WEU, I_WED, I_GFIN };

struct RowInfo { int hf, r, isctx, b, t; };
__device__ __forceinline__ RowInfo row_info(int R) {
    RowInfo q; q.hf = R >= MH ? 1 : 0; q.r = R - q.hf * MH;
    if (q.r < CTXROWS) { q.isctx = 1; q.b = q.hf * HBAT + (q.r >> 8); q.t = q.r & 255; }
    else { q.isctx = 0; const int s = q.r - CTXROWS; q.b = q.hf * HBAT + (s >> 11); q.t = s & 2047; }
    return q;
}
#define XB_TMO      128
#define XB_XCNT(j)  (256  + 64 * (j))
#define XB_XSUB(j)  (1280 + 64 * (j))
#define XB_XGEN(j)  (2304 + 64 * (j))
#define XB_TOP      3328
#define XB_TOPGEN   3392
#define XCD_BAR_WORDS 3456
#define XB_SPIN_CAP (1u << 18)

__device__ __forceinline__ unsigned xb_ld(unsigned* p)              { return __hip_atomic_load(p, __ATOMIC_RELAXED, __HIP_MEMORY_SCOPE_AGENT); }
__device__ __forceinline__ unsigned xb_add(unsigned* p, unsigned v) { return __hip_atomic_fetch_add(p, v, __ATOMIC_RELAXED, __HIP_MEMORY_SCOPE_AGENT); }
__device__ __forceinline__ unsigned xb_xcc_id() { return (unsigned)__builtin_amdgcn_s_getreg((3 << 11) | 20) & 0xFu; }
#define XB_SPIN(cond, bar) do { unsigned _sp = 0; while (cond) { __builtin_amdgcn_s_sleep(1); \
    if ((++_sp & 255u) == 0u) { if (xb_ld(&(bar)[XB_TMO])) break; if (_sp > XB_SPIN_CAP) { atomicAdd(&(bar)[XB_TMO], 1u); break; } } } } while (0)

struct XcdBarrier {
    unsigned* bar; unsigned x;
    volatile LAS unsigned* st;
};

__device__ __forceinline__ XcdBarrier xcd_barrier_post(unsigned* bar, volatile LAS unsigned* st) {
    XcdBarrier b; b.bar = bar; b.x = xb_xcc_id(); b.st = st;
    if (threadIdx.x == 0) (void)xb_add(&bar[XB_XCNT(b.x)], 1u);
    return b;
}
__device__ __forceinline__ void xcd_barrier_complete(unsigned* bar, unsigned x, unsigned& nloc, unsigned& nx) {
    const unsigned G = gridDim.x * gridDim.y * gridDim.z;
    unsigned sum, cnt, mine, sp = 0u;
    for (;;) {
        sum = 0u; cnt = 0u; mine = 0u;
#pragma unroll
        for (unsigned j = 0; j < 16; ++j) { const unsigned c = xb_ld(&bar[XB_XCNT(j)]); sum += c; cnt += (c > 0u) ? 1u : 0u; mine = (j == x) ? c : mine; }
        if (sum == G) break;
        __builtin_amdgcn_s_sleep(1);
        if ((++sp & 255u) == 0u) { if (xb_ld(&bar[XB_TMO])) break; if (sp > XB_SPIN_CAP) { atomicAdd(&bar[XB_TMO], 1u); break; } }
    }
    nloc = mine > 0u ? mine : 1u; nx = cnt > 0u ? cnt : 1u;
}

__device__ __forceinline__ void xcd_barrier(const XcdBarrier& b) {
    asm volatile("s_waitcnt vmcnt(0)" ::: "memory");
    __syncthreads();
    if (threadIdx.x == 0) {
        unsigned* bar = b.bar;
        __builtin_amdgcn_s_waitcnt(0);
        unsigned nloc = b.st[0], nx = b.st[1];
        if (nloc == 0u) { xcd_barrier_complete(bar, b.x, nloc, nx); b.st[0] = nloc; b.st[1] = nx; }
        const unsigned old = xb_add(&bar[XB_XSUB(b.x)], 1u);
        const unsigned gen = old / nloc;
        if (old + 1u == (gen + 1u) * nloc) {
            __builtin_amdgcn_fence(__ATOMIC_RELEASE, "agent");
            asm volatile("s_waitcnt vmcnt(0)" ::: "memory");
            const unsigned og = xb_add(&bar[XB_TOP], 1u);
            const unsigned tg = og / nx;
            if (og + 1u == (tg + 1u) * nx) xb_add(&bar[XB_TOPGEN], 1u);
            else XB_SPIN(xb_ld(&bar[XB_TOPGEN]) == tg, bar);
            __builtin_amdgcn_fence(__ATOMIC_ACQUIRE, "agent");
            xb_add(&bar[XB_XGEN(b.x)], 1u);
            asm volatile("s_waitcnt vmcnt(0)" ::: "memory");
        } else {
            XB_SPIN(xb_ld(&bar[XB_XGEN(b.x)]) == gen, bar);
            __builtin_amdgcn_fence(__ATOMIC_ACQUIRE, "agent");
            asm volatile("s_waitcnt vmcnt(0)" ::: "memory");
        }
    }
    __syncthreads();
}
namespace pg8 {
#define PG8_LAS __attribute__((address_space(3)))
typedef unsigned short bf16_t;
typedef short bf16x8 __attribute__((ext_vector_type(8)));
typedef float f32x4 __attribute__((ext_vector_type(4)));
typedef unsigned u32x4 __attribute__((ext_vector_type(4)));
constexpr int BM = 256, BK = 64, HALF = 128, HTB = HALF * BK * 2  , STAGE_BYTES = 8 * HTB, NXCD = 8, WGM = 8;

__host__ __device__ __forceinline__ int lds_byte(int r, int c) { const int st = (r >> 4) * 2 + (c >> 5), rr = r & 15, cc = c & 31, ob = rr * 64 + cc * 2; return st * 1024 + (ob ^ (((ob >> 9) & 1) << 5)); }
__host__ __device__ __forceinline__ void stage_rc(int b, int& R, int& C) { const int st = b / 1024, sb = b % 1024, swz = sb ^ (((sb >> 9) & 1) << 5); R = (st >> 1) * 16 + swz / 64; C = (st & 1) * 32 + (swz % 64) / 2; }
__host__ __device__ __forceinline__ int perm32(int rho) { const int n = rho >> 4, i = rho & 15; return 8 * (i >> 2) + 4 * n + (i & 3); }

struct Unit { int pm, pn; };
struct Gemm { const bf16_t* A; const bf16_t* Bt; int M, N, K; };

struct StaticOrder {
    int nM, nN, nwg, G, c;
    __host__ __device__ void init(int M, int N, int G_, int c_) { nM = M / BM; nN = N / BM; nwg = nM * nN; G = G_; c = c_; }
    __host__ __device__ bool next(int i, Unit& u) const {
        const long L = (long)i * G + c; if (L >= nwg) return false;
        int wgid = (int)L; { const int q = nwg / NXCD, r = nwg % NXCD, xcd = wgid % NXCD, off = wgid / NXCD; wgid = (xcd < r ? xcd * (q + 1) : r * (q + 1) + (xcd - r) * q) + off; }
        const int nig = WGM * nN, gid = wgid / nig, fm = gid * WGM, gsz = (nM - fm) < WGM ? (nM - fm) : WGM;
        u.pm = fm + ((wgid % nig) % gsz); u.pn = (wgid % nig) / gsz; return true;
    }
    __device__ __forceinline__ void a_ready(const Unit&) const {}
    __device__ __forceinline__ void done(const Unit&) const {}
};
__device__ __forceinline__ unsigned cvt_pk_bf16(float lo, float hi) { unsigned r; asm volatile("v_cvt_pk_bf16_f32 %0, %1, %2" : "=v"(r) : "v"(lo), "v"(hi)); return r; }
typedef float f32x2 __attribute__((ext_vector_type(2)));
__device__ __forceinline__ f32x2 gelu_pk(f32x2 v) {
    const f32x2 av = __builtin_elementwise_abs(v), d = av * 0.2316418882f + 1.0f;
    f32x2 t; t.x = __builtin_amdgcn_rcpf(d.x); t.y = __builtin_amdgcn_rcpf(d.y);
    f32x2 q = t * 0.5307027145f + (-0.7265760135f); q = q * t + 0.7107068705f; q = q * t + (-0.142248368f); q = q * t + 0.127414796f; q = q * t;
    const f32x2 s = (v * v) * (-0.72134752044f);
    f32x2 e; e.x = __builtin_amdgcn_exp2f(s.x); e.y = __builtin_amdgcn_exp2f(s.y);
    const f32x2 m = v * (q * e), r = v - m;
    f32x2 o; o.x = v.x < 0.f ? m.x : r.x; o.y = v.y < 0.f ? m.y : r.y; return o;
}

typedef int pg8_i32x4 __attribute__((ext_vector_type(4)));
template <bool F8> struct Frag { bf16x8 k[2]; };
template <class Epi, class Sched, bool STAMP = false, bool F8 = false, bool GA = false>
__device__ __forceinline__ void gemm_phase(PG8_LAS unsigned char* lds, const Gemm g, const Sched& S, const Epi& E, unsigned long long* stamps) {
    int tid_o = threadIdx.x; asm volatile("" : "+v"(tid_o));
    const int tid = tid_o, wid = __builtin_amdgcn_readfirstlane(tid >> 6), lane = tid & 63, wr = wid >> 2, wc = wid & 3, fr = lane & 15, fq = lane >> 4;
    const int K = g.K, nt = K / BK;
    int ts_lo = 0, ts_hi = 0, nts = 0; const unsigned long long rt_entry = STAMP ? (unsigned long long)wall_clock64() : 0ull;
#define PG8_STAMP() do { if (STAMP && wid == 0 && nts < 64) { const unsigned long long _c = (unsigned long long)clock64(); \
        ts_lo = (lane == nts) ? (int)(unsigned)_c : ts_lo; ts_hi = (lane == nts) ? (int)(unsigned)(_c >> 32) : ts_hi; ++nts; } } while (0)
    PG8_STAMP();
    unsigned voffA[2], voffB[2];
#pragma unroll
    for (int i = 0; i < 2; ++i) { int R, C; stage_rc(tid * 16 + i * 8192, R, C); const int Rb = Epi::PERM ? ((R & ~31) + perm32(R & 31)) : R;
        voffA[i] = (unsigned)(R * K + C) * 2u; voffB[i] = (unsigned)(Rb * K + C) * 2u; }
    const size_t pstep = (size_t)64 * K * 2;
    const size_t kstep = (size_t)(BK * 2);
    const size_t hstep = (size_t)HALF * K * 2;
    const size_t tstep = 2 * hstep;
    const unsigned ldsw = (unsigned)wid * 1024u;
    const int aoff = lds_byte(wr * 64 + fr, fq * 8), boff = lds_byte(wc * 32 + fr, fq * 8);
#define PG8_SA(b, h) (((b) * 2 + (h)) * HTB)
#define PG8_SB(b, h) ((4 + (b) * 2 + (h)) * HTB)
#define PG8_STAGE(bufoff, gbase, voff) do { const char* _b0 = (const char*)(gbase); const char* _b1 = _b0 + pstep; asm volatile("" : "+s"(_b0), "+s"(_b1)); \
        __builtin_amdgcn_global_load_lds((const unsigned*)(_b0 + (voff)[0]), (PG8_LAS unsigned*)(lds + (bufoff) + ldsw), 16, 0, 0); \
        __builtin_amdgcn_global_load_lds((const unsigned*)(_b1 + (voff)[0]), (PG8_LAS unsigned*)(lds + (bufoff) + ldsw + 8192), 16, 0, 0); } while (0)
    unsigned gC[4] = {0u, 0u, 0u, 0u}, gN[4] = {0u, 0u, 0u, 0u}; int gR = 0, gCol = 0; stage_rc(tid * 16, gR, gCol);
#define PG8_GOFF(dst, ui_) do { _Pragma("unroll") for (int _j = 0; _j < 4; ++_j) dst[_j] = (unsigned)S.src_row((ui_), gR + 64 * _j) * (unsigned)(K * 2) + (unsigned)(gCol * 2); } while (0)
#define PG8_STAGE_G(bufoff, kptr, h, nx) do { const char* _b = (const char*)(kptr); asm volatile("" : "+s"(_b)); const unsigned _o0 = (nx) ? gN[2 * (h)] : gC[2 * (h)], _o1 = (nx) ? gN[2 * (h) + 1] : gC[2 * (h) + 1]; \
        __builtin_amdgcn_global_load_lds((const unsigned*)(_b + _o0), (PG8_LAS unsigned*)(lds + (bufoff) + ldsw), 16, 0, 0); \
        __builtin_amdgcn_global_load_lds((const unsigned*)(_b + _o1), (PG8_LAS unsigned*)(lds + (bufoff) + ldsw + 8192), 16, 0, 0); } while (0)
#define PG8_LDF(dstf, addr) do { (dstf).k[0] = *(const PG8_LAS bf16x8*)(addr); (dstf).k[1] = *(const PG8_LAS bf16x8*)((addr) + 1024); } while (0)
#define PG8_LDA(dst, b, h) do { _Pragma("unroll") for (int m = 0; m < 4; ++m) PG8_LDF(dst[m], lds + PG8_SA(b, h) + aoff + m * 2048); } while (0)
#define PG8_LDB(dst, b, h) do { _Pragma("unroll") for (int n = 0; n < 2; ++n) PG8_LDF(dst[n], lds + PG8_SB(b, h) + boff + n * 2048); } while (0)
#define PG8_MMA(ai, bj, At, Bt) do { __builtin_amdgcn_s_setprio(1); _Pragma("unroll") for (int m = 0; m < 4; ++m) _Pragma("unroll") for (int n = 0; n < 2; ++n) _Pragma("unroll") for (int k = 0; k < 2; ++k) { \
        if constexpr (F8) acc[ai][bj][m][n] = __builtin_bit_cast(f32x4, __builtin_amdgcn_mfma_i32_16x16x64_i8(__builtin_bit_cast(pg8_i32x4, Bt[n].k[k]), __builtin_bit_cast(pg8_i32x4, At[m].k[k]), __builtin_bit_cast(pg8_i32x4, acc[ai][bj][m][n]), 0, 0, 0)); \
        else acc[ai][bj][m][n] = __builtin_amdgcn_mfma_f32_16x16x32_bf16(Bt[n].k[k], At[m].k[k], acc[ai][bj][m][n], 0, 0, 0); } \
        __builtin_amdgcn_s_setprio(0); } while (0)
#define PG8_WAIT_V(n) asm volatile("s_waitcnt vmcnt(" #n ")" ::: "memory")
#define PG8_WAIT_L(n) asm volatile("s_waitcnt lgkmcnt(" #n ")" ::: "memory")
#define PG8_BAR __builtin_amdgcn_s_barrier()
#define PG8_SCHED __builtin_amdgcn_sched_barrier(0)
    Unit cur, nxt; int ui = 0;
    if (!S.next(0, cur)) return;
    f32x4 acc[2][2][4][2];
#pragma unroll
    for (int a = 0; a < 2; ++a)
#pragma unroll
        for (int b = 0; b < 2; ++b)
#pragma unroll
            for (int m = 0; m < 4; ++m)
#pragma unroll
                for (int n = 0; n < 2; ++n) acc[a][b][m][n] = (f32x4){0.f, 0.f, 0.f, 0.f};
    Frag<F8> At[4], B0[2], B1[2];
    const char* cA = (const char*)g.A + (size_t)cur.pm * tstep; const char* cB = (const char*)g.Bt + (size_t)cur.pn * tstep;
    S.a_ready(cur);
    const char* A0 = (const char*)g.A; if constexpr (GA) PG8_GOFF(gC, 0);
    PG8_STAGE(PG8_SB(0, 0), cB, voffB); if constexpr (GA) PG8_STAGE_G(PG8_SA(0, 0), A0, 0, false); else PG8_STAGE(PG8_SA(0, 0), cA, voffA);
    PG8_STAGE(PG8_SB(0, 1), cB + hstep, voffB); if constexpr (GA) PG8_STAGE_G(PG8_SA(0, 1), A0, 1, false); else PG8_STAGE(PG8_SA(0, 1), cA + hstep, voffA);
    if (wr == 1) PG8_BAR;
    PG8_WAIT_V(4); PG8_BAR;
    PG8_STAGE(PG8_SB(1, 0), cB + kstep, voffB); if constexpr (GA) PG8_STAGE_G(PG8_SA(1, 0), A0 + kstep, 0, false); else PG8_STAGE(PG8_SA(1, 0), cA + kstep, voffA);
    PG8_STAGE(PG8_SB(1, 1), cB + hstep + kstep, voffB);
    PG8_WAIT_V(6); PG8_BAR;
    PG8_STAMP();
    for (;;) {
        const bool has_next = S.next(ui + 1, nxt);
        const char* nA = has_next ? (const char*)g.A + (size_t)nxt.pm * tstep : cA; const char* nB = has_next ? (const char*)g.Bt + (size_t)nxt.pn * tstep : cB;
        if constexpr (GA) { if (has_next) PG8_GOFF(gN, ui + 1); else { gN[0] = gC[0]; gN[1] = gC[1]; gN[2] = gC[2]; gN[3] = gC[3]; } }
        for (int t = 0; t < nt; t += 2) {
            const bool last = (t == nt - 2);
            const char* a1 = cA + (size_t)(t + 1) * kstep;
            const char* a2 = last ? nA : cA + (size_t)(t + 2) * kstep; const char* b2 = last ? nB : cB + (size_t)(t + 2) * kstep;
            const char* a3 = a2 + kstep; const char* b3 = b2 + kstep;
            const char* kA1 = A0 + (size_t)(t + 1) * kstep; const char* kA2 = last ? A0 : A0 + (size_t)(t + 2) * kstep; const char* kA3 = kA2 + kstep;
            if (last && has_next) S.a_ready(nxt);
            PG8_LDB(B0, 0, 0); PG8_SCHED; PG8_LDA(At, 0, 0); if constexpr (GA) PG8_STAGE_G(PG8_SA(1, 1), kA1, 1, false); else PG8_STAGE(PG8_SA(1, 1), a1 + hstep, voffA);
            PG8_WAIT_L(8); PG8_BAR; PG8_WAIT_L(0); PG8_MMA(0, 0, At, B0); PG8_BAR; PG8_SCHED;
            PG8_LDB(B1, 0, 1); PG8_STAGE(PG8_SB(0, 0), b2, voffB);
            PG8_BAR; PG8_WAIT_L(0); PG8_MMA(0, 1, At, B1); PG8_BAR;
            PG8_LDA(At, 0, 1); if constexpr (GA) PG8_STAGE_G(PG8_SA(0, 0), kA2, 0, last); else PG8_STAGE(PG8_SA(0, 0), a2, voffA);
            PG8_BAR; PG8_WAIT_L(0); PG8_MMA(1, 0, At, B0); PG8_BAR; PG8_SCHED;
            PG8_STAGE(PG8_SB(0, 1), b2 + hstep, voffB);
            PG8_WAIT_V(6); PG8_BAR; PG8_MMA(1, 1, At, B1); PG8_BAR;
            PG8_LDB(B0, 1, 0); PG8_SCHED; PG8_LDA(At, 1, 0); if constexpr (GA) PG8_STAGE_G(PG8_SA(0, 1), kA2, 1, last); else PG8_STAGE(PG8_SA(0, 1), a2 + hstep, voffA);
            PG8_WAIT_L(8); PG8_BAR; PG8_WAIT_L(0); PG8_MMA(0, 0, At, B0); PG8_BAR; PG8_SCHED;
            PG8_LDB(B1, 1, 1); PG8_STAGE(PG8_SB(1, 0), b3, voffB);
            PG8_BAR; PG8_WAIT_L(0); PG8_MMA(0, 1, At, B1); PG8_BAR;
            PG8_LDA(At, 1, 1); if constexpr (GA) PG8_STAGE_G(PG8_SA(1, 0), kA3, 0, last); else PG8_STAGE(PG8_SA(1, 0), a3, voffA);
            PG8_BAR; PG8_WAIT_L(0); PG8_MMA(1, 0, At, B0); PG8_BAR; PG8_SCHED;
            PG8_STAGE(PG8_SB(1, 1), b3 + hstep, voffB);
            PG8_WAIT_V(6); PG8_BAR; PG8_MMA(1, 1, At, B1); PG8_BAR;
        }
        PG8_STAMP();
#ifdef PROBE_EPI
        const unsigned long long te0_ = __builtin_amdgcn_s_memrealtime();
#endif
        const bool keep_acc = E(acc, cur, wr, wc, fr, fq); S.done(cur);
#ifdef PROBE_EPI
        if (blockIdx.x == 0 && tid == 0) { unsigned long long* ec_ = probe_epi_counter(); *ec_ += __builtin_amdgcn_s_memrealtime() - te0_; }
#endif
        PG8_STAMP();
        if (!has_next) break;
        if (!keep_acc)
#pragma unroll
        for (int a = 0; a < 2; ++a)
#pragma unroll
            for (int b = 0; b < 2; ++b)
#pragma unroll
                for (int m = 0; m < 4; ++m)
#pragma unroll
                    for (int n = 0; n < 2; ++n) acc[a][b][m][n] = (f32x4){0.f, 0.f, 0.f, 0.f};
        cur = nxt; cA = nA; cB = nB; ++ui;
        if constexpr (GA) { gC[0] = gN[0]; gC[1] = gN[1]; gC[2] = gN[2]; gC[3] = gN[3]; }
    }
    PG8_WAIT_V(0);
    if (wr == 0) PG8_BAR;
    PG8_BAR;
    PG8_STAMP();
    if (STAMP && wid == 0) { stamps[lane] = lane < nts ? (((unsigned long long)(unsigned)ts_hi << 32) | (unsigned)ts_lo) : 0ull;
        if (lane == 62) stamps[62] = rt_entry; if (lane == 63) stamps[63] = (unsigned long long)wall_clock64(); }
#undef PG8_STAMP
#undef PG8_SA
#undef PG8_SB
#undef PG8_STAGE
#undef PG8_STAGE_G
#undef PG8_GOFF
#undef PG8_LDA
#undef PG8_LDF
#undef PG8_LDB
#undef PG8_MMA
#undef PG8_WAIT_V
#undef PG8_WAIT_L
#undef PG8_BAR
#undef PG8_SCHED
}
}
struct RectOrder {
    pg8::StaticOrder so; int offA, nwgA, nMb, nNb, offB, nwgB, G, c;
    __device__ void init(int nMa, int nNa, int offA_, int nMb_, int nNb_, int offB_, int G_, int c_) {
        so.init(nMa * 256, nNa * 256, G_, c_); offA = offA_; nwgA = nMa * nNa; nMb = nMb_; nNb = nNb_; offB = offB_; nwgB = nMb_ * nNb_; G = G_; c = c_; }
    __device__ bool next(int i, pg8::Unit& u) const {
        const int L = i * G + c;
        if (L < nwgA) { so.next(i, u); u.pm += offA; return true; }
        const int Lb = L - nwgA; if (Lb >= nwgB) return false;
        u.pm = offB + Lb % nMb; u.pn = Lb / nMb; return true;
    }
    __device__ __forceinline__ void a_ready(const pg8::Unit&) const {}
    __device__ __forceinline__ void done(const pg8::Unit&) const {}
};
struct MergeOrder {
    pg8::StaticOrder so; int off, G, c;
    __device__ void init(int nM, int off_, int G_, int c_) { so.init(nM * 256, 1024, G_, c_); off = off_; G = G_; c = c_; }
    __device__ bool next(int i, pg8::Unit& u) const {
        const int ti = i / 3, br = i - ti * 3;
        if (!so.next(ti, u)) return false;
        u.pm += off + br * (MH / 256); u.pn += br * 4; return true;
    }
    __device__ __forceinline__ void a_ready(const pg8::Unit&) const {}
    __device__ __forceinline__ void done(const pg8::Unit&) const {}
};
struct MoeOrder {
    const LAS int* srcl = nullptr;
    __device__ __forceinline__ int src_row(int i, int r) const { return srcl[i * 256 + r]; }
    int e0, e1, e2, e3, e4, e5, ntiles, G, c;
    __device__ __forceinline__ void unit_of(int i, int& pm, int& pn) const {
        if ((G & 31) == 0) { const int j = c >> 3; pm = i * (G >> 2) + (c & 7) * (G >> 5) + (j >> 2); pn = j & 3; }
        else { const int L = i * G + c; pm = L >> 2; pn = L & 3; } }
    __device__ __forceinline__ int look(const LAS int* tile_e, int i) const { int pm, pn; unit_of(i, pm, pn); return __builtin_amdgcn_readfirstlane(pm < ntiles ? tile_e[pm] : 0); }
    __device__ __forceinline__ void init(const LAS int* tile_e, int nt, int G_, int c_) { ntiles = nt; G = G_; c = c_;
        e0 = look(tile_e, 0); e1 = look(tile_e, 1); e2 = look(tile_e, 2); e3 = look(tile_e, 3); e4 = look(tile_e, 4); e5 = look(tile_e, 5); }
    __device__ __forceinline__ bool next(int i, pg8::Unit& u) const {
        int pm, pn; unit_of(i, pm, pn); if (pm >= ntiles || i >= 6) return false;
        const int e = i == 0 ? e0 : i == 1 ? e1 : i == 2 ? e2 : i == 3 ? e3 : i == 4 ? e4 : e5;
        u.pm = pm; u.pn = e * 4 + pn; return true;
    }
    __device__ __forceinline__ void a_ready(const pg8::Unit&) const {}
    __device__ __forceinline__ void done(const pg8::Unit&) const {}
};

struct EpiIn {
    static constexpr bool PERM = true, AFTER_DRAIN = false;
    bf16_t* P; bf16_t* GB; const float* cosT; const float* sinT;
    __device__ __forceinline__ bool operator()(pg8::f32x4 (&acc)[2][2][4][2], const pg8::Unit& u, int wr, int wc, int fr, int fq) const {
        const int pn = u.pn, rbase = u.pm * 256 + wr * 64 + fr;
        int act, ld; bf16_t* dst; int cb; bool rope = false; float scl = 1.0f;
        if (pn < 14) {
            const int kind = pn >> 1;
            const int bufidx = kind == 5 ? 6 : (kind == 6 ? 5 : kind);
            dst = P + (size_t)bufidx * ((size_t)MH * 512); ld = 512; cb = (pn & 1) * 256 + wc * 32 + 8 * fq;
            act = (kind == 4 || kind == 5) ? 1 : (kind == 6 ? 2 : 0);
            rope = (kind == 0 || kind == 3) && (u.pm >= 8);
            if (kind == 3) scl = QSCALE;
        } else {
            const int gi = (pn - 14) >> 2, pnl = (pn - 14) & 3, tid = (wr * 4 + wc) * 64 + fq * 16 + fr;
            u32x2* gdst = (u32x2*)GB + ((size_t)((gi * (MH / 256) + u.pm) * 4 + pnl) * 16) * 512 + tid;
#pragma unroll
            for (int ai = 0; ai < 2; ++ai)
#pragma unroll
                for (int m = 0; m < 4; ++m)
#pragma unroll
                    for (int bj = 0; bj < 2; ++bj) { unsigned q[8];
#pragma unroll
                        for (int j = 0; j < 4; ++j) { q[j] = (unsigned)fminf(fmaxf(sigmoid_f(acc[ai][bj][m][0][j]) * 255.0f + 0.5f, 1.0f), 255.0f); q[4 + j] = (unsigned)fminf(fmaxf(sigmoid_f(acc[ai][bj][m][1][j]) * 255.0f + 0.5f, 1.0f), 255.0f); }
                        u32x2 w; w.x = q[0] | (q[1] << 8) | (q[2] << 16) | (q[3] << 24); w.y = q[4] | (q[5] << 8) | (q[6] << 16) | (q[7] << 24);
                        gdst[(size_t)((ai * 4 + m) * 2 + bj) * 512] = w; }
            return false;
        }
        pg8::f32x4 csv[8], snv[8];
#pragma unroll
        for (int i = 0; i < 8; ++i) { csv[i] = (pg8::f32x4){1.f, 1.f, 1.f, 1.f}; snv[i] = (pg8::f32x4){0.f, 0.f, 0.f, 0.f}; }
        if (rope) {
#pragma unroll
            for (int i = 0; i < 8; ++i) { const int row = rbase + (i >> 2) * 128 + (i & 3) * 16; const int t = (row - CTXROWS) & 2047; const int pos = (wc & 1) ? (t & 63) : (t >> 6);
                csv[i] = *(const pg8::f32x4*)(cosT + pos * 16 + 4 * fq); snv[i] = *(const pg8::f32x4*)(sinT + pos * 16 + 4 * fq); } }
#pragma unroll
        for (int ai = 0; ai < 2; ++ai)
#pragma unroll
            for (int m = 0; m < 4; ++m) {
                const int row = rbase + ai * 128 + m * 16;
                const pg8::f32x4 cs = csv[ai * 4 + m], sn = snv[ai * 4 + m];
                bf16_t* rowp = dst + (size_t)row * ld + cb;
#pragma unroll
                for (int bj = 0; bj < 2; ++bj) {
                    pg8::f32x4 v0 = acc[ai][bj][m][0], v1 = acc[ai][bj][m][1];
                    if (rope) { const pg8::f32x4 o0 = v0 * cs - v1 * sn, o1 = v0 * sn + v1 * cs; v0 = o0; v1 = o1; }
                    v0 *= scl; v1 *= scl;
                    if (act == 1) {
#pragma unroll
                        for (int j = 0; j < 4; ++j) { v0[j] = gelu_tanh_f(v0[j]); v1[j] = gelu_tanh_f(v1[j]); } }
                    else if (act == 2) {
#pragma unroll
                        for (int j = 0; j < 4; ++j) { v0[j] = fmaxf(sigmoid_f(v0[j]), 1e-6f); v1[j] = fmaxf(sigmoid_f(v1[j]), 1e-6f); } }
                    u32x4 w; w.x = cvtpk(v0[0], v0[1]); w.y = cvtpk(v0[2], v0[3]); w.z = cvtpk(v1[0], v1[1]); w.w = cvtpk(v1[2], v1[3]);
                    *(u32x4*)(rowp + bj * 128) = w;
                }
            }
        return false;
    }
};
struct EpiGate8 {
    static constexpr bool PERM = true, AFTER_DRAIN = false;
    bf16_t* GB;
    __device__ __forceinline__ bool operator()(pg8::f32x4 (&acc)[2][2][4][2], const pg8::Unit& u, int wr, int wc, int fr, int fq) const {
        const int gi = u.pn >> 2, pnl = u.pn & 3, tid = (wr * 4 + wc) * 64 + fq * 16 + fr; const float sc = 1.0f / (HSCALE8 * WSCALE8);
        u32x2* gdst = (u32x2*)GB + ((size_t)((gi * (MH / 256) + u.pm) * 4 + pnl) * 16) * 512 + tid;
#pragma unroll
        for (int ai = 0; ai < 2; ++ai)
#pragma unroll
            for (int m = 0; m < 4; ++m)
#pragma unroll
                for (int bj = 0; bj < 2; ++bj) { unsigned q[8];
#pragma unroll
                    for (int j = 0; j < 4; ++j) { q[j] = (unsigned)fminf(fmaxf(sigmoid_f((float)__float_as_int(acc[ai][bj][m][0][j]) * sc) * 255.0f + 0.5f, 1.0f), 255.0f);
                        q[4 + j] = (unsigned)fminf(fmaxf(sigmoid_f((float)__float_as_int(acc[ai][bj][m][1][j]) * sc) * 255.0f + 0.5f, 1.0f), 255.0f); }
                    u32x2 w; w.x = q[0] | (q[1] << 8) | (q[2] << 16) | (q[3] << 24); w.y = q[4] | (q[5] << 8) | (q[6] << 16) | (q[7] << 24);
                    gdst[(size_t)((ai * 4 + m) * 2 + bj) * 512] = w; }
        return false;
    }
};
struct EpiMerge {
    static constexpr bool PERM = true, AFTER_DRAIN = false;
    const bf16_t* GB; bf16_t* OUT;
    __device__ __forceinline__ bool operator()(pg8::f32x4 (&acc)[2][2][4][2], const pg8::Unit& u, int wr, int wc, int fr, int fq) const {
        const int br = u.pn >> 2, pn = u.pn & 3, pm = u.pm - br * (MH / 256), tid = (wr * 4 + wc) * 64 + fq * 16 + fr;
        const int rbase = pm * 256 + wr * 64 + fr, cb = pn * 256 + wc * 32 + 8 * fq;
        const u32x2* g0 = (const u32x2*)GB + ((size_t)((br * (MH / 256) + pm) * 4 + pn) * 16) * 512 + tid;
        const u32x2* g1 = g0 + (size_t)(MH / 256) * 4 * 16 * 512;
        u32x2 ga_[16], gb_[16];
#pragma unroll
        for (int s = 0; s < 16; ++s) { ga_[s] = g0[(size_t)s * 512]; gb_[s] = (br < 2) ? g1[(size_t)s * 512] : (u32x2){0x01010101u, 0x01010101u}; }
#pragma unroll
        for (int ai = 0; ai < 2; ++ai)
#pragma unroll
            for (int m = 0; m < 4; ++m) {
                const size_t off = (size_t)(rbase + ai * 128 + m * 16) * 1024 + cb;
#pragma unroll
                for (int bj = 0; bj < 2; ++bj) {
                    const int slot = (ai * 4 + m) * 2 + bj;
                    const u32x2 a = ga_[slot], b = gb_[slot];
                    float ga[8];
#pragma unroll
                    for (int j = 0; j < 4; ++j) { ga[j] = (float)((a.x >> (8 * j)) & 0xffu); ga[4 + j] = (float)((a.y >> (8 * j)) & 0xffu); }
                    if (br < 2) {
#pragma unroll
                        for (int j = 0; j < 4; ++j) { ga[j] *= __builtin_amdgcn_rcpf((float)((b.x >> (8 * j)) & 0xffu)); ga[4 + j] *= __builtin_amdgcn_rcpf((float)((b.y >> (8 * j)) & 0xffu)); }
                    } else {
#pragma unroll
                        for (int j = 0; j < 8; ++j) ga[j] *= (1.0f / 255.0f);
                    }
                    pg8::f32x4 v0 = acc[ai][bj][m][0], v1 = acc[ai][bj][m][1];
#pragma unroll
                    for (int j = 0; j < 4; ++j) { v0[j] *= ga[j]; v1[j] *= ga[4 + j]; }
                    if (br < 2) { acc[ai][bj][m][0] = v0; acc[ai][bj][m][1] = v1; }
                    else { u32x4 w; w.x = cvtpk(v0[0], v0[1]); w.y = cvtpk(v0[2], v0[3]); w.z = cvtpk(v1[0], v1[1]); w.w = cvtpk(v1[2], v1[3]);
                        *(u32x4*)(OUT + off + bj * 128) = w; }
                }
            }
        return br < 2;
    }
};
struct EpiOut {
    static constexpr bool PERM = false, AFTER_DRAIN = false;
    const float* xres_lat; const float* xres_ctx; float* xs_lat; float* xs_ctx; const float* mod; int hf;
    __device__ __forceinline__ bool operator()(pg8::f32x4 (&acc)[2][2][4][2], const pg8::Unit& u, int wr, int wc, int fr, int fq) const {
        const int pm = u.pm; const float* src; float* dst; int b;
        if (pm < 8) { b = 16; const size_t o = (size_t)((hf * HBAT + pm) * 256) * 1024; src = xres_ctx + o; dst = xs_ctx + o; }
        else { const int q = pm - 8; b = hf * HBAT + (q >> 3); const size_t o = ((size_t)b * 2048 + (size_t)(q & 7) * 256) * 1024; src = xres_lat + o; dst = xs_lat + o; }
        const int col0 = u.pn * 256 + wc * 32 + 4 * fq;
        const float* mrow = mod + (size_t)b * 6144 + 2 * 1024 + col0;
        pg8::f32x4 mv[2][2];
#pragma unroll
        for (int bj = 0; bj < 2; ++bj)
#pragma unroll
            for (int n = 0; n < 2; ++n) mv[bj][n] = *(const pg8::f32x4*)(mrow + bj * 128 + n * 16);
#pragma unroll
        for (int ai = 0; ai < 2; ++ai) {
            pg8::f32x4 xr[4][2][2];
#pragma unroll
            for (int m = 0; m < 4; ++m) { const size_t off = (size_t)(wr * 64 + fr + ai * 128 + m * 16) * 1024 + col0;
#pragma unroll
                for (int bj = 0; bj < 2; ++bj)
#pragma unroll
                    for (int n = 0; n < 2; ++n) xr[m][bj][n] = *(const pg8::f32x4*)(src + off + bj * 128 + n * 16); }
#pragma unroll
            for (int m = 0; m < 4; ++m) { const size_t off = (size_t)(wr * 64 + fr + ai * 128 + m * 16) * 1024 + col0;
#pragma unroll
                for (int bj = 0; bj < 2; ++bj)
#pragma unroll
                    for (int n = 0; n < 2; ++n) *(pg8::f32x4*)(dst + off + bj * 128 + n * 16) = xr[m][bj][n] + mv[bj][n] * acc[ai][bj][m][n]; }
            asm volatile("" ::: "memory");
        }
        return false;
    }
};
struct EpiGU {
    static constexpr bool PERM = true, AFTER_DRAIN = false;
    unsigned char* ACT;
    __device__ __forceinline__ bool operator()(pg8::f32x4 (&acc)[2][2][4][2], const pg8::Unit& u, int wr, int wc, int fr, int fq) const {
        const int rbase = u.pm * 256 + wr * 64 + fr, cb = (u.pn & 3) * 128 + wc * 32 + 8 * fq;
        const float sc = 1.0f / (HSCALE8 * WSCALE8);
#pragma unroll
        for (int ai = 0; ai < 2; ++ai)
#pragma unroll
            for (int m = 0; m < 4; ++m) {
                float o[8];
#pragma unroll
                for (int n = 0; n < 2; ++n)
#pragma unroll
                    for (int j = 0; j < 4; ++j) o[4 * n + j] = silu_f((float)__float_as_int(acc[ai][0][m][n][j]) * sc) * ((float)__float_as_int(acc[ai][1][m][n][j]) * (sc * ASCALE8));
                u32x2 w; w.x = pk4_fp8(o[0], o[1], o[2], o[3]); w.y = pk4_fp8(o[4], o[5], o[6], o[7]);
                *(u32x2*)(ACT + (size_t)(rbase + ai * 128 + m * 16) * 512 + cb) = w;
            }
        return false;
    }
};
struct EpiDown {
    static constexpr bool PERM = true, AFTER_DRAIN = false;
    bf16_t* YS;
    __device__ __forceinline__ bool operator()(pg8::f32x4 (&acc)[2][2][4][2], const pg8::Unit& u, int wr, int wc, int fr, int fq) const {
        const int rbase = u.pm * 256 + wr * 64 + fr, cb = (u.pn & 3) * 256 + wc * 32 + 8 * fq;
#pragma unroll
        for (int ai = 0; ai < 2; ++ai)
#pragma unroll
            for (int m = 0; m < 4; ++m) {
                const int row = rbase + ai * 128 + m * 16;
#pragma unroll
                for (int bj = 0; bj < 2; ++bj) { const float s8 = 1.0f / (ASCALE8 * WSCALE8); u32x4 w;
                    w.x = cvtpk((float)__float_as_int(acc[ai][bj][m][0][0]) * s8, (float)__float_as_int(acc[ai][bj][m][0][1]) * s8); w.y = cvtpk((float)__float_as_int(acc[ai][bj][m][0][2]) * s8, (float)__float_as_int(acc[ai][bj][m][0][3]) * s8);
                    w.z = cvtpk((float)__float_as_int(acc[ai][bj][m][1][0]) * s8, (float)__float_as_int(acc[ai][bj][m][1][1]) * s8); w.w = cvtpk((float)__float_as_int(acc[ai][bj][m][1][2]) * s8, (float)__float_as_int(acc[ai][bj][m][1][3]) * s8);
                    *(u32x4*)(YS + (size_t)row * 1024 + cb + bj * 128) = w; }
            }
        return false;
    }
};
template <class ColMap>
__device__ __forceinline__ void cvt_tile_T(const float* __restrict__ src, int ldsrc, bf16_t* __restrict__ dst, int K, int k0, int n0, const ColMap& cm, float scale, LAS float* tile) {
    const int tid = opaque_tid();
    {
        const int n = tid & 63, kb = tid >> 6; const int sc = cm(n0 + n);
#pragma unroll
        for (int i = 0; i < 8; ++i) { const int k = kb + 8 * i; tile[k * 65 + n] = src[(size_t)(k0 + k) * ldsrc + sc] * scale; }
    }
    __syncthreads();
    {
        const int kp = (tid & 31) * 2, nb = tid >> 5;
#pragma unroll
        for (int i = 0; i < 4; ++i) { const int n = nb + 16 * i; *(unsigned*)(dst + (size_t)(n0 + n) * K + k0 + kp) = cvtpk(tile[kp * 65 + n], tile[(kp + 1) * 65 + n]); }
    }
    __syncthreads();
}
struct CmIdent { int off; __device__ __forceinline__ int operator()(int n) const { return n + off; } };
struct CmWin {
    __device__ __forceinline__ int operator()(int n) const {
        if (n < 512 || (n >= 1536 && n < 2048)) { const int c = n & 31, f = c >> 3, j = c & 7; return (n & ~31) + ((j < 4) ? (4 * f + j) : (16 + 4 * f + (j - 4))); }
        return n; }
};
struct CmGU {
    __device__ __forceinline__ int operator()(int n) const { return 128 * (n >> 8) + (n & 127); }
};

template <int MODE, bool OUT8 = false>
__device__ __forceinline__ void cvt_tile_T256(const float* __restrict__ baseA, const float* __restrict__ baseB, int ldsrc, void* __restrict__ dstv, int K, int k0, int n0, float scale, LAS float* tile) {
    const int tid = opaque_tid();
    {
        const int n = tid & 255, kb = tid >> 8, ng = n0 + n;
        const float* sp = (MODE == 2 ? ((ng & 128) ? baseB : baseA) + 128 * (ng >> 8) + (ng & 127) : MODE == 1 ? baseA + CmWin{}(ng) : baseA + ng) + (size_t)(k0 + kb) * ldsrc;
        float v[32];
#pragma unroll
        for (int i = 0; i < 32; ++i) v[i] = sp[(size_t)(2 * i) * ldsrc];
#pragma unroll
        for (int i = 0; i < 32; ++i) tile[(kb + 2 * i) * 257 + n] = v[i] * scale;
    }
    __syncthreads();
    {
        const int n = tid >> 1, kh = (tid & 1) * 32;
        if constexpr (OUT8) { unsigned char* dp = (unsigned char*)dstv + (size_t)(n0 + n) * K + k0 + kh;
#pragma unroll
            for (int i = 0; i < 2; ++i) { float f[16];
#pragma unroll
                for (int j = 0; j < 16; ++j) f[j] = tile[(kh + 16 * i + j) * 257 + n];
                u32x4 w; w.x = pk4_fp8(f[0], f[1], f[2], f[3]); w.y = pk4_fp8(f[4], f[5], f[6], f[7]); w.z = pk4_fp8(f[8], f[9], f[10], f[11]); w.w = pk4_fp8(f[12], f[13], f[14], f[15]);
                *(u32x4*)(dp + 16 * i) = w; } }
        else { bf16_t* dp = (bf16_t*)dstv + (size_t)(n0 + n) * K + k0 + kh;
#pragma unroll
            for (int i = 0; i < 4; ++i) { float f[8];
#pragma unroll
                for (int j = 0; j < 8; ++j) f[j] = tile[(kh + 8 * i + j) * 257 + n];
                *(u32x4*)(dp + 8 * i) = pack8(f); } }
    }
    __syncthreads();
}

__device__ __forceinline__ void phase_prologue(const Params& p, LAS unsigned char* lds) {
    LAS float* tile = (LAS float*)lds;
    const int tid = opaque_tid(), G = gridDim.x, bid = blockIdx.x;
    unsigned char* ws = p.ws;
    for (int u = bid; u < 1248; u += G) {
        if (u < 448) { const int l = u / 224, r = u % 224, kt = r / 14, nt = r % 14;
            cvt_tile_T256<1>(p.in[I_WIN] + (size_t)l * 1024 * NCOL, nullptr, NCOL, (bf16_t*)(ws + WS_WTIN) + (size_t)l * NCOL * 1024, 1024, kt * 64, nt * 256, 1.0f, tile); }
        else if (u < 832) { const int v = u - 448, l = v / 192, r = v % 192, kt = r / 12, nt = r % 12;
            cvt_tile_T256<0, true>(p.in[I_WIN] + (size_t)l * 1024 * NCOL + 3584, nullptr, NCOL, ws + WS_WTIN8 + (size_t)l * 3072 * 1024, 1024, kt * 64, nt * 256, WSCALE8, tile); }
        else if (u < 1024) { const int v = u - 832, li = v / 32, r = v % 32, kt = r / 4, nt = r % 4;
            cvt_tile_T256<0>(p.in[I_WBR] + (size_t)li * 512 * 1024, nullptr, 1024, (bf16_t*)(ws + WS_WTBR) + (size_t)li * 1024 * 512, 512, kt * 64, nt * 256, 1.0f, tile); }
        else if (u < 1152) { const int v = u - 1024, l = v / 64, r = v % 64, kt = r / 4, nt = r % 4;
            cvt_tile_T256<0>(p.in[I_WOUT] + (size_t)l * 1024 * 1024, nullptr, 1024, (bf16_t*)(ws + WS_WTO) + (size_t)l * 1024 * 1024, 1024, kt * 64, nt * 256, 1.0f, tile); }
        else { const int v = u - 1152, m = v / 4, r = v % 4, kt = r >> 1, nt = r & 1;
            const int j = (m >> 2) % 3;
            cvt_tile_T(p.in[I_WQKV] + (size_t)m * 16384, 128, (bf16_t*)(ws + WS_WTQKV) + (size_t)m * 16384, 128, kt * 64, nt * 64, CmIdent{0}, j == 1 ? 0.08838834764831845f : 1.0f, tile); }
    }
    const int gt = bid * NTHR + tid, gn = G * NTHR;
    for (int i = gt; i < 2 * 4 * 16384; i += gn) ((bf16_t*)(ws + WS_WSB))[i] = f2bf(p.in[I_WGS][i]);
    for (int i = gt; i < 2 * 48 * 1024; i += gn) {
        const int l = i / (48 * 1024), r = i % (48 * 1024), n = r >> 10, k = r & 1023;
        float w = 0.f; if (n < 4) w = p.in[I_WRG][((size_t)l * 1024 + k) * 4 + n]; else if (n < 36) w = p.in[I_WRE][((size_t)l * 1024 + k) * 32 + (n - 4)];
        const bf16_t hi = f2bf(w); const bf16_t lo = f2bf(w - bf2f(hi));
        bf16_t* d = (bf16_t*)(ws + WS_WRT) + (size_t)l * 2 * 48 * 1024;
        d[r] = hi; d[48 * 1024 + r] = lo;
    }
    for (int i = gt; i < 1024; i += gn) { const int pos = i >> 4, f = i & 15; const float inv = powf(10000.0f, -(float)f / 16.0f); const float a = (float)pos * inv;
        ((float*)(ws + WS_ROPE))[i] = cosf(a); ((float*)(ws + WS_ROPE))[1024 + i] = sinf(a); }
    if (gt < 2) { const int l = gt; const float* lp = p.in[I_DLAM] + l * 256; float s01 = 0.f, s23 = 0.f;
        for (int i = 0; i < 64; ++i) { s01 += lp[i] * lp[64 + i]; s23 += lp[128 + i] * lp[192 + i]; }
        const float lam_init = 0.8f - 0.6f * expf(-0.3f * (float)l);
        float* o = (float*)(ws + WS_LAM) + l * 4; o[0] = expf(s01) - expf(s23) + lam_init; o[1] = 1.0f - lam_init; }
    for (int i = gt; i < 2 * 16 * 1024; i += gn) {
        const int l = i >> 14, gc = (i >> 10) & 15, ch = i & 1023, part = ch >> 9, c = ch & 511, h = c >> 7, d = c & 127;
        const float* wif = p.in[I_WIF] + (size_t)l * 1536 * 16; const float* wq = p.in[I_WQKV] + (size_t)l * 3 * 4 * 16384;
        float s = 0.f;
        if (part == 0) { const float* a = wq + ((size_t)(0 * 4 + h) * 128 + d) * 128; const float* b = wq + ((size_t)(1 * 4 + h) * 128 + d) * 128;
            for (int e = 0; e < 128; ++e) s += a[e] * wif[(size_t)(h * 128 + e) * 16 + gc] + b[e] * wif[(size_t)(512 + h * 128 + e) * 16 + gc]; }
        else { const float* a = wq + ((size_t)(2 * 4 + h) * 128 + d) * 128;
            for (int e = 0; e < 128; ++e) s += a[e] * wif[(size_t)(1024 + h * 128 + e) * 16 + gc]; }
        ((float*)(ws + WS_WFOLD))[i] = s;
    }
    {
        LAS float* sc = (LAS float*)lds;
        LAS float* red = sc + 17 * 1024;
        bool loaded = false;
        for (int u = bid; u < 192; u += G) {
            if (!loaded) { for (int i = tid; i < 17 * 1024; i += NTHR) { const float v = i < 16384 ? p.in[I_C][i] : p.in[I_CCTX][i - 16384]; sc[i] = silu_f(v); } loaded = true; }
            __syncthreads();
            const int l = u / 96, cbk = u % 96, col = cbk * 64 + (tid & 63), kq = tid >> 6;
            float a[17];
#pragma unroll
            for (int b = 0; b < 17; ++b) a[b] = 0.f;
            const float* wp = p.in[I_WMOD] + (size_t)l * 1024 * 6144 + col;
            for (int k0 = kq * 128; k0 < kq * 128 + 128; k0 += 8) { float w[8];
#pragma unroll
                for (int j = 0; j < 8; ++j) w[j] = wp[(size_t)(k0 + j) * 6144];
#pragma unroll
                for (int j = 0; j < 8; ++j)
#pragma unroll
                    for (int b = 0; b < 17; ++b) a[b] += sc[b * 1024 + k0 + j] * w[j]; }
#pragma unroll
            for (int b = 0; b < 17; ++b) red[(kq * 17 + b) * 64 + (tid & 63)] = a[b];
            __syncthreads();
            for (int i = tid; i < 17 * 64; i += NTHR) { const int b = i >> 6, c = i & 63; float s2 = 0.f;
#pragma unroll
                for (int k = 0; k < 8; ++k) s2 += red[(k * 17 + b) * 64 + c];
                ((float*)(ws + WS_MOD))[((size_t)l * 17 + b) * 6144 + cbk * 64 + c] = s2 + p.in[I_BMOD][(size_t)l * 6144 + cbk * 64 + c]; }
            __syncthreads();
        }
    }
}

constexpr int CVT_TILES = 3072;
struct CvtT { const float* a; const float* b; unsigned char* dst; int ldsrc, K, k0, n0; };
__device__ __forceinline__ CvtT cvt_decode(const Params& p, int t) {
    const int l = t >= CVT_TILES ? 1 : 0, u = t - l * CVT_TILES; CvtT c;
    if (u < 2048) { const int e = u >> 6, q = u & 63; const size_t eo = ((size_t)l * 32 + e) * 1024 * 512;
        c.a = p.in[I_WEG] + eo; c.b = p.in[I_WEU] + eo; c.dst = p.ws + WS_WTGU + ((size_t)l * 32 + e) * 1024 * 1024; c.ldsrc = 512; c.K = 1024; c.k0 = (q >> 2) * 64; c.n0 = (q & 3) * 256; }
    else { const int v = u - 2048, e = v >> 5, q = v & 31;
        c.a = p.in[I_WED] + ((size_t)l * 32 + e) * 512 * 1024; c.b = nullptr; c.dst = p.ws + WS_WTD + ((size_t)l * 32 + e) * 1024 * 512; c.ldsrc = 1024; c.K = 512; c.k0 = (q >> 2) * 64; c.n0 = (q & 3) * 256; }
    return c;
}
__device__ __forceinline__ void cvt_load(const CvtT& c, float (&v)[32]) {
    const int tid = opaque_tid(), n = tid & 255, kb = tid >> 8, ng = c.n0 + n;
    const float* sp = (c.b ? ((ng & 128) ? c.b : c.a) + 128 * (ng >> 8) + (ng & 127) : c.a + ng) + (size_t)(c.k0 + kb) * c.ldsrc;
#pragma unroll
    for (int i = 0; i < 32; ++i) v[i] = sp[(size_t)(2 * i) * c.ldsrc];
}
__device__ __forceinline__ void cvt_finish(const CvtT& c, const float (&v)[32], LAS float* tile) {
    const int tid = opaque_tid();
    { const int n = tid & 255, kb = tid >> 8;
#pragma unroll
      for (int i = 0; i < 32; ++i) tile[(kb + 2 * i) * 257 + n] = v[i] * WSCALE8; }
    __syncthreads();
    { const int n = tid >> 1, kh = (tid & 1) * 32; unsigned char* dp = c.dst + (size_t)(c.n0 + n) * c.K + c.k0 + kh;
#pragma unroll
      for (int i = 0; i < 2; ++i) { float f[16];
#pragma unroll
          for (int j = 0; j < 16; ++j) f[j] = tile[(kh + 16 * i + j) * 257 + n];
          u32x4 w; w.x = pk4_fp8(f[0], f[1], f[2], f[3]); w.y = pk4_fp8(f[4], f[5], f[6], f[7]); w.z = pk4_fp8(f[8], f[9], f[10], f[11]); w.w = pk4_fp8(f[12], f[13], f[14], f[15]);
          *(u32x4*)(dp + 16 * i) = w; } }
}
__device__ __forceinline__ void cvt_fill(const Params& p, LAS unsigned char* lds, int t0, int t1, int r, int nr) {
    LAS float* tA = (LAS float*)lds; LAS float* tB = tA + 64 * 257 + 64;
    asm volatile("" : "+s"(r));
    float va[32], vb[32]; int t = t0 + r;
    if (t < t1) cvt_load(cvt_decode(p, t), va);
    for (; t < t1; t += 2 * nr) {
        if (t + nr < t1) cvt_load(cvt_decode(p, t + nr), vb);
        cvt_finish(cvt_decode(p, t), va, tA);
        if (t + 2 * nr < t1) cvt_load(cvt_decode(p, t + 2 * nr), va);
        if (t + nr < t1) cvt_finish(cvt_decode(p, t + nr), vb, tB);
    }
    __syncthreads();
}
constexpr int CVT_Q0 = 0, CVT_Q1 = 2240, CVT_Q2 = 2240, CVT_Q3 = 4480, CVT_Q4 = 5600;

__device__ __forceinline__ void ld_row_f32(const float* src, int lane, float (&v)[16]) {
    const f32x4 a = *(const f32x4*)(src + 8 * lane), b = *(const f32x4*)(src + 8 * lane + 4), c = *(const f32x4*)(src + 512 + 8 * lane), d = *(const f32x4*)(src + 512 + 8 * lane + 4);
#pragma unroll
    for (int j = 0; j < 4; ++j) { v[j] = a[j]; v[4 + j] = b[j]; v[8 + j] = c[j]; v[12 + j] = d[j]; }
}
__device__ __forceinline__ void st_row_f32(float* dst, int lane, const float (&v)[16]) {
    *(f32x4*)(dst + 8 * lane) = (f32x4){v[0], v[1], v[2], v[3]}; *(f32x4*)(dst + 8 * lane + 4) = (f32x4){v[4], v[5], v[6], v[7]};
    *(f32x4*)(dst + 512 + 8 * lane) = (f32x4){v[8], v[9], v[10], v[11]}; *(f32x4*)(dst + 512 + 8 * lane + 4) = (f32x4){v[12], v[13], v[14], v[15]};
}
__device__ __forceinline__ void ld_row_bf16(const bf16_t* src, int lane, float (&v)[16]) {
    const u32x4 a = *(const u32x4*)(src + 8 * lane), b = *(const u32x4*)(src + 512 + 8 * lane);
    v[0] = bf_lo(a.x); v[1] = bf_hi(a.x); v[2] = bf_lo(a.y); v[3] = bf_hi(a.y); v[4] = bf_lo(a.z); v[5] = bf_hi(a.z); v[6] = bf_lo(a.w); v[7] = bf_hi(a.w);
    v[8] = bf_lo(b.x); v[9] = bf_hi(b.x); v[10] = bf_lo(b.y); v[11] = bf_hi(b.y); v[12] = bf_lo(b.z); v[13] = bf_hi(b.z); v[14] = bf_lo(b.w); v[15] = bf_hi(b.w);
}
__device__ __forceinline__ void st_row_bf16(bf16_t* dst, int lane, const float (&v)[16]) {
    u32x4 a, b; a.x = cvtpk(v[0], v[1]); a.y = cvtpk(v[2], v[3]); a.z = cvtpk(v[4], v[5]); a.w = cvtpk(v[6], v[7]);
    b.x = cvtpk(v[8], v[9]); b.y = cvtpk(v[10], v[11]); b.z = cvtpk(v[12], v[13]); b.w = cvtpk(v[14], v[15]);
    *(u32x4*)(dst + 8 * lane) = a; *(u32x4*)(dst + 512 + 8 * lane) = b;
}
template <int MODE>
__device__ __forceinline__ void load_resid4(const Params& p, int R0, const RowInfo& q, int lmoe, int lane, float (&v)[4][16]) {
    const float* src; float* dst;
    if (q.isctx) { const size_t o = ((size_t)q.b * 256 + q.t) * 1024; src = (MODE == 0 ? p.in[I_CTX] : (const float*)(p.ws + WS_XC)) + o; dst = (float*)(p.ws + WS_XC) + o; }
    else { const size_t o = ((size_t)q.b * 2048 + q.t) * 1024; src = (MODE == 0 ? p.in[I_X] : (const float*)p.out) + o; dst = p.out + o; }
#pragma unroll
    for (int i = 0; i < 4; ++i) ld_row_f32(src + (size_t)i * 1024, lane, v[i]);
    if (MODE == 1 || MODE == 3) {
        const int* slot = (const int*)(p.ws + WS_POS) + 2 * (size_t)R0; const float* wk = (const float*)(p.ws + WS_WTK) + 2 * (size_t)R0;
        const bf16_t* ys = (const bf16_t*)(p.ws + WS_P + P_YS);
        int sl[8]; float ww[8];
#pragma unroll
        for (int i = 0; i < 8; ++i) { sl[i] = ld_i32_dev(slot + i); ww[i] = ld_f32_dev(wk + i); }
        float m5[16]; ld_row_f32((const float*)(p.ws + WS_MOD) + ((size_t)lmoe * 17 + (q.isctx ? 16 : q.b)) * 6144 + 5 * 1024, lane, m5);
        u32x4 ya[4][2], yb[4][2];
#pragma unroll
        for (int i = 0; i < 4; ++i) { const bf16_t* r1 = ys + (size_t)sl[2 * i] * 1024; const bf16_t* r2 = ys + (size_t)sl[2 * i + 1] * 1024;
            ya[i][0] = *(const u32x4*)(r1 + 8 * lane); ya[i][1] = *(const u32x4*)(r1 + 512 + 8 * lane); yb[i][0] = *(const u32x4*)(r2 + 8 * lane); yb[i][1] = *(const u32x4*)(r2 + 512 + 8 * lane); }
#pragma unroll
        for (int i = 0; i < 4; ++i) { float y1[8], y2[8];
#pragma unroll
            for (int hh = 0; hh < 2; ++hh) { unpack8(ya[i][hh], y1); unpack8(yb[i][hh], y2);
#pragma unroll
                for (int j = 0; j < 8; ++j) v[i][8 * hh + j] += m5[8 * hh + j] * (ww[2 * i] * y1[j] + ww[2 * i + 1] * y2[j]); }
            if (MODE == 1) st_row_f32(dst + (size_t)i * 1024, lane, v[i]); }
    }
}
struct RowPar { float g[16], sh[16], sc[16]; };
__device__ __forceinline__ void load_rowpar(const Params& p, int l, int which, const RowInfo& q, int lane, RowPar& rp) {
    const float* mrow = (const float*)(p.ws + WS_MOD) + ((size_t)l * 17 + (q.isctx ? 16 : q.b)) * 6144;
    ld_row_f32(p.in[which ? I_GN2 : I_GN1] + (size_t)l * 1024, lane, rp.g);
    ld_row_f32(mrow + (which ? 3 : 0) * 1024, lane, rp.sh); ld_row_f32(mrow + (which ? 4 : 1) * 1024, lane, rp.sc);
}
__device__ __forceinline__ void norm_mod_row(const RowPar& rp, int lane, const float (&v)[16], bf16_t* hrow, unsigned char* h8row = nullptr) {
    float ss = 0.f;
#pragma unroll
    for (int j = 0; j < 16; ++j) ss += v[j] * v[j];
    ss = wave_sum(ss); const float rs = rsqrtf(ss * (1.0f / 1024.0f) + EPS);
    float o[16];
#pragma unroll
    for (int j = 0; j < 16; ++j) o[j] = v[j] * rs * rp.g[j] * (1.0f + rp.sc[j]) + rp.sh[j];
    st_row_bf16(hrow, lane, o);
    if (h8row) { u32x2 a, b; a.x = pk4_fp8(o[0] * HSCALE8, o[1] * HSCALE8, o[2] * HSCALE8, o[3] * HSCALE8); a.y = pk4_fp8(o[4] * HSCALE8, o[5] * HSCALE8, o[6] * HSCALE8, o[7] * HSCALE8);
        b.x = pk4_fp8(o[8] * HSCALE8, o[9] * HSCALE8, o[10] * HSCALE8, o[11] * HSCALE8); b.y = pk4_fp8(o[12] * HSCALE8, o[13] * HSCALE8, o[14] * HSCALE8, o[15] * HSCALE8);
        *(u32x2*)(h8row + 8 * lane) = a; *(u32x2*)(h8row + 512 + 8 * lane) = b; }
}
__device__ __forceinline__ void phase_norm1(const Params& p, int l) {
    const int tid = opaque_tid(), wid = __builtin_amdgcn_readfirstlane(tid >> 6), lane = tid & 63;
    for (int gq = blockIdx.x * 8 + wid; gq < MTOT / 4; gq += gridDim.x * 8) {
        const int R0 = 4 * gq; const RowInfo q = row_info(R0); float v[4][16]; RowPar rp;
        load_rowpar(p, l, 0, q, lane, rp);
        if (l == 0) load_resid4<0>(p, R0, q, 0, lane, v); else load_resid4<1>(p, R0, q, l - 1, lane, v);
#pragma unroll
        for (int i = 0; i < 4; ++i) norm_mod_row(rp, lane, v[i], (bf16_t*)(p.ws + WS_H) + (size_t)(R0 + i) * 1024, p.ws + WS_H8 + (size_t)(R0 + i) * 1024);
    }
}
__device__ __forceinline__ void phase_final(const Params& p) {
    const int tid = opaque_tid(), wid = __builtin_amdgcn_readfirstlane(tid >> 6), lane = tid & 63;
    float g[16]; ld_row_f32(p.in[I_GFIN], lane, g);
    for (int gq = blockIdx.x * 8 + wid; gq < NBATCH * SEQ / 4; gq += gridDim.x * 8) {
        const int a = 4 * gq, R0 = (a >> 14) * MH + CTXROWS + (a & 16383);
        const RowInfo q = row_info(R0); float v[4][16];
        load_resid4<3>(p, R0, q, 1, lane, v);
#pragma unroll
        for (int i = 0; i < 4; ++i) { float ss = 0.f;
#pragma unroll
            for (int j = 0; j < 16; ++j) ss += v[i][j] * v[i][j];
            ss = wave_sum(ss); const float rs = rsqrtf(ss * (1.0f / 1024.0f) + EPS);
#pragma unroll
            for (int j = 0; j < 16; ++j) v[i][j] = v[i][j] * rs * g[j];
            st_row_f32(p.out + ((size_t)q.b * 2048 + q.t + i) * 1024, lane, v[i]); }
    }
}
__device__ __forceinline__ int active_row(int l, int a) { return l == 0 ? a : (a >> 14) * MH + CTXROWS + (a & 16383); }
typedef float f32x4v __attribute__((ext_vector_type(4)));
__device__ __forceinline__ void phase_norm2_router(const Params& p, int l, LAS unsigned char* lds) {
    const int tid = opaque_tid(), wid = tid >> 6, lane = tid & 63, G = gridDim.x, bid = blockIdx.x;
    const int NA = l == 0 ? MTOT : NBATCH * SEQ;
    const int chunk = (((NA + G - 1) / G) + 15) & ~15;
    const int a0 = bid * chunk, a1 = (a0 + chunk < NA) ? a0 + chunk : NA, na = a1 > a0 ? a1 - a0 : 0;
    LAS float* lg = (LAS float*)lds;
    LAS float* lgs = (LAS float*)(lds + 73728);
    LAS int* re = (LAS int*)(lds + 83968);
    LAS float* rw = (LAS float*)(lds + 83968 + 2048);
    LAS int* rr = (LAS int*)(lds + 83968 + 4096);
    LAS int* hist = (LAS int*)(lds + 83968 + 6144);
    LAS int* base = hist + 32;
    if (tid < 32) hist[tid] = 0;
    bf16_t* H = (bf16_t*)(p.ws + WS_H);
    PSEC_BEGINN(11);
    for (int g = wid; g * 16 < na; g += 8)
        for (int i = 0; i < 16; i += 4) { const int a = a0 + g * 16 + i; if (a >= a1) break;
            const int R0 = active_row(l, a); const RowInfo q = row_info(R0); float v[4][16]; RowPar rp;
            load_rowpar(p, l, 1, q, lane, rp);
            load_resid4<2>(p, R0, q, 0, lane, v);
#pragma unroll
            for (int k = 0; k < 4; ++k) norm_mod_row(rp, lane, v[k], H + (size_t)(R0 + k) * 1024, p.ws + WS_H8 + (size_t)(R0 + k) * 1024); }
    asm volatile("s_waitcnt vmcnt(0)" ::: "memory"); __syncthreads();
    PSEC(11);
    const bf16_t* Wr = (const bf16_t*)(p.ws + WS_WRT) + (size_t)l * 2 * 48 * 1024;
    const float* brg = p.in[I_BRG] + l * 4; const float* bre = p.in[I_BRE] + l * 32;
    const int ng = (na + 15) >> 4, r16 = lane & 15, kq = lane >> 4;
    LAS float* brl = (LAS float*)(lds + 83968 + 6144 + 512);
    if (tid < 36) brl[tid] = tid < 4 ? brg[tid] : bre[tid - 4];
    if (ng > 0) {
        bf16x8 bh[4][3], bl[4][3];
        { const bf16_t* bp = Wr + (size_t)r16 * 1024 + 128 * wid + 8 * kq;
#pragma unroll
          for (int ks = 0; ks < 4; ++ks)
#pragma unroll
              for (int ct = 0; ct < 3; ++ct) { bh[ks][ct] = *(const bf16x8*)(bp + (size_t)ct * 16 * 1024 + ks * 32); bl[ks][ct] = *(const bf16x8*)(bp + (size_t)(48 + ct * 16) * 1024 + ks * 32); } }
        __builtin_amdgcn_sched_barrier(0);
#pragma unroll 1
        for (int g0 = 0; g0 < ng; g0 += 3) {
            bf16x8 a[3][4];
#pragma unroll
            for (int gq = 0; gq < 3; ++gq) { int ar = a0 + (g0 + gq) * 16 + r16; if (ar >= a1) ar = a1 - 1;
                const bf16_t* ap = H + (size_t)active_row(l, ar) * 1024 + 128 * wid + 8 * kq;
#pragma unroll
                for (int ks = 0; ks < 4; ++ks) a[gq][ks] = *(const bf16x8*)(ap + ks * 32); }
            __builtin_amdgcn_sched_barrier(0);
#pragma unroll
            for (int gq = 0; gq < 3; ++gq) {
                f32x4v acc[3] = {{0.f, 0.f, 0.f, 0.f}, {0.f, 0.f, 0.f, 0.f}, {0.f, 0.f, 0.f, 0.f}};
#pragma unroll
                for (int ks = 0; ks < 4; ++ks)
#pragma unroll
                    for (int ct = 0; ct < 3; ++ct) { acc[ct] = __builtin_amdgcn_mfma_f32_16x16x32_bf16(a[gq][ks], bh[ks][ct], acc[ct], 0, 0, 0); acc[ct] = __builtin_amdgcn_mfma_f32_16x16x32_bf16(a[gq][ks], bl[ks][ct], acc[ct], 0, 0, 0); }
#pragma unroll
                for (int ct = 0; ct < 3; ++ct)
#pragma unroll
                    for (int r = 0; r < 4; ++r) lg[((gq * 8 + wid) * 16 + 4 * kq + r) * 48 + ct * 16 + r16] = acc[ct][r];
            }
            __syncthreads();
            for (int o = tid; o < 3 * 768; o += NTHR) { const int gq = o >= 1536 ? 2 : (o >= 768 ? 1 : 0), rem = o - gq * 768; float s = 0.f;
#pragma unroll
                for (int w = 0; w < 8; ++w) s += lg[(gq * 8 + w) * 768 + rem];
                lgs[o] = s; }
            __syncthreads();
            if (tid < 48) {
                const int a = a0 + (g0 + (tid >> 4)) * 16 + (tid & 15);
                if (g0 + (tid >> 4) < ng && a < a1) {
                    const LAS float* x = lgs + tid * 48;
                    float gl[4]; int gs = 0; float gmax;
#pragma unroll
                    for (int j = 0; j < 4; ++j) gl[j] = x[j] + brl[j];
                    gmax = gl[0];
#pragma unroll
                    for (int j = 1; j < 4; ++j) if (gl[j] > gmax) { gmax = gl[j]; gs = j; }
                    float gsum = 0.f;
#pragma unroll
                    for (int j = 0; j < 4; ++j) gsum += __expf(gl[j] - gmax);
                    const float pg = 1.0f / gsum;
                    float v1 = -3.0e38f, v2 = -3.0e38f; int i1 = 0, i2 = 0;
                    for (int j = 0; j < 8; ++j) { const float ev = x[4 + gs * 8 + j] + brl[4 + gs * 8 + j];
                        if (ev > v1) { v2 = v1; i2 = i1; v1 = ev; i1 = j; } else if (ev > v2) { v2 = ev; i2 = j; } }
                    const float t = __expf(v2 - v1); const float w1 = pg / (1.0f + t), w2 = pg * t / (1.0f + t);
                    const int e1 = gs * 8 + i1, e2 = gs * 8 + i2, i = a - a0;
                    re[i] = e1; re[256 + i] = e2; rw[i] = w1; rw[256 + i] = w2;
                }
            }
            __syncthreads();
        }
    }
    __syncthreads();
    PSEC(12);
    if (tid < 32) { int c = 0; for (int i = 0; i < na; ++i) { if (re[i] == tid) rr[i] = c++; if (re[256 + i] == tid) rr[256 + i] = c++; } hist[tid] = c; }
    __syncthreads();
    int* hg = (int*)(p.ws + WS_CTL) + CW_HIST + (l * 256 + bid) * 32;
    if (tid < 32) hg[tid] = hist[tid];
    (void)base;
    int* EID = (int*)(p.ws + WS_EID); float* WTK = (float*)(p.ws + WS_WTK); int* POS = (int*)(p.ws + WS_POS);
    for (int i = tid; i < na; i += NTHR) { const size_t R = (size_t)active_row(l, a0 + i);
        EID[2 * R] = re[i]; EID[2 * R + 1] = re[256 + i]; WTK[2 * R] = rw[i]; WTK[2 * R + 1] = rw[256 + i];
        POS[2 * R] = rr[i]; POS[2 * R + 1] = rr[256 + i]; }
    __syncthreads();
    PSEC(13);
}
__device__ __forceinline__ void moe_segments(const Params& p, int l, LAS int* seg, int myblk) {
    const int tid = opaque_tid(); LAS int* cnt = seg + 40; LAS int* pre = seg + 80; LAS int* part = seg + 4096;
    { const int e = tid & 31, pt = tid >> 5, nb = (int)gridDim.x, per = (nb + 15) >> 4;
      const int* hg = (const int*)(p.ws + WS_CTL) + CW_HIST + l * 256 * 32 + e; int tot = 0, pr = 0;
      for (int b = pt * per; b < (pt + 1) * per && b < nb; ++b) { const int c = hg[b * 32]; if (b < myblk) pr += c; tot += c; }
      part[(pt * 2) * 32 + e] = tot; part[(pt * 2 + 1) * 32 + e] = pr; }
    __syncthreads();
    if (tid < 32) { int tot = 0, pr = 0;
#pragma unroll
        for (int pt = 0; pt < 16; ++pt) { tot += part[(pt * 2) * 32 + tid]; pr += part[(pt * 2 + 1) * 32 + tid]; }
        cnt[tid] = tot; pre[tid] = pr; }
    __syncthreads();
    if (tid == 0) { int s = 0; for (int e = 0; e < 32; ++e) { seg[e] = s; s += (cnt[e] + 255) & ~255; } if (s > SLOTS) s = SLOTS; seg[32] = s; }
    __syncthreads();
}
__device__ __forceinline__ void phase_dispatch(const Params& p, int l, LAS unsigned char* lds) {
    const int tid = opaque_tid(), G = gridDim.x, bid = blockIdx.x;
    LAS int* seg = (LAS int*)lds; moe_segments(p, l, seg, bid); const LAS int* cnt = seg + 40; const LAS int* pre = seg + 80;
    const int NA = l == 0 ? MTOT : NBATCH * SEQ;
    const int chunk = (((NA + G - 1) / G) + 15) & ~15;
    const int a0 = bid * chunk, a1 = (a0 + chunk < NA) ? a0 + chunk : NA;
    const int* EID = (const int*)(p.ws + WS_EID); const float* WTK = (const float*)(p.ws + WS_WTK); int* POS = (int*)(p.ws + WS_POS); float* WTS = (float*)(p.ws + WS_WTS); int* SRC = (int*)(p.ws + WS_SRC);
    for (int i = tid; i < 2 * (a1 - a0); i += NTHR) {
        const int R = active_row(l, a0 + (i >> 1)); const size_t x = 2 * (size_t)R + (i & 1);
        const int e = EID[x], ps = POS[x]; const float w = WTK[x];
        const int s = seg[e] + pre[e] + ps;
        SRC[s] = R; POS[x] = s; WTS[s] = w; }
    for (int e = bid; e < 32; e += G)
        for (int s = seg[e] + cnt[e] + tid; s < seg[e + 1]; s += NTHR) SRC[s] = 0;
    __syncthreads();
}
__device__ __forceinline__ int moe_tile_table(const Params& p, int l, LAS int* seg, LAS int* tile_e) {
    moe_segments(p, l, seg, 0);
    const int nt = seg[32] >> 8;
    for (int i = opaque_tid(); i < nt; i += NTHR) { int e = 0; for (int k = 1; k < 32; ++k) if ((i << 8) >= seg[k]) e = k; tile_e[i] = e; }
    __syncthreads();
    return __builtin_amdgcn_readfirstlane(nt);
}
__device__ __forceinline__ void lds_addf(LAS float* a, float v) { (void)__hip_atomic_fetch_add(a, v, __ATOMIC_RELAXED, __HIP_MEMORY_SCOPE_WORKGROUP); }
__device__ __forceinline__ bf16_t* pbuf(const Params& p, size_t off) { return (bf16_t*)(p.ws + WS_P + off); }
#ifndef MMU
#define MMU 2
#endif
__device__ __forceinline__ void mm128(const LAS bf16_t* A, const LAS bf16_t* Bt, f32x16 (&acc)[2], int wid, int lane) {
    const int r32 = lane & 31, hi = lane >> 5;
    const LAS bf16_t* ap = A + (32 * (wid >> 1) + r32) * TLD + hi * 8;
    const LAS bf16_t* bp = Bt + (64 * (wid & 1) + r32) * TLD + hi * 8;
#pragma unroll MMU
    for (int ks = 0; ks < 8; ++ks) {
        const bf16x8 a = *(const LAS bf16x8*)(ap + ks * 16), b0 = *(const LAS bf16x8*)(bp + ks * 16), b1 = *(const LAS bf16x8*)(bp + 32 * TLD + ks * 16);
        acc[0] = mfma32(a, b0, acc[0]); acc[1] = mfma32(a, b1, acc[1]);
    }
}
__device__ __forceinline__ void mm128_gB(const LAS bf16_t* A, const bf16_t* __restrict__ Bg, f32x16 (&acc)[2], int wid, int lane) {
    const int r32 = lane & 31, hi = lane >> 5;
    const LAS bf16_t* ap = A + (32 * (wid >> 1) + r32) * TLD + hi * 8;
    const bf16_t* bp = Bg + (64 * (wid & 1) + r32) * 128 + hi * 8;
#pragma unroll MMU
    for (int ks = 0; ks < 8; ++ks) {
        const bf16x8 a = *(const LAS bf16x8*)(ap + ks * 16), b0 = *(const bf16x8*)(bp + ks * 16), b1 = *(const bf16x8*)(bp + 32 * 128 + ks * 16);
        acc[0] = mfma32(a, b0, acc[0]); acc[1] = mfma32(a, b1, acc[1]);
    }
}
__device__ __forceinline__ void st_acc_T(LAS bf16_t* T, const f32x16 (&acc)[2], int wid, int lane) {
    const int r32 = lane & 31, hi = lane >> 5;
#pragma unroll
    for (int tl = 0; tl < 2; ++tl)
#pragma unroll
        for (int g = 0; g < 4; ++g) { u32x2 w; w.x = cvtpk(acc[tl][4 * g], acc[tl][4 * g + 1]); w.y = cvtpk(acc[tl][4 * g + 2], acc[tl][4 * g + 3]);
            *(LAS u32x2*)(T + (64 * (wid & 1) + 32 * tl + r32) * TLD + 32 * (wid >> 1) + 8 * g + 4 * hi) = w; }
}

__device__ __forceinline__ void st_acc_rm(LAS bf16_t* T, const f32x16 (&acc)[2], int wid, int lane) {
    const int r32 = lane & 31, hi = lane >> 5;
    LAS bf16_t* b = T + (32 * (wid >> 1) + 4 * hi) * TLD + 64 * (wid & 1) + r32;
#pragma unroll
    for (int tl = 0; tl < 2; ++tl)
#pragma unroll
        for (int r = 0; r < 16; ++r) b[((r & 3) + 8 * (r >> 2)) * TLD + 32 * tl] = (bf16_t)(cvtpk(acc[tl][r], acc[tl][r]) & 0xffffu);
}
constexpr int FLD = 132;
__device__ __forceinline__ void st_acc_f32(LAS float* F, const f32x16 (&acc)[2], int wid, int lane) {
    const int r32 = lane & 31, hi = lane >> 5;
    LAS float* b = F + (32 * (wid >> 1) + 4 * hi) * FLD + 64 * (wid & 1) + r32;
#pragma unroll
    for (int tl = 0; tl < 2; ++tl)
#pragma unroll
        for (int r = 0; r < 16; ++r) b[((r & 3) + 8 * (r >> 2)) * FLD + 32 * tl] = acc[tl][r];
}
__device__ __forceinline__ void copy_tile_out(const LAS bf16_t* T, bf16_t* dst, int ld) {
    const int tx = opaque_tid(), t = tx >> 2, c0 = (tx & 3) * 32;
#pragma unroll
    for (int i = 0; i < 4; ++i) *(u32x4*)(dst + (size_t)t * ld + c0 + 8 * i) = *(const LAS u32x4*)(T + t * TLD + c0 + 8 * i);
}

__device__ __forceinline__ bool seq_start(int r) { return r < CTXROWS ? (r & 255) == 0 : ((r - CTXROWS) & 2047) == 0; }
template <int CTRL> __device__ __forceinline__ u32x4 dpp4(const u32x4 v) { u32x4 o;
    o.x = (unsigned)__builtin_amdgcn_update_dpp(0, (int)v.x, CTRL, 0xf, 0xf, true); o.y = (unsigned)__builtin_amdgcn_update_dpp(0, (int)v.y, CTRL, 0xf, 0xf, true);
    o.z = (unsigned)__builtin_amdgcn_update_dpp(0, (int)v.z, CTRL, 0xf, 0xf, true); o.w = (unsigned)__builtin_amdgcn_update_dpp(0, (int)v.w, CTRL, 0xf, 0xf, true); return o; }
__device__ __forceinline__ void phase_conv(const Params& p, int l, LAS unsigned char* lds) {
    const int tid = opaque_tid(), wid = __builtin_amdgcn_readfirstlane(tid >> 6), lane = tid & 63, r16 = lane & 15, kg = lane >> 4, G = gridDim.x, bid = blockIdx.x;
    constexpr int NG = MH / 16, NU = 5;
    const bf16_t* XM = pbuf(p, P_XMB); bf16_t* XCV = pbuf(p, P_XCV); float* GT = (float*)(p.ws + WS_P + P_GATES);
    LAS float* PX = (LAS float*)lds;
    for (int g0 = bid; g0 < NG; g0 += NU * G) {
        f32x4v acc[NU];
#pragma unroll
        for (int u = 0; u < NU; ++u) acc[u] = (f32x4v){0.f, 0.f, 0.f, 0.f};
#pragma unroll 1
        for (int ks = 0; ks < 2; ++ks) {
            const int c = 64 * wid + 32 * ks + 8 * kg;
            u32x4 cur[NU], edge[NU];
#pragma unroll
            for (int u = 0; u < NU; ++u) { const int g = g0 + G * u; const bool valid = g < NG; const int row = 16 * g + r16;
                cur[u] = valid ? *(const u32x4*)(XM + (size_t)row * 512 + c) : (u32x4){0u, 0u, 0u, 0u};
                const bool he = valid && ((r16 == 0 && !seq_start(16 * g)) || (r16 == 15 && !seq_start(16 * g + 16)));
                const int er = r16 == 0 ? row - 1 : row + 1;
                edge[u] = he ? *(const u32x4*)(XM + (size_t)er * 512 + c) : (u32x4){0u, 0u, 0u, 0u}; }
            float w0[8], w1[8], w2[8], bc[8];
            { const float* wc = p.in[I_WCONV] + (size_t)l * 3 * 512 + c; const float* bcp = p.in[I_BCONV] + (size_t)l * 512 + c;
#pragma unroll
              for (int j = 0; j < 8; ++j) { w0[j] = wc[j]; w1[j] = wc[512 + j]; w2[j] = wc[1024 + j]; bc[j] = bcp[j]; } }
            bf16x8 wyh, wyl, wxh, wxl;
            { const float* wf = (const float*)(p.ws + WS_WFOLD) + ((size_t)l * 16 + r16) * 1024 + c; float a[8], b[8], t8[8];
#pragma unroll
              for (int j = 0; j < 8; ++j) { a[j] = wf[j]; b[j] = wf[512 + j]; }
              u32x4 hh = pack8(a); unpack8(hh, t8);
#pragma unroll
              for (int j = 0; j < 8; ++j) t8[j] = a[j] - t8[j];
              u32x4 ll = pack8(t8); wyh = *(const bf16x8*)&hh; wyl = *(const bf16x8*)&ll;
              hh = pack8(b); unpack8(hh, t8);
#pragma unroll
              for (int j = 0; j < 8; ++j) t8[j] = b[j] - t8[j];
              ll = pack8(t8); wxh = *(const bf16x8*)&hh; wxl = *(const bf16x8*)&ll; }
#pragma unroll
            for (int u = 0; u < NU; ++u) { const int g = g0 + G * u;
                const u32x4 sp = dpp4<0x111>(cur[u]), sn = dpp4<0x101>(cur[u]);
                u32x4 pw, nw;
                pw.x = r16 == 0 ? edge[u].x : sp.x; pw.y = r16 == 0 ? edge[u].y : sp.y; pw.z = r16 == 0 ? edge[u].z : sp.z; pw.w = r16 == 0 ? edge[u].w : sp.w;
                nw.x = r16 == 15 ? edge[u].x : sn.x; nw.y = r16 == 15 ? edge[u].y : sn.y; nw.z = r16 == 15 ? edge[u].z : sn.z; nw.w = r16 == 15 ? edge[u].w : sn.w;
                float xp[8], xc[8], xn[8], y[8], yl[8]; unpack8(pw, xp); unpack8(cur[u], xc); unpack8(nw, xn);
#pragma unroll
                for (int j = 0; j < 8; ++j) y[j] = silu_f(w0[j] * xp[j] + w1[j] * xc[j] + w2[j] * xn[j] + bc[j]);
                const u32x4 yh = pack8(y); unpack8(yh, yl);
#pragma unroll
                for (int j = 0; j < 8; ++j) yl[j] = y[j] - yl[j];
                const u32x4 ylw = pack8(yl);
                const bf16x8 ah = *(const bf16x8*)&yh, al = *(const bf16x8*)&ylw, ax = *(const bf16x8*)&cur[u];
                acc[u] = __builtin_amdgcn_mfma_f32_16x16x32_bf16(ah, wyh, acc[u], 0, 0, 0); acc[u] = __builtin_amdgcn_mfma_f32_16x16x32_bf16(ah, wyl, acc[u], 0, 0, 0);
                acc[u] = __builtin_amdgcn_mfma_f32_16x16x32_bf16(al, wyh, acc[u], 0, 0, 0);
                acc[u] = __builtin_amdgcn_mfma_f32_16x16x32_bf16(ax, wxh, acc[u], 0, 0, 0); acc[u] = __builtin_amdgcn_mfma_f32_16x16x32_bf16(ax, wxl, acc[u], 0, 0, 0);
                if (g < NG) *(u32x4*)(XCV + (size_t)(16 * g + r16) * 512 + c) = yh; }
        }
#pragma unroll
        for (int u = 0; u < NU; ++u)
#pragma unroll
            for (int r = 0; r < 4; ++r) PX[((u * 8 + wid) * 16 + 4 * kg + r) * 16 + r16] = acc[u][r];
        __syncthreads();
        for (int o = tid; o < NU * 256; o += NTHR) { const int u = o >> 8, row = (o >> 4) & 15, n = o & 15, g = g0 + G * u; float s = p.in[I_BIF][l * 16 + n];
#pragma unroll
            for (int w = 0; w < 8; ++w) s += PX[((u * 8 + w) * 16 + row) * 16 + n];
            if (g < NG) GT[(size_t)(16 * g + row) * 16 + (n & 3) * 4 + (n >> 2)] = s; }
        __syncthreads();
    }
}
__device__ __forceinline__ void ld8row(const bf16_t* base, int pos, int seqlen, float (&o)[8]) {
    if (pos < 0 || pos >= seqlen) {
#pragma unroll
        for (int j = 0; j < 8; ++j) o[j] = 0.f; }
    else unpack8(*(const u32x4*)(base + (size_t)pos * 512), o);
}
__device__ __forceinline__ void mlstm_a_ids(int u, int& bl, int& J, int& h, int& r0) {
    bl = u / (NJ * 4); const int rem = u - bl * (NJ * 4); J = rem >> 2; h = rem & 3;
    r0 = (J < 2 ? bl * 256 : CTXROWS + bl * 2048) + (J < 2 ? J * 128 : (J - 2) * 128);
}
#define APRE_PARAMS u32x4 (&qa)[4], u32x4 (&qb)[4], u32x4 (&qwq)[4], u32x4 (&qwk)[4], u32x4 (&qwv)[4], f32x4& qg
#define APRE_ARGS qa, qb, qwq, qwk, qwv, qg
__device__ __forceinline__ void mlstm_a_load(const Params& p, int l, int u, APRE_PARAMS) {
    const int tid = opaque_tid(); int bl, J, h, r0; mlstm_a_ids(u, bl, J, h, r0);
    const int t = tid >> 2, cc = (tid & 3) * 32; const size_t o = (size_t)(r0 + t) * 512 + h * 128 + cc;
    const bf16_t* XM = pbuf(p, P_XMB) + o; const bf16_t* XCV = pbuf(p, P_XCV) + o;
    const bf16_t* Wq = (const bf16_t*)(p.ws + WS_WTQKV) + ((size_t)(l * 3) * 4 + h) * 16384 + t * 128 + cc;
#pragma unroll
    for (int i = 0; i < 4; ++i) { qa[i] = *(const u32x4*)(XCV + 8 * i); qb[i] = *(const u32x4*)(XM + 8 * i);
        qwq[i] = *(const u32x4*)(Wq + 8 * i); qwk[i] = *(const u32x4*)(Wq + (size_t)4 * 16384 + 8 * i); qwv[i] = *(const u32x4*)(Wq + (size_t)8 * 16384 + 8 * i); }
    qg = *(const f32x4*)((const float*)(p.ws + WS_P + P_GATES) + (size_t)(r0 + (tid & 127)) * 16 + h * 4);
}
__device__ __forceinline__ void mlstm_a_unit(const Params& p, int l, int u, int unext, int n_a, APRE_PARAMS, LAS unsigned char* lds) {
    int tid_ = threadIdx.x; asm volatile("" : "+v"(tid_));
    const int tid = tid_, wid = __builtin_amdgcn_readfirstlane(tid >> 6), lane = tid & 63, r32 = lane & 31, hi = lane >> 5;
    LAS bf16_t* T0 = (LAS bf16_t*)lds; LAS bf16_t* T1 = (LAS bf16_t*)(lds + TILE_B); LAS bf16_t* T2 = (LAS bf16_t*)(lds + 2 * TILE_B); LAS bf16_t* T3 = (LAS bf16_t*)(lds + 3 * TILE_B);
    LAS float* gl = (LAS float*)(lds + 4 * TILE_B);
    LAS float* wend = gl + 512;
    int bl, J, h, r0; mlstm_a_ids(u, bl, J, h, r0);
    const int wr_ = tid >> 2, wc_ = (tid & 3) * 32;
    u32x4 wv_[4];
#pragma unroll
    for (int i = 0; i < 4; ++i) { *(LAS u32x4*)(T0 + wr_ * TLD + wc_ + 8 * i) = qa[i]; *(LAS u32x4*)(T1 + wr_ * TLD + wc_ + 8 * i) = qb[i];
        *(LAS u32x4*)(T2 + wr_ * TLD + wc_ + 8 * i) = qwq[i]; *(LAS u32x4*)(T3 + wr_ * TLD + wc_ + 8 * i) = qwk[i]; wv_[i] = qwv[i]; }
    if (tid < 128) *(LAS f32x4*)(gl + tid * 4) = qg;
    LBAR();
    if (wid < 2) {
        const int dir = wid, p0 = 2 * lane, p1 = p0 + 1, s0 = dir ? 127 - p0 : p0, s1 = dir ? 127 - p1 : p1;
        const float ig0 = gl[s0 * 4 + 2 * dir], ig1 = gl[s1 * 4 + 2 * dir];
        const float lf0 = logsigmoid_f(gl[s0 * 4 + 2 * dir + 1]), lf1 = logsigmoid_f(gl[s1 * 4 + 2 * dir + 1]);
        float incl = lf0 + lf1;
        for (int o = 1; o < 64; o <<= 1) { const float t = __shfl_up(incl, o); if (lane >= o) incl += t; }
        const float bc1 = incl, bc0 = incl - lf1, gg = __shfl(incl, 63);
        const float ae0 = gg - bc0 + ig0, ae1 = gg - bc1 + ig1; const float ml = wave_max(fmaxf(ae0, ae1));
        wend[dir * 128 + s0] = __expf(ae0 - ml); wend[dir * 128 + s1] = __expf(ae1 - ml);
        if (lane == 0) { float* mst = (float*)(p.ws + WS_P + P_MST) + ((size_t)(((bl * 4 + h) * 2 + dir) * NJ + J)) * 4; mst[0] = ml; mst[1] = gg; }
    }
    f32x16 ack[2] = {};
    {
        f32x16 acq[2] = {}, akp[2] = {};
        mm128(T2, T0, acq, wid, lane); mm128(T0, T3, ack, wid, lane); mm128(T3, T0, akp, wid, lane);
        LBAR();
        st_acc_T(T2, acq, wid, lane); st_acc_T(T3, akp, wid, lane);
#pragma unroll
        for (int i = 0; i < 4; ++i) *(LAS u32x4*)(T0 + wr_ * TLD + wc_ + 8 * i) = wv_[i];
    }
    LBAR();
    copy_tile_out(T2, pbuf(p, P_MQ) + (size_t)r0 * 512 + h * 128, 512);
    copy_tile_out(T3, pbuf(p, P_MK) + (size_t)r0 * 512 + h * 128, 512);
    {
        f32x16 acv[2] = {}; mm128(T1, T0, acv, wid, lane);
        LBAR();
        st_acc_T(T2, ack, wid, lane); st_acc_T(T3, acv, wid, lane);
    }
    mlstm_a_load(p, l, unext < n_a ? unext : u, APRE_ARGS);
    LBAR();
    {
        bf16_t* MVT = pbuf(p, P_MVT) + ((size_t)((bl * NJ + J) * 4 + h)) * 16384; const int d = tid >> 2, s0 = (tid & 3) * 32;
#pragma unroll
        for (int i = 0; i < 4; ++i) *(u32x4*)(MVT + d * 128 + s0 + 8 * i) = *(const LAS u32x4*)(T3 + d * TLD + s0 + 8 * i);
    }
#pragma unroll 1
    for (int dir = 0; dir < 2; ++dir) {
        const int combo = (bl * 4 + h) * 2 + dir;
        f32x16 acc[2] = {};
        const LAS bf16_t* ap = T3 + (32 * (wid >> 1) + r32) * TLD + hi * 8; const LAS bf16_t* bp = T2 + (64 * (wid & 1) + r32) * TLD + hi * 8;
        const LAS float* wv = wend + dir * 128 + hi * 8;
#pragma unroll
        for (int ks = 0; ks < 8; ++ks) {
            float a8[8]; unpack8(*(const LAS u32x4*)(ap + ks * 16), a8);
            const f32x4 wa = *(const LAS f32x4*)(wv + ks * 16), wb = *(const LAS f32x4*)(wv + ks * 16 + 4);
#pragma unroll
            for (int j = 0; j < 4; ++j) { a8[j] *= wa[j]; a8[4 + j] *= wb[j]; }
            const u32x4 aw = pack8(a8); const bf16x8 a = *(const bf16x8*)&aw;
            const bf16x8 b0 = *(const LAS bf16x8*)(bp + ks * 16), b1 = *(const LAS bf16x8*)(bp + 32 * TLD + ks * 16);
            acc[0] = mfma32(a, b0, acc[0]); acc[1] = mfma32(a, b1, acc[1]);
        }
        bf16_t* CL = (bf16_t*)(p.ws + WS_P + P_CLOC) + ((size_t)combo * NJ + J) * 16384;
        LAS float* F = (LAS float*)lds;
        st_acc_f32(F, acc, wid, lane);
        LBAR();
        { const int d = tid >> 2, e0 = (tid & 3) * 32;
#pragma unroll
          for (int i = 0; i < 4; ++i) { const f32x4 a = *(const LAS f32x4*)(F + d * FLD + e0 + 8 * i), b = *(const LAS f32x4*)(F + d * FLD + e0 + 8 * i + 4);
              u32x4 w; w.x = cvtpk(a[0], a[1]); w.y = cvtpk(a[2], a[3]); w.z = cvtpk(b[0], b[1]); w.w = cvtpk(b[2], b[3]);
              *(u32x4*)(CL + d * 128 + e0 + 8 * i) = w; } }
        LBAR();
    }
    if (tid < 256) { const int dir = tid >> 7, e = tid & 127; float s = 0.f;
#pragma unroll 4
        for (int j = 0; j < 128; j += 8) { float k8[8]; unpack8(*(const LAS u32x4*)(T2 + e * TLD + j), k8);
            const f32x4 wa = *(const LAS f32x4*)(wend + dir * 128 + j), wb = *(const LAS f32x4*)(wend + dir * 128 + j + 4);
#pragma unroll
            for (int i = 0; i < 4; ++i) s += wa[i] * k8[i] + wb[i] * k8[4 + i]; }
        ((float*)(p.ws + WS_P + P_NLOC))[((size_t)(((bl * 4 + h) * 2 + dir) * NJ + J)) * 128 + e] = s; }
    LBAR();
}

__device__ __forceinline__ int scan_J(int dir, int pidx) { return dir == 0 ? pidx : (pidx == 0 ? 1 : (pidx == 1 ? 0 : 19 - pidx)); }
__device__ __forceinline__ void phase_scan(const Params& p) {
    const int NIT = 64 * 2048;
    bf16_t* CL = (bf16_t*)(p.ws + WS_P + P_CLOC); float* NL = (float*)(p.ws + WS_P + P_NLOC); float* MST = (float*)(p.ws + WS_P + P_MST);
    const int tid = opaque_tid();
    for (int w = blockIdx.x * NTHR + tid; w < NIT; w += gridDim.x * NTHR) {
        const int combo = w >> 11, q = w & 2047, dir = combo & 1; const bool hasn = q < 32;
        float m_st = 0.f; float st[8]; f32x4 s4 = {0.f, 0.f, 0.f, 0.f};
#pragma unroll
        for (int j = 0; j < 8; ++j) st[j] = 0.f;
        bf16_t* base = CL + (size_t)combo * NJ * 16384 + 8 * q; float* nbase = NL + (size_t)combo * NJ * 128 + 4 * (q & 31);
#pragma unroll 1
        for (int i = 0; i < NJ; ++i) {
            const int J = scan_J(dir, i); float* ms = MST + ((size_t)combo * NJ + J) * 4;
            const u32x4 vc = *(const u32x4*)(base + (size_t)J * 16384);
            f32x4 vn = {0.f, 0.f, 0.f, 0.f}; if (hasn) vn = *(const f32x4*)(nbase + (size_t)J * 128);
            const float ml = ms[0], gg = ms[1];
            const float m_new = fmaxf(gg + m_st, ml), a_old = __expf(gg + m_st - m_new), a_new = __expf(ml - m_new);
            *(u32x4*)(base + (size_t)J * 16384) = pack8(st);
            if (hasn) *(f32x4*)(nbase + (size_t)J * 128) = s4;
            if (q == 0) ms[2] = m_st;
            float c8[8]; unpack8(vc, c8);
#pragma unroll
            for (int j = 0; j < 8; ++j) st[j] = st[j] * a_old + c8[j] * a_new;
            s4 = s4 * a_old + vn * a_new; m_st = m_new;
        }
    }
}

__device__ __forceinline__ unsigned zap_nf(unsigned w) { if ((w & 0x7f80u) >= 0x4980u) w &= 0xffff0000u; if ((w & 0x7f800000u) >= 0x49800000u) w &= 0x0000ffffu; return w; }
template <int dir>
__device__ __forceinline__ void mlstm_c_dir(const unsigned (&Xp)[4][8], f32x16 (&acc)[2], const LAS bf16_t* Tq, const LAS bf16_t* Tc, const LAS bf16_t* Tv,
                                            const LAS float* av, const LAS float* Mv, const LAS float* wi, LAS float* denw, const LAS float* n0l, int wid, int lane) {
    const int r32 = lane & 31, hi = lane >> 5, tb = wid >> 1, t = 32 * tb + r32;
    acc[0] = f32x16{}; acc[1] = f32x16{};
    mm128(Tq, Tc, acc, wid, lane);
#pragma unroll
    for (int r = 0; r < 16; ++r) { const float w = wi[dir * 128 + 32 * tb + crow(r, hi)]; acc[0][r] *= w; acc[1][r] *= w; }
    float nq = 0.f;
#pragma unroll
    for (int i = 0; i < 8; ++i) { float q8[8]; unpack8(*(const LAS u32x4*)(Tq + t * TLD + 64 * hi + 8 * i), q8);
        const f32x4 na = *(const LAS f32x4*)(n0l + dir * 128 + 64 * hi + 8 * i), nb = *(const LAS f32x4*)(n0l + dir * 128 + 64 * hi + 8 * i + 4);
#pragma unroll
        for (int j = 0; j < 4; ++j) nq += na[j] * q8[j] + nb[j] * q8[4 + j]; }
    const float Mt = Mv[dir * 128 + t]; float den = 0.f;
    const LAS bf16_t* vp = Tv + (64 * (wid & 1) + r32) * TLD + 4 * hi;
#pragma unroll
    for (int sb = 0; sb < 4; ++sb) {
        float o[16];
#pragma unroll
        for (int r = 0; r < 16; ++r) { const int s = 32 * sb + crow(r, hi); const bool ok = dir ? (s >= t) : (s <= t);
            const float xs = (r & 1) ? bf_hi(Xp[sb][r >> 1]) : bf_lo(Xp[sb][r >> 1]);
            const float ev = xs * __builtin_amdgcn_exp2f((av[dir * 128 + s] - Mt) * LOG2E);
            o[r] = ok ? ev : 0.f; den += o[r]; }
#pragma unroll
        for (int s2 = 0; s2 < 2; ++s2) {
            u32x4 aw; aw.x = cvtpk(o[8 * s2 + 0], o[8 * s2 + 1]); aw.y = cvtpk(o[8 * s2 + 2], o[8 * s2 + 3]); aw.z = cvtpk(o[8 * s2 + 4], o[8 * s2 + 5]); aw.w = cvtpk(o[8 * s2 + 6], o[8 * s2 + 7]);
            const bf16x8 af = *(const bf16x8*)&aw;
#pragma unroll
            for (int tl = 0; tl < 2; ++tl) { const LAS bf16_t* bp = vp + 32 * tl * TLD + 32 * sb + 16 * s2;
                const u32x2 b0 = *(const LAS u32x2*)bp, b1 = *(const LAS u32x2*)(bp + 8); u32x4 bw; bw.x = b0.x; bw.y = b0.y; bw.z = b1.x; bw.w = b1.y;
                acc[tl] = mfma32(af, *(const bf16x8*)&bw, acc[tl]); }
        }
        __builtin_amdgcn_sched_barrier(0);
    }
    { auto rr = __builtin_amdgcn_permlane32_swap(__float_as_uint(den), __float_as_uint(den), false, false); den = __uint_as_float(rr[0]) + __uint_as_float(rr[1]); }
    { auto rr = __builtin_amdgcn_permlane32_swap(__float_as_uint(nq), __float_as_uint(nq), false, false); nq = __uint_as_float(rr[0]) + __uint_as_float(rr[1]); }
    if (hi == 0) denw[(wid * 2 + dir) * 32 + r32] = den + wi[dir * 128 + t] * nq;
}
__device__ __forceinline__ void mlstm_c_unit(const Params& p, int l, int bl, int J, int h, LAS unsigned char* lds) {
    int tid_ = threadIdx.x; asm volatile("" : "+v"(tid_));
    const int tid = tid_, wid = __builtin_amdgcn_readfirstlane(tid >> 6), lane = tid & 63, r32 = lane & 31, hi = lane >> 5;
    LAS bf16_t* Tq = (LAS bf16_t*)lds; LAS bf16_t* Tk = (LAS bf16_t*)(lds + TILE_B); LAS bf16_t* Tv = (LAS bf16_t*)(lds + 2 * TILE_B); LAS bf16_t* Ts = (LAS bf16_t*)(lds + 3 * TILE_B);
    LAS float* sc = (LAS float*)(lds + 4 * TILE_B);
    LAS float* gl = sc;
    LAS float* av = sc + 512;
    LAS float* Mv = sc + 768;
    LAS float* wi = sc + 1024;
    LAS float* fl = sc + 1280;
    LAS float* ssq = sc + 1536;
    LAS float* denp = sc + 1664;
    LAS float* n0l = sc + 2944;
    const int rseq = J < 2 ? bl * 256 : CTXROWS + bl * 2048, r0 = rseq + (J < 2 ? J * 128 : (J - 2) * 128);
    u32x4 cf_[4], cbp_[4];
    { const int d_ = tid >> 2, e_ = (tid & 3) * 32; const bf16_t* c0f = (const bf16_t*)(p.ws + WS_P + P_CLOC) + ((size_t)((bl * 4 + h) * 2) * NJ + J) * 16384 + d_ * 128 + e_;
#pragma unroll
      for (int i = 0; i < 4; ++i) { cf_[i] = *(const u32x4*)(c0f + 8 * i); cbp_[i] = *(const u32x4*)(c0f + (size_t)NJ * 16384 + 8 * i); } }
    {
        const int t = tid >> 2, c0 = (tid & 3) * 32;
        const bf16_t* q = pbuf(p, P_MQ) + (size_t)(r0 + t) * 512 + h * 128 + c0; const bf16_t* k = pbuf(p, P_MK) + (size_t)(r0 + t) * 512 + h * 128 + c0;
        const bf16_t* v = pbuf(p, P_MVT) + ((size_t)((bl * NJ + J) * 4 + h)) * 16384 + t * 128 + c0;
#pragma unroll
        for (int i = 0; i < 4; ++i) { *(LAS u32x4*)(Tq + t * TLD + c0 + 8 * i) = *(const u32x4*)(q + 8 * i); *(LAS u32x4*)(Tk + t * TLD + c0 + 8 * i) = *(const u32x4*)(k + 8 * i);
            *(LAS u32x4*)(Tv + t * TLD + c0 + 8 * i) = *(const u32x4*)(v + 8 * i); }
        if (tid < 128) { *(LAS f32x4*)(gl + tid * 4) = *(const f32x4*)((const float*)(p.ws + WS_P + P_GATES) + (size_t)(r0 + tid) * 16 + h * 4); ssq[tid] = 0.f; }
        if (tid < 256) n0l[tid] = ((const float*)(p.ws + WS_P + P_NLOC))[((size_t)(((bl * 4 + h) * 2 + (tid >> 7)) * NJ + J)) * 128 + (tid & 127)];
    }
    __syncthreads();
    { const int d_ = tid >> 2, e_ = (tid & 3) * 32;
#pragma unroll
      for (int i = 0; i < 4; ++i) *(LAS u32x4*)(Ts + d_ * TLD + e_ + 8 * i) = cf_[i]; }
    const float* MST = (const float*)(p.ws + WS_P + P_MST);
    if (wid < 2) {
        const int dir = wid, p0 = 2 * lane, p1 = p0 + 1, s0 = dir ? 127 - p0 : p0, s1 = dir ? 127 - p1 : p1;
        const float m0 = ld_f32_dev(MST + ((size_t)(((bl * 4 + h) * 2 + dir) * NJ + J)) * 4 + 2);
        const float ig0 = gl[s0 * 4 + 2 * dir], ig1 = gl[s1 * 4 + 2 * dir];
        const float lf0 = logsigmoid_f(gl[s0 * 4 + 2 * dir + 1]), lf1 = logsigmoid_f(gl[s1 * 4 + 2 * dir + 1]);
        float incl = lf0 + lf1;
        for (int o = 1; o < 64; o <<= 1) { const float t = __shfl_up(incl, o); if (lane >= o) incl += t; }
        const float bc1 = incl, bc0 = incl - lf1;
        const float a0 = ig0 - bc0, a1 = ig1 - bc1;
        float mx = fmaxf(a0, a1);
        for (int o = 1; o < 64; o <<= 1) { const float t = __shfl_up(mx, o); if (lane >= o) mx = fmaxf(mx, t); }
        float mxprev = __shfl_up(mx, 1); if (lane == 0) mxprev = -3.0e38f;
        const float M0 = fmaxf(m0, fmaxf(mxprev, a0)), M1 = fmaxf(m0, mx);
        av[dir * 128 + s0] = a0; av[dir * 128 + s1] = a1; Mv[dir * 128 + s0] = M0; Mv[dir * 128 + s1] = M1;
        wi[dir * 128 + s0] = __expf(m0 - M0); wi[dir * 128 + s1] = __expf(m0 - M1);
        fl[dir * 128 + s0] = __expf(-bc0 - M0); fl[dir * 128 + s1] = __expf(-bc1 - M1);
    }
    __builtin_amdgcn_sched_barrier(0);
    unsigned Xp[4][8];
    {
    f32x16 X[4] = {};
    { const LAS bf16_t* bq = Tq + (32 * (wid >> 1) + r32) * TLD + hi * 8; const LAS bf16_t* ak = Tk + r32 * TLD + hi * 8;
#pragma unroll 2
      for (int ks = 0; ks < 8; ++ks) { const bf16x8 b = *(const LAS bf16x8*)(bq + ks * 16);
#pragma unroll
          for (int sb = 0; sb < 4; ++sb) X[sb] = mfma32(*(const LAS bf16x8*)(ak + 32 * sb * TLD + ks * 16), b, X[sb]); } }
#pragma unroll
    for (int sb = 0; sb < 4; ++sb)
#pragma unroll
        for (int i = 0; i < 8; ++i) Xp[sb][i] = cvtpk(X[sb][2 * i], X[sb][2 * i + 1]);
    }
    __syncthreads();
    { const int d_ = tid >> 2, e_ = (tid & 3) * 32;
#pragma unroll
      for (int i = 0; i < 4; ++i) *(LAS u32x4*)(Tk + d_ * TLD + e_ + 8 * i) = cbp_[i]; }
    __syncthreads();
    f32x16 ao0[2], ao1[2];
    LAS float* denw = denp;
    mlstm_c_dir<0>(Xp, ao0, Tq, Ts, Tv, av, Mv, wi, denw, n0l, wid, lane);
    mlstm_c_dir<1>(Xp, ao1, Tq, Tk, Tv, av, Mv, wi, denw, n0l, wid, lane);
    float hv[2][16];
#pragma unroll
    for (int r = 0; r < 16; ++r) { const int t = 32 * (wid >> 1) + crow(r, hi);
        const float df = denw[(wid * 2 + 0) * 32 + crow(r, hi)], db = denw[(wid * 2 + 1) * 32 + crow(r, hi)];
        const float rf = 1.0f / fmaxf(fabsf(df), fl[t]), rb = 1.0f / fmaxf(fabsf(db), fl[128 + t]);
        hv[0][r] = ao0[0][r] * rf + ao1[0][r] * rb; hv[1][r] = ao0[1][r] * rf + ao1[1][r] * rb;
        float q = hv[0][r] * hv[0][r] + hv[1][r] * hv[1][r];
        q = half_sum31(q);
        if (r32 == 31) lds_addf(&ssq[t], q); }
    __syncthreads();
    const float* gm = p.in[I_GMN] + l * 512 + h * 128; const float* sk = p.in[I_SKIP] + l * 512 + h * 128;
    f32x16 hn[2];
#pragma unroll
    for (int tl = 0; tl < 2; ++tl) { const float gd = gm[64 * (wid & 1) + 32 * tl + r32];
#pragma unroll
        for (int r = 0; r < 16; ++r) hn[tl][r] = hv[tl][r] * rsqrtf(ssq[32 * (wid >> 1) + crow(r, hi)] * (1.0f / 128.0f) + EPS) * gd; }
    LAS float* F = (LAS float*)lds;
    st_acc_f32(F, hn, wid, lane);
    __syncthreads();
    { int te_ = tid; asm volatile("" : "+v"(te_));
      const int t = te_ >> 2, c0 = (te_ & 3) * 32; const size_t o = (size_t)(r0 + t) * 512 + h * 128 + c0;
      const bf16_t* xcv = pbuf(p, P_XCV) + o; bf16_t* zb = pbuf(p, P_ZB) + o;
      u32x4 xw[4], zw[4]; f32x4 s0[4], s1[4];
#pragma unroll
      for (int i = 0; i < 4; ++i) { xw[i] = *(const u32x4*)(xcv + 8 * i); zw[i] = *(const u32x4*)(zb + 8 * i); s0[i] = *(const f32x4*)(sk + c0 + 8 * i); s1[i] = *(const f32x4*)(sk + c0 + 8 * i + 4); }
#pragma unroll
      for (int i = 0; i < 4; ++i) { float x8[8], z8[8]; unpack8(xw[i], x8); unpack8(zw[i], z8);
          const f32x4 h0 = *(const LAS f32x4*)(F + t * FLD + c0 + 8 * i), h1 = *(const LAS f32x4*)(F + t * FLD + c0 + 8 * i + 4);
#pragma unroll
          for (int j = 0; j < 4; ++j) { z8[j] = (h0[j] + s0[i][j] * x8[j]) * z8[j]; z8[4 + j] = (h1[j] + s1[i][j] * x8[4 + j]) * z8[4 + j]; }
          zw[i] = pack8(z8); }
#pragma unroll
      for (int i = 0; i < 4; ++i) *(u32x4*)(zb + 8 * i) = zw[i]; }
    __syncthreads();
}
namespace att {
constexpr int SHM_V = 64 * 128 * 2, SHM_K = 64 * 64 * 2, OFF_K = 2 * SHM_V, OFF_WS = OFF_K + 2 * SHM_K, OFF_ST = OFF_WS + 8 * 64 * 4, LDS_NEED = OFF_ST + 32 * 512 * 4;
static_assert(LDS_NEED <= LDS_BYTES - 64, "attention LDS");
constexpr float THR2 = 11.5f;
#define KSWZ64(row, colB) ((row) * 128 + ((colB) ^ (((row) & 7) << 4)))
#define ASBAR() __builtin_amdgcn_sched_barrier(0)
__device__ __forceinline__ void partialSM(f32x16& p0, f32x16& p1, float& m_reg, float& mn, float& alpha) {
    float pmax = p0[0];
#pragma unroll
    for (int r = 1; r < 16; ++r) pmax = fmaxf(pmax, p0[r]);
#pragma unroll
    for (int r = 0; r < 16; ++r) pmax = fmaxf(pmax, p1[r]);
    { auto rr = __builtin_amdgcn_permlane32_swap(__float_as_uint(pmax), __float_as_uint(pmax), false, false); pmax = fmaxf(__uint_as_float(rr[0]), __uint_as_float(rr[1])); }
    if (__builtin_expect(__all(pmax - m_reg <= THR2), 1)) { mn = m_reg; alpha = 1.f; }
    else { mn = fmaxf(m_reg, pmax); alpha = __builtin_amdgcn_exp2f(m_reg - mn); m_reg = mn; }
#pragma unroll
    for (int r = 0; r < 16; ++r) { p0[r] -= mn; p1[r] -= mn; }
#pragma unroll
    for (int r = 0; r < 16; ++r) p0[r] = __builtin_amdgcn_exp2f(p0[r]);
}
__device__ __forceinline__ void finishSM(f32x16& p0, f32x16& p1, float alpha, float& l_reg, bf16x8& pa0, bf16x8& pa1, bf16x8& pa2, bf16x8& pa3) {
#pragma unroll
    for (int r = 0; r < 16; ++r) p1[r] = __builtin_amdgcn_exp2f(p1[r]);
    float ps = 0;
#pragma unroll
    for (int r = 0; r < 16; ++r) ps += p0[r];
#pragma unroll
    for (int r = 0; r < 16; ++r) ps += p1[r];
    { auto rr = __builtin_amdgcn_permlane32_swap(__float_as_uint(ps), __float_as_uint(ps), false, false); ps = __uint_as_float(rr[0]) + __uint_as_float(rr[1]); }
    l_reg = l_reg * alpha + ps;
#define PK4(P, BASE, OUT) do { unsigned a0 = cvtpk(P[BASE + 0], P[BASE + 1]), a1 = cvtpk(P[BASE + 2], P[BASE + 3]);   \
    unsigned b0 = cvtpk(P[BASE + 4], P[BASE + 5]), b1 = cvtpk(P[BASE + 6], P[BASE + 7]);                              \
    auto r0 = __builtin_amdgcn_permlane32_swap(a0, b0, false, false); auto r1 = __builtin_amdgcn_permlane32_swap(a1, b1, false, false); \
    u32x4 w = {r0[0], r1[0], r0[1], r1[1]}; OUT = *reinterpret_cast<bf16x8*>(&w); } while (0)
    PK4(p0, 0, pa0); PK4(p0, 8, pa1); PK4(p1, 0, pa2); PK4(p1, 8, pa3);
#undef PK4
}
__device__ __forceinline__ void qkt(f32x16& p0, f32x16& p1, const LAS char* Ks, const bf16x8 (&qr)[4], int r32, int hi) {
    p0 = f32x16{}; p1 = f32x16{};
#pragma unroll
    for (int d0 = 0; d0 < 4; ++d0) { const int cb = (d0 * 16 + hi * 8) * 2;
        const bf16x8 b0 = *reinterpret_cast<const LAS bf16x8*>(Ks + KSWZ64(r32, cb));
        const bf16x8 b1 = *reinterpret_cast<const LAS bf16x8*>(Ks + KSWZ64(32 + r32, cb));
        p0 = mfma32(b0, qr[d0], p0); p1 = mfma32(b1, qr[d0], p1); }
}
__device__ __forceinline__ int v_st(int k, int c) { const int kk = (k & ~0xC) | ((k & 4) << 1) | ((k & 8) >> 1); return ((kk >> 3) * 4 + (c >> 5)) * 512 + ((kk & 7) * 32 + (c & 31)) * 2; }
__device__ __forceinline__ int v_rd_base(int lane) { return ((lane & 3) << 3) | (((lane >> 2) & 3) << 6) | (((lane >> 4) & 1) << 5) | (((lane >> 5) & 1) << 8); }
constexpr int v_rd_off(int d0, int ks, int half) { return d0 * 512 + ks * 4096 + half * 2048; }
template <int OFF> __device__ __forceinline__ s16x4 tr_read(int vb) { s16x4 r; asm volatile("ds_read_b64_tr_b16 %0, %1 offset:%2" : "=&v"(r) : "v"(vb), "i"(OFF) : "memory"); return r; }
template <int D0> __device__ __forceinline__ void pv_one(f32x16& od, int vb, bf16x8 pa0, bf16x8 pa1, bf16x8 pa2, bf16x8 pa3) {
    const s16x4 l0 = tr_read<v_rd_off(D0, 0, 0)>(vb), h0 = tr_read<v_rd_off(D0, 0, 1)>(vb), l1 = tr_read<v_rd_off(D0, 1, 0)>(vb), h1 = tr_read<v_rd_off(D0, 1, 1)>(vb);
    const s16x4 l2 = tr_read<v_rd_off(D0, 2, 0)>(vb), h2 = tr_read<v_rd_off(D0, 2, 1)>(vb), l3 = tr_read<v_rd_off(D0, 3, 0)>(vb), h3 = tr_read<v_rd_off(D0, 3, 1)>(vb);
    asm volatile("s_waitcnt lgkmcnt(0)" ::: "memory"); ASBAR();
#define PKV(L, H) (bf16x8){L[0], L[1], L[2], L[3], H[0], H[1], H[2], H[3]}
    od = mfma32(pa0, PKV(l0, h0), od); od = mfma32(pa1, PKV(l1, h1), od); od = mfma32(pa2, PKV(l2, h2), od); od = mfma32(pa3, PKV(l3, h3), od);
#undef PKV
}
__device__ __forceinline__ void pv_d0(f32x16 (&o)[4], int vb, bf16x8 pa0, bf16x8 pa1, bf16x8 pa2, bf16x8 pa3) {
    pv_one<0>(o[0], vb, pa0, pa1, pa2, pa3); pv_one<1>(o[1], vb, pa0, pa1, pa2, pa3); pv_one<2>(o[2], vb, pa0, pa1, pa2, pa3); pv_one<3>(o[3], vb, pa0, pa1, pa2, pa3);
}
__device__ __forceinline__ int krow(int j, int rc, int rl) { return j < 4 ? rc + 64 * j : rl + 64 * (j - 4); }

__device__ __forceinline__ void attn_unit(const Params& p, int l, int h, int qrow0, int rc, int rl, int NT, LAS unsigned char* lds8) {
    int tid_ = threadIdx.x; asm volatile("" : "+v"(tid_));
    const int tid = tid_, wid = __builtin_amdgcn_readfirstlane(tid >> 6), lane = tid & 63, r32 = lane & 31, hi = lane >> 5;
    LAS char* V_lds = (LAS char*)lds8; LAS char* K_lds = (LAS char*)lds8 + OFF_K;
    LAS float* wsx = (LAS float*)(lds8 + OFF_WS) + wid * 64; LAS float* li_l = wsx; LAS float* al_l = wsx + 32;
    LAS unsigned* stash = (LAS unsigned*)(lds8 + OFF_ST);
    bf16_t* QB = pbuf(p, P_QB); const bf16_t* KB = pbuf(p, P_KB); const bf16_t* VB = pbuf(p, P_VB);
    const int sr = tid >> 4, sc = (tid & 15) * 8, vst0 = v_st(sr, sc);
    const int kr = tid >> 3, kc = (tid & 7) * 8, kst = KSWZ64(kr, kc * 2);
    const int vb0 = (int)(uintptr_t)V_lds + v_rd_base(lane);
    f32x16 o[4];
#pragma unroll 1
    for (int m = 0; m < 2; ++m) {
        const unsigned voV0 = (unsigned)((sr * 512 + h * 128 + sc) * 2), voK = (unsigned)((kr * 512 + h * 128 + m * 64 + kc) * 2);
        float m_reg = -1e30f, l_reg = 0.f;
#pragma unroll
        for (int d = 0; d < 4; ++d) o[d] = f32x16{};
        bf16x8 qr[4];
        { const bf16_t* Qw = QB + (size_t)(qrow0 + wid * 32 + r32) * 512 + h * 128 + m * 64 + hi * 8;
#pragma unroll
          for (int d0 = 0; d0 < 4; ++d0) qr[d0] = *(const bf16x8*)(Qw + d0 * 16); }
        struct { bf16x8 vs0, vs1, ks0; } sr_[2];
#define SLOAD(i, j) do { const int _r = __builtin_amdgcn_readfirstlane(krow((j), rc, rl)); const char* _vb = (const char*)(VB + (size_t)_r * 512); const char* _kb = (const char*)(KB + (size_t)_r * 512); \
    sr_[i].vs0 = *(const bf16x8*)(_vb + voV0); sr_[i].vs1 = *(const bf16x8*)(_vb + 32 * 512 * 2 + voV0); sr_[i].ks0 = *(const bf16x8*)(_kb + voK); } while (0)
#define SWRITE(b, i) do { *(LAS bf16x8*)(V_lds + (b) * SHM_V + vst0) = sr_[i].vs0; *(LAS bf16x8*)(V_lds + (b) * SHM_V + 8192 + vst0) = sr_[i].vs1; \
    *(LAS bf16x8*)(K_lds + (b) * SHM_K + kst) = sr_[i].ks0; } while (0)
#define SWAIT() asm volatile("s_waitcnt vmcnt(3)" ::: "memory")
#define RESC(a) do { if (__any((a) < 1.f)) { if (hi == 0) al_l[r32] = (a); asm volatile("s_waitcnt lgkmcnt(0)" ::: "memory"); \
    _Pragma("unroll") for (int d = 0; d < 4; ++d) _Pragma("unroll") for (int r = 0; r < 16; ++r) o[d][r] *= al_l[crow(r, hi)]; } } while (0)
        f32x16 pA0, pA1, pB0, pB1; float mnA, mnB, alA, alB; bf16x8 pa0, pa1, pa2, pa3;
        SLOAD(0, 0); asm volatile("s_waitcnt vmcnt(0)" ::: "memory"); SWRITE(0, 0); __syncthreads();
        qkt(pA0, pA1, K_lds, qr, r32, hi); partialSM(pA0, pA1, m_reg, mnA, alA);
        SLOAD(1, 1); if (2 < NT) SLOAD(0, 2);
        SWAIT(); SWRITE(1, 1); __syncthreads();
        for (int j = 1; j + 1 < NT; j += 2) {
            ASBAR(); qkt(pB0, pB1, K_lds + SHM_K, qr, r32, hi);
            finishSM(pA0, pA1, alA, l_reg, pa0, pa1, pa2, pa3); ASBAR();
            SLOAD(1, j + 2); ASBAR();
            pv_d0(o, vb0, pa0, pa1, pa2, pa3); partialSM(pB0, pB1, m_reg, mnB, alB);
            __syncthreads(); SWAIT(); SWRITE(0, 0);
            RESC(alB); __syncthreads();
            ASBAR(); qkt(pA0, pA1, K_lds, qr, r32, hi);
            finishSM(pB0, pB1, alB, l_reg, pa0, pa1, pa2, pa3); ASBAR();
            if (j + 3 < NT) SLOAD(0, j + 3); ASBAR();
            pv_d0(o, vb0 + SHM_V, pa0, pa1, pa2, pa3); partialSM(pA0, pA1, m_reg, mnA, alA);
            __syncthreads(); SWAIT(); SWRITE(1, 1);
            RESC(alA); __syncthreads();
        }
        ASBAR(); qkt(pB0, pB1, K_lds + SHM_K, qr, r32, hi);
        finishSM(pA0, pA1, alA, l_reg, pa0, pa1, pa2, pa3); ASBAR();
        pv_d0(o, vb0, pa0, pa1, pa2, pa3); partialSM(pB0, pB1, m_reg, mnB, alB);
        __syncthreads(); RESC(alB);
        finishSM(pB0, pB1, alB, l_reg, pa0, pa1, pa2, pa3); ASBAR();
        pv_d0(o, vb0 + SHM_V, pa0, pa1, pa2, pa3);
#undef SLOAD
#undef SWRITE
#undef SWAIT
#undef RESC
        int lane_e = lane; asm volatile("" : "+v"(lane_e)); const int r32e = lane_e & 31, hie = lane_e >> 5;
        if (hie == 0) li_l[r32e] = l_reg; asm volatile("s_waitcnt lgkmcnt(0)" ::: "memory");
        float rli[16];
#pragma unroll
        for (int r = 0; r < 16; ++r) rli[r] = __builtin_amdgcn_rcpf(li_l[crow(r, hie)]);
        if (m == 0) {
#pragma unroll
            for (int d0 = 0; d0 < 4; ++d0)
#pragma unroll
                for (int r = 0; r < 16; r += 2) stash[(wid * 32 + d0 * 8 + (r >> 1)) * 64 + lane_e] = cvtpk(o[d0][r] * rli[r], o[d0][r + 1] * rli[r + 1]);
        } else {
            const float lam = ld_f32_dev((const float*)(p.ws + WS_LAM) + l * 4), oml = ld_f32_dev((const float*)(p.ws + WS_LAM) + l * 4 + 1);
            float ss[16];
#pragma unroll
            for (int r = 0; r < 16; ++r) ss[r] = 0.f;
#pragma unroll
            for (int d0 = 0; d0 < 4; ++d0)
#pragma unroll
                for (int r = 0; r < 16; r += 2) { const unsigned w = stash[(wid * 32 + d0 * 8 + (r >> 1)) * 64 + lane_e];
                    o[d0][r] = bf_lo(w) - lam * o[d0][r] * rli[r]; o[d0][r + 1] = bf_hi(w) - lam * o[d0][r + 1] * rli[r + 1];
                    ss[r] += o[d0][r] * o[d0][r]; ss[r + 1] += o[d0][r + 1] * o[d0][r + 1]; }
#pragma unroll
            for (int r = 0; r < 16; ++r) { float q = ss[r]; q += __shfl_xor(q, 1); q += __shfl_xor(q, 2); q += __shfl_xor(q, 4); q += __shfl_xor(q, 8); q += __shfl_xor(q, 16);
                ss[r] = rsqrtf(q * (1.0f / 128.0f) + EPS) * oml; }
            const float* gs = p.in[I_GSUBLN] + l * 128;
            asm volatile("s_waitcnt lgkmcnt(0)" ::: "memory");
            LAS bf16_t* ot = (LAS bf16_t*)(stash + wid * 32 * 64);
#pragma unroll
            for (int d0 = 0; d0 < 4; ++d0) { const float g = gs[d0 * 32 + r32e];
#pragma unroll
                for (int r = 0; r < 16; ++r) ot[((r & 3) + 8 * (r >> 2) + 4 * hie) * 128 + d0 * 32 + r32e] = (bf16_t)(cvtpk(o[d0][r] * ss[r] * g, 0.f) & 0xffffu); }
            asm volatile("s_waitcnt lgkmcnt(0)" ::: "memory");
            { bf16_t* dst = QB + (size_t)(qrow0 + wid * 32) * 512 + h * 128;
#pragma unroll
              for (int i = 0; i < 8; ++i) { const int row = i * 4 + (lane_e >> 4), pc = (lane_e & 15) * 8;
                  *(u32x4*)(dst + (size_t)row * 512 + pc) = *(const LAS u32x4*)(ot + row * 128 + pc); } }
        }
        __syncthreads();
    }
}
}
__device__ __forceinline__ void gmlp_unit(const Params& p, int l, int r0, LAS unsigned char* lds) {
    int tid_ = threadIdx.x; asm volatile("" : "+v"(tid_));
    const int tid = tid_, wid = __builtin_amdgcn_readfirstlane(tid >> 6), lane = tid & 63, r32 = lane & 31, hi = lane >> 5;
    const bf16_t* VG = pbuf(p, P_VGB); bf16_t* UB = pbuf(p, P_UB);
    PSEC_BEGIN8();
    {
        const int sr = tid >> 4, sc = (tid & 15) * 8, vst0 = att::v_st(sr, sc);
        u32x4 x[4][4]; float rs[4];
#pragma unroll
        for (int k = 0; k < 4; ++k)
#pragma unroll
            for (int g = 0; g < 4; ++g) x[k][g] = *(const u32x4*)(VG + (size_t)(r0 + sr + 32 * k) * 512 + g * 128 + sc);
#pragma unroll
        for (int k = 0; k < 4; ++k) { float ss = 0.f;
#pragma unroll
            for (int g = 0; g < 4; ++g) { float v[8]; unpack8(x[k][g], v);
#pragma unroll
                for (int j = 0; j < 8; ++j) ss += v[j] * v[j]; }
            ss += __shfl_xor(ss, 1); ss += __shfl_xor(ss, 2); ss += __shfl_xor(ss, 4); ss += __shfl_xor(ss, 8);
            rs[k] = rsqrtf(ss * (1.0f / 512.0f) + EPS); }
#pragma unroll
        for (int k = 0; k < 4; ++k)
#pragma unroll
            for (int g = 0; g < 4; ++g) { float v[8]; unpack8(x[k][g], v);
#pragma unroll
                for (int j = 0; j < 8; ++j) v[j] *= rs[k];
                *(LAS u32x4*)(lds + (g * 2 + (k >> 1)) * att::SHM_V + (k & 1) * 8192 + vst0) = pack8(v); }
    }
    __syncthreads();
    const int rb = wid >> 1, dh = wid & 1;
    const int vb0 = (int)(uintptr_t)lds + att::v_rd_base(lane) + dh * 1024;
    LAS float* F = (LAS float*)(lds + 8 * att::SHM_V) + wid * 576;
    const bf16_t* Wsb = (const bf16_t*)(p.ws + WS_WSB) + (size_t)l * 4 * 16384 + (size_t)(32 * rb + r32) * 128 + 8 * hi;
#pragma unroll 1
    for (int g = 0; g < 4; ++g) {
        bf16x8 pa[2][4];
#pragma unroll
        for (int kt = 0; kt < 2; ++kt)
#pragma unroll
            for (int k4 = 0; k4 < 4; ++k4) pa[kt][k4] = *(const bf16x8*)(Wsb + (size_t)g * 16384 + 64 * kt + 16 * k4);
        bf16_t* up = UB + (size_t)(r0 + 32 * rb + (lane >> 2)) * 512 + g * 128 + 64 * dh + 8 * (lane & 3);
        u32x4 uu[2][2];
#pragma unroll
        for (int d0 = 0; d0 < 2; ++d0)
#pragma unroll
            for (int rd = 0; rd < 2; ++rd) uu[d0][rd] = *(const u32x4*)(up + (size_t)(16 * rd) * 512 + 32 * d0);
        const float* gv = p.in[I_GGV] + l * 512 + g * 128 + 64 * dh + r32; const float* bs = p.in[I_BGS] + (l * 4 + g) * 128 + 32 * rb;
        const float gv0 = gv[0], gv1 = gv[32];
        float bsv[16];
#pragma unroll
        for (int r = 0; r < 16; ++r) bsv[r] = bs[crow(r, hi)];
        __builtin_amdgcn_sched_barrier(0);
        f32x16 o[2] = {};
        att::pv_one<0>(o[0], vb0 + (g * 2) * att::SHM_V, pa[0][0], pa[0][1], pa[0][2], pa[0][3]); att::pv_one<1>(o[1], vb0 + (g * 2) * att::SHM_V, pa[0][0], pa[0][1], pa[0][2], pa[0][3]);
        att::pv_one<0>(o[0], vb0 + (g * 2 + 1) * att::SHM_V, pa[1][0], pa[1][1], pa[1][2], pa[1][3]); att::pv_one<1>(o[1], vb0 + (g * 2 + 1) * att::SHM_V, pa[1][0], pa[1][1], pa[1][2], pa[1][3]);
#pragma unroll
        for (int d0 = 0; d0 < 2; ++d0)
#pragma unroll
            for (int rd = 0; rd < 2; ++rd) {
#pragma unroll
                for (int r = 0; r < 8; ++r) { const int rr = 8 * rd + r; F[((r & 3) + 8 * ((r >> 2) & 1) + 4 * hi) * 36 + r32] = o[d0][rr] * (d0 ? gv1 : gv0) + bsv[rr]; }
                asm volatile("s_waitcnt lgkmcnt(0)" ::: "memory");
                const f32x4 m0 = *(const LAS f32x4*)(F + (lane >> 2) * 36 + 8 * (lane & 3)), m1 = *(const LAS f32x4*)(F + (lane >> 2) * 36 + 8 * (lane & 3) + 4);
                float u8[8]; unpack8(uu[d0][rd], u8);
#pragma unroll
                for (int j = 0; j < 4; ++j) { u8[j] *= m0[j]; u8[4 + j] *= m1[j]; }
                *(u32x4*)(up + (size_t)(16 * rd) * 512 + 32 * d0) = pack8(u8);
                asm volatile("s_waitcnt lgkmcnt(0)" ::: "memory");
            }
    }
    __syncthreads();
    PSEC(8);
}
constexpr int N_PHASES = 36;
typedef const __attribute__((address_space(4))) Params* KParams;
#define PHASE_P() const Params& p = *(const Params*)opaque_kp()
__device__ __forceinline__ KParams opaque_kp() { KParams q = (KParams)__builtin_amdgcn_kernarg_segment_ptr(); asm volatile("" : "+s"(q)); return q; }
__global__ void __launch_bounds__(NTHR, 2) mk_fwd(Params p_arg, int bar_region) {
    extern __shared__ __attribute__((aligned(16))) unsigned char lds_raw[];
    LAS unsigned char* lds = (LAS unsigned char*)lds_raw;
    const int tid = threadIdx.x, G = gridDim.x, bid = blockIdx.x;
    volatile LAS unsigned* xbw = (volatile LAS unsigned*)(lds + LDS_BYTES - 16);
    if (tid == 0) { xbw[0] = 0u; xbw[1] = 0u; xbw[2] = 0u; xbw[3] = 0u; }
    __syncthreads();
    (void)xcd_barrier_post((unsigned*)(p_arg.ws + WS_CTL) + CW_BAR + bar_region * 4096, xbw);
    const int lo = p_arg.ph_lo, hi = p_arg.ph_hi;
#define IN(k) (lo <= (k) && (k) < hi)
#ifdef PROBE
#define STAMP(k) do { if (tid == 0) { if (bid == 0) ((unsigned long long*)(opaque_kp()->ws + WS_CTL))[30000 + (k)] = __builtin_amdgcn_s_memrealtime(); *(volatile LAS int*)(lds + LDS_BYTES - 32) = (k); } __syncthreads(); } while (0)
#else
#define STAMP(k) do { } while (0)
#endif
#define GRID_BARRIER() do { KParams kq = opaque_kp(); XcdBarrier b_; b_.bar = (unsigned*)(kq->ws + WS_CTL) + CW_BAR + ((const __attribute__((address_space(4))) int*)(kq + 1))[0] * 4096; b_.x = xb_xcc_id(); b_.st = xbw; xcd_barrier(b_); } while (0)
#define SEAM(k) do { if (IN(k) && IN((k) + 1)) { GRID_BARRIER(); STAMP((k) + 1); } } while (0)

    STAMP(0);
#if !defined(ONLY) || ONLY == 0
    if (IN(0)) { PHASE_P(); phase_prologue(p, lds); }
#endif
    SEAM(0);
    for (int l = 0; l < 2; ++l) {
        const int base = 1 + 17 * l;
#if !defined(ONLY) || ONLY == 1
        if (IN(base)) { PHASE_P(); phase_norm1(p, l); }
#endif
        SEAM(base);
        for (int hf = 0; hf < 2; ++hf) {
            const int hb = base + 1 + 6 * hf;
#if !defined(ONLY) || ONLY == 2
            if (IN(hb)) {
                PHASE_P(); unsigned char* ws = p.ws; bf16_t* Hh = (bf16_t*)(ws + WS_H) + (size_t)hf * MH * 1024; (void)Hh;
                const float* cosT = (const float*)(ws + WS_ROPE); const float* sinT = cosT + 1024;
                pg8::Gemm g{Hh, (const bf16_t*)(ws + WS_WTIN) + (size_t)l * NCOL * 1024, MH, NCOL, 1024};
                int cin = bid; if (hf == 1) { cin += G >> 1; if (cin >= G) cin -= G; }
                RectOrder S; if (l == 0) S.init(72, 14, 0, 0, 0, 0, G, cin); else S.init(64, 14, 8, 8, 6, 0, G, cin);
                EpiIn E{pbuf(p, 0), pbuf(p, P_GB), cosT, sinT};
                pg8::gemm_phase<EpiIn, RectOrder>((PG8_LAS unsigned char*)lds, g, S, E, nullptr);
                pg8::Gemm g8{(const bf16_t*)(ws + WS_H8 + (size_t)hf * MH * 1024), (const bf16_t*)(ws + WS_WTIN8 + (size_t)l * 3072 * 1024), MH, 3072, 512};
                RectOrder S8; S8.init(l == 0 ? 72 : 64, 12, l == 0 ? 0 : 8, 0, 0, 0, G, G - 1 - cin);
                EpiGate8 E8{pbuf(p, P_GB)};
                pg8::gemm_phase<EpiGate8, RectOrder, false, true>((PG8_LAS unsigned char*)lds, g8, S8, E8, nullptr);
            }
#endif
            SEAM(hb);
#if !defined(ONLY) || ONLY == 3
            if (IN(hb + 1)) {
                PSEC_BEGIN6();
                { PHASE_P(); phase_conv(p, l, lds); }
                PSEC(6);
                GRID_BARRIER(); PSEC(7);
                PHASE_P();
                const int n_a = HBAT * NJ * 4, n_g = HBAT * 16 + (l == 0 ? HBAT * 2 : 0);
                const int bidx = (G == 256) ? ((bid & 7) * 32 + (bid >> 3)) : bid;
                int u = bidx;
                PSEC(13);
                { u32x4 qa[4], qb[4], qwq[4], qwk[4], qwv[4]; f32x4 qg; mlstm_a_load(p, l, u < n_a ? u : 0, APRE_ARGS);
                  for (; u < n_a; u += G) mlstm_a_unit(p, l, u, u + G, n_a, APRE_ARGS, lds); }
                PSEC(14);
                for (; u < n_a + n_g; u += G) { const int v = u - n_a; int r0; if (v < HBAT * 16) r0 = CTXROWS + (v >> 4) * 2048 + (v & 15) * 128; else { const int w = v - HBAT * 16; r0 = (w >> 1) * 256 + (w & 1) * 128; }
                    gmlp_unit(p, l, r0, lds); }
            }
#endif
            SEAM(hb + 1);
#if !defined(ONLY) || ONLY == 4
            if (IN(hb + 2)) {
                PHASE_P();
                phase_scan(p);
            }
#endif
            SEAM(hb + 2);
#if !defined(ONLY) || ONLY == 5
            if (IN(hb + 3)) {
                PHASE_P();
                const int n_l = HBAT * 4 * 8, n_c = (l == 0 ? HBAT * 4 : 0);
                for (int u = bid; u < n_l + n_c; u += G) {
                    int h, qrow0, rc, rl, NT;
                    if (u < n_l) { const int ue = (G == 256) ? ((((u & 7) * 4 + (u >> 6)) << 3) | ((u >> 3) & 7)) : u;
                        const int bl = ue >> 5, qb = ue & 7; h = (ue >> 3) & 3; qrow0 = CTXROWS + bl * 2048 + qb * 256; rc = bl * 256; rl = CTXROWS + bl * 2048; NT = 36; }
                    else { const int v = u - n_l, bl = v >> 2; h = v & 3; qrow0 = bl * 256; rc = bl * 256; rl = 0; NT = 4; }
                    PSEC_BEGINN(9); att::attn_unit(p, l, h, qrow0, rc, rl, NT, lds); PSEC(9);
                }
                const int m_l = HBAT * 16 * 4, m_c = (l == 0 ? HBAT * 2 * 4 : 0);
                int u0 = bid + 192; if (u0 >= G) u0 -= G;
                for (int u = u0; u < m_l + m_c; u += G) {
                    int bl, J, h;
                    if (u < m_l) { const int rem = u & 63; bl = u >> 6; J = 2 + (rem >> 2); h = rem & 3; }
                    else { const int v = u - m_l, rem = v & 7; bl = v >> 3; J = rem >> 2; h = rem & 3; }
                    PSEC_BEGINN(10); mlstm_c_unit(p, l, bl, J, h, lds); PSEC(10);
                }
                if (l == 0 && G == 256 && !(bid >= 64 && bid < 128)) cvt_fill(p, lds, hf == 0 ? 0 : CVT_Q1, hf == 0 ? CVT_Q0 : CVT_Q2, bid < 64 ? bid : bid - 64, 192);
                else if (l == 0 && G != 256) cvt_fill(p, lds, hf == 0 ? 0 : CVT_Q1, hf == 0 ? CVT_Q0 : CVT_Q2, bid, G);
            }
#endif
            SEAM(hb + 3);
#if !defined(ONLY) || ONLY == 6
            if (IN(hb + 4)) {
                PHASE_P(); unsigned char* ws = p.ws; bf16_t* Hh = (bf16_t*)(ws + WS_H) + (size_t)hf * MH * 1024; (void)Hh;
                pg8::Gemm g{pbuf(p, P_QB), (const bf16_t*)(ws + WS_WTBR) + (size_t)l * 3072 * 512, 3 * MH, 3072, 512};
                MergeOrder S; S.init(l == 0 ? 72 : 64, l == 0 ? 0 : 8, G, bid);
                EpiMerge E{pbuf(p, P_GB), Hh};
                pg8::gemm_phase<EpiMerge, MergeOrder>((PG8_LAS unsigned char*)lds, g, S, E, nullptr);
                if (l == 0) { const int skip = G > 64 ? 32 : 0; __syncthreads(); if (bid >= skip) cvt_fill(p, lds, hf == 0 ? CVT_Q0 : CVT_Q2, hf == 0 ? CVT_Q1 : CVT_Q3, bid - skip, G - skip); }
            }
#endif
            SEAM(hb + 4);
#if !defined(ONLY) || ONLY == 7
            if (IN(hb + 5)) {
                PHASE_P(); unsigned char* ws = p.ws; bf16_t* Hh = (bf16_t*)(ws + WS_H) + (size_t)hf * MH * 1024; (void)Hh;
                pg8::Gemm g{Hh, (const bf16_t*)(ws + WS_WTO) + (size_t)l * 1024 * 1024, MH, 1024, 1024};
                RectOrder S; S.init(l == 0 ? 72 : 64, 4, l == 0 ? 0 : 8, 0, 0, 0, G, bid);
                EpiOut E{l == 0 ? p.in[I_X] : (const float*)p.out, l == 0 ? p.in[I_CTX] : (const float*)(ws + WS_XC), p.out, (float*)(ws + WS_XC), (const float*)(ws + WS_MOD) + (size_t)l * 17 * 6144, hf};
                pg8::gemm_phase<EpiOut, RectOrder>((PG8_LAS unsigned char*)lds, g, S, E, nullptr);
                if (l == 0 && hf == 1) { const int skip = G > 64 ? 32 : 0; __syncthreads(); if (bid >= skip) cvt_fill(p, lds, CVT_Q3, CVT_Q4, bid - skip, G - skip); }
            }
#endif
            if (hf == 1) SEAM(hb + 5);
        }
#if !defined(ONLY) || ONLY == 8
        if (IN(base + 13)) { PHASE_P(); phase_norm2_router(p, l, lds); if (l == 1) cvt_fill(p, lds, CVT_Q4, 2 * CVT_TILES, bid, G); }
#endif
        SEAM(base + 13);
#if !defined(ONLY) || ONLY == 9
        if (IN(base + 14)) { PHASE_P(); phase_dispatch(p, l, lds); }
#endif
        SEAM(base + 14);
#if !defined(ONLY) || ONLY == 10
        if (IN(base + 15)) {
            PHASE_P(); unsigned char* ws = p.ws;
            LAS int* seg = (LAS int*)(lds + 131072); LAS int* tile_e = seg + 128;
            const int nt = moe_tile_table(p, l, seg, tile_e);
            pg8::Gemm g{(const bf16_t*)(ws + WS_H8), (const bf16_t*)(ws + WS_WTGU + (size_t)l * 32 * 1024 * 1024), SLOTS, 32 * 1024, 512};
            MoeOrder S; S.init(tile_e, nt, G, bid);
            { LAS int* srcl = (LAS int*)(lds + 131072 + 2048); const int* SRC = (const int*)(ws + WS_SRC);
              for (int i = 0; i < 6; ++i) { int pm, pn; S.unit_of(i, pm, pn); for (int r = opaque_tid(); r < 256; r += NTHR) srcl[i * 256 + r] = pm < nt ? SRC[pm * 256 + r] : 0; }
              S.srcl = srcl; }
            __syncthreads(); EpiGU E{ws + WS_P + P_ACT};
            pg8::gemm_phase<EpiGU, MoeOrder, false, true, true>((PG8_LAS unsigned char*)lds, g, S, E, nullptr);
        }
#endif
        SEAM(base + 15);
#if !defined(ONLY) || ONLY == 11
        if (IN(base + 16)) {
            PHASE_P(); unsigned char* ws = p.ws;
            LAS int* seg = (LAS int*)(lds + 131072); LAS int* tile_e = seg + 128;
            const int nt = moe_tile_table(p, l, seg, tile_e);
            pg8::Gemm g{pbuf(p, P_ACT), (const bf16_t*)(ws + WS_WTD + (size_t)l * 32 * 1024 * 512), SLOTS, 32 * 1024, 256};
            MoeOrder S; S.init(tile_e, nt, G, bid); __syncthreads(); EpiDown E{pbuf(p, P_YS)};
            pg8::gemm_phase<EpiDown, MoeOrder, false, true>((PG8_LAS unsigned char*)lds, g, S, E, nullptr);
        }
#endif
        SEAM(base + 16);
    }
#if !defined(ONLY) || ONLY == 12
    if (IN(35)) { PHASE_P(); phase_final(p); }
#endif
#ifdef PROBE
    if (bid == 0 && tid == 0) {
        asm volatile("s_waitcnt vmcnt(0)" ::: "memory");
        const unsigned long long tend = __builtin_amdgcn_s_memrealtime();
        volatile unsigned long long* st = (volatile unsigned long long*)(opaque_kp()->ws + WS_CTL) + 30000;
        unsigned long long ta = 0, tb = 0;
        for (int k = 0; k < N_PHASES; ++k) { const unsigned long long t0 = st[k], t1 = (k == N_PHASES - 1) ? tend : st[k + 1]; const unsigned long long d = t1 - t0;
            if ((PROBE_A >> k) & 1ull) ta += d; if ((PROBE_B >> k) & 1ull) tb += st[100 + k]; }
        const unsigned long long spin = ((ta + tb) / 1000ull) * 100000ull;
        while (__builtin_amdgcn_s_memrealtime() - tend < spin) __builtin_amdgcn_s_sleep(32);
    }
#endif
#undef IN
#undef SEAM
}

#ifndef MK_CUTS
#define MK_CUTS 0
#endif
extern "C" void kernel_launch(void* const* d_in, const int* in_sizes, int n_in, void* d_out, int out_size, void* d_ws, size_t ws_size, hipStream_t stream) {
    static int grid = 0;
    if (grid == 0) {
        if (n_in != 31 || in_sizes[0] != NBATCH * SEQ * DM || out_size != NBATCH * SEQ * DM || ws_size < WS_END) {
            fprintf(stderr, "kernel_launch: unexpected shapes or workspace (n_in %d, ws %zu, need %zu); nothing launched\n", n_in, ws_size, (size_t)WS_END); grid = -1; return; }
        int dev = 0, cus = 0, per_cu = 0;
        if (hipGetDevice(&dev) != hipSuccess || hipDeviceGetAttribute(&cus, hipDeviceAttributeMultiprocessorCount, dev) != hipSuccess) { grid = -1; return; }
        if (hipFuncSetAttribute((const void*)mk_fwd, hipFuncAttributeMaxDynamicSharedMemorySize, LDS_BYTES) != hipSuccess) { fprintf(stderr, "kernel_launch: hipFuncSetAttribute failed\n"); grid = -1; return; }
        if (hipOccupancyMaxActiveBlocksPerMultiprocessor(&per_cu, (const void*)mk_fwd, NTHR, LDS_BYTES) != hipSuccess || per_cu < 1) { fprintf(stderr, "kernel_launch: occupancy query says %d\n", per_cu); }
        (void)hipGetLastError();
        grid = cus;
    }
    if (grid < 0) return;
    if (hipMemsetAsync((char*)d_ws + WS_CTL, 0, CTL_BYTES, stream) != hipSuccess) return;
    Params p{};
    for (int i = 0; i < 31; ++i) p.in[i] = (const float*)d_in[i];
    p.out = (float*)d_out; p.ws = (unsigned char*)d_ws;
#if MK_CUTS == 0
    p.ph_lo = 0; p.ph_hi = N_PHASES;
    hipLaunchKernelGGL(mk_fwd, dim3(grid), dim3(NTHR), LDS_BYTES, stream, p, 0);
#else
    for (int k = 0; k < N_PHASES; ++k) {
#ifdef EXP_NOMOE
        if ((k >= 14 && k <= 17) || (k >= 31 && k <= 34)) continue;
#endif
#ifdef EXP_NOEXPERT
        if (k == 16 || k == 17 || k == 33 || k == 34) continue;
#endif
#ifdef EXP_NOGU
        if (k == 16 || k == 33) continue;
#endif
#ifdef EXP_NOMIX
        if ((k >= 2 && k <= 13) || (k >= 19 && k <= 30)) continue;
#endif
#ifdef EXP_ZEROXB
        if (k == 15 || k == 32) { hipMemsetAsync((char*)d_ws + WS_P + P_XB, 0, P_MOE_END, stream); hipMemsetAsync((char*)d_ws + WS_WTS, 0, (size_t)SLOTS * 4, stream); }
#endif
        p.ph_lo = k; p.ph_hi = k + 1; hipLaunchKernelGGL(mk_fwd, dim3(grid), dim3(NTHR), LDS_BYTES, stream, p, 0); }
#endif
}
```

```cpp
#include <hip/hip_runtime.h>
#include <cstdio>
#include <cstdint>

#define LAS __attribute__((address_space(3)))
typedef unsigned short bf16_t;
typedef short bf16x8 __attribute__((ext_vector_type(8)));
typedef short s16x4 __attribute__((ext_vector_type(4)));
typedef float f32x2 __attribute__((ext_vector_type(2)));
typedef float f32x4 __attribute__((ext_vector_type(4)));
typedef float f32x16 __attribute__((ext_vector_type(16)));
typedef unsigned u32x2 __attribute__((ext_vector_type(2)));
typedef unsigned u32x4 __attribute__((ext_vector_type(4)));

constexpr int DM = 1024, NBATCH = 16, SEQ = 2048, CTXL = 256, NCOL = 6656;
constexpr int HBAT = 8;
constexpr int MH = HBAT * (SEQ + CTXL);
constexpr int MTOT = 2 * MH;
constexpr int CTXROWS = HBAT * CTXL;
constexpr int NJ = 18;
constexpr int NEXP = 32, DEXP = 512;
constexpr int SLOTS = 81920;
constexpr float EPS = 1e-6f;
constexpr float LOG2E = 1.4426950408889634f;
constexpr float QSCALE = 0.125f * LOG2E;
constexpr int NTHR = 512;
constexpr int LDS_BYTES = 155648;
constexpr int TLD = 136;
constexpr int TILE_B = 128 * TLD * 2;

constexpr size_t AL(size_t x) { return (x + 255) / 256 * 256; }
constexpr size_t WS_CTL   = 0;
constexpr size_t CTL_BYTES = 262144;
constexpr size_t WS_MOD   = WS_CTL + CTL_BYTES;
constexpr size_t WS_WFOLD = WS_MOD + AL((size_t)2 * 17 * 6144 * 4);
constexpr size_t WS_ROPE  = WS_WFOLD + AL((size_t)2 * 16 * 1024 * 4);
constexpr size_t WS_LAM   = WS_ROPE + AL((size_t)2 * 64 * 16 * 4);
constexpr size_t WS_WRT   = WS_LAM + 256;
constexpr size_t WS_WTIN  = WS_WRT + AL((size_t)2 * 2 * 48 * 1024 * 2);
constexpr size_t WS_WTBR  = WS_WTIN + AL((size_t)2 * NCOL * 1024 * 2);
constexpr size_t WS_WTO   = WS_WTBR + AL((size_t)2 * 3072 * 512 * 2);
constexpr size_t WS_WTQKV = WS_WTO + AL((size_t)2 * 1024 * 1024 * 2);
constexpr size_t WS_WSB   = WS_WTQKV + AL((size_t)2 * 12 * 16384 * 2);
constexpr size_t WS_WTGU  = WS_WSB + AL((size_t)2 * 4 * 16384 * 2);
constexpr size_t WS_WTD   = WS_WTGU + AL((size_t)32 * 1024 * 1024 * 2);
constexpr size_t WS_XC    = WS_WTD + AL((size_t)32 * 1024 * 512 * 2);
constexpr size_t WS_H     = WS_XC + AL((size_t)4096 * 1024 * 4);
constexpr size_t WS_H8    = WS_H + AL((size_t)MTOT * 1024 * 2);
constexpr size_t WS_WTIN8 = WS_H8 + AL((size_t)MTOT * 1024);
constexpr size_t WS_EID   = WS_WTIN8 + AL((size_t)2 * 3072 * 1024);
constexpr size_t WS_WTK   = WS_EID + AL((size_t)MTOT * 8);
constexpr size_t WS_POS   = WS_WTK + AL((size_t)MTOT * 8);
constexpr size_t WS_WTS   = WS_POS + AL((size_t)MTOT * 8);
constexpr size_t WS_SRC   = WS_WTS + AL((size_t)SLOTS * 4);
constexpr size_t WS_P     = WS_SRC + AL((size_t)SLOTS * 4);
constexpr size_t S1B      = (size_t)MH * 512 * 2;
constexpr size_t P_KB = 0, P_VB = S1B, P_XMB = 2 * S1B, P_QB = 3 * S1B, P_UB = 4 * S1B, P_ZB = 5 * S1B, P_VGB = 6 * S1B;
constexpr size_t P_GB   = 7 * S1B;
constexpr size_t P_MQ   = P_GB + (size_t)3 * MH * 1024;
constexpr size_t P_MK   = P_MQ + S1B, P_MVT = P_MK + S1B, P_XCV = P_MVT + S1B;
constexpr size_t P_GATES = P_XCV + S1B;
constexpr size_t P_CLOC = P_GATES + AL((size_t)MH * 16 * 4);
constexpr size_t P_NLOC = P_CLOC + (size_t)64 * NJ * 16384 * 2;
constexpr size_t P_MST  = P_NLOC + AL((size_t)64 * NJ * 128 * 4);
constexpr size_t P_END  = P_MST + AL((size_t)64 * NJ * 4 * 4);
constexpr size_t P_XB   = 0;
constexpr size_t P_ACT  = (size_t)SLOTS * 1024;
constexpr size_t P_YS   = P_ACT + (size_t)SLOTS * 512;
constexpr size_t P_MOE_END = P_YS + (size_t)SLOTS * 1024 * 2;
constexpr float WSCALE8 = 635.0f, HSCALE8 = 10.5f, ASCALE8 = 16.0f;
constexpr size_t WS_END = WS_P + (P_END > P_MOE_END ? P_END : P_MOE_END);
constexpr int CW_EXPCNT = 0;
constexpr int CW_HIST = 32768;
constexpr int CW_BAR = 1024;

__device__ __forceinline__ unsigned cvtpk(float lo, float hi) { unsigned r; asm volatile("v_cvt_pk_bf16_f32 %0, %1, %2" : "=v"(r) : "v"(lo), "v"(hi)); return r; }
__device__ __forceinline__ float bf_lo(unsigned w) { return __uint_as_float(w << 16); }
__device__ __forceinline__ float bf_hi(unsigned w) { return __uint_as_float(w & 0xffff0000u); }
__device__ __forceinline__ float bf2f(bf16_t b) { return __uint_as_float(((unsigned)b) << 16); }
__device__ __forceinline__ bf16_t f2bf(float f) { unsigned u = __float_as_uint(f); u += 0x7FFFu + ((u >> 16) & 1u); return (bf16_t)(u >> 16); }
__device__ __forceinline__ float sigmoid_f(float x) { return __builtin_amdgcn_rcpf(1.0f + __builtin_amdgcn_exp2f(-x * LOG2E)); }
__device__ __forceinline__ float gelu_tanh_f(float x) { const float u = 0.7978845608028654f * (x + 0.044715f * x * x * x); return x * sigmoid_f(2.0f * u); }
__device__ __forceinline__ float silu_f(float x) { return x * sigmoid_f(x); }
__device__ __forceinline__ float logsigmoid_f(float x) { return fminf(x, 0.f) - 0.6931471805599453f * __builtin_amdgcn_logf(1.0f + __builtin_amdgcn_exp2f(-fabsf(x) * LOG2E)); }
__device__ __forceinline__ int crow(int r, int hi) { return (r & 3) + 8 * (r >> 2) + 4 * hi; }
__device__ __forceinline__ f32x16 mfma32(bf16x8 a, bf16x8 b, f32x16 c) { return __builtin_amdgcn_mfma_f32_32x32x16_bf16(a, b, c, 0, 0, 0); }
__device__ __forceinline__ float wave_sum(float v) { for (int o = 32; o >= 1; o >>= 1) v += __shfl_xor(v, o); return v; }
template <int CTRL, int ROWMASK> __device__ __forceinline__ float dpp_add(float v) {
    return v + __builtin_bit_cast(float, __builtin_amdgcn_update_dpp(0, __builtin_bit_cast(int, v), CTRL, ROWMASK, 0xf, true)); }
__device__ __forceinline__ float wave_sum63(float v) {
    v = dpp_add<0x111, 0xf>(v); v = dpp_add<0x112, 0xf>(v); v = dpp_add<0x114, 0xf>(v); v = dpp_add<0x118, 0xf>(v);
    v = dpp_add<0x142, 0xa>(v);
    v = dpp_add<0x143, 0xc>(v);
    return v; }
__device__ __forceinline__ float half_sum31(float v) {
    v = dpp_add<0x111, 0xf>(v); v = dpp_add<0x112, 0xf>(v); v = dpp_add<0x114, 0xf>(v); v = dpp_add<0x118, 0xf>(v);
    v = dpp_add<0x142, 0xa>(v); return v; }
__device__ __forceinline__ float wave_max(float v) { for (int o = 32; o >= 1; o >>= 1) v = fmaxf(v, __shfl_xor(v, o)); return v; }

__device__ __forceinline__ void unpack8(const u32x4 w, float (&o)[8]) { o[0] = bf_lo(w.x); o[1] = bf_hi(w.x); o[2] = bf_lo(w.y); o[3] = bf_hi(w.y); o[4] = bf_lo(w.z); o[5] = bf_hi(w.z); o[6] = bf_lo(w.w); o[7] = bf_hi(w.w); }
__device__ __forceinline__ u32x4 pack8(const float (&v)[8]) { u32x4 w; w.x = cvtpk(v[0], v[1]); w.y = cvtpk(v[2], v[3]); w.z = cvtpk(v[4], v[5]); w.w = cvtpk(v[6], v[7]); return w; }
__device__ __forceinline__ int ld_i32_dev(const int* p) { return __hip_atomic_load(p, __ATOMIC_RELAXED, __HIP_MEMORY_SCOPE_AGENT); }
__device__ __forceinline__ float ld_f32_dev(const float* p) { return __hip_atomic_load(p, __ATOMIC_RELAXED, __HIP_MEMORY_SCOPE_AGENT); }
__device__ __forceinline__ unsigned q8(float x) { return (unsigned)(int)fminf(fmaxf(rintf(x), -127.0f), 127.0f) & 0xffu; }
__device__ __forceinline__ unsigned pk4_fp8(float a, float b, float c, float d) { return q8(a) | (q8(b) << 8) | (q8(c) << 16) | (q8(d) << 24); }
#define LBAR() do { asm volatile("s_waitcnt lgkmcnt(0)" ::: "memory"); __builtin_amdgcn_s_barrier(); asm volatile("" ::: "memory"); } while (0)
__device__ __forceinline__ int opaque_tid() { int t = threadIdx.x; asm volatile("" : "+v"(t)); return t; }
#ifdef PROBE
__device__ __forceinline__ unsigned long long* probe_epi_counter() {
    unsigned char* ws = *(unsigned char* const __attribute__((address_space(4)))*)((const __attribute__((address_space(4))) char*)__builtin_amdgcn_kernarg_segment_ptr() + 256);
    const int ph = *(volatile LAS int*)(uintptr_t)(LDS_BYTES - 32);
    return (unsigned long long*)ws + 30100 + ph; }
#endif
#ifdef PROBE
#define PSEC_BEGIN() unsigned pt_ = 0; if (PROBE_SEC == 1) pt_ = (unsigned)__builtin_amdgcn_s_memrealtime()
#define PSEC_BEGINN(n) unsigned pt_ = 0; if (PROBE_SEC == (n)) pt_ = (unsigned)__builtin_amdgcn_s_memrealtime()
#define PSEC_BEGIN6() unsigned pt_ = 0; if (PROBE_SEC == 6) pt_ = (unsigned)__builtin_amdgcn_s_memrealtime()
#define PSEC_BEGIN8() unsigned pt_ = 0; if (PROBE_SEC == 8) pt_ = (unsigned)__builtin_amdgcn_s_memrealtime()
#define PSEC(id) do { if (PROBE_SEC == (id)) { const unsigned pn_ = (unsigned)__builtin_amdgcn_s_memrealtime(); if (blockIdx.x == PROBE_BLK && tid == 0) *probe_epi_counter() += (unsigned long long)(pn_ - pt_); } if (PROBE_SEC == (id) + 1) pt_ = (unsigned)__builtin_amdgcn_s_memrealtime(); } while (0)
#else
#define PSEC_BEGIN() do { } while (0)
#define PSEC_BEGIN6() do { } while (0)
#define PSEC_BEGINN(n) do { } while (0)
#define PSEC_BEGIN8() do { } while (0)
#define PSEC(id) do { } while (0)
#endif
struct Params {
    const float* in[31];
    float* out;
    unsigned char* ws;
    int ph_lo, ph_hi;
};
enum { I_X = 0, I_C, I_CTX, I_CCTX, I_WMOD, I_BMOD, I_GN1, I_GN2, I_WIN, I_DLAM, I_GSUBLN, I_WGS, I_BGS, I_GGV, I_WCONV, I_BCONV, I_WQKV, I_WIF, I_BIF,
       I_GMN, I_SKIP, I_WBR, I_WOUT, I_WRG, I_BRG, I_WRE, I_BRE, I_WEG, I_WEU, I_WED, I_GFIN };

struct RowInfo { int hf, r, isctx, b, t; };
__device__ __forceinline__ RowInfo row_info(int R) {
    RowInfo q; q.hf = R >= MH ? 1 : 0; q.r = R - q.hf * MH;
    if (q.r < CTXROWS) { q.isctx = 1; q.b = q.hf * HBAT + (q.r >> 8); q.t = q.r & 255; }
    else { q.isctx = 0; const int s = q.r - CTXROWS; q.b = q.hf * HBAT + (s >> 11); q.t = s & 2047; }
    return q;
}
#define XB_TMO      128
#define XB_XCNT(j)  (256  + 64 * (j))
#define XB_XSUB(j)  (1280 + 64 * (j))
#define XB_XGEN(j)  (2304 + 64 * (j))
#define XB_TOP      3328
#define XB_TOPGEN   3392
#define XCD_BAR_WORDS 3456
#define XB_SPIN_CAP (1u << 18)

__device__ __forceinline__ unsigned xb_ld(unsigned* p)              { return __hip_atomic_load(p, __ATOMIC_RELAXED, __HIP_MEMORY_SCOPE_AGENT); }
__device__ __forceinline__ unsigned xb_add(unsigned* p, unsigned v) { return __hip_atomic_fetch_add(p, v, __ATOMIC_RELAXED, __HIP_MEMORY_SCOPE_AGENT); }
__device__ __forceinline__ unsigned xb_xcc_id() { return (unsigned)__builtin_amdgcn_s_getreg((3 << 11) | 20) & 0xFu; }
#define XB_SPIN(cond, bar) do { unsigned _sp = 0; while (cond) { __builtin_amdgcn_s_sleep(1); \
    if ((++_sp & 255u) == 0u) { if (xb_ld(&(bar)[XB_TMO])) break; if (_sp > XB_SPIN_CAP) { atomicAdd(&(bar)[XB_TMO], 1u); break; } } } } while (0)

struct XcdBarrier {
    unsigned* bar; unsigned x;
    volatile LAS unsigned* st;
};

__device__ __forceinline__ XcdBarrier xcd_barrier_post(unsigned* bar, volatile LAS unsigned* st) {
    XcdBarrier b; b.bar = bar; b.x = xb_xcc_id(); b.st = st;
    if (threadIdx.x == 0) (void)xb_add(&bar[XB_XCNT(b.x)], 1u);
    return b;
}
__device__ __forceinline__ void xcd_barrier_complete(unsigned* bar, unsigned x, unsigned& nloc, unsigned& nx) {
    const unsigned G = gridDim.x * gridDim.y * gridDim.z;
    unsigned sum, cnt, mine, sp = 0u;
    for (;;) {
        sum = 0u; cnt = 0u; mine = 0u;
#pragma unroll
        for (unsigned j = 0; j < 16; ++j) { const unsigned c = xb_ld(&bar[XB_XCNT(j)]); sum += c; cnt += (c > 0u) ? 1u : 0u; mine = (j == x) ? c : mine; }
        if (sum == G) break;
        __builtin_amdgcn_s_sleep(1);
        if ((++sp & 255u) == 0u) { if (xb_ld(&bar[XB_TMO])) break; if (sp > XB_SPIN_CAP) { atomicAdd(&bar[XB_TMO], 1u); break; } }
    }
    nloc = mine > 0u ? mine : 1u; nx = cnt > 0u ? cnt : 1u;
}

__device__ __forceinline__ void xcd_barrier(const XcdBarrier& b) {
    asm volatile("s_waitcnt vmcnt(0)" ::: "memory");
    __syncthreads();
    if (threadIdx.x == 0) {
        unsigned* bar = b.bar;
        __builtin_amdgcn_s_waitcnt(0);
        unsigned nloc = b.st[0], nx = b.st[1];
        if (nloc == 0u) { xcd_barrier_complete(bar, b.x, nloc, nx); b.st[0] = nloc; b.st[1] = nx; }
        const unsigned old = xb_add(&bar[XB_XSUB(b.x)], 1u);
        const unsigned gen = old / nloc;
        if (old + 1u == (gen + 1u) * nloc) {
            __builtin_amdgcn_fence(__ATOMIC_RELEASE, "agent");
            asm volatile("s_waitcnt vmcnt(0)" ::: "memory");
            const unsigned og = xb_add(&bar[XB_TOP], 1u);
            const unsigned tg = og / nx;
            if (og + 1u == (tg + 1u) * nx) xb_add(&bar[XB_TOPGEN], 1u);
            else XB_SPIN(xb_ld(&bar[XB_TOPGEN]) == tg, bar);
            __builtin_amdgcn_fence(__ATOMIC_ACQUIRE, "agent");
            xb_add(&bar[XB_XGEN(b.x)], 1u);
            asm volatile("s_waitcnt vmcnt(0)" ::: "memory");
        } else {
            XB_SPIN(xb_ld(&bar[XB_XGEN(b.x)]) == gen, bar);
            __builtin_amdgcn_fence(__ATOMIC_ACQUIRE, "agent");
            asm volatile("s_waitcnt vmcnt(0)" ::: "memory");
        }
    }
    __syncthreads();
}
namespace pg8 {
#define PG8_LAS __attribute__((address_space(3)))
typedef unsigned short bf16_t;
typedef short bf16x8 __attribute__((ext_vector_type(8)));
typedef float f32x4 __attribute__((ext_vector_type(4)));
typedef unsigned u32x4 __attribute__((ext_vector_type(4)));
constexpr int BM = 256, BK = 64, HALF = 128, HTB = HALF * BK * 2  , STAGE_BYTES = 8 * HTB, NXCD = 8, WGM = 8;

__host__ __device__ __forceinline__ int lds_byte(int r, int c) { const int st = (r >> 4) * 2 + (c >> 5), rr = r & 15, cc = c & 31, ob = rr * 64 + cc * 2; return st * 1024 + (ob ^ (((ob >> 9) & 1) << 5)); }
__host__ __device__ __forceinline__ void stage_rc(int b, int& R, int& C) { const int st = b / 1024, sb = b % 1024, swz = sb ^ (((sb >> 9) & 1) << 5); R = (st >> 1) * 16 + swz / 64; C = (st & 1) * 32 + (swz % 64) / 2; }
__host__ __device__ __forceinline__ int perm32(int rho) { const int n = rho >> 4, i = rho & 15; return 8 * (i >> 2) + 4 * n + (i & 3); }

struct Unit { int pm, pn; };
struct Gemm { const bf16_t* A; const bf16_t* Bt; int M, N, K; };

struct StaticOrder {
    int nM, nN, nwg, G, c;
    __host__ __device__ void init(int M, int N, int G_, int c_) { nM = M / BM; nN = N / BM; nwg = nM * nN; G = G_; c = c_; }
    __host__ __device__ bool next(int i, Unit& u) const {
        const long L = (long)i * G + c; if (L >= nwg) return false;
        int wgid = (int)L; { const int q = nwg / NXCD, r = nwg % NXCD, xcd = wgid % NXCD, off = wgid / NXCD; wgid = (xcd < r ? xcd * (q + 1) : r * (q + 1) + (xcd - r) * q) + off; }
        const int nig = WGM * nN, gid = wgid / nig, fm = gid * WGM, gsz = (nM - fm) < WGM ? (nM - fm) : WGM;
        u.pm = fm + ((wgid % nig) % gsz); u.pn = (wgid % nig) / gsz; return true;
    }
    __device__ __forceinline__ void a_ready(const Unit&) const {}
    __device__ __forceinline__ void done(const Unit&) const {}
};
__device__ __forceinline__ unsigned cvt_pk_bf16(float lo, float hi) { unsigned r; asm volatile("v_cvt_pk_bf16_f32 %0, %1, %2" : "=v"(r) : "v"(lo), "v"(hi)); return r; }
typedef float f32x2 __attribute__((ext_vector_type(2)));
__device__ __forceinline__ f32x2 gelu_pk(f32x2 v) {
    const f32x2 av = __builtin_elementwise_abs(v), d = av * 0.2316418882f + 1.0f;
    f32x2 t; t.x = __builtin_amdgcn_rcpf(d.x); t.y = __builtin_amdgcn_rcpf(d.y);
    f32x2 q = t * 0.5307027145f + (-0.7265760135f); q = q * t + 0.7107068705f; q = q * t + (-0.142248368f); q = q * t + 0.127414796f; q = q * t;
    const f32x2 s = (v * v) * (-0.72134752044f);
    f32x2 e; e.x = __builtin_amdgcn_exp2f(s.x); e.y = __builtin_amdgcn_exp2f(s.y);
    const f32x2 m = v * (q * e), r = v - m;
    f32x2 o; o.x = v.x < 0.f ? m.x : r.x; o.y = v.y < 0.f ? m.y : r.y; return o;
}

typedef int pg8_i32x4 __attribute__((ext_vector_type(4)));
template <bool F8> struct Frag { bf16x8 k[2]; };
template <class Epi, class Sched, bool STAMP = false, bool F8 = false, bool GA = false>
__device__ __forceinline__ void gemm_phase(PG8_LAS unsigned char* lds, const Gemm g, const Sched& S, const Epi& E, unsigned long long* stamps) {
    int tid_o = threadIdx.x; asm volatile("" : "+v"(tid_o));
    const int tid = tid_o, wid = __builtin_amdgcn_readfirstlane(tid >> 6), lane = tid & 63, wr = wid >> 2, wc = wid & 3, fr = lane & 15, fq = lane >> 4;
    const int K = g.K, nt = K / BK;
    int ts_lo = 0, ts_hi = 0, nts = 0; const unsigned long long rt_entry = STAMP ? (unsigned long long)wall_clock64() : 0ull;
#define PG8_STAMP() do { if (STAMP && wid == 0 && nts < 64) { const unsigned long long _c = (unsigned long long)clock64(); \
        ts_lo = (lane == nts) ? (int)(unsigned)_c : ts_lo; ts_hi = (lane == nts) ? (int)(unsigned)(_c >> 32) : ts_hi; ++nts; } } while (0)
    PG8_STAMP();
    unsigned voffA[2], voffB[2];
#pragma unroll
    for (int i = 0; i < 2; ++i) { int R, C; stage_rc(tid * 16 + i * 8192, R, C); const int Rb = Epi::PERM ? ((R & ~31) + perm32(R & 31)) : R;
        voffA[i] = (unsigned)(R * K + C) * 2u; voffB[i] = (unsigned)(Rb * K + C) * 2u; }
    const size_t pstep = (size_t)64 * K * 2;
    const size_t kstep = (size_t)(BK * 2);
    const size_t hstep = (size_t)HALF * K * 2;
    const size_t tstep = 2 * hstep;
    const unsigned ldsw = (unsigned)wid * 1024u;
    const int aoff = lds_byte(wr * 64 + fr, fq * 8), boff = lds_byte(wc * 32 + fr, fq * 8);
#define PG8_SA(b, h) (((b) * 2 + (h)) * HTB)
#define PG8_SB(b, h) ((4 + (b) * 2 + (h)) * HTB)
#define PG8_STAGE(bufoff, gbase, voff) do { const char* _b0 = (const char*)(gbase); const char* _b1 = _b0 + pstep; asm volatile("" : "+s"(_b0), "+s"(_b1)); \
        __builtin_amdgcn_global_load_lds((const unsigned*)(_b0 + (voff)[0]), (PG8_LAS unsigned*)(lds + (bufoff) + ldsw), 16, 0, 0); \
        __builtin_amdgcn_global_load_lds((const unsigned*)(_b1 + (voff)[0]), (PG8_LAS unsigned*)(lds + (bufoff) + ldsw + 8192), 16, 0, 0); } while (0)
    unsigned gC[4] = {0u, 0u, 0u, 0u}, gN[4] = {0u, 0u, 0u, 0u}; int gR = 0, gCol = 0; stage_rc(tid * 16, gR, gCol);
#define PG8_GOFF(dst, ui_) do { _Pragma("unroll") for (int _j = 0; _j < 4; ++_j) dst[_j] = (unsigned)S.src_row((ui_), gR + 64 * _j) * (unsigned)(K * 2) + (unsigned)(gCol * 2); } while (0)
#define PG8_STAGE_G(bufoff, kptr, h, nx) do { const char* _b = (const char*)(kptr); asm volatile("" : "+s"(_b)); const unsigned _o0 = (nx) ? gN[2 * (h)] : gC[2 * (h)], _o1 = (nx) ? gN[2 * (h) + 1] : gC[2 * (h) + 1]; \
        __builtin_amdgcn_global_load_lds((const unsigned*)(_b + _o0), (PG8_LAS unsigned*)(lds + (bufoff) + ldsw), 16, 0, 0); \
        __builtin_amdgcn_global_load_lds((const unsigned*)(_b + _o1), (PG8_LAS unsigned*)(lds + (bufoff) + ldsw + 8192), 16, 0, 0); } while (0)
#define PG8_LDF(dstf, addr) do { (dstf).k[0] = *(const PG8_LAS bf16x8*)(addr); (dstf).k[1] = *(const PG8_LAS bf16x8*)((addr) + 1024); } while (0)
#define PG8_LDA(dst, b, h) do { _Pragma("unroll") for (int m = 0; m < 4; ++m) PG8_LDF(dst[m], lds + PG8_SA(b, h) + aoff + m * 2048); } while (0)
#define PG8_LDB(dst, b, h) do { _Pragma("unroll") for (int n = 0; n < 2; ++n) PG8_LDF(dst[n], lds + PG8_SB(b, h) + boff + n * 2048); } while (0)
#define PG8_MMA(ai, bj, At, Bt) do { __builtin_amdgcn_s_setprio(1); _Pragma("unroll") for (int m = 0; m < 4; ++m) _Pragma("unroll") for (int n = 0; n < 2; ++n) _Pragma("unroll") for (int k = 0; k < 2; ++k) { \
        if constexpr (F8) acc[ai][bj][m][n] = __builtin_bit_cast(f32x4, __builtin_amdgcn_mfma_i32_16x16x64_i8(__builtin_bit_cast(pg8_i32x4, Bt[n].k[k]), __builtin_bit_cast(pg8_i32x4, At[m].k[k]), __builtin_bit_cast(pg8_i32x4, acc[ai][bj][m][n]), 0, 0, 0)); \
        else acc[ai][bj][m][n] = __builtin_amdgcn_mfma_f32_16x16x32_bf16(Bt[n].k[k], At[m].k[k], acc[ai][bj][m][n], 0, 0, 0); } \
        __builtin_amdgcn_s_setprio(0); } while (0)
#define PG8_WAIT_V(n) asm volatile("s_waitcnt vmcnt(" #n ")" ::: "memory")
#define PG8_WAIT_L(n) asm volatile("s_waitcnt lgkmcnt(" #n ")" ::: "memory")
#define PG8_BAR __builtin_amdgcn_s_barrier()
#define PG8_SCHED __builtin_amdgcn_sched_barrier(0)
    Unit cur, nxt; int ui = 0;
    if (!S.next(0, cur)) return;
    f32x4 acc[2][2][4][2];
#pragma unroll
    for (int a = 0; a < 2; ++a)
#pragma unroll
        for (int b = 0; b < 2; ++b)
#pragma unroll
            for (int m = 0; m < 4; ++m)
#pragma unroll
                for (int n = 0; n < 2; ++n) acc[a][b][m][n] = (f32x4){0.f, 0.f, 0.f, 0.f};
    Frag<F8> At[4], B0[2], B1[2];
    const char* cA = (const char*)g.A + (size_t)cur.pm * tstep; const char* cB = (const char*)g.Bt + (size_t)cur.pn * tstep;
    S.a_ready(cur);
    const char* A0 = (const char*)g.A; if constexpr (GA) PG8_GOFF(gC, 0);
    PG8_STAGE(PG8_SB(0, 0), cB, voffB); if constexpr (GA) PG8_STAGE_G(PG8_SA(0, 0), A0, 0, false); else PG8_STAGE(PG8_SA(0, 0), cA, voffA);
    PG8_STAGE(PG8_SB(0, 1), cB + hstep, voffB); if constexpr (GA) PG8_STAGE_G(PG8_SA(0, 1), A0, 1, false); else PG8_STAGE(PG8_SA(0, 1), cA + hstep, voffA);
    if (wr == 1) PG8_BAR;
    PG8_WAIT_V(4); PG8_BAR;
    PG8_STAGE(PG8_SB(1, 0), cB + kstep, voffB); if constexpr (GA) PG8_STAGE_G(PG8_SA(1, 0), A0 + kstep, 0, false); else PG8_STAGE(PG8_SA(1, 0), cA + kstep, voffA);
    PG8_STAGE(PG8_SB(1, 1), cB + hstep + kstep, voffB);
    PG8_WAIT_V(6); PG8_BAR;
    PG8_STAMP();
    for (;;) {
        const bool has_next = S.next(ui + 1, nxt);
        const char* nA = has_next ? (const char*)g.A + (size_t)nxt.pm * tstep : cA; const char* nB = has_next ? (const char*)g.Bt + (size_t)nxt.pn * tstep : cB;
        if constexpr (GA) { if (has_next) PG8_GOFF(gN, ui + 1); else { gN[0] = gC[0]; gN[1] = gC[1]; gN[2] = gC[2]; gN[3] = gC[3]; } }
        for (int t = 0; t < nt; t += 2) {
            const bool last = (t == nt - 2);
            const char* a1 = cA + (size_t)(t + 1) * kstep;
            const char* a2 = last ? nA : cA + (size_t)(t + 2) * kstep; const char* b2 = last ? nB : cB + (size_t)(t + 2) * kstep;
            const char* a3 = a2 + kstep; const char* b3 = b2 + kstep;
            const char* kA1 = A0 + (size_t)(t + 1) * kstep; const char* kA2 = last ? A0 : A0 + (size_t)(t + 2) * kstep; const char* kA3 = kA2 + kstep;
            if (last && has_next) S.a_ready(nxt);
            PG8_LDB(B0, 0, 0); PG8_SCHED; PG8_LDA(At, 0, 0); if constexpr (GA) PG8_STAGE_G(PG8_SA(1, 1), kA1, 1, false); else PG8_STAGE(PG8_SA(1, 1), a1 + hstep, voffA);
            PG8_WAIT_L(8); PG8_BAR; PG8_WAIT_L(0); PG8_MMA(0, 0, At, B0); PG8_BAR; PG8_SCHED;
            PG8_LDB(B1, 0, 1); PG8_STAGE(PG8_SB(0, 0), b2, voffB);
            PG8_BAR; PG8_WAIT_L(0); PG8_MMA(0, 1, At, B1); PG8_BAR;
            PG8_LDA(At, 0, 1); if constexpr (GA) PG8_STAGE_G(PG8_SA(0, 0), kA2, 0, last); else PG8_STAGE(PG8_SA(0, 0), a2, voffA);
            PG8_BAR; PG8_WAIT_L(0); PG8_MMA(1, 0, At, B0); PG8_BAR; PG8_SCHED;
            PG8_STAGE(PG8_SB(0, 1), b2 + hstep, voffB);
            PG8_WAIT_V(6); PG8_BAR; PG8_MMA(1, 1, At, B1); PG8_BAR;
            PG8_LDB(B0, 1, 0); PG8_SCHED; PG8_LDA(At, 1, 0); if constexpr (GA) PG8_STAGE_G(PG8_SA(0, 1), kA2, 1, last); else PG8_STAGE(PG8_SA(0, 1), a2 + hstep, voffA);
            PG8_WAIT_L(8); PG8_BAR; PG8_WAIT_L(0); PG8_MMA(0, 0, At, B0); PG8_BAR; PG8_SCHED;
            PG8_LDB(B1, 1, 1); PG8_STAGE(PG8_SB(1, 0), b3, voffB);
            PG8_BAR; PG8_WAIT_L(0); PG8_MMA(0, 1, At, B1); PG8_BAR;
            PG8_LDA(At, 1, 1); if constexpr (GA) PG8_STAGE_G(PG8_SA(1, 0), kA3, 0, last); else PG8_STAGE(PG8_SA(1, 0), a3, voffA);
            PG8_BAR; PG8_WAIT_L(0); PG8_MMA(1, 0, At, B0); PG8_BAR; PG8_SCHED;
            PG8_STAGE(PG8_SB(1, 1), b3 + hstep, voffB);
            PG8_WAIT_V(6); PG8_BAR; PG8_MMA(1, 1, At, B1); PG8_BAR;
        }
        PG8_STAMP();
#ifdef PROBE_EPI
        const unsigned long long te0_ = __builtin_amdgcn_s_memrealtime();
#endif
        const bool keep_acc = E(acc, cur, wr, wc, fr, fq); S.done(cur);
#ifdef PROBE_EPI
        if (blockIdx.x == 0 && tid == 0) { unsigned long long* ec_ = probe_epi_counter(); *ec_ += __builtin_amdgcn_s_memrealtime() - te0_; }
#endif
        PG8_STAMP();
        if (!has_next) break;
        if (!keep_acc)
#pragma unroll
        for (int a = 0; a < 2; ++a)
#pragma unroll
            for (int b = 0; b < 2; ++b)
#pragma unroll
                for (int m = 0; m < 4; ++m)
#pragma unroll
                    for (int n = 0; n < 2; ++n) acc[a][b][m][n] = (f32x4){0.f, 0.f, 0.f, 0.f};
        cur = nxt; cA = nA; cB = nB; ++ui;
        if constexpr (GA) { gC[0] = gN[0]; gC[1] = gN[1]; gC[2] = gN[2]; gC[3] = gN[3]; }
    }
    PG8_WAIT_V(0);
    if (wr == 0) PG8_BAR;
    PG8_BAR;
    PG8_STAMP();
    if (STAMP && wid == 0) { stamps[lane] = lane < nts ? (((unsigned long long)(unsigned)ts_hi << 32) | (unsigned)ts_lo) : 0ull;
        if (lane == 62) stamps[62] = rt_entry; if (lane == 63) stamps[63] = (unsigned long long)wall_clock64(); }
#undef PG8_STAMP
#undef PG8_SA
#undef PG8_SB
#undef PG8_STAGE
#undef PG8_STAGE_G
#undef PG8_GOFF
#undef PG8_LDA
#undef PG8_LDF
#undef PG8_LDB
#undef PG8_MMA
#undef PG8_WAIT_V
#undef PG8_WAIT_L
#undef PG8_BAR
#undef PG8_SCHED
}
}
struct RectOrder {
    pg8::StaticOrder so; int offA, nwgA, nMb, nNb, offB, nwgB, G, c;
    __device__ void init(int nMa, int nNa, int offA_, int nMb_, int nNb_, int offB_, int G_, int c_) {
        so.init(nMa * 256, nNa * 256, G_, c_); offA = offA_; nwgA = nMa * nNa; nMb = nMb_; nNb = nNb_; offB = offB_; nwgB = nMb_ * nNb_; G = G_; c = c_; }
    __device__ bool next(int i, pg8::Unit& u) const {
        const int L = i * G + c;
        if (L < nwgA) { so.next(i, u); u.pm += offA; return true; }
        const int Lb = L - nwgA; if (Lb >= nwgB) return false;
        u.pm = offB + Lb % nMb; u.pn = Lb / nMb; return true;
    }
    __device__ __forceinline__ void a_ready(const pg8::Unit&) const {}
    __device__ __forceinline__ void done(const pg8::Unit&) const {}
};
struct MergeOrder {
    pg8::StaticOrder so; int off, G, c;
    __device__ void init(int nM, int off_, int G_, int c_) { so.init(nM * 256, 1024, G_, c_); off = off_; G = G_; c = c_; }
    __device__ bool next(int i, pg8::Unit& u) const {
        const int ti = i / 3, br = i - ti * 3;
        if (!so.next(ti, u)) return false;
        u.pm += off + br * (MH / 256); u.pn += br * 4; return true;
    }
    __device__ __forceinline__ void a_ready(const pg8::Unit&) const {}
    __device__ __forceinline__ void done(const pg8::Unit&) const {}
};
struct MoeOrder {
    const LAS int* srcl = nullptr;
    __device__ __forceinline__ int src_row(int i, int r) const { return srcl[i * 256 + r]; }
    int e0, e1, e2, e3, e4, e5, ntiles, G, c;
    __device__ __forceinline__ void unit_of(int i, int& pm, int& pn) const {
        if ((G & 31) == 0) { const int j = c >> 3; pm = i * (G >> 2) + (c & 7) * (G >> 5) + (j >> 2); pn = j & 3; }
        else { const int L = i * G + c; pm = L >> 2; pn = L & 3; } }
    __device__ __forceinline__ int look(const LAS int* tile_e, int i) const { int pm, pn; unit_of(i, pm, pn); return __builtin_amdgcn_readfirstlane(pm < ntiles ? tile_e[pm] : 0); }
    __device__ __forceinline__ void init(const LAS int* tile_e, int nt, int G_, int c_) { ntiles = nt; G = G_; c = c_;
        e0 = look(tile_e, 0); e1 = look(tile_e, 1); e2 = look(tile_e, 2); e3 = look(tile_e, 3); e4 = look(tile_e, 4); e5 = look(tile_e, 5); }
    __device__ __forceinline__ bool next(int i, pg8::Unit& u) const {
        int pm, pn; unit_of(i, pm, pn); if (pm >= ntiles || i >= 6) return false;
        const int e = i == 0 ? e0 : i == 1 ? e1 : i == 2 ? e2 : i == 3 ? e3 : i == 4 ? e4 : e5;
        u.pm = pm; u.pn = e * 4 + pn; return true;
    }
    __device__ __forceinline__ void a_ready(const pg8::Unit&) const {}
    __device__ __forceinline__ void done(const pg8::Unit&) const {}
};

struct EpiIn {
    static constexpr bool PERM = true, AFTER_DRAIN = false;
    bf16_t* P; bf16_t* GB; const float* cosT; const float* sinT;
    __device__ __forceinline__ bool operator()(pg8::f32x4 (&acc)[2][2][4][2], const pg8::Unit& u, int wr, int wc, int fr, int fq) const {
        const int pn = u.pn, rbase = u.pm * 256 + wr * 64 + fr;
        int act, ld; bf16_t* dst; int cb; bool rope = false; float scl = 1.0f;
        if (pn < 14) {
            const int kind = pn >> 1;
            const int bufidx = kind == 5 ? 6 : (kind == 6 ? 5 : kind);
            dst = P + (size_t)bufidx * ((size_t)MH * 512); ld = 512; cb = (pn & 1) * 256 + wc * 32 + 8 * fq;
            act = (kind == 4 || kind == 5) ? 1 : (kind == 6 ? 2 : 0);
            rope = (kind == 0 || kind == 3) && (u.pm >= 8);
            if (kind == 3) scl = QSCALE;
        } else {
            const int gi = (pn - 14) >> 2, pnl = (pn - 14) & 3, tid = (wr * 4 + wc) * 64 + fq * 16 + fr;
            u32x2* gdst = (u32x2*)GB + ((size_t)((gi * (MH / 256) + u.pm) * 4 + pnl) * 16) * 512 + tid;
#pragma unroll
            for (int ai = 0; ai < 2; ++ai)
#pragma unroll
                for (int m = 0; m < 4; ++m)
#pragma unroll
                    for (int bj = 0; bj < 2; ++bj) { unsigned q[8];
#pragma unroll
                        for (int j = 0; j < 4; ++j) { q[j] = (unsigned)fminf(fmaxf(sigmoid_f(acc[ai][bj][m][0][j]) * 255.0f + 0.5f, 1.0f), 255.0f); q[4 + j] = (unsigned)fminf(fmaxf(sigmoid_f(acc[ai][bj][m][1][j]) * 255.0f + 0.5f, 1.0f), 255.0f); }
                        u32x2 w; w.x = q[0] | (q[1] << 8) | (q[2] << 16) | (q[3] << 24); w.y = q[4] | (q[5] << 8) | (q[6] << 16) | (q[7] << 24);
                        gdst[(size_t)((ai * 4 + m) * 2 + bj) * 512] = w; }
            return false;
        }
        pg8::f32x4 csv[8], snv[8];
#pragma unroll
        for (int i = 0; i < 8; ++i) { csv[i] = (pg8::f32x4){1.f, 1.f, 1.f, 1.f}; snv[i] = (pg8::f32x4){0.f, 0.f, 0.f, 0.f}; }
        if (rope) {
#pragma unroll
            for (int i = 0; i < 8; ++i) { const int row = rbase + (i >> 2) * 128 + (i & 3) * 16; const int t = (row - CTXROWS) & 2047; const int pos = (wc & 1) ? (t & 63) : (t >> 6);
                csv[i] = *(const pg8::f32x4*)(cosT + pos * 16 + 4 * fq); snv[i] = *(const pg8::f32x4*)(sinT + pos * 16 + 4 * fq); } }
#pragma unroll
        for (int ai = 0; ai < 2; ++ai)
#pragma unroll
            for (int m = 0; m < 4; ++m) {
                const int row = rbase + ai * 128 + m * 16;
                const pg8::f32x4 cs = csv[ai * 4 + m], sn = snv[ai * 4 + m];
                bf16_t* rowp = dst + (size_t)row * ld + cb;
#pragma unroll
                for (int bj = 0; bj < 2; ++bj) {
                    pg8::f32x4 v0 = acc[ai][bj][m][0], v1 = acc[ai][bj][m][1];
                    if (rope) { const pg8::f32x4 o0 = v0 * cs - v1 * sn, o1 = v0 * sn + v1 * cs; v0 = o0; v1 = o1; }
                    v0 *= scl; v1 *= scl;
                    if (act == 1) {
#pragma unroll
                        for (int j = 0; j < 4; ++j) { v0[j] = gelu_tanh_f(v0[j]); v1[j] = gelu_tanh_f(v1[j]); } }
                    else if (act == 2) {
#pragma unroll
                        for (int j = 0; j < 4; ++j) { v0[j] = fmaxf(sigmoid_f(v0[j]), 1e-6f); v1[j] = fmaxf(sigmoid_f(v1[j]), 1e-6f); } }
                    u32x4 w; w.x = cvtpk(v0[0], v0[1]); w.y = cvtpk(v0[2], v0[3]); w.z = cvtpk(v1[0], v1[1]); w.w = cvtpk(v1[2], v1[3]);
                    *(u32x4*)(rowp + bj * 128) = w;
                }
            }
        return false;
    }
};
struct EpiGate8 {
    static constexpr bool PERM = true, AFTER_DRAIN = false;
    bf16_t* GB;
    __device__ __forceinline__ bool operator()(pg8::f32x4 (&acc)[2][2][4][2], const pg8::Unit& u, int wr, int wc, int fr, int fq) const {
        const int gi = u.pn >> 2, pnl = u.pn & 3, tid = (wr * 4 + wc) * 64 + fq * 16 + fr; const float sc = 1.0f / (HSCALE8 * WSCALE8);
        u32x2* gdst = (u32x2*)GB + ((size_t)((gi * (MH / 256) + u.pm) * 4 + pnl) * 16) * 512 + tid;
#pragma unroll
        for (int ai = 0; ai < 2; ++ai)
#pragma unroll
            for (int m = 0; m < 4; ++m)
#pragma unroll
                for (int bj = 0; bj < 2; ++bj) { unsigned q[8];
#pragma unroll
                    for (int j = 0; j < 4; ++j) { q[j] = (unsigned)fminf(fmaxf(sigmoid_f((float)__float_as_int(acc[ai][bj][m][0][j]) * sc) * 255.0f + 0.5f, 1.0f), 255.0f);
                        q[4 + j] = (unsigned)fminf(fmaxf(sigmoid_f((float)__float_as_int(acc[ai][bj][m][1][j]) * sc) * 255.0f + 0.5f, 1.0f), 255.0f); }
                    u32x2 w; w.x = q[0] | (q[1] << 8) | (q[2] << 16) | (q[3] << 24); w.y = q[4] | (q[5] << 8) | (q[6] << 16) | (q[7] << 24);
                    gdst[(size_t)((ai * 4 + m) * 2 + bj) * 512] = w; }
        return false;
    }
};
struct EpiMerge {
    static constexpr bool PERM = true, AFTER_DRAIN = false;
    const bf16_t* GB; bf16_t* OUT;
    __device__ __forceinline__ bool operator()(pg8::f32x4 (&acc)[2][2][4][2], const pg8::Unit& u, int wr, int wc, int fr, int fq) const {
        const int br = u.pn >> 2, pn = u.pn & 3, pm = u.pm - br * (MH / 256), tid = (wr * 4 + wc) * 64 + fq * 16 + fr;
        const int rbase = pm * 256 + wr * 64 + fr, cb = pn * 256 + wc * 32 + 8 * fq;
        const u32x2* g0 = (const u32x2*)GB + ((size_t)((br * (MH / 256) + pm) * 4 + pn) * 16) * 512 + tid;
        const u32x2* g1 = g0 + (size_t)(MH / 256) * 4 * 16 * 512;
        u32x2 ga_[16], gb_[16];
#pragma unroll
        for (int s = 0; s < 16; ++s) { ga_[s] = g0[(size_t)s * 512]; gb_[s] = (br < 2) ? g1[(size_t)s * 512] : (u32x2){0x01010101u, 0x01010101u}; }
#pragma unroll
        for (int ai = 0; ai < 2; ++ai)
#pragma unroll
            for (int m = 0; m < 4; ++m) {
                const size_t off = (size_t)(rbase + ai * 128 + m * 16) * 1024 + cb;
#pragma unroll
                for (int bj = 0; bj < 2; ++bj) {
                    const int slot = (ai * 4 + m) * 2 + bj;
                    const u32x2 a = ga_[slot], b = gb_[slot];
                    float ga[8];
#pragma unroll
                    for (int j = 0; j < 4; ++j) { ga[j] = (float)((a.x >> (8 * j)) & 0xffu); ga[4 + j] = (float)((a.y >> (8 * j)) & 0xffu); }
                    if (br < 2) {
#pragma unroll
                        for (int j = 0; j < 4; ++j) { ga[j] *= __builtin_amdgcn_rcpf((float)((b.x >> (8 * j)) & 0xffu)); ga[4 + j] *= __builtin_amdgcn_rcpf((float)((b.y >> (8 * j)) & 0xffu)); }
                    } else {
#pragma unroll
                        for (int j = 0; j < 8; ++j) ga[j] *= (1.0f / 255.0f);
                    }
                    pg8::f32x4 v0 = acc[ai][bj][m][0], v1 = acc[ai][bj][m][1];
#pragma unroll
                    for (int j = 0; j < 4; ++j) { v0[j] *= ga[j]; v1[j] *= ga[4 + j]; }
                    if (br < 2) { acc[ai][bj][m][0] = v0; acc[ai][bj][m][1] = v1; }
                    else { u32x4 w; w.x = cvtpk(v0[0], v0[1]); w.y = cvtpk(v0[2], v0[3]); w.z = cvtpk(v1[0], v1[1]); w.w = cvtpk(v1[2], v1[3]);
                        *(u32x4*)(OUT + off + bj * 128) = w; }
                }
            }
        return br < 2;
    }
};
struct EpiOut {
    static constexpr bool PERM = false, AFTER_DRAIN = false;
    const float* xres_lat; const float* xres_ctx; float* xs_lat; float* xs_ctx; const float* mod; int hf;
    __device__ __forceinline__ bool operator()(pg8::f32x4 (&acc)[2][2][4][2], const pg8::Unit& u, int wr, int wc, int fr, int fq) const {
        const int pm = u.pm; const float* src; float* dst; int b;
        if (pm < 8) { b = 16; const size_t o = (size_t)((hf * HBAT + pm) * 256) * 1024; src = xres_ctx + o; dst = xs_ctx + o; }
        else { const int q = pm - 8; b = hf * HBAT + (q >> 3); const size_t o = ((size_t)b * 2048 + (size_t)(q & 7) * 256) * 1024; src = xres_lat + o; dst = xs_lat + o; }
        const int col0 = u.pn * 256 + wc * 32 + 4 * fq;
        const float* mrow = mod + (size_t)b * 6144 + 2 * 1024 + col0;
        pg8::f32x4 mv[2][2];
#pragma unroll
        for (int bj = 0; bj < 2; ++bj)
#pragma unroll
            for (int n = 0; n < 2; ++n) mv[bj][n] = *(const pg8::f32x4*)(mrow + bj * 128 + n * 16);
#pragma unroll
        for (int ai = 0; ai < 2; ++ai) {
            pg8::f32x4 xr[4][2][2];
#pragma unroll
            for (int m = 0; m < 4; ++m) { const size_t off = (size_t)(wr * 64 + fr + ai * 128 + m * 16) * 1024 + col0;
#pragma unroll
                for (int bj = 0; bj < 2; ++bj)
#pragma unroll
                    for (int n = 0; n < 2; ++n) xr[m][bj][n] = *(const pg8::f32x4*)(src + off + bj * 128 + n * 16); }
#pragma unroll
            for (int m = 0; m < 4; ++m) { const size_t off = (size_t)(wr * 64 + fr + ai * 128 + m * 16) * 1024 + col0;
#pragma unroll
                for (int bj = 0; bj < 2; ++bj)
#pragma unroll
                    for (int n = 0; n < 2; ++n) *(pg8::f32x4*)(dst + off + bj * 128 + n * 16) = xr[m][bj][n] + mv[bj][n] * acc[ai][bj][m][n]; }
            asm volatile("" ::: "memory");
        }
        return false;
    }
};
struct EpiGU {
    static constexpr bool PERM = true, AFTER_DRAIN = false;
    unsigned char* ACT;
    __device__ __forceinline__ bool operator()(pg8::f32x4 (&acc)[2][2][4][2], const pg8::Unit& u, int wr, int wc, int fr, int fq) const {
        const int rbase = u.pm * 256 + wr * 64 + fr, cb = (u.pn & 3) * 128 + wc * 32 + 8 * fq;
        const float sc = 1.0f / (HSCALE8 * WSCALE8);
#pragma unroll
        for (int ai = 0; ai < 2; ++ai)
#pragma unroll
            for (int m = 0; m < 4; ++m) {
                float o[8];
#pragma unroll
                for (int n = 0; n < 2; ++n)
#pragma unroll
                    for (int j = 0; j < 4; ++j) o[4 * n + j] = silu_f((float)__float_as_int(acc[ai][0][m][n][j]) * sc) * ((float)__float_as_int(acc[ai][1][m][n][j]) * (sc * ASCALE8));
                u32x2 w; w.x = pk4_fp8(o[0], o[1], o[2], o[3]); w.y = pk4_fp8(o[4], o[5], o[6], o[7]);
                *(u32x2*)(ACT + (size_t)(rbase + ai * 128 + m * 16) * 512 + cb) = w;
            }
        return false;
    }
};
struct EpiDown {
    static constexpr bool PERM = true, AFTER_DRAIN = false;
    bf16_t* YS;
    __device__ __forceinline__ bool operator()(pg8::f32x4 (&acc)[2][2][4][2], const pg8::Unit& u, int wr, int wc, int fr, int fq) const {
        const int rbase = u.pm * 256 + wr * 64 + fr, cb = (u.pn & 3) * 256 + wc * 32 + 8 * fq;
#pragma unroll
        for (int ai = 0; ai < 2; ++ai)
#pragma unroll
            for (int m = 0; m < 4; ++m) {
                const int row = rbase + ai * 128 + m * 16;
#pragma unroll
                for (int bj = 0; bj < 2; ++bj) { const float s8 = 1.0f / (ASCALE8 * WSCALE8); u32x4 w;
                    w.x = cvtpk((float)__float_as_int(acc[ai][bj][m][0][0]) * s8, (float)__float_as_int(acc[ai][bj][m][0][1]) * s8); w.y = cvtpk((float)__float_as_int(acc[ai][bj][m][0][2]) * s8, (float)__float_as_int(acc[ai][bj][m][0][3]) * s8);
                    w.z = cvtpk((float)__float_as_int(acc[ai][bj][m][1][0]) * s8, (float)__float_as_int(acc[ai][bj][m][1][1]) * s8); w.w = cvtpk((float)__float_as_int(acc[ai][bj][m][1][2]) * s8, (float)__float_as_int(acc[ai][bj][m][1][3]) * s8);
                    *(u32x4*)(YS + (size_t)row * 1024 + cb + bj * 128) = w; }
            }
        return false;
    }
};
template <class ColMap>
__device__ __forceinline__ void cvt_tile_T(const float* __restrict__ src, int ldsrc, bf16_t* __restrict__ dst, int K, int k0, int n0, const ColMap& cm, float scale, LAS float* tile) {
    const int tid = opaque_tid();
    {
        const int n = tid & 63, kb = tid >> 6; const int sc = cm(n0 + n);
#pragma unroll
        for (int i = 0; i < 8; ++i) { const int k = kb + 8 * i; tile[k * 65 + n] = src[(size_t)(k0 + k) * ldsrc + sc] * scale; }
    }
    __syncthreads();
    {
        const int kp = (tid & 31) * 2, nb = tid >> 5;
#pragma unroll
        for (int i = 0; i < 4; ++i) { const int n = nb + 16 * i; *(unsigned*)(dst + (size_t)(n0 + n) * K + k0 + kp) = cvtpk(tile[kp * 65 + n], tile[(kp + 1) * 65 + n]); }
    }
    __syncthreads();
}
struct CmIdent { int off; __device__ __forceinline__ int operator()(int n) const { return n + off; } };
struct CmWin {
    __device__ __forceinline__ int operator()(int n) const {
        if (n < 512 || (n >= 1536 && n < 2048)) { const int c = n & 31, f = c >> 3, j = c & 7; return (n & ~31) + ((j < 4) ? (4 * f + j) : (16 + 4 * f + (j - 4))); }
        return n; }
};
struct CmGU {
    __device__ __forceinline__ int operator()(int n) const { return 128 * (n >> 8) + (n & 127); }
};

template <int MODE, bool OUT8 = false>
__device__ __forceinline__ void cvt_tile_T256(const float* __restrict__ baseA, const float* __restrict__ baseB, int ldsrc, void* __restrict__ dstv, int K, int k0, int n0, float scale, LAS float* tile) {
    const int tid = opaque_tid();
    {
        const int n = tid & 255, kb = tid >> 8, ng = n0 + n;
        const float* sp = (MODE == 2 ? ((ng & 128) ? baseB : baseA) + 128 * (ng >> 8) + (ng & 127) : MODE == 1 ? baseA + CmWin{}(ng) : baseA + ng) + (size_t)(k0 + kb) * ldsrc;
        float v[32];
#pragma unroll
        for (int i = 0; i < 32; ++i) v[i] = sp[(size_t)(2 * i) * ldsrc];
#pragma unroll
        for (int i = 0; i < 32; ++i) tile[(kb + 2 * i) * 257 + n] = v[i] * scale;
    }
    __syncthreads();
    {
        const int n = tid >> 1, kh = (tid & 1) * 32;
        if constexpr (OUT8) { unsigned char* dp = (unsigned char*)dstv + (size_t)(n0 + n) * K + k0 + kh;
#pragma unroll
            for (int i = 0; i < 2; ++i) { float f[16];
#pragma unroll
                for (int j = 0; j < 16; ++j) f[j] = tile[(kh + 16 * i + j) * 257 + n];
                u32x4 w; w.x = pk4_fp8(f[0], f[1], f[2], f[3]); w.y = pk4_fp8(f[4], f[5], f[6], f[7]); w.z = pk4_fp8(f[8], f[9], f[10], f[11]); w.w = pk4_fp8(f[12], f[13], f[14], f[15]);
                *(u32x4*)(dp + 16 * i) = w; } }
        else { bf16_t* dp = (bf16_t*)dstv + (size_t)(n0 + n) * K + k0 + kh;
#pragma unroll
            for (int i = 0; i < 4; ++i) { float f[8];
#pragma unroll
                for (int j = 0; j < 8; ++j) f[j] = tile[(kh + 8 * i + j) * 257 + n];
                *(u32x4*)(dp + 8 * i) = pack8(f); } }
    }
    __syncthreads();
}

__device__ __forceinline__ void phase_prologue(const Params& p, LAS unsigned char* lds) {
    LAS float* tile = (LAS float*)lds;
    const int tid = opaque_tid(), G = gridDim.x, bid = blockIdx.x;
    unsigned char* ws = p.ws;
    for (int u = bid; u < 1248; u += G) {
        if (u < 448) { const int l = u / 224, r = u % 224, kt = r / 14, nt = r % 14;
            cvt_tile_T256<1>(p.in[I_WIN] + (size_t)l * 1024 * NCOL, nullptr, NCOL, (bf16_t*)(ws + WS_WTIN) + (size_t)l * NCOL * 1024, 1024, kt * 64, nt * 256, 1.0f, tile); }
        else if (u < 832) { const int v = u - 448, l = v / 192, r = v % 192, kt = r / 12, nt = r % 12;
            cvt_tile_T256<0, true>(p.in[I_WIN] + (size_t)l * 1024 * NCOL + 3584, nullptr, NCOL, ws + WS_WTIN8 + (size_t)l * 3072 * 1024, 1024, kt * 64, nt * 256, WSCALE8, tile); }
        else if (u < 1024) { const int v = u - 832, li = v / 32, r = v % 32, kt = r / 4, nt = r % 4;
            cvt_tile_T256<0>(p.in[I_WBR] + (size_t)li * 512 * 1024, nullptr, 1024, (bf16_t*)(ws + WS_WTBR) + (size_t)li * 1024 * 512, 512, kt * 64, nt * 256, 1.0f, tile); }
        else if (u < 1152) { const int v = u - 1024, l = v / 64, r = v % 64, kt = r / 4, nt = r % 4;
            cvt_tile_T256<0>(p.in[I_WOUT] + (size_t)l * 1024 * 1024, nullptr, 1024, (bf16_t*)(ws + WS_WTO) + (size_t)l * 1024 * 1024, 1024, kt * 64, nt * 256, 1.0f, tile); }
        else { const int v = u - 1152, m = v / 4, r = v % 4, kt = r >> 1, nt = r & 1;
            const int j = (m >> 2) % 3;
            cvt_tile_T(p.in[I_WQKV] + (size_t)m * 16384, 128, (bf16_t*)(ws + WS_WTQKV) + (size_t)m * 16384, 128, kt * 64, nt * 64, CmIdent{0}, j == 1 ? 0.08838834764831845f : 1.0f, tile); }
    }
    const int gt = bid * NTHR + tid, gn = G * NTHR;
    for (int i = gt; i < 2 * 4 * 16384; i += gn) ((bf16_t*)(ws + WS_WSB))[i] = f2bf(p.in[I_WGS][i]);
    for (int i = gt; i < 2 * 48 * 1024; i += gn) {
        const int l = i / (48 * 1024), r = i % (48 * 1024), n = r >> 10, k = r & 1023;
        float w = 0.f; if (n < 4) w = p.in[I_WRG][((size_t)l * 1024 + k) * 4 + n]; else if (n < 36) w = p.in[I_WRE][((size_t)l * 1024 + k) * 32 + (n - 4)];
        const bf16_t hi = f2bf(w); const bf16_t lo = f2bf(w - bf2f(hi));
        bf16_t* d = (bf16_t*)(ws + WS_WRT) + (size_t)l * 2 * 48 * 1024;
        d[r] = hi; d[48 * 1024 + r] = lo;
    }
    for (int i = gt; i < 1024; i += gn) { const int pos = i >> 4, f = i & 15; const float inv = powf(10000.0f, -(float)f / 16.0f); const float a = (float)pos * inv;
        ((float*)(ws + WS_ROPE))[i] = cosf(a); ((float*)(ws + WS_ROPE))[1024 + i] = sinf(a); }
    if (gt < 2) { const int l = gt; const float* lp = p.in[I_DLAM] + l * 256; float s01 = 0.f, s23 = 0.f;
        for (int i = 0; i < 64; ++i) { s01 += lp[i] * lp[64 + i]; s23 += lp[128 + i] * lp[192 + i]; }
        const float lam_init = 0.8f - 0.6f * expf(-0.3f * (float)l);
        float* o = (float*)(ws + WS_LAM) + l * 4; o[0] = expf(s01) - expf(s23) + lam_init; o[1] = 1.0f - lam_init; }
    for (int i = gt; i < 2 * 16 * 1024; i += gn) {
        const int l = i >> 14, gc = (i >> 10) & 15, ch = i & 1023, part = ch >> 9, c = ch & 511, h = c >> 7, d = c & 127;
        const float* wif = p.in[I_WIF] + (size_t)l * 1536 * 16; const float* wq = p.in[I_WQKV] + (size_t)l * 3 * 4 * 16384;
        float s = 0.f;
        if (part == 0) { const float* a = wq + ((size_t)(0 * 4 + h) * 128 + d) * 128; const float* b = wq + ((size_t)(1 * 4 + h) * 128 + d) * 128;
            for (int e = 0; e < 128; ++e) s += a[e] * wif[(size_t)(h * 128 + e) * 16 + gc] + b[e] * wif[(size_t)(512 + h * 128 + e) * 16 + gc]; }
        else { const float* a = wq + ((size_t)(2 * 4 + h) * 128 + d) * 128;
            for (int e = 0; e < 128; ++e) s += a[e] * wif[(size_t)(1024 + h * 128 + e) * 16 + gc]; }
        ((float*)(ws + WS_WFOLD))[i] = s;
    }
    {
        LAS float* sc = (LAS float*)lds;
        LAS float* red = sc + 17 * 1024;
        bool loaded = false;
        for (int u = bid; u < 192; u += G) {
            if (!loaded) { for (int i = tid; i < 17 * 1024; i += NTHR) { const float v = i < 16384 ? p.in[I_C][i] : p.in[I_CCTX][i - 16384]; sc[i] = silu_f(v); } loaded = true; }
            __syncthreads();
            const int l = u / 96, cbk = u % 96, col = cbk * 64 + (tid & 63), kq = tid >> 6;
            float a[17];
#pragma unroll
            for (int b = 0; b < 17; ++b) a[b] = 0.f;
            const float* wp = p.in[I_WMOD] + (size_t)l * 1024 * 6144 + col;
            for (int k0 = kq * 128; k0 < kq * 128 + 128; k0 += 8) { float w[8];
#pragma unroll
                for (int j = 0; j < 8; ++j) w[j] = wp[(size_t)(k0 + j) * 6144];
#pragma unroll
                for (int j = 0; j < 8; ++j)
#pragma unroll
                    for (int b = 0; b < 17; ++b) a[b] += sc[b * 1024 + k0 + j] * w[j]; }
#pragma unroll
            for (int b = 0; b < 17; ++b) red[(kq * 17 + b) * 64 + (tid & 63)] = a[b];
            __syncthreads();
            for (int i = tid; i < 17 * 64; i += NTHR) { const int b = i >> 6, c = i & 63; float s2 = 0.f;
#pragma unroll
                for (int k = 0; k < 8; ++k) s2 += red[(k * 17 + b) * 64 + c];
                ((float*)(ws + WS_MOD))[((size_t)l * 17 + b) * 6144 + cbk * 64 + c] = s2 + p.in[I_BMOD][(size_t)l * 6144 + cbk * 64 + c]; }
            __syncthreads();
        }
    }
}

constexpr int CVT_TILES = 3072;
struct CvtT { const float* a; const float* b; unsigned char* dst; int ldsrc, K, k0, n0; };
__device__ __forceinline__ CvtT cvt_decode(const Params& p, int t) {
    const int l = t >= CVT_TILES ? 1 : 0, u = t - l * CVT_TILES; CvtT c;
    if (u < 2048) { const int e = u >> 6, q = u & 63; const size_t eo = ((size_t)l * 32 + e) * 1024 * 512;
        c.a = p.in[I_WEG] + eo; c.b = p.in[I_WEU] + eo; c.dst = p.ws + WS_WTGU + ((size_t)l * 32 + e) * 1024 * 1024; c.ldsrc = 512; c.K = 1024; c.k0 = (q >> 2) * 64; c.n0 = (q & 3) * 256; }
    else { const int v = u - 2048, e = v >> 5, q = v & 31;
        c.a = p.in[I_WED] + ((size_t)l * 32 + e) * 512 * 1024; c.b = nullptr; c.dst = p.ws + WS_WTD + ((size_t)l * 32 + e) * 1024 * 512; c.ldsrc = 1024; c.K = 512; c.k0 = (q >> 2) * 64; c.n0 = (q & 3) * 256; }
    return c;
}
__device__ __forceinline__ void cvt_load(const CvtT& c, float (&v)[32]) {
    const int tid = opaque_tid(), n = tid & 255, kb = tid >> 8, ng = c.n0 + n;
    const float* sp = (c.b ? ((ng & 128) ? c.b : c.a) + 128 * (ng >> 8) + (ng & 127) : c.a + ng) + (size_t)(c.k0 + kb) * c.ldsrc;
#pragma unroll
    for (int i = 0; i < 32; ++i) v[i] = sp[(size_t)(2 * i) * c.ldsrc];
}
__device__ __forceinline__ void cvt_finish(const CvtT& c, const float (&v)[32], LAS float* tile) {
    const int tid = opaque_tid();
    { const int n = tid & 255, kb = tid >> 8;
#pragma unroll
      for (int i = 0; i < 32; ++i) tile[(kb + 2 * i) * 257 + n] = v[i] * WSCALE8; }
    __syncthreads();
    { const int n = tid >> 1, kh = (tid & 1) * 32; unsigned char* dp = c.dst + (size_t)(c.n0 + n) * c.K + c.k0 + kh;
#pragma unroll
      for (int i = 0; i < 2; ++i) { float f[16];
#pragma unroll
          for (int j = 0; j < 16; ++j) f[j] = tile[(kh + 16 * i + j) * 257 + n];
          u32x4 w; w.x = pk4_fp8(f[0], f[1], f[2], f[3]); w.y = pk4_fp8(f[4], f[5], f[6], f[7]); w.z = pk4_fp8(f[8], f[9], f[10], f[11]); w.w = pk4_fp8(f[12], f[13], f[14], f[15]);
          *(u32x4*)(dp + 16 * i) = w; } }
}
__device__ __forceinline__ void cvt_fill(const Params& p, LAS unsigned char* lds, int t0, int t1, int r, int nr) {
    LAS float* tA = (LAS float*)lds; LAS float* tB = tA + 64 * 257 + 64;
    asm volatile("" : "+s"(r));
    float va[32], vb[32]; int t = t0 + r;
    if (t < t1) cvt_load(cvt_decode(p, t), va);
    for (; t < t1; t += 2 * nr) {
        if (t + nr < t1) cvt_load(cvt_decode(p, t + nr), vb);
        cvt_finish(cvt_decode(p, t), va, tA);
        if (t + 2 * nr < t1) cvt_load(cvt_decode(p, t + 2 * nr), va);
        if (t + nr < t1) cvt_finish(cvt_decode(p, t + nr), vb, tB);
    }
    __syncthreads();
}
constexpr int CVT_Q0 = 0, CVT_Q1 = 2240, CVT_Q2 = 2240, CVT_Q3 = 4480, CVT_Q4 = 5600;

__device__ __forceinline__ void ld_row_f32(const float* src, int lane, float (&v)[16]) {
    const f32x4 a = *(const f32x4*)(src + 8 * lane), b = *(const f32x4*)(src + 8 * lane + 4), c = *(const f32x4*)(src + 512 + 8 * lane), d = *(const f32x4*)(src + 512 + 8 * lane + 4);
#pragma unroll
    for (int j = 0; j < 4; ++j) { v[j] = a[j]; v[4 + j] = b[j]; v[8 + j] = c[j]; v[12 + j] = d[j]; }
}
__device__ __forceinline__ void st_row_f32(float* dst, int lane, const float (&v)[16]) {
    *(f32x4*)(dst + 8 * lane) = (f32x4){v[0], v[1], v[2], v[3]}; *(f32x4*)(dst + 8 * lane + 4) = (f32x4){v[4], v[5], v[6], v[7]};
    *(f32x4*)(dst + 512 + 8 * lane) = (f32x4){v[8], v[9], v[10], v[11]}; *(f32x4*)(dst + 512 + 8 * lane + 4) = (f32x4){v[12], v[13], v[14], v[15]};
}
__device__ __forceinline__ void ld_row_bf16(const bf16_t* src, int lane, float (&v)[16]) {
    const u32x4 a = *(const u32x4*)(src + 8 * lane), b = *(const u32x4*)(src + 512 + 8 * lane);
    v[0] = bf_lo(a.x); v[1] = bf_hi(a.x); v[2] = bf_lo(a.y); v[3] = bf_hi(a.y); v[4] = bf_lo(a.z); v[5] = bf_hi(a.z); v[6] = bf_lo(a.w); v[7] = bf_hi(a.w);
    v[8] = bf_lo(b.x); v[9] = bf_hi(b.x); v[10] = bf_lo(b.y); v[11] = bf_hi(b.y); v[12] = bf_lo(b.z); v[13] = bf_hi(b.z); v[14] = bf_lo(b.w); v[15] = bf_hi(b.w);
}
__device__ __forceinline__ void st_row_bf16(bf16_t* dst, int lane, const float (&v)[16]) {
    u32x4 a, b; a.x = cvtpk(v[0], v[1]); a.y = cvtpk(v[2], v[3]); a.z = cvtpk(v[4], v[5]); a.w = cvtpk(v[6], v[7]);
    b.x = cvtpk(v[8], v[9]); b.y = cvtpk(v[10], v[11]); b.z = cvtpk(v[12], v[13]); b.w = cvtpk(v[14], v[15]);
    *(u32x4*)(dst + 8 * lane) = a; *(u32x4*)(dst + 512 + 8 * lane) = b;
}
template <int MODE>
__device__ __forceinline__ void load_resid4(const Params& p, int R0, const RowInfo& q, int lmoe, int lane, float (&v)[4][16]) {
    const float* src; float* dst;
    if (q.isctx) { const size_t o = ((size_t)q.b * 256 + q.t) * 1024; src = (MODE == 0 ? p.in[I_CTX] : (const float*)(p.ws + WS_XC)) + o; dst = (float*)(p.ws + WS_XC) + o; }
    else { const size_t o = ((size_t)q.b * 2048 + q.t) * 1024; src = (MODE == 0 ? p.in[I_X] : (const float*)p.out) + o; dst = p.out + o; }
#pragma unroll
    for (int i = 0; i < 4; ++i) ld_row_f32(src + (size_t)i * 1024, lane, v[i]);
    if (MODE == 1 || MODE == 3) {
        const int* slot = (const int*)(p.ws + WS_POS) + 2 * (size_t)R0; const float* wk = (const float*)(p.ws + WS_WTK) + 2 * (size_t)R0;
        const bf16_t* ys = (const bf16_t*)(p.ws + WS_P + P_YS);
        int sl[8]; float ww[8];
#pragma unroll
        for (int i = 0; i < 8; ++i) { sl[i] = ld_i32_dev(slot + i); ww[i] = ld_f32_dev(wk + i); }
        float m5[16]; ld_row_f32((const float*)(p.ws + WS_MOD) + ((size_t)lmoe * 17 + (q.isctx ? 16 : q.b)) * 6144 + 5 * 1024, lane, m5);
        u32x4 ya[4][2], yb[4][2];
#pragma unroll
        for (int i = 0; i < 4; ++i) { const bf16_t* r1 = ys + (size_t)sl[2 * i] * 1024; const bf16_t* r2 = ys + (size_t)sl[2 * i + 1] * 1024;
            ya[i][0] = *(const u32x4*)(r1 + 8 * lane); ya[i][1] = *(const u32x4*)(r1 + 512 + 8 * lane); yb[i][0] = *(const u32x4*)(r2 + 8 * lane); yb[i][1] = *(const u32x4*)(r2 + 512 + 8 * lane); }
#pragma unroll
        for (int i = 0; i < 4; ++i) { float y1[8], y2[8];
#pragma unroll
            for (int hh = 0; hh < 2; ++hh) { unpack8(ya[i][hh], y1); unpack8(yb[i][hh], y2);
#pragma unroll
                for (int j = 0; j < 8; ++j) v[i][8 * hh + j] += m5[8 * hh + j] * (ww[2 * i] * y1[j] + ww[2 * i + 1] * y2[j]); }
            if (MODE == 1) st_row_f32(dst + (size_t)i * 1024, lane, v[i]); }
    }
}
struct RowPar { float g[16], sh[16], sc[16]; };
__device__ __forceinline__ void load_rowpar(const Params& p, int l, int which, const RowInfo& q, int lane, RowPar& rp) {
    const float* mrow = (const float*)(p.ws + WS_MOD) + ((size_t)l * 17 + (q.isctx ? 16 : q.b)) * 6144;
    ld_row_f32(p.in[which ? I_GN2 : I_GN1] + (size_t)l * 1024, lane, rp.g);
    ld_row_f32(mrow + (which ? 3 : 0) * 1024, lane, rp.sh); ld_row_f32(mrow + (which ? 4 : 1) * 1024, lane, rp.sc);
}
__device__ __forceinline__ void norm_mod_row(const RowPar& rp, int lane, const float (&v)[16], bf16_t* hrow, unsigned char* h8row = nullptr) {
    float ss = 0.f;
#pragma unroll
    for (int j = 0; j < 16; ++j) ss += v[j] * v[j];
    ss = wave_sum(ss); const float rs = rsqrtf(ss * (1.0f / 1024.0f) + EPS);
    float o[16];
#pragma unroll
    for (int j = 0; j < 16; ++j) o[j] = v[j] * rs * rp.g[j] * (1.0f + rp.sc[j]) + rp.sh[j];
    st_row_bf16(hrow, lane, o);
    if (h8row) { u32x2 a, b; a.x = pk4_fp8(o[0] * HSCALE8, o[1] * HSCALE8, o[2] * HSCALE8, o[3] * HSCALE8); a.y = pk4_fp8(o[4] * HSCALE8, o[5] * HSCALE8, o[6] * HSCALE8, o[7] * HSCALE8);
        b.x = pk4_fp8(o[8] * HSCALE8, o[9] * HSCALE8, o[10] * HSCALE8, o[11] * HSCALE8); b.y = pk4_fp8(o[12] * HSCALE8, o[13] * HSCALE8, o[14] * HSCALE8, o[15] * HSCALE8);
        *(u32x2*)(h8row + 8 * lane) = a; *(u32x2*)(h8row + 512 + 8 * lane) = b; }
}
__device__ __forceinline__ void phase_norm1(const Params& p, int l) {
    const int tid = opaque_tid(), wid = __builtin_amdgcn_readfirstlane(tid >> 6), lane = tid & 63;
    for (int gq = blockIdx.x * 8 + wid; gq < MTOT / 4; gq += gridDim.x * 8) {
        const int R0 = 4 * gq; const RowInfo q = row_info(R0); float v[4][16]; RowPar rp;
        load_rowpar(p, l, 0, q, lane, rp);
        if (l == 0) load_resid4<0>(p, R0, q, 0, lane, v); else load_resid4<1>(p, R0, q, l - 1, lane, v);
#pragma unroll
        for (int i = 0; i < 4; ++i) norm_mod_row(rp, lane, v[i], (bf16_t*)(p.ws + WS_H) + (size_t)(R0 + i) * 1024, p.ws + WS_H8 + (size_t)(R0 + i) * 1024);
    }
}
__device__ __forceinline__ void phase_final(const Params& p) {
    const int tid = opaque_tid(), wid = __builtin_amdgcn_readfirstlane(tid >> 6), lane = tid & 63;
    float g[16]; ld_row_f32(p.in[I_GFIN], lane, g);
    for (int gq = blockIdx.x * 8 + wid; gq < NBATCH * SEQ / 4; gq += gridDim.x * 8) {
        const int a = 4 * gq, R0 = (a >> 14) * MH + CTXROWS + (a & 16383);
        const RowInfo q = row_info(R0); float v[4][16];
        load_resid4<3>(p, R0, q, 1, lane, v);
#pragma unroll
        for (int i = 0; i < 4; ++i) { float ss = 0.f;
#pragma unroll
            for (int j = 0; j < 16; ++j) ss += v[i][j] * v[i][j];
            ss = wave_sum(ss); const float rs = rsqrtf(ss * (1.0f / 1024.0f) + EPS);
#pragma unroll
            for (int j = 0; j < 16; ++j) v[i][j] = v[i][j] * rs * g[j];
            st_row_f32(p.out + ((size_t)q.b * 2048 + q.t + i) * 1024, lane, v[i]); }
    }
}
__device__ __forceinline__ int active_row(int l, int a) { return l == 0 ? a : (a >> 14) * MH + CTXROWS + (a & 16383); }
typedef float f32x4v __attribute__((ext_vector_type(4)));
__device__ __forceinline__ void phase_norm2_router(const Params& p, int l, LAS unsigned char* lds) {
    const int tid = opaque_tid(), wid = tid >> 6, lane = tid & 63, G = gridDim.x, bid = blockIdx.x;
    const int NA = l == 0 ? MTOT : NBATCH * SEQ;
    const int chunk = (((NA + G - 1) / G) + 15) & ~15;
    const int a0 = bid * chunk, a1 = (a0 + chunk < NA) ? a0 + chunk : NA, na = a1 > a0 ? a1 - a0 : 0;
    LAS float* lg = (LAS float*)lds;
    LAS float* lgs = (LAS float*)(lds + 73728);
    LAS int* re = (LAS int*)(lds + 83968);
    LAS float* rw = (LAS float*)(lds + 83968 + 2048);
    LAS int* rr = (LAS int*)(lds + 83968 + 4096);
    LAS int* hist = (LAS int*)(lds + 83968 + 6144);
    LAS int* base = hist + 32;
    if (tid < 32) hist[tid] = 0;
    bf16_t* H = (bf16_t*)(p.ws + WS_H);
    PSEC_BEGINN(11);
    for (int g = wid; g * 16 < na; g += 8)
        for (int i = 0; i < 16; i += 4) { const int a = a0 + g * 16 + i; if (a >= a1) break;
            const int R0 = active_row(l, a); const RowInfo q = row_info(R0); float v[4][16]; RowPar rp;
            load_rowpar(p, l, 1, q, lane, rp);
            load_resid4<2>(p, R0, q, 0, lane, v);
#pragma unroll
            for (int k = 0; k < 4; ++k) norm_mod_row(rp, lane, v[k], H + (size_t)(R0 + k) * 1024, p.ws + WS_H8 + (size_t)(R0 + k) * 1024); }
    asm volatile("s_waitcnt vmcnt(0)" ::: "memory"); __syncthreads();
    PSEC(11);
    const bf16_t* Wr = (const bf16_t*)(p.ws + WS_WRT) + (size_t)l * 2 * 48 * 1024;
    const float* brg = p.in[I_BRG] + l * 4; const float* bre = p.in[I_BRE] + l * 32;
    const int ng = (na + 15) >> 4, r16 = lane & 15, kq = lane >> 4;
    LAS float* brl = (LAS float*)(lds + 83968 + 6144 + 512);
    if (tid < 36) brl[tid] = tid < 4 ? brg[tid] : bre[tid - 4];
    if (ng > 0) {
        bf16x8 bh[4][3], bl[4][3];
        { const bf16_t* bp = Wr + (size_t)r16 * 1024 + 128 * wid + 8 * kq;
#pragma unroll
          for (int ks = 0; ks < 4; ++ks)
#pragma unroll
              for (int ct = 0; ct < 3; ++ct) { bh[ks][ct] = *(const bf16x8*)(bp + (size_t)ct * 16 * 1024 + ks * 32); bl[ks][ct] = *(const bf16x8*)(bp + (size_t)(48 + ct * 16) * 1024 + ks * 32); } }
        __builtin_amdgcn_sched_barrier(0);
#pragma unroll 1
        for (int g0 = 0; g0 < ng; g0 += 3) {
            bf16x8 a[3][4];
#pragma unroll
            for (int gq = 0; gq < 3; ++gq) { int ar = a0 + (g0 + gq) * 16 + r16; if (ar >= a1) ar = a1 - 1;
                const bf16_t* ap = H + (size_t)active_row(l, ar) * 1024 + 128 * wid + 8 * kq;
#pragma unroll
                for (int ks = 0; ks < 4; ++ks) a[gq][ks] = *(const bf16x8*)(ap + ks * 32); }
            __builtin_amdgcn_sched_barrier(0);
#pragma unroll
            for (int gq = 0; gq < 3; ++gq) {
                f32x4v acc[3] = {{0.f, 0.f, 0.f, 0.f}, {0.f, 0.f, 0.f, 0.f}, {0.f, 0.f, 0.f, 0.f}};
#pragma unroll
                for (int ks = 0; ks < 4; ++ks)
#pragma unroll
                    for (int ct = 0; ct < 3; ++ct) { acc[ct] = __builtin_amdgcn_mfma_f32_16x16x32_bf16(a[gq][ks], bh[ks][ct], acc[ct], 0, 0, 0); acc[ct] = __builtin_amdgcn_mfma_f32_16x16x32_bf16(a[gq][ks], bl[ks][ct], acc[ct], 0, 0, 0); }
#pragma unroll
                for (int ct = 0; ct < 3; ++ct)
#pragma unroll
                    for (int r = 0; r < 4; ++r) lg[((gq * 8 + wid) * 16 + 4 * kq + r) * 48 + ct * 16 + r16] = acc[ct][r];
            }
            __syncthreads();
            for (int o = tid; o < 3 * 768; o += NTHR) { const int gq = o >= 1536 ? 2 : (o >= 768 ? 1 : 0), rem = o - gq * 768; float s = 0.f;
#pragma unroll
                for (int w = 0; w < 8; ++w) s += lg[(gq * 8 + w) * 768 + rem];
                lgs[o] = s; }
            __syncthreads();
            if (tid < 48) {
                const int a = a0 + (g0 + (tid >> 4)) * 16 + (tid & 15);
                if (g0 + (tid >> 4) < ng && a < a1) {
                    const LAS float* x = lgs + tid * 48;
                    float gl[4]; int gs = 0; float gmax;
#pragma unroll
                    for (int j = 0; j < 4; ++j) gl[j] = x[j] + brl[j];
                    gmax = gl[0];
#pragma unroll
                    for (int j = 1; j < 4; ++j) if (gl[j] > gmax) { gmax = gl[j]; gs = j; }
                    float gsum = 0.f;
#pragma unroll
                    for (int j = 0; j < 4; ++j) gsum += __expf(gl[j] - gmax);
                    const float pg = 1.0f / gsum;
                    float v1 = -3.0e38f, v2 = -3.0e38f; int i1 = 0, i2 = 0;
                    for (int j = 0; j < 8; ++j) { const float ev = x[4 + gs * 8 + j] + brl[4 + gs * 8 + j];
                        if (ev > v1) { v2 = v1; i2 = i1; v1 = ev; i1 = j; } else if (ev > v2) { v2 = ev; i2 = j; } }
                    const float t = __expf(v2 - v1); const float w1 = pg / (1.0f + t), w2 = pg * t / (1.0f + t);
                    const int e1 = gs * 8 + i1, e2 = gs * 8 + i2, i = a - a0;
                    re[i] = e1; re[256 + i] = e2; rw[i] = w1; rw[256 + i] = w2;
                }
            }
            __syncthreads();
        }
    }
    __syncthreads();
    PSEC(12);
    if (tid < 32) { int c = 0; for (int i = 0; i < na; ++i) { if (re[i] == tid) rr[i] = c++; if (re[256 + i] == tid) rr[256 + i] = c++; } hist[tid] = c; }
    __syncthreads();
    int* hg = (int*)(p.ws + WS_CTL) + CW_HIST + (l * 256 + bid) * 32;
    if (tid < 32) hg[tid] = hist[tid];
    (void)base;
    int* EID = (int*)(p.ws + WS_EID); float* WTK = (float*)(p.ws + WS_WTK); int* POS = (int*)(p.ws + WS_POS);
    for (int i = tid; i < na; i += NTHR) { const size_t R = (size_t)active_row(l, a0 + i);
        EID[2 * R] = re[i]; EID[2 * R + 1] = re[256 + i]; WTK[2 * R] = rw[i]; WTK[2 * R + 1] = rw[256 + i];
        POS[2 * R] = rr[i]; POS[2 * R + 1] = rr[256 + i]; }
    __syncthreads();
    PSEC(13);
}
__device__ __forceinline__ void moe_segments(const Params& p, int l, LAS int* seg, int myblk) {
    const int tid = opaque_tid(); LAS int* cnt = seg + 40; LAS int* pre = seg + 80; LAS int* part = seg + 4096;
    { const int e = tid & 31, pt = tid >> 5, nb = (int)gridDim.x, per = (nb + 15) >> 4;
      const int* hg = (const int*)(p.ws + WS_CTL) + CW_HIST + l * 256 * 32 + e; int tot = 0, pr = 0;
      for (int b = pt * per; b < (pt + 1) * per && b < nb; ++b) { const int c = hg[b * 32]; if (b < myblk) pr += c; tot += c; }
      part[(pt * 2) * 32 + e] = tot; part[(pt * 2 + 1) * 32 + e] = pr; }
    __syncthreads();
    if (tid < 32) { int tot = 0, pr = 0;
#pragma unroll
        for (int pt = 0; pt < 16; ++pt) { tot += part[(pt * 2) * 32 + tid]; pr += part[(pt * 2 + 1) * 32 + tid]; }
        cnt[tid] = tot; pre[tid] = pr; }
    __syncthreads();
    if (tid == 0) { int s = 0; for (int e = 0; e < 32; ++e) { seg[e] = s; s += (cnt[e] + 255) & ~255; } if (s > SLOTS) s = SLOTS; seg[32] = s; }
    __syncthreads();
}
__device__ __forceinline__ void phase_dispatch(const Params& p, int l, LAS unsigned char* lds) {
    const int tid = opaque_tid(), G = gridDim.x, bid = blockIdx.x;
    LAS int* seg = (LAS int*)lds; moe_segments(p, l, seg, bid); const LAS int* cnt = seg + 40; const LAS int* pre = seg + 80;
    const int NA = l == 0 ? MTOT : NBATCH * SEQ;
    const int chunk = (((NA + G - 1) / G) + 15) & ~15;
    const int a0 = bid * chunk, a1 = (a0 + chunk < NA) ? a0 + chunk : NA;
    const int* EID = (const int*)(p.ws + WS_EID); const float* WTK = (const float*)(p.ws + WS_WTK); int* POS = (int*)(p.ws + WS_POS); float* WTS = (float*)(p.ws + WS_WTS); int* SRC = (int*)(p.ws + WS_SRC);
    for (int i = tid; i < 2 * (a1 - a0); i += NTHR) {
        const int R = active_row(l, a0 + (i >> 1)); const size_t x = 2 * (size_t)R + (i & 1);
        const int e = EID[x], ps = POS[x]; const float w = WTK[x];
        const int s = seg[e] + pre[e] + ps;
        SRC[s] = R; POS[x] = s; WTS[s] = w; }
    for (int e = bid; e < 32; e += G)
        for (int s = seg[e] + cnt[e] + tid; s < seg[e + 1]; s += NTHR) SRC[s] = 0;
    __syncthreads();
}
__device__ __forceinline__ int moe_tile_table(const Params& p, int l, LAS int* seg, LAS int* tile_e) {
    moe_segments(p, l, seg, 0);
    const int nt = seg[32] >> 8;
    for (int i = opaque_tid(); i < nt; i += NTHR) { int e = 0; for (int k = 1; k < 32; ++k) if ((i << 8) >= seg[k]) e = k; tile_e[i] = e; }
    __syncthreads();
    return __builtin_amdgcn_readfirstlane(nt);
}
__device__ __forceinline__ void lds_addf(LAS float* a, float v) { (void)__hip_atomic_fetch_add(a, v, __ATOMIC_RELAXED, __HIP_MEMORY_SCOPE_WORKGROUP); }
__device__ __forceinline__ bf16_t* pbuf(const Params& p, size_t off) { return (bf16_t*)(p.ws + WS_P + off); }
#ifndef MMU
#define MMU 2
#endif
__device__ __forceinline__ void mm128(const LAS bf16_t* A, const LAS bf16_t* Bt, f32x16 (&acc)[2], int wid, int lane) {
    const int r32 = lane & 31, hi = lane >> 5;
    const LAS bf16_t* ap = A + (32 * (wid >> 1) + r32) * TLD + hi * 8;
    const LAS bf16_t* bp = Bt + (64 * (wid & 1) + r32) * TLD + hi * 8;
#pragma unroll MMU
    for (int ks = 0; ks < 8; ++ks) {
        const bf16x8 a = *(const LAS bf16x8*)(ap + ks * 16), b0 = *(const LAS bf16x8*)(bp + ks * 16), b1 = *(const LAS bf16x8*)(bp + 32 * TLD + ks * 16);
        acc[0] = mfma32(a, b0, acc[0]); acc[1] = mfma32(a, b1, acc[1]);
    }
}
__device__ __forceinline__ void mm128_gB(const LAS bf16_t* A, const bf16_t* __restrict__ Bg, f32x16 (&acc)[2], int wid, int lane) {
    const int r32 = lane & 31, hi = lane >> 5;
    const LAS bf16_t* ap = A + (32 * (wid >> 1) + r32) * TLD + hi * 8;
    const bf16_t* bp = Bg + (64 * (wid & 1) + r32) * 128 + hi * 8;
#pragma unroll MMU
    for (int ks = 0; ks < 8; ++ks) {
        const bf16x8 a = *(const LAS bf16x8*)(ap + ks * 16), b0 = *(const bf16x8*)(bp + ks * 16), b1 = *(const bf16x8*)(bp + 32 * 128 + ks * 16);
        acc[0] = mfma32(a, b0, acc[0]); acc[1] = mfma32(a, b1, acc[1]);
    }
}
__device__ __forceinline__ void st_acc_T(LAS bf16_t* T, const f32x16 (&acc)[2], int wid, int lane) {
    const int r32 = lane & 31, hi = lane >> 5;
#pragma unroll
    for (int tl = 0; tl < 2; ++tl)
#pragma unroll
        for (int g = 0; g < 4; ++g) { u32x2 w; w.x = cvtpk(acc[tl][4 * g], acc[tl][4 * g + 1]); w.y = cvtpk(acc[tl][4 * g + 2], acc[tl][4 * g + 3]);
            *(LAS u32x2*)(T + (64 * (wid & 1) + 32 * tl + r32) * TLD + 32 * (wid >> 1) + 8 * g + 4 * hi) = w; }
}

__device__ __forceinline__ void st_acc_rm(LAS bf16_t* T, const f32x16 (&acc)[2], int wid, int lane) {
    const int r32 = lane & 31, hi = lane >> 5;
    LAS bf16_t* b = T + (32 * (wid >> 1) + 4 * hi) * TLD + 64 * (wid & 1) + r32;
#pragma unroll
    for (int tl = 0; tl < 2; ++tl)
#pragma unroll
        for (int r = 0; r < 16; ++r) b[((r & 3) + 8 * (r >> 2)) * TLD + 32 * tl] = (bf16_t)(cvtpk(acc[tl][r], acc[tl][r]) & 0xffffu);
}
constexpr int FLD = 132;
__device__ __forceinline__ void st_acc_f32(LAS float* F, const f32x16 (&acc)[2], int wid, int lane) {
    const int r32 = lane & 31, hi = lane >> 5;
    LAS float* b = F + (32 * (wid >> 1) + 4 * hi) * FLD + 64 * (wid & 1) + r32;
#pragma unroll
    for (int tl = 0; tl < 2; ++tl)
#pragma unroll
        for (int r = 0; r < 16; ++r) b[((r & 3) + 8 * (r >> 2)) * FLD + 32 * tl] = acc[tl][r];
}
__device__ __forceinline__ void copy_tile_out(const LAS bf16_t* T, bf16_t* dst, int ld) {
    const int tx = opaque_tid(), t = tx >> 2, c0 = (tx & 3) * 32;
#pragma unroll
    for (int i = 0; i < 4; ++i) *(u32x4*)(dst + (size_t)t * ld + c0 + 8 * i) = *(const LAS u32x4*)(T + t * TLD + c0 + 8 * i);
}

__device__ __forceinline__ bool seq_start(int r) { return r < CTXROWS ? (r & 255) == 0 : ((r - CTXROWS) & 2047) == 0; }
template <int CTRL> __device__ __forceinline__ u32x4 dpp4(const u32x4 v) { u32x4 o;
    o.x = (unsigned)__builtin_amdgcn_update_dpp(0, (int)v.x, CTRL, 0xf, 0xf, true); o.y = (unsigned)__builtin_amdgcn_update_dpp(0, (int)v.y, CTRL, 0xf, 0xf, true);
    o.z = (unsigned)__builtin_amdgcn_update_dpp(0, (int)v.z, CTRL, 0xf, 0xf, true); o.w = (unsigned)__builtin_amdgcn_update_dpp(0, (int)v.w, CTRL, 0xf, 0xf, true); return o; }
__device__ __forceinline__ void phase_conv(const Params& p, int l, LAS unsigned char* lds) {
    const int tid = opaque_tid(), wid = __builtin_amdgcn_readfirstlane(tid >> 6), lane = tid & 63, r16 = lane & 15, kg = lane >> 4, G = gridDim.x, bid = blockIdx.x;
    constexpr int NG = MH / 16, NU = 5;
    const bf16_t* XM = pbuf(p, P_XMB); bf16_t* XCV = pbuf(p, P_XCV); float* GT = (float*)(p.ws + WS_P + P_GATES);
    LAS float* PX = (LAS float*)lds;
    for (int g0 = bid; g0 < NG; g0 += NU * G) {
        f32x4v acc[NU];
#pragma unroll
        for (int u = 0; u < NU; ++u) acc[u] = (f32x4v){0.f, 0.f, 0.f, 0.f};
#pragma unroll 1
        for (int ks = 0; ks < 2; ++ks) {
            const int c = 64 * wid + 32 * ks + 8 * kg;
            u32x4 cur[NU], edge[NU];
#pragma unroll
            for (int u = 0; u < NU; ++u) { const int g = g0 + G * u; const bool valid = g < NG; const int row = 16 * g + r16;
                cur[u] = valid ? *(const u32x4*)(XM + (size_t)row * 512 + c) : (u32x4){0u, 0u, 0u, 0u};
                const bool he = valid && ((r16 == 0 && !seq_start(16 * g)) || (r16 == 15 && !seq_start(16 * g + 16)));
                const int er = r16 == 0 ? row - 1 : row + 1;
                edge[u] = he ? *(const u32x4*)(XM + (size_t)er * 512 + c) : (u32x4){0u, 0u, 0u, 0u}; }
            float w0[8], w1[8], w2[8], bc[8];
            { const float* wc = p.in[I_WCONV] + (size_t)l * 3 * 512 + c; const float* bcp = p.in[I_BCONV] + (size_t)l * 512 + c;
#pragma unroll
              for (int j = 0; j < 8; ++j) { w0[j] = wc[j]; w1[j] = wc[512 + j]; w2[j] = wc[1024 + j]; bc[j] = bcp[j]; } }
            bf16x8 wyh, wyl, wxh, wxl;
            { const float* wf = (const float*)(p.ws + WS_WFOLD) + ((size_t)l * 16 + r16) * 1024 + c; float a[8], b[8], t8[8];
#pragma unroll
              for (int j = 0; j < 8; ++j) { a[j] = wf[j]; b[j] = wf[512 + j]; }
              u32x4 hh = pack8(a); unpack8(hh, t8);
#pragma unroll
              for (int j = 0; j < 8; ++j) t8[j] = a[j] - t8[j];
              u32x4 ll = pack8(t8); wyh = *(const bf16x8*)&hh; wyl = *(const bf16x8*)&ll;
              hh = pack8(b); unpack8(hh, t8);
#pragma unroll
              for (int j = 0; j < 8; ++j) t8[j] = b[j] - t8[j];
              ll = pack8(t8); wxh = *(const bf16x8*)&hh; wxl = *(const bf16x8*)&ll; }
#pragma unroll
            for (int u = 0; u < NU; ++u) { const int g = g0 + G * u;
                const u32x4 sp = dpp4<0x111>(cur[u]), sn = dpp4<0x101>(cur[u]);
                u32x4 pw, nw;
                pw.x = r16 == 0 ? edge[u].x : sp.x; pw.y = r16 == 0 ? edge[u].y : sp.y; pw.z = r16 == 0 ? edge[u].z : sp.z; pw.w = r16 == 0 ? edge[u].w : sp.w;
                nw.x = r16 == 15 ? edge[u].x : sn.x; nw.y = r16 == 15 ? edge[u].y : sn.y; nw.z = r16 == 15 ? edge[u].z : sn.z; nw.w = r16 == 15 ? edge[u].w : sn.w;
                float xp[8], xc[8], xn[8], y[8], yl[8]; unpack8(pw, xp); unpack8(cur[u], xc); unpack8(nw, xn);
#pragma unroll
                for (int j = 0; j < 8; ++j) y[j] = silu_f(w0[j] * xp[j] + w1[j] * xc[j] + w2[j] * xn[j] + bc[j]);
                const u32x4 yh = pack8(y); unpack8(yh, yl);
#pragma unroll
                for (int j = 0; j < 8; ++j) yl[j] = y[j] - yl[j];
                const u32x4 ylw = pack8(yl);
                const bf16x8 ah = *(const bf16x8*)&yh, al = *(const bf16x8*)&ylw, ax = *(const bf16x8*)&cur[u];
                acc[u] = __builtin_amdgcn_mfma_f32_16x16x32_bf16(ah, wyh, acc[u], 0, 0, 0); acc[u] = __builtin_amdgcn_mfma_f32_16x16x32_bf16(ah, wyl, acc[u], 0, 0, 0);
                acc[u] = __builtin_amdgcn_mfma_f32_16x16x32_bf16(al, wyh, acc[u], 0, 0, 0);
                acc[u] = __builtin_amdgcn_mfma_f32_16x16x32_bf16(ax, wxh, acc[u], 0, 0, 0); acc[u] = __builtin_amdgcn_mfma_f32_16x16x32_bf16(ax, wxl, acc[u], 0, 0, 0);
                if (g < NG) *(u32x4*)(XCV + (size_t)(16 * g + r16) * 512 + c) = yh; }
        }
#pragma unroll
        for (int u = 0; u < NU; ++u)
#pragma unroll
            for (int r = 0; r < 4; ++r) PX[((u * 8 + wid) * 16 + 4 * kg + r) * 16 + r16] = acc[u][r];
        __syncthreads();
        for (int o = tid; o < NU * 256; o += NTHR) { const int u = o >> 8, row = (o >> 4) & 15, n = o & 15, g = g0 + G * u; float s = p.in[I_BIF][l * 16 + n];
#pragma unroll
            for (int w = 0; w < 8; ++w) s += PX[((u * 8 + w) * 16 + row) * 16 + n];
            if (g < NG) GT[(size_t)(16 * g + row) * 16 + (n & 3) * 4 + (n >> 2)] = s; }
        __syncthreads();
    }
}
__device__ __forceinline__ void ld8row(const bf16_t* base, int pos, int seqlen, float (&o)[8]) {
    if (pos < 0 || pos >= seqlen) {
#pragma unroll
        for (int j = 0; j < 8; ++j) o[j] = 0.f; }
    else unpack8(*(const u32x4*)(base + (size_t)pos * 512), o);
}
__device__ __forceinline__ void mlstm_a_ids(int u, int& bl, int& J, int& h, int& r0) {
    bl = u / (NJ * 4); const int rem = u - bl * (NJ * 4); J = rem >> 2; h = rem & 3;
    r0 = (J < 2 ? bl * 256 : CTXROWS + bl * 2048) + (J < 2 ? J * 128 : (J - 2) * 128);
}
#define APRE_PARAMS u32x4 (&qa)[4], u32x4 (&qb)[4], u32x4 (&qwq)[4], u32x4 (&qwk)[4], u32x4 (&qwv)[4], f32x4& qg
#define APRE_ARGS qa, qb, qwq, qwk, qwv, qg
__device__ __forceinline__ void mlstm_a_load(const Params& p, int l, int u, APRE_PARAMS) {
    const int tid = opaque_tid(); int bl, J, h, r0; mlstm_a_ids(u, bl, J, h, r0);
    const int t = tid >> 2, cc = (tid & 3) * 32; const size_t o = (size_t)(r0 + t) * 512 + h * 128 + cc;
    const bf16_t* XM = pbuf(p, P_XMB) + o; const bf16_t* XCV = pbuf(p, P_XCV) + o;
    const bf16_t* Wq = (const bf16_t*)(p.ws + WS_WTQKV) + ((size_t)(l * 3) * 4 + h) * 16384 + t * 128 + cc;
#pragma unroll
    for (int i = 0; i < 4; ++i) { qa[i] = *(const u32x4*)(XCV + 8 * i); qb[i] = *(const u32x4*)(XM + 8 * i);
        qwq[i] = *(const u32x4*)(Wq + 8 * i); qwk[i] = *(const u32x4*)(Wq + (size_t)4 * 16384 + 8 * i); qwv[i] = *(const u32x4*)(Wq + (size_t)8 * 16384 + 8 * i); }
    qg = *(const f32x4*)((const float*)(p.ws + WS_P + P_GATES) + (size_t)(r0 + (tid & 127)) * 16 + h * 4);
}
__device__ __forceinline__ void mlstm_a_unit(const Params& p, int l, int u, int unext, int n_a, APRE_PARAMS, LAS unsigned char* lds) {
    int tid_ = threadIdx.x; asm volatile("" : "+v"(tid_));
    const int tid = tid_, wid = __builtin_amdgcn_readfirstlane(tid >> 6), lane = tid & 63, r32 = lane & 31, hi = lane >> 5;
    LAS bf16_t* T0 = (LAS bf16_t*)lds; LAS bf16_t* T1 = (LAS bf16_t*)(lds + TILE_B); LAS bf16_t* T2 = (LAS bf16_t*)(lds + 2 * TILE_B); LAS bf16_t* T3 = (LAS bf16_t*)(lds + 3 * TILE_B);
    LAS float* gl = (LAS float*)(lds + 4 * TILE_B);
    LAS float* wend = gl + 512;
    int bl, J, h, r0; mlstm_a_ids(u, bl, J, h, r0);
    const int wr_ = tid >> 2, wc_ = (tid & 3) * 32;
    u32x4 wv_[4];
#pragma unroll
    for (int i = 0; i < 4; ++i) { *(LAS u32x4*)(T0 + wr_ * TLD + wc_ + 8 * i) = qa[i]; *(LAS u32x4*)(T1 + wr_ * TLD + wc_ + 8 * i) = qb[i];
        *(LAS u32x4*)(T2 + wr_ * TLD + wc_ + 8 * i) = qwq[i]; *(LAS u32x4*)(T3 + wr_ * TLD + wc_ + 8 * i) = qwk[i]; wv_[i] = qwv[i]; }
    if (tid < 128) *(LAS f32x4*)(gl + tid * 4) = qg;
    LBAR();
    if (wid < 2) {
        const int dir = wid, p0 = 2 * lane, p1 = p0 + 1, s0 = dir ? 127 - p0 : p0, s1 = dir ? 127 - p1 : p1;
        const float ig0 = gl[s0 * 4 + 2 * dir], ig1 = gl[s1 * 4 + 2 * dir];
        const float lf0 = logsigmoid_f(gl[s0 * 4 + 2 * dir + 1]), lf1 = logsigmoid_f(gl[s1 * 4 + 2 * dir + 1]);
        float incl = lf0 + lf1;
        for (int o = 1; o < 64; o <<= 1) { const float t = __shfl_up(incl, o); if (lane >= o) incl += t; }
        const float bc1 = incl, bc0 = incl - lf1, gg = __shfl(incl, 63);
        const float ae0 = gg - bc0 + ig0, ae1 = gg - bc1 + ig1; const float ml = wave_max(fmaxf(ae0, ae1));
        wend[dir * 128 + s0] = __expf(ae0 - ml); wend[dir * 128 + s1] = __expf(ae1 - ml);
        if (lane == 0) { float* mst = (float*)(p.ws + WS_P + P_MST) + ((size_t)(((bl * 4 + h) * 2 + dir) * NJ + J)) * 4; mst[0] = ml; mst[1] = gg; }
    }
    f32x16 ack[2] = {};
    {
        f32x16 acq[2] = {}, akp[2] = {};
        mm128(T2, T0, acq, wid, lane); mm128(T0, T3, ack, wid, lane); mm128(T3, T0, akp, wid, lane);
        LBAR();
        st_acc_T(T2, acq, wid, lane); st_acc_T(T3, akp, wid, lane);
#pragma unroll
        for (int i = 0; i < 4; ++i) *(LAS u32x4*)(T0 + wr_ * TLD + wc_ + 8 * i) = wv_[i];
    }
    LBAR();
    copy_tile_out(T2, pbuf(p, P_MQ) + (size_t)r0 * 512 + h * 128, 512);
    copy_tile_out(T3, pbuf(p, P_MK) + (size_t)r0 * 512 + h * 128, 512);
    {
        f32x16 acv[2] = {}; mm128(T1, T0, acv, wid, lane);
        LBAR();
        st_acc_T(T2, ack, wid, lane); st_acc_T(T3, acv, wid, lane);
    }
    mlstm_a_load(p, l, unext < n_a ? unext : u, APRE_ARGS);
    LBAR();
    {
        bf16_t* MVT = pbuf(p, P_MVT) + ((size_t)((bl * NJ + J) * 4 + h)) * 16384; const int d = tid >> 2, s0 = (tid & 3) * 32;
#pragma unroll
        for (int i = 0; i < 4; ++i) *(u32x4*)(MVT + d * 128 + s0 + 8 * i) = *(const LAS u32x4*)(T3 + d * TLD + s0 + 8 * i);
    }
#pragma unroll 1
    for (int dir = 0; dir < 2; ++dir) {
        const int combo = (bl * 4 + h) * 2 + dir;
        f32x16 acc[2] = {};
        const LAS bf16_t* ap = T3 + (32 * (wid >> 1) + r32) * TLD + hi * 8; const LAS bf16_t* bp = T2 + (64 * (wid & 1) + r32) * TLD + hi * 8;
        const LAS float* wv = wend + dir * 128 + hi * 8;
#pragma unroll
        for (int ks = 0; ks < 8; ++ks) {
            float a8[8]; unpack8(*(const LAS u32x4*)(ap + ks * 16), a8);
            const f32x4 wa = *(const LAS f32x4*)(wv + ks * 16), wb = *(const LAS f32x4*)(wv + ks * 16 + 4);
#pragma unroll
            for (int j = 0; j < 4; ++j) { a8[j] *= wa[j]; a8[4 + j] *= wb[j]; }
            const u32x4 aw = pack8(a8); const bf16x8 a = *(const bf16x8*)&aw;
            const bf16x8 b0 = *(const LAS bf16x8*)(bp + ks * 16), b1 = *(const LAS bf16x8*)(bp + 32 * TLD + ks * 16);
            acc[0] = mfma32(a, b0, acc[0]); acc[1] = mfma32(a, b1, acc[1]);
        }
        bf16_t* CL = (bf16_t*)(p.ws + WS_P + P_CLOC) + ((size_t)combo * NJ + J) * 16384;
        LAS float* F = (LAS float*)lds;
        st_acc_f32(F, acc, wid, lane);
        LBAR();
        { const int d = tid >> 2, e0 = (tid & 3) * 32;
#pragma unroll
          for (int i = 0; i < 4; ++i) { const f32x4 a = *(const LAS f32x4*)(F + d * FLD + e0 + 8 * i), b = *(const LAS f32x4*)(F + d * FLD + e0 + 8 * i + 4);
              u32x4 w; w.x = cvtpk(a[0], a[1]); w.y = cvtpk(a[2], a[3]); w.z = cvtpk(b[0], b[1]); w.w = cvtpk(b[2], b[3]);
              *(u32x4*)(CL + d * 128 + e0 + 8 * i) = w; } }
        LBAR();
    }
    if (tid < 256) { const int dir = tid >> 7, e = tid & 127; float s = 0.f;
#pragma unroll 4
        for (int j = 0; j < 128; j += 8) { float k8[8]; unpack8(*(const LAS u32x4*)(T2 + e * TLD + j), k8);
            const f32x4 wa = *(const LAS f32x4*)(wend + dir * 128 + j), wb = *(const LAS f32x4*)(wend + dir * 128 + j + 4);
#pragma unroll
            for (int i = 0; i < 4; ++i) s += wa[i] * k8[i] + wb[i] * k8[4 + i]; }
        ((float*)(p.ws + WS_P + P_NLOC))[((size_t)(((bl * 4 + h) * 2 + dir) * NJ + J)) * 128 + e] = s; }
    LBAR();
}

__device__ __forceinline__ int scan_J(int dir, int pidx) { return dir == 0 ? pidx : (pidx == 0 ? 1 : (pidx == 1 ? 0 : 19 - pidx)); }
__device__ __forceinline__ void phase_scan(const Params& p) {
    const int NIT = 64 * 2048;
    bf16_t* CL = (bf16_t*)(p.ws + WS_P + P_CLOC); float* NL = (float*)(p.ws + WS_P + P_NLOC); float* MST = (float*)(p.ws + WS_P + P_MST);
    const int tid = opaque_tid();
    for (int w = blockIdx.x * NTHR + tid; w < NIT; w += gridDim.x * NTHR) {
        const int combo = w >> 11, q = w & 2047, dir = combo & 1; const bool hasn = q < 32;
        float m_st = 0.f; float st[8]; f32x4 s4 = {0.f, 0.f, 0.f, 0.f};
#pragma unroll
        for (int j = 0; j < 8; ++j) st[j] = 0.f;
        bf16_t* base = CL + (size_t)combo * NJ * 16384 + 8 * q; float* nbase = NL + (size_t)combo * NJ * 128 + 4 * (q & 31);
#pragma unroll 1
        for (int i = 0; i < NJ; ++i) {
            const int J = scan_J(dir, i); float* ms = MST + ((size_t)combo * NJ + J) * 4;
            const u32x4 vc = *(const u32x4*)(base + (size_t)J * 16384);
            f32x4 vn = {0.f, 0.f, 0.f, 0.f}; if (hasn) vn = *(const f32x4*)(nbase + (size_t)J * 128);
            const float ml = ms[0], gg = ms[1];
            const float m_new = fmaxf(gg + m_st, ml), a_old = __expf(gg + m_st - m_new), a_new = __expf(ml - m_new);
            *(u32x4*)(base + (size_t)J * 16384) = pack8(st);
            if (hasn) *(f32x4*)(nbase + (size_t)J * 128) = s4;
            if (q == 0) ms[2] = m_st;
            float c8[8]; unpack8(vc, c8);
#pragma unroll
            for (int j = 0; j < 8; ++j) st[j] = st[j] * a_old + c8[j] * a_new;
            s4 = s4 * a_old + vn * a_new; m_st = m_new;
        }
    }
}

__device__ __forceinline__ unsigned zap_nf(unsigned w) { if ((w & 0x7f80u) >= 0x4980u) w &= 0xffff0000u; if ((w & 0x7f800000u) >= 0x49800000u) w &= 0x0000ffffu; return w; }
template <int dir>
__device__ __forceinline__ void mlstm_c_dir(const unsigned (&Xp)[4][8], f32x16 (&acc)[2], const LAS bf16_t* Tq, const LAS bf16_t* Tc, const LAS bf16_t* Tv,
                                            const LAS float* av, const LAS float* Mv, const LAS float* wi, LAS float* denw, const LAS float* n0l, int wid, int lane) {
    const int r32 = lane & 31, hi = lane >> 5, tb = wid >> 1, t = 32 * tb + r32;
    acc[0] = f32x16{}; acc[1] = f32x16{};
    mm128(Tq, Tc, acc, wid, lane);
#pragma unroll
    for (int r = 0; r < 16; ++r) { const float w = wi[dir * 128 + 32 * tb + crow(r, hi)]; acc[0][r] *= w; acc[1][r] *= w; }
    float nq = 0.f;
#pragma unroll
    for (int i = 0; i < 8; ++i) { float q8[8]; unpack8(*(const LAS u32x4*)(Tq + t * TLD + 64 * hi + 8 * i), q8);
        const f32x4 na = *(const LAS f32x4*)(n0l + dir * 128 + 64 * hi + 8 * i), nb = *(const LAS f32x4*)(n0l + dir * 128 + 64 * hi + 8 * i + 4);
#pragma unroll
        for (int j = 0; j < 4; ++j) nq += na[j] * q8[j] + nb[j] * q8[4 + j]; }
    const float Mt = Mv[dir * 128 + t]; float den = 0.f;
    const LAS bf16_t* vp = Tv + (64 * (wid & 1) + r32) * TLD + 4 * hi;
#pragma unroll
    for (int sb = 0; sb < 4; ++sb) {
        float o[16];
#pragma unroll
        for (int r = 0; r < 16; ++r) { const int s = 32 * sb + crow(r, hi); const bool ok = dir ? (s >= t) : (s <= t);
            const float xs = (r & 1) ? bf_hi(Xp[sb][r >> 1]) : bf_lo(Xp[sb][r >> 1]);
            const float ev = xs * __builtin_amdgcn_exp2f((av[dir * 128 + s] - Mt) * LOG2E);
            o[r] = ok ? ev : 0.f; den += o[r]; }
#pragma unroll
        for (int s2 = 0; s2 < 2; ++s2) {
            u32x4 aw; aw.x = cvtpk(o[8 * s2 + 0], o[8 * s2 + 1]); aw.y = cvtpk(o[8 * s2 + 2], o[8 * s2 + 3]); aw.z = cvtpk(o[8 * s2 + 4], o[8 * s2 + 5]); aw.w = cvtpk(o[8 * s2 + 6], o[8 * s2 + 7]);
            const bf16x8 af = *(const bf16x8*)&aw;
#pragma unroll
            for (int tl = 0; tl < 2; ++tl) { const LAS bf16_t* bp = vp + 32 * tl * TLD + 32 * sb + 16 * s2;
                const u32x2 b0 = *(const LAS u32x2*)bp, b1 = *(const LAS u32x2*)(bp + 8); u32x4 bw; bw.x = b0.x; bw.y = b0.y; bw.z = b1.x; bw.w = b1.y;
                acc[tl] = mfma32(af, *(const bf16x8*)&bw, acc[tl]); }
        }
        __builtin_amdgcn_sched_barrier(0);
    }
    { auto rr = __builtin_amdgcn_permlane32_swap(__float_as_uint(den), __float_as_uint(den), false, false); den = __uint_as_float(rr[0]) + __uint_as_float(rr[1]); }
    { auto rr = __builtin_amdgcn_permlane32_swap(__float_as_uint(nq), __float_as_uint(nq), false, false); nq = __uint_as_float(rr[0]) + __uint_as_float(rr[1]); }
    if (hi == 0) denw[(wid * 2 + dir) * 32 + r32] = den + wi[dir * 128 + t] * nq;
}
__device__ __forceinline__ void mlstm_c_unit(const Params& p, int l, int bl, int J, int h, LAS unsigned char* lds) {
    int tid_ = threadIdx.x; asm volatile("" : "+v"(tid_));
    const int tid = tid_, wid = __builtin_amdgcn_readfirstlane(tid >> 6), lane = tid & 63, r32 = lane & 31, hi = lane >> 5;
    LAS bf16_t* Tq = (LAS bf16_t*)lds; LAS bf16_t* Tk = (LAS bf16_t*)(lds + TILE_B); LAS bf16_t* Tv = (LAS bf16_t*)(lds + 2 * TILE_B); LAS bf16_t* Ts = (LAS bf16_t*)(lds + 3 * TILE_B);
    LAS float* sc = (LAS float*)(lds + 4 * TILE_B);
    LAS float* gl = sc;
    LAS float* av = sc + 512;
    LAS float* Mv = sc + 768;
    LAS float* wi = sc + 1024;
    LAS float* fl = sc + 1280;
    LAS float* ssq = sc + 1536;
    LAS float* denp = sc + 1664;
    LAS float* n0l = sc + 2944;
    const int rseq = J < 2 ? bl * 256 : CTXROWS + bl * 2048, r0 = rseq + (J < 2 ? J * 128 : (J - 2) * 128);
    u32x4 cf_[4], cbp_[4];
    { const int d_ = tid >> 2, e_ = (tid & 3) * 32; const bf16_t* c0f = (const bf16_t*)(p.ws + WS_P + P_CLOC) + ((size_t)((bl * 4 + h) * 2) * NJ + J) * 16384 + d_ * 128 + e_;
#pragma unroll
      for (int i = 0; i < 4; ++i) { cf_[i] = *(const u32x4*)(c0f + 8 * i); cbp_[i] = *(const u32x4*)(c0f + (size_t)NJ * 16384 + 8 * i); } }
    {
        const int t = tid >> 2, c0 = (tid & 3) * 32;
        const bf16_t* q = pbuf(p, P_MQ) + (size_t)(r0 + t) * 512 + h * 128 + c0; const bf16_t* k = pbuf(p, P_MK) + (size_t)(r0 + t) * 512 + h * 128 + c0;
        const bf16_t* v = pbuf(p, P_MVT) + ((size_t)((bl * NJ + J) * 4 + h)) * 16384 + t * 128 + c0;
#pragma unroll
        for (int i = 0; i < 4; ++i) { *(LAS u32x4*)(Tq + t * TLD + c0 + 8 * i) = *(const u32x4*)(q + 8 * i); *(LAS u32x4*)(Tk + t * TLD + c0 + 8 * i) = *(const u32x4*)(k + 8 * i);
            *(LAS u32x4*)(Tv + t * TLD + c0 + 8 * i) = *(const u32x4*)(v + 8 * i); }
        if (tid < 128) { *(LAS f32x4*)(gl + tid * 4) = *(const f32x4*)((const float*)(p.ws + WS_P + P_GATES) + (size_t)(r0 + tid) * 16 + h * 4); ssq[tid] = 0.f; }
        if (tid < 256) n0l[tid] = ((const float*)(p.ws + WS_P + P_NLOC))[((size_t)(((bl * 4 + h) * 2 + (tid >> 7)) * NJ + J)) * 128 + (tid & 127)];
    }
    __syncthreads();
    { const int d_ = tid >> 2, e_ = (tid & 3) * 32;
#pragma unroll
      for (int i = 0; i < 4; ++i) *(LAS u32x4*)(Ts + d_ * TLD + e_ + 8 * i) = cf_[i]; }
    const float* MST = (const float*)(p.ws + WS_P + P_MST);
    if (wid < 2) {
        const int dir = wid, p0 = 2 * lane, p1 = p0 + 1, s0 = dir ? 127 - p0 : p0, s1 = dir ? 127 - p1 : p1;
        const float m0 = ld_f32_dev(MST + ((size_t)(((bl * 4 + h) * 2 + dir) * NJ + J)) * 4 + 2);
        const float ig0 = gl[s0 * 4 + 2 * dir], ig1 = gl[s1 * 4 + 2 * dir];
        const float lf0 = logsigmoid_f(gl[s0 * 4 + 2 * dir + 1]), lf1 = logsigmoid_f(gl[s1 * 4 + 2 * dir + 1]);
        float incl = lf0 + lf1;
        for (int o = 1; o < 64; o <<= 1) { const float t = __shfl_up(incl, o); if (lane >= o) incl += t; }
        const float bc1 = incl, bc0 = incl - lf1;
        const float a0 = ig0 - bc0, a1 = ig1 - bc1;
        float mx = fmaxf(a0, a1);
        for (int o = 1; o < 64; o <<= 1) { const float t = __shfl_up(mx, o); if (lane >= o) mx = fmaxf(mx, t); }
        float mxprev = __shfl_up(mx, 1); if (lane == 0) mxprev = -3.0e38f;
        const float M0 = fmaxf(m0, fmaxf(mxprev, a0)), M1 = fmaxf(m0, mx);
        av[dir * 128 + s0] = a0; av[dir * 128 + s1] = a1; Mv[dir * 128 + s0] = M0; Mv[dir * 128 + s1] = M1;
        wi[dir * 128 + s0] = __expf(m0 - M0); wi[dir * 128 + s1] = __expf(m0 - M1);
        fl[dir * 128 + s0] = __expf(-bc0 - M0); fl[dir * 128 + s1] = __expf(-bc1 - M1);
    }
    __builtin_amdgcn_sched_barrier(0);
    unsigned Xp[4][8];
    {
    f32x16 X[4] = {};
    { const LAS bf16_t* bq = Tq + (32 * (wid >> 1) + r32) * TLD + hi * 8; const LAS bf16_t* ak = Tk + r32 * TLD + hi * 8;
#pragma unroll 2
      for (int ks = 0; ks < 8; ++ks) { const bf16x8 b = *(const LAS bf16x8*)(bq + ks * 16);
#pragma unroll
          for (int sb = 0; sb < 4; ++sb) X[sb] = mfma32(*(const LAS bf16x8*)(ak + 32 * sb * TLD + ks * 16), b, X[sb]); } }
#pragma unroll
    for (int sb = 0; sb < 4; ++sb)
#pragma unroll
        for (int i = 0; i < 8; ++i) Xp[sb][i] = cvtpk(X[sb][2 * i], X[sb][2 * i + 1]);
    }
    __syncthreads();
    { const int d_ = tid >> 2, e_ = (tid & 3) * 32;
#pragma unroll
      for (int i = 0; i < 4; ++i) *(LAS u32x4*)(Tk + d_ * TLD + e_ + 8 * i) = cbp_[i]; }
    __syncthreads();
    f32x16 ao0[2], ao1[2];
    LAS float* denw = denp;
    mlstm_c_dir<0>(Xp, ao0, Tq, Ts, Tv, av, Mv, wi, denw, n0l, wid, lane);
    mlstm_c_dir<1>(Xp, ao1, Tq, Tk, Tv, av, Mv, wi, denw, n0l, wid, lane);
    float hv[2][16];
#pragma unroll
    for (int r = 0; r < 16; ++r) { const int t = 32 * (wid >> 1) + crow(r, hi);
        const float df = denw[(wid * 2 + 0) * 32 + crow(r, hi)], db = denw[(wid * 2 + 1) * 32 + crow(r, hi)];
        const float rf = 1.0f / fmaxf(fabsf(df), fl[t]), rb = 1.0f / fmaxf(fabsf(db), fl[128 + t]);
        hv[0][r] = ao0[0][r] * rf + ao1[0][r] * rb; hv[1][r] = ao0[1][r] * rf + ao1[1][r] * rb;
        float q = hv[0][r] * hv[0][r] + hv[1][r] * hv[1][r];
        q = half_sum31(q);
        if (r32 == 31) lds_addf(&ssq[t], q); }
    __syncthreads();
    const float* gm = p.in[I_GMN] + l * 512 + h * 128; const float* sk = p.in[I_SKIP] + l * 512 + h * 128;
    f32x16 hn[2];
#pragma unroll
    for (int tl = 0; tl < 2; ++tl) { const float gd = gm[64 * (wid & 1) + 32 * tl + r32];
#pragma unroll
        for (int r = 0; r < 16; ++r) hn[tl][r] = hv[tl][r] * rsqrtf(ssq[32 * (wid >> 1) + crow(r, hi)] * (1.0f / 128.0f) + EPS) * gd; }
    LAS float* F = (LAS float*)lds;
    st_acc_f32(F, hn, wid, lane);
    __syncthreads();
    { int te_ = tid; asm volatile("" : "+v"(te_));
      const int t = te_ >> 2, c0 = (te_ & 3) * 32; const size_t o = (size_t)(r0 + t) * 512 + h * 128 + c0;
      const bf16_t* xcv = pbuf(p, P_XCV) + o; bf16_t* zb = pbuf(p, P_ZB) + o;
      u32x4 xw[4], zw[4]; f32x4 s0[4], s1[4];
#pragma unroll
      for (int i = 0; i < 4; ++i) { xw[i] = *(const u32x4*)(xcv + 8 * i); zw[i] = *(const u32x4*)(zb + 8 * i); s0[i] = *(const f32x4*)(sk + c0 + 8 * i); s1[i] = *(const f32x4*)(sk + c0 + 8 * i + 4); }
#pragma unroll
      for (int i = 0; i < 4; ++i) { float x8[8], z8[8]; unpack8(xw[i], x8); unpack8(zw[i], z8);
          const f32x4 h0 = *(const LAS f32x4*)(F + t * FLD + c0 + 8 * i), h1 = *(const LAS f32x4*)(F + t * FLD + c0 + 8 * i + 4);
#pragma unroll
          for (int j = 0; j < 4; ++j) { z8[j] = (h0[j] + s0[i][j] * x8[j]) * z8[j]; z8[4 + j] = (h1[j] + s1[i][j] * x8[4 + j]) * z8[4 + j]; }
          zw[i] = pack8(z8); }
#pragma unroll
      for (int i = 0; i < 4; ++i) *(u32x4*)(zb + 8 * i) = zw[i]; }
    __syncthreads();
}
namespace att {
typedef float f32x2v __attribute__((ext_vector_type(2)));
constexpr int SHM_V = 64 * 128 * 2, SHM_K = 64 * 64 * 2, OFF_K = 2 * SHM_V, OFF_WS = OFF_K + 2 * SHM_K, OFF_ST = OFF_WS + 8 * 64 * 4, LDS_NEED = OFF_ST + 32 * 512 * 4;
static_assert(LDS_NEED <= LDS_BYTES - 64, "attention LDS");
constexpr float THR2 = 11.5f;
#define KSWZ64(row, colB) ((row) * 128 + ((colB) ^ (((row) & 7) << 4)))
#define ASBAR() __builtin_amdgcn_sched_barrier(0)
__device__ __forceinline__ void partialSM(f32x16& p0, f32x16& p1, float& m_reg, float& mn, float& alpha) {
    float pmax = p0[0];
#pragma unroll
    for (int r = 1; r < 16; ++r) pmax = fmaxf(pmax, p0[r]);
#pragma unroll
    for (int r = 0; r < 16; ++r) pmax = fmaxf(pmax, p1[r]);
    { auto rr = __builtin_amdgcn_permlane32_swap(__float_as_uint(pmax), __float_as_uint(pmax), false, false); pmax = fmaxf(__uint_as_float(rr[0]), __uint_as_float(rr[1])); }
    if (__builtin_expect(__all(pmax - m_reg <= THR2), 1)) { mn = m_reg; alpha = 1.f; }
    else { mn = fmaxf(m_reg, pmax); alpha = __builtin_amdgcn_exp2f(m_reg - mn); m_reg = mn; }
    { const f32x2v mn2 = {mn, mn};
#pragma unroll
      for (int r = 0; r < 16; r += 2) { f32x2v t0 = {p0[r], p0[r + 1]}, t1 = {p1[r], p1[r + 1]}; t0 -= mn2; t1 -= mn2; p0[r] = t0[0]; p0[r + 1] = t0[1]; p1[r] = t1[0]; p1[r + 1] = t1[1]; } }
#pragma unroll
    for (int r = 0; r < 16; ++r) p0[r] = __builtin_amdgcn_exp2f(p0[r]);
}
__device__ __forceinline__ void finishSM(f32x16& p0, f32x16& p1, float alpha, float& l_reg, bf16x8& pa0, bf16x8& pa1, bf16x8& pa2, bf16x8& pa3) {
#pragma unroll
    for (int r = 0; r < 16; ++r) p1[r] = __builtin_amdgcn_exp2f(p1[r]);
    float ps;
    { f32x2v s2 = {p0[0], p0[1]};
#pragma unroll
      for (int r = 2; r < 16; r += 2) s2 += (f32x2v){p0[r], p0[r + 1]};
#pragma unroll
      for (int r = 0; r < 16; r += 2) s2 += (f32x2v){p1[r], p1[r + 1]};
      ps = s2[0] + s2[1]; }
    { auto rr = __builtin_amdgcn_permlane32_swap(__float_as_uint(ps), __float_as_uint(ps), false, false); ps = __uint_as_float(rr[0]) + __uint_as_float(rr[1]); }
    l_reg = l_reg * alpha + ps;
#define PK4(P, BASE, OUT) do { unsigned a0 = cvtpk(P[BASE + 0], P[BASE + 1]), a1 = cvtpk(P[BASE + 2], P[BASE + 3]);   \
    unsigned b0 = cvtpk(P[BASE + 4], P[BASE + 5]), b1 = cvtpk(P[BASE + 6], P[BASE + 7]);                              \
    auto r0 = __builtin_amdgcn_permlane32_swap(a0, b0, false, false); auto r1 = __builtin_amdgcn_permlane32_swap(a1, b1, false, false); \
    u32x4 w = {r0[0], r1[0], r0[1], r1[1]}; OUT = *reinterpret_cast<bf16x8*>(&w); } while (0)
    PK4(p0, 0, pa0); PK4(p0, 8, pa1); PK4(p1, 0, pa2); PK4(p1, 8, pa3);
#undef PK4
}
__device__ __forceinline__ void qkt(f32x16& p0, f32x16& p1, const LAS char* Ks, const bf16x8 (&qr)[4], int r32, int hi) {
    p0 = f32x16{}; p1 = f32x16{};
#pragma unroll
    for (int d0 = 0; d0 < 4; ++d0) { const int cb = (d0 * 16 + hi * 8) * 2;
        const bf16x8 b0 = *reinterpret_cast<const LAS bf16x8*>(Ks + KSWZ64(r32, cb));
        const bf16x8 b1 = *reinterpret_cast<const LAS bf16x8*>(Ks + KSWZ64(32 + r32, cb));
        p0 = mfma32(b0, qr[d0], p0); p1 = mfma32(b1, qr[d0], p1); }
}
__device__ __forceinline__ int v_st(int k, int c) { const int kk = (k & ~0xC) | ((k & 4) << 1) | ((k & 8) >> 1); return ((kk >> 3) * 4 + (c >> 5)) * 512 + ((kk & 7) * 32 + (c & 31)) * 2; }
__device__ __forceinline__ int v_rd_base(int lane) { return ((lane & 3) << 3) | (((lane >> 2) & 3) << 6) | (((lane >> 4) & 1) << 5) | (((lane >> 5) & 1) << 8); }
constexpr int v_rd_off(int d0, int ks, int half) { return d0 * 512 + ks * 4096 + half * 2048; }
template <int OFF> __device__ __forceinline__ s16x4 tr_read(int vb) { s16x4 r; asm volatile("ds_read_b64_tr_b16 %0, %1 offset:%2" : "=&v"(r) : "v"(vb), "i"(OFF) : "memory"); return r; }
template <int D0> __device__ __forceinline__ void pv_one(f32x16& od, int vb, bf16x8 pa0, bf16x8 pa1, bf16x8 pa2, bf16x8 pa3) {
    const s16x4 l0 = tr_read<v_rd_off(D0, 0, 0)>(vb), h0 = tr_read<v_rd_off(D0, 0, 1)>(vb), l1 = tr_read<v_rd_off(D0, 1, 0)>(vb), h1 = tr_read<v_rd_off(D0, 1, 1)>(vb);
    const s16x4 l2 = tr_read<v_rd_off(D0, 2, 0)>(vb), h2 = tr_read<v_rd_off(D0, 2, 1)>(vb), l3 = tr_read<v_rd_off(D0, 3, 0)>(vb), h3 = tr_read<v_rd_off(D0, 3, 1)>(vb);
    asm volatile("s_waitcnt lgkmcnt(0)" ::: "memory"); ASBAR();
#define PKV(L, H) (bf16x8){L[0], L[1], L[2], L[3], H[0], H[1], H[2], H[3]}
    od = mfma32(pa0, PKV(l0, h0), od); od = mfma32(pa1, PKV(l1, h1), od); od = mfma32(pa2, PKV(l2, h2), od); od = mfma32(pa3, PKV(l3, h3), od);
#undef PKV
}
__device__ __forceinline__ void pv_d0(f32x16 (&o)[4], int vb, bf16x8 pa0, bf16x8 pa1, bf16x8 pa2, bf16x8 pa3) {
    pv_one<0>(o[0], vb, pa0, pa1, pa2, pa3); pv_one<1>(o[1], vb, pa0, pa1, pa2, pa3); pv_one<2>(o[2], vb, pa0, pa1, pa2, pa3); pv_one<3>(o[3], vb, pa0, pa1, pa2, pa3);
}
__device__ __forceinline__ int krow(int j, int rc, int rl) { return j < 4 ? rc + 64 * j : rl + 64 * (j - 4); }

__device__ __forceinline__ void attn_unit(const Params& p, int l, int h, int qrow0, int rc, int rl, int NT, LAS unsigned char* lds8) {
    int tid_ = threadIdx.x; asm volatile("" : "+v"(tid_));
    const int tid = tid_, wid = __builtin_amdgcn_readfirstlane(tid >> 6), lane = tid & 63, r32 = lane & 31, hi = lane >> 5;
    LAS char* V_lds = (LAS char*)lds8; LAS char* K_lds = (LAS char*)lds8 + OFF_K;
    LAS float* wsx = (LAS float*)(lds8 + OFF_WS) + wid * 64; LAS float* li_l = wsx; LAS float* al_l = wsx + 32;
    LAS unsigned* stash = (LAS unsigned*)(lds8 + OFF_ST);
    bf16_t* QB = pbuf(p, P_QB); const bf16_t* KB = pbuf(p, P_KB); const bf16_t* VB = pbuf(p, P_VB);
    const int sr = tid >> 4, sc = (tid & 15) * 8, vst0 = v_st(sr, sc);
    const int kr = tid >> 3, kc = (tid & 7) * 8, kst = KSWZ64(kr, kc * 2);
    const int vb0 = (int)(uintptr_t)V_lds + v_rd_base(lane);
    f32x16 o[4];
#pragma unroll 1
    for (int m = 0; m < 2; ++m) {
        const unsigned voV0 = (unsigned)((sr * 512 + h * 128 + sc) * 2), voK = (unsigned)((kr * 512 + h * 128 + m * 64 + kc) * 2);
        float m_reg = -1e30f, l_reg = 0.f;
#pragma unroll
        for (int d = 0; d < 4; ++d) o[d] = f32x16{};
        bf16x8 qr[4];
        { const bf16_t* Qw = QB + (size_t)(qrow0 + wid * 32 + r32) * 512 + h * 128 + m * 64 + hi * 8;
#pragma unroll
          for (int d0 = 0; d0 < 4; ++d0) qr[d0] = *(const bf16x8*)(Qw + d0 * 16); }
        struct { bf16x8 vs0, vs1, ks0; } sr_[2];
#define SLOAD(i, j) do { const int _r = __builtin_amdgcn_readfirstlane(krow((j), rc, rl)); const char* _vb = (const char*)(VB + (size_t)_r * 512); const char* _kb = (const char*)(KB + (size_t)_r * 512); \
    sr_[i].vs0 = *(const bf16x8*)(_vb + voV0); sr_[i].vs1 = *(const bf16x8*)(_vb + 32 * 512 * 2 + voV0); sr_[i].ks0 = *(const bf16x8*)(_kb + voK); } while (0)
#define SWRITE(b, i) do { *(LAS bf16x8*)(V_lds + (b) * SHM_V + vst0) = sr_[i].vs0; *(LAS bf16x8*)(V_lds + (b) * SHM_V + 8192 + vst0) = sr_[i].vs1; \
    *(LAS bf16x8*)(K_lds + (b) * SHM_K + kst) = sr_[i].ks0; } while (0)
#define SWAIT() asm volatile("s_waitcnt vmcnt(3)" ::: "memory")
#define RESC(a) do { if (__any((a) < 1.f)) { if (hi == 0) al_l[r32] = (a); asm volatile("s_waitcnt lgkmcnt(0)" ::: "memory"); \
    _Pragma("unroll") for (int d = 0; d < 4; ++d) _Pragma("unroll") for (int r = 0; r < 16; ++r) o[d][r] *= al_l[crow(r, hi)]; } } while (0)
        f32x16 pA0, pA1, pB0, pB1; float mnA, mnB, alA, alB; bf16x8 pa0, pa1, pa2, pa3;
        SLOAD(0, 0); asm volatile("s_waitcnt vmcnt(0)" ::: "memory"); SWRITE(0, 0); __syncthreads();
        qkt(pA0, pA1, K_lds, qr, r32, hi); partialSM(pA0, pA1, m_reg, mnA, alA);
        SLOAD(1, 1); if (2 < NT) SLOAD(0, 2);
        SWAIT(); SWRITE(1, 1); __syncthreads();
        for (int j = 1; j + 1 < NT; j += 2) {
            ASBAR(); qkt(pB0, pB1, K_lds + SHM_K, qr, r32, hi);
            finishSM(pA0, pA1, alA, l_reg, pa0, pa1, pa2, pa3); ASBAR();
            SLOAD(1, j + 2); ASBAR();
            pv_d0(o, vb0, pa0, pa1, pa2, pa3); partialSM(pB0, pB1, m_reg, mnB, alB);
            __syncthreads(); SWAIT(); SWRITE(0, 0);
            RESC(alB); __syncthreads();
            ASBAR(); qkt(pA0, pA1, K_lds, qr, r32, hi);
            finishSM(pB0, pB1, alB, l_reg, pa0, pa1, pa2, pa3); ASBAR();
            if (j + 3 < NT) SLOAD(0, j + 3); ASBAR();
            pv_d0(o, vb0 + SHM_V, pa0, pa1, pa2, pa3); partialSM(pA0, pA1, m_reg, mnA, alA);
            __syncthreads(); SWAIT(); SWRITE(1, 1);
            RESC(alA); __syncthreads();
        }
        ASBAR(); qkt(pB0, pB1, K_lds + SHM_K, qr, r32, hi);
        finishSM(pA0, pA1, alA, l_reg, pa0, pa1, pa2, pa3); ASBAR();
        pv_d0(o, vb0, pa0, pa1, pa2, pa3); partialSM(pB0, pB1, m_reg, mnB, alB);
        __syncthreads(); RESC(alB);
        finishSM(pB0, pB1, alB, l_reg, pa0, pa1, pa2, pa3); ASBAR();
        pv_d0(o, vb0 + SHM_V, pa0, pa1, pa2, pa3);
#undef SLOAD
#undef SWRITE
#undef SWAIT
#undef RESC
        int lane_e = lane; asm volatile("" : "+v"(lane_e)); const int r32e = lane_e & 31, hie = lane_e >> 5;
        if (hie == 0) li_l[r32e] = l_reg; asm volatile("s_waitcnt lgkmcnt(0)" ::: "memory");
        float rli[16];
#pragma unroll
        for (int r = 0; r < 16; ++r) rli[r] = __builtin_amdgcn_rcpf(li_l[crow(r, hie)]);
        if (m == 0) {
#pragma unroll
            for (int d0 = 0; d0 < 4; ++d0)
#pragma unroll
                for (int r = 0; r < 16; r += 2) stash[(wid * 32 + d0 * 8 + (r >> 1)) * 64 + lane_e] = cvtpk(o[d0][r] * rli[r], o[d0][r + 1] * rli[r + 1]);
        } else {
            const float lam = ld_f32_dev((const float*)(p.ws + WS_LAM) + l * 4), oml = ld_f32_dev((const float*)(p.ws + WS_LAM) + l * 4 + 1);
            float ss[16];
#pragma unroll
            for (int r = 0; r < 16; ++r) ss[r] = 0.f;
#pragma unroll
            for (int d0 = 0; d0 < 4; ++d0)
#pragma unroll
                for (int r = 0; r < 16; r += 2) { const unsigned w = stash[(wid * 32 + d0 * 8 + (r >> 1)) * 64 + lane_e];
                    o[d0][r] = bf_lo(w) - lam * o[d0][r] * rli[r]; o[d0][r + 1] = bf_hi(w) - lam * o[d0][r + 1] * rli[r + 1];
                    ss[r] += o[d0][r] * o[d0][r]; ss[r + 1] += o[d0][r + 1] * o[d0][r + 1]; }
#pragma unroll
            for (int r = 0; r < 16; ++r) { float q = ss[r]; q += __shfl_xor(q, 1); q += __shfl_xor(q, 2); q += __shfl_xor(q, 4); q += __shfl_xor(q, 8); q += __shfl_xor(q, 16);
                ss[r] = rsqrtf(q * (1.0f / 128.0f) + EPS) * oml; }
            const float* gs = p.in[I_GSUBLN] + l * 128;
            asm volatile("s_waitcnt lgkmcnt(0)" ::: "memory");
            LAS bf16_t* ot = (LAS bf16_t*)(stash + wid * 32 * 64);
#pragma unroll
            for (int d0 = 0; d0 < 4; ++d0) { const float g = gs[d0 * 32 + r32e];
#pragma unroll
                for (int r = 0; r < 16; ++r) ot[((r & 3) + 8 * (r >> 2) + 4 * hie) * 128 + d0 * 32 + r32e] = (bf16_t)(cvtpk(o[d0][r] * ss[r] * g, 0.f) & 0xffffu); }
            asm volatile("s_waitcnt lgkmcnt(0)" ::: "memory");
            { bf16_t* dst = QB + (size_t)(qrow0 + wid * 32) * 512 + h * 128;
#pragma unroll
              for (int i = 0; i < 8; ++i) { const int row = i * 4 + (lane_e >> 4), pc = (lane_e & 15) * 8;
                  *(u32x4*)(dst + (size_t)row * 512 + pc) = *(const LAS u32x4*)(ot + row * 128 + pc); } }
        }
        __syncthreads();
    }
}
}
__device__ __forceinline__ void gmlp_unit(const Params& p, int l, int r0, LAS unsigned char* lds) {
    int tid_ = threadIdx.x; asm volatile("" : "+v"(tid_));
    const int tid = tid_, wid = __builtin_amdgcn_readfirstlane(tid >> 6), lane = tid & 63, r32 = lane & 31, hi = lane >> 5;
    const bf16_t* VG = pbuf(p, P_VGB); bf16_t* UB = pbuf(p, P_UB);
    PSEC_BEGIN8();
    {
        const int sr = tid >> 4, sc = (tid & 15) * 8, vst0 = att::v_st(sr, sc);
        u32x4 x[4][4]; float rs[4];
#pragma unroll
        for (int k = 0; k < 4; ++k)
#pragma unroll
            for (int g = 0; g < 4; ++g) x[k][g] = *(const u32x4*)(VG + (size_t)(r0 + sr + 32 * k) * 512 + g * 128 + sc);
#pragma unroll
        for (int k = 0; k < 4; ++k) { float ss = 0.f;
#pragma unroll
            for (int g = 0; g < 4; ++g) { float v[8]; unpack8(x[k][g], v);
#pragma unroll
                for (int j = 0; j < 8; ++j) ss += v[j] * v[j]; }
            ss += __shfl_xor(ss, 1); ss += __shfl_xor(ss, 2); ss += __shfl_xor(ss, 4); ss += __shfl_xor(ss, 8);
            rs[k] = rsqrtf(ss * (1.0f / 512.0f) + EPS); }
#pragma unroll
        for (int k = 0; k < 4; ++k)
#pragma unroll
            for (int g = 0; g < 4; ++g) { float v[8]; unpack8(x[k][g], v);
#pragma unroll
                for (int j = 0; j < 8; ++j) v[j] *= rs[k];
                *(LAS u32x4*)(lds + (g * 2 + (k >> 1)) * att::SHM_V + (k & 1) * 8192 + vst0) = pack8(v); }
    }
    __syncthreads();
    const int rb = wid >> 1, dh = wid & 1;
    const int vb0 = (int)(uintptr_t)lds + att::v_rd_base(lane) + dh * 1024;
    LAS float* F = (LAS float*)(lds + 8 * att::SHM_V) + wid * 576;
    const bf16_t* Wsb = (const bf16_t*)(p.ws + WS_WSB) + (size_t)l * 4 * 16384 + (size_t)(32 * rb + r32) * 128 + 8 * hi;
#pragma unroll 1
    for (int g = 0; g < 4; ++g) {
        bf16x8 pa[2][4];
#pragma unroll
        for (int kt = 0; kt < 2; ++kt)
#pragma unroll
            for (int k4 = 0; k4 < 4; ++k4) pa[kt][k4] = *(const bf16x8*)(Wsb + (size_t)g * 16384 + 64 * kt + 16 * k4);
        bf16_t* up = UB + (size_t)(r0 + 32 * rb + (lane >> 2)) * 512 + g * 128 + 64 * dh + 8 * (lane & 3);
        u32x4 uu[2][2];
#pragma unroll
        for (int d0 = 0; d0 < 2; ++d0)
#pragma unroll
            for (int rd = 0; rd < 2; ++rd) uu[d0][rd] = *(const u32x4*)(up + (size_t)(16 * rd) * 512 + 32 * d0);
        const float* gv = p.in[I_GGV] + l * 512 + g * 128 + 64 * dh + r32; const float* bs = p.in[I_BGS] + (l * 4 + g) * 128 + 32 * rb;
        const float gv0 = gv[0], gv1 = gv[32];
        float bsv[16];
#pragma unroll
        for (int r = 0; r < 16; ++r) bsv[r] = bs[crow(r, hi)];
        __builtin_amdgcn_sched_barrier(0);
        f32x16 o[2] = {};
        att::pv_one<0>(o[0], vb0 + (g * 2) * att::SHM_V, pa[0][0], pa[0][1], pa[0][2], pa[0][3]); att::pv_one<1>(o[1], vb0 + (g * 2) * att::SHM_V, pa[0][0], pa[0][1], pa[0][2], pa[0][3]);
        att::pv_one<0>(o[0], vb0 + (g * 2 + 1) * att::SHM_V, pa[1][0], pa[1][1], pa[1][2], pa[1][3]); att::pv_one<1>(o[1], vb0 + (g * 2 + 1) * att::SHM_V, pa[1][0], pa[1][1], pa[1][2], pa[1][3]);
#pragma unroll
        for (int d0 = 0; d0 < 2; ++d0)
#pragma unroll
            for (int rd = 0; rd < 2; ++rd) {
#pragma unroll
                for (int r = 0; r < 8; ++r) { const int rr = 8 * rd + r; F[((r & 3) + 8 * ((r >> 2) & 1) + 4 * hi) * 36 + r32] = o[d0][rr] * (d0 ? gv1 : gv0) + bsv[rr]; }
                asm volatile("s_waitcnt lgkmcnt(0)" ::: "memory");
                const f32x4 m0 = *(const LAS f32x4*)(F + (lane >> 2) * 36 + 8 * (lane & 3)), m1 = *(const LAS f32x4*)(F + (lane >> 2) * 36 + 8 * (lane & 3) + 4);
                float u8[8]; unpack8(uu[d0][rd], u8);
#pragma unroll
                for (int j = 0; j < 4; ++j) { u8[j] *= m0[j]; u8[4 + j] *= m1[j]; }
                *(u32x4*)(up + (size_t)(16 * rd) * 512 + 32 * d0) = pack8(u8);
                asm volatile("s_waitcnt lgkmcnt(0)" ::: "memory");
            }
    }
    __syncthreads();
    PSEC(8);
}
constexpr int N_PHASES = 36;
typedef const __attribute__((address_space(4))) Params* KParams;
#define PHASE_P() const Params& p = *(const Params*)opaque_kp()
__device__ __forceinline__ KParams opaque_kp() { KParams q = (KParams)__builtin_amdgcn_kernarg_segment_ptr(); asm volatile("" : "+s"(q)); return q; }
__global__ void __launch_bounds__(NTHR, 2) mk_fwd(Params p_arg, int bar_region) {
    extern __shared__ __attribute__((aligned(16))) unsigned char lds_raw[];
    LAS unsigned char* lds = (LAS unsigned char*)lds_raw;
    const int tid = threadIdx.x, G = gridDim.x, bid = blockIdx.x;
    volatile LAS unsigned* xbw = (volatile LAS unsigned*)(lds + LDS_BYTES - 16);
    if (tid == 0) { xbw[0] = 0u; xbw[1] = 0u; xbw[2] = 0u; xbw[3] = 0u; }
    __syncthreads();
    (void)xcd_barrier_post((unsigned*)(p_arg.ws + WS_CTL) + CW_BAR + bar_region * 4096, xbw);
    const int lo = p_arg.ph_lo, hi = p_arg.ph_hi;
#define IN(k) (lo <= (k) && (k) < hi)
#ifdef PROBE
#define STAMP(k) do { if (tid == 0) { if (bid == 0) ((unsigned long long*)(opaque_kp()->ws + WS_CTL))[30000 + (k)] = __builtin_amdgcn_s_memrealtime(); *(volatile LAS int*)(lds + LDS_BYTES - 32) = (k); } __syncthreads(); } while (0)
#else
#define STAMP(k) do { } while (0)
#endif
#define GRID_BARRIER() do { KParams kq = opaque_kp(); XcdBarrier b_; b_.bar = (unsigned*)(kq->ws + WS_CTL) + CW_BAR + ((const __attribute__((address_space(4))) int*)(kq + 1))[0] * 4096; b_.x = xb_xcc_id(); b_.st = xbw; xcd_barrier(b_); } while (0)
#define SEAM(k) do { if (IN(k) && IN((k) + 1)) { GRID_BARRIER(); STAMP((k) + 1); } } while (0)

    STAMP(0);
#if !defined(ONLY) || ONLY == 0
    if (IN(0)) { PHASE_P(); phase_prologue(p, lds); }
#endif
    SEAM(0);
    for (int l = 0; l < 2; ++l) {
        const int base = 1 + 17 * l;
#if !defined(ONLY) || ONLY == 1
        if (IN(base)) { PHASE_P(); phase_norm1(p, l); }
#endif
        SEAM(base);
        for (int hf = 0; hf < 2; ++hf) {
            const int hb = base + 1 + 6 * hf;
#if !defined(ONLY) || ONLY == 2
            if (IN(hb)) {
                PHASE_P(); unsigned char* ws = p.ws; bf16_t* Hh = (bf16_t*)(ws + WS_H) + (size_t)hf * MH * 1024; (void)Hh;
                const float* cosT = (const float*)(ws + WS_ROPE); const float* sinT = cosT + 1024;
                pg8::Gemm g{Hh, (const bf16_t*)(ws + WS_WTIN) + (size_t)l * NCOL * 1024, MH, NCOL, 1024};
                int cin = bid; if (hf == 1) { cin += G >> 1; if (cin >= G) cin -= G; }
                RectOrder S; if (l == 0) S.init(72, 14, 0, 0, 0, 0, G, cin); else S.init(64, 14, 8, 8, 6, 0, G, cin);
                EpiIn E{pbuf(p, 0), pbuf(p, P_GB), cosT, sinT};
                pg8::gemm_phase<EpiIn, RectOrder>((PG8_LAS unsigned char*)lds, g, S, E, nullptr);
                pg8::Gemm g8{(const bf16_t*)(ws + WS_H8 + (size_t)hf * MH * 1024), (const bf16_t*)(ws + WS_WTIN8 + (size_t)l * 3072 * 1024), MH, 3072, 512};
                RectOrder S8; S8.init(l == 0 ? 72 : 64, 12, l == 0 ? 0 : 8, 0, 0, 0, G, G - 1 - cin);
                EpiGate8 E8{pbuf(p, P_GB)};
                pg8::gemm_phase<EpiGate8, RectOrder, false, true>((PG8_LAS unsigned char*)lds, g8, S8, E8, nullptr);
            }
#endif
            SEAM(hb);
#if !defined(ONLY) || ONLY == 3
            if (IN(hb + 1)) {
                PSEC_BEGIN6();
                { PHASE_P(); phase_conv(p, l, lds); }
                PSEC(6);
                GRID_BARRIER(); PSEC(7);
                PHASE_P();
                const int n_a = HBAT * NJ * 4, n_g = HBAT * 16 + (l == 0 ? HBAT * 2 : 0);
                const int bidx = (G == 256) ? ((bid & 7) * 32 + (bid >> 3)) : bid;
                int u = bidx;
                PSEC(13);
                { u32x4 qa[4], qb[4], qwq[4], qwk[4], qwv[4]; f32x4 qg; mlstm_a_load(p, l, u < n_a ? u : 0, APRE_ARGS);
                  for (; u < n_a; u += G) mlstm_a_unit(p, l, u, u + G, n_a, APRE_ARGS, lds); }
                PSEC(14);
                for (; u < n_a + n_g; u += G) { const int v = u - n_a; int r0; if (v < HBAT * 16) r0 = CTXROWS + (v >> 4) * 2048 + (v & 15) * 128; else { const int w = v - HBAT * 16; r0 = (w >> 1) * 256 + (w & 1) * 128; }
                    gmlp_unit(p, l, r0, lds); }
            }
#endif
            SEAM(hb + 1);
#if !defined(ONLY) || ONLY == 4
            if (IN(hb + 2)) {
                PHASE_P();
                phase_scan(p);
            }
#endif
            SEAM(hb + 2);
#if !defined(ONLY) || ONLY == 5
            if (IN(hb + 3)) {
                PHASE_P();
                const int n_l = HBAT * 4 * 8, n_c = (l == 0 ? HBAT * 4 : 0);
                for (int u = bid; u < n_l + n_c; u += G) {
                    int h, qrow0, rc, rl, NT;
                    if (u < n_l) { const int ue = (G == 256) ? ((((u & 7) * 4 + (u >> 6)) << 3) | ((u >> 3) & 7)) : u;
                        const int bl = ue >> 5, qb = ue & 7; h = (ue >> 3) & 3; qrow0 = CTXROWS + bl * 2048 + qb * 256; rc = bl * 256; rl = CTXROWS + bl * 2048; NT = 36; }
                    else { const int v = u - n_l, bl = v >> 2; h = v & 3; qrow0 = bl * 256; rc = bl * 256; rl = 0; NT = 4; }
                    PSEC_BEGINN(9); att::attn_unit(p, l, h, qrow0, rc, rl, NT, lds); PSEC(9);
                }
                const int m_l = HBAT * 16 * 4, m_c = (l == 0 ? HBAT * 2 * 4 : 0);
                int u0 = bid + 192; if (u0 >= G) u0 -= G;
                for (int u = u0; u < m_l + m_c; u += G) {
                    int bl, J, h;
                    if (u < m_l) { const int rem = u & 63; bl = u >> 6; J = 2 + (rem >> 2); h = rem & 3; }
                    else { const int v = u - m_l, rem = v & 7; bl = v >> 3; J = rem >> 2; h = rem & 3; }
                    PSEC_BEGINN(10); mlstm_c_unit(p, l, bl, J, h, lds); PSEC(10);
                }
                if (l == 0 && G == 256 && !(bid >= 64 && bid < 128)) cvt_fill(p, lds, hf == 0 ? 0 : CVT_Q1, hf == 0 ? CVT_Q0 : CVT_Q2, bid < 64 ? bid : bid - 64, 192);
                else if (l == 0 && G != 256) cvt_fill(p, lds, hf == 0 ? 0 : CVT_Q1, hf == 0 ? CVT_Q0 : CVT_Q2, bid, G);
            }
#endif
            SEAM(hb + 3);
#if !defined(ONLY) || ONLY == 6
            if (IN(hb + 4)) {
                PHASE_P(); unsigned char* ws = p.ws; bf16_t* Hh = (bf16_t*)(ws + WS_H) + (size_t)hf * MH * 1024; (void)Hh;
                pg8::Gemm g{pbuf(p, P_QB), (const bf16_t*)(ws + WS_WTBR) + (size_t)l * 3072 * 512, 3 * MH, 3072, 512};
                MergeOrder S; S.init(l == 0 ? 72 : 64, l == 0 ? 0 : 8, G, bid);
                EpiMerge E{pbuf(p, P_GB), Hh};
                pg8::gemm_phase<EpiMerge, MergeOrder>((PG8_LAS unsigned char*)lds, g, S, E, nullptr);
                if (l == 0) { const int skip = G > 64 ? 32 : 0; __syncthreads(); if (bid >= skip) cvt_fill(p, lds, hf == 0 ? CVT_Q0 : CVT_Q2, hf == 0 ? CVT_Q1 : CVT_Q3, bid - skip, G - skip); }
            }
#endif
            SEAM(hb + 4);
#if !defined(ONLY) || ONLY == 7
            if (IN(hb + 5)) {
                PHASE_P(); unsigned char* ws = p.ws; bf16_t* Hh = (bf16_t*)(ws + WS_H) + (size_t)hf * MH * 1024; (void)Hh;
                pg8::Gemm g{Hh, (const bf16_t*)(ws + WS_WTO) + (size_t)l * 1024 * 1024, MH, 1024, 1024};
                RectOrder S; S.init(l == 0 ? 72 : 64, 4, l == 0 ? 0 : 8, 0, 0, 0, G, bid);
                EpiOut E{l == 0 ? p.in[I_X] : (const float*)p.out, l == 0 ? p.in[I_CTX] : (const float*)(ws + WS_XC), p.out, (float*)(ws + WS_XC), (const float*)(ws + WS_MOD) + (size_t)l * 17 * 6144, hf};
                pg8::gemm_phase<EpiOut, RectOrder>((PG8_LAS unsigned char*)lds, g, S, E, nullptr);
                if (l == 0 && hf == 1) { const int skip = G > 64 ? 32 : 0; __syncthreads(); if (bid >= skip) cvt_fill(p, lds, CVT_Q3, CVT_Q4, bid - skip, G - skip); }
            }
#endif
            if (hf == 1) SEAM(hb + 5);
        }
#if !defined(ONLY) || ONLY == 8
        if (IN(base + 13)) { PHASE_P(); phase_norm2_router(p, l, lds); if (l == 1) cvt_fill(p, lds, CVT_Q4, 2 * CVT_TILES, bid, G); }
#endif
        SEAM(base + 13);
#if !defined(ONLY) || ONLY == 9
        if (IN(base + 14)) { PHASE_P(); phase_dispatch(p, l, lds); }
#endif
        SEAM(base + 14);
#if !defined(ONLY) || ONLY == 10
        if (IN(base + 15)) {
            PHASE_P(); unsigned char* ws = p.ws;
            LAS int* seg = (LAS int*)(lds + 131072); LAS int* tile_e = seg + 128;
            const int nt = moe_tile_table(p, l, seg, tile_e);
            pg8::Gemm g{(const bf16_t*)(ws + WS_H8), (const bf16_t*)(ws + WS_WTGU + (size_t)l * 32 * 1024 * 1024), SLOTS, 32 * 1024, 512};
            MoeOrder S; S.init(tile_e, nt, G, bid);
            { LAS int* srcl = (LAS int*)(lds + 131072 + 2048); const int* SRC = (const int*)(ws + WS_SRC);
              for (int i = 0; i < 6; ++i) { int pm, pn; S.unit_of(i, pm, pn); for (int r = opaque_tid(); r < 256; r += NTHR) srcl[i * 256 + r] = pm < nt ? SRC[pm * 256 + r] : 0; }
              S.srcl = srcl; }
            __syncthreads(); EpiGU E{ws + WS_P + P_ACT};
            pg8::gemm_phase<EpiGU, MoeOrder, false, true, true>((PG8_LAS unsigned char*)lds, g, S, E, nullptr);
        }
#endif
        SEAM(base + 15);
#if !defined(ONLY) || ONLY == 11
        if (IN(base + 16)) {
            PHASE_P(); unsigned char* ws = p.ws;
            LAS int* seg = (LAS int*)(lds + 131072); LAS int* tile_e = seg + 128;
            const int nt = moe_tile_table(p, l, seg, tile_e);
            pg8::Gemm g{pbuf(p, P_ACT), (const bf16_t*)(ws + WS_WTD + (size_t)l * 32 * 1024 * 512), SLOTS, 32 * 1024, 256};
            MoeOrder S; S.init(tile_e, nt, G, bid); __syncthreads(); EpiDown E{pbuf(p, P_YS)};
            pg8::gemm_phase<EpiDown, MoeOrder, false, true>((PG8_LAS unsigned char*)lds, g, S, E, nullptr);
        }
#endif
        SEAM(base + 16);
    }
#if !defined(ONLY) || ONLY == 12
    if (IN(35)) { PHASE_P(); phase_final(p); }
#endif
#ifdef PROBE
    if (bid == 0 && tid == 0) {
        asm volatile("s_waitcnt vmcnt(0)" ::: "memory");
        const unsigned long long tend = __builtin_amdgcn_s_memrealtime();
        volatile unsigned long long* st = (volatile unsigned long long*)(opaque_kp()->ws + WS_CTL) + 30000;
        unsigned long long ta = 0, tb = 0;
        for (int k = 0; k < N_PHASES; ++k) { const unsigned long long t0 = st[k], t1 = (k == N_PHASES - 1) ? tend : st[k + 1]; const unsigned long long d = t1 - t0;
            if ((PROBE_A >> k) & 1ull) ta += d; if ((PROBE_B >> k) & 1ull) tb += st[100 + k]; }
        const unsigned long long spin = ((ta + tb) / 1000ull) * 100000ull;
        while (__builtin_amdgcn_s_memrealtime() - tend < spin) __builtin_amdgcn_s_sleep(32);
    }
#endif
#undef IN
#undef SEAM
}

#ifndef MK_CUTS
#define MK_CUTS 0
#endif
extern "C" void kernel_launch(void* const* d_in, const int* in_sizes, int n_in, void* d_out, int out_size, void* d_ws, size_t ws_size, hipStream_t stream) {
    static int grid = 0;
    if (grid == 0) {
        if (n_in != 31 || in_sizes[0] != NBATCH * SEQ * DM || out_size != NBATCH * SEQ * DM || ws_size < WS_END) {
            fprintf(stderr, "kernel_launch: unexpected shapes or workspace (n_in %d, ws %zu, need %zu); nothing launched\n", n_in, ws_size, (size_t)WS_END); grid = -1; return; }
        int dev = 0, cus = 0, per_cu = 0;
        if (hipGetDevice(&dev) != hipSuccess || hipDeviceGetAttribute(&cus, hipDeviceAttributeMultiprocessorCount, dev) != hipSuccess) { grid = -1; return; }
        if (hipFuncSetAttribute((const void*)mk_fwd, hipFuncAttributeMaxDynamicSharedMemorySize, LDS_BYTES) != hipSuccess) { fprintf(stderr, "kernel_launch: hipFuncSetAttribute failed\n"); grid = -1; return; }
        if (hipOccupancyMaxActiveBlocksPerMultiprocessor(&per_cu, (const void*)mk_fwd, NTHR, LDS_BYTES) != hipSuccess || per_cu < 1) { fprintf(stderr, "kernel_launch: occupancy query says %d\n", per_cu); }
        (void)hipGetLastError();
        grid = cus;
    }
    if (grid < 0) return;
    if (hipMemsetAsync((char*)d_ws + WS_CTL, 0, CTL_BYTES, stream) != hipSuccess) return;
    Params p{};
    for (int i = 0; i < 31; ++i) p.in[i] = (const float*)d_in[i];
    p.out = (float*)d_out; p.ws = (unsigned char*)d_ws;
#if MK_CUTS == 0
    p.ph_lo = 0; p.ph_hi = N_PHASES;
    hipLaunchKernelGGL(mk_fwd, dim3(grid), dim3(NTHR), LDS_BYTES, stream, p, 0);
#else
    for (int k = 0; k < N_PHASES; ++k) {
#ifdef EXP_NOMOE
        if ((k >= 14 && k <= 17) || (k >= 31 && k <= 34)) continue;
#endif
#ifdef EXP_NOEXPERT
        if (k == 16 || k == 17 || k == 33 || k == 34) continue;
#endif
#ifdef EXP_NOGU
        if (k == 16 || k == 33) continue;
#endif
#ifdef EXP_NOMIX
        if ((k >= 2 && k <= 13) || (k >= 19 && k <= 30)) continue;
#endif
#ifdef EXP_ZEROXB
        if (k == 15 || k == 32) { hipMemsetAsync((char*)d_ws + WS_P + P_XB, 0, P_MOE_END, stream); hipMemsetAsync((char*)d_ws + WS_WTS, 0, (size_t)SLOTS * 4, stream); }
#endif
        p.ph_lo = k; p.ph_hi = k + 1; hipLaunchKernelGGL(mk_fwd, dim3(grid), dim3(NTHR), LDS_BYTES, stream, p, 0); }
#endif
}
```

```cpp
#include <hip/hip_runtime.h>
#include <cstdio>
#include <cstdint>

#define LAS __attribute__((address_space(3)))
typedef unsigned short bf16_t;
typedef short bf16x8 __attribute__((ext_vector_type(8)));
typedef short s16x4 __attribute__((ext_vector_type(4)));
typedef float f32x2 __attribute__((ext_vector_type(2)));
typedef float f32x4 __attribute__((ext_vector_type(4)));
typedef float f32x16 __attribute__((ext_vector_type(16)));
typedef unsigned u32x2 __attribute__((ext_vector_type(2)));
typedef unsigned u32x4 __attribute__((ext_vector_type(4)));

constexpr int DM = 1024, NBATCH = 16, SEQ = 2048, CTXL = 256, NCOL = 6656;
constexpr int HBAT = 8;
constexpr int MH = HBAT * (SEQ + CTXL);
constexpr int MTOT = 2 * MH;
constexpr int CTXROWS = HBAT * CTXL;
constexpr int NJ = 18;
constexpr int NEXP = 32, DEXP = 512;
constexpr int SLOTS = 81920;
constexpr float EPS = 1e-6f;
constexpr float LOG2E = 1.4426950408889634f;
constexpr float QSCALE = 0.125f * LOG2E;
constexpr int NTHR = 512;
constexpr int LDS_BYTES = 155648;
constexpr int TLD = 136;
constexpr int TILE_B = 128 * TLD * 2;

constexpr size_t AL(size_t x) { return (x + 255) / 256 * 256; }
constexpr size_t WS_CTL   = 0;
constexpr size_t CTL_BYTES = 262144;
constexpr size_t WS_MOD   = WS_CTL + CTL_BYTES;
constexpr size_t WS_WFOLD = WS_MOD + AL((size_t)2 * 17 * 6144 * 4);
constexpr size_t WS_ROPE  = WS_WFOLD + AL((size_t)2 * 16 * 1024 * 4);
constexpr size_t WS_LAM   = WS_ROPE + AL((size_t)2 * 64 * 16 * 4);
constexpr size_t WS_WRT   = WS_LAM + 256;
constexpr size_t WS_WTIN  = WS_WRT + AL((size_t)2 * 2 * 48 * 1024 * 2);
constexpr size_t WS_WTBR  = WS_WTIN + AL((size_t)2 * NCOL * 1024 * 2);
constexpr size_t WS_WTO   = WS_WTBR + AL((size_t)2 * 3072 * 512 * 2);
constexpr size_t WS_WTQKV = WS_WTO + AL((size_t)2 * 1024 * 1024 * 2);
constexpr size_t WS_WSB   = WS_WTQKV + AL((size_t)2 * 12 * 16384 * 2);
constexpr size_t WS_WTGU  = WS_WSB + AL((size_t)2 * 4 * 16384 * 2);
constexpr size_t WS_WTD   = WS_WTGU + AL((size_t)32 * 1024 * 1024 * 2);
constexpr size_t WS_XC    = WS_WTD + AL((size_t)32 * 1024 * 512 * 2);
constexpr size_t WS_H     = WS_XC + AL((size_t)4096 * 1024 * 4);
constexpr size_t WS_H8    = WS_H + AL((size_t)MTOT * 1024 * 2);
constexpr size_t WS_WTIN8 = WS_H8 + AL((size_t)MTOT * 1024);
constexpr size_t WS_EID   = WS_WTIN8 + AL((size_t)2 * 3072 * 1024);
constexpr size_t WS_WTK   = WS_EID + AL((size_t)MTOT * 8);
constexpr size_t WS_POS   = WS_WTK + AL((size_t)MTOT * 8);
constexpr size_t WS_WTS   = WS_POS + AL((size_t)MTOT * 8);
constexpr size_t WS_SRC   = WS_WTS + AL((size_t)SLOTS * 4);
constexpr size_t WS_P     = WS_SRC + AL((size_t)SLOTS * 4);
constexpr size_t S1B      = (size_t)MH * 512 * 2;
constexpr size_t P_KB = 0, P_VB = S1B, P_XMB = 2 * S1B, P_QB = 3 * S1B, P_UB = 4 * S1B, P_ZB = 5 * S1B, P_VGB = 6 * S1B;
constexpr size_t P_GB   = 7 * S1B;
constexpr size_t P_MQ   = P_GB + (size_t)3 * MH * 1024;
constexpr size_t P_MK   = P_MQ + S1B, P_MVT = P_MK + S1B, P_XCV = P_MVT + S1B;
constexpr size_t P_GATES = P_XCV + S1B;
constexpr size_t P_CLOC = P_GATES + AL((size_t)MH * 16 * 4);
constexpr size_t P_NLOC = P_CLOC + (size_t)64 * NJ * 16384 * 2;
constexpr size_t P_MST  = P_NLOC + AL((size_t)64 * NJ * 128 * 4);
constexpr size_t P_END  = P_MST + AL((size_t)64 * NJ * 4 * 4);
constexpr size_t P_XB   = 0;
constexpr size_t P_ACT  = (size_t)SLOTS * 1024;
constexpr size_t P_YS   = P_ACT + (size_t)SLOTS * 512;
constexpr size_t P_MOE_END = P_YS + (size_t)SLOTS * 1024 * 2;
constexpr float WSCALE8 = 635.0f, HSCALE8 = 10.5f, ASCALE8 = 16.0f;
constexpr size_t WS_END = WS_P + (P_END > P_MOE_END ? P_END : P_MOE_END);
constexpr int CW_EXPCNT = 0;
constexpr int CW_HIST = 32768;
constexpr int CW_BAR = 1024;

__device__ __forceinline__ unsigned cvtpk(float lo, float hi) { unsigned r; asm volatile("v_cvt_pk_bf16_f32 %0, %1, %2" : "=v"(r) : "v"(lo), "v"(hi)); return r; }
__device__ __forceinline__ float bf_lo(unsigned w) { return __uint_as_float(w << 16); }
__device__ __forceinline__ float bf_hi(unsigned w) { return __uint_as_float(w & 0xffff0000u); }
__device__ __forceinline__ float bf2f(bf16_t b) { return __uint_as_float(((unsigned)b) << 16); }
__device__ __forceinline__ bf16_t f2bf(float f) { unsigned u = __float_as_uint(f); u += 0x7FFFu + ((u >> 16) & 1u); return (bf16_t)(u >> 16); }
__device__ __forceinline__ float sigmoid_f(float x) { return __builtin_amdgcn_rcpf(1.0f + __builtin_amdgcn_exp2f(-x * LOG2E)); }
__device__ __forceinline__ float gelu_tanh_f(float x) { const float u = 0.7978845608028654f * (x + 0.044715f * x * x * x); return x * sigmoid_f(2.0f * u); }
__device__ __forceinline__ float silu_f(float x) { return x * sigmoid_f(x); }
__device__ __forceinline__ float logsigmoid_f(float x) { return fminf(x, 0.f) - 0.6931471805599453f * __builtin_amdgcn_logf(1.0f + __builtin_amdgcn_exp2f(-fabsf(x) * LOG2E)); }
__device__ __forceinline__ int crow(int r, int hi) { return (r & 3) + 8 * (r >> 2) + 4 * hi; }
__device__ __forceinline__ f32x16 mfma32(bf16x8 a, bf16x8 b, f32x16 c) { return __builtin_amdgcn_mfma_f32_32x32x16_bf16(a, b, c, 0, 0, 0); }
__device__ __forceinline__ float wave_sum(float v) { for (int o = 32; o >= 1; o >>= 1) v += __shfl_xor(v, o); return v; }
template <int CTRL, int ROWMASK> __device__ __forceinline__ float dpp_add(float v) {
    return v + __builtin_bit_cast(float, __builtin_amdgcn_update_dpp(0, __builtin_bit_cast(int, v), CTRL, ROWMASK, 0xf, true)); }
__device__ __forceinline__ float wave_sum63(float v) {
    v = dpp_add<0x111, 0xf>(v); v = dpp_add<0x112, 0xf>(v); v = dpp_add<0x114, 0xf>(v); v = dpp_add<0x118, 0xf>(v);
    v = dpp_add<0x142, 0xa>(v);
    v = dpp_add<0x143, 0xc>(v);
    return v; }
__device__ __forceinline__ float half_sum31(float v) {
    v = dpp_add<0x111, 0xf>(v); v = dpp_add<0x112, 0xf>(v); v = dpp_add<0x114, 0xf>(v); v = dpp_add<0x118, 0xf>(v);
    v = dpp_add<0x142, 0xa>(v); return v; }
__device__ __forceinline__ float wave_max(float v) { for (int o = 32; o >= 1; o >>= 1) v = fmaxf(v, __shfl_xor(v, o)); return v; }

__device__ __forceinline__ void unpack8(const u32x4 w, float (&o)[8]) { o[0] = bf_lo(w.x); o[1] = bf_hi(w.x); o[2] = bf_lo(w.y); o[3] = bf_hi(w.y); o[4] = bf_lo(w.z); o[5] = bf_hi(w.z); o[6] = bf_lo(w.w); o[7] = bf_hi(w.w); }
__device__ __forceinline__ u32x4 pack8(const float (&v)[8]) { u32x4 w; w.x = cvtpk(v[0], v[1]); w.y = cvtpk(v[2], v[3]); w.z = cvtpk(v[4], v[5]); w.w = cvtpk(v[6], v[7]); return w; }
__device__ __forceinline__ int ld_i32_dev(const int* p) { return __hip_atomic_load(p, __ATOMIC_RELAXED, __HIP_MEMORY_SCOPE_AGENT); }
__device__ __forceinline__ float ld_f32_dev(const float* p) { return __hip_atomic_load(p, __ATOMIC_RELAXED, __HIP_MEMORY_SCOPE_AGENT); }
__device__ __forceinline__ unsigned q8(float x) { return (unsigned)(int)fminf(fmaxf(rintf(x), -127.0f), 127.0f) & 0xffu; }
__device__ __forceinline__ unsigned pk4_fp8(float a, float b, float c, float d) { return q8(a) | (q8(b) << 8) | (q8(c) << 16) | (q8(d) << 24); }
#define LBAR() do { asm volatile("s_waitcnt lgkmcnt(0)" ::: "memory"); __builtin_amdgcn_s_barrier(); asm volatile("" ::: "memory"); } while (0)
__device__ __forceinline__ int opaque_tid() { int t = threadIdx.x; asm volatile("" : "+v"(t)); return t; }
#ifdef PROBE
__device__ __forceinline__ unsigned long long* probe_epi_counter() {
    unsigned char* ws = *(unsigned char* const __attribute__((address_space(4)))*)((const __attribute__((address_space(4))) char*)__builtin_amdgcn_kernarg_segment_ptr() + 256);
    const int ph = *(volatile LAS int*)(uintptr_t)(LDS_BYTES - 32);
    return (unsigned long long*)ws + 30100 + ph; }
#endif
#ifdef PROBE
#define PSEC_BEGIN() unsigned pt_ = 0; if (PROBE_SEC == 1) pt_ = (unsigned)__builtin_amdgcn_s_memrealtime()
#define PSEC_BEGINN(n) unsigned pt_ = 0; if (PROBE_SEC == (n)) pt_ = (unsigned)__builtin_amdgcn_s_memrealtime()
#define PSEC_BEGIN6() unsigned pt_ = 0; if (PROBE_SEC == 6) pt_ = (unsigned)__builtin_amdgcn_s_memrealtime()
#define PSEC_BEGIN8() unsigned pt_ = 0; if (PROBE_SEC == 8) pt_ = (unsigned)__builtin_amdgcn_s_memrealtime()
#define PSEC(id) do { if (PROBE_SEC == (id)) { const unsigned pn_ = (unsigned)__builtin_amdgcn_s_memrealtime(); if (blockIdx.x == PROBE_BLK && tid == 0) *probe_epi_counter() += (unsigned long long)(pn_ - pt_); } if (PROBE_SEC == (id) + 1) pt_ = (unsigned)__builtin_amdgcn_s_memrealtime(); } while (0)
#else
#define PSEC_BEGIN() do { } while (0)
#define PSEC_BEGIN6() do { } while (0)
#define PSEC_BEGINN(n) do { } while (0)
#define PSEC_BEGIN8() do { } while (0)
#define PSEC(id) do { } while (0)
#endif
struct Params {
    const float* in[31];
    float* out;
    unsigned char* ws;
    int ph_lo, ph_hi;
};
enum { I_X = 0, I_C, I_CTX, I_CCTX, I_WMOD, I_BMOD, I_GN1, I_GN2, I_WIN, I_DLAM, I_GSUBLN, I_WGS, I_BGS, I_GGV, I_WCONV, I_BCONV, I_WQKV, I_WIF, I_BIF,
       I_GMN, I_SKIP, I_WBR, I_WOUT, I_WRG, I_BRG, I_WRE, I_BRE, I_WEG, I_WEU, I_WED, I_GFIN };

struct RowInfo { int hf, r, isctx, b, t; };
__device__ __forceinline__ RowInfo row_info(int R) {
    RowInfo q; q.hf = R >= MH ? 1 : 0; q.r = R - q.hf * MH;
    if (q.r < CTXROWS) { q.isctx = 1; q.b = q.hf * HBAT + (q.r >> 8); q.t = q.r & 255; }
    else { q.isctx = 0; const int s = q.r - CTXROWS; q.b = q.hf * HBAT + (s >> 11); q.t = s & 2047; }
    return q;
}
#define XB_TMO      128
#define XB_XCNT(j)  (256  + 64 * (j))
#define XB_XSUB(j)  (1280 + 64 * (j))
#define XB_XGEN(j)  (2304 + 64 * (j))
#define XB_TOP      3328
#define XB_TOPGEN   3392
#define XCD_BAR_WORDS 3456
#define XB_SPIN_CAP (1u << 18)

__device__ __forceinline__ unsigned xb_ld(unsigned* p)              { return __hip_atomic_load(p, __ATOMIC_RELAXED, __HIP_MEMORY_SCOPE_AGENT); }
__device__ __forceinline__ unsigned xb_add(unsigned* p, unsigned v) { return __hip_atomic_fetch_add(p, v, __ATOMIC_RELAXED, __HIP_MEMORY_SCOPE_AGENT); }
__device__ __forceinline__ unsigned xb_xcc_id() { return (unsigned)__builtin_amdgcn_s_getreg((3 << 11) | 20) & 0xFu; }
#define XB_SPIN(cond, bar) do { unsigned _sp = 0; while (cond) { __builtin_amdgcn_s_sleep(1); \
    if ((++_sp & 255u) == 0u) { if (xb_ld(&(bar)[XB_TMO])) break; if (_sp > XB_SPIN_CAP) { atomicAdd(&(bar)[XB_TMO], 1u); break; } } } } while (0)

struct XcdBarrier {
    unsigned* bar; unsigned x;
    volatile LAS unsigned* st;
};

__device__ __forceinline__ XcdBarrier xcd_barrier_post(unsigned* bar, volatile LAS unsigned* st) {
    XcdBarrier b; b.bar = bar; b.x = xb_xcc_id(); b.st = st;
    if (threadIdx.x == 0) (void)xb_add(&bar[XB_XCNT(b.x)], 1u);
    return b;
}
__device__ __forceinline__ void xcd_barrier_complete(unsigned* bar, unsigned x, unsigned& nloc, unsigned& nx) {
    const unsigned G = gridDim.x * gridDim.y * gridDim.z;
    unsigned sum, cnt, mine, sp = 0u;
    for (;;) {
        sum = 0u; cnt = 0u; mine = 0u;
#pragma unroll
        for (unsigned j = 0; j < 16; ++j) { const unsigned c = xb_ld(&bar[XB_XCNT(j)]); sum += c; cnt += (c > 0u) ? 1u : 0u; mine = (j == x) ? c : mine; }
        if (sum == G) break;
        __builtin_amdgcn_s_sleep(1);
        if ((++sp & 255u) == 0u) { if (xb_ld(&bar[XB_TMO])) break; if (sp > XB_SPIN_CAP) { atomicAdd(&bar[XB_TMO], 1u); break; } }
    }
    nloc = mine > 0u ? mine : 1u; nx = cnt > 0u ? cnt : 1u;
}

__device__ __forceinline__ void xcd_barrier(const XcdBarrier& b) {
    asm volatile("s_waitcnt vmcnt(0)" ::: "memory");
    __syncthreads();
    if (threadIdx.x == 0) {
        unsigned* bar = b.bar;
        __builtin_amdgcn_s_waitcnt(0);
        unsigned nloc = b.st[0], nx = b.st[1];
        if (nloc == 0u) { xcd_barrier_complete(bar, b.x, nloc, nx); b.st[0] = nloc; b.st[1] = nx; }
        const unsigned old = xb_add(&bar[XB_XSUB(b.x)], 1u);
        const unsigned gen = old / nloc;
        if (old + 1u == (gen + 1u) * nloc) {
            __builtin_amdgcn_fence(__ATOMIC_RELEASE, "agent");
            asm volatile("s_waitcnt vmcnt(0)" ::: "memory");
            const unsigned og = xb_add(&bar[XB_TOP], 1u);
            const unsigned tg = og / nx;
            if (og + 1u == (tg + 1u) * nx) xb_add(&bar[XB_TOPGEN], 1u);
            else XB_SPIN(xb_ld(&bar[XB_TOPGEN]) == tg, bar);
            __builtin_amdgcn_fence(__ATOMIC_ACQUIRE, "agent");
            xb_add(&bar[XB_XGEN(b.x)], 1u);
            asm volatile("s_waitcnt vmcnt(0)" ::: "memory");
        } else {
            XB_SPIN(xb_ld(&bar[XB_XGEN(b.x)]) == gen, bar);
            __builtin_amdgcn_fence(__ATOMIC_ACQUIRE, "agent");
            asm volatile("s_waitcnt vmcnt(0)" ::: "memory");
        }
    }
    __syncthreads();
}
namespace pg8 {
#define PG8_LAS __attribute__((address_space(3)))
typedef unsigned short bf16_t;
typedef short bf16x8 __attribute__((ext_vector_type(8)));
typedef float f32x4 __attribute__((ext_vector_type(4)));
typedef unsigned u32x4 __attribute__((ext_vector_type(4)));
constexpr int BM = 256, BK = 64, HALF = 128, HTB = HALF * BK * 2  , STAGE_BYTES = 8 * HTB, NXCD = 8, WGM = 8;

__host__ __device__ __forceinline__ int lds_byte(int r, int c) { const int st = (r >> 4) * 2 + (c >> 5), rr = r & 15, cc = c & 31, ob = rr * 64 + cc * 2; return st * 1024 + (ob ^ (((ob >> 9) & 1) << 5)); }
__host__ __device__ __forceinline__ void stage_rc(int b, int& R, int& C) { const int st = b / 1024, sb = b % 1024, swz = sb ^ (((sb >> 9) & 1) << 5); R = (st >> 1) * 16 + swz / 64; C = (st & 1) * 32 + (swz % 64) / 2; }
__host__ __device__ __forceinline__ int perm32(int rho) { const int n = rho >> 4, i = rho & 15; return 8 * (i >> 2) + 4 * n + (i & 3); }

struct Unit { int pm, pn; };
struct Gemm { const bf16_t* A; const bf16_t* Bt; int M, N, K; };

struct StaticOrder {
    int nM, nN, nwg, G, c;
    __host__ __device__ void init(int M, int N, int G_, int c_) { nM = M / BM; nN = N / BM; nwg = nM * nN; G = G_; c = c_; }
    __host__ __device__ bool next(int i, Unit& u) const {
        const long L = (long)i * G + c; if (L >= nwg) return false;
        int wgid = (int)L; { const int q = nwg / NXCD, r = nwg % NXCD, xcd = wgid % NXCD, off = wgid / NXCD; wgid = (xcd < r ? xcd * (q + 1) : r * (q + 1) + (xcd - r) * q) + off; }
        const int nig = WGM * nN, gid = wgid / nig, fm = gid * WGM, gsz = (nM - fm) < WGM ? (nM - fm) : WGM;
        u.pm = fm + ((wgid % nig) % gsz); u.pn = (wgid % nig) / gsz; return true;
    }
    __device__ __forceinline__ void a_ready(const Unit&) const {}
    __device__ __forceinline__ void done(const Unit&) const {}
};
__device__ __forceinline__ unsigned cvt_pk_bf16(float lo, float hi) { unsigned r; asm volatile("v_cvt_pk_bf16_f32 %0, %1, %2" : "=v"(r) : "v"(lo), "v"(hi)); return r; }
typedef float f32x2 __attribute__((ext_vector_type(2)));
__device__ __forceinline__ f32x2 gelu_pk(f32x2 v) {
    const f32x2 av = __builtin_elementwise_abs(v), d = av * 0.2316418882f + 1.0f;
    f32x2 t; t.x = __builtin_amdgcn_rcpf(d.x); t.y = __builtin_amdgcn_rcpf(d.y);
    f32x2 q = t * 0.5307027145f + (-0.7265760135f); q = q * t + 0.7107068705f; q = q * t + (-0.142248368f); q = q * t + 0.127414796f; q = q * t;
    const f32x2 s = (v * v) * (-0.72134752044f);
    f32x2 e; e.x = __builtin_amdgcn_exp2f(s.x); e.y = __builtin_amdgcn_exp2f(s.y);
    const f32x2 m = v * (q * e), r = v - m;
    f32x2 o; o.x = v.x < 0.f ? m.x : r.x; o.y = v.y < 0.f ? m.y : r.y; return o;
}

typedef int pg8_i32x4 __attribute__((ext_vector_type(4)));
template <bool F8> struct Frag { bf16x8 k[2]; };
template <class Epi, class Sched, bool STAMP = false, bool F8 = false, bool GA = false>
__device__ __forceinline__ void gemm_phase(PG8_LAS unsigned char* lds, const Gemm g, const Sched& S, const Epi& E, unsigned long long* stamps) {
    int tid_o = threadIdx.x; asm volatile("" : "+v"(tid_o));
    const int tid = tid_o, wid = __builtin_amdgcn_readfirstlane(tid >> 6), lane = tid & 63, wr = wid >> 2, wc = wid & 3, fr = lane & 15, fq = lane >> 4;
    const int K = g.K, nt = K / BK;
    int ts_lo = 0, ts_hi = 0, nts = 0; const unsigned long long rt_entry = STAMP ? (unsigned long long)wall_clock64() : 0ull;
#define PG8_STAMP() do { if (STAMP && wid == 0 && nts < 64) { const unsigned long long _c = (unsigned long long)clock64(); \
        ts_lo = (lane == nts) ? (int)(unsigned)_c : ts_lo; ts_hi = (lane == nts) ? (int)(unsigned)(_c >> 32) : ts_hi; ++nts; } } while (0)
    PG8_STAMP();
    unsigned voffA[2], voffB[2];
#pragma unroll
    for (int i = 0; i < 2; ++i) { int R, C; stage_rc(tid * 16 + i * 8192, R, C); const int Rb = Epi::PERM ? ((R & ~31) + perm32(R & 31)) : R;
        voffA[i] = (unsigned)(R * K + C) * 2u; voffB[i] = (unsigned)(Rb * K + C) * 2u; }
    const size_t pstep = (size_t)64 * K * 2;
    const size_t kstep = (size_t)(BK * 2);
    const size_t hstep = (size_t)HALF * K * 2;
    const size_t tstep = 2 * hstep;
    const unsigned ldsw = (unsigned)wid * 1024u;
    const int aoff = lds_byte(wr * 64 + fr, fq * 8), boff = lds_byte(wc * 32 + fr, fq * 8);
#define PG8_SA(b, h) (((b) * 2 + (h)) * HTB)
#define PG8_SB(b, h) ((4 + (b) * 2 + (h)) * HTB)
#define PG8_STAGE(bufoff, gbase, voff) do { const char* _b0 = (const char*)(gbase); const char* _b1 = _b0 + pstep; asm volatile("" : "+s"(_b0), "+s"(_b1)); \
        __builtin_amdgcn_global_load_lds((const unsigned*)(_b0 + (voff)[0]), (PG8_LAS unsigned*)(lds + (bufoff) + ldsw), 16, 0, 0); \
        __builtin_amdgcn_global_load_lds((const unsigned*)(_b1 + (voff)[0]), (PG8_LAS unsigned*)(lds + (bufoff) + ldsw + 8192), 16, 0, 0); } while (0)
    unsigned gC[4] = {0u, 0u, 0u, 0u}, gN[4] = {0u, 0u, 0u, 0u}; int gR = 0, gCol = 0; stage_rc(tid * 16, gR, gCol);
#define PG8_GOFF(dst, ui_) do { _Pragma("unroll") for (int _j = 0; _j < 4; ++_j) dst[_j] = (unsigned)S.src_row((ui_), gR + 64 * _j) * (unsigned)(K * 2) + (unsigned)(gCol * 2); } while (0)
#define PG8_STAGE_G(bufoff, kptr, h, nx) do { const char* _b = (const char*)(kptr); asm volatile("" : "+s"(_b)); const unsigned _o0 = (nx) ? gN[2 * (h)] : gC[2 * (h)], _o1 = (nx) ? gN[2 * (h) + 1] : gC[2 * (h) + 1]; \
        __builtin_amdgcn_global_load_lds((const unsigned*)(_b + _o0), (PG8_LAS unsigned*)(lds + (bufoff) + ldsw), 16, 0, 0); \
        __builtin_amdgcn_global_load_lds((const unsigned*)(_b + _o1), (PG8_LAS unsigned*)(lds + (bufoff) + ldsw + 8192), 16, 0, 0); } while (0)
#define PG8_LDF(dstf, addr) do { (dstf).k[0] = *(const PG8_LAS bf16x8*)(addr); (dstf).k[1] = *(const PG8_LAS bf16x8*)((addr) + 1024); } while (0)
#define PG8_LDA(dst, b, h) do { _Pragma("unroll") for (int m = 0; m < 4; ++m) PG8_LDF(dst[m], lds + PG8_SA(b, h) + aoff + m * 2048); } while (0)
#define PG8_LDB(dst, b, h) do { _Pragma("unroll") for (int n = 0; n < 2; ++n) PG8_LDF(dst[n], lds + PG8_SB(b, h) + boff + n * 2048); } while (0)
#define PG8_MMA(ai, bj, At, Bt) do { __builtin_amdgcn_s_setprio(1); _Pragma("unroll") for (int m = 0; m < 4; ++m) _Pragma("unroll") for (int n = 0; n < 2; ++n) _Pragma("unroll") for (int k = 0; k < 2; ++k) { \
        if constexpr (F8) acc[ai][bj][m][n] = __builtin_bit_cast(f32x4, __builtin_amdgcn_mfma_i32_16x16x64_i8(__builtin_bit_cast(pg8_i32x4, Bt[n].k[k]), __builtin_bit_cast(pg8_i32x4, At[m].k[k]), __builtin_bit_cast(pg8_i32x4, acc[ai][bj][m][n]), 0, 0, 0)); \
        else acc[ai][bj][m][n] = __builtin_amdgcn_mfma_f32_16x16x32_bf16(Bt[n].k[k], At[m].k[k], acc[ai][bj][m][n], 0, 0, 0); } \
        __builtin_amdgcn_s_setprio(0); } while (0)
#define PG8_WAIT_V(n) asm volatile("s_waitcnt vmcnt(" #n ")" ::: "memory")
#define PG8_WAIT_L(n) asm volatile("s_waitcnt lgkmcnt(" #n ")" ::: "memory")
#define PG8_BAR __builtin_amdgcn_s_barrier()
#define PG8_SCHED __builtin_amdgcn_sched_barrier(0)
    Unit cur, nxt; int ui = 0;
    if (!S.next(0, cur)) return;
    f32x4 acc[2][2][4][2];
#pragma unroll
    for (int a = 0; a < 2; ++a)
#pragma unroll
        for (int b = 0; b < 2; ++b)
#pragma unroll
            for (int m = 0; m < 4; ++m)
#pragma unroll
                for (int n = 0; n < 2; ++n) acc[a][b][m][n] = (f32x4){0.f, 0.f, 0.f, 0.f};
    Frag<F8> At[4], B0[2], B1[2];
    const char* cA = (const char*)g.A + (size_t)cur.pm * tstep; const char* cB = (const char*)g.Bt + (size_t)cur.pn * tstep;
    S.a_ready(cur);
    const char* A0 = (const char*)g.A; if constexpr (GA) PG8_GOFF(gC, 0);
    PG8_STAGE(PG8_SB(0, 0), cB, voffB); if constexpr (GA) PG8_STAGE_G(PG8_SA(0, 0), A0, 0, false); else PG8_STAGE(PG8_SA(0, 0), cA, voffA);
    PG8_STAGE(PG8_SB(0, 1), cB + hstep, voffB); if constexpr (GA) PG8_STAGE_G(PG8_SA(0, 1), A0, 1, false); else PG8_STAGE(PG8_SA(0, 1), cA + hstep, voffA);
    if (wr == 1) PG8_BAR;
    PG8_WAIT_V(4); PG8_BAR;
    PG8_STAGE(PG8_SB(1, 0), cB + kstep, voffB); if constexpr (GA) PG8_STAGE_G(PG8_SA(1, 0), A0 + kstep, 0, false); else PG8_STAGE(PG8_SA(1, 0), cA + kstep, voffA);
    PG8_STAGE(PG8_SB(1, 1), cB + hstep + kstep, voffB);
    PG8_WAIT_V(6); PG8_BAR;
    PG8_STAMP();
    for (;;) {
        const bool has_next = S.next(ui + 1, nxt);
        const char* nA = has_next ? (const char*)g.A + (size_t)nxt.pm * tstep : cA; const char* nB = has_next ? (const char*)g.Bt + (size_t)nxt.pn * tstep : cB;
        if constexpr (GA) { if (has_next) PG8_GOFF(gN, ui + 1); else { gN[0] = gC[0]; gN[1] = gC[1]; gN[2] = gC[2]; gN[3] = gC[3]; } }
        for (int t = 0; t < nt; t += 2) {
            const bool last = (t == nt - 2);
            const char* a1 = cA + (size_t)(t + 1) * kstep;
            const char* a2 = last ? nA : cA + (size_t)(t + 2) * kstep; const char* b2 = last ? nB : cB + (size_t)(t + 2) * kstep;
            const char* a3 = a2 + kstep; const char* b3 = b2 + kstep;
            const char* kA1 = A0 + (size_t)(t + 1) * kstep; const char* kA2 = last ? A0 : A0 + (size_t)(t + 2) * kstep; const char* kA3 = kA2 + kstep;
            if (last && has_next) S.a_ready(nxt);
            PG8_LDB(B0, 0, 0); PG8_SCHED; PG8_LDA(At, 0, 0); if constexpr (GA) PG8_STAGE_G(PG8_SA(1, 1), kA1, 1, false); else PG8_STAGE(PG8_SA(1, 1), a1 + hstep, voffA);
            PG8_WAIT_L(8); PG8_BAR; PG8_WAIT_L(0); PG8_MMA(0, 0, At, B0); PG8_BAR; PG8_SCHED;
            PG8_LDB(B1, 0, 1); PG8_STAGE(PG8_SB(0, 0), b2, voffB);
            PG8_BAR; PG8_WAIT_L(0); PG8_MMA(0, 1, At, B1); PG8_BAR;
            PG8_LDA(At, 0, 1); if constexpr (GA) PG8_STAGE_G(PG8_SA(0, 0), kA2, 0, last); else PG8_STAGE(PG8_SA(0, 0), a2, voffA);
            PG8_BAR; PG8_WAIT_L(0); PG8_MMA(1, 0, At, B0); PG8_BAR; PG8_SCHED;
            PG8_STAGE(PG8_SB(0, 1), b2 + hstep, voffB);
            PG8_WAIT_V(6); PG8_BAR; PG8_MMA(1, 1, At, B1); PG8_BAR;
            PG8_LDB(B0, 1, 0); PG8_SCHED; PG8_LDA(At, 1, 0); if constexpr (GA) PG8_STAGE_G(PG8_SA(0, 1), kA2, 1, last); else PG8_STAGE(PG8_SA(0, 1), a2 + hstep, voffA);
            PG8_WAIT_L(8); PG8_BAR; PG8_WAIT_L(0); PG8_MMA(0, 0, At, B0); PG8_BAR; PG8_SCHED;
            PG8_LDB(B1, 1, 1); PG8_STAGE(PG8_SB(1, 0), b3, voffB);
            PG8_BAR; PG8_WAIT_L(0); PG8_MMA(0, 1, At, B1); PG8_BAR;
            PG8_LDA(At, 1, 1); if constexpr (GA) PG8_STAGE_G(PG8_SA(1, 0), kA3, 0, last); else PG8_STAGE(PG8_SA(1, 0), a3, voffA);
            PG8_BAR; PG8_WAIT_L(0); PG8_MMA(1, 0, At, B0); PG8_BAR; PG8_SCHED;
            PG8_STAGE(PG8_SB(1, 1), b3 + hstep, voffB);
            PG8_WAIT_V(6); PG8_BAR; PG8_MMA(1, 1, At, B1); PG8_BAR;
        }
        PG8_STAMP();
#ifdef PROBE_EPI
        const unsigned long long te0_ = __builtin_amdgcn_s_memrealtime();
#endif
        const bool keep_acc = E(acc, cur, wr, wc, fr, fq); S.done(cur);
#ifdef PROBE_EPI
        if (blockIdx.x == 0 && tid == 0) { unsigned long long* ec_ = probe_epi_counter(); *ec_ += __builtin_amdgcn_s_memrealtime() - te0_; }
#endif
        PG8_STAMP();
        if (!has_next) break;
        if (!keep_acc)
#pragma unroll
        for (int a = 0; a < 2; ++a)
#pragma unroll
            for (int b = 0; b < 2; ++b)
#pragma unroll
                for (int m = 0; m < 4; ++m)
#pragma unroll
                    for (int n = 0; n < 2; ++n) acc[a][b][m][n] = (f32x4){0.f, 0.f, 0.f, 0.f};
        cur = nxt; cA = nA; cB = nB; ++ui;
        if constexpr (GA) { gC[0] = gN[0]; gC[1] = gN[1]; gC[2] = gN[2]; gC[3] = gN[3]; }
    }
    PG8_WAIT_V(0);
    if (wr == 0) PG8_BAR;
    PG8_BAR;
    PG8_STAMP();
    if (STAMP && wid == 0) { stamps[lane] = lane < nts ? (((unsigned long long)(unsigned)ts_hi << 32) | (unsigned)ts_lo) : 0ull;
        if (lane == 62) stamps[62] = rt_entry; if (lane == 63) stamps[63] = (unsigned long long)wall_clock64(); }
#undef PG8_STAMP
#undef PG8_SA
#undef PG8_SB
#undef PG8_STAGE
#undef PG8_STAGE_G
#undef PG8_GOFF
#undef PG8_LDA
#undef PG8_LDF
#undef PG8_LDB
#undef PG8_MMA
#undef PG8_WAIT_V
#undef PG8_WAIT_L
#undef PG8_BAR
#undef PG8_SCHED
}
}
struct RectOrder {
    pg8::StaticOrder so; int offA, nwgA, nMb, nNb, offB, nwgB, G, c;
    __device__ void init(int nMa, int nNa, int offA_, int nMb_, int nNb_, int offB_, int G_, int c_) {
        so.init(nMa * 256, nNa * 256, G_, c_); offA = offA_; nwgA = nMa * nNa; nMb = nMb_; nNb = nNb_; offB = offB_; nwgB = nMb_ * nNb_; G = G_; c = c_; }
    __device__ bool next(int i, pg8::Unit& u) const {
        const int L = i * G + c;
        if (L < nwgA) { so.next(i, u); u.pm += offA; return true; }
        const int Lb = L - nwgA; if (Lb >= nwgB) return false;
        u.pm = offB + Lb % nMb; u.pn = Lb / nMb; return true;
    }
    __device__ __forceinline__ void a_ready(const pg8::Unit&) const {}
    __device__ __forceinline__ void done(const pg8::Unit&) const {}
};
struct MergeOrder {
    pg8::StaticOrder so; int off, G, c;
    __device__ void init(int nM, int off_, int G_, int c_) { so.init(nM * 256, 1024, G_, c_); off = off_; G = G_; c = c_; }
    __device__ bool next(int i, pg8::Unit& u) const {
        const int ti = i / 3, br = i - ti * 3;
        if (!so.next(ti, u)) return false;
        u.pm += off + br * (MH / 256); u.pn += br * 4; return true;
    }
    __device__ __forceinline__ void a_ready(const pg8::Unit&) const {}
    __device__ __forceinline__ void done(const pg8::Unit&) const {}
};
struct MoeOrder {
    const LAS int* srcl = nullptr;
    __device__ __forceinline__ int src_row(int i, int r) const { return srcl[i * 256 + r]; }
    int e0, e1, e2, e3, e4, e5, ntiles, G, c;
    __device__ __forceinline__ void unit_of(int i, int& pm, int& pn) const {
        if ((G & 31) == 0) { const int j = c >> 3; pm = i * (G >> 2) + (c & 7) * (G >> 5) + (j >> 2); pn = j & 3; }
        else { const int L = i * G + c; pm = L >> 2; pn = L & 3; } }
    __device__ __forceinline__ int look(const LAS int* tile_e, int i) const { int pm, pn; unit_of(i, pm, pn); return __builtin_amdgcn_readfirstlane(pm < ntiles ? tile_e[pm] : 0); }
    __device__ __forceinline__ void init(const LAS int* tile_e, int nt, int G_, int c_) { ntiles = nt; G = G_; c = c_;
        e0 = look(tile_e, 0); e1 = look(tile_e, 1); e2 = look(tile_e, 2); e3 = look(tile_e, 3); e4 = look(tile_e, 4); e5 = look(tile_e, 5); }
    __device__ __forceinline__ bool next(int i, pg8::Unit& u) const {
        int pm, pn; unit_of(i, pm, pn); if (pm >= ntiles || i >= 6) return false;
        const int e = i == 0 ? e0 : i == 1 ? e1 : i == 2 ? e2 : i == 3 ? e3 : i == 4 ? e4 : e5;
        u.pm = pm; u.pn = e * 4 + pn; return true;
    }
    __device__ __forceinline__ void a_ready(const pg8::Unit&) const {}
    __device__ __forceinline__ void done(const pg8::Unit&) const {}
};

struct EpiIn {
    static constexpr bool PERM = true, AFTER_DRAIN = false;
    bf16_t* P; bf16_t* GB; const float* cosT; const float* sinT;
    __device__ __forceinline__ bool operator()(pg8::f32x4 (&acc)[2][2][4][2], const pg8::Unit& u, int wr, int wc, int fr, int fq) const {
        const int pn = u.pn, rbase = u.pm * 256 + wr * 64 + fr;
        int act, ld; bf16_t* dst; int cb; bool rope = false; float scl = 1.0f;
        if (pn < 14) {
            const int kind = pn >> 1;
            const int bufidx = kind == 5 ? 6 : (kind == 6 ? 5 : kind);
            dst = P + (size_t)bufidx * ((size_t)MH * 512); ld = 512; cb = (pn & 1) * 256 + wc * 32 + 8 * fq;
            act = (kind == 4 || kind == 5) ? 1 : (kind == 6 ? 2 : 0);
            rope = (kind == 0 || kind == 3) && (u.pm >= 8);
            if (kind == 3) scl = QSCALE;
        } else {
            const int gi = (pn - 14) >> 2, pnl = (pn - 14) & 3, tid = (wr * 4 + wc) * 64 + fq * 16 + fr;
            u32x2* gdst = (u32x2*)GB + ((size_t)((gi * (MH / 256) + u.pm) * 4 + pnl) * 16) * 512 + tid;
#pragma unroll
            for (int ai = 0; ai < 2; ++ai)
#pragma unroll
                for (int m = 0; m < 4; ++m)
#pragma unroll
                    for (int bj = 0; bj < 2; ++bj) { unsigned q[8];
#pragma unroll
                        for (int j = 0; j < 4; ++j) { q[j] = (unsigned)fminf(fmaxf(sigmoid_f(acc[ai][bj][m][0][j]) * 255.0f + 0.5f, 1.0f), 255.0f); q[4 + j] = (unsigned)fminf(fmaxf(sigmoid_f(acc[ai][bj][m][1][j]) * 255.0f + 0.5f, 1.0f), 255.0f); }
                        u32x2 w; w.x = q[0] | (q[1] << 8) | (q[2] << 16) | (q[3] << 24); w.y = q[4] | (q[5] << 8) | (q[6] << 16) | (q[7] << 24);
                        gdst[(size_t)((ai * 4 + m) * 2 + bj) * 512] = w; }
            return false;
        }
        pg8::f32x4 csv[8], snv[8];
#pragma unroll
        for (int i = 0; i < 8; ++i) { csv[i] = (pg8::f32x4){1.f, 1.f, 1.f, 1.f}; snv[i] = (pg8::f32x4){0.f, 0.f, 0.f, 0.f}; }
        if (rope) {
#pragma unroll
            for (int i = 0; i < 8; ++i) { const int row = rbase + (i >> 2) * 128 + (i & 3) * 16; const int t = (row - CTXROWS) & 2047; const int pos = (wc & 1) ? (t & 63) : (t >> 6);
                csv[i] = *(const pg8::f32x4*)(cosT + pos * 16 + 4 * fq); snv[i] = *(const pg8::f32x4*)(sinT + pos * 16 + 4 * fq); } }
#pragma unroll
        for (int ai = 0; ai < 2; ++ai)
#pragma unroll
            for (int m = 0; m < 4; ++m) {
                const int row = rbase + ai * 128 + m * 16;
                const pg8::f32x4 cs = csv[ai * 4 + m], sn = snv[ai * 4 + m];
                bf16_t* rowp = dst + (size_t)row * ld + cb;
#pragma unroll
                for (int bj = 0; bj < 2; ++bj) {
                    pg8::f32x4 v0 = acc[ai][bj][m][0], v1 = acc[ai][bj][m][1];
                    if (rope) { const pg8::f32x4 o0 = v0 * cs - v1 * sn, o1 = v0 * sn + v1 * cs; v0 = o0; v1 = o1; }
                    v0 *= scl; v1 *= scl;
                    if (act == 1) {
#pragma unroll
                        for (int j = 0; j < 4; ++j) { v0[j] = gelu_tanh_f(v0[j]); v1[j] = gelu_tanh_f(v1[j]); } }
                    else if (act == 2) {
#pragma unroll
                        for (int j = 0; j < 4; ++j) { v0[j] = fmaxf(sigmoid_f(v0[j]), 1e-6f); v1[j] = fmaxf(sigmoid_f(v1[j]), 1e-6f); } }
                    u32x4 w; w.x = cvtpk(v0[0], v0[1]); w.y = cvtpk(v0[2], v0[3]); w.z = cvtpk(v1[0], v1[1]); w.w = cvtpk(v1[2], v1[3]);
                    *(u32x4*)(rowp + bj * 128) = w;
                }
            }
        return false;
    }
};
struct EpiGate8 {
    static constexpr bool PERM = true, AFTER_DRAIN = false;
    bf16_t* GB;
    __device__ __forceinline__ bool operator()(pg8::f32x4 (&acc)[2][2][4][2], const pg8::Unit& u, int wr, int wc, int fr, int fq) const {
        const int gi = u.pn >> 2, pnl = u.pn & 3, tid = (wr * 4 + wc) * 64 + fq * 16 + fr; const float sc = 1.0f / (HSCALE8 * WSCALE8);
        u32x2* gdst = (u32x2*)GB + ((size_t)((gi * (MH / 256) + u.pm) * 4 + pnl) * 16) * 512 + tid;
#pragma unroll
        for (int ai = 0; ai < 2; ++ai)
#pragma unroll
            for (int m = 0; m < 4; ++m)
#pragma unroll
                for (int bj = 0; bj < 2; ++bj) { unsigned q[8];
#pragma unroll
                    for (int j = 0; j < 4; ++j) { q[j] = (unsigned)fminf(fmaxf(sigmoid_f((float)__float_as_int(acc[ai][bj][m][0][j]) * sc) * 255.0f + 0.5f, 1.0f), 255.0f);
                        q[4 + j] = (unsigned)fminf(fmaxf(sigmoid_f((float)__float_as_int(acc[ai][bj][m][1][j]) * sc) * 255.0f + 0.5f, 1.0f), 255.0f); }
                    u32x2 w; w.x = q[0] | (q[1] << 8) | (q[2] << 16) | (q[3] << 24); w.y = q[4] | (q[5] << 8) | (q[6] << 16) | (q[7] << 24);
                    gdst[(size_t)((ai * 4 + m) * 2 + bj) * 512] = w; }
        return false;
    }
};
struct EpiMerge {
    static constexpr bool PERM = true, AFTER_DRAIN = false;
    const bf16_t* GB; bf16_t* OUT;
    __device__ __forceinline__ bool operator()(pg8::f32x4 (&acc)[2][2][4][2], const pg8::Unit& u, int wr, int wc, int fr, int fq) const {
        const int br = u.pn >> 2, pn = u.pn & 3, pm = u.pm - br * (MH / 256), tid = (wr * 4 + wc) * 64 + fq * 16 + fr;
        const int rbase = pm * 256 + wr * 64 + fr, cb = pn * 256 + wc * 32 + 8 * fq;
        const u32x2* g0 = (const u32x2*)GB + ((size_t)((br * (MH / 256) + pm) * 4 + pn) * 16) * 512 + tid;
        const u32x2* g1 = g0 + (size_t)(MH / 256) * 4 * 16 * 512;
        u32x2 ga_[16], gb_[16];
#pragma unroll
        for (int s = 0; s < 16; ++s) { ga_[s] = g0[(size_t)s * 512]; gb_[s] = (br < 2) ? g1[(size_t)s * 512] : (u32x2){0x01010101u, 0x01010101u}; }
#pragma unroll
        for (int ai = 0; ai < 2; ++ai)
#pragma unroll
            for (int m = 0; m < 4; ++m) {
                const size_t off = (size_t)(rbase + ai * 128 + m * 16) * 1024 + cb;
#pragma unroll
                for (int bj = 0; bj < 2; ++bj) {
                    const int slot = (ai * 4 + m) * 2 + bj;
                    const u32x2 a = ga_[slot], b = gb_[slot];
                    float ga[8];
#pragma unroll
                    for (int j = 0; j < 4; ++j) { ga[j] = (float)((a.x >> (8 * j)) & 0xffu); ga[4 + j] = (float)((a.y >> (8 * j)) & 0xffu); }
                    if (br < 2) {
#pragma unroll
                        for (int j = 0; j < 4; ++j) { ga[j] *= __builtin_amdgcn_rcpf((float)((b.x >> (8 * j)) & 0xffu)); ga[4 + j] *= __builtin_amdgcn_rcpf((float)((b.y >> (8 * j)) & 0xffu)); }
                    } else {
#pragma unroll
                        for (int j = 0; j < 8; ++j) ga[j] *= (1.0f / 255.0f);
                    }
                    pg8::f32x4 v0 = acc[ai][bj][m][0], v1 = acc[ai][bj][m][1];
#pragma unroll
                    for (int j = 0; j < 4; ++j) { v0[j] *= ga[j]; v1[j] *= ga[4 + j]; }
                    if (br < 2) { acc[ai][bj][m][0] = v0; acc[ai][bj][m][1] = v1; }
                    else { u32x4 w; w.x = cvtpk(v0[0], v0[1]); w.y = cvtpk(v0[2], v0[3]); w.z = cvtpk(v1[0], v1[1]); w.w = cvtpk(v1[2], v1[3]);
                        *(u32x4*)(OUT + off + bj * 128) = w; }
                }
            }
        return br < 2;
    }
};
struct EpiOut {
    static constexpr bool PERM = false, AFTER_DRAIN = false;
    const float* xres_lat; const float* xres_ctx; float* xs_lat; float* xs_ctx; const float* mod; int hf;
    __device__ __forceinline__ bool operator()(pg8::f32x4 (&acc)[2][2][4][2], const pg8::Unit& u, int wr, int wc, int fr, int fq) const {
        const int pm = u.pm; const float* src; float* dst; int b;
        if (pm < 8) { b = 16; const size_t o = (size_t)((hf * HBAT + pm) * 256) * 1024; src = xres_ctx + o; dst = xs_ctx + o; }
        else { const int q = pm - 8; b = hf * HBAT + (q >> 3); const size_t o = ((size_t)b * 2048 + (size_t)(q & 7) * 256) * 1024; src = xres_lat + o; dst = xs_lat + o; }
        const int col0 = u.pn * 256 + wc * 32 + 4 * fq;
        const float* mrow = mod + (size_t)b * 6144 + 2 * 1024 + col0;
        pg8::f32x4 mv[2][2];
#pragma unroll
        for (int bj = 0; bj < 2; ++bj)
#pragma unroll
            for (int n = 0; n < 2; ++n) mv[bj][n] = *(const pg8::f32x4*)(mrow + bj * 128 + n * 16);
#pragma unroll
        for (int ai = 0; ai < 2; ++ai) {
            pg8::f32x4 xr[4][2][2];
#pragma unroll
            for (int m = 0; m < 4; ++m) { const size_t off = (size_t)(wr * 64 + fr + ai * 128 + m * 16) * 1024 + col0;
#pragma unroll
                for (int bj = 0; bj < 2; ++bj)
#pragma unroll
                    for (int n = 0; n < 2; ++n) xr[m][bj][n] = *(const pg8::f32x4*)(src + off + bj * 128 + n * 16); }
#pragma unroll
            for (int m = 0; m < 4; ++m) { const size_t off = (size_t)(wr * 64 + fr + ai * 128 + m * 16) * 1024 + col0;
#pragma unroll
                for (int bj = 0; bj < 2; ++bj)
#pragma unroll
                    for (int n = 0; n < 2; ++n) *(pg8::f32x4*)(dst + off + bj * 128 + n * 16) = xr[m][bj][n] + mv[bj][n] * acc[ai][bj][m][n]; }
            asm volatile("" ::: "memory");
        }
        return false;
    }
};
struct EpiGU {
    static constexpr bool PERM = true, AFTER_DRAIN = false;
    unsigned char* ACT;
    __device__ __forceinline__ bool operator()(pg8::f32x4 (&acc)[2][2][4][2], const pg8::Unit& u, int wr, int wc, int fr, int fq) const {
        const int rbase = u.pm * 256 + wr * 64 + fr, cb = (u.pn & 3) * 128 + wc * 32 + 8 * fq;
        const float sc = 1.0f / (HSCALE8 * WSCALE8);
#pragma unroll
        for (int ai = 0; ai < 2; ++ai)
#pragma unroll
            for (int m = 0; m < 4; ++m) {
                float o[8];
#pragma unroll
                for (int n = 0; n < 2; ++n)
#pragma unroll
                    for (int j = 0; j < 4; ++j) o[4 * n + j] = silu_f((float)__float_as_int(acc[ai][0][m][n][j]) * sc) * ((float)__float_as_int(acc[ai][1][m][n][j]) * (sc * ASCALE8));
                u32x2 w; w.x = pk4_fp8(o[0], o[1], o[2], o[3]); w.y = pk4_fp8(o[4], o[5], o[6], o[7]);
                *(u32x2*)(ACT + (size_t)(rbase + ai * 128 + m * 16) * 512 + cb) = w;
            }
        return false;
    }
};
struct EpiDown {
    static constexpr bool PERM = true, AFTER_DRAIN = false;
    bf16_t* YS;
    __device__ __forceinline__ bool operator()(pg8::f32x4 (&acc)[2][2][4][2], const pg8::Unit& u, int wr, int wc, int fr, int fq) const {
        const int rbase = u.pm * 256 + wr * 64 + fr, cb = (u.pn & 3) * 256 + wc * 32 + 8 * fq;
#pragma unroll
        for (int ai = 0; ai < 2; ++ai)
#pragma unroll
            for (int m = 0; m < 4; ++m) {
                const int row = rbase + ai * 128 + m * 16;
#pragma unroll
                for (int bj = 0; bj < 2; ++bj) { const float s8 = 1.0f / (ASCALE8 * WSCALE8); u32x4 w;
                    w.x = cvtpk((float)__float_as_int(acc[ai][bj][m][0][0]) * s8, (float)__float_as_int(acc[ai][bj][m][0][1]) * s8); w.y = cvtpk((float)__float_as_int(acc[ai][bj][m][0][2]) * s8, (float)__float_as_int(acc[ai][bj][m][0][3]) * s8);
                    w.z = cvtpk((float)__float_as_int(acc[ai][bj][m][1][0]) * s8, (float)__float_as_int(acc[ai][bj][m][1][1]) * s8); w.w = cvtpk((float)__float_as_int(acc[ai][bj][m][1][2]) * s8, (float)__float_as_int(acc[ai][bj][m][1][3]) * s8);
                    *(u32x4*)(YS + (size_t)row * 1024 + cb + bj * 128) = w; }
            }
        return false;
    }
};
template <class ColMap>
__device__ __forceinline__ void cvt_tile_T(const float* __restrict__ src, int ldsrc, bf16_t* __restrict__ dst, int K, int k0, int n0, const ColMap& cm, float scale, LAS float* tile) {
    const int tid = opaque_tid();
    {
        const int n = tid & 63, kb = tid >> 6; const int sc = cm(n0 + n);
#pragma unroll
        for (int i = 0; i < 8; ++i) { const int k = kb + 8 * i; tile[k * 65 + n] = src[(size_t)(k0 + k) * ldsrc + sc] * scale; }
    }
    __syncthreads();
    {
        const int kp = (tid & 31) * 2, nb = tid >> 5;
#pragma unroll
        for (int i = 0; i < 4; ++i) { const int n = nb + 16 * i; *(unsigned*)(dst + (size_t)(n0 + n) * K + k0 + kp) = cvtpk(tile[kp * 65 + n], tile[(kp + 1) * 65 + n]); }
    }
    __syncthreads();
}
struct CmIdent { int off; __device__ __forceinline__ int operator()(int n) const { return n + off; } };
struct CmWin {
    __device__ __forceinline__ int operator()(int n) const {
        if (n < 512 || (n >= 1536 && n < 2048)) { const int c = n & 31, f = c >> 3, j = c & 7; return (n & ~31) + ((j < 4) ? (4 * f + j) : (16 + 4 * f + (j - 4))); }
        return n; }
};
struct CmGU {
    __device__ __forceinline__ int operator()(int n) const { return 128 * (n >> 8) + (n & 127); }
};

template <int MODE, bool OUT8 = false>
__device__ __forceinline__ void cvt_tile_T256(const float* __restrict__ baseA, const float* __restrict__ baseB, int ldsrc, void* __restrict__ dstv, int K, int k0, int n0, float scale, LAS float* tile) {
    const int tid = opaque_tid();
    {
        const int n = tid & 255, kb = tid >> 8, ng = n0 + n;
        const float* sp = (MODE == 2 ? ((ng & 128) ? baseB : baseA) + 128 * (ng >> 8) + (ng & 127) : MODE == 1 ? baseA + CmWin{}(ng) : baseA + ng) + (size_t)(k0 + kb) * ldsrc;
        float v[32];
#pragma unroll
        for (int i = 0; i < 32; ++i) v[i] = sp[(size_t)(2 * i) * ldsrc];
#pragma unroll
        for (int i = 0; i < 32; ++i) tile[(kb + 2 * i) * 257 + n] = v[i] * scale;
    }
    __syncthreads();
    {
        const int n = tid >> 1, kh = (tid & 1) * 32;
        if constexpr (OUT8) { unsigned char* dp = (unsigned char*)dstv + (size_t)(n0 + n) * K + k0 + kh;
#pragma unroll
            for (int i = 0; i < 2; ++i) { float f[16];
#pragma unroll
                for (int j = 0; j < 16; ++j) f[j] = tile[(kh + 16 * i + j) * 257 + n];
                u32x4 w; w.x = pk4_fp8(f[0], f[1], f[2], f[3]); w.y = pk4_fp8(f[4], f[5], f[6], f[7]); w.z = pk4_fp8(f[8], f[9], f[10], f[11]); w.w = pk4_fp8(f[12], f[13], f[14], f[15]);
                *(u32x4*)(dp + 16 * i) = w; } }
        else { bf16_t* dp = (bf16_t*)dstv + (size_t)(n0 + n) * K + k0 + kh;
#pragma unroll
            for (int i = 0; i < 4; ++i) { float f[8];
#pragma unroll
                for (int j = 0; j < 8; ++j) f[j] = tile[(kh + 8 * i + j) * 257 + n];
                *(u32x4*)(dp + 8 * i) = pack8(f); } }
    }
    __syncthreads();
}

__device__ __forceinline__ void phase_prologue(const Params& p, LAS unsigned char* lds) {
    LAS float* tile = (LAS float*)lds;
    const int tid = opaque_tid(), G = gridDim.x, bid = blockIdx.x;
    unsigned char* ws = p.ws;
    for (int u = bid; u < 1248; u += G) {
        if (u < 448) { const int l = u / 224, r = u % 224, kt = r / 14, nt = r % 14;
            cvt_tile_T256<1>(p.in[I_WIN] + (size_t)l * 1024 * NCOL, nullptr, NCOL, (bf16_t*)(ws + WS_WTIN) + (size_t)l * NCOL * 1024, 1024, kt * 64, nt * 256, 1.0f, tile); }
        else if (u < 832) { const int v = u - 448, l = v / 192, r = v % 192, kt = r / 12, nt = r % 12;
            cvt_tile_T256<0, true>(p.in[I_WIN] + (size_t)l * 1024 * NCOL + 3584, nullptr, NCOL, ws + WS_WTIN8 + (size_t)l * 3072 * 1024, 1024, kt * 64, nt * 256, WSCALE8, tile); }
        else if (u < 1024) { const int v = u - 832, li = v / 32, r = v % 32, kt = r / 4, nt = r % 4;
            cvt_tile_T256<0>(p.in[I_WBR] + (size_t)li * 512 * 1024, nullptr, 1024, (bf16_t*)(ws + WS_WTBR) + (size_t)li * 1024 * 512, 512, kt * 64, nt * 256, 1.0f, tile); }
        else if (u < 1152) { const int v = u - 1024, l = v / 64, r = v % 64, kt = r / 4, nt = r % 4;
            cvt_tile_T256<0>(p.in[I_WOUT] + (size_t)l * 1024 * 1024, nullptr, 1024, (bf16_t*)(ws + WS_WTO) + (size_t)l * 1024 * 1024, 1024, kt * 64, nt * 256, 1.0f, tile); }
        else { const int v = u - 1152, m = v / 4, r = v % 4, kt = r >> 1, nt = r & 1;
            const int j = (m >> 2) % 3;
            cvt_tile_T(p.in[I_WQKV] + (size_t)m * 16384, 128, (bf16_t*)(ws + WS_WTQKV) + (size_t)m * 16384, 128, kt * 64, nt * 64, CmIdent{0}, j == 1 ? 0.08838834764831845f : 1.0f, tile); }
    }
    const int gt = bid * NTHR + tid, gn = G * NTHR;
    for (int i = gt; i < 2 * 4 * 16384; i += gn) ((bf16_t*)(ws + WS_WSB))[i] = f2bf(p.in[I_WGS][i]);
    for (int i = gt; i < 2 * 48 * 1024; i += gn) {
        const int l = i / (48 * 1024), r = i % (48 * 1024), n = r >> 10, k = r & 1023;
        float w = 0.f; if (n < 4) w = p.in[I_WRG][((size_t)l * 1024 + k) * 4 + n]; else if (n < 36) w = p.in[I_WRE][((size_t)l * 1024 + k) * 32 + (n - 4)];
        const bf16_t hi = f2bf(w); const bf16_t lo = f2bf(w - bf2f(hi));
        bf16_t* d = (bf16_t*)(ws + WS_WRT) + (size_t)l * 2 * 48 * 1024;
        d[r] = hi; d[48 * 1024 + r] = lo;
    }
    for (int i = gt; i < 1024; i += gn) { const int pos = i >> 4, f = i & 15; const float inv = powf(10000.0f, -(float)f / 16.0f); const float a = (float)pos * inv;
        ((float*)(ws + WS_ROPE))[i] = cosf(a); ((float*)(ws + WS_ROPE))[1024 + i] = sinf(a); }
    if (gt < 2) { const int l = gt; const float* lp = p.in[I_DLAM] + l * 256; float s01 = 0.f, s23 = 0.f;
        for (int i = 0; i < 64; ++i) { s01 += lp[i] * lp[64 + i]; s23 += lp[128 + i] * lp[192 + i]; }
        const float lam_init = 0.8f - 0.6f * expf(-0.3f * (float)l);
        float* o = (float*)(ws + WS_LAM) + l * 4; o[0] = expf(s01) - expf(s23) + lam_init; o[1] = 1.0f - lam_init; }
    for (int i = gt; i < 2 * 16 * 1024; i += gn) {
        const int l = i >> 14, gc = (i >> 10) & 15, ch = i & 1023, part = ch >> 9, c = ch & 511, h = c >> 7, d = c & 127;
        const float* wif = p.in[I_WIF] + (size_t)l * 1536 * 16; const float* wq = p.in[I_WQKV] + (size_t)l * 3 * 4 * 16384;
        float s = 0.f;
        if (part == 0) { const float* a = wq + ((size_t)(0 * 4 + h) * 128 + d) * 128; const float* b = wq + ((size_t)(1 * 4 + h) * 128 + d) * 128;
            for (int e = 0; e < 128; ++e) s += a[e] * wif[(size_t)(h * 128 + e) * 16 + gc] + b[e] * wif[(size_t)(512 + h * 128 + e) * 16 + gc]; }
        else { const float* a = wq + ((size_t)(2 * 4 + h) * 128 + d) * 128;
            for (int e = 0; e < 128; ++e) s += a[e] * wif[(size_t)(1024 + h * 128 + e) * 16 + gc]; }
        ((float*)(ws + WS_WFOLD))[i] = s;
    }
    {
        LAS float* sc = (LAS float*)lds;
        LAS float* red = sc + 17 * 1024;
        bool loaded = false;
        for (int u = bid; u < 192; u += G) {
            if (!loaded) { for (int i = tid; i < 17 * 1024; i += NTHR) { const float v = i < 16384 ? p.in[I_C][i] : p.in[I_CCTX][i - 16384]; sc[i] = silu_f(v); } loaded = true; }
            __syncthreads();
            const int l = u / 96, cbk = u % 96, col = cbk * 64 + (tid & 63), kq = tid >> 6;
            float a[17];
#pragma unroll
            for (int b = 0; b < 17; ++b) a[b] = 0.f;
            const float* wp = p.in[I_WMOD] + (size_t)l * 1024 * 6144 + col;
            for (int k0 = kq * 128; k0 < kq * 128 + 128; k0 += 8) { float w[8];
#pragma unroll
                for (int j = 0; j < 8; ++j) w[j] = wp[(size_t)(k0 + j) * 6144];
#pragma unroll
                for (int j = 0; j < 8; ++j)
#pragma unroll
                    for (int b = 0; b < 17; ++b) a[b] += sc[b * 1024 + k0 + j] * w[j]; }
#pragma unroll
            for (int b = 0; b < 17; ++b) red[(kq * 17 + b) * 64 + (tid & 63)] = a[b];
            __syncthreads();
            for (int i = tid; i < 17 * 64; i += NTHR) { const int b = i >> 6, c = i & 63; float s2 = 0.f;
#pragma unroll
                for (int k = 0; k < 8; ++k) s2 += red[(k * 17 + b) * 64 + c];
                ((float*)(ws + WS_MOD))[((size_t)l * 17 + b) * 6144 + cbk * 64 + c] = s2 + p.in[I_BMOD][(size_t)l * 6144 + cbk * 64 + c]; }
            __syncthreads();
        }
    }
}

constexpr int CVT_TILES = 3072;
struct CvtT { const float* a; const float* b; unsigned char* dst; int ldsrc, K, k0, n0; };
__device__ __forceinline__ CvtT cvt_decode(const Params& p, int t) {
    const int l = t >= CVT_TILES ? 1 : 0, u = t - l * CVT_TILES; CvtT c;
    if (u < 2048) { const int e = u >> 6, q = u & 63; const size_t eo = ((size_t)l * 32 + e) * 1024 * 512;
        c.a = p.in[I_WEG] + eo; c.b = p.in[I_WEU] + eo; c.dst = p.ws + WS_WTGU + ((size_t)l * 32 + e) * 1024 * 1024; c.ldsrc = 512; c.K = 1024; c.k0 = (q >> 2) * 64; c.n0 = (q & 3) * 256; }
    else { const int v = u - 2048, e = v >> 5, q = v & 31;
        c.a = p.in[I_WED] + ((size_t)l * 32 + e) * 512 * 1024; c.b = nullptr; c.dst = p.ws + WS_WTD + ((size_t)l * 32 + e) * 1024 * 512; c.ldsrc = 1024; c.K = 512; c.k0 = (q >> 2) * 64; c.n0 = (q & 3) * 256; }
    return c;
}
__device__ __forceinline__ void cvt_load(const CvtT& c, float (&v)[32]) {
    const int tid = opaque_tid(), n = tid & 255, kb = tid >> 8, ng = c.n0 + n;
    const float* sp = (c.b ? ((ng & 128) ? c.b : c.a) + 128 * (ng >> 8) + (ng & 127) : c.a + ng) + (size_t)(c.k0 + kb) * c.ldsrc;
#pragma unroll
    for (int i = 0; i < 32; ++i) v[i] = sp[(size_t)(2 * i) * c.ldsrc];
}
__device__ __forceinline__ void cvt_finish(const CvtT& c, const float (&v)[32], LAS float* tile) {
    const int tid = opaque_tid();
    { const int n = tid & 255, kb = tid >> 8;
#pragma unroll
      for (int i = 0; i < 32; ++i) tile[(kb + 2 * i) * 257 + n] = v[i] * WSCALE8; }
    __syncthreads();
    { const int n = tid >> 1, kh = (tid & 1) * 32; unsigned char* dp = c.dst + (size_t)(c.n0 + n) * c.K + c.k0 + kh;
#pragma unroll
      for (int i = 0; i < 2; ++i) { float f[16];
#pragma unroll
          for (int j = 0; j < 16; ++j) f[j] = tile[(kh + 16 * i + j) * 257 + n];
          u32x4 w; w.x = pk4_fp8(f[0], f[1], f[2], f[3]); w.y = pk4_fp8(f[4], f[5], f[6], f[7]); w.z = pk4_fp8(f[8], f[9], f[10], f[11]); w.w = pk4_fp8(f[12], f[13], f[14], f[15]);
          *(u32x4*)(dp + 16 * i) = w; } }
}
__device__ __forceinline__ void cvt_fill(const Params& p, LAS unsigned char* lds, int t0, int t1, int r, int nr) {
    LAS float* tA = (LAS float*)lds; LAS float* tB = tA + 64 * 257 + 64;
    asm volatile("" : "+s"(r));
    float va[32], vb[32]; int t = t0 + r;
    if (t < t1) cvt_load(cvt_decode(p, t), va);
    for (; t < t1; t += 2 * nr) {
        if (t + nr < t1) cvt_load(cvt_decode(p, t + nr), vb);
        cvt_finish(cvt_decode(p, t), va, tA);
        if (t + 2 * nr < t1) cvt_load(cvt_decode(p, t + 2 * nr), va);
        if (t + nr < t1) cvt_finish(cvt_decode(p, t + nr), vb, tB);
    }
    __syncthreads();
}
constexpr int CVT_Q0 = 0, CVT_Q1 = 2240, CVT_Q2 = 2240, CVT_Q3 = 4480, CVT_Q4 = 5600;

__device__ __forceinline__ void ld_row_f32(const float* src, int lane, float (&v)[16]) {
    const f32x4 a = *(const f32x4*)(src + 8 * lane), b = *(const f32x4*)(src + 8 * lane + 4), c = *(const f32x4*)(src + 512 + 8 * lane), d = *(const f32x4*)(src + 512 + 8 * lane + 4);
#pragma unroll
    for (int j = 0; j < 4; ++j) { v[j] = a[j]; v[4 + j] = b[j]; v[8 + j] = c[j]; v[12 + j] = d[j]; }
}
__device__ __forceinline__ void st_row_f32(float* dst, int lane, const float (&v)[16]) {
    *(f32x4*)(dst + 8 * lane) = (f32x4){v[0], v[1], v[2], v[3]}; *(f32x4*)(dst + 8 * lane + 4) = (f32x4){v[4], v[5], v[6], v[7]};
    *(f32x4*)(dst + 512 + 8 * lane) = (f32x4){v[8], v[9], v[10], v[11]}; *(f32x4*)(dst + 512 + 8 * lane + 4) = (f32x4){v[12], v[13], v[14], v[15]};
}
__device__ __forceinline__ void ld_row_bf16(const bf16_t* src, int lane, float (&v)[16]) {
    const u32x4 a = *(const u32x4*)(src + 8 * lane), b = *(const u32x4*)(src + 512 + 8 * lane);
    v[0] = bf_lo(a.x); v[1] = bf_hi(a.x); v[2] = bf_lo(a.y); v[3] = bf_hi(a.y); v[4] = bf_lo(a.z); v[5] = bf_hi(a.z); v[6] = bf_lo(a.w); v[7] = bf_hi(a.w);
    v[8] = bf_lo(b.x); v[9] = bf_hi(b.x); v[10] = bf_lo(b.y); v[11] = bf_hi(b.y); v[12] = bf_lo(b.z); v[13] = bf_hi(b.z); v[14] = bf_lo(b.w); v[15] = bf_hi(b.w);
}
__device__ __forceinline__ void st_row_bf16(bf16_t* dst, int lane, const float (&v)[16]) {
    u32x4 a, b; a.x = cvtpk(v[0], v[1]); a.y = cvtpk(v[2], v[3]); a.z = cvtpk(v[4], v[5]); a.w = cvtpk(v[6], v[7]);
    b.x = cvtpk(v[8], v[9]); b.y = cvtpk(v[10], v[11]); b.z = cvtpk(v[12], v[13]); b.w = cvtpk(v[14], v[15]);
    *(u32x4*)(dst + 8 * lane) = a; *(u32x4*)(dst + 512 + 8 * lane) = b;
}
template <int MODE>
__device__ __forceinline__ void load_resid4(const Params& p, int R0, const RowInfo& q, int lmoe, int lane, float (&v)[4][16]) {
    const float* src; float* dst;
    if (q.isctx) { const size_t o = ((size_t)q.b * 256 + q.t) * 1024; src = (MODE == 0 ? p.in[I_CTX] : (const float*)(p.ws + WS_XC)) + o; dst = (float*)(p.ws + WS_XC) + o; }
    else { const size_t o = ((size_t)q.b * 2048 + q.t) * 1024; src = (MODE == 0 ? p.in[I_X] : (const float*)p.out) + o; dst = p.out + o; }
#pragma unroll
    for (int i = 0; i < 4; ++i) ld_row_f32(src + (size_t)i * 1024, lane, v[i]);
    if (MODE == 1 || MODE == 3) {
        const int* slot = (const int*)(p.ws + WS_POS) + 2 * (size_t)R0; const float* wk = (const float*)(p.ws + WS_WTK) + 2 * (size_t)R0;
        const bf16_t* ys = (const bf16_t*)(p.ws + WS_P + P_YS);
        int sl[8]; float ww[8];
#pragma unroll
        for (int i = 0; i < 8; ++i) { sl[i] = ld_i32_dev(slot + i); ww[i] = ld_f32_dev(wk + i); }
        float m5[16]; ld_row_f32((const float*)(p.ws + WS_MOD) + ((size_t)lmoe * 17 + (q.isctx ? 16 : q.b)) * 6144 + 5 * 1024, lane, m5);
        u32x4 ya[4][2], yb[4][2];
#pragma unroll
        for (int i = 0; i < 4; ++i) { const bf16_t* r1 = ys + (size_t)sl[2 * i] * 1024; const bf16_t* r2 = ys + (size_t)sl[2 * i + 1] * 1024;
            ya[i][0] = *(const u32x4*)(r1 + 8 * lane); ya[i][1] = *(const u32x4*)(r1 + 512 + 8 * lane); yb[i][0] = *(const u32x4*)(r2 + 8 * lane); yb[i][1] = *(const u32x4*)(r2 + 512 + 8 * lane); }
#pragma unroll
        for (int i = 0; i < 4; ++i) { float y1[8], y2[8];
#pragma unroll
            for (int hh = 0; hh < 2; ++hh) { unpack8(ya[i][hh], y1); unpack8(yb[i][hh], y2);
#pragma unroll
                for (int j = 0; j < 8; ++j) v[i][8 * hh + j] += m5[8 * hh + j] * (ww[2 * i] * y1[j] + ww[2 * i + 1] * y2[j]); }
            if (MODE == 1) st_row_f32(dst + (size_t)i * 1024, lane, v[i]); }
    }
}
struct RowPar { float g[16], sh[16], sc[16]; };
__device__ __forceinline__ void load_rowpar(const Params& p, int l, int which, const RowInfo& q, int lane, RowPar& rp) {
    const float* mrow = (const float*)(p.ws + WS_MOD) + ((size_t)l * 17 + (q.isctx ? 16 : q.b)) * 6144;
    ld_row_f32(p.in[which ? I_GN2 : I_GN1] + (size_t)l * 1024, lane, rp.g);
    ld_row_f32(mrow + (which ? 3 : 0) * 1024, lane, rp.sh); ld_row_f32(mrow + (which ? 4 : 1) * 1024, lane, rp.sc);
}
__device__ __forceinline__ void norm_mod_row(const RowPar& rp, int lane, const float (&v)[16], bf16_t* hrow, unsigned char* h8row = nullptr) {
    float ss = 0.f;
#pragma unroll
    for (int j = 0; j < 16; ++j) ss += v[j] * v[j];
    ss = wave_sum(ss); const float rs = rsqrtf(ss * (1.0f / 1024.0f) + EPS);
    float o[16];
#pragma unroll
    for (int j = 0; j < 16; ++j) o[j] = v[j] * rs * rp.g[j] * (1.0f + rp.sc[j]) + rp.sh[j];
    st_row_bf16(hrow, lane, o);
    if (h8row) { u32x2 a, b; a.x = pk4_fp8(o[0] * HSCALE8, o[1] * HSCALE8, o[2] * HSCALE8, o[3] * HSCALE8); a.y = pk4_fp8(o[4] * HSCALE8, o[5] * HSCALE8, o[6] * HSCALE8, o[7] * HSCALE8);
        b.x = pk4_fp8(o[8] * HSCALE8, o[9] * HSCALE8, o[10] * HSCALE8, o[11] * HSCALE8); b.y = pk4_fp8(o[12] * HSCALE8, o[13] * HSCALE8, o[14] * HSCALE8, o[15] * HSCALE8);
        *(u32x2*)(h8row + 8 * lane) = a; *(u32x2*)(h8row + 512 + 8 * lane) = b; }
}
__device__ __forceinline__ void phase_norm1(const Params& p, int l) {
    const int tid = opaque_tid(), wid = __builtin_amdgcn_readfirstlane(tid >> 6), lane = tid & 63;
    for (int gq = blockIdx.x * 8 + wid; gq < MTOT / 4; gq += gridDim.x * 8) {
        const int R0 = 4 * gq; const RowInfo q = row_info(R0); float v[4][16]; RowPar rp;
        load_rowpar(p, l, 0, q, lane, rp);
        if (l == 0) load_resid4<0>(p, R0, q, 0, lane, v); else load_resid4<1>(p, R0, q, l - 1, lane, v);
#pragma unroll
        for (int i = 0; i < 4; ++i) norm_mod_row(rp, lane, v[i], (bf16_t*)(p.ws + WS_H) + (size_t)(R0 + i) * 1024, p.ws + WS_H8 + (size_t)(R0 + i) * 1024);
    }
}
__device__ __forceinline__ void phase_final(const Params& p) {
    const int tid = opaque_tid(), wid = __builtin_amdgcn_readfirstlane(tid >> 6), lane = tid & 63;
    float g[16]; ld_row_f32(p.in[I_GFIN], lane, g);
    for (int gq = blockIdx.x * 8 + wid; gq < NBATCH * SEQ / 4; gq += gridDim.x * 8) {
        const int a = 4 * gq, R0 = (a >> 14) * MH + CTXROWS + (a & 16383);
        const RowInfo q = row_info(R0); float v[4][16];
        load_resid4<3>(p, R0, q, 1, lane, v);
#pragma unroll
        for (int i = 0; i < 4; ++i) { float ss = 0.f;
#pragma unroll
            for (int j = 0; j < 16; ++j) ss += v[i][j] * v[i][j];
            ss = wave_sum(ss); const float rs = rsqrtf(ss * (1.0f / 1024.0f) + EPS);
#pragma unroll
            for (int j = 0; j < 16; ++j) v[i][j] = v[i][j] * rs * g[j];
            st_row_f32(p.out + ((size_t)q.b * 2048 + q.t + i) * 1024, lane, v[i]); }
    }
}
__device__ __forceinline__ int active_row(int l, int a) { return l == 0 ? a : (a >> 14) * MH + CTXROWS + (a & 16383); }
typedef float f32x4v __attribute__((ext_vector_type(4)));
__device__ __forceinline__ void phase_norm2_router(const Params& p, int l, LAS unsigned char* lds) {
    const int tid = opaque_tid(), wid = tid >> 6, lane = tid & 63, G = gridDim.x, bid = blockIdx.x;
    const int NA = l == 0 ? MTOT : NBATCH * SEQ;
    const int chunk = (((NA + G - 1) / G) + 15) & ~15;
    const int a0 = bid * chunk, a1 = (a0 + chunk < NA) ? a0 + chunk : NA, na = a1 > a0 ? a1 - a0 : 0;
    LAS float* lg = (LAS float*)lds;
    LAS float* lgs = (LAS float*)(lds + 73728);
    LAS int* re = (LAS int*)(lds + 83968);
    LAS float* rw = (LAS float*)(lds + 83968 + 2048);
    LAS int* rr = (LAS int*)(lds + 83968 + 4096);
    LAS int* hist = (LAS int*)(lds + 83968 + 6144);
    LAS int* base = hist + 32;
    if (tid < 32) hist[tid] = 0;
    bf16_t* H = (bf16_t*)(p.ws + WS_H);
    PSEC_BEGINN(11);
    for (int g = wid; g * 16 < na; g += 8)
        for (int i = 0; i < 16; i += 4) { const int a = a0 + g * 16 + i; if (a >= a1) break;
            const int R0 = active_row(l, a); const RowInfo q = row_info(R0); float v[4][16]; RowPar rp;
            load_rowpar(p, l, 1, q, lane, rp);
            load_resid4<2>(p, R0, q, 0, lane, v);
#pragma unroll
            for (int k = 0; k < 4; ++k) norm_mod_row(rp, lane, v[k], H + (size_t)(R0 + k) * 1024, p.ws + WS_H8 + (size_t)(R0 + k) * 1024); }
    asm volatile("s_waitcnt vmcnt(0)" ::: "memory"); __syncthreads();
    PSEC(11);
    const bf16_t* Wr = (const bf16_t*)(p.ws + WS_WRT) + (size_t)l * 2 * 48 * 1024;
    const float* brg = p.in[I_BRG] + l * 4; const float* bre = p.in[I_BRE] + l * 32;
    const int ng = (na + 15) >> 4, r16 = lane & 15, kq = lane >> 4;
    LAS float* brl = (LAS float*)(lds + 83968 + 6144 + 512);
    if (tid < 36) brl[tid] = tid < 4 ? brg[tid] : bre[tid - 4];
    if (ng > 0) {
        bf16x8 bh[4][3], bl[4][3];
        { const bf16_t* bp = Wr + (size_t)r16 * 1024 + 128 * wid + 8 * kq;
#pragma unroll
          for (int ks = 0; ks < 4; ++ks)
#pragma unroll
              for (int ct = 0; ct < 3; ++ct) { bh[ks][ct] = *(const bf16x8*)(bp + (size_t)ct * 16 * 1024 + ks * 32); bl[ks][ct] = *(const bf16x8*)(bp + (size_t)(48 + ct * 16) * 1024 + ks * 32); } }
        __builtin_amdgcn_sched_barrier(0);
#pragma unroll 1
        for (int g0 = 0; g0 < ng; g0 += 3) {
            bf16x8 a[3][4];
#pragma unroll
            for (int gq = 0; gq < 3; ++gq) { int ar = a0 + (g0 + gq) * 16 + r16; if (ar >= a1) ar = a1 - 1;
                const bf16_t* ap = H + (size_t)active_row(l, ar) * 1024 + 128 * wid + 8 * kq;
#pragma unroll
                for (int ks = 0; ks < 4; ++ks) a[gq][ks] = *(const bf16x8*)(ap + ks * 32); }
            __builtin_amdgcn_sched_barrier(0);
#pragma unroll
            for (int gq = 0; gq < 3; ++gq) {
                f32x4v acc[3] = {{0.f, 0.f, 0.f, 0.f}, {0.f, 0.f, 0.f, 0.f}, {0.f, 0.f, 0.f, 0.f}};
#pragma unroll
                for (int ks = 0; ks < 4; ++ks)
#pragma unroll
                    for (int ct = 0; ct < 3; ++ct) { acc[ct] = __builtin_amdgcn_mfma_f32_16x16x32_bf16(a[gq][ks], bh[ks][ct], acc[ct], 0, 0, 0); acc[ct] = __builtin_amdgcn_mfma_f32_16x16x32_bf16(a[gq][ks], bl[ks][ct], acc[ct], 0, 0, 0); }
#pragma unroll
                for (int ct = 0; ct < 3; ++ct)
#pragma unroll
                    for (int r = 0; r < 4; ++r) lg[((gq * 8 + wid) * 16 + 4 * kq + r) * 48 + ct * 16 + r16] = acc[ct][r];
            }
            __syncthreads();
            for (int o = tid; o < 3 * 768; o += NTHR) { const int gq = o >= 1536 ? 2 : (o >= 768 ? 1 : 0), rem = o - gq * 768; float s = 0.f;
#pragma unroll
                for (int w = 0; w < 8; ++w) s += lg[(gq * 8 + w) * 768 + rem];
                lgs[o] = s; }
            __syncthreads();
            if (tid < 48) {
                const int a = a0 + (g0 + (tid >> 4)) * 16 + (tid & 15);
                if (g0 + (tid >> 4) < ng && a < a1) {
                    const LAS float* x = lgs + tid * 48;
                    float gl[4]; int gs = 0; float gmax;
#pragma unroll
                    for (int j = 0; j < 4; ++j) gl[j] = x[j] + brl[j];
                    gmax = gl[0];
#pragma unroll
                    for (int j = 1; j < 4; ++j) if (gl[j] > gmax) { gmax = gl[j]; gs = j; }
                    float gsum = 0.f;
#pragma unroll
                    for (int j = 0; j < 4; ++j) gsum += __expf(gl[j] - gmax);
                    const float pg = 1.0f / gsum;
                    float v1 = -3.0e38f, v2 = -3.0e38f; int i1 = 0, i2 = 0;
                    for (int j = 0; j < 8; ++j) { const float ev = x[4 + gs * 8 + j] + brl[4 + gs * 8 + j];
                        if (ev > v1) { v2 = v1; i2 = i1; v1 = ev; i1 = j; } else if (ev > v2) { v2 = ev; i2 = j; } }
                    const float t = __expf(v2 - v1); const float w1 = pg / (1.0f + t), w2 = pg * t / (1.0f + t);
                    const int e1 = gs * 8 + i1, e2 = gs * 8 + i2, i = a - a0;
                    re[i] = e1; re[256 + i] = e2; rw[i] = w1; rw[256 + i] = w2;
                }
            }
            __syncthreads();
        }
    }
    __syncthreads();
    PSEC(12);
    if (tid < 32) { int c = 0; for (int i = 0; i < na; ++i) { if (re[i] == tid) rr[i] = c++; if (re[256 + i] == tid) rr[256 + i] = c++; } hist[tid] = c; }
    __syncthreads();
    int* hg = (int*)(p.ws + WS_CTL) + CW_HIST + (l * 256 + bid) * 32;
    if (tid < 32) hg[tid] = hist[tid];
    (void)base;
    int* EID = (int*)(p.ws + WS_EID); float* WTK = (float*)(p.ws + WS_WTK); int* POS = (int*)(p.ws + WS_POS);
    for (int i = tid; i < na; i += NTHR) { const size_t R = (size_t)active_row(l, a0 + i);
        EID[2 * R] = re[i]; EID[2 * R + 1] = re[256 + i]; WTK[2 * R] = rw[i]; WTK[2 * R + 1] = rw[256 + i];
        POS[2 * R] = rr[i]; POS[2 * R + 1] = rr[256 + i]; }
    __syncthreads();
    PSEC(13);
}
__device__ __forceinline__ void moe_segments(const Params& p, int l, LAS int* seg, int myblk) {
    const int tid = opaque_tid(); LAS int* cnt = seg + 40; LAS int* pre = seg + 80; LAS int* part = seg + 4096;
    { const int e = tid & 31, pt = tid >> 5, nb = (int)gridDim.x, per = (nb + 15) >> 4;
      const int* hg = (const int*)(p.ws + WS_CTL) + CW_HIST + l * 256 * 32 + e; int tot = 0, pr = 0;
      for (int b = pt * per; b < (pt + 1) * per && b < nb; ++b) { const int c = hg[b * 32]; if (b < myblk) pr += c; tot += c; }
      part[(pt * 2) * 32 + e] = tot; part[(pt * 2 + 1) * 32 + e] = pr; }
    __syncthreads();
    if (tid < 32) { int tot = 0, pr = 0;
#pragma unroll
        for (int pt = 0; pt < 16; ++pt) { tot += part[(pt * 2) * 32 + tid]; pr += part[(pt * 2 + 1) * 32 + tid]; }
        cnt[tid] = tot; pre[tid] = pr; }
    __syncthreads();
    if (tid == 0) { int s = 0; for (int e = 0; e < 32; ++e) { seg[e] = s; s += (cnt[e] + 255) & ~255; } if (s > SLOTS) s = SLOTS; seg[32] = s; }
    __syncthreads();
}
__device__ __forceinline__ void phase_dispatch(const Params& p, int l, LAS unsigned char* lds) {
    const int tid = opaque_tid(), G = gridDim.x, bid = blockIdx.x;
    LAS int* seg = (LAS int*)lds; moe_segments(p, l, seg, bid); const LAS int* cnt = seg + 40; const LAS int* pre = seg + 80;
    const int NA = l == 0 ? MTOT : NBATCH * SEQ;
    const int chunk = (((NA + G - 1) / G) + 15) & ~15;
    const int a0 = bid * chunk, a1 = (a0 + chunk < NA) ? a0 + chunk : NA;
    const int* EID = (const int*)(p.ws + WS_EID); const float* WTK = (const float*)(p.ws + WS_WTK); int* POS = (int*)(p.ws + WS_POS); float* WTS = (float*)(p.ws + WS_WTS); int* SRC = (int*)(p.ws + WS_SRC);
    for (int i = tid; i < 2 * (a1 - a0); i += NTHR) {
        const int R = active_row(l, a0 + (i >> 1)); const size_t x = 2 * (size_t)R + (i & 1);
        const int e = EID[x], ps = POS[x]; const float w = WTK[x];
        const int s = seg[e] + pre[e] + ps;
        SRC[s] = R; POS[x] = s; WTS[s] = w; }
    for (int e = bid; e < 32; e += G)
        for (int s = seg[e] + cnt[e] + tid; s < seg[e + 1]; s += NTHR) SRC[s] = 0;
    __syncthreads();
}
__device__ __forceinline__ int moe_tile_table(const Params& p, int l, LAS int* seg, LAS int* tile_e) {
    moe_segments(p, l, seg, 0);
    const int nt = seg[32] >> 8;
    for (int i = opaque_tid(); i < nt; i += NTHR) { int e = 0; for (int k = 1; k < 32; ++k) if ((i << 8) >= seg[k]) e = k; tile_e[i] = e; }
    __syncthreads();
    return __builtin_amdgcn_readfirstlane(nt);
}
__device__ __forceinline__ void lds_addf(LAS float* a, float v) { (void)__hip_atomic_fetch_add(a, v, __ATOMIC_RELAXED, __HIP_MEMORY_SCOPE_WORKGROUP); }
__device__ __forceinline__ bf16_t* pbuf(const Params& p, size_t off) { return (bf16_t*)(p.ws + WS_P + off); }
#ifndef MMU
#define MMU 2
#endif
__device__ __forceinline__ void mm128(const LAS bf16_t* A, const LAS bf16_t* Bt, f32x16 (&acc)[2], int wid, int lane) {
    const int r32 = lane & 31, hi = lane >> 5;
    const LAS bf16_t* ap = A + (32 * (wid >> 1) + r32) * TLD + hi * 8;
    const LAS bf16_t* bp = Bt + (64 * (wid & 1) + r32) * TLD + hi * 8;
#pragma unroll MMU
    for (int ks = 0; ks < 8; ++ks) {
        const bf16x8 a = *(const LAS bf16x8*)(ap + ks * 16), b0 = *(const LAS bf16x8*)(bp + ks * 16), b1 = *(const LAS bf16x8*)(bp + 32 * TLD + ks * 16);
        acc[0] = mfma32(a, b0, acc[0]); acc[1] = mfma32(a, b1, acc[1]);
    }
}
__device__ __forceinline__ void mm128_gB(const LAS bf16_t* A, const bf16_t* __restrict__ Bg, f32x16 (&acc)[2], int wid, int lane) {
    const int r32 = lane & 31, hi = lane >> 5;
    const LAS bf16_t* ap = A + (32 * (wid >> 1) + r32) * TLD + hi * 8;
    const bf16_t* bp = Bg + (64 * (wid & 1) + r32) * 128 + hi * 8;
#pragma unroll MMU
    for (int ks = 0; ks < 8; ++ks) {
        const bf16x8 a = *(const LAS bf16x8*)(ap + ks * 16), b0 = *(const bf16x8*)(bp + ks * 16), b1 = *(const bf16x8*)(bp + 32 * 128 + ks * 16);
        acc[0] = mfma32(a, b0, acc[0]); acc[1] = mfma32(a, b1, acc[1]);
    }
}
__device__ __forceinline__ void st_acc_T(LAS bf16_t* T, const f32x16 (&acc)[2], int wid, int lane) {
    const int r32 = lane & 31, hi = lane >> 5;
#pragma unroll
    for (int tl = 0; tl < 2; ++tl)
#pragma unroll
        for (int g = 0; g < 4; ++g) { u32x2 w; w.x = cvtpk(acc[tl][4 * g], acc[tl][4 * g + 1]); w.y = cvtpk(acc[tl][4 * g + 2], acc[tl][4 * g + 3]);
            *(LAS u32x2*)(T + (64 * (wid & 1) + 32 * tl + r32) * TLD + 32 * (wid >> 1) + 8 * g + 4 * hi) = w; }
}

__device__ __forceinline__ void st_acc_rm(LAS bf16_t* T, const f32x16 (&acc)[2], int wid, int lane) {
    const int r32 = lane & 31, hi = lane >> 5;
    LAS bf16_t* b = T + (32 * (wid >> 1) + 4 * hi) * TLD + 64 * (wid & 1) + r32;
#pragma unroll
    for (int tl = 0; tl < 2; ++tl)
#pragma unroll
        for (int r = 0; r < 16; ++r) b[((r & 3) + 8 * (r >> 2)) * TLD + 32 * tl] = (bf16_t)(cvtpk(acc[tl][r], acc[tl][r]) & 0xffffu);
}
constexpr int FLD = 132;
__device__ __forceinline__ void st_acc_f32(LAS float* F, const f32x16 (&acc)[2], int wid, int lane) {
    const int r32 = lane & 31, hi = lane >> 5;
    LAS float* b = F + (32 * (wid >> 1) + 4 * hi) * FLD + 64 * (wid & 1) + r32;
#pragma unroll
    for (int tl = 0; tl < 2; ++tl)
#pragma unroll
        for (int r = 0; r < 16; ++r) b[((r & 3) + 8 * (r >> 2)) * FLD + 32 * tl] = acc[tl][r];
}
__device__ __forceinline__ void copy_tile_out(const LAS bf16_t* T, bf16_t* dst, int ld) {
    const int tx = opaque_tid(), t = tx >> 2, c0 = (tx & 3) * 32;
#pragma unroll
    for (int i = 0; i < 4; ++i) *(u32x4*)(dst + (size_t)t * ld + c0 + 8 * i) = *(const LAS u32x4*)(T + t * TLD + c0 + 8 * i);
}

__device__ __forceinline__ bool seq_start(int r) { return r < CTXROWS ? (r & 255) == 0 : ((r - CTXROWS) & 2047) == 0; }
template <int CTRL> __device__ __forceinline__ u32x4 dpp4(const u32x4 v) { u32x4 o;
    o.x = (unsigned)__builtin_amdgcn_update_dpp(0, (int)v.x, CTRL, 0xf, 0xf, true); o.y = (unsigned)__builtin_amdgcn_update_dpp(0, (int)v.y, CTRL, 0xf, 0xf, true);
    o.z = (unsigned)__builtin_amdgcn_update_dpp(0, (int)v.z, CTRL, 0xf, 0xf, true); o.w = (unsigned)__builtin_amdgcn_update_dpp(0, (int)v.w, CTRL, 0xf, 0xf, true); return o; }
__device__ __forceinline__ void phase_conv(const Params& p, int l, LAS unsigned char* lds) {
    const int tid = opaque_tid(), wid = __builtin_amdgcn_readfirstlane(tid >> 6), lane = tid & 63, r16 = lane & 15, kg = lane >> 4, G = gridDim.x, bid = blockIdx.x;
    constexpr int NG = MH / 16, NU = 5;
    const bf16_t* XM = pbuf(p, P_XMB); bf16_t* XCV = pbuf(p, P_XCV); float* GT = (float*)(p.ws + WS_P + P_GATES);
    LAS float* PX = (LAS float*)lds;
    for (int g0 = bid; g0 < NG; g0 += NU * G) {
        f32x4v acc[NU];
#pragma unroll
        for (int u = 0; u < NU; ++u) acc[u] = (f32x4v){0.f, 0.f, 0.f, 0.f};
#pragma unroll 1
        for (int ks = 0; ks < 2; ++ks) {
            const int c = 64 * wid + 32 * ks + 8 * kg;
            u32x4 cur[NU], edge[NU];
#pragma unroll
            for (int u = 0; u < NU; ++u) { const int g = g0 + G * u; const bool valid = g < NG; const int row = 16 * g + r16;
                cur[u] = valid ? *(const u32x4*)(XM + (size_t)row * 512 + c) : (u32x4){0u, 0u, 0u, 0u};
                const bool he = valid && ((r16 == 0 && !seq_start(16 * g)) || (r16 == 15 && !seq_start(16 * g + 16)));
                const int er = r16 == 0 ? row - 1 : row + 1;
                edge[u] = he ? *(const u32x4*)(XM + (size_t)er * 512 + c) : (u32x4){0u, 0u, 0u, 0u}; }
            float w0[8], w1[8], w2[8], bc[8];
            { const float* wc = p.in[I_WCONV] + (size_t)l * 3 * 512 + c; const float* bcp = p.in[I_BCONV] + (size_t)l * 512 + c;
#pragma unroll
              for (int j = 0; j < 8; ++j) { w0[j] = wc[j]; w1[j] = wc[512 + j]; w2[j] = wc[1024 + j]; bc[j] = bcp[j]; } }
            bf16x8 wyh, wyl, wxh, wxl;
            { const float* wf = (const float*)(p.ws + WS_WFOLD) + ((size_t)l * 16 + r16) * 1024 + c; float a[8], b[8], t8[8];
#pragma unroll
              for (int j = 0; j < 8; ++j) { a[j] = wf[j]; b[j] = wf[512 + j]; }
              u32x4 hh = pack8(a); unpack8(hh, t8);
#pragma unroll
              for (int j = 0; j < 8; ++j) t8[j] = a[j] - t8[j];
              u32x4 ll = pack8(t8); wyh = *(const bf16x8*)&hh; wyl = *(const bf16x8*)&ll;
              hh = pack8(b); unpack8(hh, t8);
#pragma unroll
              for (int j = 0; j < 8; ++j) t8[j] = b[j] - t8[j];
              ll = pack8(t8); wxh = *(const bf16x8*)&hh; wxl = *(const bf16x8*)&ll; }
#pragma unroll
            for (int u = 0; u < NU; ++u) { const int g = g0 + G * u;
                const u32x4 sp = dpp4<0x111>(cur[u]), sn = dpp4<0x101>(cur[u]);
                u32x4 pw, nw;
                pw.x = r16 == 0 ? edge[u].x : sp.x; pw.y = r16 == 0 ? edge[u].y : sp.y; pw.z = r16 == 0 ? edge[u].z : sp.z; pw.w = r16 == 0 ? edge[u].w : sp.w;
                nw.x = r16 == 15 ? edge[u].x : sn.x; nw.y = r16 == 15 ? edge[u].y : sn.y; nw.z = r16 == 15 ? edge[u].z : sn.z; nw.w = r16 == 15 ? edge[u].w : sn.w;
                float xp[8], xc[8], xn[8], y[8], yl[8]; unpack8(pw, xp); unpack8(cur[u], xc); unpack8(nw, xn);
#pragma unroll
                for (int j = 0; j < 8; ++j) y[j] = silu_f(w0[j] * xp[j] + w1[j] * xc[j] + w2[j] * xn[j] + bc[j]);
                const u32x4 yh = pack8(y); unpack8(yh, yl);
#pragma unroll
                for (int j = 0; j < 8; ++j) yl[j] = y[j] - yl[j];
                const u32x4 ylw = pack8(yl);
                const bf16x8 ah = *(const bf16x8*)&yh, al = *(const bf16x8*)&ylw, ax = *(const bf16x8*)&cur[u];
                acc[u] = __builtin_amdgcn_mfma_f32_16x16x32_bf16(ah, wyh, acc[u], 0, 0, 0); acc[u] = __builtin_amdgcn_mfma_f32_16x16x32_bf16(ah, wyl, acc[u], 0, 0, 0);
                acc[u] = __builtin_amdgcn_mfma_f32_16x16x32_bf16(al, wyh, acc[u], 0, 0, 0);
                acc[u] = __builtin_amdgcn_mfma_f32_16x16x32_bf16(ax, wxh, acc[u], 0, 0, 0); acc[u] = __builtin_amdgcn_mfma_f32_16x16x32_bf16(ax, wxl, acc[u], 0, 0, 0);
                if (g < NG) *(u32x4*)(XCV + (size_t)(16 * g + r16) * 512 + c) = yh; }
        }
#pragma unroll
        for (int u = 0; u < NU; ++u)
#pragma unroll
            for (int r = 0; r < 4; ++r) PX[((u * 8 + wid) * 16 + 4 * kg + r) * 16 + r16] = acc[u][r];
        __syncthreads();
        for (int o = tid; o < NU * 256; o += NTHR) { const int u = o >> 8, row = (o >> 4) & 15, n = o & 15, g = g0 + G * u; float s = p.in[I_BIF][l * 16 + n];
#pragma unroll
            for (int w = 0; w < 8; ++w) s += PX[((u * 8 + w) * 16 + row) * 16 + n];
            if (g < NG) GT[(size_t)(16 * g + row) * 16 + (n & 3) * 4 + (n >> 2)] = s; }
        __syncthreads();
    }
}
__device__ __forceinline__ void ld8row(const bf16_t* base, int pos, int seqlen, float (&o)[8]) {
    if (pos < 0 || pos >= seqlen) {
#pragma unroll
        for (int j = 0; j < 8; ++j) o[j] = 0.f; }
    else unpack8(*(const u32x4*)(base + (size_t)pos * 512), o);
}
__device__ __forceinline__ void mlstm_a_ids(int u, int& bl, int& J, int& h, int& r0) {
    bl = u / (NJ * 4); const int rem = u - bl * (NJ * 4); J = rem >> 2; h = rem & 3;
    r0 = (J < 2 ? bl * 256 : CTXROWS + bl * 2048) + (J < 2 ? J * 128 : (J - 2) * 128);
}
#define APRE_PARAMS u32x4 (&qa)[4], u32x4 (&qb)[4], u32x4 (&qwq)[4], u32x4 (&qwk)[4], u32x4 (&qwv)[4], f32x4& qg
#define APRE_ARGS qa, qb, qwq, qwk, qwv, qg
__device__ __forceinline__ void mlstm_a_load(const Params& p, int l, int u, APRE_PARAMS) {
    const int tid = opaque_tid(); int bl, J, h, r0; mlstm_a_ids(u, bl, J, h, r0);
    const int t = tid >> 2, cc = (tid & 3) * 32; const size_t o = (size_t)(r0 + t) * 512 + h * 128 + cc;
    const bf16_t* XM = pbuf(p, P_XMB) + o; const bf16_t* XCV = pbuf(p, P_XCV) + o;
    const bf16_t* Wq = (const bf16_t*)(p.ws + WS_WTQKV) + ((size_t)(l * 3) * 4 + h) * 16384 + t * 128 + cc;
#pragma unroll
    for (int i = 0; i < 4; ++i) { qa[i] = *(const u32x4*)(XCV + 8 * i); qb[i] = *(const u32x4*)(XM + 8 * i);
        qwq[i] = *(const u32x4*)(Wq + 8 * i); qwk[i] = *(const u32x4*)(Wq + (size_t)4 * 16384 + 8 * i); qwv[i] = *(const u32x4*)(Wq + (size_t)8 * 16384 + 8 * i); }
    qg = *(const f32x4*)((const float*)(p.ws + WS_P + P_GATES) + (size_t)(r0 + (tid & 127)) * 16 + h * 4);
}
__device__ __forceinline__ void mlstm_a_unit(const Params& p, int l, int u, int unext, int n_a, APRE_PARAMS, LAS unsigned char* lds) {
    int tid_ = threadIdx.x; asm volatile("" : "+v"(tid_));
    const int tid = tid_, wid = __builtin_amdgcn_readfirstlane(tid >> 6), lane = tid & 63, r32 = lane & 31, hi = lane >> 5;
    LAS bf16_t* T0 = (LAS bf16_t*)lds; LAS bf16_t* T1 = (LAS bf16_t*)(lds + TILE_B); LAS bf16_t* T2 = (LAS bf16_t*)(lds + 2 * TILE_B); LAS bf16_t* T3 = (LAS bf16_t*)(lds + 3 * TILE_B);
    LAS float* gl = (LAS float*)(lds + 4 * TILE_B);
    LAS float* wend = gl + 512;
    int bl, J, h, r0; mlstm_a_ids(u, bl, J, h, r0);
    const int wr_ = tid >> 2, wc_ = (tid & 3) * 32;
    u32x4 wv_[4];
#pragma unroll
    for (int i = 0; i < 4; ++i) { *(LAS u32x4*)(T0 + wr_ * TLD + wc_ + 8 * i) = qa[i]; *(LAS u32x4*)(T1 + wr_ * TLD + wc_ + 8 * i) = qb[i];
        *(LAS u32x4*)(T2 + wr_ * TLD + wc_ + 8 * i) = qwq[i]; *(LAS u32x4*)(T3 + wr_ * TLD + wc_ + 8 * i) = qwk[i]; wv_[i] = qwv[i]; }
    if (tid < 128) *(LAS f32x4*)(gl + tid * 4) = qg;
    LBAR();
    if (wid < 2) {
        const int dir = wid, p0 = 2 * lane, p1 = p0 + 1, s0 = dir ? 127 - p0 : p0, s1 = dir ? 127 - p1 : p1;
        const float ig0 = gl[s0 * 4 + 2 * dir], ig1 = gl[s1 * 4 + 2 * dir];
        const float lf0 = logsigmoid_f(gl[s0 * 4 + 2 * dir + 1]), lf1 = logsigmoid_f(gl[s1 * 4 + 2 * dir + 1]);
        float incl = lf0 + lf1;
        for (int o = 1; o < 64; o <<= 1) { const float t = __shfl_up(incl, o); if (lane >= o) incl += t; }
        const float bc1 = incl, bc0 = incl - lf1, gg = __shfl(incl, 63);
        const float ae0 = gg - bc0 + ig0, ae1 = gg - bc1 + ig1; const float ml = wave_max(fmaxf(ae0, ae1));
        wend[dir * 128 + s0] = __expf(ae0 - ml); wend[dir * 128 + s1] = __expf(ae1 - ml);
        if (lane == 0) { float* mst = (float*)(p.ws + WS_P + P_MST) + ((size_t)(((bl * 4 + h) * 2 + dir) * NJ + J)) * 4; mst[0] = ml; mst[1] = gg; }
    }
    f32x16 ack[2] = {};
    {
        f32x16 acq[2] = {}, akp[2] = {};
        mm128(T2, T0, acq, wid, lane); mm128(T0, T3, ack, wid, lane); mm128(T3, T0, akp, wid, lane);
        LBAR();
        st_acc_T(T2, acq, wid, lane); st_acc_T(T3, akp, wid, lane);
#pragma unroll
        for (int i = 0; i < 4; ++i) *(LAS u32x4*)(T0 + wr_ * TLD + wc_ + 8 * i) = wv_[i];
    }
    LBAR();
    copy_tile_out(T2, pbuf(p, P_MQ) + (size_t)r0 * 512 + h * 128, 512);
    copy_tile_out(T3, pbuf(p, P_MK) + (size_t)r0 * 512 + h * 128, 512);
    {
        f32x16 acv[2] = {}; mm128(T1, T0, acv, wid, lane);
        LBAR();
        st_acc_T(T2, ack, wid, lane); st_acc_T(T3, acv, wid, lane);
    }
    mlstm_a_load(p, l, unext < n_a ? unext : u, APRE_ARGS);
    LBAR();
    {
        bf16_t* MVT = pbuf(p, P_MVT) + ((size_t)((bl * NJ + J) * 4 + h)) * 16384; const int d = tid >> 2, s0 = (tid & 3) * 32;
#pragma unroll
        for (int i = 0; i < 4; ++i) *(u32x4*)(MVT + d * 128 + s0 + 8 * i) = *(const LAS u32x4*)(T3 + d * TLD + s0 + 8 * i);
    }
#pragma unroll 1
    for (int dir = 0; dir < 2; ++dir) {
        const int combo = (bl * 4 + h) * 2 + dir;
        f32x16 acc[2] = {};
        const LAS bf16_t* ap = T3 + (32 * (wid >> 1) + r32) * TLD + hi * 8; const LAS bf16_t* bp = T2 + (64 * (wid & 1) + r32) * TLD + hi * 8;
        const LAS float* wv = wend + dir * 128 + hi * 8;
#pragma unroll
        for (int ks = 0; ks < 8; ++ks) {
            float a8[8]; unpack8(*(const LAS u32x4*)(ap + ks * 16), a8);
            const f32x4 wa = *(const LAS f32x4*)(wv + ks * 16), wb = *(const LAS f32x4*)(wv + ks * 16 + 4);
#pragma unroll
            for (int j = 0; j < 4; ++j) { a8[j] *= wa[j]; a8[4 + j] *= wb[j]; }
            const u32x4 aw = pack8(a8); const bf16x8 a = *(const bf16x8*)&aw;
            const bf16x8 b0 = *(const LAS bf16x8*)(bp + ks * 16), b1 = *(const LAS bf16x8*)(bp + 32 * TLD + ks * 16);
            acc[0] = mfma32(a, b0, acc[0]); acc[1] = mfma32(a, b1, acc[1]);
        }
        bf16_t* CL = (bf16_t*)(p.ws + WS_P + P_CLOC) + ((size_t)combo * NJ + J) * 16384;
        LAS float* F = (LAS float*)lds;
        st_acc_f32(F, acc, wid, lane);
        LBAR();
        { const int d = tid >> 2, e0 = (tid & 3) * 32;
#pragma unroll
          for (int i = 0; i < 4; ++i) { const f32x4 a = *(const LAS f32x4*)(F + d * FLD + e0 + 8 * i), b = *(const LAS f32x4*)(F + d * FLD + e0 + 8 * i + 4);
              u32x4 w; w.x = cvtpk(a[0], a[1]); w.y = cvtpk(a[2], a[3]); w.z = cvtpk(b[0], b[1]); w.w = cvtpk(b[2], b[3]);
              *(u32x4*)(CL + d * 128 + e0 + 8 * i) = w; } }
        LBAR();
    }
    if (tid < 256) { const int dir = tid >> 7, e = tid & 127; float s = 0.f;
#pragma unroll 4
        for (int j = 0; j < 128; j += 8) { float k8[8]; unpack8(*(const LAS u32x4*)(T2 + e * TLD + j), k8);
            const f32x4 wa = *(const LAS f32x4*)(wend + dir * 128 + j), wb = *(const LAS f32x4*)(wend + dir * 128 + j + 4);
#pragma unroll
            for (int i = 0; i < 4; ++i) s += wa[i] * k8[i] + wb[i] * k8[4 + i]; }
        ((float*)(p.ws + WS_P + P_NLOC))[((size_t)(((bl * 4 + h) * 2 + dir) * NJ + J)) * 128 + e] = s; }
    LBAR();
}

__device__ __forceinline__ int scan_J(int dir, int pidx) { return dir == 0 ? pidx : (pidx == 0 ? 1 : (pidx == 1 ? 0 : 19 - pidx)); }
__device__ __forceinline__ void phase_scan(const Params& p) {
    const int NIT = 64 * 2048;
    bf16_t* CL = (bf16_t*)(p.ws + WS_P + P_CLOC); float* NL = (float*)(p.ws + WS_P + P_NLOC); float* MST = (float*)(p.ws + WS_P + P_MST);
    const int tid = opaque_tid();
    for (int w = blockIdx.x * NTHR + tid; w < NIT; w += gridDim.x * NTHR) {
        const int combo = w >> 11, q = w & 2047, dir = combo & 1; const bool hasn = q < 32;
        float m_st = 0.f; float st[8]; f32x4 s4 = {0.f, 0.f, 0.f, 0.f};
#pragma unroll
        for (int j = 0; j < 8; ++j) st[j] = 0.f;
        bf16_t* base = CL + (size_t)combo * NJ * 16384 + 8 * q; float* nbase = NL + (size_t)combo * NJ * 128 + 4 * (q & 31);
#pragma unroll 1
        for (int i = 0; i < NJ; ++i) {
            const int J = scan_J(dir, i); float* ms = MST + ((size_t)combo * NJ + J) * 4;
            const u32x4 vc = *(const u32x4*)(base + (size_t)J * 16384);
            f32x4 vn = {0.f, 0.f, 0.f, 0.f}; if (hasn) vn = *(const f32x4*)(nbase + (size_t)J * 128);
            const float ml = ms[0], gg = ms[1];
            const float m_new = fmaxf(gg + m_st, ml), a_old = __expf(gg + m_st - m_new), a_new = __expf(ml - m_new);
            *(u32x4*)(base + (size_t)J * 16384) = pack8(st);
            if (hasn) *(f32x4*)(nbase + (size_t)J * 128) = s4;
            if (q == 0) ms[2] = m_st;
            float c8[8]; unpack8(vc, c8);
#pragma unroll
            for (int j = 0; j < 8; ++j) st[j] = st[j] * a_old + c8[j] * a_new;
            s4 = s4 * a_old + vn * a_new; m_st = m_new;
        }
    }
}

__device__ __forceinline__ unsigned zap_nf(unsigned w) { if ((w & 0x7f80u) >= 0x4980u) w &= 0xffff0000u; if ((w & 0x7f800000u) >= 0x49800000u) w &= 0x0000ffffu; return w; }
template <int dir>
__device__ __forceinline__ void mlstm_c_dir(const unsigned (&Xp)[4][8], f32x16 (&acc)[2], const LAS bf16_t* Tq, const LAS bf16_t* Tc, const LAS bf16_t* Tv,
                                            const LAS float* av, const LAS float* Mv, const LAS float* wi, LAS float* denw, const LAS float* n0l, int wid, int lane) {
    const int r32 = lane & 31, hi = lane >> 5, tb = wid >> 1, t = 32 * tb + r32;
    acc[0] = f32x16{}; acc[1] = f32x16{};
    mm128(Tq, Tc, acc, wid, lane);
#pragma unroll
    for (int r = 0; r < 16; ++r) { const float w = wi[dir * 128 + 32 * tb + crow(r, hi)]; acc[0][r] *= w; acc[1][r] *= w; }
    float nq = 0.f;
#pragma unroll
    for (int i = 0; i < 8; ++i) { float q8[8]; unpack8(*(const LAS u32x4*)(Tq + t * TLD + 64 * hi + 8 * i), q8);
        const f32x4 na = *(const LAS f32x4*)(n0l + dir * 128 + 64 * hi + 8 * i), nb = *(const LAS f32x4*)(n0l + dir * 128 + 64 * hi + 8 * i + 4);
#pragma unroll
        for (int j = 0; j < 4; ++j) nq += na[j] * q8[j] + nb[j] * q8[4 + j]; }
    const float Mt = Mv[dir * 128 + t]; float den = 0.f;
    const LAS bf16_t* vp = Tv + (64 * (wid & 1) + r32) * TLD + 4 * hi;
#pragma unroll
    for (int sb = 0; sb < 4; ++sb) {
        float o[16];
#pragma unroll
        for (int r = 0; r < 16; ++r) { const int s = 32 * sb + crow(r, hi); const bool ok = dir ? (s >= t) : (s <= t);
            const float xs = (r & 1) ? bf_hi(Xp[sb][r >> 1]) : bf_lo(Xp[sb][r >> 1]);
            const float ev = xs * __builtin_amdgcn_exp2f((av[dir * 128 + s] - Mt) * LOG2E);
            o[r] = ok ? ev : 0.f; den += o[r]; }
#pragma unroll
        for (int s2 = 0; s2 < 2; ++s2) {
            u32x4 aw; aw.x = cvtpk(o[8 * s2 + 0], o[8 * s2 + 1]); aw.y = cvtpk(o[8 * s2 + 2], o[8 * s2 + 3]); aw.z = cvtpk(o[8 * s2 + 4], o[8 * s2 + 5]); aw.w = cvtpk(o[8 * s2 + 6], o[8 * s2 + 7]);
            const bf16x8 af = *(const bf16x8*)&aw;
#pragma unroll
            for (int tl = 0; tl < 2; ++tl) { const LAS bf16_t* bp = vp + 32 * tl * TLD + 32 * sb + 16 * s2;
                const u32x2 b0 = *(const LAS u32x2*)bp, b1 = *(const LAS u32x2*)(bp + 8); u32x4 bw; bw.x = b0.x; bw.y = b0.y; bw.z = b1.x; bw.w = b1.y;
                acc[tl] = mfma32(af, *(const bf16x8*)&bw, acc[tl]); }
        }
        __builtin_amdgcn_sched_barrier(0);
    }
    { auto rr = __builtin_amdgcn_permlane32_swap(__float_as_uint(den), __float_as_uint(den), false, false); den = __uint_as_float(rr[0]) + __uint_as_float(rr[1]); }
    { auto rr = __builtin_amdgcn_permlane32_swap(__float_as_uint(nq), __float_as_uint(nq), false, false); nq = __uint_as_float(rr[0]) + __uint_as_float(rr[1]); }
    if (hi == 0) denw[(wid * 2 + dir) * 32 + r32] = den + wi[dir * 128 + t] * nq;
}
__device__ __forceinline__ void mlstm_c_ids(int u, int& bl, int& J, int& h) {
    const int m_l = HBAT * 16 * 4;
    if (u < m_l) { const int rem = u & 63; bl = u >> 6; J = 2 + (rem >> 2); h = rem & 3; }
    else { const int v = u - m_l, rem = v & 7; bl = v >> 3; J = rem >> 2; h = rem & 3; }
}
#define CPRE_PARAMS u32x4 (&cq)[4], u32x4 (&ck)[4], u32x4 (&cv)[4], u32x4 (&ccf)[4], u32x4 (&ccb)[4], f32x4& cg, float& cn
#define CPRE_ARGS cq, ck, cv, ccf, ccb, cg, cn
__device__ __forceinline__ void mlstm_c_load(const Params& p, int u, CPRE_PARAMS) {
    const int tid = opaque_tid(); int bl, J, h; mlstm_c_ids(u, bl, J, h);
    const int r0 = (J < 2 ? bl * 256 : CTXROWS + bl * 2048) + (J < 2 ? J * 128 : (J - 2) * 128);
    const int t = tid >> 2, c0 = (tid & 3) * 32;
    const bf16_t* q = pbuf(p, P_MQ) + (size_t)(r0 + t) * 512 + h * 128 + c0; const bf16_t* k = pbuf(p, P_MK) + (size_t)(r0 + t) * 512 + h * 128 + c0;
    const bf16_t* v = pbuf(p, P_MVT) + ((size_t)((bl * NJ + J) * 4 + h)) * 16384 + t * 128 + c0;
    const bf16_t* c0f = (const bf16_t*)(p.ws + WS_P + P_CLOC) + ((size_t)((bl * 4 + h) * 2) * NJ + J) * 16384 + t * 128 + c0;
#pragma unroll
    for (int i = 0; i < 4; ++i) { cq[i] = *(const u32x4*)(q + 8 * i); ck[i] = *(const u32x4*)(k + 8 * i); cv[i] = *(const u32x4*)(v + 8 * i);
        ccf[i] = *(const u32x4*)(c0f + 8 * i); ccb[i] = *(const u32x4*)(c0f + (size_t)NJ * 16384 + 8 * i); }
    cg = *(const f32x4*)((const float*)(p.ws + WS_P + P_GATES) + (size_t)(r0 + (tid & 127)) * 16 + h * 4);
    cn = ((const float*)(p.ws + WS_P + P_NLOC))[((size_t)(((bl * 4 + h) * 2 + ((tid >> 7) & 1)) * NJ + J)) * 128 + (tid & 127)];
}
__device__ __forceinline__ void mlstm_c_unit(const Params& p, int l, int u, int unext, int n_c, CPRE_PARAMS, LAS unsigned char* lds) {
    int tid_ = threadIdx.x; asm volatile("" : "+v"(tid_));
    const int tid = tid_, wid = __builtin_amdgcn_readfirstlane(tid >> 6), lane = tid & 63, r32 = lane & 31, hi = lane >> 5;
    LAS bf16_t* Tq = (LAS bf16_t*)lds; LAS bf16_t* Tk = (LAS bf16_t*)(lds + TILE_B); LAS bf16_t* Tv = (LAS bf16_t*)(lds + 2 * TILE_B); LAS bf16_t* Ts = (LAS bf16_t*)(lds + 3 * TILE_B);
    LAS float* sc = (LAS float*)(lds + 4 * TILE_B);
    LAS float* gl = sc;
    LAS float* av = sc + 512;
    LAS float* Mv = sc + 768;
    LAS float* wi = sc + 1024;
    LAS float* fl = sc + 1280;
    LAS float* ssq = sc + 1536;
    LAS float* denp = sc + 1664;
    LAS float* n0l = sc + 2944;
    int bl, J, h; mlstm_c_ids(u, bl, J, h);
    const int rseq = J < 2 ? bl * 256 : CTXROWS + bl * 2048, r0 = rseq + (J < 2 ? J * 128 : (J - 2) * 128);
    u32x4 cf_[4], cbp_[4];
    {
        const int t = tid >> 2, c0 = (tid & 3) * 32;
#pragma unroll
        for (int i = 0; i < 4; ++i) { *(LAS u32x4*)(Tq + t * TLD + c0 + 8 * i) = cq[i]; *(LAS u32x4*)(Tk + t * TLD + c0 + 8 * i) = ck[i]; *(LAS u32x4*)(Tv + t * TLD + c0 + 8 * i) = cv[i]; cf_[i] = ccf[i]; cbp_[i] = ccb[i]; }
        if (tid < 128) { *(LAS f32x4*)(gl + tid * 4) = cg; ssq[tid] = 0.f; }
        if (tid < 256) n0l[tid] = cn;
    }
    LBAR();
    { const int d_ = tid >> 2, e_ = (tid & 3) * 32;
#pragma unroll
      for (int i = 0; i < 4; ++i) *(LAS u32x4*)(Ts + d_ * TLD + e_ + 8 * i) = cf_[i]; }
    const float* MST = (const float*)(p.ws + WS_P + P_MST);
    if (wid < 2) {
        const int dir = wid, p0 = 2 * lane, p1 = p0 + 1, s0 = dir ? 127 - p0 : p0, s1 = dir ? 127 - p1 : p1;
        const float m0 = ld_f32_dev(MST + ((size_t)(((bl * 4 + h) * 2 + dir) * NJ + J)) * 4 + 2);
        const float ig0 = gl[s0 * 4 + 2 * dir], ig1 = gl[s1 * 4 + 2 * dir];
        const float lf0 = logsigmoid_f(gl[s0 * 4 + 2 * dir + 1]), lf1 = logsigmoid_f(gl[s1 * 4 + 2 * dir + 1]);
        float incl = lf0 + lf1;
        for (int o = 1; o < 64; o <<= 1) { const float t = __shfl_up(incl, o); if (lane >= o) incl += t; }
        const float bc1 = incl, bc0 = incl - lf1;
        const float a0 = ig0 - bc0, a1 = ig1 - bc1;
        float mx = fmaxf(a0, a1);
        for (int o = 1; o < 64; o <<= 1) { const float t = __shfl_up(mx, o); if (lane >= o) mx = fmaxf(mx, t); }
        float mxprev = __shfl_up(mx, 1); if (lane == 0) mxprev = -3.0e38f;
        const float M0 = fmaxf(m0, fmaxf(mxprev, a0)), M1 = fmaxf(m0, mx);
        av[dir * 128 + s0] = a0; av[dir * 128 + s1] = a1; Mv[dir * 128 + s0] = M0; Mv[dir * 128 + s1] = M1;
        wi[dir * 128 + s0] = __expf(m0 - M0); wi[dir * 128 + s1] = __expf(m0 - M1);
        fl[dir * 128 + s0] = __expf(-bc0 - M0); fl[dir * 128 + s1] = __expf(-bc1 - M1);
    }
    __builtin_amdgcn_sched_barrier(0);
    unsigned Xp[4][8];
    {
    f32x16 X[4] = {};
    { const LAS bf16_t* bq = Tq + (32 * (wid >> 1) + r32) * TLD + hi * 8; const LAS bf16_t* ak = Tk + r32 * TLD + hi * 8;
#pragma unroll 2
      for (int ks = 0; ks < 8; ++ks) { const bf16x8 b = *(const LAS bf16x8*)(bq + ks * 16);
#pragma unroll
          for (int sb = 0; sb < 4; ++sb) X[sb] = mfma32(*(const LAS bf16x8*)(ak + 32 * sb * TLD + ks * 16), b, X[sb]); } }
#pragma unroll
    for (int sb = 0; sb < 4; ++sb)
#pragma unroll
        for (int i = 0; i < 8; ++i) Xp[sb][i] = cvtpk(X[sb][2 * i], X[sb][2 * i + 1]);
    }
    LBAR();
    { const int d_ = tid >> 2, e_ = (tid & 3) * 32;
#pragma unroll
      for (int i = 0; i < 4; ++i) *(LAS u32x4*)(Tk + d_ * TLD + e_ + 8 * i) = cbp_[i]; }
    LBAR();
    f32x16 ao0[2], ao1[2];
    LAS float* denw = denp;
    mlstm_c_dir<0>(Xp, ao0, Tq, Ts, Tv, av, Mv, wi, denw, n0l, wid, lane);
    mlstm_c_dir<1>(Xp, ao1, Tq, Tk, Tv, av, Mv, wi, denw, n0l, wid, lane);
    __builtin_amdgcn_sched_barrier(0);
    float hv[2][16];
#pragma unroll
    for (int r = 0; r < 16; ++r) { const int t = 32 * (wid >> 1) + crow(r, hi);
        const float df = denw[(wid * 2 + 0) * 32 + crow(r, hi)], db = denw[(wid * 2 + 1) * 32 + crow(r, hi)];
        const float rf = 1.0f / fmaxf(fabsf(df), fl[t]), rb = 1.0f / fmaxf(fabsf(db), fl[128 + t]);
        hv[0][r] = ao0[0][r] * rf + ao1[0][r] * rb; hv[1][r] = ao0[1][r] * rf + ao1[1][r] * rb;
        float q = hv[0][r] * hv[0][r] + hv[1][r] * hv[1][r];
        q = half_sum31(q);
        if (r32 == 31) lds_addf(&ssq[t], q); }
    __builtin_amdgcn_sched_barrier(0);
    int te_ = tid; asm volatile("" : "+v"(te_));
    const bf16_t* xcv = pbuf(p, P_XCV) + (size_t)(r0 + (te_ >> 2)) * 512 + h * 128 + (te_ & 3) * 32; bf16_t* zb = pbuf(p, P_ZB) + (size_t)(r0 + (te_ >> 2)) * 512 + h * 128 + (te_ & 3) * 32;
    const float* sk = p.in[I_SKIP] + l * 512 + h * 128;
    u32x4 xw[4], zw[4]; f32x4 s0[4], s1[4];
#pragma unroll
    for (int i = 0; i < 4; ++i) { xw[i] = *(const u32x4*)(xcv + 8 * i); zw[i] = *(const u32x4*)(zb + 8 * i); s0[i] = *(const f32x4*)(sk + (te_ & 3) * 32 + 8 * i); s1[i] = *(const f32x4*)(sk + (te_ & 3) * 32 + 8 * i + 4); }
    mlstm_c_load(p, unext < n_c ? unext : u, CPRE_ARGS);
    __builtin_amdgcn_sched_barrier(0);
    LBAR();
    const float* gm = p.in[I_GMN] + l * 512 + h * 128;
    f32x16 hn[2];
#pragma unroll
    for (int tl = 0; tl < 2; ++tl) { const float gd = gm[64 * (wid & 1) + 32 * tl + r32];
#pragma unroll
        for (int r = 0; r < 16; ++r) hn[tl][r] = hv[tl][r] * rsqrtf(ssq[32 * (wid >> 1) + crow(r, hi)] * (1.0f / 128.0f) + EPS) * gd; }
    LAS float* F = (LAS float*)lds;
    st_acc_f32(F, hn, wid, lane);
    LBAR();
    { const int t = te_ >> 2, c0 = (te_ & 3) * 32;
#pragma unroll
      for (int i = 0; i < 4; ++i) { float x8[8], z8[8]; unpack8(xw[i], x8); unpack8(zw[i], z8);
          const f32x4 h0 = *(const LAS f32x4*)(F + t * FLD + c0 + 8 * i), h1 = *(const LAS f32x4*)(F + t * FLD + c0 + 8 * i + 4);
#pragma unroll
          for (int j = 0; j < 4; ++j) { z8[j] = (h0[j] + s0[i][j] * x8[j]) * z8[j]; z8[4 + j] = (h1[j] + s1[i][j] * x8[4 + j]) * z8[4 + j]; }
          zw[i] = pack8(z8); }
#pragma unroll
      for (int i = 0; i < 4; ++i) *(u32x4*)(zb + 8 * i) = zw[i]; }
    LBAR();
}
namespace att {
typedef float f32x2v __attribute__((ext_vector_type(2)));
constexpr int SHM_V = 64 * 128 * 2, SHM_K = 64 * 64 * 2, OFF_K = 2 * SHM_V, OFF_WS = OFF_K + 2 * SHM_K, OFF_ST = OFF_WS + 8 * 64 * 4, LDS_NEED = OFF_ST + 32 * 512 * 4;
static_assert(LDS_NEED <= LDS_BYTES - 64, "attention LDS");
constexpr float THR2 = 11.5f;
#define KSWZ64(row, colB) ((row) * 128 + ((colB) ^ (((row) & 7) << 4)))
#define ASBAR() __builtin_amdgcn_sched_barrier(0)
__device__ __forceinline__ void partialSM(f32x16& p0, f32x16& p1, float& m_reg, float& mn, float& alpha) {
    float pmax = p0[0];
#pragma unroll
    for (int r = 1; r < 16; ++r) pmax = fmaxf(pmax, p0[r]);
#pragma unroll
    for (int r = 0; r < 16; ++r) pmax = fmaxf(pmax, p1[r]);
    { auto rr = __builtin_amdgcn_permlane32_swap(__float_as_uint(pmax), __float_as_uint(pmax), false, false); pmax = fmaxf(__uint_as_float(rr[0]), __uint_as_float(rr[1])); }
    if (__builtin_expect(__all(pmax - m_reg <= THR2), 1)) { mn = m_reg; alpha = 1.f; }
    else { mn = fmaxf(m_reg, pmax); alpha = __builtin_amdgcn_exp2f(m_reg - mn); m_reg = mn; }
    { const f32x2v mn2 = {mn, mn};
#pragma unroll
      for (int r = 0; r < 16; r += 2) { f32x2v t0 = {p0[r], p0[r + 1]}, t1 = {p1[r], p1[r + 1]}; t0 -= mn2; t1 -= mn2; p0[r] = t0[0]; p0[r + 1] = t0[1]; p1[r] = t1[0]; p1[r + 1] = t1[1]; } }
#pragma unroll
    for (int r = 0; r < 16; ++r) p0[r] = __builtin_amdgcn_exp2f(p0[r]);
}
__device__ __forceinline__ void finishSM(f32x16& p0, f32x16& p1, float alpha, float& l_reg, bf16x8& pa0, bf16x8& pa1, bf16x8& pa2, bf16x8& pa3) {
#pragma unroll
    for (int r = 0; r < 16; ++r) p1[r] = __builtin_amdgcn_exp2f(p1[r]);
    float ps;
    { f32x2v s2 = {p0[0], p0[1]};
#pragma unroll
      for (int r = 2; r < 16; r += 2) s2 += (f32x2v){p0[r], p0[r + 1]};
#pragma unroll
      for (int r = 0; r < 16; r += 2) s2 += (f32x2v){p1[r], p1[r + 1]};
      ps = s2[0] + s2[1]; }
    { auto rr = __builtin_amdgcn_permlane32_swap(__float_as_uint(ps), __float_as_uint(ps), false, false); ps = __uint_as_float(rr[0]) + __uint_as_float(rr[1]); }
    l_reg = l_reg * alpha + ps;
#define PK4(P, BASE, OUT) do { unsigned a0 = cvtpk(P[BASE + 0], P[BASE + 1]), a1 = cvtpk(P[BASE + 2], P[BASE + 3]);   \
    unsigned b0 = cvtpk(P[BASE + 4], P[BASE + 5]), b1 = cvtpk(P[BASE + 6], P[BASE + 7]);                              \
    auto r0 = __builtin_amdgcn_permlane32_swap(a0, b0, false, false); auto r1 = __builtin_amdgcn_permlane32_swap(a1, b1, false, false); \
    u32x4 w = {r0[0], r1[0], r0[1], r1[1]}; OUT = *reinterpret_cast<bf16x8*>(&w); } while (0)
    PK4(p0, 0, pa0); PK4(p0, 8, pa1); PK4(p1, 0, pa2); PK4(p1, 8, pa3);
#undef PK4
}
__device__ __forceinline__ void qkt(f32x16& p0, f32x16& p1, const LAS char* Ks, const bf16x8 (&qr)[4], int r32, int hi) {
    p0 = f32x16{}; p1 = f32x16{};
#pragma unroll
    for (int d0 = 0; d0 < 4; ++d0) { const int cb = (d0 * 16 + hi * 8) * 2;
        const bf16x8 b0 = *reinterpret_cast<const LAS bf16x8*>(Ks + KSWZ64(r32, cb));
        const bf16x8 b1 = *reinterpret_cast<const LAS bf16x8*>(Ks + KSWZ64(32 + r32, cb));
        p0 = mfma32(b0, qr[d0], p0); p1 = mfma32(b1, qr[d0], p1); }
}
__device__ __forceinline__ int v_st(int k, int c) { const int kk = (k & ~0xC) | ((k & 4) << 1) | ((k & 8) >> 1); return ((kk >> 3) * 4 + (c >> 5)) * 512 + ((kk & 7) * 32 + (c & 31)) * 2; }
__device__ __forceinline__ int v_rd_base(int lane) { return ((lane & 3) << 3) | (((lane >> 2) & 3) << 6) | (((lane >> 4) & 1) << 5) | (((lane >> 5) & 1) << 8); }
constexpr int v_rd_off(int d0, int ks, int half) { return d0 * 512 + ks * 4096 + half * 2048; }
template <int OFF> __device__ __forceinline__ s16x4 tr_read(int vb) { s16x4 r; asm volatile("ds_read_b64_tr_b16 %0, %1 offset:%2" : "=&v"(r) : "v"(vb), "i"(OFF) : "memory"); return r; }
template <int D0> __device__ __forceinline__ void pv_one(f32x16& od, int vb, bf16x8 pa0, bf16x8 pa1, bf16x8 pa2, bf16x8 pa3) {
    const s16x4 l0 = tr_read<v_rd_off(D0, 0, 0)>(vb), h0 = tr_read<v_rd_off(D0, 0, 1)>(vb), l1 = tr_read<v_rd_off(D0, 1, 0)>(vb), h1 = tr_read<v_rd_off(D0, 1, 1)>(vb);
    const s16x4 l2 = tr_read<v_rd_off(D0, 2, 0)>(vb), h2 = tr_read<v_rd_off(D0, 2, 1)>(vb), l3 = tr_read<v_rd_off(D0, 3, 0)>(vb), h3 = tr_read<v_rd_off(D0, 3, 1)>(vb);
    asm volatile("s_waitcnt lgkmcnt(0)" ::: "memory"); ASBAR();
#define PKV(L, H) (bf16x8){L[0], L[1], L[2], L[3], H[0], H[1], H[2], H[3]}
    od = mfma32(pa0, PKV(l0, h0), od); od = mfma32(pa1, PKV(l1, h1), od); od = mfma32(pa2, PKV(l2, h2), od); od = mfma32(pa3, PKV(l3, h3), od);
#undef PKV
}
__device__ __forceinline__ void pv_d0(f32x16 (&o)[4], int vb, bf16x8 pa0, bf16x8 pa1, bf16x8 pa2, bf16x8 pa3) {
    pv_one<0>(o[0], vb, pa0, pa1, pa2, pa3); pv_one<1>(o[1], vb, pa0, pa1, pa2, pa3); pv_one<2>(o[2], vb, pa0, pa1, pa2, pa3); pv_one<3>(o[3], vb, pa0, pa1, pa2, pa3);
}
__device__ __forceinline__ int krow(int j, int rc, int rl) { return j < 4 ? rc + 64 * j : rl + 64 * (j - 4); }

__device__ __forceinline__ void attn_unit(const Params& p, int l, int h, int qrow0, int rc, int rl, int NT, LAS unsigned char* lds8) {
    int tid_ = threadIdx.x; asm volatile("" : "+v"(tid_));
    const int tid = tid_, wid = __builtin_amdgcn_readfirstlane(tid >> 6), lane = tid & 63, r32 = lane & 31, hi = lane >> 5;
    LAS char* V_lds = (LAS char*)lds8; LAS char* K_lds = (LAS char*)lds8 + OFF_K;
    LAS float* wsx = (LAS float*)(lds8 + OFF_WS) + wid * 64; LAS float* li_l = wsx; LAS float* al_l = wsx + 32;
    LAS unsigned* stash = (LAS unsigned*)(lds8 + OFF_ST);
    bf16_t* QB = pbuf(p, P_QB); const bf16_t* KB = pbuf(p, P_KB); const bf16_t* VB = pbuf(p, P_VB);
    const int sr = tid >> 4, sc = (tid & 15) * 8, vst0 = v_st(sr, sc);
    const int kr = tid >> 3, kc = (tid & 7) * 8, kst = KSWZ64(kr, kc * 2);
    const int vb0 = (int)(uintptr_t)V_lds + v_rd_base(lane);
    f32x16 o[4];
#pragma unroll 1
    for (int m = 0; m < 2; ++m) {
        const unsigned voV0 = (unsigned)((sr * 512 + h * 128 + sc) * 2), voK = (unsigned)((kr * 512 + h * 128 + m * 64 + kc) * 2);
        float m_reg = -1e30f, l_reg = 0.f;
#pragma unroll
        for (int d = 0; d < 4; ++d) o[d] = f32x16{};
        bf16x8 qr[4];
        { const bf16_t* Qw = QB + (size_t)(qrow0 + wid * 32 + r32) * 512 + h * 128 + m * 64 + hi * 8;
#pragma unroll
          for (int d0 = 0; d0 < 4; ++d0) qr[d0] = *(const bf16x8*)(Qw + d0 * 16); }
        struct { bf16x8 vs0, vs1, ks0; } sr_[2];
#define SLOAD(i, j) do { const int _r = __builtin_amdgcn_readfirstlane(krow((j), rc, rl)); const char* _vb = (const char*)(VB + (size_t)_r * 512); const char* _kb = (const char*)(KB + (size_t)_r * 512); \
    sr_[i].vs0 = *(const bf16x8*)(_vb + voV0); sr_[i].vs1 = *(const bf16x8*)(_vb + 32 * 512 * 2 + voV0); sr_[i].ks0 = *(const bf16x8*)(_kb + voK); } while (0)
#define SWRITE(b, i) do { *(LAS bf16x8*)(V_lds + (b) * SHM_V + vst0) = sr_[i].vs0; *(LAS bf16x8*)(V_lds + (b) * SHM_V + 8192 + vst0) = sr_[i].vs1; \
    *(LAS bf16x8*)(K_lds + (b) * SHM_K + kst) = sr_[i].ks0; } while (0)
#define SWAIT() asm volatile("s_waitcnt vmcnt(3)" ::: "memory")
#define RESC(a) do { if (__any((a) < 1.f)) { if (hi == 0) al_l[r32] = (a); asm volatile("s_waitcnt lgkmcnt(0)" ::: "memory"); \
    _Pragma("unroll") for (int d = 0; d < 4; ++d) _Pragma("unroll") for (int r = 0; r < 16; ++r) o[d][r] *= al_l[crow(r, hi)]; } } while (0)
        f32x16 pA0, pA1, pB0, pB1; float mnA, mnB, alA, alB; bf16x8 pa0, pa1, pa2, pa3;
        SLOAD(0, 0); asm volatile("s_waitcnt vmcnt(0)" ::: "memory"); SWRITE(0, 0); __syncthreads();
        qkt(pA0, pA1, K_lds, qr, r32, hi); partialSM(pA0, pA1, m_reg, mnA, alA);
        SLOAD(1, 1); if (2 < NT) SLOAD(0, 2);
        SWAIT(); SWRITE(1, 1); __syncthreads();
        for (int j = 1; j + 1 < NT; j += 2) {
            ASBAR(); qkt(pB0, pB1, K_lds + SHM_K, qr, r32, hi);
            finishSM(pA0, pA1, alA, l_reg, pa0, pa1, pa2, pa3); ASBAR();
            SLOAD(1, j + 2); ASBAR();
            pv_d0(o, vb0, pa0, pa1, pa2, pa3); partialSM(pB0, pB1, m_reg, mnB, alB);
            __syncthreads(); SWAIT(); SWRITE(0, 0);
            RESC(alB); __syncthreads();
            ASBAR(); qkt(pA0, pA1, K_lds, qr, r32, hi);
            finishSM(pB0, pB1, alB, l_reg, pa0, pa1, pa2, pa3); ASBAR();
            if (j + 3 < NT) SLOAD(0, j + 3); ASBAR();
            pv_d0(o, vb0 + SHM_V, pa0, pa1, pa2, pa3); partialSM(pA0, pA1, m_reg, mnA, alA);
            __syncthreads(); SWAIT(); SWRITE(1, 1);
            RESC(alA); __syncthreads();
        }
        ASBAR(); qkt(pB0, pB1, K_lds + SHM_K, qr, r32, hi);
        finishSM(pA0, pA1, alA, l_reg, pa0, pa1, pa2, pa3); ASBAR();
        pv_d0(o, vb0, pa0, pa1, pa2, pa3); partialSM(pB0, pB1, m_reg, mnB, alB);
        __syncthreads(); RESC(alB);
        finishSM(pB0, pB1, alB, l_reg, pa0, pa1, pa2, pa3); ASBAR();
        pv_d0(o, vb0 + SHM_V, pa0, pa1, pa2, pa3);
#undef SLOAD
#undef SWRITE
#undef SWAIT
#undef RESC
        int lane_e = lane; asm volatile("" : "+v"(lane_e)); const int r32e = lane_e & 31, hie = lane_e >> 5;
        if (hie == 0) li_l[r32e] = l_reg; asm volatile("s_waitcnt lgkmcnt(0)" ::: "memory");
        float rli[16];
#pragma unroll
        for (int r = 0; r < 16; ++r) rli[r] = __builtin_amdgcn_rcpf(li_l[crow(r, hie)]);
        if (m == 0) {
#pragma unroll
            for (int d0 = 0; d0 < 4; ++d0)
#pragma unroll
                for (int r = 0; r < 16; r += 2) stash[(wid * 32 + d0 * 8 + (r >> 1)) * 64 + lane_e] = cvtpk(o[d0][r] * rli[r], o[d0][r + 1] * rli[r + 1]);
        } else {
            const float lam = ld_f32_dev((const float*)(p.ws + WS_LAM) + l * 4), oml = ld_f32_dev((const float*)(p.ws + WS_LAM) + l * 4 + 1);
            float ss[16];
#pragma unroll
            for (int r = 0; r < 16; ++r) ss[r] = 0.f;
#pragma unroll
            for (int d0 = 0; d0 < 4; ++d0)
#pragma unroll
                for (int r = 0; r < 16; r += 2) { const unsigned w = stash[(wid * 32 + d0 * 8 + (r >> 1)) * 64 + lane_e];
                    o[d0][r] = bf_lo(w) - lam * o[d0][r] * rli[r]; o[d0][r + 1] = bf_hi(w) - lam * o[d0][r + 1] * rli[r + 1];
                    ss[r] += o[d0][r] * o[d0][r]; ss[r + 1] += o[d0][r + 1] * o[d0][r + 1]; }
#pragma unroll
            for (int r = 0; r < 16; ++r) { float q = ss[r]; q += __shfl_xor(q, 1); q += __shfl_xor(q, 2); q += __shfl_xor(q, 4); q += __shfl_xor(q, 8); q += __shfl_xor(q, 16);
                ss[r] = rsqrtf(q * (1.0f / 128.0f) + EPS) * oml; }
            const float* gs = p.in[I_GSUBLN] + l * 128;
            asm volatile("s_waitcnt lgkmcnt(0)" ::: "memory");
            LAS bf16_t* ot = (LAS bf16_t*)(stash + wid * 32 * 64);
#pragma unroll
            for (int d0 = 0; d0 < 4; ++d0) { const float g = gs[d0 * 32 + r32e];
#pragma unroll
                for (int r = 0; r < 16; ++r) ot[((r & 3) + 8 * (r >> 2) + 4 * hie) * 128 + d0 * 32 + r32e] = (bf16_t)(cvtpk(o[d0][r] * ss[r] * g, 0.f) & 0xffffu); }
            asm volatile("s_waitcnt lgkmcnt(0)" ::: "memory");
            { bf16_t* dst = QB + (size_t)(qrow0 + wid * 32) * 512 + h * 128;
#pragma unroll
              for (int i = 0; i < 8; ++i) { const int row = i * 4 + (lane_e >> 4), pc = (lane_e & 15) * 8;
                  *(u32x4*)(dst + (size_t)row * 512 + pc) = *(const LAS u32x4*)(ot + row * 128 + pc); } }
        }
        __syncthreads();
    }
}
}
__device__ __forceinline__ void gmlp_unit(const Params& p, int l, int r0, LAS unsigned char* lds) {
    int tid_ = threadIdx.x; asm volatile("" : "+v"(tid_));
    const int tid = tid_, wid = __builtin_amdgcn_readfirstlane(tid >> 6), lane = tid & 63, r32 = lane & 31, hi = lane >> 5;
    const bf16_t* VG = pbuf(p, P_VGB); bf16_t* UB = pbuf(p, P_UB);
    PSEC_BEGIN8();
    {
        const int sr = tid >> 4, sc = (tid & 15) * 8, vst0 = att::v_st(sr, sc);
        u32x4 x[4][4]; float rs[4];
#pragma unroll
        for (int k = 0; k < 4; ++k)
#pragma unroll
            for (int g = 0; g < 4; ++g) x[k][g] = *(const u32x4*)(VG + (size_t)(r0 + sr + 32 * k) * 512 + g * 128 + sc);
#pragma unroll
        for (int k = 0; k < 4; ++k) { float ss = 0.f;
#pragma unroll
            for (int g = 0; g < 4; ++g) { float v[8]; unpack8(x[k][g], v);
#pragma unroll
                for (int j = 0; j < 8; ++j) ss += v[j] * v[j]; }
            ss += __shfl_xor(ss, 1); ss += __shfl_xor(ss, 2); ss += __shfl_xor(ss, 4); ss += __shfl_xor(ss, 8);
            rs[k] = rsqrtf(ss * (1.0f / 512.0f) + EPS); }
#pragma unroll
        for (int k = 0; k < 4; ++k)
#pragma unroll
            for (int g = 0; g < 4; ++g) { float v[8]; unpack8(x[k][g], v);
#pragma unroll
                for (int j = 0; j < 8; ++j) v[j] *= rs[k];
                *(LAS u32x4*)(lds + (g * 2 + (k >> 1)) * att::SHM_V + (k & 1) * 8192 + vst0) = pack8(v); }
    }
    __syncthreads();
    const int rb = wid >> 1, dh = wid & 1;
    const int vb0 = (int)(uintptr_t)lds + att::v_rd_base(lane) + dh * 1024;
    LAS float* F = (LAS float*)(lds + 8 * att::SHM_V) + wid * 576;
    const bf16_t* Wsb = (const bf16_t*)(p.ws + WS_WSB) + (size_t)l * 4 * 16384 + (size_t)(32 * rb + r32) * 128 + 8 * hi;
#pragma unroll 1
    for (int g = 0; g < 4; ++g) {
        bf16x8 pa[2][4];
#pragma unroll
        for (int kt = 0; kt < 2; ++kt)
#pragma unroll
            for (int k4 = 0; k4 < 4; ++k4) pa[kt][k4] = *(const bf16x8*)(Wsb + (size_t)g * 16384 + 64 * kt + 16 * k4);
        bf16_t* up = UB + (size_t)(r0 + 32 * rb + (lane >> 2)) * 512 + g * 128 + 64 * dh + 8 * (lane & 3);
        u32x4 uu[2][2];
#pragma unroll
        for (int d0 = 0; d0 < 2; ++d0)
#pragma unroll
            for (int rd = 0; rd < 2; ++rd) uu[d0][rd] = *(const u32x4*)(up + (size_t)(16 * rd) * 512 + 32 * d0);
        const float* gv = p.in[I_GGV] + l * 512 + g * 128 + 64 * dh + r32; const float* bs = p.in[I_BGS] + (l * 4 + g) * 128 + 32 * rb;
        const float gv0 = gv[0], gv1 = gv[32];
        float bsv[16];
#pragma unroll
        for (int r = 0; r < 16; ++r) bsv[r] = bs[crow(r, hi)];
        __builtin_amdgcn_sched_barrier(0);
        f32x16 o[2] = {};
        att::pv_one<0>(o[0], vb0 + (g * 2) * att::SHM_V, pa[0][0], pa[0][1], pa[0][2], pa[0][3]); att::pv_one<1>(o[1], vb0 + (g * 2) * att::SHM_V, pa[0][0], pa[0][1], pa[0][2], pa[0][3]);
        att::pv_one<0>(o[0], vb0 + (g * 2 + 1) * att::SHM_V, pa[1][0], pa[1][1], pa[1][2], pa[1][3]); att::pv_one<1>(o[1], vb0 + (g * 2 + 1) * att::SHM_V, pa[1][0], pa[1][1], pa[1][2], pa[1][3]);
#pragma unroll
        for (int d0 = 0; d0 < 2; ++d0)
#pragma unroll
            for (int rd = 0; rd < 2; ++rd) {
#pragma unroll
                for (int r = 0; r < 8; ++r) { const int rr = 8 * rd + r; F[((r & 3) + 8 * ((r >> 2) & 1) + 4 * hi) * 36 + r32] = o[d0][rr] * (d0 ? gv1 : gv0) + bsv[rr]; }
                asm volatile("s_waitcnt lgkmcnt(0)" ::: "memory");
                const f32x4 m0 = *(const LAS f32x4*)(F + (lane >> 2) * 36 + 8 * (lane & 3)), m1 = *(const LAS f32x4*)(F + (lane >> 2) * 36 + 8 * (lane & 3) + 4);
                float u8[8]; unpack8(uu[d0][rd], u8);
#pragma unroll
                for (int j = 0; j < 4; ++j) { u8[j] *= m0[j]; u8[4 + j] *= m1[j]; }
                *(u32x4*)(up + (size_t)(16 * rd) * 512 + 32 * d0) = pack8(u8);
                asm volatile("s_waitcnt lgkmcnt(0)" ::: "memory");
            }
    }
    __syncthreads();
    PSEC(8);
}
constexpr int N_PHASES = 36;
typedef const __attribute__((address_space(4))) Params* KParams;
#define PHASE_P() const Params& p = *(const Params*)opaque_kp()
__device__ __forceinline__ KParams opaque_kp() { KParams q = (KParams)__builtin_amdgcn_kernarg_segment_ptr(); asm volatile("" : "+s"(q)); return q; }
__global__ void __launch_bounds__(NTHR, 2) mk_fwd(Params p_arg, int bar_region) {
    extern __shared__ __attribute__((aligned(16))) unsigned char lds_raw[];
    LAS unsigned char* lds = (LAS unsigned char*)lds_raw;
    const int tid = threadIdx.x, G = gridDim.x, bid = blockIdx.x;
    volatile LAS unsigned* xbw = (volatile LAS unsigned*)(lds + LDS_BYTES - 16);
    if (tid == 0) { xbw[0] = 0u; xbw[1] = 0u; xbw[2] = 0u; xbw[3] = 0u; }
    __syncthreads();
    (void)xcd_barrier_post((unsigned*)(p_arg.ws + WS_CTL) + CW_BAR + bar_region * 4096, xbw);
    const int lo = p_arg.ph_lo, hi = p_arg.ph_hi;
#define IN(k) (lo <= (k) && (k) < hi)
#ifdef PROBE
#define STAMP(k) do { if (tid == 0) { if (bid == 0) ((unsigned long long*)(opaque_kp()->ws + WS_CTL))[30000 + (k)] = __builtin_amdgcn_s_memrealtime(); *(volatile LAS int*)(lds + LDS_BYTES - 32) = (k); } __syncthreads(); } while (0)
#else
#define STAMP(k) do { } while (0)
#endif
#define GRID_BARRIER() do { KParams kq = opaque_kp(); XcdBarrier b_; b_.bar = (unsigned*)(kq->ws + WS_CTL) + CW_BAR + ((const __attribute__((address_space(4))) int*)(kq + 1))[0] * 4096; b_.x = xb_xcc_id(); b_.st = xbw; xcd_barrier(b_); } while (0)
#define SEAM(k) do { if (IN(k) && IN((k) + 1)) { GRID_BARRIER(); STAMP((k) + 1); } } while (0)

    STAMP(0);
#if !defined(ONLY) || ONLY == 0
    if (IN(0)) { PHASE_P(); phase_prologue(p, lds); }
#endif
    SEAM(0);
    for (int l = 0; l < 2; ++l) {
        const int base = 1 + 17 * l;
#if !defined(ONLY) || ONLY == 1
        if (IN(base)) { PHASE_P(); phase_norm1(p, l); }
#endif
        SEAM(base);
        for (int hf = 0; hf < 2; ++hf) {
            const int hb = base + 1 + 6 * hf;
#if !defined(ONLY) || ONLY == 2
            if (IN(hb)) {
                PHASE_P(); unsigned char* ws = p.ws; bf16_t* Hh = (bf16_t*)(ws + WS_H) + (size_t)hf * MH * 1024; (void)Hh;
                const float* cosT = (const float*)(ws + WS_ROPE); const float* sinT = cosT + 1024;
                pg8::Gemm g{Hh, (const bf16_t*)(ws + WS_WTIN) + (size_t)l * NCOL * 1024, MH, NCOL, 1024};
                int cin = bid; if (hf == 1) { cin += G >> 1; if (cin >= G) cin -= G; }
                RectOrder S; if (l == 0) S.init(72, 14, 0, 0, 0, 0, G, cin); else S.init(64, 14, 8, 8, 6, 0, G, cin);
                EpiIn E{pbuf(p, 0), pbuf(p, P_GB), cosT, sinT};
                pg8::gemm_phase<EpiIn, RectOrder>((PG8_LAS unsigned char*)lds, g, S, E, nullptr);
                pg8::Gemm g8{(const bf16_t*)(ws + WS_H8 + (size_t)hf * MH * 1024), (const bf16_t*)(ws + WS_WTIN8 + (size_t)l * 3072 * 1024), MH, 3072, 512};
                RectOrder S8; S8.init(l == 0 ? 72 : 64, 12, l == 0 ? 0 : 8, 0, 0, 0, G, G - 1 - cin);
                EpiGate8 E8{pbuf(p, P_GB)};
                pg8::gemm_phase<EpiGate8, RectOrder, false, true>((PG8_LAS unsigned char*)lds, g8, S8, E8, nullptr);
            }
#endif
            SEAM(hb);
#if !defined(ONLY) || ONLY == 3
            if (IN(hb + 1)) {
                PSEC_BEGIN6();
                { PHASE_P(); phase_conv(p, l, lds); }
                PSEC(6);
                GRID_BARRIER(); PSEC(7);
                PHASE_P();
                const int n_a = HBAT * NJ * 4, n_g = HBAT * 16 + (l == 0 ? HBAT * 2 : 0);
                const int bidx = (G == 256) ? ((bid & 7) * 32 + (bid >> 3)) : bid;
                int u = bidx;
                PSEC(13);
                { u32x4 qa[4], qb[4], qwq[4], qwk[4], qwv[4]; f32x4 qg; mlstm_a_load(p, l, u < n_a ? u : 0, APRE_ARGS);
                  for (; u < n_a; u += G) mlstm_a_unit(p, l, u, u + G, n_a, APRE_ARGS, lds); }
                PSEC(14);
                for (; u < n_a + n_g; u += G) { const int v = u - n_a; int r0; if (v < HBAT * 16) r0 = CTXROWS + (v >> 4) * 2048 + (v & 15) * 128; else { const int w = v - HBAT * 16; r0 = (w >> 1) * 256 + (w & 1) * 128; }
                    gmlp_unit(p, l, r0, lds); }
            }
#endif
            SEAM(hb + 1);
#if !defined(ONLY) || ONLY == 4
            if (IN(hb + 2)) {
                PHASE_P();
                phase_scan(p);
            }
#endif
            SEAM(hb + 2);
#if !defined(ONLY) || ONLY == 5
            if (IN(hb + 3)) {
                PHASE_P();
                const int n_l = HBAT * 4 * 8, n_c = (l == 0 ? HBAT * 4 : 0);
                for (int u = bid; u < n_l + n_c; u += G) {
                    int h, qrow0, rc, rl, NT;
                    if (u < n_l) { const int ue = (G == 256) ? ((((u & 7) * 4 + (u >> 6)) << 3) | ((u >> 3) & 7)) : u;
                        const int bl = ue >> 5, qb = ue & 7; h = (ue >> 3) & 3; qrow0 = CTXROWS + bl * 2048 + qb * 256; rc = bl * 256; rl = CTXROWS + bl * 2048; NT = 36; }
                    else { const int v = u - n_l, bl = v >> 2; h = v & 3; qrow0 = bl * 256; rc = bl * 256; rl = 0; NT = 4; }
                    PSEC_BEGINN(9); att::attn_unit(p, l, h, qrow0, rc, rl, NT, lds); PSEC(9);
                }
                const int m_l = HBAT * 16 * 4, m_c = (l == 0 ? HBAT * 2 * 4 : 0);
                int u0 = bid + 192; if (u0 >= G) u0 -= G;
                { u32x4 cq[4], ck[4], cv[4], ccf[4], ccb[4]; f32x4 cg; float cn; const int n_c = m_l + m_c;
                  mlstm_c_load(p, u0 < n_c ? u0 : 0, CPRE_ARGS);
                  for (int u = u0; u < n_c; u += G) mlstm_c_unit(p, l, u, u + G, n_c, CPRE_ARGS, lds); }
                if (l == 0 && G == 256 && !(bid >= 64 && bid < 128)) cvt_fill(p, lds, hf == 0 ? 0 : CVT_Q1, hf == 0 ? CVT_Q0 : CVT_Q2, bid < 64 ? bid : bid - 64, 192);
                else if (l == 0 && G != 256) cvt_fill(p, lds, hf == 0 ? 0 : CVT_Q1, hf == 0 ? CVT_Q0 : CVT_Q2, bid, G);
            }
#endif
            SEAM(hb + 3);
#if !defined(ONLY) || ONLY == 6
            if (IN(hb + 4)) {
                PHASE_P(); unsigned char* ws = p.ws; bf16_t* Hh = (bf16_t*)(ws + WS_H) + (size_t)hf * MH * 1024; (void)Hh;
                pg8::Gemm g{pbuf(p, P_QB), (const bf16_t*)(ws + WS_WTBR) + (size_t)l * 3072 * 512, 3 * MH, 3072, 512};
                MergeOrder S; S.init(l == 0 ? 72 : 64, l == 0 ? 0 : 8, G, bid);
                EpiMerge E{pbuf(p, P_GB), Hh};
                pg8::gemm_phase<EpiMerge, MergeOrder>((PG8_LAS unsigned char*)lds, g, S, E, nullptr);
                if (l == 0) { const int skip = G > 64 ? 32 : 0; __syncthreads(); if (bid >= skip) cvt_fill(p, lds, hf == 0 ? CVT_Q0 : CVT_Q2, hf == 0 ? CVT_Q1 : CVT_Q3, bid - skip, G - skip); }
            }
#endif
            SEAM(hb + 4);
#if !defined(ONLY) || ONLY == 7
            if (IN(hb + 5)) {
                PHASE_P(); unsigned char* ws = p.ws; bf16_t* Hh = (bf16_t*)(ws + WS_H) + (size_t)hf * MH * 1024; (void)Hh;
                pg8::Gemm g{Hh, (const bf16_t*)(ws + WS_WTO) + (size_t)l * 1024 * 1024, MH, 1024, 1024};
                RectOrder S; S.init(l == 0 ? 72 : 64, 4, l == 0 ? 0 : 8, 0, 0, 0, G, bid);
                EpiOut E{l == 0 ? p.in[I_X] : (const float*)p.out, l == 0 ? p.in[I_CTX] : (const float*)(ws + WS_XC), p.out, (float*)(ws + WS_XC), (const float*)(ws + WS_MOD) + (size_t)l * 17 * 6144, hf};
                pg8::gemm_phase<EpiOut, RectOrder>((PG8_LAS unsigned char*)lds, g, S, E, nullptr);
                if (l == 0 && hf == 1) { const int skip = G > 64 ? 32 : 0; __syncthreads(); if (bid >= skip) cvt_fill(p, lds, CVT_Q3, CVT_Q4, bid - skip, G - skip); }
            }
#endif
            if (hf == 1) SEAM(hb + 5);
        }
#if !defined(ONLY) || ONLY == 8
        if (IN(base + 13)) { PHASE_P(); phase_norm2_router(p, l, lds); if (l == 1) cvt_fill(p, lds, CVT_Q4, 2 * CVT_TILES, bid, G); }
#endif
        SEAM(base + 13);
#if !defined(ONLY) || ONLY == 9
        if (IN(base + 14)) { PHASE_P(); phase_dispatch(p, l, lds); }
#endif
        SEAM(base + 14);
#if !defined(ONLY) || ONLY == 10
        if (IN(base + 15)) {
            PHASE_P(); unsigned char* ws = p.ws;
            LAS int* seg = (LAS int*)(lds + 131072); LAS int* tile_e = seg + 128;
            const int nt = moe_tile_table(p, l, seg, tile_e);
            pg8::Gemm g{(const bf16_t*)(ws + WS_H8), (const bf16_t*)(ws + WS_WTGU + (size_t)l * 32 * 1024 * 1024), SLOTS, 32 * 1024, 512};
            MoeOrder S; S.init(tile_e, nt, G, bid);
            { LAS int* srcl = (LAS int*)(lds + 131072 + 2048); const int* SRC = (const int*)(ws + WS_SRC);
              for (int i = 0; i < 6; ++i) { int pm, pn; S.unit_of(i, pm, pn); for (int r = opaque_tid(); r < 256; r += NTHR) srcl[i * 256 + r] = pm < nt ? SRC[pm * 256 + r] : 0; }
              S.srcl = srcl; }
            __syncthreads(); EpiGU E{ws + WS_P + P_ACT};
            pg8::gemm_phase<EpiGU, MoeOrder, false, true, true>((PG8_LAS unsigned char*)lds, g, S, E, nullptr);
        }
#endif
        SEAM(base + 15);
#if !defined(ONLY) || ONLY == 11
        if (IN(base + 16)) {
            PHASE_P(); unsigned char* ws = p.ws;
            LAS int* seg = (LAS int*)(lds + 131072); LAS int* tile_e = seg + 128;
            const int nt = moe_tile_table(p, l, seg, tile_e);
            pg8::Gemm g{pbuf(p, P_ACT), (const bf16_t*)(ws + WS_WTD + (size_t)l * 32 * 1024 * 512), SLOTS, 32 * 1024, 256};
            MoeOrder S; S.init(tile_e, nt, G, bid); __syncthreads(); EpiDown E{pbuf(p, P_YS)};
            pg8::gemm_phase<EpiDown, MoeOrder, false, true>((PG8_LAS unsigned char*)lds, g, S, E, nullptr);
        }
#endif
        SEAM(base + 16);
    }
#if !defined(ONLY) || ONLY == 12
    if (IN(35)) { PHASE_P(); phase_final(p); }
#endif
#ifdef PROBE
    if (bid == 0 && tid == 0) {
        asm volatile("s_waitcnt vmcnt(0)" ::: "memory");
        const unsigned long long tend = __builtin_amdgcn_s_memrealtime();
        volatile unsigned long long* st = (volatile unsigned long long*)(opaque_kp()->ws + WS_CTL) + 30000;
        unsigned long long ta = 0, tb = 0;
        for (int k = 0; k < N_PHASES; ++k) { const unsigned long long t0 = st[k], t1 = (k == N_PHASES - 1) ? tend : st[k + 1]; const unsigned long long d = t1 - t0;
            if ((PROBE_A >> k) & 1ull) ta += d; if ((PROBE_B >> k) & 1ull) tb += st[100 + k]; }
        const unsigned long long spin = ((ta + tb) / 1000ull) * 100000ull;
        while (__builtin_amdgcn_s_memrealtime() - tend < spin) __builtin_amdgcn_s_sleep(32);
    }
#endif
#undef IN
#undef SEAM
}

#ifndef MK_CUTS
#define MK_CUTS 0
#endif
extern "C" void kernel_launch(void* const* d_in, const int* in_sizes, int n_in, void* d_out, int out_size, void* d_ws, size_t ws_size, hipStream_t stream) {
    static int grid = 0;
    if (grid == 0) {
        if (n_in != 31 || in_sizes[0] != NBATCH * SEQ * DM || out_size != NBATCH * SEQ * DM || ws_size < WS_END) {
            fprintf(stderr, "kernel_launch: unexpected shapes or workspace (n_in %d, ws %zu, need %zu); nothing launched\n", n_in, ws_size, (size_t)WS_END); grid = -1; return; }
        int dev = 0, cus = 0, per_cu = 0;
        if (hipGetDevice(&dev) != hipSuccess || hipDeviceGetAttribute(&cus, hipDeviceAttributeMultiprocessorCount, dev) != hipSuccess) { grid = -1; return; }
        if (hipFuncSetAttribute((const void*)mk_fwd, hipFuncAttributeMaxDynamicSharedMemorySize, LDS_BYTES) != hipSuccess) { fprintf(stderr, "kernel_launch: hipFuncSetAttribute failed\n"); grid = -1; return; }
        if (hipOccupancyMaxActiveBlocksPerMultiprocessor(&per_cu, (const void*)mk_fwd, NTHR, LDS_BYTES) != hipSuccess || per_cu < 1) { fprintf(stderr, "kernel_launch: occupancy query says %d\n", per_cu); }
        (void)hipGetLastError();
        grid = cus;
    }
    if (grid < 0) return;
    if (hipMemsetAsync((char*)d_ws + WS_CTL, 0, CTL_BYTES, stream) != hipSuccess) return;
    Params p{};
    for (int i = 0; i < 31; ++i) p.in[i] = (const float*)d_in[i];
    p.out = (float*)d_out; p.ws = (unsigned char*)d_ws;
#if MK_CUTS == 0
    p.ph_lo = 0; p.ph_hi = N_PHASES;
    hipLaunchKernelGGL(mk_fwd, dim3(grid), dim3(NTHR), LDS_BYTES, stream, p, 0);
#else
    for (int k = 0; k < N_PHASES; ++k) {
#ifdef EXP_NOMOE
        if ((k >= 14 && k <= 17) || (k >= 31 && k <= 34)) continue;
#endif
#ifdef EXP_NOEXPERT
        if (k == 16 || k == 17 || k == 33 || k == 34) continue;
#endif
#ifdef EXP_NOGU
        if (k == 16 || k == 33) continue;
#endif
#ifdef EXP_NOMIX
        if ((k >= 2 && k <= 13) || (k >= 19 && k <= 30)) continue;
#endif
#ifdef EXP_ZEROXB
        if (k == 15 || k == 32) { hipMemsetAsync((char*)d_ws + WS_P + P_XB, 0, P_MOE_END, stream); hipMemsetAsync((char*)d_ws + WS_WTS, 0, (size_t)SLOTS * 4, stream); }
#endif
        p.ph_lo = k; p.ph_hi = k + 1; hipLaunchKernelGGL(mk_fwd, dim3(grid), dim3(NTHR), LDS_BYTES, stream, p, 0); }
#endif
}
```

```cpp
#include <hip/hip_runtime.h>
#include <cstdio>
#include <cstdint>

#define LAS __attribute__((address_space(3)))
typedef unsigned short bf16_t;
typedef short bf16x8 __attribute__((ext_vector_type(8)));
typedef short s16x4 __attribute__((ext_vector_type(4)));
typedef float f32x2 __attribute__((ext_vector_type(2)));
typedef float f32x4 __attribute__((ext_vector_type(4)));
typedef float f32x16 __attribute__((ext_vector_type(16)));
typedef unsigned u32x2 __attribute__((ext_vector_type(2)));
typedef unsigned u32x4 __attribute__((ext_vector_type(4)));

constexpr int DM = 1024, NBATCH = 16, SEQ = 2048, CTXL = 256, NCOL = 6656;
constexpr int HBAT = 8;
constexpr int MH = HBAT * (SEQ + CTXL);
constexpr int MTOT = 2 * MH;
constexpr int CTXROWS = HBAT * CTXL;
constexpr int NJ = 18;
constexpr int NEXP = 32, DEXP = 512;
constexpr int SLOTS = 81920;
constexpr float EPS = 1e-6f;
constexpr float LOG2E = 1.4426950408889634f;
constexpr float QSCALE = 0.125f * LOG2E;
constexpr int NTHR = 512;
constexpr int LDS_BYTES = 155648;
constexpr int TLD = 136;
constexpr int TILE_B = 128 * TLD * 2;

constexpr size_t AL(size_t x) { return (x + 255) / 256 * 256; }
constexpr size_t WS_CTL   = 0;
constexpr size_t CTL_BYTES = 262144;
constexpr size_t WS_MOD   = WS_CTL + CTL_BYTES;
constexpr size_t WS_WFOLD = WS_MOD + AL((size_t)2 * 17 * 6144 * 4);
constexpr size_t WS_ROPE  = WS_WFOLD + AL((size_t)2 * 16 * 1024 * 4);
constexpr size_t WS_LAM   = WS_ROPE + AL((size_t)2 * 64 * 16 * 4);
constexpr size_t WS_WRT   = WS_LAM + 256;
constexpr size_t WS_WTIN  = WS_WRT + AL((size_t)2 * 2 * 48 * 1024 * 2);
constexpr size_t WS_WTBR  = WS_WTIN + AL((size_t)2 * NCOL * 1024 * 2);
constexpr size_t WS_WTO   = WS_WTBR + AL((size_t)2 * 3072 * 512 * 2);
constexpr size_t WS_WTQKV = WS_WTO + AL((size_t)2 * 1024 * 1024 * 2);
constexpr size_t WS_WSB   = WS_WTQKV + AL((size_t)2 * 12 * 16384 * 2);
constexpr size_t WS_WTGU  = WS_WSB + AL((size_t)2 * 4 * 16384 * 2);
constexpr size_t WS_WTD   = WS_WTGU + AL((size_t)32 * 1024 * 1024 * 2);
constexpr size_t WS_XC    = WS_WTD + AL((size_t)32 * 1024 * 512 * 2);
constexpr size_t WS_H     = WS_XC + AL((size_t)4096 * 1024 * 4);
constexpr size_t WS_H8    = WS_H + AL((size_t)MTOT * 1024 * 2);
constexpr size_t WS_WTIN8 = WS_H8 + AL((size_t)MTOT * 1024);
constexpr size_t WS_EID   = WS_WTIN8 + AL((size_t)2 * 3072 * 1024);
constexpr size_t WS_WTK   = WS_EID + AL((size_t)MTOT * 8);
constexpr size_t WS_POS   = WS_WTK + AL((size_t)MTOT * 8);
constexpr size_t WS_WTS   = WS_POS + AL((size_t)MTOT * 8);
constexpr size_t WS_SRC   = WS_WTS + AL((size_t)SLOTS * 4);
constexpr size_t WS_P     = WS_SRC + AL((size_t)SLOTS * 4);
constexpr size_t S1B      = (size_t)MH * 512 * 2;
constexpr size_t P_KB = 0, P_VB = S1B, P_XMB = 2 * S1B, P_QB = 3 * S1B, P_UB = 4 * S1B, P_ZB = 5 * S1B, P_VGB = 6 * S1B;
constexpr size_t P_GB   = 7 * S1B;
constexpr size_t P_MQ   = P_GB + (size_t)3 * MH * 1024;
constexpr size_t P_MK   = P_MQ + S1B, P_MVT = P_MK + S1B, P_XCV = P_MVT + S1B;
constexpr size_t P_GATES = P_XCV + S1B;
constexpr size_t P_CLOC = P_GATES + AL((size_t)MH * 16 * 4);
constexpr size_t P_NLOC = P_CLOC + (size_t)64 * NJ * 16384 * 2;
constexpr size_t P_MST  = P_NLOC + AL((size_t)64 * NJ * 128 * 4);
constexpr size_t P_END  = P_MST + AL((size_t)64 * NJ * 4 * 4);
constexpr size_t P_XB   = 0;
constexpr size_t P_ACT  = (size_t)SLOTS * 1024;
constexpr size_t P_YS   = P_ACT + (size_t)SLOTS * 512;
constexpr size_t P_MOE_END = P_YS + (size_t)SLOTS * 1024 * 2;
constexpr float WSCALE8 = 635.0f, HSCALE8 = 10.5f, ASCALE8 = 16.0f;
constexpr size_t WS_END = WS_P + (P_END > P_MOE_END ? P_END : P_MOE_END);
constexpr int CW_EXPCNT = 0;
constexpr int CW_HIST = 32768;
constexpr int CW_BAR = 1024;

__device__ __forceinline__ unsigned cvtpk(float lo, float hi) { unsigned r; asm volatile("v_cvt_pk_bf16_f32 %0, %1, %2" : "=v"(r) : "v"(lo), "v"(hi)); return r; }
__device__ __forceinline__ float bf_lo(unsigned w) { return __uint_as_float(w << 16); }
__device__ __forceinline__ float bf_hi(unsigned w) { return __uint_as_float(w & 0xffff0000u); }
__device__ __forceinline__ float bf2f(bf16_t b) { return __uint_as_float(((unsigned)b) << 16); }
__device__ __forceinline__ bf16_t f2bf(float f) { unsigned u = __float_as_uint(f); u += 0x7FFFu + ((u >> 16) & 1u); return (bf16_t)(u >> 16); }
__device__ __forceinline__ float sigmoid_f(float x) { return __builtin_amdgcn_rcpf(1.0f + __builtin_amdgcn_exp2f(-x * LOG2E)); }
__device__ __forceinline__ float gelu_tanh_f(float x) { const float u = 0.7978845608028654f * (x + 0.044715f * x * x * x); return x * sigmoid_f(2.0f * u); }
__device__ __forceinline__ float silu_f(float x) { return x * sigmoid_f(x); }
__device__ __forceinline__ float logsigmoid_f(float x) { return fminf(x, 0.f) - 0.6931471805599453f * __builtin_amdgcn_logf(1.0f + __builtin_amdgcn_exp2f(-fabsf(x) * LOG2E)); }
__device__ __forceinline__ int crow(int r, int hi) { return (r & 3) + 8 * (r >> 2) + 4 * hi; }
__device__ __forceinline__ f32x16 mfma32(bf16x8 a, bf16x8 b, f32x16 c) { return __builtin_amdgcn_mfma_f32_32x32x16_bf16(a, b, c, 0, 0, 0); }
__device__ __forceinline__ float wave_sum(float v) { for (int o = 32; o >= 1; o >>= 1) v += __shfl_xor(v, o); return v; }
template <int CTRL, int ROWMASK> __device__ __forceinline__ float dpp_add(float v) {
    return v + __builtin_bit_cast(float, __builtin_amdgcn_update_dpp(0, __builtin_bit_cast(int, v), CTRL, ROWMASK, 0xf, true)); }
__device__ __forceinline__ float wave_sum63(float v) {
    v = dpp_add<0x111, 0xf>(v); v = dpp_add<0x112, 0xf>(v); v = dpp_add<0x114, 0xf>(v); v = dpp_add<0x118, 0xf>(v);
    v = dpp_add<0x142, 0xa>(v);
    v = dpp_add<0x143, 0xc>(v);
    return v; }
__device__ __forceinline__ float half_sum31(float v) {
    v = dpp_add<0x111, 0xf>(v); v = dpp_add<0x112, 0xf>(v); v = dpp_add<0x114, 0xf>(v); v = dpp_add<0x118, 0xf>(v);
    v = dpp_add<0x142, 0xa>(v); return v; }
__device__ __forceinline__ float wave_max(float v) { for (int o = 32; o >= 1; o >>= 1) v = fmaxf(v, __shfl_xor(v, o)); return v; }

__device__ __forceinline__ void unpack8(const u32x4 w, float (&o)[8]) { o[0] = bf_lo(w.x); o[1] = bf_hi(w.x); o[2] = bf_lo(w.y); o[3] = bf_hi(w.y); o[4] = bf_lo(w.z); o[5] = bf_hi(w.z); o[6] = bf_lo(w.w); o[7] = bf_hi(w.w); }
__device__ __forceinline__ u32x4 pack8(const float (&v)[8]) { u32x4 w; w.x = cvtpk(v[0], v[1]); w.y = cvtpk(v[2], v[3]); w.z = cvtpk(v[4], v[5]); w.w = cvtpk(v[6], v[7]); return w; }
__device__ __forceinline__ int ld_i32_dev(const int* p) { return __hip_atomic_load(p, __ATOMIC_RELAXED, __HIP_MEMORY_SCOPE_AGENT); }
__device__ __forceinline__ float ld_f32_dev(const float* p) { return __hip_atomic_load(p, __ATOMIC_RELAXED, __HIP_MEMORY_SCOPE_AGENT); }
__device__ __forceinline__ unsigned q8(float x) { return (unsigned)(int)fminf(fmaxf(rintf(x), -127.0f), 127.0f) & 0xffu; }
__device__ __forceinline__ unsigned pk4_fp8(float a, float b, float c, float d) { return q8(a) | (q8(b) << 8) | (q8(c) << 16) | (q8(d) << 24); }
#define LBAR() do { asm volatile("s_waitcnt lgkmcnt(0)" ::: "memory"); __builtin_amdgcn_s_barrier(); asm volatile("" ::: "memory"); } while (0)
__device__ __forceinline__ int opaque_tid() { int t = threadIdx.x; asm volatile("" : "+v"(t)); return t; }
#ifdef PROBE
__device__ __forceinline__ unsigned long long* probe_epi_counter() {
    unsigned char* ws = *(unsigned char* const __attribute__((address_space(4)))*)((const __attribute__((address_space(4))) char*)__builtin_amdgcn_kernarg_segment_ptr() + 256);
    const int ph = *(volatile LAS int*)(uintptr_t)(LDS_BYTES - 32);
    return (unsigned long long*)ws + 30100 + ph; }
#endif
#ifdef PROBE
#define PSEC_BEGIN() unsigned pt_ = 0; if (PROBE_SEC == 1) pt_ = (unsigned)__builtin_amdgcn_s_memrealtime()
#define PSEC_BEGINN(n) unsigned pt_ = 0; if (PROBE_SEC == (n)) pt_ = (unsigned)__builtin_amdgcn_s_memrealtime()
#define PSEC_BEGIN6() unsigned pt_ = 0; if (PROBE_SEC == 6) pt_ = (unsigned)__builtin_amdgcn_s_memrealtime()
#define PSEC_BEGIN8() unsigned pt_ = 0; if (PROBE_SEC == 8) pt_ = (unsigned)__builtin_amdgcn_s_memrealtime()
#define PSEC(id) do { if (PROBE_SEC == (id)) { const unsigned pn_ = (unsigned)__builtin_amdgcn_s_memrealtime(); if (blockIdx.x == PROBE_BLK && tid == 0) *probe_epi_counter() += (unsigned long long)(pn_ - pt_); } if (PROBE_SEC == (id) + 1) pt_ = (unsigned)__builtin_amdgcn_s_memrealtime(); } while (0)
#else
#define PSEC_BEGIN() do { } while (0)
#define PSEC_BEGIN6() do { } while (0)
#define PSEC_BEGINN(n) do { } while (0)
#define PSEC_BEGIN8() do { } while (0)
#define PSEC(id) do { } while (0)
#endif
struct Params {
    const float* in[31];
    float* out;
    unsigned char* ws;
    int ph_lo, ph_hi;
};
enum { I_X = 0, I_C, I_CTX, I_CCTX, I_WMOD, I_BMOD, I_GN1, I_GN2, I_WIN, I_DLAM, I_GSUBLN, I_WGS, I_BGS, I_GGV, I_WCONV, I_BCONV, I_WQKV, I_WIF, I_BIF,
       I_GMN, I_SKIP, I_WBR, I_WOUT, I_WRG, I_BRG, I_WRE, I_BRE, I_WEG, I_WEU, I_WED, I_GFIN };

struct RowInfo { int hf, r, isctx, b, t; };
__device__ __forceinline__ RowInfo row_info(int R) {
    RowInfo q; q.hf = R >= MH ? 1 : 0; q.r = R - q.hf * MH;
    if (q.r < CTXROWS) { q.isctx = 1; q.b = q.hf * HBAT + (q.r >> 8); q.t = q.r & 255; }
    else { q.isctx = 0; const int s = q.r - CTXROWS; q.b = q.hf * HBAT + (s >> 11); q.t = s & 2047; }
    return q;
}
#define XB_TMO      128
#define XB_XCNT(j)  (256  + 64 * (j))
#define XB_XSUB(j)  (1280 + 64 * (j))
#define XB_XGEN(j)  (2304 + 64 * (j))
#define XB_TOP      3328
#define XB_TOPGEN   3392
#define XCD_BAR_WORDS 3456
#define XB_SPIN_CAP (1u << 18)

__device__ __forceinline__ unsigned xb_ld(unsigned* p)              { return __hip_atomic_load(p, __ATOMIC_RELAXED, __HIP_MEMORY_SCOPE_AGENT); }
__device__ __forceinline__ unsigned xb_add(unsigned* p, unsigned v) { return __hip_atomic_fetch_add(p, v, __ATOMIC_RELAXED, __HIP_MEMORY_SCOPE_AGENT); }
__device__ __forceinline__ unsigned xb_xcc_id() { return (unsigned)__builtin_amdgcn_s_getreg((3 << 11) | 20) & 0xFu; }
#define XB_SPIN(cond, bar) do { unsigned _sp = 0; while (cond) { __builtin_amdgcn_s_sleep(1); \
    if ((++_sp & 255u) == 0u) { if (xb_ld(&(bar)[XB_TMO])) break; if (_sp > XB_SPIN_CAP) { atomicAdd(&(bar)[XB_TMO], 1u); break; } } } } while (0)

struct XcdBarrier {
    unsigned* bar; unsigned x;
    volatile LAS unsigned* st;
};

__device__ __forceinline__ XcdBarrier xcd_barrier_post(unsigned* bar, volatile LAS unsigned* st) {
    XcdBarrier b; b.bar = bar; b.x = xb_xcc_id(); b.st = st;
    if (threadIdx.x == 0) (void)xb_add(&bar[XB_XCNT(b.x)], 1u);
    return b;
}
__device__ __forceinline__ void xcd_barrier_complete(unsigned* bar, unsigned x, unsigned& nloc, unsigned& nx) {
    const unsigned G = gridDim.x * gridDim.y * gridDim.z;
    unsigned sum, cnt, mine, sp = 0u;
    for (;;) {
        sum = 0u; cnt = 0u; mine = 0u;
#pragma unroll
        for (unsigned j = 0; j < 16; ++j) { const unsigned c = xb_ld(&bar[XB_XCNT(j)]); sum += c; cnt += (c > 0u) ? 1u : 0u; mine = (j == x) ? c : mine; }
        if (sum == G) break;
        __builtin_amdgcn_s_sleep(1);
        if ((++sp & 255u) == 0u) { if (xb_ld(&bar[XB_TMO])) break; if (sp > XB_SPIN_CAP) { atomicAdd(&bar[XB_TMO], 1u); break; } }
    }
    nloc = mine > 0u ? mine : 1u; nx = cnt > 0u ? cnt : 1u;
}

__device__ __forceinline__ void xcd_barrier(const XcdBarrier& b) {
    asm volatile("s_waitcnt vmcnt(0)" ::: "memory");
    __syncthreads();
    if (threadIdx.x == 0) {
        unsigned* bar = b.bar;
        __builtin_amdgcn_s_waitcnt(0);
        unsigned nloc = b.st[0], nx = b.st[1];
        if (nloc == 0u) { xcd_barrier_complete(bar, b.x, nloc, nx); b.st[0] = nloc; b.st[1] = nx; }
        const unsigned old = xb_add(&bar[XB_XSUB(b.x)], 1u);
        const unsigned gen = old / nloc;
        if (old + 1u == (gen + 1u) * nloc) {
            __builtin_amdgcn_fence(__ATOMIC_RELEASE, "agent");
            asm volatile("s_waitcnt vmcnt(0)" ::: "memory");
            const unsigned og = xb_add(&bar[XB_TOP], 1u);
            const unsigned tg = og / nx;
            if (og + 1u == (tg + 1u) * nx) xb_add(&bar[XB_TOPGEN], 1u);
            else XB_SPIN(xb_ld(&bar[XB_TOPGEN]) == tg, bar);
            __builtin_amdgcn_fence(__ATOMIC_ACQUIRE, "agent");
            xb_add(&bar[XB_XGEN(b.x)], 1u);
            asm volatile("s_waitcnt vmcnt(0)" ::: "memory");
        } else {
            XB_SPIN(xb_ld(&bar[XB_XGEN(b.x)]) == gen, bar);
            __builtin_amdgcn_fence(__ATOMIC_ACQUIRE, "agent");
            asm volatile("s_waitcnt vmcnt(0)" ::: "memory");
        }
    }
    __syncthreads();
}
namespace pg8 {
#define PG8_LAS __attribute__((address_space(3)))
typedef unsigned short bf16_t;
typedef short bf16x8 __attribute__((ext_vector_type(8)));
typedef float f32x4 __attribute__((ext_vector_type(4)));
typedef unsigned u32x4 __attribute__((ext_vector_type(4)));
constexpr int BM = 256, BK = 64, HALF = 128, HTB = HALF * BK * 2  , STAGE_BYTES = 8 * HTB, NXCD = 8, WGM = 8;

__host__ __device__ __forceinline__ int lds_byte(int r, int c) { const int st = (r >> 4) * 2 + (c >> 5), rr = r & 15, cc = c & 31, ob = rr * 64 + cc * 2; return st * 1024 + (ob ^ (((ob >> 9) & 1) << 5)); }
__host__ __device__ __forceinline__ void stage_rc(int b, int& R, int& C) { const int st = b / 1024, sb = b % 1024, swz = sb ^ (((sb >> 9) & 1) << 5); R = (st >> 1) * 16 + swz / 64; C = (st & 1) * 32 + (swz % 64) / 2; }
__host__ __device__ __forceinline__ int perm32(int rho) { const int n = rho >> 4, i = rho & 15; return 8 * (i >> 2) + 4 * n + (i & 3); }

struct Unit { int pm, pn; };
struct Gemm { const bf16_t* A; const bf16_t* Bt; int M, N, K; };

struct StaticOrder {
    int nM, nN, nwg, G, c;
    __host__ __device__ void init(int M, int N, int G_, int c_) { nM = M / BM; nN = N / BM; nwg = nM * nN; G = G_; c = c_; }
    __host__ __device__ bool next(int i, Unit& u) const {
        const long L = (long)i * G + c; if (L >= nwg) return false;
        int wgid = (int)L; { const int q = nwg / NXCD, r = nwg % NXCD, xcd = wgid % NXCD, off = wgid / NXCD; wgid = (xcd < r ? xcd * (q + 1) : r * (q + 1) + (xcd - r) * q) + off; }
        const int nig = WGM * nN, gid = wgid / nig, fm = gid * WGM, gsz = (nM - fm) < WGM ? (nM - fm) : WGM;
        u.pm = fm + ((wgid % nig) % gsz); u.pn = (wgid % nig) / gsz; return true;
    }
    __device__ __forceinline__ void a_ready(const Unit&) const {}
    __device__ __forceinline__ void done(const Unit&) const {}
};
__device__ __forceinline__ unsigned cvt_pk_bf16(float lo, float hi) { unsigned r; asm volatile("v_cvt_pk_bf16_f32 %0, %1, %2" : "=v"(r) : "v"(lo), "v"(hi)); return r; }
typedef float f32x2 __attribute__((ext_vector_type(2)));
__device__ __forceinline__ f32x2 gelu_pk(f32x2 v) {
    const f32x2 av = __builtin_elementwise_abs(v), d = av * 0.2316418882f + 1.0f;
    f32x2 t; t.x = __builtin_amdgcn_rcpf(d.x); t.y = __builtin_amdgcn_rcpf(d.y);
    f32x2 q = t * 0.5307027145f + (-0.7265760135f); q = q * t + 0.7107068705f; q = q * t + (-0.142248368f); q = q * t + 0.127414796f; q = q * t;
    const f32x2 s = (v * v) * (-0.72134752044f);
    f32x2 e; e.x = __builtin_amdgcn_exp2f(s.x); e.y = __builtin_amdgcn_exp2f(s.y);
    const f32x2 m = v * (q * e), r = v - m;
    f32x2 o; o.x = v.x < 0.f ? m.x : r.x; o.y = v.y < 0.f ? m.y : r.y; return o;
}

typedef int pg8_i32x4 __attribute__((ext_vector_type(4)));
template <bool F8> struct Frag { bf16x8 k[2]; };
template <class Epi, class Sched, bool STAMP = false, bool F8 = false, bool GA = false>
__device__ __forceinline__ void gemm_phase(PG8_LAS unsigned char* lds, const Gemm g, const Sched& S, const Epi& E, unsigned long long* stamps) {
    int tid_o = threadIdx.x; asm volatile("" : "+v"(tid_o));
    const int tid = tid_o, wid = __builtin_amdgcn_readfirstlane(tid >> 6), lane = tid & 63, wr = wid >> 2, wc = wid & 3, fr = lane & 15, fq = lane >> 4;
    const int K = g.K, nt = K / BK;
    int ts_lo = 0, ts_hi = 0, nts = 0; const unsigned long long rt_entry = STAMP ? (unsigned long long)wall_clock64() : 0ull;
#define PG8_STAMP() do { if (STAMP && wid == 0 && nts < 64) { const unsigned long long _c = (unsigned long long)clock64(); \
        ts_lo = (lane == nts) ? (int)(unsigned)_c : ts_lo; ts_hi = (lane == nts) ? (int)(unsigned)(_c >> 32) : ts_hi; ++nts; } } while (0)
    PG8_STAMP();
    unsigned voffA[2], voffB[2];
#pragma unroll
    for (int i = 0; i < 2; ++i) { int R, C; stage_rc(tid * 16 + i * 8192, R, C); const int Rb = Epi::PERM ? ((R & ~31) + perm32(R & 31)) : R;
        voffA[i] = (unsigned)(R * K + C) * 2u; voffB[i] = (unsigned)(Rb * K + C) * 2u; }
    const size_t pstep = (size_t)64 * K * 2;
    const size_t kstep = (size_t)(BK * 2);
    const size_t hstep = (size_t)HALF * K * 2;
    const size_t tstep = 2 * hstep;
    const unsigned ldsw = (unsigned)wid * 1024u;
    const int aoff = lds_byte(wr * 64 + fr, fq * 8), boff = lds_byte(wc * 32 + fr, fq * 8);
#define PG8_SA(b, h) (((b) * 2 + (h)) * HTB)
#define PG8_SB(b, h) ((4 + (b) * 2 + (h)) * HTB)
#define PG8_STAGE(bufoff, gbase, voff) do { const char* _b0 = (const char*)(gbase); const char* _b1 = _b0 + pstep; asm volatile("" : "+s"(_b0), "+s"(_b1)); \
        __builtin_amdgcn_global_load_lds((const unsigned*)(_b0 + (voff)[0]), (PG8_LAS unsigned*)(lds + (bufoff) + ldsw), 16, 0, 0); \
        __builtin_amdgcn_global_load_lds((const unsigned*)(_b1 + (voff)[0]), (PG8_LAS unsigned*)(lds + (bufoff) + ldsw + 8192), 16, 0, 0); } while (0)
    unsigned gC[4] = {0u, 0u, 0u, 0u}, gN[4] = {0u, 0u, 0u, 0u}; int gR = 0, gCol = 0; stage_rc(tid * 16, gR, gCol);
#define PG8_GOFF(dst, ui_) do { _Pragma("unroll") for (int _j = 0; _j < 4; ++_j) dst[_j] = (unsigned)S.src_row((ui_), gR + 64 * _j) * (unsigned)(K * 2) + (unsigned)(gCol * 2); } while (0)
#define PG8_STAGE_G(bufoff, kptr, h, nx) do { const char* _b = (const char*)(kptr); asm volatile("" : "+s"(_b)); const unsigned _o0 = (nx) ? gN[2 * (h)] : gC[2 * (h)], _o1 = (nx) ? gN[2 * (h) + 1] : gC[2 * (h) + 1]; \
        __builtin_amdgcn_global_load_lds((const unsigned*)(_b + _o0), (PG8_LAS unsigned*)(lds + (bufoff) + ldsw), 16, 0, 0); \
        __builtin_amdgcn_global_load_lds((const unsigned*)(_b + _o1), (PG8_LAS unsigned*)(lds + (bufoff) + ldsw + 8192), 16, 0, 0); } while (0)
#define PG8_LDF(dstf, addr) do { (dstf).k[0] = *(const PG8_LAS bf16x8*)(addr); (dstf).k[1] = *(const PG8_LAS bf16x8*)((addr) + 1024); } while (0)
#define PG8_LDA(dst, b, h) do { _Pragma("unroll") for (int m = 0; m < 4; ++m) PG8_LDF(dst[m], lds + PG8_SA(b, h) + aoff + m * 2048); } while (0)
#define PG8_LDB(dst, b, h) do { _Pragma("unroll") for (int n = 0; n < 2; ++n) PG8_LDF(dst[n], lds + PG8_SB(b, h) + boff + n * 2048); } while (0)
#define PG8_MMA(ai, bj, At, Bt) do { __builtin_amdgcn_s_setprio(1); _Pragma("unroll") for (int m = 0; m < 4; ++m) _Pragma("unroll") for (int n = 0; n < 2; ++n) _Pragma("unroll") for (int k = 0; k < 2; ++k) { \
        if constexpr (F8) acc[ai][bj][m][n] = __builtin_bit_cast(f32x4, __builtin_amdgcn_mfma_i32_16x16x64_i8(__builtin_bit_cast(pg8_i32x4, Bt[n].k[k]), __builtin_bit_cast(pg8_i32x4, At[m].k[k]), __builtin_bit_cast(pg8_i32x4, acc[ai][bj][m][n]), 0, 0, 0)); \
        else acc[ai][bj][m][n] = __builtin_amdgcn_mfma_f32_16x16x32_bf16(Bt[n].k[k], At[m].k[k], acc[ai][bj][m][n], 0, 0, 0); } \
        __builtin_amdgcn_s_setprio(0); } while (0)
#define PG8_WAIT_V(n) asm volatile("s_waitcnt vmcnt(" #n ")" ::: "memory")
#define PG8_WAIT_L(n) asm volatile("s_waitcnt lgkmcnt(" #n ")" ::: "memory")
#define PG8_BAR __builtin_amdgcn_s_barrier()
#define PG8_SCHED __builtin_amdgcn_sched_barrier(0)
    Unit cur, nxt; int ui = 0;
    if (!S.next(0, cur)) return;
    f32x4 acc[2][2][4][2];
#pragma unroll
    for (int a = 0; a < 2; ++a)
#pragma unroll
        for (int b = 0; b < 2; ++b)
#pragma unroll
            for (int m = 0; m < 4; ++m)
#pragma unroll
                for (int n = 0; n < 2; ++n) acc[a][b][m][n] = (f32x4){0.f, 0.f, 0.f, 0.f};
    Frag<F8> At[4], B0[2], B1[2];
    const char* cA = (const char*)g.A + (size_t)cur.pm * tstep; const char* cB = (const char*)g.Bt + (size_t)cur.pn * tstep;
    S.a_ready(cur);
    const char* A0 = (const char*)g.A; if constexpr (GA) PG8_GOFF(gC, 0);
    PG8_STAGE(PG8_SB(0, 0), cB, voffB); if constexpr (GA) PG8_STAGE_G(PG8_SA(0, 0), A0, 0, false); else PG8_STAGE(PG8_SA(0, 0), cA, voffA);
    PG8_STAGE(PG8_SB(0, 1), cB + hstep, voffB); if constexpr (GA) PG8_STAGE_G(PG8_SA(0, 1), A0, 1, false); else PG8_STAGE(PG8_SA(0, 1), cA + hstep, voffA);
    if (wr == 1) PG8_BAR;
    PG8_WAIT_V(4); PG8_BAR;
    PG8_STAGE(PG8_SB(1, 0), cB + kstep, voffB); if constexpr (GA) PG8_STAGE_G(PG8_SA(1, 0), A0 + kstep, 0, false); else PG8_STAGE(PG8_SA(1, 0), cA + kstep, voffA);
    PG8_STAGE(PG8_SB(1, 1), cB + hstep + kstep, voffB);
    PG8_WAIT_V(6); PG8_BAR;
    PG8_STAMP();
    for (;;) {
        const bool has_next = S.next(ui + 1, nxt);
        const char* nA = has_next ? (const char*)g.A + (size_t)nxt.pm * tstep : cA; const char* nB = has_next ? (const char*)g.Bt + (size_t)nxt.pn * tstep : cB;
        if constexpr (GA) { if (has_next) PG8_GOFF(gN, ui + 1); else { gN[0] = gC[0]; gN[1] = gC[1]; gN[2] = gC[2]; gN[3] = gC[3]; } }
        for (int t = 0; t < nt; t += 2) {
            const bool last = (t == nt - 2);
            const char* a1 = cA + (size_t)(t + 1) * kstep;
            const char* a2 = last ? nA : cA + (size_t)(t + 2) * kstep; const char* b2 = last ? nB : cB + (size_t)(t + 2) * kstep;
            const char* a3 = a2 + kstep; const char* b3 = b2 + kstep;
            const char* kA1 = A0 + (size_t)(t + 1) * kstep; const char* kA2 = last ? A0 : A0 + (size_t)(t + 2) * kstep; const char* kA3 = kA2 + kstep;
            if (last && has_next) S.a_ready(nxt);
            PG8_LDB(B0, 0, 0); PG8_SCHED; PG8_LDA(At, 0, 0); if constexpr (GA) PG8_STAGE_G(PG8_SA(1, 1), kA1, 1, false); else PG8_STAGE(PG8_SA(1, 1), a1 + hstep, voffA);
            PG8_WAIT_L(8); PG8_BAR; PG8_WAIT_L(0); PG8_MMA(0, 0, At, B0); PG8_BAR; PG8_SCHED;
            PG8_LDB(B1, 0, 1); PG8_STAGE(PG8_SB(0, 0), b2, voffB);
            PG8_BAR; PG8_WAIT_L(0); PG8_MMA(0, 1, At, B1); PG8_BAR;
            PG8_LDA(At, 0, 1); if constexpr (GA) PG8_STAGE_G(PG8_SA(0, 0), kA2, 0, last); else PG8_STAGE(PG8_SA(0, 0), a2, voffA);
            PG8_BAR; PG8_WAIT_L(0); PG8_MMA(1, 0, At, B0); PG8_BAR; PG8_SCHED;
            PG8_STAGE(PG8_SB(0, 1), b2 + hstep, voffB);
            PG8_WAIT_V(6); PG8_BAR; PG8_MMA(1, 1, At, B1); PG8_BAR;
            PG8_LDB(B0, 1, 0); PG8_SCHED; PG8_LDA(At, 1, 0); if constexpr (GA) PG8_STAGE_G(PG8_SA(0, 1), kA2, 1, last); else PG8_STAGE(PG8_SA(0, 1), a2 + hstep, voffA);
            PG8_WAIT_L(8); PG8_BAR; PG8_WAIT_L(0); PG8_MMA(0, 0, At, B0); PG8_BAR; PG8_SCHED;
            PG8_LDB(B1, 1, 1); PG8_STAGE(PG8_SB(1, 0), b3, voffB);
            PG8_BAR; PG8_WAIT_L(0); PG8_MMA(0, 1, At, B1); PG8_BAR;
            PG8_LDA(At, 1, 1); if constexpr (GA) PG8_STAGE_G(PG8_SA(1, 0), kA3, 0, last); else PG8_STAGE(PG8_SA(1, 0), a3, voffA);
            PG8_BAR; PG8_WAIT_L(0); PG8_MMA(1, 0, At, B0); PG8_BAR; PG8_SCHED;
            PG8_STAGE(PG8_SB(1, 1), b3 + hstep, voffB);
            PG8_WAIT_V(6); PG8_BAR; PG8_MMA(1, 1, At, B1); PG8_BAR;
        }
        PG8_STAMP();
#ifdef PROBE_EPI
        const unsigned long long te0_ = __builtin_amdgcn_s_memrealtime();
#endif
        const bool keep_acc = E(acc, cur, wr, wc, fr, fq); S.done(cur);
#ifdef PROBE_EPI
        if (blockIdx.x == 0 && tid == 0) { unsigned long long* ec_ = probe_epi_counter(); *ec_ += __builtin_amdgcn_s_memrealtime() - te0_; }
#endif
        PG8_STAMP();
        if (!has_next) break;
        if (!keep_acc)
#pragma unroll
        for (int a = 0; a < 2; ++a)
#pragma unroll
            for (int b = 0; b < 2; ++b)
#pragma unroll
                for (int m = 0; m < 4; ++m)
#pragma unroll
                    for (int n = 0; n < 2; ++n) acc[a][b][m][n] = (f32x4){0.f, 0.f, 0.f, 0.f};
        cur = nxt; cA = nA; cB = nB; ++ui;
        if constexpr (GA) { gC[0] = gN[0]; gC[1] = gN[1]; gC[2] = gN[2]; gC[3] = gN[3]; }
    }
    PG8_WAIT_V(0);
    if (wr == 0) PG8_BAR;
    PG8_BAR;
    PG8_STAMP();
    if (STAMP && wid == 0) { stamps[lane] = lane < nts ? (((unsigned long long)(unsigned)ts_hi << 32) | (unsigned)ts_lo) : 0ull;
        if (lane == 62) stamps[62] = rt_entry; if (lane == 63) stamps[63] = (unsigned long long)wall_clock64(); }
#undef PG8_STAMP
#undef PG8_SA
#undef PG8_SB
#undef PG8_STAGE
#undef PG8_STAGE_G
#undef PG8_GOFF
#undef PG8_LDA
#undef PG8_LDF
#undef PG8_LDB
#undef PG8_MMA
#undef PG8_WAIT_V
#undef PG8_WAIT_L
#undef PG8_BAR
#undef PG8_SCHED
}
}
struct RectOrder {
    pg8::StaticOrder so; int offA, nwgA, nMb, nNb, offB, nwgB, G, c;
    __device__ void init(int nMa, int nNa, int offA_, int nMb_, int nNb_, int offB_, int G_, int c_) {
        so.init(nMa * 256, nNa * 256, G_, c_); offA = offA_; nwgA = nMa * nNa; nMb = nMb_; nNb = nNb_; offB = offB_; nwgB = nMb_ * nNb_; G = G_; c = c_; }
    __device__ bool next(int i, pg8::Unit& u) const {
        const int L = i * G + c;
        if (L < nwgA) { so.next(i, u); u.pm += offA; return true; }
        const int Lb = L - nwgA; if (Lb >= nwgB) return false;
        u.pm = offB + Lb % nMb; u.pn = Lb / nMb; return true;
    }
    __device__ __forceinline__ void a_ready(const pg8::Unit&) const {}
    __device__ __forceinline__ void done(const pg8::Unit&) const {}
};
struct MergeOrder {
    pg8::StaticOrder so; int off, G, c;
    __device__ void init(int nM, int off_, int G_, int c_) { so.init(nM * 256, 1024, G_, c_); off = off_; G = G_; c = c_; }
    __device__ bool next(int i, pg8::Unit& u) const {
        const int ti = i / 3, br = i - ti * 3;
        if (!so.next(ti, u)) return false;
        u.pm += off + br * (MH / 256); u.pn += br * 4; return true;
    }
    __device__ __forceinline__ void a_ready(const pg8::Unit&) const {}
    __device__ __forceinline__ void done(const pg8::Unit&) const {}
};
struct MoeOrder {
    const LAS int* srcl = nullptr;
    __device__ __forceinline__ int src_row(int i, int r) const { return srcl[i * 256 + r]; }
    int e0, e1, e2, e3, e4, e5, ntiles, G, c;
    __device__ __forceinline__ void unit_of(int i, int& pm, int& pn) const {
        if ((G & 31) == 0) { const int j = c >> 3; pm = i * (G >> 2) + (c & 7) * (G >> 5) + (j >> 2); pn = j & 3; }
        else { const int L = i * G + c; pm = L >> 2; pn = L & 3; } }
    __device__ __forceinline__ int look(const LAS int* tile_e, int i) const { int pm, pn; unit_of(i, pm, pn); return __builtin_amdgcn_readfirstlane(pm < ntiles ? tile_e[pm] : 0); }
    __device__ __forceinline__ void init(const LAS int* tile_e, int nt, int G_, int c_) { ntiles = nt; G = G_; c = c_;
        e0 = look(tile_e, 0); e1 = look(tile_e, 1); e2 = look(tile_e, 2); e3 = look(tile_e, 3); e4 = look(tile_e, 4); e5 = look(tile_e, 5); }
    __device__ __forceinline__ bool next(int i, pg8::Unit& u) const {
        int pm, pn; unit_of(i, pm, pn); if (pm >= ntiles || i >= 6) return false;
        const int e = i == 0 ? e0 : i == 1 ? e1 : i == 2 ? e2 : i == 3 ? e3 : i == 4 ? e4 : e5;
        u.pm = pm; u.pn = e * 4 + pn; return true;
    }
    __device__ __forceinline__ void a_ready(const pg8::Unit&) const {}
    __device__ __forceinline__ void done(const pg8::Unit&) const {}
};

struct EpiIn {
    static constexpr bool PERM = true, AFTER_DRAIN = false;
    bf16_t* P; bf16_t* GB; const float* cosT; const float* sinT;
    __device__ __forceinline__ bool operator()(pg8::f32x4 (&acc)[2][2][4][2], const pg8::Unit& u, int wr, int wc, int fr, int fq) const {
        const int pn = u.pn, rbase = u.pm * 256 + wr * 64 + fr;
        int act, ld; bf16_t* dst; int cb; bool rope = false; float scl = 1.0f;
        if (pn < 14) {
            const int kind = pn >> 1;
            const int bufidx = kind == 5 ? 6 : (kind == 6 ? 5 : kind);
            dst = P + (size_t)bufidx * ((size_t)MH * 512); ld = 512; cb = (pn & 1) * 256 + wc * 32 + 8 * fq;
            act = (kind == 4 || kind == 5) ? 1 : (kind == 6 ? 2 : 0);
            rope = (kind == 0 || kind == 3) && (u.pm >= 8);
            if (kind == 3) scl = QSCALE;
        } else {
            const int gi = (pn - 14) >> 2, pnl = (pn - 14) & 3, tid = (wr * 4 + wc) * 64 + fq * 16 + fr;
            u32x2* gdst = (u32x2*)GB + ((size_t)((gi * (MH / 256) + u.pm) * 4 + pnl) * 16) * 512 + tid;
#pragma unroll
            for (int ai = 0; ai < 2; ++ai)
#pragma unroll
                for (int m = 0; m < 4; ++m)
#pragma unroll
                    for (int bj = 0; bj < 2; ++bj) { unsigned q[8];
#pragma unroll
                        for (int j = 0; j < 4; ++j) { q[j] = (unsigned)fminf(fmaxf(sigmoid_f(acc[ai][bj][m][0][j]) * 255.0f + 0.5f, 1.0f), 255.0f); q[4 + j] = (unsigned)fminf(fmaxf(sigmoid_f(acc[ai][bj][m][1][j]) * 255.0f + 0.5f, 1.0f), 255.0f); }
                        u32x2 w; w.x = q[0] | (q[1] << 8) | (q[2] << 16) | (q[3] << 24); w.y = q[4] | (q[5] << 8) | (q[6] << 16) | (q[7] << 24);
                        gdst[(size_t)((ai * 4 + m) * 2 + bj) * 512] = w; }
            return false;
        }
        pg8::f32x4 csv[8], snv[8];
#pragma unroll
        for (int i = 0; i < 8; ++i) { csv[i] = (pg8::f32x4){1.f, 1.f, 1.f, 1.f}; snv[i] = (pg8::f32x4){0.f, 0.f, 0.f, 0.f}; }
        if (rope) {
#pragma unroll
            for (int i = 0; i < 8; ++i) { const int row = rbase + (i >> 2) * 128 + (i & 3) * 16; const int t = (row - CTXROWS) & 2047; const int pos = (wc & 1) ? (t & 63) : (t >> 6);
                csv[i] = *(const pg8::f32x4*)(cosT + pos * 16 + 4 * fq); snv[i] = *(const pg8::f32x4*)(sinT + pos * 16 + 4 * fq); } }
#pragma unroll
        for (int ai = 0; ai < 2; ++ai)
#pragma unroll
            for (int m = 0; m < 4; ++m) {
                const int row = rbase + ai * 128 + m * 16;
                const pg8::f32x4 cs = csv[ai * 4 + m], sn = snv[ai * 4 + m];
                bf16_t* rowp = dst + (size_t)row * ld + cb;
#pragma unroll
                for (int bj = 0; bj < 2; ++bj) {
                    pg8::f32x4 v0 = acc[ai][bj][m][0], v1 = acc[ai][bj][m][1];
                    if (rope) { const pg8::f32x4 o0 = v0 * cs - v1 * sn, o1 = v0 * sn + v1 * cs; v0 = o0; v1 = o1; }
                    v0 *= scl; v1 *= scl;
                    if (act == 1) {
#pragma unroll
                        for (int j = 0; j < 4; ++j) { v0[j] = gelu_tanh_f(v0[j]); v1[j] = gelu_tanh_f(v1[j]); } }
                    else if (act == 2) {
#pragma unroll
                        for (int j = 0; j < 4; ++j) { v0[j] = fmaxf(sigmoid_f(v0[j]), 1e-6f); v1[j] = fmaxf(sigmoid_f(v1[j]), 1e-6f); } }
                    u32x4 w; w.x = cvtpk(v0[0], v0[1]); w.y = cvtpk(v0[2], v0[3]); w.z = cvtpk(v1[0], v1[1]); w.w = cvtpk(v1[2], v1[3]);
                    *(u32x4*)(rowp + bj * 128) = w;
                }
            }
        return false;
    }
};
struct EpiGate8 {
    static constexpr bool PERM = true, AFTER_DRAIN = false;
    bf16_t* GB;
    __device__ __forceinline__ bool operator()(pg8::f32x4 (&acc)[2][2][4][2], const pg8::Unit& u, int wr, int wc, int fr, int fq) const {
        const int gi = u.pn >> 2, pnl = u.pn & 3, tid = (wr * 4 + wc) * 64 + fq * 16 + fr; const float sc = 1.0f / (HSCALE8 * WSCALE8);
        u32x2* gdst = (u32x2*)GB + ((size_t)((gi * (MH / 256) + u.pm) * 4 + pnl) * 16) * 512 + tid;
#pragma unroll
        for (int ai = 0; ai < 2; ++ai)
#pragma unroll
            for (int m = 0; m < 4; ++m)
#pragma unroll
                for (int bj = 0; bj < 2; ++bj) { unsigned q[8];
#pragma unroll
                    for (int j = 0; j < 4; ++j) { q[j] = (unsigned)fminf(fmaxf(sigmoid_f((float)__float_as_int(acc[ai][bj][m][0][j]) * sc) * 255.0f + 0.5f, 1.0f), 255.0f);
                        q[4 + j] = (unsigned)fminf(fmaxf(sigmoid_f((float)__float_as_int(acc[ai][bj][m][1][j]) * sc) * 255.0f + 0.5f, 1.0f), 255.0f); }
                    u32x2 w; w.x = q[0] | (q[1] << 8) | (q[2] << 16) | (q[3] << 24); w.y = q[4] | (q[5] << 8) | (q[6] << 16) | (q[7] << 24);
                    gdst[(size_t)((ai * 4 + m) * 2 + bj) * 512] = w; }
        return false;
    }
};
struct EpiMerge {
    static constexpr bool PERM = true, AFTER_DRAIN = false;
    const bf16_t* GB; bf16_t* OUT;
    __device__ __forceinline__ bool operator()(pg8::f32x4 (&acc)[2][2][4][2], const pg8::Unit& u, int wr, int wc, int fr, int fq) const {
        const int br = u.pn >> 2, pn = u.pn & 3, pm = u.pm - br * (MH / 256), tid = (wr * 4 + wc) * 64 + fq * 16 + fr;
        const int rbase = pm * 256 + wr * 64 + fr, cb = pn * 256 + wc * 32 + 8 * fq;
        const u32x2* g0 = (const u32x2*)GB + ((size_t)((br * (MH / 256) + pm) * 4 + pn) * 16) * 512 + tid;
        const u32x2* g1 = g0 + (size_t)(MH / 256) * 4 * 16 * 512;
        u32x2 ga_[16], gb_[16];
#pragma unroll
        for (int s = 0; s < 16; ++s) { ga_[s] = g0[(size_t)s * 512]; gb_[s] = (br < 2) ? g1[(size_t)s * 512] : (u32x2){0x01010101u, 0x01010101u}; }
#pragma unroll
        for (int ai = 0; ai < 2; ++ai)
#pragma unroll
            for (int m = 0; m < 4; ++m) {
                const size_t off = (size_t)(rbase + ai * 128 + m * 16) * 1024 + cb;
#pragma unroll
                for (int bj = 0; bj < 2; ++bj) {
                    const int slot = (ai * 4 + m) * 2 + bj;
                    const u32x2 a = ga_[slot], b = gb_[slot];
                    float ga[8];
#pragma unroll
                    for (int j = 0; j < 4; ++j) { ga[j] = (float)((a.x >> (8 * j)) & 0xffu); ga[4 + j] = (float)((a.y >> (8 * j)) & 0xffu); }
                    if (br < 2) {
#pragma unroll
                        for (int j = 0; j < 4; ++j) { ga[j] *= __builtin_amdgcn_rcpf((float)((b.x >> (8 * j)) & 0xffu)); ga[4 + j] *= __builtin_amdgcn_rcpf((float)((b.y >> (8 * j)) & 0xffu)); }
                    } else {
#pragma unroll
                        for (int j = 0; j < 8; ++j) ga[j] *= (1.0f / 255.0f);
                    }
                    pg8::f32x4 v0 = acc[ai][bj][m][0], v1 = acc[ai][bj][m][1];
#pragma unroll
                    for (int j = 0; j < 4; ++j) { v0[j] *= ga[j]; v1[j] *= ga[4 + j]; }
                    if (br < 2) { acc[ai][bj][m][0] = v0; acc[ai][bj][m][1] = v1; }
                    else { u32x4 w; w.x = cvtpk(v0[0], v0[1]); w.y = cvtpk(v0[2], v0[3]); w.z = cvtpk(v1[0], v1[1]); w.w = cvtpk(v1[2], v1[3]);
                        *(u32x4*)(OUT + off + bj * 128) = w; }
                }
            }
        return br < 2;
    }
};
struct EpiOut {
    static constexpr bool PERM = false, AFTER_DRAIN = false;
    const float* xres_lat; const float* xres_ctx; float* xs_lat; float* xs_ctx; const float* mod; int hf;
    __device__ __forceinline__ bool operator()(pg8::f32x4 (&acc)[2][2][4][2], const pg8::Unit& u, int wr, int wc, int fr, int fq) const {
        const int pm = u.pm; const float* src; float* dst; int b;
        if (pm < 8) { b = 16; const size_t o = (size_t)((hf * HBAT + pm) * 256) * 1024; src = xres_ctx + o; dst = xs_ctx + o; }
        else { const int q = pm - 8; b = hf * HBAT + (q >> 3); const size_t o = ((size_t)b * 2048 + (size_t)(q & 7) * 256) * 1024; src = xres_lat + o; dst = xs_lat + o; }
        const int col0 = u.pn * 256 + wc * 32 + 4 * fq;
        const float* mrow = mod + (size_t)b * 6144 + 2 * 1024 + col0;
        pg8::f32x4 mv[2][2];
#pragma unroll
        for (int bj = 0; bj < 2; ++bj)
#pragma unroll
            for (int n = 0; n < 2; ++n) mv[bj][n] = *(const pg8::f32x4*)(mrow + bj * 128 + n * 16);
#pragma unroll
        for (int ai = 0; ai < 2; ++ai) {
            pg8::f32x4 xr[4][2][2];
#pragma unroll
            for (int m = 0; m < 4; ++m) { const size_t off = (size_t)(wr * 64 + fr + ai * 128 + m * 16) * 1024 + col0;
#pragma unroll
                for (int bj = 0; bj < 2; ++bj)
#pragma unroll
                    for (int n = 0; n < 2; ++n) xr[m][bj][n] = *(const pg8::f32x4*)(src + off + bj * 128 + n * 16); }
#pragma unroll
            for (int m = 0; m < 4; ++m) { const size_t off = (size_t)(wr * 64 + fr + ai * 128 + m * 16) * 1024 + col0;
#pragma unroll
                for (int bj = 0; bj < 2; ++bj)
#pragma unroll
                    for (int n = 0; n < 2; ++n) *(pg8::f32x4*)(dst + off + bj * 128 + n * 16) = xr[m][bj][n] + mv[bj][n] * acc[ai][bj][m][n]; }
            asm volatile("" ::: "memory");
        }
        return false;
    }
};
struct EpiGU {
    static constexpr bool PERM = true, AFTER_DRAIN = false;
    unsigned char* ACT;
    __device__ __forceinline__ bool operator()(pg8::f32x4 (&acc)[2][2][4][2], const pg8::Unit& u, int wr, int wc, int fr, int fq) const {
        const int rbase = u.pm * 256 + wr * 64 + fr, cb = (u.pn & 3) * 128 + wc * 32 + 8 * fq;
        const float sc = 1.0f / (HSCALE8 * WSCALE8);
#pragma unroll
        for (int ai = 0; ai < 2; ++ai)
#pragma unroll
            for (int m = 0; m < 4; ++m) {
                float o[8];
#pragma unroll
                for (int n = 0; n < 2; ++n)
#pragma unroll
                    for (int j = 0; j < 4; ++j) o[4 * n + j] = silu_f((float)__float_as_int(acc[ai][0][m][n][j]) * sc) * ((float)__float_as_int(acc[ai][1][m][n][j]) * (sc * ASCALE8));
                u32x2 w; w.x = pk4_fp8(o[0], o[1], o[2], o[3]); w.y = pk4_fp8(o[4], o[5], o[6], o[7]);
                *(u32x2*)(ACT + (size_t)(rbase + ai * 128 + m * 16) * 512 + cb) = w;
            }
        return false;
    }
};
struct EpiDown {
    static constexpr bool PERM = true, AFTER_DRAIN = false;
    bf16_t* YS;
    __device__ __forceinline__ bool operator()(pg8::f32x4 (&acc)[2][2][4][2], const pg8::Unit& u, int wr, int wc, int fr, int fq) const {
        const int rbase = u.pm * 256 + wr * 64 + fr, cb = (u.pn & 3) * 256 + wc * 32 + 8 * fq;
#pragma unroll
        for (int ai = 0; ai < 2; ++ai)
#pragma unroll
            for (int m = 0; m < 4; ++m) {
                const int row = rbase + ai * 128 + m * 16;
#pragma unroll
                for (int bj = 0; bj < 2; ++bj) { const float s8 = 1.0f / (ASCALE8 * WSCALE8); u32x4 w;
                    w.x = cvtpk((float)__float_as_int(acc[ai][bj][m][0][0]) * s8, (float)__float_as_int(acc[ai][bj][m][0][1]) * s8); w.y = cvtpk((float)__float_as_int(acc[ai][bj][m][0][2]) * s8, (float)__float_as_int(acc[ai][bj][m][0][3]) * s8);
                    w.z = cvtpk((float)__float_as_int(acc[ai][bj][m][1][0]) * s8, (float)__float_as_int(acc[ai][bj][m][1][1]) * s8); w.w = cvtpk((float)__float_as_int(acc[ai][bj][m][1][2]) * s8, (float)__float_as_int(acc[ai][bj][m][1][3]) * s8);
                    *(u32x4*)(YS + (size_t)row * 1024 + cb + bj * 128) = w; }
            }
        return false;
    }
};
template <class ColMap>
__device__ __forceinline__ void cvt_tile_T(const float* __restrict__ src, int ldsrc, bf16_t* __restrict__ dst, int K, int k0, int n0, const ColMap& cm, float scale, LAS float* tile) {
    const int tid = opaque_tid();
    {
        const int n = tid & 63, kb = tid >> 6; const int sc = cm(n0 + n);
#pragma unroll
        for (int i = 0; i < 8; ++i) { const int k = kb + 8 * i; tile[k * 65 + n] = src[(size_t)(k0 + k) * ldsrc + sc] * scale; }
    }
    __syncthreads();
    {
        const int kp = (tid & 31) * 2, nb = tid >> 5;
#pragma unroll
        for (int i = 0; i < 4; ++i) { const int n = nb + 16 * i; *(unsigned*)(dst + (size_t)(n0 + n) * K + k0 + kp) = cvtpk(tile[kp * 65 + n], tile[(kp + 1) * 65 + n]); }
    }
    __syncthreads();
}
struct CmIdent { int off; __device__ __forceinline__ int operator()(int n) const { return n + off; } };
struct CmWin {
    __device__ __forceinline__ int operator()(int n) const {
        if (n < 512 || (n >= 1536 && n < 2048)) { const int c = n & 31, f = c >> 3, j = c & 7; return (n & ~31) + ((j < 4) ? (4 * f + j) : (16 + 4 * f + (j - 4))); }
        return n; }
};
struct CmGU {
    __device__ __forceinline__ int operator()(int n) const { return 128 * (n >> 8) + (n & 127); }
};

template <int MODE, bool OUT8 = false>
__device__ __forceinline__ void cvt_tile_T256(const float* __restrict__ baseA, const float* __restrict__ baseB, int ldsrc, void* __restrict__ dstv, int K, int k0, int n0, float scale, LAS float* tile) {
    const int tid = opaque_tid();
    {
        const int n = tid & 255, kb = tid >> 8, ng = n0 + n;
        const float* sp = (MODE == 2 ? ((ng & 128) ? baseB : baseA) + 128 * (ng >> 8) + (ng & 127) : MODE == 1 ? baseA + CmWin{}(ng) : baseA + ng) + (size_t)(k0 + kb) * ldsrc;
        float v[32];
#pragma unroll
        for (int i = 0; i < 32; ++i) v[i] = sp[(size_t)(2 * i) * ldsrc];
#pragma unroll
        for (int i = 0; i < 32; ++i) tile[(kb + 2 * i) * 257 + n] = v[i] * scale;
    }
    __syncthreads();
    {
        const int n = tid >> 1, kh = (tid & 1) * 32;
        if constexpr (OUT8) { unsigned char* dp = (unsigned char*)dstv + (size_t)(n0 + n) * K + k0 + kh;
#pragma unroll
            for (int i = 0; i < 2; ++i) { float f[16];
#pragma unroll
                for (int j = 0; j < 16; ++j) f[j] = tile[(kh + 16 * i + j) * 257 + n];
                u32x4 w; w.x = pk4_fp8(f[0], f[1], f[2], f[3]); w.y = pk4_fp8(f[4], f[5], f[6], f[7]); w.z = pk4_fp8(f[8], f[9], f[10], f[11]); w.w = pk4_fp8(f[12], f[13], f[14], f[15]);
                *(u32x4*)(dp + 16 * i) = w; } }
        else { bf16_t* dp = (bf16_t*)dstv + (size_t)(n0 + n) * K + k0 + kh;
#pragma unroll
            for (int i = 0; i < 4; ++i) { float f[8];
#pragma unroll
                for (int j = 0; j < 8; ++j) f[j] = tile[(kh + 8 * i + j) * 257 + n];
                *(u32x4*)(dp + 8 * i) = pack8(f); } }
    }
    __syncthreads();
}

__device__ __forceinline__ void phase_prologue(const Params& p, LAS unsigned char* lds) {
    LAS float* tile = (LAS float*)lds;
    const int tid = opaque_tid(), G = gridDim.x, bid = blockIdx.x;
    unsigned char* ws = p.ws;
    for (int u = bid; u < 1248; u += G) {
        if (u < 448) { const int l = u / 224, r = u % 224, kt = r / 14, nt = r % 14;
            cvt_tile_T256<1>(p.in[I_WIN] + (size_t)l * 1024 * NCOL, nullptr, NCOL, (bf16_t*)(ws + WS_WTIN) + (size_t)l * NCOL * 1024, 1024, kt * 64, nt * 256, 1.0f, tile); }
        else if (u < 832) { const int v = u - 448, l = v / 192, r = v % 192, kt = r / 12, nt = r % 12;
            cvt_tile_T256<0, true>(p.in[I_WIN] + (size_t)l * 1024 * NCOL + 3584, nullptr, NCOL, ws + WS_WTIN8 + (size_t)l * 3072 * 1024, 1024, kt * 64, nt * 256, WSCALE8, tile); }
        else if (u < 1024) { const int v = u - 832, li = v / 32, r = v % 32, kt = r / 4, nt = r % 4;
            cvt_tile_T256<0>(p.in[I_WBR] + (size_t)li * 512 * 1024, nullptr, 1024, (bf16_t*)(ws + WS_WTBR) + (size_t)li * 1024 * 512, 512, kt * 64, nt * 256, 1.0f, tile); }
        else if (u < 1152) { const int v = u - 1024, l = v / 64, r = v % 64, kt = r / 4, nt = r % 4;
            cvt_tile_T256<0>(p.in[I_WOUT] + (size_t)l * 1024 * 1024, nullptr, 1024, (bf16_t*)(ws + WS_WTO) + (size_t)l * 1024 * 1024, 1024, kt * 64, nt * 256, 1.0f, tile); }
        else { const int v = u - 1152, m = v / 4, r = v % 4, kt = r >> 1, nt = r & 1;
            const int j = (m >> 2) % 3;
            cvt_tile_T(p.in[I_WQKV] + (size_t)m * 16384, 128, (bf16_t*)(ws + WS_WTQKV) + (size_t)m * 16384, 128, kt * 64, nt * 64, CmIdent{0}, j == 1 ? 0.08838834764831845f : 1.0f, tile); }
    }
    const int gt = bid * NTHR + tid, gn = G * NTHR;
    for (int i = gt; i < 2 * 4 * 16384; i += gn) ((bf16_t*)(ws + WS_WSB))[i] = f2bf(p.in[I_WGS][i]);
    for (int i = gt; i < 2 * 48 * 1024; i += gn) {
        const int l = i / (48 * 1024), r = i % (48 * 1024), n = r >> 10, k = r & 1023;
        float w = 0.f; if (n < 4) w = p.in[I_WRG][((size_t)l * 1024 + k) * 4 + n]; else if (n < 36) w = p.in[I_WRE][((size_t)l * 1024 + k) * 32 + (n - 4)];
        const bf16_t hi = f2bf(w); const bf16_t lo = f2bf(w - bf2f(hi));
        bf16_t* d = (bf16_t*)(ws + WS_WRT) + (size_t)l * 2 * 48 * 1024;
        d[r] = hi; d[48 * 1024 + r] = lo;
    }
    for (int i = gt; i < 1024; i += gn) { const int pos = i >> 4, f = i & 15; const float inv = powf(10000.0f, -(float)f / 16.0f); const float a = (float)pos * inv;
        ((float*)(ws + WS_ROPE))[i] = cosf(a); ((float*)(ws + WS_ROPE))[1024 + i] = sinf(a); }
    if (gt < 2) { const int l = gt; const float* lp = p.in[I_DLAM] + l * 256; float s01 = 0.f, s23 = 0.f;
        for (int i = 0; i < 64; ++i) { s01 += lp[i] * lp[64 + i]; s23 += lp[128 + i] * lp[192 + i]; }
        const float lam_init = 0.8f - 0.6f * expf(-0.3f * (float)l);
        float* o = (float*)(ws + WS_LAM) + l * 4; o[0] = expf(s01) - expf(s23) + lam_init; o[1] = 1.0f - lam_init; }
    for (int i = gt; i < 2 * 16 * 1024; i += gn) {
        const int l = i >> 14, gc = (i >> 10) & 15, ch = i & 1023, part = ch >> 9, c = ch & 511, h = c >> 7, d = c & 127;
        const float* wif = p.in[I_WIF] + (size_t)l * 1536 * 16; const float* wq = p.in[I_WQKV] + (size_t)l * 3 * 4 * 16384;
        float s = 0.f;
        if (part == 0) { const float* a = wq + ((size_t)(0 * 4 + h) * 128 + d) * 128; const float* b = wq + ((size_t)(1 * 4 + h) * 128 + d) * 128;
            for (int e = 0; e < 128; ++e) s += a[e] * wif[(size_t)(h * 128 + e) * 16 + gc] + b[e] * wif[(size_t)(512 + h * 128 + e) * 16 + gc]; }
        else { const float* a = wq + ((size_t)(2 * 4 + h) * 128 + d) * 128;
            for (int e = 0; e < 128; ++e) s += a[e] * wif[(size_t)(1024 + h * 128 + e) * 16 + gc]; }
        ((float*)(ws + WS_WFOLD))[i] = s;
    }
    {
        LAS float* sc = (LAS float*)lds;
        LAS float* red = sc + 17 * 1024;
        bool loaded = false;
        for (int u = bid; u < 192; u += G) {
            if (!loaded) { for (int i = tid; i < 17 * 1024; i += NTHR) { const float v = i < 16384 ? p.in[I_C][i] : p.in[I_CCTX][i - 16384]; sc[i] = silu_f(v); } loaded = true; }
            __syncthreads();
            const int l = u / 96, cbk = u % 96, col = cbk * 64 + (tid & 63), kq = tid >> 6;
            float a[17];
#pragma unroll
            for (int b = 0; b < 17; ++b) a[b] = 0.f;
            const float* wp = p.in[I_WMOD] + (size_t)l * 1024 * 6144 + col;
            for (int k0 = kq * 128; k0 < kq * 128 + 128; k0 += 8) { float w[8];
#pragma unroll
                for (int j = 0; j < 8; ++j) w[j] = wp[(size_t)(k0 + j) * 6144];
#pragma unroll
                for (int j = 0; j < 8; ++j)
#pragma unroll
                    for (int b = 0; b < 17; ++b) a[b] += sc[b * 1024 + k0 + j] * w[j]; }
#pragma unroll
            for (int b = 0; b < 17; ++b) red[(kq * 17 + b) * 64 + (tid & 63)] = a[b];
            __syncthreads();
            for (int i = tid; i < 17 * 64; i += NTHR) { const int b = i >> 6, c = i & 63; float s2 = 0.f;
#pragma unroll
                for (int k = 0; k < 8; ++k) s2 += red[(k * 17 + b) * 64 + c];
                ((float*)(ws + WS_MOD))[((size_t)l * 17 + b) * 6144 + cbk * 64 + c] = s2 + p.in[I_BMOD][(size_t)l * 6144 + cbk * 64 + c]; }
            __syncthreads();
        }
    }
}

constexpr int CVT_TILES = 3072;
struct CvtT { const float* a; const float* b; unsigned char* dst; int ldsrc, K, k0, n0; };
__device__ __forceinline__ CvtT cvt_decode(const Params& p, int t) {
    const int l = t >= CVT_TILES ? 1 : 0, u = t - l * CVT_TILES; CvtT c;
    if (u < 2048) { const int e = u >> 6, q = u & 63; const size_t eo = ((size_t)l * 32 + e) * 1024 * 512;
        c.a = p.in[I_WEG] + eo; c.b = p.in[I_WEU] + eo; c.dst = p.ws + WS_WTGU + ((size_t)l * 32 + e) * 1024 * 1024; c.ldsrc = 512; c.K = 1024; c.k0 = (q >> 2) * 64; c.n0 = (q & 3) * 256; }
    else { const int v = u - 2048, e = v >> 5, q = v & 31;
        c.a = p.in[I_WED] + ((size_t)l * 32 + e) * 512 * 1024; c.b = nullptr; c.dst = p.ws + WS_WTD + ((size_t)l * 32 + e) * 1024 * 512; c.ldsrc = 1024; c.K = 512; c.k0 = (q >> 2) * 64; c.n0 = (q & 3) * 256; }
    return c;
}
__device__ __forceinline__ void cvt_load(const CvtT& c, float (&v)[32]) {
    const int tid = opaque_tid(), n = tid & 255, kb = tid >> 8, ng = c.n0 + n;
    const float* sp = (c.b ? ((ng & 128) ? c.b : c.a) + 128 * (ng >> 8) + (ng & 127) : c.a + ng) + (size_t)(c.k0 + kb) * c.ldsrc;
#pragma unroll
    for (int i = 0; i < 32; ++i) v[i] = sp[(size_t)(2 * i) * c.ldsrc];
}
__device__ __forceinline__ void cvt_finish(const CvtT& c, const float (&v)[32], LAS float* tile) {
    const int tid = opaque_tid();
    { const int n = tid & 255, kb = tid >> 8;
#pragma unroll
      for (int i = 0; i < 32; ++i) tile[(kb + 2 * i) * 257 + n] = v[i] * WSCALE8; }
    __syncthreads();
    { const int n = tid >> 1, kh = (tid & 1) * 32; unsigned char* dp = c.dst + (size_t)(c.n0 + n) * c.K + c.k0 + kh;
#pragma unroll
      for (int i = 0; i < 2; ++i) { float f[16];
#pragma unroll
          for (int j = 0; j < 16; ++j) f[j] = tile[(kh + 16 * i + j) * 257 + n];
          u32x4 w; w.x = pk4_fp8(f[0], f[1], f[2], f[3]); w.y = pk4_fp8(f[4], f[5], f[6], f[7]); w.z = pk4_fp8(f[8], f[9], f[10], f[11]); w.w = pk4_fp8(f[12], f[13], f[14], f[15]);
          *(u32x4*)(dp + 16 * i) = w; } }
}
__device__ __forceinline__ void cvt_fill(const Params& p, LAS unsigned char* lds, int t0, int t1, int r, int nr) {
    LAS float* tA = (LAS float*)lds; LAS float* tB = tA + 64 * 257 + 64;
    asm volatile("" : "+s"(r));
    float va[32], vb[32]; int t = t0 + r;
    if (t < t1) cvt_load(cvt_decode(p, t), va);
    for (; t < t1; t += 2 * nr) {
        if (t + nr < t1) cvt_load(cvt_decode(p, t + nr), vb);
        cvt_finish(cvt_decode(p, t), va, tA);
        if (t + 2 * nr < t1) cvt_load(cvt_decode(p, t + 2 * nr), va);
        if (t + nr < t1) cvt_finish(cvt_decode(p, t + nr), vb, tB);
    }
    __syncthreads();
}
constexpr int CVT_Q0 = 0, CVT_Q1 = 2240, CVT_Q2 = 2240, CVT_Q3 = 4480, CVT_Q4 = 5600;

__device__ __forceinline__ void ld_row_f32(const float* src, int lane, float (&v)[16]) {
    const f32x4 a = *(const f32x4*)(src + 8 * lane), b = *(const f32x4*)(src + 8 * lane + 4), c = *(const f32x4*)(src + 512 + 8 * lane), d = *(const f32x4*)(src + 512 + 8 * lane + 4);
#pragma unroll
    for (int j = 0; j < 4; ++j) { v[j] = a[j]; v[4 + j] = b[j]; v[8 + j] = c[j]; v[12 + j] = d[j]; }
}
__device__ __forceinline__ void st_row_f32(float* dst, int lane, const float (&v)[16]) {
    *(f32x4*)(dst + 8 * lane) = (f32x4){v[0], v[1], v[2], v[3]}; *(f32x4*)(dst + 8 * lane + 4) = (f32x4){v[4], v[5], v[6], v[7]};
    *(f32x4*)(dst + 512 + 8 * lane) = (f32x4){v[8], v[9], v[10], v[11]}; *(f32x4*)(dst + 512 + 8 * lane + 4) = (f32x4){v[12], v[13], v[14], v[15]};
}
__device__ __forceinline__ void ld_row_bf16(const bf16_t* src, int lane, float (&v)[16]) {
    const u32x4 a = *(const u32x4*)(src + 8 * lane), b = *(const u32x4*)(src + 512 + 8 * lane);
    v[0] = bf_lo(a.x); v[1] = bf_hi(a.x); v[2] = bf_lo(a.y); v[3] = bf_hi(a.y); v[4] = bf_lo(a.z); v[5] = bf_hi(a.z); v[6] = bf_lo(a.w); v[7] = bf_hi(a.w);
    v[8] = bf_lo(b.x); v[9] = bf_hi(b.x); v[10] = bf_lo(b.y); v[11] = bf_hi(b.y); v[12] = bf_lo(b.z); v[13] = bf_hi(b.z); v[14] = bf_lo(b.w); v[15] = bf_hi(b.w);
}
__device__ __forceinline__ void st_row_bf16(bf16_t* dst, int lane, const float (&v)[16]) {
    u32x4 a, b; a.x = cvtpk(v[0], v[1]); a.y = cvtpk(v[2], v[3]); a.z = cvtpk(v[4], v[5]); a.w = cvtpk(v[6], v[7]);
    b.x = cvtpk(v[8], v[9]); b.y = cvtpk(v[10], v[11]); b.z = cvtpk(v[12], v[13]); b.w = cvtpk(v[14], v[15]);
    *(u32x4*)(dst + 8 * lane) = a; *(u32x4*)(dst + 512 + 8 * lane) = b;
}
template <int MODE>
__device__ __forceinline__ void load_resid4(const Params& p, int R0, const RowInfo& q, int lmoe, int lane, float (&v)[4][16]) {
    const float* src; float* dst;
    if (q.isctx) { const size_t o = ((size_t)q.b * 256 + q.t) * 1024; src = (MODE == 0 ? p.in[I_CTX] : (const float*)(p.ws + WS_XC)) + o; dst = (float*)(p.ws + WS_XC) + o; }
    else { const size_t o = ((size_t)q.b * 2048 + q.t) * 1024; src = (MODE == 0 ? p.in[I_X] : (const float*)p.out) + o; dst = p.out + o; }
#pragma unroll
    for (int i = 0; i < 4; ++i) ld_row_f32(src + (size_t)i * 1024, lane, v[i]);
    if (MODE == 1 || MODE == 3) {
        const int* slot = (const int*)(p.ws + WS_POS) + 2 * (size_t)R0; const float* wk = (const float*)(p.ws + WS_WTK) + 2 * (size_t)R0;
        const bf16_t* ys = (const bf16_t*)(p.ws + WS_P + P_YS);
        int sl[8]; float ww[8];
#pragma unroll
        for (int i = 0; i < 8; ++i) { sl[i] = ld_i32_dev(slot + i); ww[i] = ld_f32_dev(wk + i); }
        float m5[16]; ld_row_f32((const float*)(p.ws + WS_MOD) + ((size_t)lmoe * 17 + (q.isctx ? 16 : q.b)) * 6144 + 5 * 1024, lane, m5);
        u32x4 ya[4][2], yb[4][2];
#pragma unroll
        for (int i = 0; i < 4; ++i) { const bf16_t* r1 = ys + (size_t)sl[2 * i] * 1024; const bf16_t* r2 = ys + (size_t)sl[2 * i + 1] * 1024;
            ya[i][0] = *(const u32x4*)(r1 + 8 * lane); ya[i][1] = *(const u32x4*)(r1 + 512 + 8 * lane); yb[i][0] = *(const u32x4*)(r2 + 8 * lane); yb[i][1] = *(const u32x4*)(r2 + 512 + 8 * lane); }
#pragma unroll
        for (int i = 0; i < 4; ++i) { float y1[8], y2[8];
#pragma unroll
            for (int hh = 0; hh < 2; ++hh) { unpack8(ya[i][hh], y1); unpack8(yb[i][hh], y2);
#pragma unroll
                for (int j = 0; j < 8; ++j) v[i][8 * hh + j] += m5[8 * hh + j] * (ww[2 * i] * y1[j] + ww[2 * i + 1] * y2[j]); }
            if (MODE == 1) st_row_f32(dst + (size_t)i * 1024, lane, v[i]); }
    }
}
struct RowPar { float g[16], sh[16], sc[16]; };
__device__ __forceinline__ void load_rowpar(const Params& p, int l, int which, const RowInfo& q, int lane, RowPar& rp) {
    const float* mrow = (const float*)(p.ws + WS_MOD) + ((size_t)l * 17 + (q.isctx ? 16 : q.b)) * 6144;
    ld_row_f32(p.in[which ? I_GN2 : I_GN1] + (size_t)l * 1024, lane, rp.g);
    ld_row_f32(mrow + (which ? 3 : 0) * 1024, lane, rp.sh); ld_row_f32(mrow + (which ? 4 : 1) * 1024, lane, rp.sc);
}
__device__ __forceinline__ void norm_mod_row(const RowPar& rp, int lane, const float (&v)[16], bf16_t* hrow, unsigned char* h8row = nullptr) {
    float ss = 0.f;
#pragma unroll
    for (int j = 0; j < 16; ++j) ss += v[j] * v[j];
    ss = wave_sum(ss); const float rs = rsqrtf(ss * (1.0f / 1024.0f) + EPS);
    float o[16];
#pragma unroll
    for (int j = 0; j < 16; ++j) o[j] = v[j] * rs * rp.g[j] * (1.0f + rp.sc[j]) + rp.sh[j];
    st_row_bf16(hrow, lane, o);
    if (h8row) { u32x2 a, b; a.x = pk4_fp8(o[0] * HSCALE8, o[1] * HSCALE8, o[2] * HSCALE8, o[3] * HSCALE8); a.y = pk4_fp8(o[4] * HSCALE8, o[5] * HSCALE8, o[6] * HSCALE8, o[7] * HSCALE8);
        b.x = pk4_fp8(o[8] * HSCALE8, o[9] * HSCALE8, o[10] * HSCALE8, o[11] * HSCALE8); b.y = pk4_fp8(o[12] * HSCALE8, o[13] * HSCALE8, o[14] * HSCALE8, o[15] * HSCALE8);
        *(u32x2*)(h8row + 8 * lane) = a; *(u32x2*)(h8row + 512 + 8 * lane) = b; }
}
__device__ __forceinline__ void phase_norm1(const Params& p, int l) {
    const int tid = opaque_tid(), wid = __builtin_amdgcn_readfirstlane(tid >> 6), lane = tid & 63;
    for (int gq = blockIdx.x * 8 + wid; gq < MTOT / 4; gq += gridDim.x * 8) {
        const int R0 = 4 * gq; const RowInfo q = row_info(R0); float v[4][16]; RowPar rp;
        load_rowpar(p, l, 0, q, lane, rp);
        if (l == 0) load_resid4<0>(p, R0, q, 0, lane, v); else load_resid4<1>(p, R0, q, l - 1, lane, v);
#pragma unroll
        for (int i = 0; i < 4; ++i) norm_mod_row(rp, lane, v[i], (bf16_t*)(p.ws + WS_H) + (size_t)(R0 + i) * 1024, p.ws + WS_H8 + (size_t)(R0 + i) * 1024);
    }
}
__device__ __forceinline__ void phase_final(const Params& p) {
    const int tid = opaque_tid(), wid = __builtin_amdgcn_readfirstlane(tid >> 6), lane = tid & 63;
    float g[16]; ld_row_f32(p.in[I_GFIN], lane, g);
    for (int gq = blockIdx.x * 8 + wid; gq < NBATCH * SEQ / 4; gq += gridDim.x * 8) {
        const int a = 4 * gq, R0 = (a >> 14) * MH + CTXROWS + (a & 16383);
        const RowInfo q = row_info(R0); float v[4][16];
        load_resid4<3>(p, R0, q, 1, lane, v);
#pragma unroll
        for (int i = 0; i < 4; ++i) { float ss = 0.f;
#pragma unroll
            for (int j = 0; j < 16; ++j) ss += v[i][j] * v[i][j];
            ss = wave_sum(ss); const float rs = rsqrtf(ss * (1.0f / 1024.0f) + EPS);
#pragma unroll
            for (int j = 0; j < 16; ++j) v[i][j] = v[i][j] * rs * g[j];
            st_row_f32(p.out + ((size_t)q.b * 2048 + q.t + i) * 1024, lane, v[i]); }
    }
}
__device__ __forceinline__ int active_row(int l, int a) { return l == 0 ? a : (a >> 14) * MH + CTXROWS + (a & 16383); }
typedef float f32x4v __attribute__((ext_vector_type(4)));
__device__ __forceinline__ void phase_norm2_router(const Params& p, int l, LAS unsigned char* lds) {
    const int tid = opaque_tid(), wid = tid >> 6, lane = tid & 63, G = gridDim.x, bid = blockIdx.x;
    const int NA = l == 0 ? MTOT : NBATCH * SEQ;
    const int chunk = (((NA + G - 1) / G) + 15) & ~15;
    const int a0 = bid * chunk, a1 = (a0 + chunk < NA) ? a0 + chunk : NA, na = a1 > a0 ? a1 - a0 : 0;
    LAS float* lg = (LAS float*)lds;
    LAS float* lgs = (LAS float*)(lds + 73728);
    LAS int* re = (LAS int*)(lds + 83968);
    LAS float* rw = (LAS float*)(lds + 83968 + 2048);
    LAS int* rr = (LAS int*)(lds + 83968 + 4096);
    LAS int* hist = (LAS int*)(lds + 83968 + 6144);
    LAS int* base = hist + 32;
    if (tid < 32) hist[tid] = 0;
    bf16_t* H = (bf16_t*)(p.ws + WS_H);
    PSEC_BEGINN(11);
    for (int g = wid; g * 16 < na; g += 8)
        for (int i = 0; i < 16; i += 4) { const int a = a0 + g * 16 + i; if (a >= a1) break;
            const int R0 = active_row(l, a); const RowInfo q = row_info(R0); float v[4][16]; RowPar rp;
            load_rowpar(p, l, 1, q, lane, rp);
            load_resid4<2>(p, R0, q, 0, lane, v);
#pragma unroll
            for (int k = 0; k < 4; ++k) norm_mod_row(rp, lane, v[k], H + (size_t)(R0 + k) * 1024, p.ws + WS_H8 + (size_t)(R0 + k) * 1024); }
    asm volatile("s_waitcnt vmcnt(0)" ::: "memory"); __syncthreads();
    PSEC(11);
    const bf16_t* Wr = (const bf16_t*)(p.ws + WS_WRT) + (size_t)l * 2 * 48 * 1024;
    const float* brg = p.in[I_BRG] + l * 4; const float* bre = p.in[I_BRE] + l * 32;
    const int ng = (na + 15) >> 4, r16 = lane & 15, kq = lane >> 4;
    LAS float* brl = (LAS float*)(lds + 83968 + 6144 + 512);
    if (tid < 36) brl[tid] = tid < 4 ? brg[tid] : bre[tid - 4];
    if (ng > 0) {
        bf16x8 bh[4][3], bl[4][3];
        { const bf16_t* bp = Wr + (size_t)r16 * 1024 + 128 * wid + 8 * kq;
#pragma unroll
          for (int ks = 0; ks < 4; ++ks)
#pragma unroll
              for (int ct = 0; ct < 3; ++ct) { bh[ks][ct] = *(const bf16x8*)(bp + (size_t)ct * 16 * 1024 + ks * 32); bl[ks][ct] = *(const bf16x8*)(bp + (size_t)(48 + ct * 16) * 1024 + ks * 32); } }
        __builtin_amdgcn_sched_barrier(0);
#pragma unroll 1
        for (int g0 = 0; g0 < ng; g0 += 3) {
            bf16x8 a[3][4];
#pragma unroll
            for (int gq = 0; gq < 3; ++gq) { int ar = a0 + (g0 + gq) * 16 + r16; if (ar >= a1) ar = a1 - 1;
                const bf16_t* ap = H + (size_t)active_row(l, ar) * 1024 + 128 * wid + 8 * kq;
#pragma unroll
                for (int ks = 0; ks < 4; ++ks) a[gq][ks] = *(const bf16x8*)(ap + ks * 32); }
            __builtin_amdgcn_sched_barrier(0);
#pragma unroll
            for (int gq = 0; gq < 3; ++gq) {
                f32x4v acc[3] = {{0.f, 0.f, 0.f, 0.f}, {0.f, 0.f, 0.f, 0.f}, {0.f, 0.f, 0.f, 0.f}};
#pragma unroll
                for (int ks = 0; ks < 4; ++ks)
#pragma unroll
                    for (int ct = 0; ct < 3; ++ct) { acc[ct] = __builtin_amdgcn_mfma_f32_16x16x32_bf16(a[gq][ks], bh[ks][ct], acc[ct], 0, 0, 0); acc[ct] = __builtin_amdgcn_mfma_f32_16x16x32_bf16(a[gq][ks], bl[ks][ct], acc[ct], 0, 0, 0); }
#pragma unroll
                for (int ct = 0; ct < 3; ++ct)
#pragma unroll
                    for (int r = 0; r < 4; ++r) lg[((gq * 8 + wid) * 16 + 4 * kq + r) * 48 + ct * 16 + r16] = acc[ct][r];
            }
            __syncthreads();
            for (int o = tid; o < 3 * 768; o += NTHR) { const int gq = o >= 1536 ? 2 : (o >= 768 ? 1 : 0), rem = o - gq * 768; float s = 0.f;
#pragma unroll
                for (int w = 0; w < 8; ++w) s += lg[(gq * 8 + w) * 768 + rem];
                lgs[o] = s; }
            __syncthreads();
            if (tid < 48) {
                const int a = a0 + (g0 + (tid >> 4)) * 16 + (tid & 15);
                if (g0 + (tid >> 4) < ng && a < a1) {
                    const LAS float* x = lgs + tid * 48;
                    float gl[4]; int gs = 0; float gmax;
#pragma unroll
                    for (int j = 0; j < 4; ++j) gl[j] = x[j] + brl[j];
                    gmax = gl[0];
#pragma unroll
                    for (int j = 1; j < 4; ++j) if (gl[j] > gmax) { gmax = gl[j]; gs = j; }
                    float gsum = 0.f;
#pragma unroll
                    for (int j = 0; j < 4; ++j) gsum += __expf(gl[j] - gmax);
                    const float pg = 1.0f / gsum;
                    float v1 = -3.0e38f, v2 = -3.0e38f; int i1 = 0, i2 = 0;
                    for (int j = 0; j < 8; ++j) { const float ev = x[4 + gs * 8 + j] + brl[4 + gs * 8 + j];
                        if (ev > v1) { v2 = v1; i2 = i1; v1 = ev; i1 = j; } else if (ev > v2) { v2 = ev; i2 = j; } }
                    const float t = __expf(v2 - v1); const float w1 = pg / (1.0f + t), w2 = pg * t / (1.0f + t);
                    const int e1 = gs * 8 + i1, e2 = gs * 8 + i2, i = a - a0;
                    re[i] = e1; re[256 + i] = e2; rw[i] = w1; rw[256 + i] = w2;
                }
            }
            __syncthreads();
        }
    }
    __syncthreads();
    PSEC(12);
    if (tid < 32) { int c = 0; for (int i = 0; i < na; ++i) { if (re[i] == tid) rr[i] = c++; if (re[256 + i] == tid) rr[256 + i] = c++; } hist[tid] = c; }
    __syncthreads();
    int* hg = (int*)(p.ws + WS_CTL) + CW_HIST + (l * 256 + bid) * 32;
    if (tid < 32) hg[tid] = hist[tid];
    (void)base;
    int* EID = (int*)(p.ws + WS_EID); float* WTK = (float*)(p.ws + WS_WTK); int* POS = (int*)(p.ws + WS_POS);
    for (int i = tid; i < na; i += NTHR) { const size_t R = (size_t)active_row(l, a0 + i);
        EID[2 * R] = re[i]; EID[2 * R + 1] = re[256 + i]; WTK[2 * R] = rw[i]; WTK[2 * R + 1] = rw[256 + i];
        POS[2 * R] = rr[i]; POS[2 * R + 1] = rr[256 + i]; }
    __syncthreads();
    PSEC(13);
}
__device__ __forceinline__ void moe_segments(const Params& p, int l, LAS int* seg, int myblk) {
    const int tid = opaque_tid(); LAS int* cnt = seg + 40; LAS int* pre = seg + 80; LAS int* part = seg + 4096;
    { const int e = tid & 31, pt = tid >> 5, nb = (int)gridDim.x, per = (nb + 15) >> 4;
      const int* hg = (const int*)(p.ws + WS_CTL) + CW_HIST + l * 256 * 32 + e; int tot = 0, pr = 0;
      for (int b = pt * per; b < (pt + 1) * per && b < nb; ++b) { const int c = hg[b * 32]; if (b < myblk) pr += c; tot += c; }
      part[(pt * 2) * 32 + e] = tot; part[(pt * 2 + 1) * 32 + e] = pr; }
    __syncthreads();
    if (tid < 32) { int tot = 0, pr = 0;
#pragma unroll
        for (int pt = 0; pt < 16; ++pt) { tot += part[(pt * 2) * 32 + tid]; pr += part[(pt * 2 + 1) * 32 + tid]; }
        cnt[tid] = tot; pre[tid] = pr; }
    __syncthreads();
    if (tid == 0) { int s = 0; for (int e = 0; e < 32; ++e) { seg[e] = s; s += (cnt[e] + 255) & ~255; } if (s > SLOTS) s = SLOTS; seg[32] = s; }
    __syncthreads();
}
__device__ __forceinline__ void phase_dispatch(const Params& p, int l, LAS unsigned char* lds) {
    const int tid = opaque_tid(), G = gridDim.x, bid = blockIdx.x;
    LAS int* seg = (LAS int*)lds; moe_segments(p, l, seg, bid); const LAS int* cnt = seg + 40; const LAS int* pre = seg + 80;
    const int NA = l == 0 ? MTOT : NBATCH * SEQ;
    const int chunk = (((NA + G - 1) / G) + 15) & ~15;
    const int a0 = bid * chunk, a1 = (a0 + chunk < NA) ? a0 + chunk : NA;
    const int* EID = (const int*)(p.ws + WS_EID); const float* WTK = (const float*)(p.ws + WS_WTK); int* POS = (int*)(p.ws + WS_POS); float* WTS = (float*)(p.ws + WS_WTS); int* SRC = (int*)(p.ws + WS_SRC);
    for (int i = tid; i < 2 * (a1 - a0); i += NTHR) {
        const int R = active_row(l, a0 + (i >> 1)); const size_t x = 2 * (size_t)R + (i & 1);
        const int e = EID[x], ps = POS[x]; const float w = WTK[x];
        const int s = seg[e] + pre[e] + ps;
        SRC[s] = R; POS[x] = s; WTS[s] = w; }
    for (int e = bid; e < 32; e += G)
        for (int s = seg[e] + cnt[e] + tid; s < seg[e + 1]; s += NTHR) SRC[s] = 0;
    __syncthreads();
}
__device__ __forceinline__ int moe_tile_table(const Params& p, int l, LAS int* seg, LAS int* tile_e) {
    moe_segments(p, l, seg, 0);
    const int nt = seg[32] >> 8;
    for (int i = opaque_tid(); i < nt; i += NTHR) { int e = 0; for (int k = 1; k < 32; ++k) if ((i << 8) >= seg[k]) e = k; tile_e[i] = e; }
    __syncthreads();
    return __builtin_amdgcn_readfirstlane(nt);
}
__device__ __forceinline__ void lds_addf(LAS float* a, float v) { (void)__hip_atomic_fetch_add(a, v, __ATOMIC_RELAXED, __HIP_MEMORY_SCOPE_WORKGROUP); }
__device__ __forceinline__ bf16_t* pbuf(const Params& p, size_t off) { return (bf16_t*)(p.ws + WS_P + off); }
#ifndef MMU
#define MMU 2
#endif
__device__ __forceinline__ void mm128(const LAS bf16_t* A, const LAS bf16_t* Bt, f32x16 (&acc)[2], int wid, int lane) {
    const int r32 = lane & 31, hi = lane >> 5;
    const LAS bf16_t* ap = A + (32 * (wid >> 1) + r32) * TLD + hi * 8;
    const LAS bf16_t* bp = Bt + (64 * (wid & 1) + r32) * TLD + hi * 8;
#pragma unroll MMU
    for (int ks = 0; ks < 8; ++ks) {
        const bf16x8 a = *(const LAS bf16x8*)(ap + ks * 16), b0 = *(const LAS bf16x8*)(bp + ks * 16), b1 = *(const LAS bf16x8*)(bp + 32 * TLD + ks * 16);
        acc[0] = mfma32(a, b0, acc[0]); acc[1] = mfma32(a, b1, acc[1]);
    }
}
__device__ __forceinline__ void mm128_gB(const LAS bf16_t* A, const bf16_t* __restrict__ Bg, f32x16 (&acc)[2], int wid, int lane) {
    const int r32 = lane & 31, hi = lane >> 5;
    const LAS bf16_t* ap = A + (32 * (wid >> 1) + r32) * TLD + hi * 8;
    const bf16_t* bp = Bg + (64 * (wid & 1) + r32) * 128 + hi * 8;
#pragma unroll MMU
    for (int ks = 0; ks < 8; ++ks) {
        const bf16x8 a = *(const LAS bf16x8*)(ap + ks * 16), b0 = *(const bf16x8*)(bp + ks * 16), b1 = *(const bf16x8*)(bp + 32 * 128 + ks * 16);
        acc[0] = mfma32(a, b0, acc[0]); acc[1] = mfma32(a, b1, acc[1]);
    }
}
__device__ __forceinline__ void st_acc_T(LAS bf16_t* T, const f32x16 (&acc)[2], int wid, int lane) {
    const int r32 = lane & 31, hi = lane >> 5;
#pragma unroll
    for (int tl = 0; tl < 2; ++tl)
#pragma unroll
        for (int g = 0; g < 4; ++g) { u32x2 w; w.x = cvtpk(acc[tl][4 * g], acc[tl][4 * g + 1]); w.y = cvtpk(acc[tl][4 * g + 2], acc[tl][4 * g + 3]);
            *(LAS u32x2*)(T + (64 * (wid & 1) + 32 * tl + r32) * TLD + 32 * (wid >> 1) + 8 * g + 4 * hi) = w; }
}

__device__ __forceinline__ void st_acc_rm(LAS bf16_t* T, const f32x16 (&acc)[2], int wid, int lane) {
    const int r32 = lane & 31, hi = lane >> 5;
    LAS bf16_t* b = T + (32 * (wid >> 1) + 4 * hi) * TLD + 64 * (wid & 1) + r32;
#pragma unroll
    for (int tl = 0; tl < 2; ++tl)
#pragma unroll
        for (int r = 0; r < 16; ++r) b[((r & 3) + 8 * (r >> 2)) * TLD + 32 * tl] = (bf16_t)(cvtpk(acc[tl][r], acc[tl][r]) & 0xffffu);
}
constexpr int FLD = 132;
__device__ __forceinline__ void st_acc_f32(LAS float* F, const f32x16 (&acc)[2], int wid, int lane) {
    const int r32 = lane & 31, hi = lane >> 5;
    LAS float* b = F + (32 * (wid >> 1) + 4 * hi) * FLD + 64 * (wid & 1) + r32;
#pragma unroll
    for (int tl = 0; tl < 2; ++tl)
#pragma unroll
        for (int r = 0; r < 16; ++r) b[((r & 3) + 8 * (r >> 2)) * FLD + 32 * tl] = acc[tl][r];
}
__device__ __forceinline__ void copy_tile_out(const LAS bf16_t* T, bf16_t* dst, int ld) {
    const int tx = opaque_tid(), t = tx >> 2, c0 = (tx & 3) * 32;
#pragma unroll
    for (int i = 0; i < 4; ++i) *(u32x4*)(dst + (size_t)t * ld + c0 + 8 * i) = *(const LAS u32x4*)(T + t * TLD + c0 + 8 * i);
}

__device__ __forceinline__ bool seq_start(int r) { return r < CTXROWS ? (r & 255) == 0 : ((r - CTXROWS) & 2047) == 0; }
template <int CTRL> __device__ __forceinline__ u32x4 dpp4(const u32x4 v) { u32x4 o;
    o.x = (unsigned)__builtin_amdgcn_update_dpp(0, (int)v.x, CTRL, 0xf, 0xf, true); o.y = (unsigned)__builtin_amdgcn_update_dpp(0, (int)v.y, CTRL, 0xf, 0xf, true);
    o.z = (unsigned)__builtin_amdgcn_update_dpp(0, (int)v.z, CTRL, 0xf, 0xf, true); o.w = (unsigned)__builtin_amdgcn_update_dpp(0, (int)v.w, CTRL, 0xf, 0xf, true); return o; }
__device__ __forceinline__ void phase_conv(const Params& p, int l, LAS unsigned char* lds) {
    const int tid = opaque_tid(), wid = __builtin_amdgcn_readfirstlane(tid >> 6), lane = tid & 63, r16 = lane & 15, kg = lane >> 4, G = gridDim.x, bid = blockIdx.x;
    constexpr int NG = MH / 16, NU = 5;
    const bf16_t* XM = pbuf(p, P_XMB); bf16_t* XCV = pbuf(p, P_XCV); float* GT = (float*)(p.ws + WS_P + P_GATES);
    LAS float* PX = (LAS float*)lds;
    for (int g0 = bid; g0 < NG; g0 += NU * G) {
        f32x4v acc[NU];
#pragma unroll
        for (int u = 0; u < NU; ++u) acc[u] = (f32x4v){0.f, 0.f, 0.f, 0.f};
#pragma unroll 1
        for (int ks = 0; ks < 2; ++ks) {
            const int c = 64 * wid + 32 * ks + 8 * kg;
            u32x4 cur[NU], edge[NU];
#pragma unroll
            for (int u = 0; u < NU; ++u) { const int g = g0 + G * u; const bool valid = g < NG; const int row = 16 * g + r16;
                cur[u] = valid ? *(const u32x4*)(XM + (size_t)row * 512 + c) : (u32x4){0u, 0u, 0u, 0u};
                const bool he = valid && ((r16 == 0 && !seq_start(16 * g)) || (r16 == 15 && !seq_start(16 * g + 16)));
                const int er = r16 == 0 ? row - 1 : row + 1;
                edge[u] = he ? *(const u32x4*)(XM + (size_t)er * 512 + c) : (u32x4){0u, 0u, 0u, 0u}; }
            float w0[8], w1[8], w2[8], bc[8];
            { const float* wc = p.in[I_WCONV] + (size_t)l * 3 * 512 + c; const float* bcp = p.in[I_BCONV] + (size_t)l * 512 + c;
#pragma unroll
              for (int j = 0; j < 8; ++j) { w0[j] = wc[j]; w1[j] = wc[512 + j]; w2[j] = wc[1024 + j]; bc[j] = bcp[j]; } }
            bf16x8 wyh, wyl, wxh, wxl;
            { const float* wf = (const float*)(p.ws + WS_WFOLD) + ((size_t)l * 16 + r16) * 1024 + c; float a[8], b[8], t8[8];
#pragma unroll
              for (int j = 0; j < 8; ++j) { a[j] = wf[j]; b[j] = wf[512 + j]; }
              u32x4 hh = pack8(a); unpack8(hh, t8);
#pragma unroll
              for (int j = 0; j < 8; ++j) t8[j] = a[j] - t8[j];
              u32x4 ll = pack8(t8); wyh = *(const bf16x8*)&hh; wyl = *(const bf16x8*)&ll;
              hh = pack8(b); unpack8(hh, t8);
#pragma unroll
              for (int j = 0; j < 8; ++j) t8[j] = b[j] - t8[j];
              ll = pack8(t8); wxh = *(const bf16x8*)&hh; wxl = *(const bf16x8*)&ll; }
#pragma unroll
            for (int u = 0; u < NU; ++u) { const int g = g0 + G * u;
                const u32x4 sp = dpp4<0x111>(cur[u]), sn = dpp4<0x101>(cur[u]);
                u32x4 pw, nw;
                pw.x = r16 == 0 ? edge[u].x : sp.x; pw.y = r16 == 0 ? edge[u].y : sp.y; pw.z = r16 == 0 ? edge[u].z : sp.z; pw.w = r16 == 0 ? edge[u].w : sp.w;
                nw.x = r16 == 15 ? edge[u].x : sn.x; nw.y = r16 == 15 ? edge[u].y : sn.y; nw.z = r16 == 15 ? edge[u].z : sn.z; nw.w = r16 == 15 ? edge[u].w : sn.w;
                float xp[8], xc[8], xn[8], y[8], yl[8]; unpack8(pw, xp); unpack8(cur[u], xc); unpack8(nw, xn);
#pragma unroll
                for (int j = 0; j < 8; ++j) y[j] = silu_f(w0[j] * xp[j] + w1[j] * xc[j] + w2[j] * xn[j] + bc[j]);
                const u32x4 yh = pack8(y); unpack8(yh, yl);
#pragma unroll
                for (int j = 0; j < 8; ++j) yl[j] = y[j] - yl[j];
                const u32x4 ylw = pack8(yl);
                const bf16x8 ah = *(const bf16x8*)&yh, al = *(const bf16x8*)&ylw, ax = *(const bf16x8*)&cur[u];
                acc[u] = __builtin_amdgcn_mfma_f32_16x16x32_bf16(ah, wyh, acc[u], 0, 0, 0); acc[u] = __builtin_amdgcn_mfma_f32_16x16x32_bf16(ah, wyl, acc[u], 0, 0, 0);
                acc[u] = __builtin_amdgcn_mfma_f32_16x16x32_bf16(al, wyh, acc[u], 0, 0, 0);
                acc[u] = __builtin_amdgcn_mfma_f32_16x16x32_bf16(ax, wxh, acc[u], 0, 0, 0); acc[u] = __builtin_amdgcn_mfma_f32_16x16x32_bf16(ax, wxl, acc[u], 0, 0, 0);
                if (g < NG) *(u32x4*)(XCV + (size_t)(16 * g + r16) * 512 + c) = yh; }
        }
#pragma unroll
        for (int u = 0; u < NU; ++u)
#pragma unroll
            for (int r = 0; r < 4; ++r) PX[((u * 8 + wid) * 16 + 4 * kg + r) * 16 + r16] = acc[u][r];
        __syncthreads();
        for (int o = tid; o < NU * 256; o += NTHR) { const int u = o >> 8, row = (o >> 4) & 15, n = o & 15, g = g0 + G * u; float s = p.in[I_BIF][l * 16 + n];
#pragma unroll
            for (int w = 0; w < 8; ++w) s += PX[((u * 8 + w) * 16 + row) * 16 + n];
            if (g < NG) GT[(size_t)(16 * g + row) * 16 + (n & 3) * 4 + (n >> 2)] = s; }
        __syncthreads();
    }
}
__device__ __forceinline__ void ld8row(const bf16_t* base, int pos, int seqlen, float (&o)[8]) {
    if (pos < 0 || pos >= seqlen) {
#pragma unroll
        for (int j = 0; j < 8; ++j) o[j] = 0.f; }
    else unpack8(*(const u32x4*)(base + (size_t)pos * 512), o);
}
__device__ __forceinline__ void mlstm_a_ids(int u, int& bl, int& J, int& h, int& r0) {
    bl = u / (NJ * 4); const int rem = u - bl * (NJ * 4); J = rem >> 2; h = rem & 3;
    r0 = (J < 2 ? bl * 256 : CTXROWS + bl * 2048) + (J < 2 ? J * 128 : (J - 2) * 128);
}
#define APRE_PARAMS u32x4 (&qa)[4], u32x4 (&qb)[4], u32x4 (&qwq)[4], u32x4 (&qwk)[4], u32x4 (&qwv)[4], f32x4& qg
#define APRE_ARGS qa, qb, qwq, qwk, qwv, qg
__device__ __forceinline__ void mlstm_a_load(const Params& p, int l, int u, APRE_PARAMS) {
    const int tid = opaque_tid(); int bl, J, h, r0; mlstm_a_ids(u, bl, J, h, r0);
    const int t = tid >> 2, cc = (tid & 3) * 32; const size_t o = (size_t)(r0 + t) * 512 + h * 128 + cc;
    const bf16_t* XM = pbuf(p, P_XMB) + o; const bf16_t* XCV = pbuf(p, P_XCV) + o;
    const bf16_t* Wq = (const bf16_t*)(p.ws + WS_WTQKV) + ((size_t)(l * 3) * 4 + h) * 16384 + t * 128 + cc;
#pragma unroll
    for (int i = 0; i < 4; ++i) { qa[i] = *(const u32x4*)(XCV + 8 * i); qb[i] = *(const u32x4*)(XM + 8 * i);
        qwq[i] = *(const u32x4*)(Wq + 8 * i); qwk[i] = *(const u32x4*)(Wq + (size_t)4 * 16384 + 8 * i); qwv[i] = *(const u32x4*)(Wq + (size_t)8 * 16384 + 8 * i); }
    qg = *(const f32x4*)((const float*)(p.ws + WS_P + P_GATES) + (size_t)(r0 + (tid & 127)) * 16 + h * 4);
}
__device__ __forceinline__ void mlstm_a_unit(const Params& p, int l, int u, int unext, int n_a, APRE_PARAMS, LAS unsigned char* lds) {
    int tid_ = threadIdx.x; asm volatile("" : "+v"(tid_));
    const int tid = tid_, wid = __builtin_amdgcn_readfirstlane(tid >> 6), lane = tid & 63, r32 = lane & 31, hi = lane >> 5;
    LAS bf16_t* T0 = (LAS bf16_t*)lds; LAS bf16_t* T1 = (LAS bf16_t*)(lds + TILE_B); LAS bf16_t* T2 = (LAS bf16_t*)(lds + 2 * TILE_B); LAS bf16_t* T3 = (LAS bf16_t*)(lds + 3 * TILE_B);
    LAS float* gl = (LAS float*)(lds + 4 * TILE_B);
    LAS float* wend = gl + 512;
    int bl, J, h, r0; mlstm_a_ids(u, bl, J, h, r0);
    const int wr_ = tid >> 2, wc_ = (tid & 3) * 32;
    u32x4 wv_[4];
#pragma unroll
    for (int i = 0; i < 4; ++i) { *(LAS u32x4*)(T0 + wr_ * TLD + wc_ + 8 * i) = qa[i]; *(LAS u32x4*)(T1 + wr_ * TLD + wc_ + 8 * i) = qb[i];
        *(LAS u32x4*)(T2 + wr_ * TLD + wc_ + 8 * i) = qwq[i]; *(LAS u32x4*)(T3 + wr_ * TLD + wc_ + 8 * i) = qwk[i]; wv_[i] = qwv[i]; }
    if (tid < 128) *(LAS f32x4*)(gl + tid * 4) = qg;
    LBAR();
    if (wid < 2) {
        const int dir = wid, p0 = 2 * lane, p1 = p0 + 1, s0 = dir ? 127 - p0 : p0, s1 = dir ? 127 - p1 : p1;
        const float ig0 = gl[s0 * 4 + 2 * dir], ig1 = gl[s1 * 4 + 2 * dir];
        const float lf0 = logsigmoid_f(gl[s0 * 4 + 2 * dir + 1]), lf1 = logsigmoid_f(gl[s1 * 4 + 2 * dir + 1]);
        float incl = lf0 + lf1;
        for (int o = 1; o < 64; o <<= 1) { const float t = __shfl_up(incl, o); if (lane >= o) incl += t; }
        const float bc1 = incl, bc0 = incl - lf1, gg = __shfl(incl, 63);
        const float ae0 = gg - bc0 + ig0, ae1 = gg - bc1 + ig1; const float ml = wave_max(fmaxf(ae0, ae1));
        wend[dir * 128 + s0] = __expf(ae0 - ml); wend[dir * 128 + s1] = __expf(ae1 - ml);
        if (lane == 0) { float* mst = (float*)(p.ws + WS_P + P_MST) + ((size_t)(((bl * 4 + h) * 2 + dir) * NJ + J)) * 4; mst[0] = ml; mst[1] = gg; }
    }
    f32x16 ack[2] = {};
    {
        f32x16 acq[2] = {}, akp[2] = {};
        mm128(T2, T0, acq, wid, lane); mm128(T0, T3, ack, wid, lane); mm128(T3, T0, akp, wid, lane);
        LBAR();
        st_acc_T(T2, acq, wid, lane); st_acc_T(T3, akp, wid, lane);
#pragma unroll
        for (int i = 0; i < 4; ++i) *(LAS u32x4*)(T0 + wr_ * TLD + wc_ + 8 * i) = wv_[i];
    }
    LBAR();
    copy_tile_out(T2, pbuf(p, P_MQ) + (size_t)r0 * 512 + h * 128, 512);
    copy_tile_out(T3, pbuf(p, P_MK) + (size_t)r0 * 512 + h * 128, 512);
    {
        f32x16 acv[2] = {}; mm128(T1, T0, acv, wid, lane);
        LBAR();
        st_acc_T(T2, ack, wid, lane); st_acc_T(T3, acv, wid, lane);
    }
    mlstm_a_load(p, l, unext < n_a ? unext : u, APRE_ARGS);
    LBAR();
    {
        bf16_t* MVT = pbuf(p, P_MVT) + ((size_t)((bl * NJ + J) * 4 + h)) * 16384; const int d = tid >> 2, s0 = (tid & 3) * 32;
#pragma unroll
        for (int i = 0; i < 4; ++i) *(u32x4*)(MVT + d * 128 + s0 + 8 * i) = *(const LAS u32x4*)(T3 + d * TLD + s0 + 8 * i);
    }
#pragma unroll 1
    for (int dir = 0; dir < 2; ++dir) {
        const int combo = (bl * 4 + h) * 2 + dir;
        f32x16 acc[2] = {};
        const LAS bf16_t* ap = T3 + (32 * (wid >> 1) + r32) * TLD + hi * 8; const LAS bf16_t* bp = T2 + (64 * (wid & 1) + r32) * TLD + hi * 8;
        const LAS float* wv = wend + dir * 128 + hi * 8;
#pragma unroll
        for (int ks = 0; ks < 8; ++ks) {
            float a8[8]; unpack8(*(const LAS u32x4*)(ap + ks * 16), a8);
            const f32x4 wa = *(const LAS f32x4*)(wv + ks * 16), wb = *(const LAS f32x4*)(wv + ks * 16 + 4);
#pragma unroll
            for (int j = 0; j < 4; ++j) { a8[j] *= wa[j]; a8[4 + j] *= wb[j]; }
            const u32x4 aw = pack8(a8); const bf16x8 a = *(const bf16x8*)&aw;
            const bf16x8 b0 = *(const LAS bf16x8*)(bp + ks * 16), b1 = *(const LAS bf16x8*)(bp + 32 * TLD + ks * 16);
            acc[0] = mfma32(a, b0, acc[0]); acc[1] = mfma32(a, b1, acc[1]);
        }
        bf16_t* CL = (bf16_t*)(p.ws + WS_P + P_CLOC) + ((size_t)combo * NJ + J) * 16384;
        LAS float* F = (LAS float*)lds;
        st_acc_f32(F, acc, wid, lane);
        LBAR();
        { const int d = tid >> 2, e0 = (tid & 3) * 32;
#pragma unroll
          for (int i = 0; i < 4; ++i) { const f32x4 a = *(const LAS f32x4*)(F + d * FLD + e0 + 8 * i), b = *(const LAS f32x4*)(F + d * FLD + e0 + 8 * i + 4);
              u32x4 w; w.x = cvtpk(a[0], a[1]); w.y = cvtpk(a[2], a[3]); w.z = cvtpk(b[0], b[1]); w.w = cvtpk(b[2], b[3]);
              *(u32x4*)(CL + d * 128 + e0 + 8 * i) = w; } }
        LBAR();
    }
    if (tid < 256) { const int dir = tid >> 7, e = tid & 127; float s = 0.f;
#pragma unroll 4
        for (int j = 0; j < 128; j += 8) { float k8[8]; unpack8(*(const LAS u32x4*)(T2 + e * TLD + j), k8);
            const f32x4 wa = *(const LAS f32x4*)(wend + dir * 128 + j), wb = *(const LAS f32x4*)(wend + dir * 128 + j + 4);
#pragma unroll
            for (int i = 0; i < 4; ++i) s += wa[i] * k8[i] + wb[i] * k8[4 + i]; }
        ((float*)(p.ws + WS_P + P_NLOC))[((size_t)(((bl * 4 + h) * 2 + dir) * NJ + J)) * 128 + e] = s; }
    LBAR();
}

__device__ __forceinline__ int scan_J(int dir, int pidx) { return dir == 0 ? pidx : (pidx == 0 ? 1 : (pidx == 1 ? 0 : 19 - pidx)); }
__device__ __forceinline__ void phase_scan(const Params& p) {
    const int NIT = 64 * 2048;
    bf16_t* CL = (bf16_t*)(p.ws + WS_P + P_CLOC); float* NL = (float*)(p.ws + WS_P + P_NLOC); float* MST = (float*)(p.ws + WS_P + P_MST);
    const int tid = opaque_tid();
    for (int w = blockIdx.x * NTHR + tid; w < NIT; w += gridDim.x * NTHR) {
        const int combo = w >> 11, q = w & 2047, dir = combo & 1; const bool hasn = q < 32;
        float m_st = 0.f; float st[8]; f32x4 s4 = {0.f, 0.f, 0.f, 0.f};
#pragma unroll
        for (int j = 0; j < 8; ++j) st[j] = 0.f;
        bf16_t* base = CL + (size_t)combo * NJ * 16384 + 8 * q; float* nbase = NL + (size_t)combo * NJ * 128 + 4 * (q & 31);
#pragma unroll 1
        for (int i = 0; i < NJ; ++i) {
            const int J = scan_J(dir, i); float* ms = MST + ((size_t)combo * NJ + J) * 4;
            const u32x4 vc = *(const u32x4*)(base + (size_t)J * 16384);
            f32x4 vn = {0.f, 0.f, 0.f, 0.f}; if (hasn) vn = *(const f32x4*)(nbase + (size_t)J * 128);
            const float ml = ms[0], gg = ms[1];
            const float m_new = fmaxf(gg + m_st, ml), a_old = __expf(gg + m_st - m_new), a_new = __expf(ml - m_new);
            *(u32x4*)(base + (size_t)J * 16384) = pack8(st);
            if (hasn) *(f32x4*)(nbase + (size_t)J * 128) = s4;
            if (q == 0) ms[2] = m_st;
            float c8[8]; unpack8(vc, c8);
#pragma unroll
            for (int j = 0; j < 8; ++j) st[j] = st[j] * a_old + c8[j] * a_new;
            s4 = s4 * a_old + vn * a_new; m_st = m_new;
        }
    }
}

__device__ __forceinline__ unsigned zap_nf(unsigned w) { if ((w & 0x7f80u) >= 0x4980u) w &= 0xffff0000u; if ((w & 0x7f800000u) >= 0x49800000u) w &= 0x0000ffffu; return w; }
template <int dir>
__device__ __forceinline__ void mlstm_c_dir(const unsigned (&Xp)[4][8], f32x16 (&acc)[2], const LAS bf16_t* Tq, const LAS bf16_t* Tc, const LAS bf16_t* Tv,
                                            const LAS float* av, const LAS float* Mv, const LAS float* wi, LAS float* denw, const LAS float* n0l, int wid, int lane) {
    const int r32 = lane & 31, hi = lane >> 5, tb = wid >> 1, t = 32 * tb + r32;
    acc[0] = f32x16{}; acc[1] = f32x16{};
    mm128(Tq, Tc, acc, wid, lane);
#pragma unroll
    for (int r = 0; r < 16; ++r) { const float w = wi[dir * 128 + 32 * tb + crow(r, hi)]; acc[0][r] *= w; acc[1][r] *= w; }
    float nq = 0.f;
#pragma unroll
    for (int i = 0; i < 8; ++i) { float q8[8]; unpack8(*(const LAS u32x4*)(Tq + t * TLD + 64 * hi + 8 * i), q8);
        const f32x4 na = *(const LAS f32x4*)(n0l + dir * 128 + 64 * hi + 8 * i), nb = *(const LAS f32x4*)(n0l + dir * 128 + 64 * hi + 8 * i + 4);
#pragma unroll
        for (int j = 0; j < 4; ++j) nq += na[j] * q8[j] + nb[j] * q8[4 + j]; }
    const float Mt = Mv[dir * 128 + t]; float den = 0.f;
    const LAS bf16_t* vp = Tv + (64 * (wid & 1) + r32) * TLD + 4 * hi;
#pragma unroll
    for (int sb = 0; sb < 4; ++sb) {
        float o[16];
#pragma unroll
        for (int r = 0; r < 16; ++r) { const int s = 32 * sb + crow(r, hi); const bool ok = dir ? (s >= t) : (s <= t);
            const float xs = (r & 1) ? bf_hi(Xp[sb][r >> 1]) : bf_lo(Xp[sb][r >> 1]);
            const float ev = xs * __builtin_amdgcn_exp2f((av[dir * 128 + s] - Mt) * LOG2E);
            o[r] = ok ? ev : 0.f; den += o[r]; }
#pragma unroll
        for (int s2 = 0; s2 < 2; ++s2) {
            u32x4 aw; aw.x = cvtpk(o[8 * s2 + 0], o[8 * s2 + 1]); aw.y = cvtpk(o[8 * s2 + 2], o[8 * s2 + 3]); aw.z = cvtpk(o[8 * s2 + 4], o[8 * s2 + 5]); aw.w = cvtpk(o[8 * s2 + 6], o[8 * s2 + 7]);
            const bf16x8 af = *(const bf16x8*)&aw;
#pragma unroll
            for (int tl = 0; tl < 2; ++tl) { const LAS bf16_t* bp = vp + 32 * tl * TLD + 32 * sb + 16 * s2;
                const u32x2 b0 = *(const LAS u32x2*)bp, b1 = *(const LAS u32x2*)(bp + 8); u32x4 bw; bw.x = b0.x; bw.y = b0.y; bw.z = b1.x; bw.w = b1.y;
                acc[tl] = mfma32(af, *(const bf16x8*)&bw, acc[tl]); }
        }
        __builtin_amdgcn_sched_barrier(0);
    }
    { auto rr = __builtin_amdgcn_permlane32_swap(__float_as_uint(den), __float_as_uint(den), false, false); den = __uint_as_float(rr[0]) + __uint_as_float(rr[1]); }
    { auto rr = __builtin_amdgcn_permlane32_swap(__float_as_uint(nq), __float_as_uint(nq), false, false); nq = __uint_as_float(rr[0]) + __uint_as_float(rr[1]); }
    if (hi == 0) denw[(wid * 2 + dir) * 32 + r32] = den + wi[dir * 128 + t] * nq;
}
__device__ __forceinline__ void mlstm_c_ids(int u, int& bl, int& J, int& h) {
    const int m_l = HBAT * 16 * 4;
    if (u < m_l) { const int rem = u & 63; bl = u >> 6; J = 2 + (rem >> 2); h = rem & 3; }
    else { const int v = u - m_l, rem = v & 7; bl = v >> 3; J = rem >> 2; h = rem & 3; }
}
#define CPRE_PARAMS u32x4 (&cq)[4], u32x4 (&ck)[4], u32x4 (&cv)[4], u32x4 (&ccf)[4], u32x4 (&ccb)[4], f32x4& cg, float& cn
#define CPRE_ARGS cq, ck, cv, ccf, ccb, cg, cn
__device__ __forceinline__ void mlstm_c_load(const Params& p, int u, CPRE_PARAMS) {
    const int tid = opaque_tid(); int bl, J, h; mlstm_c_ids(u, bl, J, h);
    const int r0 = (J < 2 ? bl * 256 : CTXROWS + bl * 2048) + (J < 2 ? J * 128 : (J - 2) * 128);
    const int t = tid >> 2, c0 = (tid & 3) * 32;
    const bf16_t* q = pbuf(p, P_MQ) + (size_t)(r0 + t) * 512 + h * 128 + c0; const bf16_t* k = pbuf(p, P_MK) + (size_t)(r0 + t) * 512 + h * 128 + c0;
    const bf16_t* v = pbuf(p, P_MVT) + ((size_t)((bl * NJ + J) * 4 + h)) * 16384 + t * 128 + c0;
    const bf16_t* c0f = (const bf16_t*)(p.ws + WS_P + P_CLOC) + ((size_t)((bl * 4 + h) * 2) * NJ + J) * 16384 + t * 128 + c0;
#pragma unroll
    for (int i = 0; i < 4; ++i) { cq[i] = *(const u32x4*)(q + 8 * i); ck[i] = *(const u32x4*)(k + 8 * i); cv[i] = *(const u32x4*)(v + 8 * i);
        ccf[i] = *(const u32x4*)(c0f + 8 * i); ccb[i] = *(const u32x4*)(c0f + (size_t)NJ * 16384 + 8 * i); }
    cg = *(const f32x4*)((const float*)(p.ws + WS_P + P_GATES) + (size_t)(r0 + (tid & 127)) * 16 + h * 4);
    cn = ((const float*)(p.ws + WS_P + P_NLOC))[((size_t)(((bl * 4 + h) * 2 + ((tid >> 7) & 1)) * NJ + J)) * 128 + (tid & 127)];
}
__device__ __forceinline__ void mlstm_c_unit(const Params& p, int l, int u, int unext, int n_c, CPRE_PARAMS, LAS unsigned char* lds) {
    int tid_ = threadIdx.x; asm volatile("" : "+v"(tid_));
    const int tid = tid_, wid = __builtin_amdgcn_readfirstlane(tid >> 6), lane = tid & 63, r32 = lane & 31, hi = lane >> 5;
    LAS bf16_t* Tq = (LAS bf16_t*)lds; LAS bf16_t* Tk = (LAS bf16_t*)(lds + TILE_B); LAS bf16_t* Tv = (LAS bf16_t*)(lds + 2 * TILE_B); LAS bf16_t* Ts = (LAS bf16_t*)(lds + 3 * TILE_B);
    LAS float* sc = (LAS float*)(lds + 4 * TILE_B);
    LAS float* gl = sc;
    LAS float* av = sc + 512;
    LAS float* Mv = sc + 768;
    LAS float* wi = sc + 1024;
    LAS float* fl = sc + 1280;
    LAS float* ssq = sc + 1536;
    LAS float* denp = sc + 1664;
    LAS float* n0l = sc + 2944;
    int bl, J, h; mlstm_c_ids(u, bl, J, h);
    const int rseq = J < 2 ? bl * 256 : CTXROWS + bl * 2048, r0 = rseq + (J < 2 ? J * 128 : (J - 2) * 128);
    u32x4 cf_[4], cbp_[4];
    {
        const int t = tid >> 2, c0 = (tid & 3) * 32;
#pragma unroll
        for (int i = 0; i < 4; ++i) { *(LAS u32x4*)(Tq + t * TLD + c0 + 8 * i) = cq[i]; *(LAS u32x4*)(Tk + t * TLD + c0 + 8 * i) = ck[i]; *(LAS u32x4*)(Tv + t * TLD + c0 + 8 * i) = cv[i]; cf_[i] = ccf[i]; cbp_[i] = ccb[i]; }
        if (tid < 128) { *(LAS f32x4*)(gl + tid * 4) = cg; ssq[tid] = 0.f; }
        if (tid < 256) n0l[tid] = cn;
    }
    LBAR();
    { const int d_ = tid >> 2, e_ = (tid & 3) * 32;
#pragma unroll
      for (int i = 0; i < 4; ++i) *(LAS u32x4*)(Ts + d_ * TLD + e_ + 8 * i) = cf_[i]; }
    const float* MST = (const float*)(p.ws + WS_P + P_MST);
    if (wid < 2) {
        const int dir = wid, p0 = 2 * lane, p1 = p0 + 1, s0 = dir ? 127 - p0 : p0, s1 = dir ? 127 - p1 : p1;
        const float m0 = ld_f32_dev(MST + ((size_t)(((bl * 4 + h) * 2 + dir) * NJ + J)) * 4 + 2);
        const float ig0 = gl[s0 * 4 + 2 * dir], ig1 = gl[s1 * 4 + 2 * dir];
        const float lf0 = logsigmoid_f(gl[s0 * 4 + 2 * dir + 1]), lf1 = logsigmoid_f(gl[s1 * 4 + 2 * dir + 1]);
        float incl = lf0 + lf1;
        for (int o = 1; o < 64; o <<= 1) { const float t = __shfl_up(incl, o); if (lane >= o) incl += t; }
        const float bc1 = incl, bc0 = incl - lf1;
        const float a0 = ig0 - bc0, a1 = ig1 - bc1;
        float mx = fmaxf(a0, a1);
        for (int o = 1; o < 64; o <<= 1) { const float t = __shfl_up(mx, o); if (lane >= o) mx = fmaxf(mx, t); }
        float mxprev = __shfl_up(mx, 1); if (lane == 0) mxprev = -3.0e38f;
        const float M0 = fmaxf(m0, fmaxf(mxprev, a0)), M1 = fmaxf(m0, mx);
        av[dir * 128 + s0] = a0; av[dir * 128 + s1] = a1; Mv[dir * 128 + s0] = M0; Mv[dir * 128 + s1] = M1;
        wi[dir * 128 + s0] = __expf(m0 - M0); wi[dir * 128 + s1] = __expf(m0 - M1);
        fl[dir * 128 + s0] = __expf(-bc0 - M0); fl[dir * 128 + s1] = __expf(-bc1 - M1);
    }
    __builtin_amdgcn_sched_barrier(0);
    unsigned Xp[4][8];
    {
    f32x16 X[4] = {};
    { const LAS bf16_t* bq = Tq + (32 * (wid >> 1) + r32) * TLD + hi * 8; const LAS bf16_t* ak = Tk + r32 * TLD + hi * 8;
#pragma unroll 2
      for (int ks = 0; ks < 8; ++ks) { const bf16x8 b = *(const LAS bf16x8*)(bq + ks * 16);
#pragma unroll
          for (int sb = 0; sb < 4; ++sb) X[sb] = mfma32(*(const LAS bf16x8*)(ak + 32 * sb * TLD + ks * 16), b, X[sb]); } }
#pragma unroll
    for (int sb = 0; sb < 4; ++sb)
#pragma unroll
        for (int i = 0; i < 8; ++i) Xp[sb][i] = cvtpk(X[sb][2 * i], X[sb][2 * i + 1]);
    }
    LBAR();
    { const int d_ = tid >> 2, e_ = (tid & 3) * 32;
#pragma unroll
      for (int i = 0; i < 4; ++i) *(LAS u32x4*)(Tk + d_ * TLD + e_ + 8 * i) = cbp_[i]; }
    LBAR();
    f32x16 ao0[2], ao1[2];
    LAS float* denw = denp;
    mlstm_c_dir<0>(Xp, ao0, Tq, Ts, Tv, av, Mv, wi, denw, n0l, wid, lane);
    mlstm_c_dir<1>(Xp, ao1, Tq, Tk, Tv, av, Mv, wi, denw, n0l, wid, lane);
    __builtin_amdgcn_sched_barrier(0);
    float hv[2][16];
#pragma unroll
    for (int r = 0; r < 16; ++r) { const int t = 32 * (wid >> 1) + crow(r, hi);
        const float df = denw[(wid * 2 + 0) * 32 + crow(r, hi)], db = denw[(wid * 2 + 1) * 32 + crow(r, hi)];
        const float rf = 1.0f / fmaxf(fabsf(df), fl[t]), rb = 1.0f / fmaxf(fabsf(db), fl[128 + t]);
        hv[0][r] = ao0[0][r] * rf + ao1[0][r] * rb; hv[1][r] = ao0[1][r] * rf + ao1[1][r] * rb;
        float q = hv[0][r] * hv[0][r] + hv[1][r] * hv[1][r];
        q = half_sum31(q);
        if (r32 == 31) lds_addf(&ssq[t], q); }
    __builtin_amdgcn_sched_barrier(0);
    int te_ = tid; asm volatile("" : "+v"(te_));
    const float* gm = p.in[I_GMN] + l * 512 + h * 128 + 64 * (wid & 1) + (te_ & 31); const float gd0 = gm[0], gd1 = gm[32];
    const bf16_t* xcv = pbuf(p, P_XCV) + (size_t)(r0 + (te_ >> 2)) * 512 + h * 128 + (te_ & 3) * 32; bf16_t* zb = pbuf(p, P_ZB) + (size_t)(r0 + (te_ >> 2)) * 512 + h * 128 + (te_ & 3) * 32;
    const float* sk = p.in[I_SKIP] + l * 512 + h * 128;
    u32x4 xw[4], zw[4]; f32x4 s0[4], s1[4];
#pragma unroll
    for (int i = 0; i < 4; ++i) { xw[i] = *(const u32x4*)(xcv + 8 * i); zw[i] = *(const u32x4*)(zb + 8 * i); s0[i] = *(const f32x4*)(sk + (te_ & 3) * 32 + 8 * i); s1[i] = *(const f32x4*)(sk + (te_ & 3) * 32 + 8 * i + 4); }
    mlstm_c_load(p, unext < n_c ? unext : u, CPRE_ARGS);
    __builtin_amdgcn_sched_barrier(0);
    LBAR();
    f32x16 hn[2];
#pragma unroll
    for (int tl = 0; tl < 2; ++tl) { const float gd = tl ? gd1 : gd0;
#pragma unroll
        for (int r = 0; r < 16; ++r) hn[tl][r] = hv[tl][r] * rsqrtf(ssq[32 * (wid >> 1) + crow(r, hi)] * (1.0f / 128.0f) + EPS) * gd; }
    LAS float* F = (LAS float*)lds;
    st_acc_f32(F, hn, wid, lane);
    LBAR();
    { const int t = te_ >> 2, c0 = (te_ & 3) * 32;
#pragma unroll
      for (int i = 0; i < 4; ++i) { float x8[8], z8[8]; unpack8(xw[i], x8); unpack8(zw[i], z8);
          const f32x4 h0 = *(const LAS f32x4*)(F + t * FLD + c0 + 8 * i), h1 = *(const LAS f32x4*)(F + t * FLD + c0 + 8 * i + 4);
#pragma unroll
          for (int j = 0; j < 4; ++j) { z8[j] = (h0[j] + s0[i][j] * x8[j]) * z8[j]; z8[4 + j] = (h1[j] + s1[i][j] * x8[4 + j]) * z8[4 + j]; }
          zw[i] = pack8(z8); }
#pragma unroll
      for (int i = 0; i < 4; ++i) *(u32x4*)(zb + 8 * i) = zw[i]; }
    LBAR();
}
namespace att {
typedef float f32x2v __attribute__((ext_vector_type(2)));
constexpr int SHM_V = 64 * 128 * 2, SHM_K = 64 * 64 * 2, OFF_K = 2 * SHM_V, OFF_WS = OFF_K + 2 * SHM_K, OFF_ST = OFF_WS + 8 * 64 * 4, LDS_NEED = OFF_ST + 32 * 512 * 4;
static_assert(LDS_NEED <= LDS_BYTES - 64, "attention LDS");
constexpr float THR2 = 11.5f;
#define KSWZ64(row, colB) ((row) * 128 + ((colB) ^ (((row) & 7) << 4)))
#define ASBAR() __builtin_amdgcn_sched_barrier(0)
__device__ __forceinline__ void partialSM(f32x16& p0, f32x16& p1, float& m_reg, float& mn, float& alpha) {
    float pmax = p0[0];
#pragma unroll
    for (int r = 1; r < 16; ++r) pmax = fmaxf(pmax, p0[r]);
#pragma unroll
    for (int r = 0; r < 16; ++r) pmax = fmaxf(pmax, p1[r]);
    { auto rr = __builtin_amdgcn_permlane32_swap(__float_as_uint(pmax), __float_as_uint(pmax), false, false); pmax = fmaxf(__uint_as_float(rr[0]), __uint_as_float(rr[1])); }
    if (__builtin_expect(__all(pmax - m_reg <= THR2), 1)) { mn = m_reg; alpha = 1.f; }
    else { mn = fmaxf(m_reg, pmax); alpha = __builtin_amdgcn_exp2f(m_reg - mn); m_reg = mn; }
    { const f32x2v mn2 = {mn, mn};
#pragma unroll
      for (int r = 0; r < 16; r += 2) { f32x2v t0 = {p0[r], p0[r + 1]}, t1 = {p1[r], p1[r + 1]}; t0 -= mn2; t1 -= mn2; p0[r] = t0[0]; p0[r + 1] = t0[1]; p1[r] = t1[0]; p1[r + 1] = t1[1]; } }
#pragma unroll
    for (int r = 0; r < 16; ++r) p0[r] = __builtin_amdgcn_exp2f(p0[r]);
}
__device__ __forceinline__ void finishSM(f32x16& p0, f32x16& p1, float alpha, float& l_reg, bf16x8& pa0, bf16x8& pa1, bf16x8& pa2, bf16x8& pa3) {
#pragma unroll
    for (int r = 0; r < 16; ++r) p1[r] = __builtin_amdgcn_exp2f(p1[r]);
    float ps;
    { f32x2v s2 = {p0[0], p0[1]};
#pragma unroll
      for (int r = 2; r < 16; r += 2) s2 += (f32x2v){p0[r], p0[r + 1]};
#pragma unroll
      for (int r = 0; r < 16; r += 2) s2 += (f32x2v){p1[r], p1[r + 1]};
      ps = s2[0] + s2[1]; }
    { auto rr = __builtin_amdgcn_permlane32_swap(__float_as_uint(ps), __float_as_uint(ps), false, false); ps = __uint_as_float(rr[0]) + __uint_as_float(rr[1]); }
    l_reg = l_reg * alpha + ps;
#define PK4(P, BASE, OUT) do { unsigned a0 = cvtpk(P[BASE + 0], P[BASE + 1]), a1 = cvtpk(P[BASE + 2], P[BASE + 3]);   \
    unsigned b0 = cvtpk(P[BASE + 4], P[BASE + 5]), b1 = cvtpk(P[BASE + 6], P[BASE + 7]);                              \
    auto r0 = __builtin_amdgcn_permlane32_swap(a0, b0, false, false); auto r1 = __builtin_amdgcn_permlane32_swap(a1, b1, false, false); \
    u32x4 w = {r0[0], r1[0], r0[1], r1[1]}; OUT = *reinterpret_cast<bf16x8*>(&w); } while (0)
    PK4(p0, 0, pa0); PK4(p0, 8, pa1); PK4(p1, 0, pa2); PK4(p1, 8, pa3);
#undef PK4
}
__device__ __forceinline__ void qkt(f32x16& p0, f32x16& p1, const LAS char* Ks, const bf16x8 (&qr)[4], int r32, int hi) {
    p0 = f32x16{}; p1 = f32x16{};
#pragma unroll
    for (int d0 = 0; d0 < 4; ++d0) { const int cb = (d0 * 16 + hi * 8) * 2;
        const bf16x8 b0 = *reinterpret_cast<const LAS bf16x8*>(Ks + KSWZ64(r32, cb));
        const bf16x8 b1 = *reinterpret_cast<const LAS bf16x8*>(Ks + KSWZ64(32 + r32, cb));
        p0 = mfma32(b0, qr[d0], p0); p1 = mfma32(b1, qr[d0], p1); }
}
__device__ __forceinline__ int v_st(int k, int c) { const int kk = (k & ~0xC) | ((k & 4) << 1) | ((k & 8) >> 1); return ((kk >> 3) * 4 + (c >> 5)) * 512 + ((kk & 7) * 32 + (c & 31)) * 2; }
__device__ __forceinline__ int v_rd_base(int lane) { return ((lane & 3) << 3) | (((lane >> 2) & 3) << 6) | (((lane >> 4) & 1) << 5) | (((lane >> 5) & 1) << 8); }
constexpr int v_rd_off(int d0, int ks, int half) { return d0 * 512 + ks * 4096 + half * 2048; }
template <int OFF> __device__ __forceinline__ s16x4 tr_read(int vb) { s16x4 r; asm volatile("ds_read_b64_tr_b16 %0, %1 offset:%2" : "=&v"(r) : "v"(vb), "i"(OFF) : "memory"); return r; }
template <int D0> __device__ __forceinline__ void pv_one(f32x16& od, int vb, bf16x8 pa0, bf16x8 pa1, bf16x8 pa2, bf16x8 pa3) {
    const s16x4 l0 = tr_read<v_rd_off(D0, 0, 0)>(vb), h0 = tr_read<v_rd_off(D0, 0, 1)>(vb), l1 = tr_read<v_rd_off(D0, 1, 0)>(vb), h1 = tr_read<v_rd_off(D0, 1, 1)>(vb);
    const s16x4 l2 = tr_read<v_rd_off(D0, 2, 0)>(vb), h2 = tr_read<v_rd_off(D0, 2, 1)>(vb), l3 = tr_read<v_rd_off(D0, 3, 0)>(vb), h3 = tr_read<v_rd_off(D0, 3, 1)>(vb);
    asm volatile("s_waitcnt lgkmcnt(0)" ::: "memory"); ASBAR();
#define PKV(L, H) (bf16x8){L[0], L[1], L[2], L[3], H[0], H[1], H[2], H[3]}
    od = mfma32(pa0, PKV(l0, h0), od); od = mfma32(pa1, PKV(l1, h1), od); od = mfma32(pa2, PKV(l2, h2), od); od = mfma32(pa3, PKV(l3, h3), od);
#undef PKV
}
__device__ __forceinline__ void pv_d0(f32x16 (&o)[4], int vb, bf16x8 pa0, bf16x8 pa1, bf16x8 pa2, bf16x8 pa3) {
    pv_one<0>(o[0], vb, pa0, pa1, pa2, pa3); pv_one<1>(o[1], vb, pa0, pa1, pa2, pa3); pv_one<2>(o[2], vb, pa0, pa1, pa2, pa3); pv_one<3>(o[3], vb, pa0, pa1, pa2, pa3);
}
__device__ __forceinline__ int krow(int j, int rc, int rl) { return j < 4 ? rc + 64 * j : rl + 64 * (j - 4); }

__device__ __forceinline__ void attn_unit(const Params& p, int l, int h, int qrow0, int rc, int rl, int NT, LAS unsigned char* lds8) {
    int tid_ = threadIdx.x; asm volatile("" : "+v"(tid_));
    const int tid = tid_, wid = __builtin_amdgcn_readfirstlane(tid >> 6), lane = tid & 63, r32 = lane & 31, hi = lane >> 5;
    LAS char* V_lds = (LAS char*)lds8; LAS char* K_lds = (LAS char*)lds8 + OFF_K;
    LAS float* wsx = (LAS float*)(lds8 + OFF_WS) + wid * 64; LAS float* li_l = wsx; LAS float* al_l = wsx + 32;
    LAS unsigned* stash = (LAS unsigned*)(lds8 + OFF_ST);
    bf16_t* QB = pbuf(p, P_QB); const bf16_t* KB = pbuf(p, P_KB); const bf16_t* VB = pbuf(p, P_VB);
    const int sr = tid >> 4, sc = (tid & 15) * 8, vst0 = v_st(sr, sc);
    const int kr = tid >> 3, kc = (tid & 7) * 8, kst = KSWZ64(kr, kc * 2);
    const int vb0 = (int)(uintptr_t)V_lds + v_rd_base(lane);
    f32x16 o[4];
#pragma unroll 1
    for (int m = 0; m < 2; ++m) {
        const unsigned voV0 = (unsigned)((sr * 512 + h * 128 + sc) * 2), voK = (unsigned)((kr * 512 + h * 128 + m * 64 + kc) * 2);
        float m_reg = -1e30f, l_reg = 0.f;
#pragma unroll
        for (int d = 0; d < 4; ++d) o[d] = f32x16{};
        bf16x8 qr[4];
        { const bf16_t* Qw = QB + (size_t)(qrow0 + wid * 32 + r32) * 512 + h * 128 + m * 64 + hi * 8;
#pragma unroll
          for (int d0 = 0; d0 < 4; ++d0) qr[d0] = *(const bf16x8*)(Qw + d0 * 16); }
        struct { bf16x8 vs0, vs1, ks0; } sr_[2];
#define SLOAD(i, j) do { const int _r = __builtin_amdgcn_readfirstlane(krow((j), rc, rl)); const char* _vb = (const char*)(VB + (size_t)_r * 512); const char* _kb = (const char*)(KB + (size_t)_r * 512); \
    sr_[i].vs0 = *(const bf16x8*)(_vb + voV0); sr_[i].vs1 = *(const bf16x8*)(_vb + 32 * 512 * 2 + voV0); sr_[i].ks0 = *(const bf16x8*)(_kb + voK); } while (0)
#define SWRITE(b, i) do { *(LAS bf16x8*)(V_lds + (b) * SHM_V + vst0) = sr_[i].vs0; *(LAS bf16x8*)(V_lds + (b) * SHM_V + 8192 + vst0) = sr_[i].vs1; \
    *(LAS bf16x8*)(K_lds + (b) * SHM_K + kst) = sr_[i].ks0; } while (0)
#define SWAIT() asm volatile("s_waitcnt vmcnt(3)" ::: "memory")
#define RESC(a) do { if (__any((a) < 1.f)) { if (hi == 0) al_l[r32] = (a); asm volatile("s_waitcnt lgkmcnt(0)" ::: "memory"); \
    _Pragma("unroll") for (int d = 0; d < 4; ++d) _Pragma("unroll") for (int r = 0; r < 16; ++r) o[d][r] *= al_l[crow(r, hi)]; } } while (0)
        f32x16 pA0, pA1, pB0, pB1; float mnA, mnB, alA, alB; bf16x8 pa0, pa1, pa2, pa3;
        SLOAD(0, 0); asm volatile("s_waitcnt vmcnt(0)" ::: "memory"); SWRITE(0, 0); __syncthreads();
        qkt(pA0, pA1, K_lds, qr, r32, hi); partialSM(pA0, pA1, m_reg, mnA, alA);
        SLOAD(1, 1); if (2 < NT) SLOAD(0, 2);
        SWAIT(); SWRITE(1, 1); __syncthreads();
        for (int j = 1; j + 1 < NT; j += 2) {
            ASBAR(); qkt(pB0, pB1, K_lds + SHM_K, qr, r32, hi);
            finishSM(pA0, pA1, alA, l_reg, pa0, pa1, pa2, pa3); ASBAR();
            SLOAD(1, j + 2); ASBAR();
            pv_d0(o, vb0, pa0, pa1, pa2, pa3); partialSM(pB0, pB1, m_reg, mnB, alB);
            __syncthreads(); SWAIT(); SWRITE(0, 0);
            RESC(alB); __syncthreads();
            ASBAR(); qkt(pA0, pA1, K_lds, qr, r32, hi);
            finishSM(pB0, pB1, alB, l_reg, pa0, pa1, pa2, pa3); ASBAR();
            if (j + 3 < NT) SLOAD(0, j + 3); ASBAR();
            pv_d0(o, vb0 + SHM_V, pa0, pa1, pa2, pa3); partialSM(pA0, pA1, m_reg, mnA, alA);
            __syncthreads(); SWAIT(); SWRITE(1, 1);
            RESC(alA); __syncthreads();
        }
        ASBAR(); qkt(pB0, pB1, K_lds + SHM_K, qr, r32, hi);
        finishSM(pA0, pA1, alA, l_reg, pa0, pa1, pa2, pa3); ASBAR();
        pv_d0(o, vb0, pa0, pa1, pa2, pa3); partialSM(pB0, pB1, m_reg, mnB, alB);
        __syncthreads(); RESC(alB);
        finishSM(pB0, pB1, alB, l_reg, pa0, pa1, pa2, pa3); ASBAR();
        pv_d0(o, vb0 + SHM_V, pa0, pa1, pa2, pa3);
#undef SLOAD
#undef SWRITE
#undef SWAIT
#undef RESC
        int lane_e = lane; asm volatile("" : "+v"(lane_e)); const int r32e = lane_e & 31, hie = lane_e >> 5;
        if (hie == 0) li_l[r32e] = l_reg; asm volatile("s_waitcnt lgkmcnt(0)" ::: "memory");
        float rli[16];
#pragma unroll
        for (int r = 0; r < 16; ++r) rli[r] = __builtin_amdgcn_rcpf(li_l[crow(r, hie)]);
        if (m == 0) {
#pragma unroll
            for (int d0 = 0; d0 < 4; ++d0)
#pragma unroll
                for (int r = 0; r < 16; r += 2) stash[(wid * 32 + d0 * 8 + (r >> 1)) * 64 + lane_e] = cvtpk(o[d0][r] * rli[r], o[d0][r + 1] * rli[r + 1]);
        } else {
            const float lam = ld_f32_dev((const float*)(p.ws + WS_LAM) + l * 4), oml = ld_f32_dev((const float*)(p.ws + WS_LAM) + l * 4 + 1);
            float ss[16];
#pragma unroll
            for (int r = 0; r < 16; ++r) ss[r] = 0.f;
#pragma unroll
            for (int d0 = 0; d0 < 4; ++d0)
#pragma unroll
                for (int r = 0; r < 16; r += 2) { const unsigned w = stash[(wid * 32 + d0 * 8 + (r >> 1)) * 64 + lane_e];
                    o[d0][r] = bf_lo(w) - lam * o[d0][r] * rli[r]; o[d0][r + 1] = bf_hi(w) - lam * o[d0][r + 1] * rli[r + 1];
                    ss[r] += o[d0][r] * o[d0][r]; ss[r + 1] += o[d0][r + 1] * o[d0][r + 1]; }
#pragma unroll
            for (int r = 0; r < 16; ++r) { float q = ss[r]; q += __shfl_xor(q, 1); q += __shfl_xor(q, 2); q += __shfl_xor(q, 4); q += __shfl_xor(q, 8); q += __shfl_xor(q, 16);
                ss[r] = rsqrtf(q * (1.0f / 128.0f) + EPS) * oml; }
            const float* gs = p.in[I_GSUBLN] + l * 128;
            asm volatile("s_waitcnt lgkmcnt(0)" ::: "memory");
            LAS bf16_t* ot = (LAS bf16_t*)(stash + wid * 32 * 64);
#pragma unroll
            for (int d0 = 0; d0 < 4; ++d0) { const float g = gs[d0 * 32 + r32e];
#pragma unroll
                for (int r = 0; r < 16; ++r) ot[((r & 3) + 8 * (r >> 2) + 4 * hie) * 128 + d0 * 32 + r32e] = (bf16_t)(cvtpk(o[d0][r] * ss[r] * g, 0.f) & 0xffffu); }
            asm volatile("s_waitcnt lgkmcnt(0)" ::: "memory");
            { bf16_t* dst = QB + (size_t)(qrow0 + wid * 32) * 512 + h * 128;
#pragma unroll
              for (int i = 0; i < 8; ++i) { const int row = i * 4 + (lane_e >> 4), pc = (lane_e & 15) * 8;
                  *(u32x4*)(dst + (size_t)row * 512 + pc) = *(const LAS u32x4*)(ot + row * 128 + pc); } }
        }
        __syncthreads();
    }
}
}
__device__ __forceinline__ void gmlp_unit(const Params& p, int l, int r0, LAS unsigned char* lds) {
    int tid_ = threadIdx.x; asm volatile("" : "+v"(tid_));
    const int tid = tid_, wid = __builtin_amdgcn_readfirstlane(tid >> 6), lane = tid & 63, r32 = lane & 31, hi = lane >> 5;
    const bf16_t* VG = pbuf(p, P_VGB); bf16_t* UB = pbuf(p, P_UB);
    PSEC_BEGIN8();
    {
        const int sr = tid >> 4, sc = (tid & 15) * 8, vst0 = att::v_st(sr, sc);
        u32x4 x[4][4]; float rs[4];
#pragma unroll
        for (int k = 0; k < 4; ++k)
#pragma unroll
            for (int g = 0; g < 4; ++g) x[k][g] = *(const u32x4*)(VG + (size_t)(r0 + sr + 32 * k) * 512 + g * 128 + sc);
#pragma unroll
        for (int k = 0; k < 4; ++k) { float ss = 0.f;
#pragma unroll
            for (int g = 0; g < 4; ++g) { float v[8]; unpack8(x[k][g], v);
#pragma unroll
                for (int j = 0; j < 8; ++j) ss += v[j] * v[j]; }
            ss += __shfl_xor(ss, 1); ss += __shfl_xor(ss, 2); ss += __shfl_xor(ss, 4); ss += __shfl_xor(ss, 8);
            rs[k] = rsqrtf(ss * (1.0f / 512.0f) + EPS); }
#pragma unroll
        for (int k = 0; k < 4; ++k)
#pragma unroll
            for (int g = 0; g < 4; ++g) { float v[8]; unpack8(x[k][g], v);
#pragma unroll
                for (int j = 0; j < 8; ++j) v[j] *= rs[k];
                *(LAS u32x4*)(lds + (g * 2 + (k >> 1)) * att::SHM_V + (k & 1) * 8192 + vst0) = pack8(v); }
    }
    __syncthreads();
    const int rb = wid >> 1, dh = wid & 1;
    const int vb0 = (int)(uintptr_t)lds + att::v_rd_base(lane) + dh * 1024;
    LAS float* F = (LAS float*)(lds + 8 * att::SHM_V) + wid * 576;
    const bf16_t* Wsb = (const bf16_t*)(p.ws + WS_WSB) + (size_t)l * 4 * 16384 + (size_t)(32 * rb + r32) * 128 + 8 * hi;
#pragma unroll 1
    for (int g = 0; g < 4; ++g) {
        bf16x8 pa[2][4];
#pragma unroll
        for (int kt = 0; kt < 2; ++kt)
#pragma unroll
            for (int k4 = 0; k4 < 4; ++k4) pa[kt][k4] = *(const bf16x8*)(Wsb + (size_t)g * 16384 + 64 * kt + 16 * k4);
        bf16_t* up = UB + (size_t)(r0 + 32 * rb + (lane >> 2)) * 512 + g * 128 + 64 * dh + 8 * (lane & 3);
        u32x4 uu[2][2];
#pragma unroll
        for (int d0 = 0; d0 < 2; ++d0)
#pragma unroll
            for (int rd = 0; rd < 2; ++rd) uu[d0][rd] = *(const u32x4*)(up + (size_t)(16 * rd) * 512 + 32 * d0);
        const float* gv = p.in[I_GGV] + l * 512 + g * 128 + 64 * dh + r32; const float* bs = p.in[I_BGS] + (l * 4 + g) * 128 + 32 * rb;
        const float gv0 = gv[0], gv1 = gv[32];
        float bsv[16];
#pragma unroll
        for (int r = 0; r < 16; ++r) bsv[r] = bs[crow(r, hi)];
        __builtin_amdgcn_sched_barrier(0);
        f32x16 o[2] = {};
        att::pv_one<0>(o[0], vb0 + (g * 2) * att::SHM_V, pa[0][0], pa[0][1], pa[0][2], pa[0][3]); att::pv_one<1>(o[1], vb0 + (g * 2) * att::SHM_V, pa[0][0], pa[0][1], pa[0][2], pa[0][3]);
        att::pv_one<0>(o[0], vb0 + (g * 2 + 1) * att::SHM_V, pa[1][0], pa[1][1], pa[1][2], pa[1][3]); att::pv_one<1>(o[1], vb0 + (g * 2 + 1) * att::SHM_V, pa[1][0], pa[1][1], pa[1][2], pa[1][3]);
#pragma unroll
        for (int d0 = 0; d0 < 2; ++d0)
#pragma unroll
            for (int rd = 0; rd < 2; ++rd) {
#pragma unroll
                for (int r = 0; r < 8; ++r) { const int rr = 8 * rd + r; F[((r & 3) + 8 * ((r >> 2) & 1) + 4 * hi) * 36 + r32] = o[d0][rr] * (d0 ? gv1 : gv0) + bsv[rr]; }
                asm volatile("s_waitcnt lgkmcnt(0)" ::: "memory");
                const f32x4 m0 = *(const LAS f32x4*)(F + (lane >> 2) * 36 + 8 * (lane & 3)), m1 = *(const LAS f32x4*)(F + (lane >> 2) * 36 + 8 * (lane & 3) + 4);
                float u8[8]; unpack8(uu[d0][rd], u8);
#pragma unroll
                for (int j = 0; j < 4; ++j) { u8[j] *= m0[j]; u8[4 + j] *= m1[j]; }
                *(u32x4*)(up + (size_t)(16 * rd) * 512 + 32 * d0) = pack8(u8);
                asm volatile("s_waitcnt lgkmcnt(0)" ::: "memory");
            }
    }
    __syncthreads();
    PSEC(8);
}
constexpr int N_PHASES = 36;
typedef const __attribute__((address_space(4))) Params* KParams;
#define PHASE_P() const Params& p = *(const Params*)opaque_kp()
__device__ __forceinline__ KParams opaque_kp() { KParams q = (KParams)__builtin_amdgcn_kernarg_segment_ptr(); asm volatile("" : "+s"(q)); return q; }
__global__ void __launch_bounds__(NTHR, 2) mk_fwd(Params p_arg, int bar_region) {
    extern __shared__ __attribute__((aligned(16))) unsigned char lds_raw[];
    LAS unsigned char* lds = (LAS unsigned char*)lds_raw;
    const int tid = threadIdx.x, G = gridDim.x, bid = blockIdx.x;
    volatile LAS unsigned* xbw = (volatile LAS unsigned*)(lds + LDS_BYTES - 16);
    if (tid == 0) { xbw[0] = 0u; xbw[1] = 0u; xbw[2] = 0u; xbw[3] = 0u; }
    __syncthreads();
    (void)xcd_barrier_post((unsigned*)(p_arg.ws + WS_CTL) + CW_BAR + bar_region * 4096, xbw);
    const int lo = p_arg.ph_lo, hi = p_arg.ph_hi;
#define IN(k) (lo <= (k) && (k) < hi)
#ifdef PROBE
#define STAMP(k) do { if (tid == 0) { if (bid == 0) ((unsigned long long*)(opaque_kp()->ws + WS_CTL))[30000 + (k)] = __builtin_amdgcn_s_memrealtime(); *(volatile LAS int*)(lds + LDS_BYTES - 32) = (k); } __syncthreads(); } while (0)
#else
#define STAMP(k) do { } while (0)
#endif
#define GRID_BARRIER() do { KParams kq = opaque_kp(); XcdBarrier b_; b_.bar = (unsigned*)(kq->ws + WS_CTL) + CW_BAR + ((const __attribute__((address_space(4))) int*)(kq + 1))[0] * 4096; b_.x = xb_xcc_id(); b_.st = xbw; xcd_barrier(b_); } while (0)
#define SEAM(k) do { if (IN(k) && IN((k) + 1)) { GRID_BARRIER(); STAMP((k) + 1); } } while (0)

    STAMP(0);
#if !defined(ONLY) || ONLY == 0
    if (IN(0)) { PHASE_P(); phase_prologue(p, lds); }
#endif
    SEAM(0);
    for (int l = 0; l < 2; ++l) {
        const int base = 1 + 17 * l;
#if !defined(ONLY) || ONLY == 1
        if (IN(base)) { PHASE_P(); phase_norm1(p, l); }
#endif
        SEAM(base);
        for (int hf = 0; hf < 2; ++hf) {
            const int hb = base + 1 + 6 * hf;
#if !defined(ONLY) || ONLY == 2
            if (IN(hb)) {
                PHASE_P(); unsigned char* ws = p.ws; bf16_t* Hh = (bf16_t*)(ws + WS_H) + (size_t)hf * MH * 1024; (void)Hh;
                const float* cosT = (const float*)(ws + WS_ROPE); const float* sinT = cosT + 1024;
                pg8::Gemm g{Hh, (const bf16_t*)(ws + WS_WTIN) + (size_t)l * NCOL * 1024, MH, NCOL, 1024};
                int cin = bid; if (hf == 1) { cin += G >> 1; if (cin >= G) cin -= G; }
                RectOrder S; if (l == 0) S.init(72, 14, 0, 0, 0, 0, G, cin); else S.init(64, 14, 8, 8, 6, 0, G, cin);
                EpiIn E{pbuf(p, 0), pbuf(p, P_GB), cosT, sinT};
                pg8::gemm_phase<EpiIn, RectOrder>((PG8_LAS unsigned char*)lds, g, S, E, nullptr);
                pg8::Gemm g8{(const bf16_t*)(ws + WS_H8 + (size_t)hf * MH * 1024), (const bf16_t*)(ws + WS_WTIN8 + (size_t)l * 3072 * 1024), MH, 3072, 512};
                RectOrder S8; S8.init(l == 0 ? 72 : 64, 12, l == 0 ? 0 : 8, 0, 0, 0, G, G - 1 - cin);
                EpiGate8 E8{pbuf(p, P_GB)};
                pg8::gemm_phase<EpiGate8, RectOrder, false, true>((PG8_LAS unsigned char*)lds, g8, S8, E8, nullptr);
            }
#endif
            SEAM(hb);
#if !defined(ONLY) || ONLY == 3
            if (IN(hb + 1)) {
                PSEC_BEGIN6();
                { PHASE_P(); phase_conv(p, l, lds); }
                PSEC(6);
                GRID_BARRIER(); PSEC(7);
                PHASE_P();
                const int n_a = HBAT * NJ * 4, n_g = HBAT * 16 + (l == 0 ? HBAT * 2 : 0);
                const int bidx = (G == 256) ? ((bid & 7) * 32 + (bid >> 3)) : bid;
                int u = bidx;
                PSEC(13);
                { u32x4 qa[4], qb[4], qwq[4], qwk[4], qwv[4]; f32x4 qg; mlstm_a_load(p, l, u < n_a ? u : 0, APRE_ARGS);
                  for (; u < n_a; u += G) mlstm_a_unit(p, l, u, u + G, n_a, APRE_ARGS, lds); }
                PSEC(14);
                for (; u < n_a + n_g; u += G) { const int v = u - n_a; int r0; if (v < HBAT * 16) r0 = CTXROWS + (v >> 4) * 2048 + (v & 15) * 128; else { const int w = v - HBAT * 16; r0 = (w >> 1) * 256 + (w & 1) * 128; }
                    gmlp_unit(p, l, r0, lds); }
            }
#endif
            SEAM(hb + 1);
#if !defined(ONLY) || ONLY == 4
            if (IN(hb + 2)) {
                PHASE_P();
                phase_scan(p);
            }
#endif
            SEAM(hb + 2);
#if !defined(ONLY) || ONLY == 5
            if (IN(hb + 3)) {
                PHASE_P();
                const int n_l = HBAT * 4 * 8, n_c = (l == 0 ? HBAT * 4 : 0);
                for (int u = bid; u < n_l + n_c; u += G) {
                    int h, qrow0, rc, rl, NT;
                    if (u < n_l) { const int ue = (G == 256) ? ((((u & 7) * 4 + (u >> 6)) << 3) | ((u >> 3) & 7)) : u;
                        const int bl = ue >> 5, qb = ue & 7; h = (ue >> 3) & 3; qrow0 = CTXROWS + bl * 2048 + qb * 256; rc = bl * 256; rl = CTXROWS + bl * 2048; NT = 36; }
                    else { const int v = u - n_l, bl = v >> 2; h = v & 3; qrow0 = bl * 256; rc = bl * 256; rl = 0; NT = 4; }
                    PSEC_BEGINN(9); att::attn_unit(p, l, h, qrow0, rc, rl, NT, lds); PSEC(9);
                }
                const int m_l = HBAT * 16 * 4, m_c = (l == 0 ? HBAT * 2 * 4 : 0);
                int u0 = bid + 192; if (u0 >= G) u0 -= G;
                { u32x4 cq[4], ck[4], cv[4], ccf[4], ccb[4]; f32x4 cg; float cn; const int n_c = m_l + m_c;
                  mlstm_c_load(p, u0 < n_c ? u0 : 0, CPRE_ARGS);
                  PSEC_BEGINN(10);
                  for (int u = u0; u < n_c; u += G) mlstm_c_unit(p, l, u, u + G, n_c, CPRE_ARGS, lds);
                  PSEC(10); }
                if (l == 0 && G == 256 && !(bid >= 64 && bid < 128)) cvt_fill(p, lds, hf == 0 ? 0 : CVT_Q1, hf == 0 ? CVT_Q0 : CVT_Q2, bid < 64 ? bid : bid - 64, 192);
                else if (l == 0 && G != 256) cvt_fill(p, lds, hf == 0 ? 0 : CVT_Q1, hf == 0 ? CVT_Q0 : CVT_Q2, bid, G);
            }
#endif
            SEAM(hb + 3);
#if !defined(ONLY) || ONLY == 6
            if (IN(hb + 4)) {
                PHASE_P(); unsigned char* ws = p.ws; bf16_t* Hh = (bf16_t*)(ws + WS_H) + (size_t)hf * MH * 1024; (void)Hh;
                pg8::Gemm g{pbuf(p, P_QB), (const bf16_t*)(ws + WS_WTBR) + (size_t)l * 3072 * 512, 3 * MH, 3072, 512};
                MergeOrder S; S.init(l == 0 ? 72 : 64, l == 0 ? 0 : 8, G, bid);
                EpiMerge E{pbuf(p, P_GB), Hh};
                pg8::gemm_phase<EpiMerge, MergeOrder>((PG8_LAS unsigned char*)lds, g, S, E, nullptr);
                if (l == 0) { const int skip = G > 64 ? 32 : 0; __syncthreads(); if (bid >= skip) cvt_fill(p, lds, hf == 0 ? CVT_Q0 : CVT_Q2, hf == 0 ? CVT_Q1 : CVT_Q3, bid - skip, G - skip); }
            }
#endif
            SEAM(hb + 4);
#if !defined(ONLY) || ONLY == 7
            if (IN(hb + 5)) {
                PHASE_P(); unsigned char* ws = p.ws; bf16_t* Hh = (bf16_t*)(ws + WS_H) + (size_t)hf * MH * 1024; (void)Hh;
                pg8::Gemm g{Hh, (const bf16_t*)(ws + WS_WTO) + (size_t)l * 1024 * 1024, MH, 1024, 1024};
                RectOrder S; S.init(l == 0 ? 72 : 64, 4, l == 0 ? 0 : 8, 0, 0, 0, G, bid);
                EpiOut E{l == 0 ? p.in[I_X] : (const float*)p.out, l == 0 ? p.in[I_CTX] : (const float*)(ws + WS_XC), p.out, (float*)(ws + WS_XC), (const float*)(ws + WS_MOD) + (size_t)l * 17 * 6144, hf};
                pg8::gemm_phase<EpiOut, RectOrder>((PG8_LAS unsigned char*)lds, g, S, E, nullptr);
                if (l == 0 && hf == 1) { const int skip = G > 64 ? 32 : 0; __syncthreads(); if (bid >= skip) cvt_fill(p, lds, CVT_Q3, CVT_Q4, bid - skip, G - skip); }
            }
#endif
            if (hf == 1) SEAM(hb + 5);
        }
#if !defined(ONLY) || ONLY == 8
        if (IN(base + 13)) { PHASE_P(); phase_norm2_router(p, l, lds); if (l == 1) cvt_fill(p, lds, CVT_Q4, 2 * CVT_TILES, bid, G); }
#endif
        SEAM(base + 13);
#if !defined(ONLY) || ONLY == 9
        if (IN(base + 14)) { PHASE_P(); phase_dispatch(p, l, lds); }
#endif
        SEAM(base + 14);
#if !defined(ONLY) || ONLY == 10
        if (IN(base + 15)) {
            PHASE_P(); unsigned char* ws = p.ws;
            LAS int* seg = (LAS int*)(lds + 131072); LAS int* tile_e = seg + 128;
            const int nt = moe_tile_table(p, l, seg, tile_e);
            pg8::Gemm g{(const bf16_t*)(ws + WS_H8), (const bf16_t*)(ws + WS_WTGU + (size_t)l * 32 * 1024 * 1024), SLOTS, 32 * 1024, 512};
            MoeOrder S; S.init(tile_e, nt, G, bid);
            { LAS int* srcl = (LAS int*)(lds + 131072 + 2048); const int* SRC = (const int*)(ws + WS_SRC);
              for (int i = 0; i < 6; ++i) { int pm, pn; S.unit_of(i, pm, pn); for (int r = opaque_tid(); r < 256; r += NTHR) srcl[i * 256 + r] = pm < nt ? SRC[pm * 256 + r] : 0; }
              S.srcl = srcl; }
            __syncthreads(); EpiGU E{ws + WS_P + P_ACT};
            pg8::gemm_phase<EpiGU, MoeOrder, false, true, true>((PG8_LAS unsigned char*)lds, g, S, E, nullptr);
        }
#endif
        SEAM(base + 15);
#if !defined(ONLY) || ONLY == 11
        if (IN(base + 16)) {
            PHASE_P(); unsigned char* ws = p.ws;
            LAS int* seg = (LAS int*)(lds + 131072); LAS int* tile_e = seg + 128;
            const int nt = moe_tile_table(p, l, seg, tile_e);
            pg8::Gemm g{pbuf(p, P_ACT), (const bf16_t*)(ws + WS_WTD + (size_t)l * 32 * 1024 * 512), SLOTS, 32 * 1024, 256};
            MoeOrder S; S.init(tile_e, nt, G, bid); __syncthreads(); EpiDown E{pbuf(p, P_YS)};
            pg8::gemm_phase<EpiDown, MoeOrder, false, true>((PG8_LAS unsigned char*)lds, g, S, E, nullptr);
        }
#endif
        SEAM(base + 16);
    }
#if !defined(ONLY) || ONLY == 12
    if (IN(35)) { PHASE_P(); phase_final(p); }
#endif
#ifdef PROBE
    if (bid == 0 && tid == 0) {
        asm volatile("s_waitcnt vmcnt(0)" ::: "memory");
        const unsigned long long tend = __builtin_amdgcn_s_memrealtime();
        volatile unsigned long long* st = (volatile unsigned long long*)(opaque_kp()->ws + WS_CTL) + 30000;
        unsigned long long ta = 0, tb = 0;
        for (int k = 0; k < N_PHASES; ++k) { const unsigned long long t0 = st[k], t1 = (k == N_PHASES - 1) ? tend : st[k + 1]; const unsigned long long d = t1 - t0;
            if ((PROBE_A >> k) & 1ull) ta += d; if ((PROBE_B >> k) & 1ull) tb += st[100 + k]; }
        const unsigned long long spin = ((ta + tb) / 1000ull) * 100000ull;
        while (__builtin_amdgcn_s_memrealtime() - tend < spin) __builtin_amdgcn_s_sleep(32);
    }
#endif
#undef IN
#undef SEAM
}

#ifndef MK_CUTS
#define MK_CUTS 0
#endif
extern "C" void kernel_launch(void* const* d_in, const int* in_sizes, int n_in, void* d_out, int out_size, void* d_ws, size_t ws_size, hipStream_t stream) {
    static int grid = 0;
    if (grid == 0) {
        if (n_in != 31 || in_sizes[0] != NBATCH * SEQ * DM || out_size != NBATCH * SEQ * DM || ws_size < WS_END) {
            fprintf(stderr, "kernel_launch: unexpected shapes or workspace (n_in %d, ws %zu, need %zu); nothing launched\n", n_in, ws_size, (size_t)WS_END); grid = -1; return; }
        int dev = 0, cus = 0, per_cu = 0;
        if (hipGetDevice(&dev) != hipSuccess || hipDeviceGetAttribute(&cus, hipDeviceAttributeMultiprocessorCount, dev) != hipSuccess) { grid = -1; return; }
        if (hipFuncSetAttribute((const void*)mk_fwd, hipFuncAttributeMaxDynamicSharedMemorySize, LDS_BYTES) != hipSuccess) { fprintf(stderr, "kernel_launch: hipFuncSetAttribute failed\n"); grid = -1; return; }
        if (hipOccupancyMaxActiveBlocksPerMultiprocessor(&per_cu, (const void*)mk_fwd, NTHR, LDS_BYTES) != hipSuccess || per_cu < 1) { fprintf(stderr, "kernel_launch: occupancy query says %d\n", per_cu); }
        (void)hipGetLastError();
        grid = cus;
    }
    if (grid < 0) return;
    if (hipMemsetAsync((char*)d_ws + WS_CTL, 0, CTL_BYTES, stream) != hipSuccess) return;
    Params p{};
    for (int i = 0; i < 31; ++i) p.in[i] = (const float*)d_in[i];
    p.out = (float*)d_out; p.ws = (unsigned char*)d_ws;
#if MK_CUTS == 0
    p.ph_lo = 0; p.ph_hi = N_PHASES;
    hipLaunchKernelGGL(mk_fwd, dim3(grid), dim3(NTHR), LDS_BYTES, stream, p, 0);
#else
    for (int k = 0; k < N_PHASES; ++k) {
#ifdef EXP_NOMOE
        if ((k >= 14 && k <= 17) || (k >= 31 && k <= 34)) continue;
#endif
#ifdef EXP_NOEXPERT
        if (k == 16 || k == 17 || k == 33 || k == 34) continue;
#endif
#ifdef EXP_NOGU
        if (k == 16 || k == 33) continue;
#endif
#ifdef EXP_NOMIX
        if ((k >= 2 && k <= 13) || (k >= 19 && k <= 30)) continue;
#endif
#ifdef EXP_ZEROXB
        if (k == 15 || k == 32) { hipMemsetAsync((char*)d_ws + WS_P + P_XB, 0, P_MOE_END, stream); hipMemsetAsync((char*)d_ws + WS_WTS, 0, (size_t)SLOTS * 4, stream); }
#endif
        p.ph_lo = k; p.ph_hi = k + 1; hipLaunchKernelGGL(mk_fwd, dim3(grid), dim3(NTHR), LDS_BYTES, stream, p, 0); }
#endif
}
```

```cpp
#include <hip/hip_runtime.h>
#include <cstdio>
#include <cstdint>

#define LAS __attribute__((address_space(3)))
typedef unsigned short bf16_t;
typedef short bf16x8 __attribute__((ext_vector_type(8)));
typedef short s16x4 __attribute__((ext_vector_type(4)));
typedef float f32x2 __attribute__((ext_vector_type(2)));
typedef float f32x4 __attribute__((ext_vector_type(4)));
typedef float f32x16 __attribute__((ext_vector_type(16)));
typedef unsigned u32x2 __attribute__((ext_vector_type(2)));
typedef unsigned u32x4 __attribute__((ext_vector_type(4)));

constexpr int DM = 1024, NBATCH = 16, SEQ = 2048, CTXL = 256, NCOL = 6656;
constexpr int HBAT = 8;
constexpr int MH = HBAT * (SEQ + CTXL);
constexpr int MTOT = 2 * MH;
constexpr int CTXROWS = HBAT * CTXL;
constexpr int NJ = 18;
constexpr int NEXP = 32, DEXP = 512;
constexpr int SLOTS = 81920;
constexpr float EPS = 1e-6f;
constexpr float LOG2E = 1.4426950408889634f;
constexpr float QSCALE = 0.125f * LOG2E;
constexpr int NTHR = 512;
constexpr int LDS_BYTES = 155648;
constexpr int TLD = 136;
constexpr int TILE_B = 128 * TLD * 2;

constexpr size_t AL(size_t x) { return (x + 255) / 256 * 256; }
constexpr size_t WS_CTL   = 0;
constexpr size_t CTL_BYTES = 262144;
constexpr size_t WS_MOD   = WS_CTL + CTL_BYTES;
constexpr size_t WS_WFOLD = WS_MOD + AL((size_t)2 * 17 * 6144 * 4);
constexpr size_t WS_ROPE  = WS_WFOLD + AL((size_t)2 * 16 * 1024 * 4);
constexpr size_t WS_LAM   = WS_ROPE + AL((size_t)2 * 64 * 16 * 4);
constexpr size_t WS_WRT   = WS_LAM + 256;
constexpr size_t WS_WTIN  = WS_WRT + AL((size_t)2 * 2 * 48 * 1024 * 2);
constexpr size_t WS_WTBR  = WS_WTIN + AL((size_t)2 * NCOL * 1024 * 2);
constexpr size_t WS_WTO   = WS_WTBR + AL((size_t)2 * 3072 * 512 * 2);
constexpr size_t WS_WTQKV = WS_WTO + AL((size_t)2 * 1024 * 1024 * 2);
constexpr size_t WS_WSB   = WS_WTQKV + AL((size_t)2 * 12 * 16384 * 2);
constexpr size_t WS_WTGU  = WS_WSB + AL((size_t)2 * 4 * 16384 * 2);
constexpr size_t WS_WTD   = WS_WTGU + AL((size_t)32 * 1024 * 1024 * 2);
constexpr size_t WS_XC    = WS_WTD + AL((size_t)32 * 1024 * 512 * 2);
constexpr size_t WS_H     = WS_XC + AL((size_t)4096 * 1024 * 4);
constexpr size_t WS_H8    = WS_H + AL((size_t)MTOT * 1024 * 2);
constexpr size_t WS_WTIN8 = WS_H8 + AL((size_t)MTOT * 1024);
constexpr size_t WS_EID   = WS_WTIN8 + AL((size_t)2 * 3072 * 1024);
constexpr size_t WS_WTK   = WS_EID + AL((size_t)MTOT * 8);
constexpr size_t WS_POS   = WS_WTK + AL((size_t)MTOT * 8);
constexpr size_t WS_WTS   = WS_POS + AL((size_t)MTOT * 8);
constexpr size_t WS_SRC   = WS_WTS + AL((size_t)SLOTS * 4);
constexpr size_t WS_P     = WS_SRC + AL((size_t)SLOTS * 4);
constexpr size_t S1B      = (size_t)MH * 512 * 2;
constexpr size_t P_KB = 0, P_VB = S1B, P_XMB = 2 * S1B, P_QB = 3 * S1B, P_UB = 4 * S1B, P_ZB = 5 * S1B, P_VGB = 6 * S1B;
constexpr size_t P_GB   = 7 * S1B;
constexpr size_t P_MQ   = P_GB + (size_t)3 * MH * 1024;
constexpr size_t P_MK   = P_MQ + S1B, P_MVT = P_MK + S1B, P_XCV = P_MVT + S1B;
constexpr size_t P_GATES = P_XCV + S1B;
constexpr size_t P_CLOC = P_GATES + AL((size_t)MH * 16 * 4);
constexpr size_t P_NLOC = P_CLOC + (size_t)64 * NJ * 16384 * 2;
constexpr size_t P_MST  = P_NLOC + AL((size_t)64 * NJ * 128 * 4);
constexpr size_t P_END  = P_MST + AL((size_t)64 * NJ * 4 * 4);
constexpr size_t P_XB   = 0;
constexpr size_t P_ACT  = (size_t)SLOTS * 1024;
constexpr size_t P_YS   = P_ACT + (size_t)SLOTS * 512;
constexpr size_t P_MOE_END = P_YS + (size_t)SLOTS * 1024 * 2;
constexpr float WSCALE8 = 635.0f, HSCALE8 = 10.5f, ASCALE8 = 16.0f;
constexpr size_t WS_END = WS_P + (P_END > P_MOE_END ? P_END : P_MOE_END);
constexpr int CW_EXPCNT = 0;
constexpr int CW_HIST = 32768;
constexpr int CW_BAR = 1024;

__device__ __forceinline__ unsigned cvtpk(float lo, float hi) { unsigned r; asm volatile("v_cvt_pk_bf16_f32 %0, %1, %2" : "=v"(r) : "v"(lo), "v"(hi)); return r; }
__device__ __forceinline__ float bf_lo(unsigned w) { return __uint_as_float(w << 16); }
__device__ __forceinline__ float bf_hi(unsigned w) { return __uint_as_float(w & 0xffff0000u); }
__device__ __forceinline__ float bf2f(bf16_t b) { return __uint_as_float(((unsigned)b) << 16); }
__device__ __forceinline__ bf16_t f2bf(float f) { unsigned u = __float_as_uint(f); u += 0x7FFFu + ((u >> 16) & 1u); return (bf16_t)(u >> 16); }
__device__ __forceinline__ float sigmoid_f(float x) { return __builtin_amdgcn_rcpf(1.0f + __builtin_amdgcn_exp2f(-x * LOG2E)); }
__device__ __forceinline__ float gelu_tanh_f(float x) { const float u = 0.7978845608028654f * (x + 0.044715f * x * x * x); return x * sigmoid_f(2.0f * u); }
__device__ __forceinline__ float silu_f(float x) { return x * sigmoid_f(x); }
__device__ __forceinline__ float logsigmoid_f(float x) { return fminf(x, 0.f) - 0.6931471805599453f * __builtin_amdgcn_logf(1.0f + __builtin_amdgcn_exp2f(-fabsf(x) * LOG2E)); }
__device__ __forceinline__ int crow(int r, int hi) { return (r & 3) + 8 * (r >> 2) + 4 * hi; }
__device__ __forceinline__ f32x16 mfma32(bf16x8 a, bf16x8 b, f32x16 c) { return __builtin_amdgcn_mfma_f32_32x32x16_bf16(a, b, c, 0, 0, 0); }
__device__ __forceinline__ float wave_sum(float v) { for (int o = 32; o >= 1; o >>= 1) v += __shfl_xor(v, o); return v; }
template <int CTRL, int ROWMASK> __device__ __forceinline__ float dpp_add(float v) {
    return v + __builtin_bit_cast(float, __builtin_amdgcn_update_dpp(0, __builtin_bit_cast(int, v), CTRL, ROWMASK, 0xf, true)); }
__device__ __forceinline__ float wave_sum63(float v) {
    v = dpp_add<0x111, 0xf>(v); v = dpp_add<0x112, 0xf>(v); v = dpp_add<0x114, 0xf>(v); v = dpp_add<0x118, 0xf>(v);
    v = dpp_add<0x142, 0xa>(v);
    v = dpp_add<0x143, 0xc>(v);
    return v; }
__device__ __forceinline__ float half_sum31(float v) {
    v = dpp_add<0x111, 0xf>(v); v = dpp_add<0x112, 0xf>(v); v = dpp_add<0x114, 0xf>(v); v = dpp_add<0x118, 0xf>(v);
    v = dpp_add<0x142, 0xa>(v); return v; }
__device__ __forceinline__ float wave_max(float v) { for (int o = 32; o >= 1; o >>= 1) v = fmaxf(v, __shfl_xor(v, o)); return v; }

__device__ __forceinline__ void unpack8(const u32x4 w, float (&o)[8]) { o[0] = bf_lo(w.x); o[1] = bf_hi(w.x); o[2] = bf_lo(w.y); o[3] = bf_hi(w.y); o[4] = bf_lo(w.z); o[5] = bf_hi(w.z); o[6] = bf_lo(w.w); o[7] = bf_hi(w.w); }
__device__ __forceinline__ u32x4 pack8(const float (&v)[8]) { u32x4 w; w.x = cvtpk(v[0], v[1]); w.y = cvtpk(v[2], v[3]); w.z = cvtpk(v[4], v[5]); w.w = cvtpk(v[6], v[7]); return w; }
__device__ __forceinline__ int ld_i32_dev(const int* p) { return __hip_atomic_load(p, __ATOMIC_RELAXED, __HIP_MEMORY_SCOPE_AGENT); }
__device__ __forceinline__ float ld_f32_dev(const float* p) { return __hip_atomic_load(p, __ATOMIC_RELAXED, __HIP_MEMORY_SCOPE_AGENT); }
__device__ __forceinline__ unsigned q8(float x) { return (unsigned)(int)fminf(fmaxf(rintf(x), -127.0f), 127.0f) & 0xffu; }
__device__ __forceinline__ unsigned pk4_fp8(float a, float b, float c, float d) { return q8(a) | (q8(b) << 8) | (q8(c) << 16) | (q8(d) << 24); }
#define LBAR() do { asm volatile("s_waitcnt lgkmcnt(0)" ::: "memory"); __builtin_amdgcn_s_barrier(); asm volatile("" ::: "memory"); } while (0)
__device__ __forceinline__ int opaque_tid() { int t = threadIdx.x; asm volatile("" : "+v"(t)); return t; }
#ifdef PROBE
__device__ __forceinline__ unsigned long long* probe_epi_counter() {
    unsigned char* ws = *(unsigned char* const __attribute__((address_space(4)))*)((const __attribute__((address_space(4))) char*)__builtin_amdgcn_kernarg_segment_ptr() + 256);
    const int ph = *(volatile LAS int*)(uintptr_t)(LDS_BYTES - 32);
    return (unsigned long long*)ws + 30100 + ph; }
#endif
#ifdef PROBE
#define PSEC_BEGIN() unsigned pt_ = 0; if (PROBE_SEC == 1) pt_ = (unsigned)__builtin_amdgcn_s_memrealtime()
#define PSEC_BEGINN(n) unsigned pt_ = 0; if (PROBE_SEC == (n)) pt_ = (unsigned)__builtin_amdgcn_s_memrealtime()
#define PSEC_BEGIN6() unsigned pt_ = 0; if (PROBE_SEC == 6) pt_ = (unsigned)__builtin_amdgcn_s_memrealtime()
#define PSEC_BEGIN8() unsigned pt_ = 0; if (PROBE_SEC == 8) pt_ = (unsigned)__builtin_amdgcn_s_memrealtime()
#define PSEC(id) do { if (PROBE_SEC == (id)) { const unsigned pn_ = (unsigned)__builtin_amdgcn_s_memrealtime(); if (blockIdx.x == PROBE_BLK && tid == 0) *probe_epi_counter() += (unsigned long long)(pn_ - pt_); } if (PROBE_SEC == (id) + 1) pt_ = (unsigned)__builtin_amdgcn_s_memrealtime(); } while (0)
#else
#define PSEC_BEGIN() do { } while (0)
#define PSEC_BEGIN6() do { } while (0)
#define PSEC_BEGINN(n) do { } while (0)
#define PSEC_BEGIN8() do { } while (0)
#define PSEC(id) do { } while (0)
#endif
struct Params {
    const float* in[31];
    float* out;
    unsigned char* ws;
    int ph_lo, ph_hi;
};
enum { I_X = 0, I_C, I_CTX, I_CCTX, I_WMOD, I_BMOD, I_GN1, I_GN2, I_WIN, I_DLAM, I_GSUBLN, I_WGS, I_BGS, I_GGV, I_WCONV, I_BCONV, I_WQKV, I_WIF, I_BIF,
       I_GMN, I_SKIP, I_WBR, I_WOUT, I_WRG, I_BRG, I_WRE, I_BRE, I_WEG, I_WEU, I_WED, I_GFIN };

struct RowInfo { int hf, r, isctx, b, t; };
__device__ __forceinline__ RowInfo row_info(int R) {
    RowInfo q; q.hf = R >= MH ? 1 : 0; q.r = R - q.hf * MH;
    if (q.r < CTXROWS) { q.isctx = 1; q.b = q.hf * HBAT + (q.r >> 8); q.t = q.r & 255; }
    else { q.isctx = 0; const int s = q.r - CTXROWS; q.b = q.hf * HBAT + (s >> 11); q.t = s & 2047; }
    return q;
}
#define XB_TMO      128
#define XB_XCNT(j)  (256  + 64 * (j))
#define XB_XSUB(j)  (1280 + 64 * (j))
#define XB_XGEN(j)  (2304 + 64 * (j))
#define XB_TOP      3328
#define XB_TOPGEN   3392
#define XCD_BAR_WORDS 3456
#define XB_SPIN_CAP (1u << 18)

__device__ __forceinline__ unsigned xb_ld(unsigned* p)              { return __hip_atomic_load(p, __ATOMIC_RELAXED, __HIP_MEMORY_SCOPE_AGENT); }
__device__ __forceinline__ unsigned xb_add(unsigned* p, unsigned v) { return __hip_atomic_fetch_add(p, v, __ATOMIC_RELAXED, __HIP_MEMORY_SCOPE_AGENT); }
__device__ __forceinline__ unsigned xb_xcc_id() { return (unsigned)__builtin_amdgcn_s_getreg((3 << 11) | 20) & 0xFu; }
#define XB_SPIN(cond, bar) do { unsigned _sp = 0; while (cond) { __builtin_amdgcn_s_sleep(1); \
    if ((++_sp & 255u) == 0u) { if (xb_ld(&(bar)[XB_TMO])) break; if (_sp > XB_SPIN_CAP) { atomicAdd(&(bar)[XB_TMO], 1u); break; } } } } while (0)

struct XcdBarrier {
    unsigned* bar; unsigned x;
    volatile LAS unsigned* st;
};

__device__ __forceinline__ XcdBarrier xcd_barrier_post(unsigned* bar, volatile LAS unsigned* st) {
    XcdBarrier b; b.bar = bar; b.x = xb_xcc_id(); b.st = st;
    if (threadIdx.x == 0) (void)xb_add(&bar[XB_XCNT(b.x)], 1u);
    return b;
}
__device__ __forceinline__ void xcd_barrier_complete(unsigned* bar, unsigned x, unsigned& nloc, unsigned& nx) {
    const unsigned G = gridDim.x * gridDim.y * gridDim.z;
    unsigned sum, cnt, mine, sp = 0u;
    for (;;) {
        sum = 0u; cnt = 0u; mine = 0u;
#pragma unroll
        for (unsigned j = 0; j < 16; ++j) { const unsigned c = xb_ld(&bar[XB_XCNT(j)]); sum += c; cnt += (c > 0u) ? 1u : 0u; mine = (j == x) ? c : mine; }
        if (sum == G) break;
        __builtin_amdgcn_s_sleep(1);
        if ((++sp & 255u) == 0u) { if (xb_ld(&bar[XB_TMO])) break; if (sp > XB_SPIN_CAP) { atomicAdd(&bar[XB_TMO], 1u); break; } }
    }
    nloc = mine > 0u ? mine : 1u; nx = cnt > 0u ? cnt : 1u;
}

__device__ __forceinline__ void xcd_barrier(const XcdBarrier& b) {
    asm volatile("s_waitcnt vmcnt(0)" ::: "memory");
    __syncthreads();
    if (threadIdx.x == 0) {
        unsigned* bar = b.bar;
        __builtin_amdgcn_s_waitcnt(0);
        unsigned nloc = b.st[0], nx = b.st[1];
        if (nloc == 0u) { xcd_barrier_complete(bar, b.x, nloc, nx); b.st[0] = nloc; b.st[1] = nx; }
        const unsigned old = xb_add(&bar[XB_XSUB(b.x)], 1u);
        const unsigned gen = old / nloc;
        if (old + 1u == (gen + 1u) * nloc) {
            __builtin_amdgcn_fence(__ATOMIC_RELEASE, "agent");
            asm volatile("s_waitcnt vmcnt(0)" ::: "memory");
            const unsigned og = xb_add(&bar[XB_TOP], 1u);
            const unsigned tg = og / nx;
            if (og + 1u == (tg + 1u) * nx) xb_add(&bar[XB_TOPGEN], 1u);
            else XB_SPIN(xb_ld(&bar[XB_TOPGEN]) == tg, bar);
            __builtin_amdgcn_fence(__ATOMIC_ACQUIRE, "agent");
            xb_add(&bar[XB_XGEN(b.x)], 1u);
            asm volatile("s_waitcnt vmcnt(0)" ::: "memory");
        } else {
            XB_SPIN(xb_ld(&bar[XB_XGEN(b.x)]) == gen, bar);
            __builtin_amdgcn_fence(__ATOMIC_ACQUIRE, "agent");
            asm volatile("s_waitcnt vmcnt(0)" ::: "memory");
        }
    }
    __syncthreads();
}
namespace pg8 {
#define PG8_LAS __attribute__((address_space(3)))
typedef unsigned short bf16_t;
typedef short bf16x8 __attribute__((ext_vector_type(8)));
typedef float f32x4 __attribute__((ext_vector_type(4)));
typedef unsigned u32x4 __attribute__((ext_vector_type(4)));
constexpr int BM = 256, BK = 64, HALF = 128, HTB = HALF * BK * 2  , STAGE_BYTES = 8 * HTB, NXCD = 8, WGM = 8;

__host__ __device__ __forceinline__ int lds_byte(int r, int c) { const int st = (r >> 4) * 2 + (c >> 5), rr = r & 15, cc = c & 31, ob = rr * 64 + cc * 2; return st * 1024 + (ob ^ (((ob >> 9) & 1) << 5)); }
__host__ __device__ __forceinline__ void stage_rc(int b, int& R, int& C) { const int st = b / 1024, sb = b % 1024, swz = sb ^ (((sb >> 9) & 1) << 5); R = (st >> 1) * 16 + swz / 64; C = (st & 1) * 32 + (swz % 64) / 2; }
__host__ __device__ __forceinline__ int perm32(int rho) { const int n = rho >> 4, i = rho & 15; return 8 * (i >> 2) + 4 * n + (i & 3); }

struct Unit { int pm, pn; };
struct Gemm { const bf16_t* A; const bf16_t* Bt; int M, N, K; };

struct StaticOrder {
    int nM, nN, nwg, G, c;
    __host__ __device__ void init(int M, int N, int G_, int c_) { nM = M / BM; nN = N / BM; nwg = nM * nN; G = G_; c = c_; }
    __host__ __device__ bool next(int i, Unit& u) const {
        const long L = (long)i * G + c; if (L >= nwg) return false;
        int wgid = (int)L; { const int q = nwg / NXCD, r = nwg % NXCD, xcd = wgid % NXCD, off = wgid / NXCD; wgid = (xcd < r ? xcd * (q + 1) : r * (q + 1) + (xcd - r) * q) + off; }
        const int nig = WGM * nN, gid = wgid / nig, fm = gid * WGM, gsz = (nM - fm) < WGM ? (nM - fm) : WGM;
        u.pm = fm + ((wgid % nig) % gsz); u.pn = (wgid % nig) / gsz; return true;
    }
    __device__ __forceinline__ void a_ready(const Unit&) const {}
    __device__ __forceinline__ void done(const Unit&) const {}
};
__device__ __forceinline__ unsigned cvt_pk_bf16(float lo, float hi) { unsigned r; asm volatile("v_cvt_pk_bf16_f32 %0, %1, %2" : "=v"(r) : "v"(lo), "v"(hi)); return r; }
typedef float f32x2 __attribute__((ext_vector_type(2)));
__device__ __forceinline__ f32x2 gelu_pk(f32x2 v) {
    const f32x2 av = __builtin_elementwise_abs(v), d = av * 0.2316418882f + 1.0f;
    f32x2 t; t.x = __builtin_amdgcn_rcpf(d.x); t.y = __builtin_amdgcn_rcpf(d.y);
    f32x2 q = t * 0.5307027145f + (-0.7265760135f); q = q * t + 0.7107068705f; q = q * t + (-0.142248368f); q = q * t + 0.127414796f; q = q * t;
    const f32x2 s = (v * v) * (-0.72134752044f);
    f32x2 e; e.x = __builtin_amdgcn_exp2f(s.x); e.y = __builtin_amdgcn_exp2f(s.y);
    const f32x2 m = v * (q * e), r = v - m;
    f32x2 o; o.x = v.x < 0.f ? m.x : r.x; o.y = v.y < 0.f ? m.y : r.y; return o;
}

typedef int pg8_i32x4 __attribute__((ext_vector_type(4)));
template <bool F8> struct Frag { bf16x8 k[2]; };
template <class Epi, class Sched, bool STAMP = false, bool F8 = false, bool GA = false>
__device__ __forceinline__ void gemm_phase(PG8_LAS unsigned char* lds, const Gemm g, const Sched& S, const Epi& E, unsigned long long* stamps) {
    int tid_o = threadIdx.x; asm volatile("" : "+v"(tid_o));
    const int tid = tid_o, wid = __builtin_amdgcn_readfirstlane(tid >> 6), lane = tid & 63, wr = wid >> 2, wc = wid & 3, fr = lane & 15, fq = lane >> 4;
    const int K = g.K, nt = K / BK;
    int ts_lo = 0, ts_hi = 0, nts = 0; const unsigned long long rt_entry = STAMP ? (unsigned long long)wall_clock64() : 0ull;
#define PG8_STAMP() do { if (STAMP && wid == 0 && nts < 64) { const unsigned long long _c = (unsigned long long)clock64(); \
        ts_lo = (lane == nts) ? (int)(unsigned)_c : ts_lo; ts_hi = (lane == nts) ? (int)(unsigned)(_c >> 32) : ts_hi; ++nts; } } while (0)
    PG8_STAMP();
    unsigned voffA[2], voffB[2];
#pragma unroll
    for (int i = 0; i < 2; ++i) { int R, C; stage_rc(tid * 16 + i * 8192, R, C); const int Rb = Epi::PERM ? ((R & ~31) + perm32(R & 31)) : R;
        voffA[i] = (unsigned)(R * K + C) * 2u; voffB[i] = (unsigned)(Rb * K + C) * 2u; }
    const size_t pstep = (size_t)64 * K * 2;
    const size_t kstep = (size_t)(BK * 2);
    const size_t hstep = (size_t)HALF * K * 2;
    const size_t tstep = 2 * hstep;
    const unsigned ldsw = (unsigned)wid * 1024u;
    const int aoff = lds_byte(wr * 64 + fr, fq * 8), boff = lds_byte(wc * 32 + fr, fq * 8);
#define PG8_SA(b, h) (((b) * 2 + (h)) * HTB)
#define PG8_SB(b, h) ((4 + (b) * 2 + (h)) * HTB)
#define PG8_STAGE(bufoff, gbase, voff) do { const char* _b0 = (const char*)(gbase); const char* _b1 = _b0 + pstep; asm volatile("" : "+s"(_b0), "+s"(_b1)); \
        __builtin_amdgcn_global_load_lds((const unsigned*)(_b0 + (voff)[0]), (PG8_LAS unsigned*)(lds + (bufoff) + ldsw), 16, 0, 0); \
        __builtin_amdgcn_global_load_lds((const unsigned*)(_b1 + (voff)[0]), (PG8_LAS unsigned*)(lds + (bufoff) + ldsw + 8192), 16, 0, 0); } while (0)
    unsigned gC[4] = {0u, 0u, 0u, 0u}, gN[4] = {0u, 0u, 0u, 0u}; int gR = 0, gCol = 0; stage_rc(tid * 16, gR, gCol);
#define PG8_GOFF(dst, ui_) do { _Pragma("unroll") for (int _j = 0; _j < 4; ++_j) dst[_j] = (unsigned)S.src_row((ui_), gR + 64 * _j) * (unsigned)(K * 2) + (unsigned)(gCol * 2); } while (0)
#define PG8_STAGE_G(bufoff, kptr, h, nx) do { const char* _b = (const char*)(kptr); asm volatile("" : "+s"(_b)); const unsigned _o0 = (nx) ? gN[2 * (h)] : gC[2 * (h)], _o1 = (nx) ? gN[2 * (h) + 1] : gC[2 * (h) + 1]; \
        __builtin_amdgcn_global_load_lds((const unsigned*)(_b + _o0), (PG8_LAS unsigned*)(lds + (bufoff) + ldsw), 16, 0, 0); \
        __builtin_amdgcn_global_load_lds((const unsigned*)(_b + _o1), (PG8_LAS unsigned*)(lds + (bufoff) + ldsw + 8192), 16, 0, 0); } while (0)
#define PG8_LDF(dstf, addr) do { (dstf).k[0] = *(const PG8_LAS bf16x8*)(addr); (dstf).k[1] = *(const PG8_LAS bf16x8*)((addr) + 1024); } while (0)
#define PG8_LDA(dst, b, h) do { _Pragma("unroll") for (int m = 0; m < 4; ++m) PG8_LDF(dst[m], lds + PG8_SA(b, h) + aoff + m * 2048); } while (0)
#define PG8_LDB(dst, b, h) do { _Pragma("unroll") for (int n = 0; n < 2; ++n) PG8_LDF(dst[n], lds + PG8_SB(b, h) + boff + n * 2048); } while (0)
#define PG8_MMA(ai, bj, At, Bt) do { __builtin_amdgcn_s_setprio(1); _Pragma("unroll") for (int m = 0; m < 4; ++m) _Pragma("unroll") for (int n = 0; n < 2; ++n) _Pragma("unroll") for (int k = 0; k < 2; ++k) { \
        if constexpr (F8) acc[ai][bj][m][n] = __builtin_bit_cast(f32x4, __builtin_amdgcn_mfma_i32_16x16x64_i8(__builtin_bit_cast(pg8_i32x4, Bt[n].k[k]), __builtin_bit_cast(pg8_i32x4, At[m].k[k]), __builtin_bit_cast(pg8_i32x4, acc[ai][bj][m][n]), 0, 0, 0)); \
        else acc[ai][bj][m][n] = __builtin_amdgcn_mfma_f32_16x16x32_bf16(Bt[n].k[k], At[m].k[k], acc[ai][bj][m][n], 0, 0, 0); } \
        __builtin_amdgcn_s_setprio(0); } while (0)
#define PG8_WAIT_V(n) asm volatile("s_waitcnt vmcnt(" #n ")" ::: "memory")
#define PG8_WAIT_L(n) asm volatile("s_waitcnt lgkmcnt(" #n ")" ::: "memory")
#define PG8_BAR __builtin_amdgcn_s_barrier()
#define PG8_SCHED __builtin_amdgcn_sched_barrier(0)
    Unit cur, nxt; int ui = 0;
    if (!S.next(0, cur)) return;
    f32x4 acc[2][2][4][2];
#pragma unroll
    for (int a = 0; a < 2; ++a)
#pragma unroll
        for (int b = 0; b < 2; ++b)
#pragma unroll
            for (int m = 0; m < 4; ++m)
#pragma unroll
                for (int n = 0; n < 2; ++n) acc[a][b][m][n] = (f32x4){0.f, 0.f, 0.f, 0.f};
    Frag<F8> At[4], B0[2], B1[2];
    const char* cA = (const char*)g.A + (size_t)cur.pm * tstep; const char* cB = (const char*)g.Bt + (size_t)cur.pn * tstep;
    S.a_ready(cur);
    const char* A0 = (const char*)g.A; if constexpr (GA) PG8_GOFF(gC, 0);
    PG8_STAGE(PG8_SB(0, 0), cB, voffB); if constexpr (GA) PG8_STAGE_G(PG8_SA(0, 0), A0, 0, false); else PG8_STAGE(PG8_SA(0, 0), cA, voffA);
    PG8_STAGE(PG8_SB(0, 1), cB + hstep, voffB); if constexpr (GA) PG8_STAGE_G(PG8_SA(0, 1), A0, 1, false); else PG8_STAGE(PG8_SA(0, 1), cA + hstep, voffA);
    if (wr == 1) PG8_BAR;
    PG8_WAIT_V(4); PG8_BAR;
    PG8_STAGE(PG8_SB(1, 0), cB + kstep, voffB); if constexpr (GA) PG8_STAGE_G(PG8_SA(1, 0), A0 + kstep, 0, false); else PG8_STAGE(PG8_SA(1, 0), cA + kstep, voffA);
    PG8_STAGE(PG8_SB(1, 1), cB + hstep + kstep, voffB);
    PG8_WAIT_V(6); PG8_BAR;
    PG8_STAMP();
    for (;;) {
        const bool has_next = S.next(ui + 1, nxt);
        const char* nA = has_next ? (const char*)g.A + (size_t)nxt.pm * tstep : cA; const char* nB = has_next ? (const char*)g.Bt + (size_t)nxt.pn * tstep : cB;
        if constexpr (GA) { if (has_next) PG8_GOFF(gN, ui + 1); else { gN[0] = gC[0]; gN[1] = gC[1]; gN[2] = gC[2]; gN[3] = gC[3]; } }
        for (int t = 0; t < nt; t += 2) {
            const bool last = (t == nt - 2);
            const char* a1 = cA + (size_t)(t + 1) * kstep;
            const char* a2 = last ? nA : cA + (size_t)(t + 2) * kstep; const char* b2 = last ? nB : cB + (size_t)(t + 2) * kstep;
            const char* a3 = a2 + kstep; const char* b3 = b2 + kstep;
            const char* kA1 = A0 + (size_t)(t + 1) * kstep; const char* kA2 = last ? A0 : A0 + (size_t)(t + 2) * kstep; const char* kA3 = kA2 + kstep;
            if (last && has_next) S.a_ready(nxt);
            PG8_LDB(B0, 0, 0); PG8_SCHED; PG8_LDA(At, 0, 0); if constexpr (GA) PG8_STAGE_G(PG8_SA(1, 1), kA1, 1, false); else PG8_STAGE(PG8_SA(1, 1), a1 + hstep, voffA);
            PG8_WAIT_L(8); PG8_BAR; PG8_WAIT_L(0); PG8_MMA(0, 0, At, B0); PG8_BAR; PG8_SCHED;
            PG8_LDB(B1, 0, 1); PG8_STAGE(PG8_SB(0, 0), b2, voffB);
            PG8_BAR; PG8_WAIT_L(0); PG8_MMA(0, 1, At, B1); PG8_BAR;
            PG8_LDA(At, 0, 1); if constexpr (GA) PG8_STAGE_G(PG8_SA(0, 0), kA2, 0, last); else PG8_STAGE(PG8_SA(0, 0), a2, voffA);
            PG8_BAR; PG8_WAIT_L(0); PG8_MMA(1, 0, At, B0); PG8_BAR; PG8_SCHED;
            PG8_STAGE(PG8_SB(0, 1), b2 + hstep, voffB);
            PG8_WAIT_V(6); PG8_BAR; PG8_MMA(1, 1, At, B1); PG8_BAR;
            PG8_LDB(B0, 1, 0); PG8_SCHED; PG8_LDA(At, 1, 0); if constexpr (GA) PG8_STAGE_G(PG8_SA(0, 1), kA2, 1, last); else PG8_STAGE(PG8_SA(0, 1), a2 + hstep, voffA);
            PG8_WAIT_L(8); PG8_BAR; PG8_WAIT_L(0); PG8_MMA(0, 0, At, B0); PG8_BAR; PG8_SCHED;
            PG8_LDB(B1, 1, 1); PG8_STAGE(PG8_SB(1, 0), b3, voffB);
            PG8_BAR; PG8_WAIT_L(0); PG8_MMA(0, 1, At, B1); PG8_BAR;
            PG8_LDA(At, 1, 1); if constexpr (GA) PG8_STAGE_G(PG8_SA(1, 0), kA3, 0, last); else PG8_STAGE(PG8_SA(1, 0), a3, voffA);
            PG8_BAR; PG8_WAIT_L(0); PG8_MMA(1, 0, At, B0); PG8_BAR; PG8_SCHED;
            PG8_STAGE(PG8_SB(1, 1), b3 + hstep, voffB);
            PG8_WAIT_V(6); PG8_BAR; PG8_MMA(1, 1, At, B1); PG8_BAR;
        }
        PG8_STAMP();
#ifdef PROBE_EPI
        const unsigned long long te0_ = __builtin_amdgcn_s_memrealtime();
#endif
        const bool keep_acc = E(acc, cur, wr, wc, fr, fq); S.done(cur);
#ifdef PROBE_EPI
        if (blockIdx.x == 0 && tid == 0) { unsigned long long* ec_ = probe_epi_counter(); *ec_ += __builtin_amdgcn_s_memrealtime() - te0_; }
#endif
        PG8_STAMP();
        if (!has_next) break;
        if (!keep_acc)
#pragma unroll
        for (int a = 0; a < 2; ++a)
#pragma unroll
            for (int b = 0; b < 2; ++b)
#pragma unroll
                for (int m = 0; m < 4; ++m)
#pragma unroll
                    for (int n = 0; n < 2; ++n) acc[a][b][m][n] = (f32x4){0.f, 0.f, 0.f, 0.f};
        cur = nxt; cA = nA; cB = nB; ++ui;
        if constexpr (GA) { gC[0] = gN[0]; gC[1] = gN[1]; gC[2] = gN[2]; gC[3] = gN[3]; }
    }
    PG8_WAIT_V(0);
    if (wr == 0) PG8_BAR;
    PG8_BAR;
    PG8_STAMP();
    if (STAMP && wid == 0) { stamps[lane] = lane < nts ? (((unsigned long long)(unsigned)ts_hi << 32) | (unsigned)ts_lo) : 0ull;
        if (lane == 62) stamps[62] = rt_entry; if (lane == 63) stamps[63] = (unsigned long long)wall_clock64(); }
#undef PG8_STAMP
#undef PG8_SA
#undef PG8_SB
#undef PG8_STAGE
#undef PG8_STAGE_G
#undef PG8_GOFF
#undef PG8_LDA
#undef PG8_LDF
#undef PG8_LDB
#undef PG8_MMA
#undef PG8_WAIT_V
#undef PG8_WAIT_L
#undef PG8_BAR
#undef PG8_SCHED
}
}
struct RectOrder {
    pg8::StaticOrder so; int offA, nwgA, nMb, nNb, offB, nwgB, G, c;
    __device__ void init(int nMa, int nNa, int offA_, int nMb_, int nNb_, int offB_, int G_, int c_) {
        so.init(nMa * 256, nNa * 256, G_, c_); offA = offA_; nwgA = nMa * nNa; nMb = nMb_; nNb = nNb_; offB = offB_; nwgB = nMb_ * nNb_; G = G_; c = c_; }
    __device__ bool next(int i, pg8::Unit& u) const {
        const int L = i * G + c;
        if (L < nwgA) { so.next(i, u); u.pm += offA; return true; }
        const int Lb = L - nwgA; if (Lb >= nwgB) return false;
        u.pm = offB + Lb % nMb; u.pn = Lb / nMb; return true;
    }
    __device__ __forceinline__ void a_ready(const pg8::Unit&) const {}
    __device__ __forceinline__ void done(const pg8::Unit&) const {}
};
struct MergeOrder {
    pg8::StaticOrder so; int off, G, c;
    __device__ void init(int nM, int off_, int G_, int c_) { so.init(nM * 256, 1024, G_, c_); off = off_; G = G_; c = c_; }
    __device__ bool next(int i, pg8::Unit& u) const {
        const int ti = i / 3, br = i - ti * 3;
        if (!so.next(ti, u)) return false;
        u.pm += off + br * (MH / 256); u.pn += br * 4; return true;
    }
    __device__ __forceinline__ void a_ready(const pg8::Unit&) const {}
    __device__ __forceinline__ void done(const pg8::Unit&) const {}
};
struct MoeOrder {
    const LAS int* srcl = nullptr;
    __device__ __forceinline__ int src_row(int i, int r) const { return srcl[i * 256 + r]; }
    int e0, e1, e2, e3, e4, e5, ntiles, G, c;
    __device__ __forceinline__ void unit_of(int i, int& pm, int& pn) const {
        if ((G & 31) == 0) { const int j = c >> 3; pm = i * (G >> 2) + (c & 7) * (G >> 5) + (j >> 2); pn = j & 3; }
        else { const int L = i * G + c; pm = L >> 2; pn = L & 3; } }
    __device__ __forceinline__ int look(const LAS int* tile_e, int i) const { int pm, pn; unit_of(i, pm, pn); return __builtin_amdgcn_readfirstlane(pm < ntiles ? tile_e[pm] : 0); }
    __device__ __forceinline__ void init(const LAS int* tile_e, int nt, int G_, int c_) { ntiles = nt; G = G_; c = c_;
        e0 = look(tile_e, 0); e1 = look(tile_e, 1); e2 = look(tile_e, 2); e3 = look(tile_e, 3); e4 = look(tile_e, 4); e5 = look(tile_e, 5); }
    __device__ __forceinline__ bool next(int i, pg8::Unit& u) const {
        int pm, pn; unit_of(i, pm, pn); if (pm >= ntiles || i >= 6) return false;
        const int e = i == 0 ? e0 : i == 1 ? e1 : i == 2 ? e2 : i == 3 ? e3 : i == 4 ? e4 : e5;
        u.pm = pm; u.pn = e * 4 + pn; return true;
    }
    __device__ __forceinline__ void a_ready(const pg8::Unit&) const {}
    __device__ __forceinline__ void done(const pg8::Unit&) const {}
};

struct EpiIn {
    static constexpr bool PERM = true, AFTER_DRAIN = false;
    bf16_t* P; bf16_t* GB; const float* cosT; const float* sinT;
    __device__ __forceinline__ bool operator()(pg8::f32x4 (&acc)[2][2][4][2], const pg8::Unit& u, int wr, int wc, int fr, int fq) const {
        const int pn = u.pn, rbase = u.pm * 256 + wr * 64 + fr;
        int act, ld; bf16_t* dst; int cb; bool rope = false; float scl = 1.0f;
        if (pn < 14) {
            const int kind = pn >> 1;
            const int bufidx = kind == 5 ? 6 : (kind == 6 ? 5 : kind);
            dst = P + (size_t)bufidx * ((size_t)MH * 512); ld = 512; cb = (pn & 1) * 256 + wc * 32 + 8 * fq;
            act = (kind == 4 || kind == 5) ? 1 : (kind == 6 ? 2 : 0);
            rope = (kind == 0 || kind == 3) && (u.pm >= 8);
            if (kind == 3) scl = QSCALE;
        } else {
            const int gi = (pn - 14) >> 2, pnl = (pn - 14) & 3, tid = (wr * 4 + wc) * 64 + fq * 16 + fr;
            u32x2* gdst = (u32x2*)GB + ((size_t)((gi * (MH / 256) + u.pm) * 4 + pnl) * 16) * 512 + tid;
#pragma unroll
            for (int ai = 0; ai < 2; ++ai)
#pragma unroll
                for (int m = 0; m < 4; ++m)
#pragma unroll
                    for (int bj = 0; bj < 2; ++bj) { unsigned q[8];
#pragma unroll
                        for (int j = 0; j < 4; ++j) { q[j] = (unsigned)fminf(fmaxf(sigmoid_f(acc[ai][bj][m][0][j]) * 255.0f + 0.5f, 1.0f), 255.0f); q[4 + j] = (unsigned)fminf(fmaxf(sigmoid_f(acc[ai][bj][m][1][j]) * 255.0f + 0.5f, 1.0f), 255.0f); }
                        u32x2 w; w.x = q[0] | (q[1] << 8) | (q[2] << 16) | (q[3] << 24); w.y = q[4] | (q[5] << 8) | (q[6] << 16) | (q[7] << 24);
                        gdst[(size_t)((ai * 4 + m) * 2 + bj) * 512] = w; }
            return false;
        }
        pg8::f32x4 csv[8], snv[8];
#pragma unroll
        for (int i = 0; i < 8; ++i) { csv[i] = (pg8::f32x4){1.f, 1.f, 1.f, 1.f}; snv[i] = (pg8::f32x4){0.f, 0.f, 0.f, 0.f}; }
        if (rope) {
#pragma unroll
            for (int i = 0; i < 8; ++i) { const int row = rbase + (i >> 2) * 128 + (i & 3) * 16; const int t = (row - CTXROWS) & 2047; const int pos = (wc & 1) ? (t & 63) : (t >> 6);
                csv[i] = *(const pg8::f32x4*)(cosT + pos * 16 + 4 * fq); snv[i] = *(const pg8::f32x4*)(sinT + pos * 16 + 4 * fq); } }
#pragma unroll
        for (int ai = 0; ai < 2; ++ai)
#pragma unroll
            for (int m = 0; m < 4; ++m) {
                const int row = rbase + ai * 128 + m * 16;
                const pg8::f32x4 cs = csv[ai * 4 + m], sn = snv[ai * 4 + m];
                bf16_t* rowp = dst + (size_t)row * ld + cb;
#pragma unroll
                for (int bj = 0; bj < 2; ++bj) {
                    pg8::f32x4 v0 = acc[ai][bj][m][0], v1 = acc[ai][bj][m][1];
                    if (rope) { const pg8::f32x4 o0 = v0 * cs - v1 * sn, o1 = v0 * sn + v1 * cs; v0 = o0; v1 = o1; }
                    v0 *= scl; v1 *= scl;
                    if (act == 1) {
#pragma unroll
                        for (int j = 0; j < 4; ++j) { v0[j] = gelu_tanh_f(v0[j]); v1[j] = gelu_tanh_f(v1[j]); } }
                    else if (act == 2) {
#pragma unroll
                        for (int j = 0; j < 4; ++j) { v0[j] = fmaxf(sigmoid_f(v0[j]), 1e-6f); v1[j] = fmaxf(sigmoid_f(v1[j]), 1e-6f); } }
                    u32x4 w; w.x = cvtpk(v0[0], v0[1]); w.y = cvtpk(v0[2], v0[3]); w.z = cvtpk(v1[0], v1[1]); w.w = cvtpk(v1[2], v1[3]);
                    *(u32x4*)(rowp + bj * 128) = w;
                }
            }
        return false;
    }
};
struct EpiGate8 {
    static constexpr bool PERM = true, AFTER_DRAIN = false;
    bf16_t* GB;
    __device__ __forceinline__ bool operator()(pg8::f32x4 (&acc)[2][2][4][2], const pg8::Unit& u, int wr, int wc, int fr, int fq) const {
        const int gi = u.pn >> 2, pnl = u.pn & 3, tid = (wr * 4 + wc) * 64 + fq * 16 + fr; const float sc = 1.0f / (HSCALE8 * WSCALE8);
        u32x2* gdst = (u32x2*)GB + ((size_t)((gi * (MH / 256) + u.pm) * 4 + pnl) * 16) * 512 + tid;
#pragma unroll
        for (int ai = 0; ai < 2; ++ai)
#pragma unroll
            for (int m = 0; m < 4; ++m)
#pragma unroll
                for (int bj = 0; bj < 2; ++bj) { unsigned q[8];
#pragma unroll
                    for (int j = 0; j < 4; ++j) { q[j] = (unsigned)fminf(fmaxf(sigmoid_f((float)__float_as_int(acc[ai][bj][m][0][j]) * sc) * 255.0f + 0.5f, 1.0f), 255.0f);
                        q[4 + j] = (unsigned)fminf(fmaxf(sigmoid_f((float)__float_as_int(acc[ai][bj][m][1][j]) * sc) * 255.0f + 0.5f, 1.0f), 255.0f); }
                    u32x2 w; w.x = q[0] | (q[1] << 8) | (q[2] << 16) | (q[3] << 24); w.y = q[4] | (q[5] << 8) | (q[6] << 16) | (q[7] << 24);
                    gdst[(size_t)((ai * 4 + m) * 2 + bj) * 512] = w; }
        return false;
    }
};
struct EpiMerge {
    static constexpr bool PERM = true, AFTER_DRAIN = false;
    const bf16_t* GB; bf16_t* OUT;
    __device__ __forceinline__ bool operator()(pg8::f32x4 (&acc)[2][2][4][2], const pg8::Unit& u, int wr, int wc, int fr, int fq) const {
        const int br = u.pn >> 2, pn = u.pn & 3, pm = u.pm - br * (MH / 256), tid = (wr * 4 + wc) * 64 + fq * 16 + fr;
        const int rbase = pm * 256 + wr * 64 + fr, cb = pn * 256 + wc * 32 + 8 * fq;
        const u32x2* g0 = (const u32x2*)GB + ((size_t)((br * (MH / 256) + pm) * 4 + pn) * 16) * 512 + tid;
        const u32x2* g1 = g0 + (size_t)(MH / 256) * 4 * 16 * 512;
        u32x2 ga_[16], gb_[16];
#pragma unroll
        for (int s = 0; s < 16; ++s) { ga_[s] = g0[(size_t)s * 512]; gb_[s] = (br < 2) ? g1[(size_t)s * 512] : (u32x2){0x01010101u, 0x01010101u}; }
#pragma unroll
        for (int ai = 0; ai < 2; ++ai)
#pragma unroll
            for (int m = 0; m < 4; ++m) {
                const size_t off = (size_t)(rbase + ai * 128 + m * 16) * 1024 + cb;
#pragma unroll
                for (int bj = 0; bj < 2; ++bj) {
                    const int slot = (ai * 4 + m) * 2 + bj;
                    const u32x2 a = ga_[slot], b = gb_[slot];
                    float ga[8];
#pragma unroll
                    for (int j = 0; j < 4; ++j) { ga[j] = (float)((a.x >> (8 * j)) & 0xffu); ga[4 + j] = (float)((a.y >> (8 * j)) & 0xffu); }
                    if (br < 2) {
#pragma unroll
                        for (int j = 0; j < 4; ++j) { ga[j] *= __builtin_amdgcn_rcpf((float)((b.x >> (8 * j)) & 0xffu)); ga[4 + j] *= __builtin_amdgcn_rcpf((float)((b.y >> (8 * j)) & 0xffu)); }
                    } else {
#pragma unroll
                        for (int j = 0; j < 8; ++j) ga[j] *= (1.0f / 255.0f);
                    }
                    pg8::f32x4 v0 = acc[ai][bj][m][0], v1 = acc[ai][bj][m][1];
#pragma unroll
                    for (int j = 0; j < 4; ++j) { v0[j] *= ga[j]; v1[j] *= ga[4 + j]; }
                    if (br < 2) { acc[ai][bj][m][0] = v0; acc[ai][bj][m][1] = v1; }
                    else { u32x4 w; w.x = cvtpk(v0[0], v0[1]); w.y = cvtpk(v0[2], v0[3]); w.z = cvtpk(v1[0], v1[1]); w.w = cvtpk(v1[2], v1[3]);
                        *(u32x4*)(OUT + off + bj * 128) = w; }
                }
            }
        return br < 2;
    }
};
struct EpiOut {
    static constexpr bool PERM = false, AFTER_DRAIN = false;
    const float* xres_lat; const float* xres_ctx; float* xs_lat; float* xs_ctx; const float* mod; int hf;
    __device__ __forceinline__ bool operator()(pg8::f32x4 (&acc)[2][2][4][2], const pg8::Unit& u, int wr, int wc, int fr, int fq) const {
        const int pm = u.pm; const float* src; float* dst; int b;
        if (pm < 8) { b = 16; const size_t o = (size_t)((hf * HBAT + pm) * 256) * 1024; src = xres_ctx + o; dst = xs_ctx + o; }
        else { const int q = pm - 8; b = hf * HBAT + (q >> 3); const size_t o = ((size_t)b * 2048 + (size_t)(q & 7) * 256) * 1024; src = xres_lat + o; dst = xs_lat + o; }
        const int col0 = u.pn * 256 + wc * 32 + 4 * fq;
        const float* mrow = mod + (size_t)b * 6144 + 2 * 1024 + col0;
        pg8::f32x4 mv[2][2];
#pragma unroll
        for (int bj = 0; bj < 2; ++bj)
#pragma unroll
            for (int n = 0; n < 2; ++n) mv[bj][n] = *(const pg8::f32x4*)(mrow + bj * 128 + n * 16);
#pragma unroll
        for (int ai = 0; ai < 2; ++ai) {
            pg8::f32x4 xr[4][2][2];
#pragma unroll
            for (int m = 0; m < 4; ++m) { const size_t off = (size_t)(wr * 64 + fr + ai * 128 + m * 16) * 1024 + col0;
#pragma unroll
                for (int bj = 0; bj < 2; ++bj)
#pragma unroll
                    for (int n = 0; n < 2; ++n) xr[m][bj][n] = *(const pg8::f32x4*)(src + off + bj * 128 + n * 16); }
#pragma unroll
            for (int m = 0; m < 4; ++m) { const size_t off = (size_t)(wr * 64 + fr + ai * 128 + m * 16) * 1024 + col0;
#pragma unroll
                for (int bj = 0; bj < 2; ++bj)
#pragma unroll
                    for (int n = 0; n < 2; ++n) *(pg8::f32x4*)(dst + off + bj * 128 + n * 16) = xr[m][bj][n] + mv[bj][n] * acc[ai][bj][m][n]; }
            asm volatile("" ::: "memory");
        }
        return false;
    }
};
struct EpiGU {
    static constexpr bool PERM = true, AFTER_DRAIN = false;
    unsigned char* ACT;
    __device__ __forceinline__ bool operator()(pg8::f32x4 (&acc)[2][2][4][2], const pg8::Unit& u, int wr, int wc, int fr, int fq) const {
        const int rbase = u.pm * 256 + wr * 64 + fr, cb = (u.pn & 3) * 128 + wc * 32 + 8 * fq;
        const float sc = 1.0f / (HSCALE8 * WSCALE8);
#pragma unroll
        for (int ai = 0; ai < 2; ++ai)
#pragma unroll
            for (int m = 0; m < 4; ++m) {
                float o[8];
#pragma unroll
                for (int n = 0; n < 2; ++n)
#pragma unroll
                    for (int j = 0; j < 4; ++j) o[4 * n + j] = silu_f((float)__float_as_int(acc[ai][0][m][n][j]) * sc) * ((float)__float_as_int(acc[ai][1][m][n][j]) * (sc * ASCALE8));
                u32x2 w; w.x = pk4_fp8(o[0], o[1], o[2], o[3]); w.y = pk4_fp8(o[4], o[5], o[6], o[7]);
                *(u32x2*)(ACT + (size_t)(rbase + ai * 128 + m * 16) * 512 + cb) = w;
            }
        return false;
    }
};
struct EpiDown {
    static constexpr bool PERM = true, AFTER_DRAIN = false;
    bf16_t* YS;
    __device__ __forceinline__ bool operator()(pg8::f32x4 (&acc)[2][2][4][2], const pg8::Unit& u, int wr, int wc, int fr, int fq) const {
        const int rbase = u.pm * 256 + wr * 64 + fr, cb = (u.pn & 3) * 256 + wc * 32 + 8 * fq;
#pragma unroll
        for (int ai = 0; ai < 2; ++ai)
#pragma unroll
            for (int m = 0; m < 4; ++m) {
                const int row = rbase + ai * 128 + m * 16;
#pragma unroll
                for (int bj = 0; bj < 2; ++bj) { const float s8 = 1.0f / (ASCALE8 * WSCALE8); u32x4 w;
                    w.x = cvtpk((float)__float_as_int(acc[ai][bj][m][0][0]) * s8, (float)__float_as_int(acc[ai][bj][m][0][1]) * s8); w.y = cvtpk((float)__float_as_int(acc[ai][bj][m][0][2]) * s8, (float)__float_as_int(acc[ai][bj][m][0][3]) * s8);
                    w.z = cvtpk((float)__float_as_int(acc[ai][bj][m][1][0]) * s8, (float)__float_as_int(acc[ai][bj][m][1][1]) * s8); w.w = cvtpk((float)__float_as_int(acc[ai][bj][m][1][2]) * s8, (float)__float_as_int(acc[ai][bj][m][1][3]) * s8);
                    *(u32x4*)(YS + (size_t)row * 1024 + cb + bj * 128) = w; }
            }
        return false;
    }
};
template <class ColMap>
__device__ __forceinline__ void cvt_tile_T(const float* __restrict__ src, int ldsrc, bf16_t* __restrict__ dst, int K, int k0, int n0, const ColMap& cm, float scale, LAS float* tile) {
    const int tid = opaque_tid();
    {
        const int n = tid & 63, kb = tid >> 6; const int sc = cm(n0 + n);
#pragma unroll
        for (int i = 0; i < 8; ++i) { const int k = kb + 8 * i; tile[k * 65 + n] = src[(size_t)(k0 + k) * ldsrc + sc] * scale; }
    }
    __syncthreads();
    {
        const int kp = (tid & 31) * 2, nb = tid >> 5;
#pragma unroll
        for (int i = 0; i < 4; ++i) { const int n = nb + 16 * i; *(unsigned*)(dst + (size_t)(n0 + n) * K + k0 + kp) = cvtpk(tile[kp * 65 + n], tile[(kp + 1) * 65 + n]); }
    }
    __syncthreads();
}
struct CmIdent { int off; __device__ __forceinline__ int operator()(int n) const { return n + off; } };
struct CmWin {
    __device__ __forceinline__ int operator()(int n) const {
        if (n < 512 || (n >= 1536 && n < 2048)) { const int c = n & 31, f = c >> 3, j = c & 7; return (n & ~31) + ((j < 4) ? (4 * f + j) : (16 + 4 * f + (j - 4))); }
        return n; }
};
struct CmGU {
    __device__ __forceinline__ int operator()(int n) const { return 128 * (n >> 8) + (n & 127); }
};

template <int MODE, bool OUT8 = false>
__device__ __forceinline__ void cvt_tile_T256(const float* __restrict__ baseA, const float* __restrict__ baseB, int ldsrc, void* __restrict__ dstv, int K, int k0, int n0, float scale, LAS float* tile) {
    const int tid = opaque_tid();
    {
        const int n = tid & 255, kb = tid >> 8, ng = n0 + n;
        const float* sp = (MODE == 2 ? ((ng & 128) ? baseB : baseA) + 128 * (ng >> 8) + (ng & 127) : MODE == 1 ? baseA + CmWin{}(ng) : baseA + ng) + (size_t)(k0 + kb) * ldsrc;
        float v[32];
#pragma unroll
        for (int i = 0; i < 32; ++i) v[i] = sp[(size_t)(2 * i) * ldsrc];
#pragma unroll
        for (int i = 0; i < 32; ++i) tile[(kb + 2 * i) * 257 + n] = v[i] * scale;
    }
    __syncthreads();
    {
        const int n = tid >> 1, kh = (tid & 1) * 32;
        if constexpr (OUT8) { unsigned char* dp = (unsigned char*)dstv + (size_t)(n0 + n) * K + k0 + kh;
#pragma unroll
            for (int i = 0; i < 2; ++i) { float f[16];
#pragma unroll
                for (int j = 0; j < 16; ++j) f[j] = tile[(kh + 16 * i + j) * 257 + n];
                u32x4 w; w.x = pk4_fp8(f[0], f[1], f[2], f[3]); w.y = pk4_fp8(f[4], f[5], f[6], f[7]); w.z = pk4_fp8(f[8], f[9], f[10], f[11]); w.w = pk4_fp8(f[12], f[13], f[14], f[15]);
                *(u32x4*)(dp + 16 * i) = w; } }
        else { bf16_t* dp = (bf16_t*)dstv + (size_t)(n0 + n) * K + k0 + kh;
#pragma unroll
            for (int i = 0; i < 4; ++i) { float f[8];
#pragma unroll
                for (int j = 0; j < 8; ++j) f[j] = tile[(kh + 8 * i + j) * 257 + n];
                *(u32x4*)(dp + 8 * i) = pack8(f); } }
    }
    __syncthreads();
}

__device__ __forceinline__ void phase_prologue(const Params& p, LAS unsigned char* lds) {
    LAS float* tile = (LAS float*)lds;
    const int tid = opaque_tid(), G = gridDim.x, bid = blockIdx.x;
    unsigned char* ws = p.ws;
    for (int u = bid; u < 1248; u += G) {
        if (u < 448) { const int l = u / 224, r = u % 224, kt = r / 14, nt = r % 14;
            cvt_tile_T256<1>(p.in[I_WIN] + (size_t)l * 1024 * NCOL, nullptr, NCOL, (bf16_t*)(ws + WS_WTIN) + (size_t)l * NCOL * 1024, 1024, kt * 64, nt * 256, 1.0f, tile); }
        else if (u < 832) { const int v = u - 448, l = v / 192, r = v % 192, kt = r / 12, nt = r % 12;
            cvt_tile_T256<0, true>(p.in[I_WIN] + (size_t)l * 1024 * NCOL + 3584, nullptr, NCOL, ws + WS_WTIN8 + (size_t)l * 3072 * 1024, 1024, kt * 64, nt * 256, WSCALE8, tile); }
        else if (u < 1024) { const int v = u - 832, li = v / 32, r = v % 32, kt = r / 4, nt = r % 4;
            cvt_tile_T256<0>(p.in[I_WBR] + (size_t)li * 512 * 1024, nullptr, 1024, (bf16_t*)(ws + WS_WTBR) + (size_t)li * 1024 * 512, 512, kt * 64, nt * 256, 1.0f, tile); }
        else if (u < 1152) { const int v = u - 1024, l = v / 64, r = v % 64, kt = r / 4, nt = r % 4;
            cvt_tile_T256<0>(p.in[I_WOUT] + (size_t)l * 1024 * 1024, nullptr, 1024, (bf16_t*)(ws + WS_WTO) + (size_t)l * 1024 * 1024, 1024, kt * 64, nt * 256, 1.0f, tile); }
        else { const int v = u - 1152, m = v / 4, r = v % 4, kt = r >> 1, nt = r & 1;
            const int j = (m >> 2) % 3;
            cvt_tile_T(p.in[I_WQKV] + (size_t)m * 16384, 128, (bf16_t*)(ws + WS_WTQKV) + (size_t)m * 16384, 128, kt * 64, nt * 64, CmIdent{0}, j == 1 ? 0.08838834764831845f : 1.0f, tile); }
    }
    const int gt = bid * NTHR + tid, gn = G * NTHR;
    for (int i = gt; i < 2 * 4 * 16384; i += gn) ((bf16_t*)(ws + WS_WSB))[i] = f2bf(p.in[I_WGS][i]);
    for (int i = gt; i < 2 * 48 * 1024; i += gn) {
        const int l = i / (48 * 1024), r = i % (48 * 1024), n = r >> 10, k = r & 1023;
        float w = 0.f; if (n < 4) w = p.in[I_WRG][((size_t)l * 1024 + k) * 4 + n]; else if (n < 36) w = p.in[I_WRE][((size_t)l * 1024 + k) * 32 + (n - 4)];
        const bf16_t hi = f2bf(w); const bf16_t lo = f2bf(w - bf2f(hi));
        bf16_t* d = (bf16_t*)(ws + WS_WRT) + (size_t)l * 2 * 48 * 1024;
        d[r] = hi; d[48 * 1024 + r] = lo;
    }
    for (int i = gt; i < 1024; i += gn) { const int pos = i >> 4, f = i & 15; const float inv = powf(10000.0f, -(float)f / 16.0f); const float a = (float)pos * inv;
        ((float*)(ws + WS_ROPE))[i] = cosf(a); ((float*)(ws + WS_ROPE))[1024 + i] = sinf(a); }
    if (gt < 2) { const int l = gt; const float* lp = p.in[I_DLAM] + l * 256; float s01 = 0.f, s23 = 0.f;
        for (int i = 0; i < 64; ++i) { s01 += lp[i] * lp[64 + i]; s23 += lp[128 + i] * lp[192 + i]; }
        const float lam_init = 0.8f - 0.6f * expf(-0.3f * (float)l);
        float* o = (float*)(ws + WS_LAM) + l * 4; o[0] = expf(s01) - expf(s23) + lam_init; o[1] = 1.0f - lam_init; }
    for (int i = gt; i < 2 * 16 * 1024; i += gn) {
        const int l = i >> 14, gc = (i >> 10) & 15, ch = i & 1023, part = ch >> 9, c = ch & 511, h = c >> 7, d = c & 127;
        const float* wif = p.in[I_WIF] + (size_t)l * 1536 * 16; const float* wq = p.in[I_WQKV] + (size_t)l * 3 * 4 * 16384;
        float s = 0.f;
        if (part == 0) { const float* a = wq + ((size_t)(0 * 4 + h) * 128 + d) * 128; const float* b = wq + ((size_t)(1 * 4 + h) * 128 + d) * 128;
            for (int e = 0; e < 128; ++e) s += a[e] * wif[(size_t)(h * 128 + e) * 16 + gc] + b[e] * wif[(size_t)(512 + h * 128 + e) * 16 + gc]; }
        else { const float* a = wq + ((size_t)(2 * 4 + h) * 128 + d) * 128;
            for (int e = 0; e < 128; ++e) s += a[e] * wif[(size_t)(1024 + h * 128 + e) * 16 + gc]; }
        ((float*)(ws + WS_WFOLD))[i] = s;
    }
    {
        LAS float* sc = (LAS float*)lds;
        LAS float* red = sc + 17 * 1024;
        bool loaded = false;
        for (int u = bid; u < 192; u += G) {
            if (!loaded) { for (int i = tid; i < 17 * 1024; i += NTHR) { const float v = i < 16384 ? p.in[I_C][i] : p.in[I_CCTX][i - 16384]; sc[i] = silu_f(v); } loaded = true; }
            __syncthreads();
            const int l = u / 96, cbk = u % 96, col = cbk * 64 + (tid & 63), kq = tid >> 6;
            float a[17];
#pragma unroll
            for (int b = 0; b < 17; ++b) a[b] = 0.f;
            const float* wp = p.in[I_WMOD] + (size_t)l * 1024 * 6144 + col;
            for (int k0 = kq * 128; k0 < kq * 128 + 128; k0 += 8) { float w[8];
#pragma unroll
                for (int j = 0; j < 8; ++j) w[j] = wp[(size_t)(k0 + j) * 6144];
#pragma unroll
                for (int j = 0; j < 8; ++j)
#pragma unroll
                    for (int b = 0; b < 17; ++b) a[b] += sc[b * 1024 + k0 + j] * w[j]; }
#pragma unroll
            for (int b = 0; b < 17; ++b) red[(kq * 17 + b) * 64 + (tid & 63)] = a[b];
            __syncthreads();
            for (int i = tid; i < 17 * 64; i += NTHR) { const int b = i >> 6, c = i & 63; float s2 = 0.f;
#pragma unroll
                for (int k = 0; k < 8; ++k) s2 += red[(k * 17 + b) * 64 + c];
                ((float*)(ws + WS_MOD))[((size_t)l * 17 + b) * 6144 + cbk * 64 + c] = s2 + p.in[I_BMOD][(size_t)l * 6144 + cbk * 64 + c]; }
            __syncthreads();
        }
    }
}

constexpr int CVT_TILES = 3072;
struct CvtT { const float* a; const float* b; unsigned char* dst; int ldsrc, K, k0, n0; };
__device__ __forceinline__ CvtT cvt_decode(const Params& p, int t) {
    const int l = t >= CVT_TILES ? 1 : 0, u = t - l * CVT_TILES; CvtT c;
    if (u < 2048) { const int e = u >> 6, q = u & 63; const size_t eo = ((size_t)l * 32 + e) * 1024 * 512;
        c.a = p.in[I_WEG] + eo; c.b = p.in[I_WEU] + eo; c.dst = p.ws + WS_WTGU + ((size_t)l * 32 + e) * 1024 * 1024; c.ldsrc = 512; c.K = 1024; c.k0 = (q >> 2) * 64; c.n0 = (q & 3) * 256; }
    else { const int v = u - 2048, e = v >> 5, q = v & 31;
        c.a = p.in[I_WED] + ((size_t)l * 32 + e) * 512 * 1024; c.b = nullptr; c.dst = p.ws + WS_WTD + ((size_t)l * 32 + e) * 1024 * 512; c.ldsrc = 1024; c.K = 512; c.k0 = (q >> 2) * 64; c.n0 = (q & 3) * 256; }
    return c;
}
__device__ __forceinline__ void cvt_load(const CvtT& c, float (&v)[32]) {
    const int tid = opaque_tid(), n = tid & 255, kb = tid >> 8, ng = c.n0 + n;
    const float* sp = (c.b ? ((ng & 128) ? c.b : c.a) + 128 * (ng >> 8) + (ng & 127) : c.a + ng) + (size_t)(c.k0 + kb) * c.ldsrc;
#pragma unroll
    for (int i = 0; i < 32; ++i) v[i] = sp[(size_t)(2 * i) * c.ldsrc];
}
__device__ __forceinline__ void cvt_finish(const CvtT& c, const float (&v)[32], LAS float* tile) {
    const int tid = opaque_tid();
    { const int n = tid & 255, kb = tid >> 8;
#pragma unroll
      for (int i = 0; i < 32; ++i) tile[(kb + 2 * i) * 257 + n] = v[i] * WSCALE8; }
    __syncthreads();
    { const int n = tid >> 1, kh = (tid & 1) * 32; unsigned char* dp = c.dst + (size_t)(c.n0 + n) * c.K + c.k0 + kh;
#pragma unroll
      for (int i = 0; i < 2; ++i) { float f[16];
#pragma unroll
          for (int j = 0; j < 16; ++j) f[j] = tile[(kh + 16 * i + j) * 257 + n];
          u32x4 w; w.x = pk4_fp8(f[0], f[1], f[2], f[3]); w.y = pk4_fp8(f[4], f[5], f[6], f[7]); w.z = pk4_fp8(f[8], f[9], f[10], f[11]); w.w = pk4_fp8(f[12], f[13], f[14], f[15]);
          *(u32x4*)(dp + 16 * i) = w; } }
}
__device__ __forceinline__ void cvt_fill(const Params& p, LAS unsigned char* lds, int t0, int t1, int r, int nr) {
    LAS float* tA = (LAS float*)lds; LAS float* tB = tA + 64 * 257 + 64;
    asm volatile("" : "+s"(r));
    float va[32], vb[32]; int t = t0 + r;
    if (t < t1) cvt_load(cvt_decode(p, t), va);
    for (; t < t1; t += 2 * nr) {
        if (t + nr < t1) cvt_load(cvt_decode(p, t + nr), vb);
        cvt_finish(cvt_decode(p, t), va, tA);
        if (t + 2 * nr < t1) cvt_load(cvt_decode(p, t + 2 * nr), va);
        if (t + nr < t1) cvt_finish(cvt_decode(p, t + nr), vb, tB);
    }
    __syncthreads();
}
constexpr int CVT_Q0 = 0, CVT_Q1 = 2240, CVT_Q2 = 2240, CVT_Q3 = 4480, CVT_Q4 = 5600;

__device__ __forceinline__ void ld_row_f32(const float* src, int lane, float (&v)[16]) {
    const f32x4 a = *(const f32x4*)(src + 8 * lane), b = *(const f32x4*)(src + 8 * lane + 4), c = *(const f32x4*)(src + 512 + 8 * lane), d = *(const f32x4*)(src + 512 + 8 * lane + 4);
#pragma unroll
    for (int j = 0; j < 4; ++j) { v[j] = a[j]; v[4 + j] = b[j]; v[8 + j] = c[j]; v[12 + j] = d[j]; }
}
__device__ __forceinline__ void st_row_f32(float* dst, int lane, const float (&v)[16]) {
    *(f32x4*)(dst + 8 * lane) = (f32x4){v[0], v[1], v[2], v[3]}; *(f32x4*)(dst + 8 * lane + 4) = (f32x4){v[4], v[5], v[6], v[7]};
    *(f32x4*)(dst + 512 + 8 * lane) = (f32x4){v[8], v[9], v[10], v[11]}; *(f32x4*)(dst + 512 + 8 * lane + 4) = (f32x4){v[12], v[13], v[14], v[15]};
}
__device__ __forceinline__ void ld_row_bf16(const bf16_t* src, int lane, float (&v)[16]) {
    const u32x4 a = *(const u32x4*)(src + 8 * lane), b = *(const u32x4*)(src + 512 + 8 * lane);
    v[0] = bf_lo(a.x); v[1] = bf_hi(a.x); v[2] = bf_lo(a.y); v[3] = bf_hi(a.y); v[4] = bf_lo(a.z); v[5] = bf_hi(a.z); v[6] = bf_lo(a.w); v[7] = bf_hi(a.w);
    v[8] = bf_lo(b.x); v[9] = bf_hi(b.x); v[10] = bf_lo(b.y); v[11] = bf_hi(b.y); v[12] = bf_lo(b.z); v[13] = bf_hi(b.z); v[14] = bf_lo(b.w); v[15] = bf_hi(b.w);
}
__device__ __forceinline__ void st_row_bf16(bf16_t* dst, int lane, const float (&v)[16]) {
    u32x4 a, b; a.x = cvtpk(v[0], v[1]); a.y = cvtpk(v[2], v[3]); a.z = cvtpk(v[4], v[5]); a.w = cvtpk(v[6], v[7]);
    b.x = cvtpk(v[8], v[9]); b.y = cvtpk(v[10], v[11]); b.z = cvtpk(v[12], v[13]); b.w = cvtpk(v[14], v[15]);
    *(u32x4*)(dst + 8 * lane) = a; *(u32x4*)(dst + 512 + 8 * lane) = b;
}
template <int MODE>
__device__ __forceinline__ void load_resid4(const Params& p, int R0, const RowInfo& q, int lmoe, int lane, float (&v)[4][16]) {
    const float* src; float* dst;
    if (q.isctx) { const size_t o = ((size_t)q.b * 256 + q.t) * 1024; src = (MODE == 0 ? p.in[I_CTX] : (const float*)(p.ws + WS_XC)) + o; dst = (float*)(p.ws + WS_XC) + o; }
    else { const size_t o = ((size_t)q.b * 2048 + q.t) * 1024; src = (MODE == 0 ? p.in[I_X] : (const float*)p.out) + o; dst = p.out + o; }
#pragma unroll
    for (int i = 0; i < 4; ++i) ld_row_f32(src + (size_t)i * 1024, lane, v[i]);
    if (MODE == 1 || MODE == 3) {
        const int* slot = (const int*)(p.ws + WS_POS) + 2 * (size_t)R0; const float* wk = (const float*)(p.ws + WS_WTK) + 2 * (size_t)R0;
        const bf16_t* ys = (const bf16_t*)(p.ws + WS_P + P_YS);
        int sl[8]; float ww[8];
#pragma unroll
        for (int i = 0; i < 8; ++i) { sl[i] = ld_i32_dev(slot + i); ww[i] = ld_f32_dev(wk + i); }
        float m5[16]; ld_row_f32((const float*)(p.ws + WS_MOD) + ((size_t)lmoe * 17 + (q.isctx ? 16 : q.b)) * 6144 + 5 * 1024, lane, m5);
        u32x4 ya[4][2], yb[4][2];
#pragma unroll
        for (int i = 0; i < 4; ++i) { const bf16_t* r1 = ys + (size_t)sl[2 * i] * 1024; const bf16_t* r2 = ys + (size_t)sl[2 * i + 1] * 1024;
            ya[i][0] = *(const u32x4*)(r1 + 8 * lane); ya[i][1] = *(const u32x4*)(r1 + 512 + 8 * lane); yb[i][0] = *(const u32x4*)(r2 + 8 * lane); yb[i][1] = *(const u32x4*)(r2 + 512 + 8 * lane); }
#pragma unroll
        for (int i = 0; i < 4; ++i) { float y1[8], y2[8];
#pragma unroll
            for (int hh = 0; hh < 2; ++hh) { unpack8(ya[i][hh], y1); unpack8(yb[i][hh], y2);
#pragma unroll
                for (int j = 0; j < 8; ++j) v[i][8 * hh + j] += m5[8 * hh + j] * (ww[2 * i] * y1[j] + ww[2 * i + 1] * y2[j]); }
            if (MODE == 1) st_row_f32(dst + (size_t)i * 1024, lane, v[i]); }
    }
}
struct RowPar { float g[16], sh[16], sc[16]; };
__device__ __forceinline__ void load_rowpar(const Params& p, int l, int which, const RowInfo& q, int lane, RowPar& rp) {
    const float* mrow = (const float*)(p.ws + WS_MOD) + ((size_t)l * 17 + (q.isctx ? 16 : q.b)) * 6144;
    ld_row_f32(p.in[which ? I_GN2 : I_GN1] + (size_t)l * 1024, lane, rp.g);
    ld_row_f32(mrow + (which ? 3 : 0) * 1024, lane, rp.sh); ld_row_f32(mrow + (which ? 4 : 1) * 1024, lane, rp.sc);
}
__device__ __forceinline__ void norm_mod_row(const RowPar& rp, int lane, const float (&v)[16], bf16_t* hrow, unsigned char* h8row = nullptr) {
    float ss = 0.f;
#pragma unroll
    for (int j = 0; j < 16; ++j) ss += v[j] * v[j];
    ss = wave_sum(ss); const float rs = rsqrtf(ss * (1.0f / 1024.0f) + EPS);
    float o[16];
#pragma unroll
    for (int j = 0; j < 16; ++j) o[j] = v[j] * rs * rp.g[j] * (1.0f + rp.sc[j]) + rp.sh[j];
    st_row_bf16(hrow, lane, o);
    if (h8row) { u32x2 a, b; a.x = pk4_fp8(o[0] * HSCALE8, o[1] * HSCALE8, o[2] * HSCALE8, o[3] * HSCALE8); a.y = pk4_fp8(o[4] * HSCALE8, o[5] * HSCALE8, o[6] * HSCALE8, o[7] * HSCALE8);
        b.x = pk4_fp8(o[8] * HSCALE8, o[9] * HSCALE8, o[10] * HSCALE8, o[11] * HSCALE8); b.y = pk4_fp8(o[12] * HSCALE8, o[13] * HSCALE8, o[14] * HSCALE8, o[15] * HSCALE8);
        *(u32x2*)(h8row + 8 * lane) = a; *(u32x2*)(h8row + 512 + 8 * lane) = b; }
}
__device__ __forceinline__ void phase_norm1(const Params& p, int l) {
    const int tid = opaque_tid(), wid = __builtin_amdgcn_readfirstlane(tid >> 6), lane = tid & 63;
    for (int gq = blockIdx.x * 8 + wid; gq < MTOT / 4; gq += gridDim.x * 8) {
        const int R0 = 4 * gq; const RowInfo q = row_info(R0); float v[4][16]; RowPar rp;
        load_rowpar(p, l, 0, q, lane, rp);
        if (l == 0) load_resid4<0>(p, R0, q, 0, lane, v); else load_resid4<1>(p, R0, q, l - 1, lane, v);
#pragma unroll
        for (int i = 0; i < 4; ++i) norm_mod_row(rp, lane, v[i], (bf16_t*)(p.ws + WS_H) + (size_t)(R0 + i) * 1024, p.ws + WS_H8 + (size_t)(R0 + i) * 1024);
    }
}
__device__ __forceinline__ void phase_final(const Params& p) {
    const int tid = opaque_tid(), wid = __builtin_amdgcn_readfirstlane(tid >> 6), lane = tid & 63;
    float g[16]; ld_row_f32(p.in[I_GFIN], lane, g);
    for (int gq = blockIdx.x * 8 + wid; gq < NBATCH * SEQ / 4; gq += gridDim.x * 8) {
        const int a = 4 * gq, R0 = (a >> 14) * MH + CTXROWS + (a & 16383);
        const RowInfo q = row_info(R0); float v[4][16];
        load_resid4<3>(p, R0, q, 1, lane, v);
#pragma unroll
        for (int i = 0; i < 4; ++i) { float ss = 0.f;
#pragma unroll
            for (int j = 0; j < 16; ++j) ss += v[i][j] * v[i][j];
            ss = wave_sum(ss); const float rs = rsqrtf(ss * (1.0f / 1024.0f) + EPS);
#pragma unroll
            for (int j = 0; j < 16; ++j) v[i][j] = v[i][j] * rs * g[j];
            st_row_f32(p.out + ((size_t)q.b * 2048 + q.t + i) * 1024, lane, v[i]); }
    }
}
__device__ __forceinline__ int active_row(int l, int a) { return l == 0 ? a : (a >> 14) * MH + CTXROWS + (a & 16383); }
typedef float f32x4v __attribute__((ext_vector_type(4)));
__device__ __forceinline__ void phase_norm2_router(const Params& p, int l, LAS unsigned char* lds) {
    const int tid = opaque_tid(), wid = tid >> 6, lane = tid & 63, G = gridDim.x, bid = blockIdx.x;
    const int NA = l == 0 ? MTOT : NBATCH * SEQ;
    const int chunk = (((NA + G - 1) / G) + 15) & ~15;
    const int a0 = bid * chunk, a1 = (a0 + chunk < NA) ? a0 + chunk : NA, na = a1 > a0 ? a1 - a0 : 0;
    LAS float* lg = (LAS float*)lds;
    LAS float* lgs = (LAS float*)(lds + 73728);
    LAS int* re = (LAS int*)(lds + 83968);
    LAS float* rw = (LAS float*)(lds + 83968 + 2048);
    LAS int* rr = (LAS int*)(lds + 83968 + 4096);
    LAS int* hist = (LAS int*)(lds + 83968 + 6144);
    LAS int* base = hist + 32;
    if (tid < 32) hist[tid] = 0;
    bf16_t* H = (bf16_t*)(p.ws + WS_H);
    PSEC_BEGINN(11);
    for (int bq = wid; bq * 4 < na; bq += 8)
        { const int a = a0 + bq * 4; if (a >= a1) break;
            const int R0 = active_row(l, a); const RowInfo q = row_info(R0); float v[4][16]; RowPar rp;
            load_rowpar(p, l, 1, q, lane, rp);
            load_resid4<2>(p, R0, q, 0, lane, v);
#pragma unroll
            for (int k = 0; k < 4; ++k) norm_mod_row(rp, lane, v[k], H + (size_t)(R0 + k) * 1024, p.ws + WS_H8 + (size_t)(R0 + k) * 1024); }
    asm volatile("s_waitcnt vmcnt(0)" ::: "memory"); __syncthreads();
    PSEC(11);
    const bf16_t* Wr = (const bf16_t*)(p.ws + WS_WRT) + (size_t)l * 2 * 48 * 1024;
    const float* brg = p.in[I_BRG] + l * 4; const float* bre = p.in[I_BRE] + l * 32;
    const int ng = (na + 15) >> 4, r16 = lane & 15, kq = lane >> 4;
    LAS float* brl = (LAS float*)(lds + 83968 + 6144 + 512);
    if (tid < 36) brl[tid] = tid < 4 ? brg[tid] : bre[tid - 4];
    if (ng > 0) {
        bf16x8 bh[4][3], bl[4][3];
        { const bf16_t* bp = Wr + (size_t)r16 * 1024 + 128 * wid + 8 * kq;
#pragma unroll
          for (int ks = 0; ks < 4; ++ks)
#pragma unroll
              for (int ct = 0; ct < 3; ++ct) { bh[ks][ct] = *(const bf16x8*)(bp + (size_t)ct * 16 * 1024 + ks * 32); bl[ks][ct] = *(const bf16x8*)(bp + (size_t)(48 + ct * 16) * 1024 + ks * 32); } }
        __builtin_amdgcn_sched_barrier(0);
#pragma unroll 1
        for (int g0 = 0; g0 < ng; g0 += 3) {
            bf16x8 a[3][4];
#pragma unroll
            for (int gq = 0; gq < 3; ++gq) { int ar = a0 + (g0 + gq) * 16 + r16; if (ar >= a1) ar = a1 - 1;
                const bf16_t* ap = H + (size_t)active_row(l, ar) * 1024 + 128 * wid + 8 * kq;
#pragma unroll
                for (int ks = 0; ks < 4; ++ks) a[gq][ks] = *(const bf16x8*)(ap + ks * 32); }
            __builtin_amdgcn_sched_barrier(0);
#pragma unroll
            for (int gq = 0; gq < 3; ++gq) {
                f32x4v acc[3] = {{0.f, 0.f, 0.f, 0.f}, {0.f, 0.f, 0.f, 0.f}, {0.f, 0.f, 0.f, 0.f}};
#pragma unroll
                for (int ks = 0; ks < 4; ++ks)
#pragma unroll
                    for (int ct = 0; ct < 3; ++ct) { acc[ct] = __builtin_amdgcn_mfma_f32_16x16x32_bf16(a[gq][ks], bh[ks][ct], acc[ct], 0, 0, 0); acc[ct] = __builtin_amdgcn_mfma_f32_16x16x32_bf16(a[gq][ks], bl[ks][ct], acc[ct], 0, 0, 0); }
#pragma unroll
                for (int ct = 0; ct < 3; ++ct)
#pragma unroll
                    for (int r = 0; r < 4; ++r) lg[((gq * 8 + wid) * 16 + 4 * kq + r) * 48 + ct * 16 + r16] = acc[ct][r];
            }
            __syncthreads();
            for (int o = tid; o < 3 * 768; o += NTHR) { const int gq = o >= 1536 ? 2 : (o >= 768 ? 1 : 0), rem = o - gq * 768; float s = 0.f;
#pragma unroll
                for (int w = 0; w < 8; ++w) s += lg[(gq * 8 + w) * 768 + rem];
                lgs[o] = s; }
            __syncthreads();
            if (tid < 48) {
                const int a = a0 + (g0 + (tid >> 4)) * 16 + (tid & 15);
                if (g0 + (tid >> 4) < ng && a < a1) {
                    const LAS float* x = lgs + tid * 48;
                    float gl[4]; int gs = 0; float gmax;
#pragma unroll
                    for (int j = 0; j < 4; ++j) gl[j] = x[j] + brl[j];
                    gmax = gl[0];
#pragma unroll
                    for (int j = 1; j < 4; ++j) if (gl[j] > gmax) { gmax = gl[j]; gs = j; }
                    float gsum = 0.f;
#pragma unroll
                    for (int j = 0; j < 4; ++j) gsum += __expf(gl[j] - gmax);
                    const float pg = 1.0f / gsum;
                    float v1 = -3.0e38f, v2 = -3.0e38f; int i1 = 0, i2 = 0;
                    for (int j = 0; j < 8; ++j) { const float ev = x[4 + gs * 8 + j] + brl[4 + gs * 8 + j];
                        if (ev > v1) { v2 = v1; i2 = i1; v1 = ev; i1 = j; } else if (ev > v2) { v2 = ev; i2 = j; } }
                    const float t = __expf(v2 - v1); const float w1 = pg / (1.0f + t), w2 = pg * t / (1.0f + t);
                    const int e1 = gs * 8 + i1, e2 = gs * 8 + i2, i = a - a0;
                    re[i] = e1; re[256 + i] = e2; rw[i] = w1; rw[256 + i] = w2;
                }
            }
            __syncthreads();
        }
    }
    __syncthreads();
    PSEC(12);
    if (tid < 32) { int c = 0; for (int i = 0; i < na; ++i) { if (re[i] == tid) rr[i] = c++; if (re[256 + i] == tid) rr[256 + i] = c++; } hist[tid] = c; }
    __syncthreads();
    int* hg = (int*)(p.ws + WS_CTL) + CW_HIST + (l * 256 + bid) * 32;
    if (tid < 32) hg[tid] = hist[tid];
    (void)base;
    int* EID = (int*)(p.ws + WS_EID); float* WTK = (float*)(p.ws + WS_WTK); int* POS = (int*)(p.ws + WS_POS);
    for (int i = tid; i < na; i += NTHR) { const size_t R = (size_t)active_row(l, a0 + i);
        EID[2 * R] = re[i]; EID[2 * R + 1] = re[256 + i]; WTK[2 * R] = rw[i]; WTK[2 * R + 1] = rw[256 + i];
        POS[2 * R] = rr[i]; POS[2 * R + 1] = rr[256 + i]; }
    __syncthreads();
    PSEC(13);
}
__device__ __forceinline__ void moe_segments(const Params& p, int l, LAS int* seg, int myblk) {
    const int tid = opaque_tid(); LAS int* cnt = seg + 40; LAS int* pre = seg + 80; LAS int* part = seg + 4096;
    { const int e = tid & 31, pt = tid >> 5, nb = (int)gridDim.x, per = (nb + 15) >> 4;
      const int* hg = (const int*)(p.ws + WS_CTL) + CW_HIST + l * 256 * 32 + e; int tot = 0, pr = 0;
      for (int b0 = pt * per; b0 < (pt + 1) * per; b0 += 16) { int cv[16];
#pragma unroll
          for (int j = 0; j < 16; ++j) { const int b = b0 + j; cv[j] = (b < (pt + 1) * per && b < nb) ? hg[b * 32] : 0; }
#pragma unroll
          for (int j = 0; j < 16; ++j) { if (b0 + j < myblk) pr += cv[j]; tot += cv[j]; } }
      part[(pt * 2) * 32 + e] = tot; part[(pt * 2 + 1) * 32 + e] = pr; }
    __syncthreads();
    if (tid < 32) { int tot = 0, pr = 0;
#pragma unroll
        for (int pt = 0; pt < 16; ++pt) { tot += part[(pt * 2) * 32 + tid]; pr += part[(pt * 2 + 1) * 32 + tid]; }
        cnt[tid] = tot; pre[tid] = pr; }
    __syncthreads();
    if (tid == 0) { int s = 0; for (int e = 0; e < 32; ++e) { seg[e] = s; s += (cnt[e] + 255) & ~255; } if (s > SLOTS) s = SLOTS; seg[32] = s; }
    __syncthreads();
}
__device__ __forceinline__ void phase_dispatch(const Params& p, int l, LAS unsigned char* lds) {
    const int tid = opaque_tid(), G = gridDim.x, bid = blockIdx.x;
    LAS int* seg = (LAS int*)lds; moe_segments(p, l, seg, bid); const LAS int* cnt = seg + 40; const LAS int* pre = seg + 80;
    const int NA = l == 0 ? MTOT : NBATCH * SEQ;
    const int chunk = (((NA + G - 1) / G) + 15) & ~15;
    const int a0 = bid * chunk, a1 = (a0 + chunk < NA) ? a0 + chunk : NA;
    const int* EID = (const int*)(p.ws + WS_EID); const float* WTK = (const float*)(p.ws + WS_WTK); int* POS = (int*)(p.ws + WS_POS); float* WTS = (float*)(p.ws + WS_WTS); int* SRC = (int*)(p.ws + WS_SRC);
    for (int i = tid; i < 2 * (a1 - a0); i += NTHR) {
        const int R = active_row(l, a0 + (i >> 1)); const size_t x = 2 * (size_t)R + (i & 1);
        const int e = EID[x], ps = POS[x]; const float w = WTK[x];
        const int s = seg[e] + pre[e] + ps;
        SRC[s] = R; POS[x] = s; WTS[s] = w; }
    for (int e = bid; e < 32; e += G)
        for (int s = seg[e] + cnt[e] + tid; s < seg[e + 1]; s += NTHR) SRC[s] = 0;
    __syncthreads();
}
__device__ __forceinline__ int moe_tile_table(const Params& p, int l, LAS int* seg, LAS int* tile_e) {
    moe_segments(p, l, seg, 0);
    const int nt = seg[32] >> 8;
    for (int i = opaque_tid(); i < nt; i += NTHR) { int e = 0; for (int k = 1; k < 32; ++k) if ((i << 8) >= seg[k]) e = k; tile_e[i] = e; }
    __syncthreads();
    return __builtin_amdgcn_readfirstlane(nt);
}
__device__ __forceinline__ void lds_addf(LAS float* a, float v) { (void)__hip_atomic_fetch_add(a, v, __ATOMIC_RELAXED, __HIP_MEMORY_SCOPE_WORKGROUP); }
__device__ __forceinline__ bf16_t* pbuf(const Params& p, size_t off) { return (bf16_t*)(p.ws + WS_P + off); }
#ifndef MMU
#define MMU 2
#endif
__device__ __forceinline__ void mm128(const LAS bf16_t* A, const LAS bf16_t* Bt, f32x16 (&acc)[2], int wid, int lane) {
    const int r32 = lane & 31, hi = lane >> 5;
    const LAS bf16_t* ap = A + (32 * (wid >> 1) + r32) * TLD + hi * 8;
    const LAS bf16_t* bp = Bt + (64 * (wid & 1) + r32) * TLD + hi * 8;
#pragma unroll MMU
    for (int ks = 0; ks < 8; ++ks) {
        const bf16x8 a = *(const LAS bf16x8*)(ap + ks * 16), b0 = *(const LAS bf16x8*)(bp + ks * 16), b1 = *(const LAS bf16x8*)(bp + 32 * TLD + ks * 16);
        acc[0] = mfma32(a, b0, acc[0]); acc[1] = mfma32(a, b1, acc[1]);
    }
}
__device__ __forceinline__ void mm128_gB(const LAS bf16_t* A, const bf16_t* __restrict__ Bg, f32x16 (&acc)[2], int wid, int lane) {
    const int r32 = lane & 31, hi = lane >> 5;
    const LAS bf16_t* ap = A + (32 * (wid >> 1) + r32) * TLD + hi * 8;
    const bf16_t* bp = Bg + (64 * (wid & 1) + r32) * 128 + hi * 8;
#pragma unroll MMU
    for (int ks = 0; ks < 8; ++ks) {
        const bf16x8 a = *(const LAS bf16x8*)(ap + ks * 16), b0 = *(const bf16x8*)(bp + ks * 16), b1 = *(const bf16x8*)(bp + 32 * 128 + ks * 16);
        acc[0] = mfma32(a, b0, acc[0]); acc[1] = mfma32(a, b1, acc[1]);
    }
}
__device__ __forceinline__ void st_acc_T(LAS bf16_t* T, const f32x16 (&acc)[2], int wid, int lane) {
    const int r32 = lane & 31, hi = lane >> 5;
#pragma unroll
    for (int tl = 0; tl < 2; ++tl)
#pragma unroll
        for (int g = 0; g < 4; ++g) { u32x2 w; w.x = cvtpk(acc[tl][4 * g], acc[tl][4 * g + 1]); w.y = cvtpk(acc[tl][4 * g + 2], acc[tl][4 * g + 3]);
            *(LAS u32x2*)(T + (64 * (wid & 1) + 32 * tl + r32) * TLD + 32 * (wid >> 1) + 8 * g + 4 * hi) = w; }
}

__device__ __forceinline__ void st_acc_rm(LAS bf16_t* T, const f32x16 (&acc)[2], int wid, int lane) {
    const int r32 = lane & 31, hi = lane >> 5;
    LAS bf16_t* b = T + (32 * (wid >> 1) + 4 * hi) * TLD + 64 * (wid & 1) + r32;
#pragma unroll
    for (int tl = 0; tl < 2; ++tl)
#pragma unroll
        for (int r = 0; r < 16; ++r) b[((r & 3) + 8 * (r >> 2)) * TLD + 32 * tl] = (bf16_t)(cvtpk(acc[tl][r], acc[tl][r]) & 0xffffu);
}
constexpr int FLD = 132;
__device__ __forceinline__ void st_acc_f32(LAS float* F, const f32x16 (&acc)[2], int wid, int lane) {
    const int r32 = lane & 31, hi = lane >> 5;
    LAS float* b = F + (32 * (wid >> 1) + 4 * hi) * FLD + 64 * (wid & 1) + r32;
#pragma unroll
    for (int tl = 0; tl < 2; ++tl)
#pragma unroll
        for (int r = 0; r < 16; ++r) b[((r & 3) + 8 * (r >> 2)) * FLD + 32 * tl] = acc[tl][r];
}
__device__ __forceinline__ void copy_tile_out(const LAS bf16_t* T, bf16_t* dst, int ld) {
    const int tx = opaque_tid(), t = tx >> 2, c0 = (tx & 3) * 32;
#pragma unroll
    for (int i = 0; i < 4; ++i) *(u32x4*)(dst + (size_t)t * ld + c0 + 8 * i) = *(const LAS u32x4*)(T + t * TLD + c0 + 8 * i);
}

__device__ __forceinline__ bool seq_start(int r) { return r < CTXROWS ? (r & 255) == 0 : ((r - CTXROWS) & 2047) == 0; }
template <int CTRL> __device__ __forceinline__ u32x4 dpp4(const u32x4 v) { u32x4 o;
    o.x = (unsigned)__builtin_amdgcn_update_dpp(0, (int)v.x, CTRL, 0xf, 0xf, true); o.y = (unsigned)__builtin_amdgcn_update_dpp(0, (int)v.y, CTRL, 0xf, 0xf, true);
    o.z = (unsigned)__builtin_amdgcn_update_dpp(0, (int)v.z, CTRL, 0xf, 0xf, true); o.w = (unsigned)__builtin_amdgcn_update_dpp(0, (int)v.w, CTRL, 0xf, 0xf, true); return o; }
__device__ __forceinline__ void phase_conv(const Params& p, int l, LAS unsigned char* lds) {
    const int tid = opaque_tid(), wid = __builtin_amdgcn_readfirstlane(tid >> 6), lane = tid & 63, r16 = lane & 15, kg = lane >> 4, G = gridDim.x, bid = blockIdx.x;
    constexpr int NG = MH / 16, NU = 5;
    const bf16_t* XM = pbuf(p, P_XMB); bf16_t* XCV = pbuf(p, P_XCV); float* GT = (float*)(p.ws + WS_P + P_GATES);
    LAS float* PX = (LAS float*)lds;
    for (int g0 = bid; g0 < NG; g0 += NU * G) {
        f32x4v acc[NU];
#pragma unroll
        for (int u = 0; u < NU; ++u) acc[u] = (f32x4v){0.f, 0.f, 0.f, 0.f};
#pragma unroll 1
        for (int ks = 0; ks < 2; ++ks) {
            const int c = 64 * wid + 32 * ks + 8 * kg;
            u32x4 cur[NU], edge[NU];
#pragma unroll
            for (int u = 0; u < NU; ++u) { const int g = g0 + G * u; const bool valid = g < NG; const int row = 16 * g + r16;
                cur[u] = valid ? *(const u32x4*)(XM + (size_t)row * 512 + c) : (u32x4){0u, 0u, 0u, 0u};
                const bool he = valid && ((r16 == 0 && !seq_start(16 * g)) || (r16 == 15 && !seq_start(16 * g + 16)));
                const int er = r16 == 0 ? row - 1 : row + 1;
                edge[u] = he ? *(const u32x4*)(XM + (size_t)er * 512 + c) : (u32x4){0u, 0u, 0u, 0u}; }
            float w0[8], w1[8], w2[8], bc[8];
            { const float* wc = p.in[I_WCONV] + (size_t)l * 3 * 512 + c; const float* bcp = p.in[I_BCONV] + (size_t)l * 512 + c;
#pragma unroll
              for (int j = 0; j < 8; ++j) { w0[j] = wc[j]; w1[j] = wc[512 + j]; w2[j] = wc[1024 + j]; bc[j] = bcp[j]; } }
            bf16x8 wyh, wyl, wxh, wxl;
            { const float* wf = (const float*)(p.ws + WS_WFOLD) + ((size_t)l * 16 + r16) * 1024 + c; float a[8], b[8], t8[8];
#pragma unroll
              for (int j = 0; j < 8; ++j) { a[j] = wf[j]; b[j] = wf[512 + j]; }
              u32x4 hh = pack8(a); unpack8(hh, t8);
#pragma unroll
              for (int j = 0; j < 8; ++j) t8[j] = a[j] - t8[j];
              u32x4 ll = pack8(t8); wyh = *(const bf16x8*)&hh; wyl = *(const bf16x8*)&ll;
              hh = pack8(b); unpack8(hh, t8);
#pragma unroll
              for (int j = 0; j < 8; ++j) t8[j] = b[j] - t8[j];
              ll = pack8(t8); wxh = *(const bf16x8*)&hh; wxl = *(const bf16x8*)&ll; }
#pragma unroll
            for (int u = 0; u < NU; ++u) { const int g = g0 + G * u;
                const u32x4 sp = dpp4<0x111>(cur[u]), sn = dpp4<0x101>(cur[u]);
                u32x4 pw, nw;
                pw.x = r16 == 0 ? edge[u].x : sp.x; pw.y = r16 == 0 ? edge[u].y : sp.y; pw.z = r16 == 0 ? edge[u].z : sp.z; pw.w = r16 == 0 ? edge[u].w : sp.w;
                nw.x = r16 == 15 ? edge[u].x : sn.x; nw.y = r16 == 15 ? edge[u].y : sn.y; nw.z = r16 == 15 ? edge[u].z : sn.z; nw.w = r16 == 15 ? edge[u].w : sn.w;
                float xp[8], xc[8], xn[8], y[8], yl[8]; unpack8(pw, xp); unpack8(cur[u], xc); unpack8(nw, xn);
#pragma unroll
                for (int j = 0; j < 8; ++j) y[j] = silu_f(w0[j] * xp[j] + w1[j] * xc[j] + w2[j] * xn[j] + bc[j]);
                const u32x4 yh = pack8(y); unpack8(yh, yl);
#pragma unroll
                for (int j = 0; j < 8; ++j) yl[j] = y[j] - yl[j];
                const u32x4 ylw = pack8(yl);
                const bf16x8 ah = *(const bf16x8*)&yh, al = *(const bf16x8*)&ylw, ax = *(const bf16x8*)&cur[u];
                acc[u] = __builtin_amdgcn_mfma_f32_16x16x32_bf16(ah, wyh, acc[u], 0, 0, 0); acc[u] = __builtin_amdgcn_mfma_f32_16x16x32_bf16(ah, wyl, acc[u], 0, 0, 0);
                acc[u] = __builtin_amdgcn_mfma_f32_16x16x32_bf16(al, wyh, acc[u], 0, 0, 0);
                acc[u] = __builtin_amdgcn_mfma_f32_16x16x32_bf16(ax, wxh, acc[u], 0, 0, 0); acc[u] = __builtin_amdgcn_mfma_f32_16x16x32_bf16(ax, wxl, acc[u], 0, 0, 0);
                if (g < NG) *(u32x4*)(XCV + (size_t)(16 * g + r16) * 512 + c) = yh; }
        }
#pragma unroll
        for (int u = 0; u < NU; ++u)
#pragma unroll
            for (int r = 0; r < 4; ++r) PX[((u * 8 + wid) * 16 + 4 * kg + r) * 16 + r16] = acc[u][r];
        __syncthreads();
        for (int o = tid; o < NU * 256; o += NTHR) { const int u = o >> 8, row = (o >> 4) & 15, n = o & 15, g = g0 + G * u; float s = p.in[I_BIF][l * 16 + n];
#pragma unroll
            for (int w = 0; w < 8; ++w) s += PX[((u * 8 + w) * 16 + row) * 16 + n];
            if (g < NG) GT[(size_t)(16 * g + row) * 16 + (n & 3) * 4 + (n >> 2)] = s; }
        __syncthreads();
    }
}
__device__ __forceinline__ void ld8row(const bf16_t* base, int pos, int seqlen, float (&o)[8]) {
    if (pos < 0 || pos >= seqlen) {
#pragma unroll
        for (int j = 0; j < 8; ++j) o[j] = 0.f; }
    else unpack8(*(const u32x4*)(base + (size_t)pos * 512), o);
}
__device__ __forceinline__ void mlstm_a_ids(int u, int& bl, int& J, int& h, int& r0) {
    bl = u / (NJ * 4); const int rem = u - bl * (NJ * 4); J = rem >> 2; h = rem & 3;
    r0 = (J < 2 ? bl * 256 : CTXROWS + bl * 2048) + (J < 2 ? J * 128 : (J - 2) * 128);
}
#define APRE_PARAMS u32x4 (&qa)[4], u32x4 (&qb)[4], u32x4 (&qwq)[4], u32x4 (&qwk)[4], u32x4 (&qwv)[4], f32x4& qg
#define APRE_ARGS qa, qb, qwq, qwk, qwv, qg
__device__ __forceinline__ void mlstm_a_load(const Params& p, int l, int u, APRE_PARAMS) {
    const int tid = opaque_tid(); int bl, J, h, r0; mlstm_a_ids(u, bl, J, h, r0);
    const int t = tid >> 2, cc = (tid & 3) * 32; const size_t o = (size_t)(r0 + t) * 512 + h * 128 + cc;
    const bf16_t* XM = pbuf(p, P_XMB) + o; const bf16_t* XCV = pbuf(p, P_XCV) + o;
    const bf16_t* Wq = (const bf16_t*)(p.ws + WS_WTQKV) + ((size_t)(l * 3) * 4 + h) * 16384 + t * 128 + cc;
#pragma unroll
    for (int i = 0; i < 4; ++i) { qa[i] = *(const u32x4*)(XCV + 8 * i); qb[i] = *(const u32x4*)(XM + 8 * i);
        qwq[i] = *(const u32x4*)(Wq + 8 * i); qwk[i] = *(const u32x4*)(Wq + (size_t)4 * 16384 + 8 * i); qwv[i] = *(const u32x4*)(Wq + (size_t)8 * 16384 + 8 * i); }
    qg = *(const f32x4*)((const float*)(p.ws + WS_P + P_GATES) + (size_t)(r0 + (tid & 127)) * 16 + h * 4);
}
__device__ __forceinline__ void mlstm_a_unit(const Params& p, int l, int u, int unext, int n_a, APRE_PARAMS, LAS unsigned char* lds) {
    int tid_ = threadIdx.x; asm volatile("" : "+v"(tid_));
    const int tid = tid_, wid = __builtin_amdgcn_readfirstlane(tid >> 6), lane = tid & 63, r32 = lane & 31, hi = lane >> 5;
    LAS bf16_t* T0 = (LAS bf16_t*)lds; LAS bf16_t* T1 = (LAS bf16_t*)(lds + TILE_B); LAS bf16_t* T2 = (LAS bf16_t*)(lds + 2 * TILE_B); LAS bf16_t* T3 = (LAS bf16_t*)(lds + 3 * TILE_B);
    LAS float* gl = (LAS float*)(lds + 4 * TILE_B);
    LAS float* wend = gl + 512;
    int bl, J, h, r0; mlstm_a_ids(u, bl, J, h, r0);
    const int wr_ = tid >> 2, wc_ = (tid & 3) * 32;
    u32x4 wv_[4];
#pragma unroll
    for (int i = 0; i < 4; ++i) { *(LAS u32x4*)(T0 + wr_ * TLD + wc_ + 8 * i) = qa[i]; *(LAS u32x4*)(T1 + wr_ * TLD + wc_ + 8 * i) = qb[i];
        *(LAS u32x4*)(T2 + wr_ * TLD + wc_ + 8 * i) = qwq[i]; *(LAS u32x4*)(T3 + wr_ * TLD + wc_ + 8 * i) = qwk[i]; wv_[i] = qwv[i]; }
    if (tid < 128) *(LAS f32x4*)(gl + tid * 4) = qg;
    LBAR();
    if (wid < 2) {
        const int dir = wid, p0 = 2 * lane, p1 = p0 + 1, s0 = dir ? 127 - p0 : p0, s1 = dir ? 127 - p1 : p1;
        const float ig0 = gl[s0 * 4 + 2 * dir], ig1 = gl[s1 * 4 + 2 * dir];
        const float lf0 = logsigmoid_f(gl[s0 * 4 + 2 * dir + 1]), lf1 = logsigmoid_f(gl[s1 * 4 + 2 * dir + 1]);
        float incl = lf0 + lf1;
        for (int o = 1; o < 64; o <<= 1) { const float t = __shfl_up(incl, o); if (lane >= o) incl += t; }
        const float bc1 = incl, bc0 = incl - lf1, gg = __shfl(incl, 63);
        const float ae0 = gg - bc0 + ig0, ae1 = gg - bc1 + ig1; const float ml = wave_max(fmaxf(ae0, ae1));
        wend[dir * 128 + s0] = __expf(ae0 - ml); wend[dir * 128 + s1] = __expf(ae1 - ml);
        if (lane == 0) { float* mst = (float*)(p.ws + WS_P + P_MST) + ((size_t)(((bl * 4 + h) * 2 + dir) * NJ + J)) * 4; mst[0] = ml; mst[1] = gg; }
    }
    f32x16 ack[2] = {};
    {
        f32x16 acq[2] = {}, akp[2] = {};
        mm128(T2, T0, acq, wid, lane); mm128(T0, T3, ack, wid, lane); mm128(T3, T0, akp, wid, lane);
        LBAR();
        st_acc_T(T2, acq, wid, lane); st_acc_T(T3, akp, wid, lane);
#pragma unroll
        for (int i = 0; i < 4; ++i) *(LAS u32x4*)(T0 + wr_ * TLD + wc_ + 8 * i) = wv_[i];
    }
    LBAR();
    copy_tile_out(T2, pbuf(p, P_MQ) + (size_t)r0 * 512 + h * 128, 512);
    copy_tile_out(T3, pbuf(p, P_MK) + (size_t)r0 * 512 + h * 128, 512);
    {
        f32x16 acv[2] = {}; mm128(T1, T0, acv, wid, lane);
        LBAR();
        st_acc_T(T2, ack, wid, lane); st_acc_T(T3, acv, wid, lane);
    }
    mlstm_a_load(p, l, unext < n_a ? unext : u, APRE_ARGS);
    LBAR();
    {
        bf16_t* MVT = pbuf(p, P_MVT) + ((size_t)((bl * NJ + J) * 4 + h)) * 16384; const int d = tid >> 2, s0 = (tid & 3) * 32;
#pragma unroll
        for (int i = 0; i < 4; ++i) *(u32x4*)(MVT + d * 128 + s0 + 8 * i) = *(const LAS u32x4*)(T3 + d * TLD + s0 + 8 * i);
    }
#pragma unroll 1
    for (int dir = 0; dir < 2; ++dir) {
        f32x16 acc[2] = {};
        const LAS bf16_t* ap = T2 + (32 * (wid >> 1) + r32) * TLD + hi * 8; const LAS bf16_t* bp = T3 + (64 * (wid & 1) + r32) * TLD + hi * 8;
        const LAS float* wv = wend + dir * 128 + hi * 8;
#pragma unroll
        for (int ks = 0; ks < 8; ++ks) {
            float a8[8]; unpack8(*(const LAS u32x4*)(ap + ks * 16), a8);
            const f32x4 wa = *(const LAS f32x4*)(wv + ks * 16), wb = *(const LAS f32x4*)(wv + ks * 16 + 4);
#pragma unroll
            for (int j = 0; j < 4; ++j) { a8[j] *= wa[j]; a8[4 + j] *= wb[j]; }
            const u32x4 aw = pack8(a8); const bf16x8 a = *(const bf16x8*)&aw;
            const bf16x8 b0 = *(const LAS bf16x8*)(bp + ks * 16), b1 = *(const LAS bf16x8*)(bp + 32 * TLD + ks * 16);
            acc[0] = mfma32(a, b0, acc[0]); acc[1] = mfma32(a, b1, acc[1]);
        }
        if (dir == 0) st_acc_T(T0, acc, wid, lane); else st_acc_T(T1, acc, wid, lane);
    }
    if (tid < 256) { const int dir = tid >> 7, e = tid & 127; float s = 0.f;
#pragma unroll 4
        for (int j = 0; j < 128; j += 8) { float k8[8]; unpack8(*(const LAS u32x4*)(T2 + e * TLD + j), k8);
            const f32x4 wa = *(const LAS f32x4*)(wend + dir * 128 + j), wb = *(const LAS f32x4*)(wend + dir * 128 + j + 4);
#pragma unroll
            for (int i = 0; i < 4; ++i) s += wa[i] * k8[i] + wb[i] * k8[4 + i]; }
        ((float*)(p.ws + WS_P + P_NLOC))[((size_t)(((bl * 4 + h) * 2 + dir) * NJ + J)) * 128 + e] = s; }
    LBAR();
    { bf16_t* CL = (bf16_t*)(p.ws + WS_P + P_CLOC) + ((size_t)((bl * 4 + h) * 2) * NJ + J) * 16384;
      copy_tile_out(T0, CL, 128); copy_tile_out(T1, CL + (size_t)NJ * 16384, 128); }
    LBAR();
}

__device__ __forceinline__ int scan_J(int dir, int pidx) { return dir == 0 ? pidx : (pidx == 0 ? 1 : (pidx == 1 ? 0 : 19 - pidx)); }
__device__ __forceinline__ void phase_scan(const Params& p) {
    const int NIT = 64 * 2048;
    bf16_t* CL = (bf16_t*)(p.ws + WS_P + P_CLOC); float* NL = (float*)(p.ws + WS_P + P_NLOC); float* MST = (float*)(p.ws + WS_P + P_MST);
    const int tid = opaque_tid();
    for (int w = blockIdx.x * NTHR + tid; w < NIT; w += gridDim.x * NTHR) {
        const int combo = w >> 11, q = w & 2047, dir = combo & 1; const bool hasn = q < 32;
        float m_st = 0.f; float st[8]; f32x4 s4 = {0.f, 0.f, 0.f, 0.f};
#pragma unroll
        for (int j = 0; j < 8; ++j) st[j] = 0.f;
        bf16_t* base = CL + (size_t)combo * NJ * 16384 + 8 * q; float* nbase = NL + (size_t)combo * NJ * 128 + 4 * (q & 31);
#pragma unroll 1
        for (int i0 = 0; i0 < NJ; i0 += 9) {
            u32x4 vc[9]; f32x4 vn[9]; float mlv[9], ggv[9];
#pragma unroll
            for (int i = 0; i < 9; ++i) { const int J = scan_J(dir, i0 + i); const float* ms = MST + ((size_t)combo * NJ + J) * 4;
                vc[i] = *(const u32x4*)(base + (size_t)J * 16384); vn[i] = (f32x4){0.f, 0.f, 0.f, 0.f}; if (hasn) vn[i] = *(const f32x4*)(nbase + (size_t)J * 128);
                mlv[i] = ms[0]; ggv[i] = ms[1]; }
            __builtin_amdgcn_sched_barrier(0);
#pragma unroll
            for (int i = 0; i < 9; ++i) {
                const int J = scan_J(dir, i0 + i); float* ms = MST + ((size_t)combo * NJ + J) * 4;
                const float ml = mlv[i], gg = ggv[i];
                const float m_new = fmaxf(gg + m_st, ml), a_old = __expf(gg + m_st - m_new), a_new = __expf(ml - m_new);
                *(u32x4*)(base + (size_t)J * 16384) = pack8(st);
                if (hasn) *(f32x4*)(nbase + (size_t)J * 128) = s4;
                if (q == 0) ms[2] = m_st;
                float c8[8]; unpack8(vc[i], c8);
#pragma unroll
                for (int j = 0; j < 8; ++j) st[j] = st[j] * a_old + c8[j] * a_new;
                s4 = s4 * a_old + vn[i] * a_new; m_st = m_new;
            }
        }
    }
}

__device__ __forceinline__ unsigned zap_nf(unsigned w) { if ((w & 0x7f80u) >= 0x4980u) w &= 0xffff0000u; if ((w & 0x7f800000u) >= 0x49800000u) w &= 0x0000ffffu; return w; }
template <int dir>
__device__ __forceinline__ void mlstm_c_dir(const unsigned (&Xp)[4][8], f32x16 (&acc)[2], const LAS bf16_t* Tq, const LAS bf16_t* Tc, const LAS bf16_t* Tv,
                                            const LAS float* av, const LAS float* Mv, const LAS float* wi, LAS float* denw, const LAS float* n0l, int wid, int lane) {
    const int r32 = lane & 31, hi = lane >> 5, tb = wid >> 1, t = 32 * tb + r32;
    acc[0] = f32x16{}; acc[1] = f32x16{};
    mm128(Tq, Tc, acc, wid, lane);
#pragma unroll
    for (int r = 0; r < 16; ++r) { const float w = wi[dir * 128 + 32 * tb + crow(r, hi)]; acc[0][r] *= w; acc[1][r] *= w; }
    float nq = 0.f;
#pragma unroll
    for (int i = 0; i < 8; ++i) { float q8[8]; unpack8(*(const LAS u32x4*)(Tq + t * TLD + 64 * hi + 8 * i), q8);
        const f32x4 na = *(const LAS f32x4*)(n0l + dir * 128 + 64 * hi + 8 * i), nb = *(const LAS f32x4*)(n0l + dir * 128 + 64 * hi + 8 * i + 4);
#pragma unroll
        for (int j = 0; j < 4; ++j) nq += na[j] * q8[j] + nb[j] * q8[4 + j]; }
    const float Mt = Mv[dir * 128 + t]; float den = 0.f;
    const LAS bf16_t* vp = Tv + (64 * (wid & 1) + r32) * TLD + 4 * hi;
#pragma unroll
    for (int sb = 0; sb < 4; ++sb) {
        float o[16];
#pragma unroll
        for (int r = 0; r < 16; ++r) { const int s = 32 * sb + crow(r, hi); const bool ok = dir ? (s >= t) : (s <= t);
            const float xs = (r & 1) ? bf_hi(Xp[sb][r >> 1]) : bf_lo(Xp[sb][r >> 1]);
            const float ev = xs * __builtin_amdgcn_exp2f((av[dir * 128 + s] - Mt) * LOG2E);
            o[r] = ok ? ev : 0.f; den += o[r]; }
#pragma unroll
        for (int s2 = 0; s2 < 2; ++s2) {
            u32x4 aw; aw.x = cvtpk(o[8 * s2 + 0], o[8 * s2 + 1]); aw.y = cvtpk(o[8 * s2 + 2], o[8 * s2 + 3]); aw.z = cvtpk(o[8 * s2 + 4], o[8 * s2 + 5]); aw.w = cvtpk(o[8 * s2 + 6], o[8 * s2 + 7]);
            const bf16x8 af = *(const bf16x8*)&aw;
#pragma unroll
            for (int tl = 0; tl < 2; ++tl) { const LAS bf16_t* bp = vp + 32 * tl * TLD + 32 * sb + 16 * s2;
                const u32x2 b0 = *(const LAS u32x2*)bp, b1 = *(const LAS u32x2*)(bp + 8); u32x4 bw; bw.x = b0.x; bw.y = b0.y; bw.z = b1.x; bw.w = b1.y;
                acc[tl] = mfma32(af, *(const bf16x8*)&bw, acc[tl]); }
        }
    }
    { auto rr = __builtin_amdgcn_permlane32_swap(__float_as_uint(den), __float_as_uint(den), false, false); den = __uint_as_float(rr[0]) + __uint_as_float(rr[1]); }
    { auto rr = __builtin_amdgcn_permlane32_swap(__float_as_uint(nq), __float_as_uint(nq), false, false); nq = __uint_as_float(rr[0]) + __uint_as_float(rr[1]); }
    if (hi == 0) denw[(wid * 2 + dir) * 32 + r32] = den + wi[dir * 128 + t] * nq;
}
__device__ __forceinline__ void mlstm_c_ids(int u, int& bl, int& J, int& h) {
    const int m_l = HBAT * 16 * 4;
    if (u < m_l) { const int rem = u & 63; bl = u >> 6; J = 2 + (rem >> 2); h = rem & 3; }
    else { const int v = u - m_l, rem = v & 7; bl = v >> 3; J = rem >> 2; h = rem & 3; }
}
#define CPRE_PARAMS u32x4 (&cq)[4], u32x4 (&ck)[4], u32x4 (&cv)[4], u32x4 (&ccf)[4], u32x4 (&ccb)[4], f32x4& cg, float& cn, float& cm0
#define CPRE_ARGS cq, ck, cv, ccf, ccb, cg, cn, cm0
__device__ __forceinline__ void mlstm_c_load(const Params& p, int u, CPRE_PARAMS) {
    const int tid = opaque_tid(); int bl, J, h; mlstm_c_ids(u, bl, J, h);
    const int r0 = (J < 2 ? bl * 256 : CTXROWS + bl * 2048) + (J < 2 ? J * 128 : (J - 2) * 128);
    const int t = tid >> 2, c0 = (tid & 3) * 32;
    const bf16_t* q = pbuf(p, P_MQ) + (size_t)(r0 + t) * 512 + h * 128 + c0; const bf16_t* k = pbuf(p, P_MK) + (size_t)(r0 + t) * 512 + h * 128 + c0;
    const bf16_t* v = pbuf(p, P_MVT) + ((size_t)((bl * NJ + J) * 4 + h)) * 16384 + t * 128 + c0;
    const bf16_t* c0f = (const bf16_t*)(p.ws + WS_P + P_CLOC) + ((size_t)((bl * 4 + h) * 2) * NJ + J) * 16384 + t * 128 + c0;
#pragma unroll
    for (int i = 0; i < 4; ++i) { cq[i] = *(const u32x4*)(q + 8 * i); ck[i] = *(const u32x4*)(k + 8 * i); cv[i] = *(const u32x4*)(v + 8 * i);
        ccf[i] = *(const u32x4*)(c0f + 8 * i); ccb[i] = *(const u32x4*)(c0f + (size_t)NJ * 16384 + 8 * i); }
    cg = *(const f32x4*)((const float*)(p.ws + WS_P + P_GATES) + (size_t)(r0 + (tid & 127)) * 16 + h * 4);
    cn = ((const float*)(p.ws + WS_P + P_NLOC))[((size_t)(((bl * 4 + h) * 2 + ((tid >> 7) & 1)) * NJ + J)) * 128 + (tid & 127)];
    { int z = 0; asm volatile("" : "+v"(z));
      cm0 = ((const float*)(p.ws + WS_P + P_MST))[((size_t)(((bl * 4 + h) * 2 + ((tid >> 6) & 1)) * NJ + J)) * 4 + 2 + z]; }
}
__device__ __forceinline__ void mlstm_c_unit(const Params& p, int l, int u, int unext, int n_c, CPRE_PARAMS, LAS unsigned char* lds) {
    int tid_ = threadIdx.x; asm volatile("" : "+v"(tid_));
    const int tid = tid_, wid = __builtin_amdgcn_readfirstlane(tid >> 6), lane = tid & 63, r32 = lane & 31, hi = lane >> 5;
    LAS bf16_t* Tq = (LAS bf16_t*)lds; LAS bf16_t* Tk = (LAS bf16_t*)(lds + TILE_B); LAS bf16_t* Tv = (LAS bf16_t*)(lds + 2 * TILE_B); LAS bf16_t* Ts = (LAS bf16_t*)(lds + 3 * TILE_B);
    LAS float* sc = (LAS float*)(lds + 4 * TILE_B);
    LAS float* gl = sc;
    LAS float* av = sc + 512;
    LAS float* Mv = sc + 768;
    LAS float* wi = sc + 1024;
    LAS float* fl = sc + 1280;
    LAS float* ssq = sc + 1536;
    LAS float* denp = sc + 1664;
    LAS float* n0l = sc + 2944;
    int bl, J, h; mlstm_c_ids(u, bl, J, h);
    const int rseq = J < 2 ? bl * 256 : CTXROWS + bl * 2048, r0 = rseq + (J < 2 ? J * 128 : (J - 2) * 128);
    u32x4 cf_[4], cbp_[4];
    {
        const int t = tid >> 2, c0 = (tid & 3) * 32;
#pragma unroll
        for (int i = 0; i < 4; ++i) { *(LAS u32x4*)(Tq + t * TLD + c0 + 8 * i) = cq[i]; *(LAS u32x4*)(Tk + t * TLD + c0 + 8 * i) = ck[i]; *(LAS u32x4*)(Tv + t * TLD + c0 + 8 * i) = cv[i]; cf_[i] = ccf[i]; cbp_[i] = ccb[i]; }
        if (tid < 128) { *(LAS f32x4*)(gl + tid * 4) = cg; ssq[tid] = 0.f; }
        if (tid < 256) n0l[tid] = cn;
    }
    LBAR();
    { const int d_ = tid >> 2, e_ = (tid & 3) * 32;
#pragma unroll
      for (int i = 0; i < 4; ++i) *(LAS u32x4*)(Ts + d_ * TLD + e_ + 8 * i) = cf_[i]; }
    const float* MST = (const float*)(p.ws + WS_P + P_MST);
    if (wid < 2) {
        const int dir = wid, p0 = 2 * lane, p1 = p0 + 1, s0 = dir ? 127 - p0 : p0, s1 = dir ? 127 - p1 : p1;
        const float m0 = cm0;
        const float ig0 = gl[s0 * 4 + 2 * dir], ig1 = gl[s1 * 4 + 2 * dir];
        const float lf0 = logsigmoid_f(gl[s0 * 4 + 2 * dir + 1]), lf1 = logsigmoid_f(gl[s1 * 4 + 2 * dir + 1]);
        float incl = lf0 + lf1;
        for (int o = 1; o < 64; o <<= 1) { const float t = __shfl_up(incl, o); if (lane >= o) incl += t; }
        const float bc1 = incl, bc0 = incl - lf1;
        const float a0 = ig0 - bc0, a1 = ig1 - bc1;
        float mx = fmaxf(a0, a1);
        for (int o = 1; o < 64; o <<= 1) { const float t = __shfl_up(mx, o); if (lane >= o) mx = fmaxf(mx, t); }
        float mxprev = __shfl_up(mx, 1); if (lane == 0) mxprev = -3.0e38f;
        const float M0 = fmaxf(m0, fmaxf(mxprev, a0)), M1 = fmaxf(m0, mx);
        av[dir * 128 + s0] = a0; av[dir * 128 + s1] = a1; Mv[dir * 128 + s0] = M0; Mv[dir * 128 + s1] = M1;
        wi[dir * 128 + s0] = __expf(m0 - M0); wi[dir * 128 + s1] = __expf(m0 - M1);
        fl[dir * 128 + s0] = __expf(-bc0 - M0); fl[dir * 128 + s1] = __expf(-bc1 - M1);
    }
    __builtin_amdgcn_sched_barrier(0);
    unsigned Xp[4][8];
    {
    f32x16 X[4] = {};
    { const LAS bf16_t* bq = Tq + (32 * (wid >> 1) + r32) * TLD + hi * 8; const LAS bf16_t* ak = Tk + r32 * TLD + hi * 8;
#pragma unroll 2
      for (int ks = 0; ks < 8; ++ks) { const bf16x8 b = *(const LAS bf16x8*)(bq + ks * 16);
#pragma unroll
          for (int sb = 0; sb < 4; ++sb) X[sb] = mfma32(*(const LAS bf16x8*)(ak + 32 * sb * TLD + ks * 16), b, X[sb]); } }
#pragma unroll
    for (int sb = 0; sb < 4; ++sb)
#pragma unroll
        for (int i = 0; i < 8; ++i) Xp[sb][i] = cvtpk(X[sb][2 * i], X[sb][2 * i + 1]);
    }
    LBAR();
    { const int d_ = tid >> 2, e_ = (tid & 3) * 32;
#pragma unroll
      for (int i = 0; i < 4; ++i) *(LAS u32x4*)(Tk + d_ * TLD + e_ + 8 * i) = cbp_[i]; }
    LBAR();
    f32x16 ao0[2], ao1[2];
    LAS float* denw = denp;
    mlstm_c_dir<0>(Xp, ao0, Tq, Ts, Tv, av, Mv, wi, denw, n0l, wid, lane);
    mlstm_c_dir<1>(Xp, ao1, Tq, Tk, Tv, av, Mv, wi, denw, n0l, wid, lane);
    __builtin_amdgcn_sched_barrier(0);
    float hv[2][16];
#pragma unroll
    for (int r = 0; r < 16; ++r) { const int t = 32 * (wid >> 1) + crow(r, hi);
        const float df = denw[(wid * 2 + 0) * 32 + crow(r, hi)], db = denw[(wid * 2 + 1) * 32 + crow(r, hi)];
        const float rf = 1.0f / fmaxf(fabsf(df), fl[t]), rb = 1.0f / fmaxf(fabsf(db), fl[128 + t]);
        hv[0][r] = ao0[0][r] * rf + ao1[0][r] * rb; hv[1][r] = ao0[1][r] * rf + ao1[1][r] * rb;
        float q = hv[0][r] * hv[0][r] + hv[1][r] * hv[1][r];
        q = half_sum31(q);
        if (r32 == 31) lds_addf(&ssq[t], q); }
    __builtin_amdgcn_sched_barrier(0);
    int te_ = tid; asm volatile("" : "+v"(te_));
    const float* gm = p.in[I_GMN] + l * 512 + h * 128 + 64 * (wid & 1) + (te_ & 31); const float gd0 = gm[0], gd1 = gm[32];
    const bf16_t* xcv = pbuf(p, P_XCV) + (size_t)(r0 + (te_ >> 2)) * 512 + h * 128 + (te_ & 3) * 32; bf16_t* zb = pbuf(p, P_ZB) + (size_t)(r0 + (te_ >> 2)) * 512 + h * 128 + (te_ & 3) * 32;
    const float* sk = p.in[I_SKIP] + l * 512 + h * 128;
    u32x4 xw[4], zw[4]; f32x4 s0[4], s1[4];
#pragma unroll
    for (int i = 0; i < 4; ++i) { xw[i] = *(const u32x4*)(xcv + 8 * i); zw[i] = *(const u32x4*)(zb + 8 * i); s0[i] = *(const f32x4*)(sk + (te_ & 3) * 32 + 8 * i); s1[i] = *(const f32x4*)(sk + (te_ & 3) * 32 + 8 * i + 4); }
    mlstm_c_load(p, unext < n_c ? unext : u, CPRE_ARGS);
    __builtin_amdgcn_sched_barrier(0);
    LBAR();
    f32x16 hn[2];
#pragma unroll
    for (int tl = 0; tl < 2; ++tl) { const float gd = tl ? gd1 : gd0;
#pragma unroll
        for (int r = 0; r < 16; ++r) hn[tl][r] = hv[tl][r] * rsqrtf(ssq[32 * (wid >> 1) + crow(r, hi)] * (1.0f / 128.0f) + EPS) * gd; }
    LAS float* F = (LAS float*)lds;
    st_acc_f32(F, hn, wid, lane);
    LBAR();
    { const int t = te_ >> 2, c0 = (te_ & 3) * 32;
#pragma unroll
      for (int i = 0; i < 4; ++i) { float x8[8], z8[8]; unpack8(xw[i], x8); unpack8(zw[i], z8);
          const f32x4 h0 = *(const LAS f32x4*)(F + t * FLD + c0 + 8 * i), h1 = *(const LAS f32x4*)(F + t * FLD + c0 + 8 * i + 4);
#pragma unroll
          for (int j = 0; j < 4; ++j) { z8[j] = (h0[j] + s0[i][j] * x8[j]) * z8[j]; z8[4 + j] = (h1[j] + s1[i][j] * x8[4 + j]) * z8[4 + j]; }
          zw[i] = pack8(z8); }
#pragma unroll
      for (int i = 0; i < 4; ++i) *(u32x4*)(zb + 8 * i) = zw[i]; }
    LBAR();
}
namespace att {
typedef float f32x2v __attribute__((ext_vector_type(2)));
constexpr int SHM_V = 64 * 128 * 2, SHM_K = 64 * 64 * 2, OFF_K = 2 * SHM_V, OFF_WS = OFF_K + 2 * SHM_K, OFF_ST = OFF_WS + 8 * 64 * 4, LDS_NEED = OFF_ST + 32 * 512 * 4;
static_assert(LDS_NEED <= LDS_BYTES - 64, "attention LDS");
constexpr float THR2 = 11.5f;
#define KSWZ64(row, colB) ((row) * 128 + ((colB) ^ (((row) & 7) << 4)))
#define ASBAR() __builtin_amdgcn_sched_barrier(0)
__device__ __forceinline__ void partialSM(f32x16& p0, f32x16& p1, float& m_reg, float& mn, float& alpha) {
    float pmax = p0[0];
#pragma unroll
    for (int r = 1; r < 16; ++r) pmax = fmaxf(pmax, p0[r]);
#pragma unroll
    for (int r = 0; r < 16; ++r) pmax = fmaxf(pmax, p1[r]);
    { auto rr = __builtin_amdgcn_permlane32_swap(__float_as_uint(pmax), __float_as_uint(pmax), false, false); pmax = fmaxf(__uint_as_float(rr[0]), __uint_as_float(rr[1])); }
    if (__builtin_expect(__all(pmax - m_reg <= THR2), 1)) { mn = m_reg; alpha = 1.f; }
    else { mn = fmaxf(m_reg, pmax); alpha = __builtin_amdgcn_exp2f(m_reg - mn); m_reg = mn; }
    { const f32x2v mn2 = {mn, mn};
#pragma unroll
      for (int r = 0; r < 16; r += 2) { f32x2v t0 = {p0[r], p0[r + 1]}, t1 = {p1[r], p1[r + 1]}; t0 -= mn2; t1 -= mn2; p0[r] = t0[0]; p0[r + 1] = t0[1]; p1[r] = t1[0]; p1[r + 1] = t1[1]; } }
#pragma unroll
    for (int r = 0; r < 16; ++r) p0[r] = __builtin_amdgcn_exp2f(p0[r]);
}
__device__ __forceinline__ void finishSM(f32x16& p0, f32x16& p1, float alpha, float& l_reg, bf16x8& pa0, bf16x8& pa1, bf16x8& pa2, bf16x8& pa3) {
#pragma unroll
    for (int r = 0; r < 16; ++r) p1[r] = __builtin_amdgcn_exp2f(p1[r]);
    float ps;
    { f32x2v s2 = {p0[0], p0[1]};
#pragma unroll
      for (int r = 2; r < 16; r += 2) s2 += (f32x2v){p0[r], p0[r + 1]};
#pragma unroll
      for (int r = 0; r < 16; r += 2) s2 += (f32x2v){p1[r], p1[r + 1]};
      ps = s2[0] + s2[1]; }
    { auto rr = __builtin_amdgcn_permlane32_swap(__float_as_uint(ps), __float_as_uint(ps), false, false); ps = __uint_as_float(rr[0]) + __uint_as_float(rr[1]); }
    l_reg = l_reg * alpha + ps;
#define PK4(P, BASE, OUT) do { unsigned a0 = cvtpk(P[BASE + 0], P[BASE + 1]), a1 = cvtpk(P[BASE + 2], P[BASE + 3]);   \
    unsigned b0 = cvtpk(P[BASE + 4], P[BASE + 5]), b1 = cvtpk(P[BASE + 6], P[BASE + 7]);                              \
    auto r0 = __builtin_amdgcn_permlane32_swap(a0, b0, false, false); auto r1 = __builtin_amdgcn_permlane32_swap(a1, b1, false, false); \
    u32x4 w = {r0[0], r1[0], r0[1], r1[1]}; OUT = *reinterpret_cast<bf16x8*>(&w); } while (0)
    PK4(p0, 0, pa0); PK4(p0, 8, pa1); PK4(p1, 0, pa2); PK4(p1, 8, pa3);
#undef PK4
}
__device__ __forceinline__ void qkt(f32x16& p0, f32x16& p1, const LAS char* Ks, const bf16x8 (&qr)[4], int r32, int hi) {
    p0 = f32x16{}; p1 = f32x16{};
#pragma unroll
    for (int d0 = 0; d0 < 4; ++d0) { const int cb = (d0 * 16 + hi * 8) * 2;
        const bf16x8 b0 = *reinterpret_cast<const LAS bf16x8*>(Ks + KSWZ64(r32, cb));
        const bf16x8 b1 = *reinterpret_cast<const LAS bf16x8*>(Ks + KSWZ64(32 + r32, cb));
        p0 = mfma32(b0, qr[d0], p0); p1 = mfma32(b1, qr[d0], p1); }
}
__device__ __forceinline__ int v_st(int k, int c) { const int kk = (k & ~0xC) | ((k & 4) << 1) | ((k & 8) >> 1); return ((kk >> 3) * 4 + (c >> 5)) * 512 + ((kk & 7) * 32 + (c & 31)) * 2; }
__device__ __forceinline__ int v_rd_base(int lane) { return ((lane & 3) << 3) | (((lane >> 2) & 3) << 6) | (((lane >> 4) & 1) << 5) | (((lane >> 5) & 1) << 8); }
constexpr int v_rd_off(int d0, int ks, int half) { return d0 * 512 + ks * 4096 + half * 2048; }
template <int OFF> __device__ __forceinline__ s16x4 tr_read(int vb) { s16x4 r; asm volatile("ds_read_b64_tr_b16 %0, %1 offset:%2" : "=&v"(r) : "v"(vb), "i"(OFF) : "memory"); return r; }
template <int D0> __device__ __forceinline__ void pv_one(f32x16& od, int vb, bf16x8 pa0, bf16x8 pa1, bf16x8 pa2, bf16x8 pa3) {
    const s16x4 l0 = tr_read<v_rd_off(D0, 0, 0)>(vb), h0 = tr_read<v_rd_off(D0, 0, 1)>(vb), l1 = tr_read<v_rd_off(D0, 1, 0)>(vb), h1 = tr_read<v_rd_off(D0, 1, 1)>(vb);
    const s16x4 l2 = tr_read<v_rd_off(D0, 2, 0)>(vb), h2 = tr_read<v_rd_off(D0, 2, 1)>(vb), l3 = tr_read<v_rd_off(D0, 3, 0)>(vb), h3 = tr_read<v_rd_off(D0, 3, 1)>(vb);
    asm volatile("s_waitcnt lgkmcnt(0)" ::: "memory"); ASBAR();
#define PKV(L, H) (bf16x8){L[0], L[1], L[2], L[3], H[0], H[1], H[2], H[3]}
    od = mfma32(pa0, PKV(l0, h0), od); od = mfma32(pa1, PKV(l1, h1), od); od = mfma32(pa2, PKV(l2, h2), od); od = mfma32(pa3, PKV(l3, h3), od);
#undef PKV
}
__device__ __forceinline__ void pv_d0(f32x16 (&o)[4], int vb, bf16x8 pa0, bf16x8 pa1, bf16x8 pa2, bf16x8 pa3) {
    pv_one<0>(o[0], vb, pa0, pa1, pa2, pa3); pv_one<1>(o[1], vb, pa0, pa1, pa2, pa3); pv_one<2>(o[2], vb, pa0, pa1, pa2, pa3); pv_one<3>(o[3], vb, pa0, pa1, pa2, pa3);
}
__device__ __forceinline__ int krow(int j, int rc, int rl) { return j < 4 ? rc + 64 * j : rl + 64 * (j - 4); }

__device__ __forceinline__ void attn_unit(const Params& p, int l, int h, int qrow0, int rc, int rl, int NT, LAS unsigned char* lds8) {
    int tid_ = threadIdx.x; asm volatile("" : "+v"(tid_));
    const int tid = tid_, wid = __builtin_amdgcn_readfirstlane(tid >> 6), lane = tid & 63, r32 = lane & 31, hi = lane >> 5;
    LAS char* V_lds = (LAS char*)lds8; LAS char* K_lds = (LAS char*)lds8 + OFF_K;
    LAS float* wsx = (LAS float*)(lds8 + OFF_WS) + wid * 64; LAS float* li_l = wsx; LAS float* al_l = wsx + 32;
    LAS unsigned* stash = (LAS unsigned*)(lds8 + OFF_ST);
    bf16_t* QB = pbuf(p, P_QB); const bf16_t* KB = pbuf(p, P_KB); const bf16_t* VB = pbuf(p, P_VB);
    const int sr = tid >> 4, sc = (tid & 15) * 8, vst0 = v_st(sr, sc);
    const int kr = tid >> 3, kc = (tid & 7) * 8, kst = KSWZ64(kr, kc * 2);
    const int vb0 = (int)(uintptr_t)V_lds + v_rd_base(lane);
    f32x16 o[4];
#pragma unroll 1
    for (int m = 0; m < 2; ++m) {
        const unsigned voV0 = (unsigned)((sr * 512 + h * 128 + sc) * 2), voK = (unsigned)((kr * 512 + h * 128 + m * 64 + kc) * 2);
        float m_reg = -1e30f, l_reg = 0.f;
#pragma unroll
        for (int d = 0; d < 4; ++d) o[d] = f32x16{};
        bf16x8 qr[4];
        { const bf16_t* Qw = QB + (size_t)(qrow0 + wid * 32 + r32) * 512 + h * 128 + m * 64 + hi * 8;
#pragma unroll
          for (int d0 = 0; d0 < 4; ++d0) qr[d0] = *(const bf16x8*)(Qw + d0 * 16); }
        struct { bf16x8 vs0, vs1, ks0; } sr_[2];
#define SLOAD(i, j) do { const int _r = __builtin_amdgcn_readfirstlane(krow((j), rc, rl)); const char* _vb = (const char*)(VB + (size_t)_r * 512); const char* _kb = (const char*)(KB + (size_t)_r * 512); \
    sr_[i].vs0 = *(const bf16x8*)(_vb + voV0); sr_[i].vs1 = *(const bf16x8*)(_vb + 32 * 512 * 2 + voV0); sr_[i].ks0 = *(const bf16x8*)(_kb + voK); } while (0)
#define SWRITE(b, i) do { *(LAS bf16x8*)(V_lds + (b) * SHM_V + vst0) = sr_[i].vs0; *(LAS bf16x8*)(V_lds + (b) * SHM_V + 8192 + vst0) = sr_[i].vs1; \
    *(LAS bf16x8*)(K_lds + (b) * SHM_K + kst) = sr_[i].ks0; } while (0)
#define SWAIT() asm volatile("s_waitcnt vmcnt(3)" ::: "memory")
#define RESC(a) do { if (__any((a) < 1.f)) { if (hi == 0) al_l[r32] = (a); asm volatile("s_waitcnt lgkmcnt(0)" ::: "memory"); \
    _Pragma("unroll") for (int d = 0; d < 4; ++d) _Pragma("unroll") for (int r = 0; r < 16; ++r) o[d][r] *= al_l[crow(r, hi)]; } } while (0)
        f32x16 pA0, pA1, pB0, pB1; float mnA, mnB, alA, alB; bf16x8 pa0, pa1, pa2, pa3;
        SLOAD(0, 0); asm volatile("s_waitcnt vmcnt(0)" ::: "memory"); SWRITE(0, 0); __syncthreads();
        qkt(pA0, pA1, K_lds, qr, r32, hi); partialSM(pA0, pA1, m_reg, mnA, alA);
        SLOAD(1, 1); if (2 < NT) SLOAD(0, 2);
        SWAIT(); SWRITE(1, 1); __syncthreads();
        for (int j = 1; j + 1 < NT; j += 2) {
            ASBAR(); qkt(pB0, pB1, K_lds + SHM_K, qr, r32, hi);
            finishSM(pA0, pA1, alA, l_reg, pa0, pa1, pa2, pa3); ASBAR();
            SLOAD(1, j + 2); ASBAR();
            pv_d0(o, vb0, pa0, pa1, pa2, pa3); partialSM(pB0, pB1, m_reg, mnB, alB);
            __syncthreads(); SWAIT(); SWRITE(0, 0);
            RESC(alB); __syncthreads();
            ASBAR(); qkt(pA0, pA1, K_lds, qr, r32, hi);
            finishSM(pB0, pB1, alB, l_reg, pa0, pa1, pa2, pa3); ASBAR();
            if (j + 3 < NT) SLOAD(0, j + 3); ASBAR();
            pv_d0(o, vb0 + SHM_V, pa0, pa1, pa2, pa3); partialSM(pA0, pA1, m_reg, mnA, alA);
            __syncthreads(); SWAIT(); SWRITE(1, 1);
            RESC(alA); __syncthreads();
        }
        ASBAR(); qkt(pB0, pB1, K_lds + SHM_K, qr, r32, hi);
        finishSM(pA0, pA1, alA, l_reg, pa0, pa1, pa2, pa3); ASBAR();
        pv_d0(o, vb0, pa0, pa1, pa2, pa3); partialSM(pB0, pB1, m_reg, mnB, alB);
        __syncthreads(); RESC(alB);
        finishSM(pB0, pB1, alB, l_reg, pa0, pa1, pa2, pa3); ASBAR();
        pv_d0(o, vb0 + SHM_V, pa0, pa1, pa2, pa3);
#undef SLOAD
#undef SWRITE
#undef SWAIT
#undef RESC
        int lane_e = lane; asm volatile("" : "+v"(lane_e)); const int r32e = lane_e & 31, hie = lane_e >> 5;
        if (hie == 0) li_l[r32e] = l_reg; asm volatile("s_waitcnt lgkmcnt(0)" ::: "memory");
        float rli[16];
#pragma unroll
        for (int r = 0; r < 16; ++r) rli[r] = __builtin_amdgcn_rcpf(li_l[crow(r, hie)]);
        if (m == 0) {
#pragma unroll
            for (int d0 = 0; d0 < 4; ++d0)
#pragma unroll
                for (int r = 0; r < 16; r += 2) stash[(wid * 32 + d0 * 8 + (r >> 1)) * 64 + lane_e] = cvtpk(o[d0][r] * rli[r], o[d0][r + 1] * rli[r + 1]);
        } else {
            const float lam = ld_f32_dev((const float*)(p.ws + WS_LAM) + l * 4), oml = ld_f32_dev((const float*)(p.ws + WS_LAM) + l * 4 + 1);
            float ss[16];
#pragma unroll
            for (int r = 0; r < 16; ++r) ss[r] = 0.f;
#pragma unroll
            for (int d0 = 0; d0 < 4; ++d0)
#pragma unroll
                for (int r = 0; r < 16; r += 2) { const unsigned w = stash[(wid * 32 + d0 * 8 + (r >> 1)) * 64 + lane_e];
                    o[d0][r] = bf_lo(w) - lam * o[d0][r] * rli[r]; o[d0][r + 1] = bf_hi(w) - lam * o[d0][r + 1] * rli[r + 1];
                    ss[r] += o[d0][r] * o[d0][r]; ss[r + 1] += o[d0][r + 1] * o[d0][r + 1]; }
#pragma unroll
            for (int r = 0; r < 16; ++r) { float q = ss[r]; q += __shfl_xor(q, 1); q += __shfl_xor(q, 2); q += __shfl_xor(q, 4); q += __shfl_xor(q, 8); q += __shfl_xor(q, 16);
                ss[r] = rsqrtf(q * (1.0f / 128.0f) + EPS) * oml; }
            const float* gs = p.in[I_GSUBLN] + l * 128;
            asm volatile("s_waitcnt lgkmcnt(0)" ::: "memory");
            LAS bf16_t* ot = (LAS bf16_t*)(stash + wid * 32 * 64);
#pragma unroll
            for (int d0 = 0; d0 < 4; ++d0) { const float g = gs[d0 * 32 + r32e];
#pragma unroll
                for (int r = 0; r < 16; ++r) ot[((r & 3) + 8 * (r >> 2) + 4 * hie) * 128 + d0 * 32 + r32e] = (bf16_t)(cvtpk(o[d0][r] * ss[r] * g, 0.f) & 0xffffu); }
            asm volatile("s_waitcnt lgkmcnt(0)" ::: "memory");
            { bf16_t* dst = QB + (size_t)(qrow0 + wid * 32) * 512 + h * 128;
#pragma unroll
              for (int i = 0; i < 8; ++i) { const int row = i * 4 + (lane_e >> 4), pc = (lane_e & 15) * 8;
                  *(u32x4*)(dst + (size_t)row * 512 + pc) = *(const LAS u32x4*)(ot + row * 128 + pc); } }
        }
        __syncthreads();
    }
}
}
__device__ __forceinline__ void gmlp_unit(const Params& p, int l, int r0, LAS unsigned char* lds) {
    int tid_ = threadIdx.x; asm volatile("" : "+v"(tid_));
    const int tid = tid_, wid = __builtin_amdgcn_readfirstlane(tid >> 6), lane = tid & 63, r32 = lane & 31, hi = lane >> 5;
    const bf16_t* VG = pbuf(p, P_VGB); bf16_t* UB = pbuf(p, P_UB);
    PSEC_BEGIN8();
    {
        const int sr = tid >> 4, sc = (tid & 15) * 8, vst0 = att::v_st(sr, sc);
        u32x4 x[4][4]; float rs[4];
#pragma unroll
        for (int k = 0; k < 4; ++k)
#pragma unroll
            for (int g = 0; g < 4; ++g) x[k][g] = *(const u32x4*)(VG + (size_t)(r0 + sr + 32 * k) * 512 + g * 128 + sc);
#pragma unroll
        for (int k = 0; k < 4; ++k) { float ss = 0.f;
#pragma unroll
            for (int g = 0; g < 4; ++g) { float v[8]; unpack8(x[k][g], v);
#pragma unroll
                for (int j = 0; j < 8; ++j) ss += v[j] * v[j]; }
            ss += __shfl_xor(ss, 1); ss += __shfl_xor(ss, 2); ss += __shfl_xor(ss, 4); ss += __shfl_xor(ss, 8);
            rs[k] = rsqrtf(ss * (1.0f / 512.0f) + EPS); }
#pragma unroll
        for (int k = 0; k < 4; ++k)
#pragma unroll
            for (int g = 0; g < 4; ++g) { float v[8]; unpack8(x[k][g], v);
#pragma unroll
                for (int j = 0; j < 8; ++j) v[j] *= rs[k];
                *(LAS u32x4*)(lds + (g * 2 + (k >> 1)) * att::SHM_V + (k & 1) * 8192 + vst0) = pack8(v); }
    }
    __syncthreads();
    const int rb = wid >> 1, dh = wid & 1;
    const int vb0 = (int)(uintptr_t)lds + att::v_rd_base(lane) + dh * 1024;
    LAS float* F = (LAS float*)(lds + 8 * att::SHM_V) + wid * 576;
    const bf16_t* Wsb = (const bf16_t*)(p.ws + WS_WSB) + (size_t)l * 4 * 16384 + (size_t)(32 * rb + r32) * 128 + 8 * hi;
#pragma unroll 1
    for (int g = 0; g < 4; ++g) {
        bf16x8 pa[2][4];
#pragma unroll
        for (int kt = 0; kt < 2; ++kt)
#pragma unroll
            for (int k4 = 0; k4 < 4; ++k4) pa[kt][k4] = *(const bf16x8*)(Wsb + (size_t)g * 16384 + 64 * kt + 16 * k4);
        bf16_t* up = UB + (size_t)(r0 + 32 * rb + (lane >> 2)) * 512 + g * 128 + 64 * dh + 8 * (lane & 3);
        u32x4 uu[2][2];
#pragma unroll
        for (int d0 = 0; d0 < 2; ++d0)
#pragma unroll
            for (int rd = 0; rd < 2; ++rd) uu[d0][rd] = *(const u32x4*)(up + (size_t)(16 * rd) * 512 + 32 * d0);
        const float* gv = p.in[I_GGV] + l * 512 + g * 128 + 64 * dh + r32; const float* bs = p.in[I_BGS] + (l * 4 + g) * 128 + 32 * rb;
        const float gv0 = gv[0], gv1 = gv[32];
        float bsv[16];
#pragma unroll
        for (int r = 0; r < 16; ++r) bsv[r] = bs[crow(r, hi)];
        __builtin_amdgcn_sched_barrier(0);
        f32x16 o[2] = {};
        att::pv_one<0>(o[0], vb0 + (g * 2) * att::SHM_V, pa[0][0], pa[0][1], pa[0][2], pa[0][3]); att::pv_one<1>(o[1], vb0 + (g * 2) * att::SHM_V, pa[0][0], pa[0][1], pa[0][2], pa[0][3]);
        att::pv_one<0>(o[0], vb0 + (g * 2 + 1) * att::SHM_V, pa[1][0], pa[1][1], pa[1][2], pa[1][3]); att::pv_one<1>(o[1], vb0 + (g * 2 + 1) * att::SHM_V, pa[1][0], pa[1][1], pa[1][2], pa[1][3]);
#pragma unroll
        for (int d0 = 0; d0 < 2; ++d0)
#pragma unroll
            for (int rd = 0; rd < 2; ++rd) {
#pragma unroll
                for (int r = 0; r < 8; ++r) { const int rr = 8 * rd + r; F[((r & 3) + 8 * ((r >> 2) & 1) + 4 * hi) * 36 + r32] = o[d0][rr] * (d0 ? gv1 : gv0) + bsv[rr]; }
                asm volatile("s_waitcnt lgkmcnt(0)" ::: "memory");
                const f32x4 m0 = *(const LAS f32x4*)(F + (lane >> 2) * 36 + 8 * (lane & 3)), m1 = *(const LAS f32x4*)(F + (lane >> 2) * 36 + 8 * (lane & 3) + 4);
                float u8[8]; unpack8(uu[d0][rd], u8);
#pragma unroll
                for (int j = 0; j < 4; ++j) { u8[j] *= m0[j]; u8[4 + j] *= m1[j]; }
                *(u32x4*)(up + (size_t)(16 * rd) * 512 + 32 * d0) = pack8(u8);
                asm volatile("s_waitcnt lgkmcnt(0)" ::: "memory");
            }
    }
    __syncthreads();
    PSEC(8);
}
constexpr int N_PHASES = 36;
typedef const __attribute__((address_space(4))) Params* KParams;
#define PHASE_P() const Params& p = *(const Params*)opaque_kp()
__device__ __forceinline__ KParams opaque_kp() { KParams q = (KParams)__builtin_amdgcn_kernarg_segment_ptr(); asm volatile("" : "+s"(q)); return q; }
__global__ void __launch_bounds__(NTHR, 2) mk_fwd(Params p_arg, int bar_region) {
    extern __shared__ __attribute__((aligned(16))) unsigned char lds_raw[];
    LAS unsigned char* lds = (LAS unsigned char*)lds_raw;
    const int tid = threadIdx.x, G = gridDim.x, bid = blockIdx.x;
    volatile LAS unsigned* xbw = (volatile LAS unsigned*)(lds + LDS_BYTES - 16);
    if (tid == 0) { xbw[0] = 0u; xbw[1] = 0u; xbw[2] = 0u; xbw[3] = 0u; }
    __syncthreads();
    (void)xcd_barrier_post((unsigned*)(p_arg.ws + WS_CTL) + CW_BAR + bar_region * 4096, xbw);
    const int lo = p_arg.ph_lo, hi = p_arg.ph_hi;
#define IN(k) (lo <= (k) && (k) < hi)
#ifdef PROBE
#define STAMP(k) do { if (tid == 0) { if (bid == 0) ((unsigned long long*)(opaque_kp()->ws + WS_CTL))[30000 + (k)] = __builtin_amdgcn_s_memrealtime(); *(volatile LAS int*)(lds + LDS_BYTES - 32) = (k); } __syncthreads(); } while (0)
#else
#define STAMP(k) do { } while (0)
#endif
#define GRID_BARRIER() do { KParams kq = opaque_kp(); XcdBarrier b_; b_.bar = (unsigned*)(kq->ws + WS_CTL) + CW_BAR + ((const __attribute__((address_space(4))) int*)(kq + 1))[0] * 4096; b_.x = xb_xcc_id(); b_.st = xbw; xcd_barrier(b_); } while (0)
#define SEAM(k) do { if (IN(k) && IN((k) + 1)) { GRID_BARRIER(); STAMP((k) + 1); } } while (0)

    STAMP(0);
#if !defined(ONLY) || ONLY == 0
    if (IN(0)) { PHASE_P(); phase_prologue(p, lds); }
#endif
    SEAM(0);
    for (int l = 0; l < 2; ++l) {
        const int base = 1 + 17 * l;
#if !defined(ONLY) || ONLY == 1
        if (IN(base)) { PHASE_P(); phase_norm1(p, l); }
#endif
        SEAM(base);
        for (int hf = 0; hf < 2; ++hf) {
            const int hb = base + 1 + 6 * hf;
#if !defined(ONLY) || ONLY == 2
            if (IN(hb)) {
                PHASE_P(); unsigned char* ws = p.ws; bf16_t* Hh = (bf16_t*)(ws + WS_H) + (size_t)hf * MH * 1024; (void)Hh;
                const float* cosT = (const float*)(ws + WS_ROPE); const float* sinT = cosT + 1024;
                pg8::Gemm g{Hh, (const bf16_t*)(ws + WS_WTIN) + (size_t)l * NCOL * 1024, MH, NCOL, 1024};
                int cin = bid; if (hf == 1) { cin += G >> 1; if (cin >= G) cin -= G; }
                RectOrder S; if (l == 0) S.init(72, 14, 0, 0, 0, 0, G, cin); else S.init(64, 14, 8, 8, 6, 0, G, cin);
                EpiIn E{pbuf(p, 0), pbuf(p, P_GB), cosT, sinT};
                PSEC_BEGINN(30);
                pg8::gemm_phase<EpiIn, RectOrder>((PG8_LAS unsigned char*)lds, g, S, E, nullptr);
                PSEC(30);
                pg8::Gemm g8{(const bf16_t*)(ws + WS_H8 + (size_t)hf * MH * 1024), (const bf16_t*)(ws + WS_WTIN8 + (size_t)l * 3072 * 1024), MH, 3072, 512};
                RectOrder S8; S8.init(l == 0 ? 72 : 64, 12, l == 0 ? 0 : 8, 0, 0, 0, G, G - 1 - cin);
                EpiGate8 E8{pbuf(p, P_GB)};
                pg8::gemm_phase<EpiGate8, RectOrder, false, true>((PG8_LAS unsigned char*)lds, g8, S8, E8, nullptr);
                PSEC(31);
            }
#endif
            SEAM(hb);
#if !defined(ONLY) || ONLY == 3
            if (IN(hb + 1)) {
                PSEC_BEGIN6();
                { PHASE_P(); phase_conv(p, l, lds); }
                PSEC(6);
                GRID_BARRIER(); PSEC(7);
                PHASE_P();
                const int n_a = HBAT * NJ * 4, n_g = HBAT * 16 + (l == 0 ? HBAT * 2 : 0);
                const int bidx = (G == 256) ? ((bid & 7) * 32 + (bid >> 3)) : bid;
                int u = bidx;
                PSEC(13);
                { u32x4 qa[4], qb[4], qwq[4], qwk[4], qwv[4]; f32x4 qg; mlstm_a_load(p, l, u < n_a ? u : 0, APRE_ARGS);
                  for (; u < n_a; u += G) mlstm_a_unit(p, l, u, u + G, n_a, APRE_ARGS, lds); }
                PSEC(14);
                for (; u < n_a + n_g; u += G) { const int v = u - n_a; int r0; if (v < HBAT * 16) r0 = CTXROWS + (v >> 4) * 2048 + (v & 15) * 128; else { const int w = v - HBAT * 16; r0 = (w >> 1) * 256 + (w & 1) * 128; }
                    gmlp_unit(p, l, r0, lds); }
            }
#endif
            SEAM(hb + 1);
#if !defined(ONLY) || ONLY == 4
            if (IN(hb + 2)) {
                PHASE_P();
                phase_scan(p);
            }
#endif
            SEAM(hb + 2);
#if !defined(ONLY) || ONLY == 5
            if (IN(hb + 3)) {
                PHASE_P();
                const int n_l = HBAT * 4 * 8, n_c = (l == 0 ? HBAT * 4 : 0);
                for (int u = bid; u < n_l + n_c; u += G) {
                    int h, qrow0, rc, rl, NT;
                    if (u < n_l) { const int ue = (G == 256) ? ((((u & 7) * 4 + (u >> 6)) << 3) | ((u >> 3) & 7)) : u;
                        const int bl = ue >> 5, qb = ue & 7; h = (ue >> 3) & 3; qrow0 = CTXROWS + bl * 2048 + qb * 256; rc = bl * 256; rl = CTXROWS + bl * 2048; NT = 36; }
                    else { const int v = u - n_l, bl = v >> 2; h = v & 3; qrow0 = bl * 256; rc = bl * 256; rl = 0; NT = 4; }
                    PSEC_BEGINN(9); att::attn_unit(p, l, h, qrow0, rc, rl, NT, lds); PSEC(9);
                }
                const int m_l = HBAT * 16 * 4, m_c = (l == 0 ? HBAT * 2 * 4 : 0);
                int u0 = bid + 192; if (u0 >= G) u0 -= G;
                { u32x4 cq[4], ck[4], cv[4], ccf[4], ccb[4]; f32x4 cg; float cn, cm0; const int n_c = m_l + m_c;
                  mlstm_c_load(p, u0 < n_c ? u0 : 0, CPRE_ARGS);
                  PSEC_BEGINN(10);
                  for (int u = u0; u < n_c; u += G) mlstm_c_unit(p, l, u, u + G, n_c, CPRE_ARGS, lds);
                  PSEC(10); }
                if (l == 0 && G == 256 && !(bid >= 64 && bid < 128)) cvt_fill(p, lds, hf == 0 ? 0 : CVT_Q1, hf == 0 ? CVT_Q0 : CVT_Q2, bid < 64 ? bid : bid - 64, 192);
                else if (l == 0 && G != 256) cvt_fill(p, lds, hf == 0 ? 0 : CVT_Q1, hf == 0 ? CVT_Q0 : CVT_Q2, bid, G);
            }
#endif
            SEAM(hb + 3);
#if !defined(ONLY) || ONLY == 6
            if (IN(hb + 4)) {
                PHASE_P(); unsigned char* ws = p.ws; bf16_t* Hh = (bf16_t*)(ws + WS_H) + (size_t)hf * MH * 1024; (void)Hh;
                pg8::Gemm g{pbuf(p, P_QB), (const bf16_t*)(ws + WS_WTBR) + (size_t)l * 3072 * 512, 3 * MH, 3072, 512};
                MergeOrder S; S.init(l == 0 ? 72 : 64, l == 0 ? 0 : 8, G, bid);
                EpiMerge E{pbuf(p, P_GB), Hh};
                pg8::gemm_phase<EpiMerge, MergeOrder>((PG8_LAS unsigned char*)lds, g, S, E, nullptr);
                if (l == 0) { const int skip = G > 64 ? 32 : 0; __syncthreads(); if (bid >= skip) cvt_fill(p, lds, hf == 0 ? CVT_Q0 : CVT_Q2, hf == 0 ? CVT_Q1 : CVT_Q3, bid - skip, G - skip); }
            }
#endif
            SEAM(hb + 4);
#if !defined(ONLY) || ONLY == 7
            if (IN(hb + 5)) {
                PHASE_P(); unsigned char* ws = p.ws; bf16_t* Hh = (bf16_t*)(ws + WS_H) + (size_t)hf * MH * 1024; (void)Hh;
                pg8::Gemm g{Hh, (const bf16_t*)(ws + WS_WTO) + (size_t)l * 1024 * 1024, MH, 1024, 1024};
                RectOrder S; S.init(l == 0 ? 72 : 64, 4, l == 0 ? 0 : 8, 0, 0, 0, G, bid);
                EpiOut E{l == 0 ? p.in[I_X] : (const float*)p.out, l == 0 ? p.in[I_CTX] : (const float*)(ws + WS_XC), p.out, (float*)(ws + WS_XC), (const float*)(ws + WS_MOD) + (size_t)l * 17 * 6144, hf};
                pg8::gemm_phase<EpiOut, RectOrder>((PG8_LAS unsigned char*)lds, g, S, E, nullptr);
                if (l == 0 && hf == 1) { const int skip = G > 64 ? 32 : 0; __syncthreads(); if (bid >= skip) cvt_fill(p, lds, CVT_Q3, CVT_Q4, bid - skip, G - skip); }
            }
#endif
            if (hf == 1) SEAM(hb + 5);
        }
#if !defined(ONLY) || ONLY == 8
        if (IN(base + 13)) { PHASE_P(); phase_norm2_router(p, l, lds); if (l == 1) cvt_fill(p, lds, CVT_Q4, 2 * CVT_TILES, bid, G); }
#endif
        SEAM(base + 13);
#if !defined(ONLY) || ONLY == 9
        if (IN(base + 14)) { PHASE_P(); phase_dispatch(p, l, lds); }
#endif
        SEAM(base + 14);
#if !defined(ONLY) || ONLY == 10
        if (IN(base + 15)) {
            PHASE_P(); unsigned char* ws = p.ws;
            LAS int* seg = (LAS int*)(lds + 131072); LAS int* tile_e = seg + 128;
            const int nt = moe_tile_table(p, l, seg, tile_e);
            pg8::Gemm g{(const bf16_t*)(ws + WS_H8), (const bf16_t*)(ws + WS_WTGU + (size_t)l * 32 * 1024 * 1024), SLOTS, 32 * 1024, 512};
            MoeOrder S; S.init(tile_e, nt, G, bid);
            { LAS int* srcl = (LAS int*)(lds + 131072 + 2048); const int* SRC = (const int*)(ws + WS_SRC);
              { const int tq = opaque_tid(); int sv[3];
#pragma unroll
                for (int j = 0; j < 3; ++j) { const int idx = tq + NTHR * j, i = idx >> 8, r = idx & 255; int pm, pn; S.unit_of(i, pm, pn); sv[j] = pm < nt ? SRC[pm * 256 + r] : 0; }
#pragma unroll
                for (int j = 0; j < 3; ++j) srcl[tq + NTHR * j] = sv[j]; }
              S.srcl = srcl; }
            __syncthreads(); EpiGU E{ws + WS_P + P_ACT};
            pg8::gemm_phase<EpiGU, MoeOrder, false, true, true>((PG8_LAS unsigned char*)lds, g, S, E, nullptr);
        }
#endif
        SEAM(base + 15);
#if !defined(ONLY) || ONLY == 11
        if (IN(base + 16)) {
            PHASE_P(); unsigned char* ws = p.ws;
            LAS int* seg = (LAS int*)(lds + 131072); LAS int* tile_e = seg + 128;
            const int nt = moe_tile_table(p, l, seg, tile_e);
            pg8::Gemm g{pbuf(p, P_ACT), (const bf16_t*)(ws + WS_WTD + (size_t)l * 32 * 1024 * 512), SLOTS, 32 * 1024, 256};
            MoeOrder S; S.init(tile_e, nt, G, bid); __syncthreads(); EpiDown E{pbuf(p, P_YS)};
            pg8::gemm_phase<EpiDown, MoeOrder, false, true>((PG8_LAS unsigned char*)lds, g, S, E, nullptr);
        }
#endif
        SEAM(base + 16);
    }
#if !defined(ONLY) || ONLY == 12
    if (IN(35)) { PHASE_P(); phase_final(p); }
#endif
#ifdef PROBE
    if (bid == 0 && tid == 0) {
        asm volatile("s_waitcnt vmcnt(0)" ::: "memory");
        const unsigned long long tend = __builtin_amdgcn_s_memrealtime();
        volatile unsigned long long* st = (volatile unsigned long long*)(opaque_kp()->ws + WS_CTL) + 30000;
        unsigned long long ta = 0, tb = 0;
        for (int k = 0; k < N_PHASES; ++k) { const unsigned long long t0 = st[k], t1 = (k == N_PHASES - 1) ? tend : st[k + 1]; const unsigned long long d = t1 - t0;
            if ((PROBE_A >> k) & 1ull) ta += d; if ((PROBE_B >> k) & 1ull) tb += st[100 + k]; }
        const unsigned long long spin = ((ta + tb) / 1000ull) * 100000ull;
        while (__builtin_amdgcn_s_memrealtime() - tend < spin) __builtin_amdgcn_s_sleep(32);
    }
#endif
#undef IN
#undef SEAM
}

#ifndef MK_CUTS
#define MK_CUTS 0
#endif
extern "C" void kernel_launch(void* const* d_in, const int* in_sizes, int n_in, void* d_out, int out_size, void* d_ws, size_t ws_size, hipStream_t stream) {
    static int grid = 0;
    if (grid == 0) {
        if (n_in != 31 || in_sizes[0] != NBATCH * SEQ * DM || out_size != NBATCH * SEQ * DM || ws_size < WS_END) {
            fprintf(stderr, "kernel_launch: unexpected shapes or workspace (n_in %d, ws %zu, need %zu); nothing launched\n", n_in, ws_size, (size_t)WS_END); grid = -1; return; }
        int dev = 0, cus = 0, per_cu = 0;
        if (hipGetDevice(&dev) != hipSuccess || hipDeviceGetAttribute(&cus, hipDeviceAttributeMultiprocessorCount, dev) != hipSuccess) { grid = -1; return; }
        if (hipFuncSetAttribute((const void*)mk_fwd, hipFuncAttributeMaxDynamicSharedMemorySize, LDS_BYTES) != hipSuccess) { fprintf(stderr, "kernel_launch: hipFuncSetAttribute failed\n"); grid = -1; return; }
        if (hipOccupancyMaxActiveBlocksPerMultiprocessor(&per_cu, (const void*)mk_fwd, NTHR, LDS_BYTES) != hipSuccess || per_cu < 1) { fprintf(stderr, "kernel_launch: occupancy query says %d\n", per_cu); }
        (void)hipGetLastError();
        grid = cus;
    }
    if (grid < 0) return;
    if (hipMemsetAsync((char*)d_ws + WS_CTL, 0, CTL_BYTES, stream) != hipSuccess) return;
    Params p{};
    for (int i = 0; i < 31; ++i) p.in[i] = (const float*)d_in[i];
    p.out = (float*)d_out; p.ws = (unsigned char*)d_ws;
#if MK_CUTS == 0
    p.ph_lo = 0; p.ph_hi = N_PHASES;
    hipLaunchKernelGGL(mk_fwd, dim3(grid), dim3(NTHR), LDS_BYTES, stream, p, 0);
#else
    for (int k = 0; k < N_PHASES; ++k) {
#ifdef EXP_NOMOE
        if ((k >= 14 && k <= 17) || (k >= 31 && k <= 34)) continue;
#endif
#ifdef EXP_NOEXPERT
        if (k == 16 || k == 17 || k == 33 || k == 34) continue;
#endif
#ifdef EXP_NOGU
        if (k == 16 || k == 33) continue;
#endif
#ifdef EXP_NOMIX
        if ((k >= 2 && k <= 13) || (k >= 19 && k <= 30)) continue;
#endif
#ifdef EXP_ZEROXB
        if (k == 15 || k == 32) { hipMemsetAsync((char*)d_ws + WS_P + P_XB, 0, P_MOE_END, stream); hipMemsetAsync((char*)d_ws + WS_WTS, 0, (size_t)SLOTS * 4, stream); }
#endif
        p.ph_lo = k; p.ph_hi = k + 1; hipLaunchKernelGGL(mk_fwd, dim3(grid), dim3(NTHR), LDS_BYTES, stream, p, 0); }
#endif
}
```
